# Optimizing an MI355X kernel written in HIP

```python
import jax, jax.numpy as jnp
from jax import lax
import numpy as np

D_MODEL = 2048
BATCH = 4
SEQ = 4096
DEPTH = 2

N_MIXERS = 2
BLOCK = 128
NEG_INF = -1e30
RMS_EPS = 1e-6
FOX_HEAD_DIM = 64
FOX_HEADS = D_MODEL // FOX_HEAD_DIM
FOX_WIDTH = FOX_HEADS * FOX_HEAD_DIM
FOX_IN = 4 * FOX_WIDTH + FOX_HEADS
SWA_HEAD_DIM = 64
SWA_Q_HEADS = D_MODEL // SWA_HEAD_DIM
SWA_KV_HEADS = SWA_Q_HEADS // 8
SWA_GROUP = SWA_Q_HEADS // SWA_KV_HEADS
SWA_WINDOW = 128
SWA_WIDTH = SWA_Q_HEADS * SWA_HEAD_DIM
SWA_KV_WIDTH = SWA_KV_HEADS * SWA_HEAD_DIM
SWA_IN = 2 * SWA_WIDTH + 2 * SWA_KV_WIDTH
ROPE_THETA = 500000.0
ROT_DIM = SWA_HEAD_DIM // 4
N_FOX_LAYERS = (DEPTH + 1) // 2
N_SWA_LAYERS = DEPTH // 2

kernel_name = "fox_swa_sink_interleaved_gated_hybrid"


def rmsnorm(x, g):
    x32 = x.astype(jnp.float32)
    y = x32 * lax.rsqrt(jnp.mean(x32 * x32, axis=-1, keepdims=True) + RMS_EPS)
    return (y * g.astype(jnp.float32)).astype(x.dtype)


def partial_rope(x, pos):
    half = ROT_DIM // 2
    inv_freq = ROPE_THETA ** (-jnp.arange(half, dtype=jnp.float32) / half)
    ang = pos[:, None] * inv_freq[None, :]
    cos = jnp.cos(ang)[None, :, None, :]
    sin = jnp.sin(ang)[None, :, None, :]
    x32 = x.astype(jnp.float32)
    x1, x2 = x32[..., :half], x32[..., half:ROT_DIM]
    rot = jnp.concatenate([x1 * cos - x2 * sin, x2 * cos + x1 * sin], axis=-1)
    return jnp.concatenate([rot.astype(x.dtype), x[..., ROT_DIM:]], axis=-1)


def fox_attention(q, k, v, log_f):
    B, S, H, d = q.shape
    nb = S // BLOCK
    scale = d ** -0.5
    c = jnp.cumsum(log_f, axis=1).transpose(0, 2, 1)
    kf = k.astype(jnp.float32)
    key_pos = jnp.arange(S)
    qb = q.reshape(B, nb, BLOCK, H, d).transpose(1, 0, 2, 3, 4)
    cb = c.reshape(B, H, nb, BLOCK).transpose(2, 0, 1, 3)

    def one_block(args):
        qi, ci, i = args
        s = jnp.einsum('bqhd,bkhd->bhqk', qi.astype(jnp.float32), kf) * scale
        s = s + ci[..., None] - c[:, :, None, :]
        qpos = i * BLOCK + jnp.arange(BLOCK)
        mask = key_pos[None, :] <= qpos[:, None]
        s = jnp.where(mask[None, None], s, NEG_INF)
        p = jax.nn.softmax(s, axis=-1).astype(v.dtype)
        return jnp.einsum('bhqk,bkhd->bqhd', p, v)

    out = lax.map(one_block, (qb, cb, jnp.arange(nb)))
    return out.transpose(1, 0, 2, 3, 4).reshape(B, S, H * d)


def swa_attention(q, k, v, sinks):
    B, S = q.shape[:2]
    nb = S // BLOCK
    scale = SWA_HEAD_DIM ** -0.5
    qb = q.reshape(B, nb, BLOCK, SWA_KV_HEADS, SWA_GROUP, SWA_HEAD_DIM)

    def band(t):
        tp = jnp.pad(t, ((0, 0), (BLOCK, 0), (0, 0), (0, 0)))
        tp = tp.reshape(B, nb + 1, BLOCK, SWA_KV_HEADS, SWA_HEAD_DIM)
        return jnp.concatenate([tp[:, :-1], tp[:, 1:]], axis=2)

    kw, vw = band(k), band(v)
    s = jnp.einsum('bnqhgd,bnkhd->bnhgqk', qb.astype(jnp.float32), kw.astype(jnp.float32)) * scale
    t_loc = jnp.arange(BLOCK)[:, None]
    j_loc = jnp.arange(2 * BLOCK)[None, :]
    diff = t_loc + BLOCK - j_loc
    key_abs = (jnp.arange(nb)[:, None, None] - 1) * BLOCK + j_loc[None]
    mask = (diff >= 0)[None] & (diff < SWA_WINDOW)[None] & (key_abs >= 0)
    s = jnp.where(mask[None, :, None, None], s, NEG_INF)
    sink = sinks.astype(jnp.float32).reshape(SWA_KV_HEADS, SWA_GROUP)[None, None, :, :, None, None]
    m = jnp.maximum(jnp.max(s, axis=-1, keepdims=True), sink)
    e = jnp.exp(s - m)
    denom = jnp.sum(e, axis=-1, keepdims=True) + jnp.exp(sink - m)
    p = (e / denom).astype(v.dtype)
    o = jnp.einsum('bnhgqk,bnkhd->bnqhgd', p, vw)
    return o.reshape(B, S, SWA_WIDTH)


def setup_inputs(seed: int = 0) -> dict:
    key = jax.random.key(seed)
    ks = jax.random.split(key, 10)
    x = jax.random.normal(ks[0], (BATCH, SEQ, D_MODEL), jnp.float32)
    norm_g = 1.0 + 0.02 * jax.random.normal(ks[1], (DEPTH, D_MODEL), jnp.float32)
    fox_w_in = jax.random.normal(ks[2], (N_FOX_LAYERS, D_MODEL, FOX_IN), jnp.float32) * D_MODEL ** -0.5
    fox_b_f = (jnp.linspace(1.0, 6.0, FOX_HEADS, dtype=jnp.float32)[None, :]
               + 0.1 * jax.random.normal(ks[3], (N_FOX_LAYERS, FOX_HEADS), jnp.float32))
    fox_w_out = jax.random.normal(ks[4], (N_FOX_LAYERS, FOX_WIDTH, D_MODEL), jnp.float32) * FOX_WIDTH ** -0.5
    swa_w_in = jax.random.normal(ks[5], (N_SWA_LAYERS, D_MODEL, SWA_IN), jnp.float32) * D_MODEL ** -0.5
    swa_sinks = 0.5 * jax.random.normal(ks[6], (N_SWA_LAYERS, SWA_Q_HEADS), jnp.float32)
    swa_w_out = jax.random.normal(ks[7], (N_SWA_LAYERS, SWA_WIDTH, D_MODEL), jnp.float32) * SWA_WIDTH ** -0.5
    final_g = 1.0 + 0.02 * jax.random.normal(ks[8], (D_MODEL,), jnp.float32)
    return {"x": x, "norm_g": norm_g, "fox_w_in": fox_w_in, "fox_b_f": fox_b_f,
            "fox_w_out": fox_w_out, "swa_w_in": swa_w_in, "swa_sinks": swa_sinks,
            "swa_w_out": swa_w_out, "final_g": final_g}


def reference(x, norm_g, fox_w_in, fox_b_f, fox_w_out, swa_w_in, swa_sinks, swa_w_out, final_g):
    B, S, _ = x.shape
    pos = jnp.arange(S, dtype=jnp.float32)
    for i in range(DEPTH):
        h = rmsnorm(x, norm_g[i])
        j = i // N_MIXERS
        if i % N_MIXERS == 0:
            p = h @ fox_w_in[j]
            W = FOX_WIDTH
            q = p[..., :W].reshape(B, S, FOX_HEADS, FOX_HEAD_DIM)
            k = p[..., W:2 * W].reshape(B, S, FOX_HEADS, FOX_HEAD_DIM)
            v = p[..., 2 * W:3 * W].reshape(B, S, FOX_HEADS, FOX_HEAD_DIM)
            gate = p[..., 3 * W:4 * W]
            log_f = jax.nn.log_sigmoid(p[..., 4 * W:].astype(jnp.float32) + fox_b_f[j].astype(jnp.float32))
            y = fox_attention(q, k, v, log_f)
            w_out = fox_w_out[j]
        else:
            p = h @ swa_w_in[j]
            WQ, WK = SWA_WIDTH, SWA_KV_WIDTH
            q = p[..., :WQ].reshape(B, S, SWA_Q_HEADS, SWA_HEAD_DIM)
            k = p[..., WQ:WQ + WK].reshape(B, S, SWA_KV_HEADS, SWA_HEAD_DIM)
            v = p[..., WQ + WK:WQ + 2 * WK].reshape(B, S, SWA_KV_HEADS, SWA_HEAD_DIM)
            gate = p[..., WQ + 2 * WK:]
            q = partial_rope(q, pos)
            k = partial_rope(k, pos)
            y = swa_attention(q, k, v, swa_sinks[j])
            w_out = swa_w_out[j]
        y = y * jax.nn.silu(gate)
        x = x + y @ w_out
    return rmsnorm(x, final_g)
```

```cpp
#include <hip/hip_runtime.h>
#include <cstdio>
#include <cstdint>

constexpr int NB = 4, SEQ = 4096, DM = 2048, MTOK = NB * SEQ, NH = 32, HD = 64;
constexpr int FOX_IN = 8224, SWA_IN = 4608, KVW = 256;
constexpr float RMS_EPS = 1e-6f;
constexpr float LOG2E = 1.4426950408889634f;
constexpr float C2 = 0.125f * LOG2E;

typedef unsigned short bf16_t;
__device__ __forceinline__ float bf2f(bf16_t v) { return __uint_as_float((unsigned)v << 16); }
__device__ __forceinline__ bf16_t f2bf(float f) { unsigned u = __float_as_uint(f); return (bf16_t)((u + 0x7fffu + ((u >> 16) & 1u)) >> 16); }
__device__ __forceinline__ float logsigmoidf(float z) { return z < 0.f ? z - log1pf(expf(z)) : -log1pf(expf(-z)); }
__device__ __forceinline__ float siluf(float g) { return g / (1.f + expf(-g)); }

constexpr size_t MiB = 1u << 20;
constexpr size_t WS_CTL = 0, CTL_ZERO_BYTES = 1 * MiB;
constexpr size_t WS_SS1 = 512 * 1024;
constexpr size_t WS_R0 = 1 * MiB;
constexpr size_t WS_ROPE = 1 * MiB + 512 * 1024;
constexpr size_t WS_LOGF = 2 * MiB;
constexpr size_t WS_CUM = 4 * MiB;
constexpr size_t WS_W1T = 8 * MiB, WS_W2T = 41 * MiB, WS_W3T = 49 * MiB, WS_W4T = 67 * MiB;
constexpr size_t WS_XB = 76 * MiB, WS_Q = 140 * MiB, WS_K = 204 * MiB, WS_V = 268 * MiB, WS_G = 332 * MiB, WS_YG = 396 * MiB, WS_END = 460 * MiB;

__global__ __launch_bounds__(256) void n_rowrms(const float* x, float* R) {
    const int row = blockIdx.x * 4 + (threadIdx.x >> 6), lane = threadIdx.x & 63;
    const float* xr = x + (size_t)row * DM; float s = 0.f;
    for (int i = lane; i < DM; i += 64) { const float v = xr[i]; s += v * v; }
#pragma unroll
    for (int o = 1; o < 64; o <<= 1) s += __shfl_xor(s, o);
    if (lane == 0) R[row] = 1.0f / sqrtf(s * (1.f / DM) + RMS_EPS);
}
__device__ __forceinline__ float toF(float v) { return v; }
__device__ __forceinline__ float toF(bf16_t v) { return bf2f(v); }

template <class AT, class Epi>
__global__ __launch_bounds__(256) void n_gemm(const AT* A, int lda, const float* kscale, const float* W, int ldw, int Kd, int N, Epi epi) {
    __shared__ float As[16][68]; __shared__ float Bs[16][68];
    const int tx = threadIdx.x & 15, ty = threadIdx.x >> 4;
    const int row0 = blockIdx.y * 64, col0 = blockIdx.x * 64;
    float acc[4][4];
#pragma unroll
    for (int i = 0; i < 4; ++i)
#pragma unroll
        for (int j = 0; j < 4; ++j) acc[i][j] = 0.f;
    for (int k0 = 0; k0 < Kd; k0 += 16) {
        for (int i = threadIdx.x; i < 1024; i += 256) { const int r = i >> 4, kk = i & 15; float a = toF(A[(size_t)(row0 + r) * lda + k0 + kk]); if (kscale) a *= kscale[k0 + kk]; As[kk][r] = a; }
        for (int i = threadIdx.x; i < 1024; i += 256) { const int kk = i >> 6, c = i & 63, col = col0 + c; Bs[kk][c] = col < N ? W[(size_t)(k0 + kk) * ldw + col] : 0.f; }
        __syncthreads();
#pragma unroll
        for (int kk = 0; kk < 16; ++kk) {
            const float4 a = *(const float4*)&As[kk][ty * 4]; const float4 b = *(const float4*)&Bs[kk][tx * 4];
            const float av[4] = {a.x, a.y, a.z, a.w}, bv[4] = {b.x, b.y, b.z, b.w};
#pragma unroll
            for (int i = 0; i < 4; ++i)
#pragma unroll
                for (int j = 0; j < 4; ++j) acc[i][j] = fmaf(av[i], bv[j], acc[i][j]);
        }
        __syncthreads();
    }
#pragma unroll
    for (int i = 0; i < 4; ++i)
#pragma unroll
        for (int j = 0; j < 4; ++j) { const int row = row0 + ty * 4 + i, col = col0 + tx * 4 + j; if (col < N) epi(row, col, acc[i][j]); }
}
struct NEpiFoxIn {
    bf16_t *Q, *K, *V, *G; float* LOGF; const float* R0; const float* bfb;
    __device__ void operator()(int row, int col, float v) const {
        v *= R0[row];
        if (col < 2048) Q[(size_t)row * DM + col] = f2bf(v * C2);
        else if (col < 4096) K[(size_t)row * DM + col - 2048] = f2bf(v);
        else if (col < 6144) V[(size_t)row * DM + col - 4096] = f2bf(v);
        else if (col < 8192) G[(size_t)row * DM + col - 6144] = f2bf(siluf(v));
        else { const int h = col - 8192, b = row >> 12, s = row & 4095; LOGF[((size_t)(b * NH + h) << 12) + s] = logsigmoidf(v + bfb[h]); }
    }
};
struct NEpiOut1 {
    const float* xin; float* xout; bf16_t* XB; float* SS;
    __device__ void operator()(int row, int col, float v) const {
        const size_t o = (size_t)row * DM + col; const float x1 = xin[o] + v; xout[o] = x1; XB[o] = f2bf(x1); atomicAdd(&SS[row], x1 * x1);
    }
};
struct NEpiSwaIn {
    bf16_t *Q, *K, *V, *G; const float* SS;
    __device__ void operator()(int row, int col, float v) const {
        v *= 1.0f / sqrtf(SS[row] * (1.f / DM) + RMS_EPS);
        if (col < 2048) Q[(size_t)row * DM + col] = f2bf(v * C2);
        else if (col < 2304) K[(size_t)row * KVW + col - 2048] = f2bf(v);
        else if (col < 2560) V[(size_t)row * KVW + col - 2304] = f2bf(v);
        else G[(size_t)row * DM + col - 2560] = f2bf(siluf(v));
    }
};
struct NEpiOut2 { float* xio; __device__ void operator()(int row, int col, float v) const { const size_t o = (size_t)row * DM + col; xio[o] = xio[o] + v; } };

__global__ void n_rope(bf16_t* T, int pitch, int nheads) {
    const long idx = (long)blockIdx.x * blockDim.x + threadIdx.x; const long total = (long)MTOK * nheads * 8; if (idx >= total) return;
    const int i = idx & 7; const long rh = idx >> 3; const int hh = rh % nheads; const long row = rh / nheads; const int pos = row & 4095;
    const double inv = pow(500000.0, -(double)i / 8.0); const float ang = (float)pos * (float)inv;
    const float c = cosf(ang), s = sinf(ang);
    bf16_t* p = T + (size_t)row * pitch + hh * 64 + i; const float x1 = bf2f(p[0]), x2 = bf2f(p[8]);
    p[0] = f2bf(x1 * c - x2 * s); p[8] = f2bf(x2 * c + x1 * s);
}
__global__ void n_cumsum(const float* LOGF, float* CUM) {
    const int sidx = blockIdx.x * blockDim.x + threadIdx.x; if (sidx >= NB * NH) return;
    const float* lf = LOGF + (size_t)sidx * SEQ; float* c = CUM + (size_t)sidx * SEQ; double a = 0.0;
    for (int s = 0; s < SEQ; ++s) { a += (double)lf[s]; c[s] = (float)(a * 1.4426950408889634); }
}
template <int MODE>
__global__ __launch_bounds__(256) void n_attn(const bf16_t* Q, const bf16_t* K, const bf16_t* V, const float* CUM, const float* sinks, const bf16_t* G, bf16_t* YG) {
    __shared__ float Ks[64][64]; __shared__ float Vs[64][64]; __shared__ float Cs[64];
    const int qb = blockIdx.x, bh = blockIdx.y, b = bh / NH, h = bh % NH, tid = threadIdx.x;
    const int t = qb * 256 + tid; const size_t row = (size_t)b * SEQ + t;
    const int kvh = MODE == 0 ? h : (h >> 3), kp = MODE == 0 ? DM : KVW;
    float q[64], o[64];
#pragma unroll
    for (int d = 0; d < 64; ++d) { q[d] = bf2f(Q[row * DM + h * 64 + d]); o[d] = 0.f; }
    const float ct = MODE == 0 ? CUM[(size_t)bh * SEQ + t] : 0.f;
    float m = MODE == 0 ? -1e30f : sinks[h] * LOG2E, l = MODE == 0 ? 0.f : 1.f;
    const int kstart = MODE == 0 ? 0 : (qb * 256 >= 128 ? qb * 256 - 128 : 0), kend = qb * 256 + 256;
    for (int k0 = kstart; k0 < kend; k0 += 64) {
        for (int i = tid; i < 4096; i += 256) { const int kk = i >> 6, d = i & 63; const size_t a = ((size_t)b * SEQ + k0 + kk) * kp + kvh * 64 + d; Ks[kk][d] = bf2f(K[a]); Vs[kk][d] = bf2f(V[a]); }
        if (MODE == 0 && tid < 64) Cs[tid] = CUM[(size_t)bh * SEQ + k0 + tid];
        __syncthreads();
        for (int kk = 0; kk < 64; ++kk) {
            const int s = k0 + kk; float sd = 0.f;
#pragma unroll
            for (int d = 0; d < 64; ++d) sd = fmaf(q[d], Ks[kk][d], sd);
            if (MODE == 0) sd += ct - Cs[kk];
            const bool ok = MODE == 0 ? (s <= t) : (s <= t && t - s < 128);
            if (!ok) sd = -INFINITY;
            const float mn = fmaxf(m, sd), a = exp2f(m - mn), p = exp2f(sd - mn);
            l = l * a + p;
#pragma unroll
            for (int d = 0; d < 64; ++d) o[d] = fmaf(p, Vs[kk][d], o[d] * a);
            m = mn;
        }
        __syncthreads();
    }
    const float rl = 1.f / l;
#pragma unroll
    for (int d = 0; d < 64; ++d) { const size_t a = row * DM + h * 64 + d; YG[a] = f2bf(o[d] * rl * bf2f(G[a])); }
}
__global__ __launch_bounds__(256) void n_finalnorm(float* xio, const float* g) {
    const int row = blockIdx.x * 4 + (threadIdx.x >> 6), lane = threadIdx.x & 63;
    float* xr = xio + (size_t)row * DM; float s = 0.f;
    for (int i = lane; i < DM; i += 64) { const float v = xr[i]; s += v * v; }
#pragma unroll
    for (int o = 1; o < 64; o <<= 1) s += __shfl_xor(s, o);
    const float r = 1.0f / sqrtf(s * (1.f / DM) + RMS_EPS);
    for (int i = lane; i < DM; i += 64) xr[i] = xr[i] * r * g[i];
}

extern "C" void kernel_launch(void* const* d_in, const int* in_sizes, int n_in, void* d_out, int out_size, void* d_ws, size_t ws_size, hipStream_t stream) {
    if (n_in != 9 || in_sizes[0] != MTOK * DM || out_size != MTOK * DM || ws_size < WS_END) { fprintf(stderr, "kernel_launch: unexpected shapes (n_in %d, in0 %d, out %d, ws %zu)\n", n_in, n_in > 0 ? in_sizes[0] : -1, out_size, ws_size); return; }
    const float* x = (const float*)d_in[0]; const float* norm_g = (const float*)d_in[1]; const float* fox_w_in = (const float*)d_in[2]; const float* fox_b_f = (const float*)d_in[3];
    const float* fox_w_out = (const float*)d_in[4]; const float* swa_w_in = (const float*)d_in[5]; const float* swa_sinks = (const float*)d_in[6]; const float* swa_w_out = (const float*)d_in[7];
    const float* final_g = (const float*)d_in[8];
    float* out = (float*)d_out; unsigned char* ws = (unsigned char*)d_ws;
    float* SS1 = (float*)(ws + WS_SS1); float* R0 = (float*)(ws + WS_R0); float* LOGF = (float*)(ws + WS_LOGF); float* CUM = (float*)(ws + WS_CUM);
    bf16_t* XB = (bf16_t*)(ws + WS_XB); bf16_t* Q = (bf16_t*)(ws + WS_Q); bf16_t* K = (bf16_t*)(ws + WS_K); bf16_t* V = (bf16_t*)(ws + WS_V); bf16_t* G = (bf16_t*)(ws + WS_G); bf16_t* YG = (bf16_t*)(ws + WS_YG);
    (void)hipMemsetAsync(ws + WS_CTL, 0, CTL_ZERO_BYTES, stream);
    n_rowrms<<<MTOK / 4, 256, 0, stream>>>(x, R0);
    n_gemm<float, NEpiFoxIn><<<dim3((FOX_IN + 63) / 64, MTOK / 64), 256, 0, stream>>>(x, DM, norm_g, fox_w_in, FOX_IN, DM, FOX_IN, NEpiFoxIn{Q, K, V, G, LOGF, R0, fox_b_f});
    n_cumsum<<<2, 64, 0, stream>>>(LOGF, CUM);
    n_attn<0><<<dim3(SEQ / 256, NB * NH), 256, 0, stream>>>(Q, K, V, CUM, nullptr, G, YG);
    n_gemm<bf16_t, NEpiOut1><<<dim3(DM / 64, MTOK / 64), 256, 0, stream>>>(YG, DM, nullptr, fox_w_out, DM, DM, DM, NEpiOut1{x, out, XB, SS1});
    n_gemm<float, NEpiSwaIn><<<dim3(SWA_IN / 64, MTOK / 64), 256, 0, stream>>>(out, DM, norm_g + DM, swa_w_in, SWA_IN, DM, SWA_IN, NEpiSwaIn{Q, K, V, G, SS1});
    n_rope<<<(MTOK * NH * 8 + 255) / 256, 256, 0, stream>>>(Q, DM, NH);
    n_rope<<<(MTOK * 4 * 8 + 255) / 256, 256, 0, stream>>>(K, KVW, 4);
    n_attn<1><<<dim3(SEQ / 256, NB * NH), 256, 0, stream>>>(Q, K, V, nullptr, swa_sinks, G, YG);
    n_gemm<bf16_t, NEpiOut2><<<dim3(DM / 64, MTOK / 64), 256, 0, stream>>>(YG, DM, nullptr, swa_w_out, DM, DM, DM, NEpiOut2{out});
    n_finalnorm<<<MTOK / 4, 256, 0, stream>>>(out, final_g);
}
```

```cpp
#include <hip/hip_runtime.h>
#include <cstdio>
#include <cstdint>

constexpr int NB = 4, SEQ = 4096, DM = 2048, MTOK = NB * SEQ, NH = 32, HD = 64;
constexpr int FOX_IN = 8224, SWA_IN = 4608, KVW = 256;
constexpr float RMS_EPS = 1e-6f;
constexpr float LOG2E = 1.4426950408889634f;
constexpr float C2 = 0.125f * LOG2E;

typedef unsigned short bf16_t;
__device__ __forceinline__ float bf2f(bf16_t v) { return __uint_as_float((unsigned)v << 16); }
__device__ __forceinline__ bf16_t f2bf(float f) { unsigned u = __float_as_uint(f); return (bf16_t)((u + 0x7fffu + ((u >> 16) & 1u)) >> 16); }
__device__ __forceinline__ float logsigmoidf(float z) { return z < 0.f ? z - log1pf(expf(z)) : -log1pf(expf(-z)); }
__device__ __forceinline__ float siluf(float g) { return g / (1.f + expf(-g)); }

constexpr size_t MiB = 1u << 20;
constexpr size_t WS_CTL = 0, CTL_ZERO_BYTES = 1 * MiB;
constexpr size_t WS_KMAX = 64 * 1024, WS_TICKET = 65 * 1024;
constexpr size_t WS_SS1 = 512 * 1024;
constexpr size_t WS_R0 = 1 * MiB;
constexpr size_t WS_ROPE = 1 * MiB + 512 * 1024;
constexpr size_t WS_LOGF = 2 * MiB;
constexpr size_t WS_CUM = 4 * MiB;
constexpr size_t WS_W1T = 8 * MiB, WS_W2T = 41 * MiB, WS_W3T = 49 * MiB, WS_W4T = 67 * MiB;
constexpr size_t WS_XB = 76 * MiB, WS_Q = 140 * MiB, WS_K = 204 * MiB, WS_V = 268 * MiB, WS_G = 332 * MiB, WS_YG = 396 * MiB, WS_END = 460 * MiB;

#ifndef FAST_MASK
#define FAST_MASK 0x1FF
#endif
#ifndef DUP_MASK
#define DUP_MASK 0x000
#endif
#ifndef ONE_LAUNCH
#define ONE_LAUNCH 1
#endif
#if FAST_MASK != 0x1FF
__global__ __launch_bounds__(256) void n_rowrms(const float* x, float* R) {
    const int row = blockIdx.x * 4 + (threadIdx.x >> 6), lane = threadIdx.x & 63;
    const float* xr = x + (size_t)row * DM; float s = 0.f;
    for (int i = lane; i < DM; i += 64) { const float v = xr[i]; s += v * v; }
#pragma unroll
    for (int o = 1; o < 64; o <<= 1) s += __shfl_xor(s, o);
    if (lane == 0) R[row] = 1.0f / sqrtf(s * (1.f / DM) + RMS_EPS);
}
__device__ __forceinline__ float toF(float v) { return v; }
__device__ __forceinline__ float toF(bf16_t v) { return bf2f(v); }

template <class AT, class Epi>
__global__ __launch_bounds__(256) void n_gemm(const AT* A, int lda, const float* kscale, const float* W, int ldw, int Kd, int N, Epi epi) {
    __shared__ float As[16][68]; __shared__ float Bs[16][68];
    const int tx = threadIdx.x & 15, ty = threadIdx.x >> 4;
    const int row0 = blockIdx.y * 64, col0 = blockIdx.x * 64;
    float acc[4][4];
#pragma unroll
    for (int i = 0; i < 4; ++i)
#pragma unroll
        for (int j = 0; j < 4; ++j) acc[i][j] = 0.f;
    for (int k0 = 0; k0 < Kd; k0 += 16) {
        for (int i = threadIdx.x; i < 1024; i += 256) { const int r = i >> 4, kk = i & 15; float a = toF(A[(size_t)(row0 + r) * lda + k0 + kk]); if (kscale) a *= kscale[k0 + kk]; As[kk][r] = a; }
        for (int i = threadIdx.x; i < 1024; i += 256) { const int kk = i >> 6, c = i & 63, col = col0 + c; Bs[kk][c] = col < N ? W[(size_t)(k0 + kk) * ldw + col] : 0.f; }
        __syncthreads();
#pragma unroll
        for (int kk = 0; kk < 16; ++kk) {
            const float4 a = *(const float4*)&As[kk][ty * 4]; const float4 b = *(const float4*)&Bs[kk][tx * 4];
            const float av[4] = {a.x, a.y, a.z, a.w}, bv[4] = {b.x, b.y, b.z, b.w};
#pragma unroll
            for (int i = 0; i < 4; ++i)
#pragma unroll
                for (int j = 0; j < 4; ++j) acc[i][j] = fmaf(av[i], bv[j], acc[i][j]);
        }
        __syncthreads();
    }
#pragma unroll
    for (int i = 0; i < 4; ++i)
#pragma unroll
        for (int j = 0; j < 4; ++j) { const int row = row0 + ty * 4 + i, col = col0 + tx * 4 + j; if (col < N) epi(row, col, acc[i][j]); }
}
struct NEpiFoxIn {
    bf16_t *Q, *K, *V, *G; float* LOGF; const float* R0; const float* bfb;
    __device__ void operator()(int row, int col, float v) const {
        v *= R0[row];
        if (col < 2048) Q[(size_t)row * DM + col] = f2bf(v * C2);
        else if (col < 4096) K[(size_t)row * DM + col - 2048] = f2bf(v);
        else if (col < 6144) V[(size_t)row * DM + col - 4096] = f2bf(v);
        else if (col < 8192) G[(size_t)row * DM + col - 6144] = f2bf(siluf(v));
        else { const int h = col - 8192, b = row >> 12, s = row & 4095; LOGF[((size_t)(b * NH + h) << 12) + s] = logsigmoidf(v + bfb[h]); }
    }
};
struct NEpiOut1 {
    const float* xin; float* xout; bf16_t* XB; float* SS;
    __device__ void operator()(int row, int col, float v) const {
        const size_t o = (size_t)row * DM + col; const float x1 = xin[o] + v; xout[o] = x1; XB[o] = f2bf(x1); atomicAdd(&SS[row], x1 * x1);
    }
};
struct NEpiSwaIn {
    bf16_t *Q, *K, *V, *G; const float* SS;
    __device__ void operator()(int row, int col, float v) const {
        v *= 1.0f / sqrtf(SS[row] * (1.f / DM) + RMS_EPS);
        if (col < 2048) Q[(size_t)row * DM + col] = f2bf(v * C2);
        else if (col < 2304) K[(size_t)row * KVW + col - 2048] = f2bf(v);
        else if (col < 2560) V[(size_t)row * KVW + col - 2304] = f2bf(v);
        else G[(size_t)row * DM + col - 2560] = f2bf(siluf(v));
    }
};
struct NEpiOut2 { float* xio; __device__ void operator()(int row, int col, float v) const { const size_t o = (size_t)row * DM + col; xio[o] = xio[o] + v; } };

__global__ void n_rope(bf16_t* T, int pitch, int nheads) {
    const long idx = (long)blockIdx.x * blockDim.x + threadIdx.x; const long total = (long)MTOK * nheads * 8; if (idx >= total) return;
    const int i = idx & 7; const long rh = idx >> 3; const int hh = rh % nheads; const long row = rh / nheads; const int pos = row & 4095;
    const double inv = pow(500000.0, -(double)i / 8.0); const float ang = (float)pos * (float)inv;
    const float c = cosf(ang), s = sinf(ang);
    bf16_t* p = T + (size_t)row * pitch + hh * 64 + i; const float x1 = bf2f(p[0]), x2 = bf2f(p[8]);
    p[0] = f2bf(x1 * c - x2 * s); p[8] = f2bf(x2 * c + x1 * s);
}
__global__ void n_cumsum(const float* LOGF, float* CUM) {
    const int sidx = blockIdx.x * blockDim.x + threadIdx.x; if (sidx >= NB * NH) return;
    const float* lf = LOGF + (size_t)sidx * SEQ; float* c = CUM + (size_t)sidx * SEQ; double a = 0.0;
    for (int s = 0; s < SEQ; ++s) { a += (double)lf[s]; c[s] = (float)(a * 1.4426950408889634); }
}
template <int MODE>
__global__ __launch_bounds__(256) void n_attn(const bf16_t* Q, const bf16_t* K, const bf16_t* V, const float* CUM, const float* sinks, const bf16_t* G, bf16_t* YG) {
    __shared__ float Ks[64][64]; __shared__ float Vs[64][64]; __shared__ float Cs[64];
    const int qb = blockIdx.x, bh = blockIdx.y, b = bh / NH, h = bh % NH, tid = threadIdx.x;
    const int t = qb * 256 + tid; const size_t row = (size_t)b * SEQ + t;
    const int kvh = MODE == 0 ? h : (h >> 3), kp = MODE == 0 ? DM : KVW;
    float q[64], o[64];
#pragma unroll
    for (int d = 0; d < 64; ++d) { q[d] = bf2f(Q[row * DM + h * 64 + d]); o[d] = 0.f; }
    const float ct = MODE == 0 ? CUM[(size_t)bh * SEQ + t] : 0.f;
    float m = MODE == 0 ? -1e30f : sinks[h] * LOG2E, l = MODE == 0 ? 0.f : 1.f;
    const int kstart = MODE == 0 ? 0 : (qb * 256 >= 128 ? qb * 256 - 128 : 0), kend = qb * 256 + 256;
    for (int k0 = kstart; k0 < kend; k0 += 64) {
        for (int i = tid; i < 4096; i += 256) { const int kk = i >> 6, d = i & 63; const size_t a = ((size_t)b * SEQ + k0 + kk) * kp + kvh * 64 + d; Ks[kk][d] = bf2f(K[a]); Vs[kk][d] = bf2f(V[a]); }
        if (MODE == 0 && tid < 64) Cs[tid] = CUM[(size_t)bh * SEQ + k0 + tid];
        __syncthreads();
        for (int kk = 0; kk < 64; ++kk) {
            const int s = k0 + kk; float sd = 0.f;
#pragma unroll
            for (int d = 0; d < 64; ++d) sd = fmaf(q[d], Ks[kk][d], sd);
            if (MODE == 0) sd += ct - Cs[kk];
            const bool ok = MODE == 0 ? (s <= t) : (s <= t && t - s < 128);
            if (!ok) sd = -INFINITY;
            const float mn = fmaxf(m, sd), a = exp2f(m - mn), p = exp2f(sd - mn);
            l = l * a + p;
#pragma unroll
            for (int d = 0; d < 64; ++d) o[d] = fmaf(p, Vs[kk][d], o[d] * a);
            m = mn;
        }
        __syncthreads();
    }
    const float rl = 1.f / l;
#pragma unroll
    for (int d = 0; d < 64; ++d) { const size_t a = row * DM + h * 64 + d; YG[a] = f2bf(o[d] * rl * bf2f(G[a])); }
}
__global__ __launch_bounds__(256) void n_finalnorm(float* xio, const float* g) {
    const int row = blockIdx.x * 4 + (threadIdx.x >> 6), lane = threadIdx.x & 63;
    float* xr = xio + (size_t)row * DM; float s = 0.f;
    for (int i = lane; i < DM; i += 64) { const float v = xr[i]; s += v * v; }
#pragma unroll
    for (int o = 1; o < 64; o <<= 1) s += __shfl_xor(s, o);
    const float r = 1.0f / sqrtf(s * (1.f / DM) + RMS_EPS);
    for (int i = lane; i < DM; i += 64) xr[i] = xr[i] * r * g[i];
}

#endif
namespace pg8 {
#define PG8_LAS __attribute__((address_space(3)))
typedef unsigned short bf16_t;
typedef short bf16x8 __attribute__((ext_vector_type(8)));
typedef float f32x4 __attribute__((ext_vector_type(4)));
typedef unsigned u32x4 __attribute__((ext_vector_type(4)));
constexpr int BM = 256, BK = 64, HALF = 128, HTB = HALF * BK * 2  , STAGE_BYTES = 8 * HTB, NXCD = 8, WGM = 8;

__host__ __device__ __forceinline__ int lds_byte(int r, int c) { const int st = (r >> 4) * 2 + (c >> 5), rr = r & 15, cc = c & 31, ob = rr * 64 + cc * 2; return st * 1024 + (ob ^ (((ob >> 9) & 1) << 5)); }
__host__ __device__ __forceinline__ void stage_rc(int b, int& R, int& C) { const int st = b / 1024, sb = b % 1024, swz = sb ^ (((sb >> 9) & 1) << 5); R = (st >> 1) * 16 + swz / 64; C = (st & 1) * 32 + (swz % 64) / 2; }
__host__ __device__ __forceinline__ int perm32(int rho) { const int n = rho >> 4, i = rho & 15; return 8 * (i >> 2) + 4 * n + (i & 3); }

struct Unit { int pm, pn; };
struct Gemm { const bf16_t* A; const bf16_t* Bt; int M, N, K; };

struct StaticOrder {
    int nM, nN, nwg, G, c, dup, epi2;
    __host__ __device__ void init(int M, int N, int G_, int c_, int dup_ = 0, int epi2_ = 0) { nM = M / BM; nN = N / BM; nwg = nM * nN; G = G_; c = c_; dup = dup_; epi2 = epi2_; }
    __host__ __device__ bool next(int i, Unit& u) const {
        if (dup) i >>= 1;
        const long L = (long)i * G + c; if (L >= nwg) return false;
        int wgid = (int)L; { const int q = nwg / NXCD, r = nwg % NXCD, xcd = wgid % NXCD, off = wgid / NXCD; wgid = (xcd < r ? xcd * (q + 1) : r * (q + 1) + (xcd - r) * q) + off; }
        const int nig = WGM * nN, gid = wgid / nig, fm = gid * WGM, gsz = (nM - fm) < WGM ? (nM - fm) : WGM;
        u.pm = fm + ((wgid % nig) % gsz); u.pn = (wgid % nig) / gsz; return true;
    }
    __device__ __forceinline__ void a_ready(const Unit&) const {}
    __device__ __forceinline__ void done(const Unit&) const {}
};

__device__ __forceinline__ unsigned cvt_pk_bf16(float lo, float hi) { unsigned r; asm volatile("v_cvt_pk_bf16_f32 %0, %1, %2" : "=v"(r) : "v"(lo), "v"(hi)); return r; }
__device__ __forceinline__ float silu_fast(float g) { return g * __builtin_amdgcn_rcpf(1.0f + __builtin_amdgcn_exp2f(-g * 1.4426950408889634f)); }
__device__ __forceinline__ u32x4 pack8(const f32x4 v0, const f32x4 v1) { u32x4 w; w.x = cvt_pk_bf16(v0[0], v0[1]); w.y = cvt_pk_bf16(v0[2], v0[3]); w.z = cvt_pk_bf16(v1[0], v1[1]); w.w = cvt_pk_bf16(v1[2], v1[3]); return w; }
struct EpiFoxIn {
    static constexpr bool PERM = true, AFTER_DRAIN = false;
    bf16_t *Q, *K, *V, *G; float* LOGF; const float* R0; const float* bfb;
    __device__ __forceinline__ void operator()(const f32x4 (&acc)[2][2][4][2], const Unit& u, int wr, int wc, int fr, int fq) const {
        const int row0 = u.pm * BM + wr * 64 + fr, pn = u.pn;
        if (pn < 32) {
            const int reg = pn >> 3; bf16_t* base = reg == 0 ? Q : reg == 1 ? K : reg == 2 ? V : G;
            const int col0 = (pn & 7) * BM + wc * 32 + 8 * fq;
#pragma unroll
            for (int ai = 0; ai < 2; ++ai)
#pragma unroll
                for (int m = 0; m < 4; ++m) { const int row = row0 + ai * HALF + m * 16; const float r = R0[row]; const float sc = reg == 0 ? r * C2 : r; bf16_t* rowp = base + (size_t)row * DM + col0;
#pragma unroll
                    for (int bj = 0; bj < 2; ++bj) { f32x4 v0 = acc[ai][bj][m][0] * sc, v1 = acc[ai][bj][m][1] * sc;
                        if (reg == 3) {
#pragma unroll
                            for (int j = 0; j < 4; ++j) { v0[j] = silu_fast(v0[j]); v1[j] = silu_fast(v1[j]); } }
                        *(u32x4*)(rowp + bj * HALF) = pack8(v0, v1); } }
        } else if (wc == 0) {
#pragma unroll
            for (int ai = 0; ai < 2; ++ai)
#pragma unroll
                for (int m = 0; m < 4; ++m) { const int row = row0 + ai * HALF + m * 16; const float r = R0[row]; const int b = row >> 12, s = row & 4095;
#pragma unroll
                    for (int n = 0; n < 2; ++n)
#pragma unroll
                        for (int j = 0; j < 4; ++j) { const int h = 8 * fq + 4 * n + j; LOGF[((size_t)(b * NH + h) << 12) + s] = logsigmoidf(acc[ai][0][m][n][j] * r + bfb[h]); } }
        }
    }
};
struct EpiSwaIn {
    static constexpr bool PERM = true, AFTER_DRAIN = false;
    bf16_t *Q, *K, *V, *G; const float* SS; const float* ROPE;
    __device__ __forceinline__ void operator()(const f32x4 (&acc)[2][2][4][2], const Unit& u, int wr, int wc, int fr, int fq) const {
        const int row0 = u.pm * BM + wr * 64 + fr, pn = u.pn;
        bf16_t* base; int pitch, colt; float osc = 1.f; const bool rope = pn <= 8, gate = pn >= 10;
        if (pn < 8) { base = Q; pitch = DM; colt = pn * BM; osc = C2; } else if (pn == 8) { base = K; pitch = KVW; colt = 0; } else if (pn == 9) { base = V; pitch = KVW; colt = 0; } else { base = G; pitch = DM; colt = (pn - 10) * BM; }
        const int col0 = colt + wc * 32 + 8 * fq; const bool rotw = rope && ((wc & 1) == 0); const float sgn = fq == 0 ? -1.f : 1.f; const bool rotl = fq < 2;
#pragma unroll
        for (int ai = 0; ai < 2; ++ai)
#pragma unroll
            for (int m = 0; m < 4; ++m) { const int row = row0 + ai * HALF + m * 16; const float r = 1.0f / sqrtf(SS[row] * (1.f / DM) + RMS_EPS); bf16_t* rowp = base + (size_t)row * pitch + col0;
                f32x4 c0, c1, s0, s1;
                if (rotw) { const float* rp = ROPE + (size_t)(row & 4095) * 16; c0 = *(const f32x4*)rp; c1 = *(const f32x4*)(rp + 4); s0 = *(const f32x4*)(rp + 8); s1 = *(const f32x4*)(rp + 12); }
#pragma unroll
                for (int bj = 0; bj < 2; ++bj) { f32x4 v0 = acc[ai][bj][m][0] * r, v1 = acc[ai][bj][m][1] * r;
                    if (rotw) {
#pragma unroll
                        for (int j = 0; j < 4; ++j) { const float p0 = __shfl_xor(v0[j], 16), p1 = __shfl_xor(v1[j], 16);
                            const float n0 = v0[j] * c0[j] + sgn * p0 * s0[j], n1 = v1[j] * c1[j] + sgn * p1 * s1[j];
                            v0[j] = rotl ? n0 : v0[j]; v1[j] = rotl ? n1 : v1[j]; } }
                    if (gate) {
#pragma unroll
                        for (int j = 0; j < 4; ++j) { v0[j] = silu_fast(v0[j]); v1[j] = silu_fast(v1[j]); } }
                    v0 = v0 * osc; v1 = v1 * osc;
                    *(u32x4*)(rowp + bj * HALF) = pack8(v0, v1); } }
    }
};
template <bool FIRST> struct EpiRes {
    static constexpr bool PERM = false, AFTER_DRAIN = false;
    const float* xin; float* xout; bf16_t* XB; float* SS;
    __device__ __forceinline__ void operator()(const f32x4 (&acc)[2][2][4][2], const Unit& u, int wr, int wc, int fr, int fq) const {
        typedef unsigned u32x2v __attribute__((ext_vector_type(2)));
        const int row0 = u.pm * BM + wr * 64 + fr, col0 = u.pn * BM + wc * 32 + 4 * fq;
#pragma unroll
        for (int ai = 0; ai < 2; ++ai)
#pragma unroll
            for (int m = 0; m < 4; ++m) { const int row = row0 + ai * HALF + m * 16; const size_t off = (size_t)row * DM + col0; float ss = 0.f;
#pragma unroll
                for (int bj = 0; bj < 2; ++bj)
#pragma unroll
                    for (int n = 0; n < 2; ++n) { const size_t o = off + bj * HALF + n * 16; const f32x4 x1 = *(const f32x4*)(xin + o) + acc[ai][bj][m][n]; *(f32x4*)(xout + o) = x1;
                        if (FIRST) { u32x2v w; w.x = cvt_pk_bf16(x1[0], x1[1]); w.y = cvt_pk_bf16(x1[2], x1[3]); *(u32x2v*)(XB + o) = w; ss += (x1[0] * x1[0] + x1[1] * x1[1]) + (x1[2] * x1[2] + x1[3] * x1[3]); } }
                if (FIRST) { ss += __shfl_xor(ss, 16); ss += __shfl_xor(ss, 32); if (fq == 0) atomicAdd(SS + row, ss); } }
    }
};
template <class Epi, class Sched, bool ALIGN_EPI = false, bool SP2 = false>
__device__ __forceinline__ void gemm_phase(PG8_LAS unsigned char* lds, const Gemm g, const Sched& S, const Epi& E) {
    const int tid = threadIdx.x, wid = __builtin_amdgcn_readfirstlane(tid >> 6), lane = tid & 63, wr = wid >> 2, wc = wid & 3, fr = lane & 15, fq = lane >> 4;
    const int K = g.K, nt = K / BK;
    unsigned voffA[2], voffB[2];
#pragma unroll
    for (int i = 0; i < 2; ++i) { int R, C; stage_rc(tid * 16 + i * 8192, R, C); const int Rb = Epi::PERM ? ((R & ~31) + perm32(R & 31)) : R;
        voffA[i] = (unsigned)(R * K + C) * 2u; voffB[i] = (unsigned)(Rb * K + C) * 2u; }
    const size_t kstep = (size_t)(BK * 2);
    const size_t hstep = (size_t)HALF * K * 2;
    const size_t tstep = 2 * hstep;
    const unsigned ldsw = (unsigned)wid * 1024u;
    const int aoff = lds_byte(wr * 64 + fr, fq * 8), boff = lds_byte(wc * 32 + fr, fq * 8);
#define PG8_SA(b, h) (((b) * 2 + (h)) * HTB)
#define PG8_SB(b, h) ((4 + (b) * 2 + (h)) * HTB)
#define PG8_STAGE(bufoff, gbase, voff) do { _Pragma("unroll") for (int _i = 0; _i < 2; ++_i) \
        __builtin_amdgcn_global_load_lds((const unsigned*)((const char*)(gbase) + (voff)[_i]), (PG8_LAS unsigned*)(lds + (bufoff) + ldsw + _i * 8192), 16, 0, 0); } while (0)
#define PG8_LDA(dst, b, h) do { _Pragma("unroll") for (int m = 0; m < 4; ++m) _Pragma("unroll") for (int k = 0; k < 2; ++k) dst[m][k] = *(const PG8_LAS bf16x8*)(lds + PG8_SA(b, h) + aoff + m * 2048 + k * 1024); } while (0)
#define PG8_LDB(dst, b, h) do { _Pragma("unroll") for (int n = 0; n < 2; ++n) _Pragma("unroll") for (int k = 0; k < 2; ++k) dst[n][k] = *(const PG8_LAS bf16x8*)(lds + PG8_SB(b, h) + boff + n * 2048 + k * 1024); } while (0)
#define PG8_MMA(ai, bj, At, Bt) do { __builtin_amdgcn_s_setprio(1); _Pragma("unroll") for (int m = 0; m < 4; ++m) _Pragma("unroll") for (int n = 0; n < 2; ++n) _Pragma("unroll") for (int k = 0; k < 2; ++k) \
        acc[ai][bj][m][n] = __builtin_amdgcn_mfma_f32_16x16x32_bf16(Bt[n][k], At[m][k], acc[ai][bj][m][n], 0, 0, 0); __builtin_amdgcn_s_setprio(0); } while (0)
#define PG8_WAIT_V(n) asm volatile("s_waitcnt vmcnt(" #n ")" ::: "memory")
#define PG8_WAIT_L(n) asm volatile("s_waitcnt lgkmcnt(" #n ")" ::: "memory")
#define PG8_BAR __builtin_amdgcn_s_barrier()
#define PG8_SCHED __builtin_amdgcn_sched_barrier(0)
    Unit cur, nxt; int ui = 0;
    if (!S.next(0, cur)) return;
    f32x4 acc[2][2][4][2];
#pragma unroll
    for (int a = 0; a < 2; ++a)
#pragma unroll
        for (int b = 0; b < 2; ++b)
#pragma unroll
            for (int m = 0; m < 4; ++m)
#pragma unroll
                for (int n = 0; n < 2; ++n) acc[a][b][m][n] = (f32x4){0.f, 0.f, 0.f, 0.f};
    bf16x8 At[4][2], B0[2][2], B1[2][2];
    const char* cA = (const char*)g.A + (size_t)cur.pm * tstep; const char* cB = (const char*)g.Bt + (size_t)cur.pn * tstep;
    S.a_ready(cur);
    if constexpr (SP2) {
        PG8_STAGE(PG8_SB(0, 0), cB, voffB); PG8_STAGE(PG8_SB(0, 1), cB + hstep, voffB); PG8_STAGE(PG8_SA(0, 0), cA, voffA); PG8_STAGE(PG8_SA(0, 1), cA + hstep, voffA);
        if (wr == 1) PG8_BAR;
        PG8_WAIT_V(2); PG8_BAR;
        PG8_STAGE(PG8_SB(1, 0), cB + kstep, voffB); PG8_STAGE(PG8_SA(1, 0), cA + kstep, voffA); PG8_STAGE(PG8_SB(1, 1), cB + hstep + kstep, voffB);
        PG8_WAIT_V(6); PG8_BAR;
    } else {
        PG8_STAGE(PG8_SB(0, 0), cB, voffB); PG8_STAGE(PG8_SA(0, 0), cA, voffA); PG8_STAGE(PG8_SB(0, 1), cB + hstep, voffB); PG8_STAGE(PG8_SA(0, 1), cA + hstep, voffA);
        if (wr == 1) PG8_BAR;
        PG8_WAIT_V(4); PG8_BAR;
        PG8_STAGE(PG8_SB(1, 0), cB + kstep, voffB); PG8_STAGE(PG8_SA(1, 0), cA + kstep, voffA); PG8_STAGE(PG8_SB(1, 1), cB + hstep + kstep, voffB);
        PG8_WAIT_V(6); PG8_BAR;
    }
    for (;;) {
        const bool has_next = S.next(ui + 1, nxt);
        const char* nA = has_next ? (const char*)g.A + (size_t)nxt.pm * tstep : cA; const char* nB = has_next ? (const char*)g.Bt + (size_t)nxt.pn * tstep : cB;
        for (int t = 0; t < nt; t += 2) {
            const bool last = (t == nt - 2);
            const char* a1 = cA + (size_t)(t + 1) * kstep;
            const char* a2 = last ? nA : cA + (size_t)(t + 2) * kstep; const char* b2 = last ? nB : cB + (size_t)(t + 2) * kstep;
            const char* a3 = a2 + kstep; const char* b3 = b2 + kstep;
            if (last && has_next) S.a_ready(nxt);
            if constexpr (SP2) {
            PG8_LDB(B0, 0, 0); PG8_LDB(B1, 0, 1); PG8_SCHED; PG8_LDA(At, 0, 0); PG8_STAGE(PG8_SA(1, 1), a1 + hstep, voffA);
            PG8_WAIT_V(8); PG8_WAIT_L(0); PG8_BAR; PG8_MMA(0, 0, At, B0); PG8_MMA(0, 1, At, B1); PG8_BAR; PG8_SCHED;
            PG8_LDA(At, 0, 1); PG8_STAGE(PG8_SB(0, 0), b2, voffB); PG8_STAGE(PG8_SB(0, 1), b2 + hstep, voffB); PG8_STAGE(PG8_SA(0, 0), a2, voffA);
            PG8_WAIT_V(8); PG8_WAIT_L(0); PG8_BAR; PG8_MMA(1, 0, At, B0); PG8_MMA(1, 1, At, B1); PG8_BAR; PG8_SCHED;
            PG8_LDB(B0, 1, 0); PG8_LDB(B1, 1, 1); PG8_SCHED; PG8_LDA(At, 1, 0); PG8_STAGE(PG8_SA(0, 1), a2 + hstep, voffA);
            PG8_WAIT_V(8); PG8_WAIT_L(0); PG8_BAR; PG8_MMA(0, 0, At, B0); PG8_MMA(0, 1, At, B1); PG8_BAR; PG8_SCHED;
            PG8_LDA(At, 1, 1); PG8_STAGE(PG8_SB(1, 0), b3, voffB); PG8_STAGE(PG8_SB(1, 1), b3 + hstep, voffB); PG8_STAGE(PG8_SA(1, 0), a3, voffA);
            PG8_WAIT_V(8); PG8_WAIT_L(0); PG8_BAR; PG8_MMA(1, 0, At, B0); PG8_MMA(1, 1, At, B1); PG8_BAR; PG8_SCHED;
            } else {
            PG8_LDB(B0, 0, 0); PG8_SCHED; PG8_LDA(At, 0, 0); PG8_STAGE(PG8_SA(1, 1), a1 + hstep, voffA);
            PG8_WAIT_L(8); PG8_BAR; PG8_WAIT_L(0); PG8_MMA(0, 0, At, B0); PG8_BAR; PG8_SCHED;
            PG8_LDB(B1, 0, 1); PG8_STAGE(PG8_SB(0, 0), b2, voffB);
            PG8_BAR; PG8_WAIT_L(0); PG8_MMA(0, 1, At, B1); PG8_BAR;
            PG8_LDA(At, 0, 1); PG8_STAGE(PG8_SA(0, 0), a2, voffA);
            PG8_BAR; PG8_WAIT_L(0); PG8_MMA(1, 0, At, B0); PG8_BAR; PG8_SCHED;
            PG8_STAGE(PG8_SB(0, 1), b2 + hstep, voffB);
            PG8_WAIT_V(6); PG8_BAR; PG8_MMA(1, 1, At, B1); PG8_BAR;
            PG8_LDB(B0, 1, 0); PG8_SCHED; PG8_LDA(At, 1, 0); PG8_STAGE(PG8_SA(0, 1), a2 + hstep, voffA);
            PG8_WAIT_L(8); PG8_BAR; PG8_WAIT_L(0); PG8_MMA(0, 0, At, B0); PG8_BAR; PG8_SCHED;
            PG8_LDB(B1, 1, 1); PG8_STAGE(PG8_SB(1, 0), b3, voffB);
            PG8_BAR; PG8_WAIT_L(0); PG8_MMA(0, 1, At, B1); PG8_BAR;
            PG8_LDA(At, 1, 1); PG8_STAGE(PG8_SA(1, 0), a3, voffA);
            PG8_BAR; PG8_WAIT_L(0); PG8_MMA(1, 0, At, B0); PG8_BAR; PG8_SCHED;
            PG8_STAGE(PG8_SB(1, 1), b3 + hstep, voffB);
            PG8_WAIT_V(6); PG8_BAR; PG8_MMA(1, 1, At, B1); PG8_BAR;
            }
        }
        if constexpr (ALIGN_EPI) { if (wr == 0) PG8_BAR; }
        if constexpr (!Epi::AFTER_DRAIN) { E(acc, cur, wr, wc, fr, fq); if (S.epi2) E(acc, cur, wr, wc, fr, fq); S.done(cur); }
        if (!has_next) break;
#pragma unroll
        for (int a = 0; a < 2; ++a)
#pragma unroll
            for (int b = 0; b < 2; ++b)
#pragma unroll
                for (int m = 0; m < 4; ++m)
#pragma unroll
                    for (int n = 0; n < 2; ++n) acc[a][b][m][n] = (f32x4){0.f, 0.f, 0.f, 0.f};
        cur = nxt; cA = nA; cB = nB; ++ui;
        if constexpr (ALIGN_EPI) { if (wr == 1) PG8_BAR; }
    }
    PG8_WAIT_V(0);
    if constexpr (!ALIGN_EPI) { if (wr == 0) PG8_BAR; }
    PG8_BAR;
    if constexpr (Epi::AFTER_DRAIN) { E.fused(acc, cur, wr, wc, fr, fq, lds, wid, lane); S.done(cur); }
#undef PG8_SA
#undef PG8_SB
#undef PG8_STAGE
#undef PG8_LDA
#undef PG8_LDB
#undef PG8_MMA
#undef PG8_WAIT_V
#undef PG8_WAIT_L
#undef PG8_BAR
#undef PG8_SCHED
}
}
namespace fa {
#define FA_LAS __attribute__((address_space(3)))
typedef short bf16x8 __attribute__((ext_vector_type(8)));
typedef short s16x4 __attribute__((ext_vector_type(4)));
typedef short v4i16_t __attribute__((ext_vector_type(4)));
typedef float f32x16 __attribute__((ext_vector_type(16)));
typedef float f32x4 __attribute__((ext_vector_type(4)));
typedef unsigned u32x4 __attribute__((ext_vector_type(4)));
typedef float f32x2_t __attribute__((ext_vector_type(2))); typedef __bf16 bf16x2_t __attribute__((ext_vector_type(2)));
constexpr float THR = 8.f, TH_SKIP = 40.f;
constexpr int F_KBUF = 18432, F_AOFF = 8192, F_VOFF = 10240, F_WSF = 3 * F_KBUF, F_FLAG = F_WSF + 8 * 256, F_OST = F_FLAG + 256, F_LDS_BYTES = F_OST + 8 * 4096;
constexpr int S_KBUF = 16384, S_VOFF = 8192, S_WSF = 6 * S_KBUF, S_OST = S_WSF + 8 * 256, S_LDS_BYTES = S_OST + 8 * 4096;
struct Params { const bf16_t* Q; const bf16_t* K; const bf16_t* V; const bf16_t* G; bf16_t* O; const float* CUM; const float* sinks; const unsigned* KMAX; unsigned* ticket; };
__device__ __forceinline__ unsigned cvtpk(float lo, float hi) { f32x2_t v = {lo, hi}; bf16x2_t b = __builtin_convertvector(v, bf16x2_t); return __builtin_bit_cast(unsigned, b); }
__device__ __forceinline__ s16x4 vtr(FA_LAS unsigned char* p) { return __builtin_bit_cast(s16x4, __builtin_amdgcn_ds_read_tr16_b64_v4i16((FA_LAS v4i16_t*)p)); }
__device__ __forceinline__ float swap_max(float v) { auto rr = __builtin_amdgcn_permlane32_swap(__float_as_uint(v), __float_as_uint(v), false, false); return __builtin_fmaxf(__uint_as_float(rr[0]), __uint_as_float(rr[1])); }
__device__ __forceinline__ float swap_add(float v) { auto rr = __builtin_amdgcn_permlane32_swap(__float_as_uint(v), __float_as_uint(v), false, false); return __uint_as_float(rr[0]) + __uint_as_float(rr[1]); }
__device__ __forceinline__ void glds16(const void* gsrc, unsigned lds_dst) { unsigned keep;
    asm volatile("s_mov_b32 %0, m0\n\ts_mov_b32 m0, %2\n\ts_nop 0\n\tglobal_load_lds_dwordx4 %1, off\n\ts_mov_b32 m0, %0" : "=&s"(keep) : "v"(gsrc), "s"(lds_dst) : "memory"); }
#define FA_MFMA(a, b, c) __builtin_amdgcn_mfma_f32_32x32x16_bf16((a), (b), (c), 0, 0, 0)
#define FA_MX3(a, b, c) __builtin_fmaxf(__builtin_fmaxf((a), (b)), (c))
struct WaveSt { bf16x8 qr[4]; bf16x8 qa; f32x16 cinit, o0, o1; float cq, mhat, lsum, mrun; };

#define FA_SBAR() __builtin_amdgcn_sched_barrier(0)
#define FA_PIN(x) asm volatile("" : "+v"(x))
#define FA_LDK(p) (*(FA_LAS bf16x8*)(p))
#define FA_VF(l, h) ((bf16x8){l[0], l[1], l[2], l[3], h[0], h[1], h[2], h[3]})
#define FA_EX4(X, B) do { X[B] = __builtin_amdgcn_exp2f(X[B]); X[B + 1] = __builtin_amdgcn_exp2f(X[B + 1]); X[B + 2] = __builtin_amdgcn_exp2f(X[B + 2]); X[B + 3] = __builtin_amdgcn_exp2f(X[B + 3]); } while (0)
__device__ __forceinline__ void split3(float v, unsigned& h1, unsigned& h2, unsigned& h3) { const bf16_t a = f2bf(v); const float r1 = v - bf2f(a); const bf16_t b = f2bf(r1); const float r2 = r1 - bf2f(b); h1 = a; h2 = b; h3 = f2bf(r2); }
__device__ __forceinline__ void set_qa(WaveSt& w, int hi) {
    unsigned g1, g2, g3; split3(w.cq - w.mhat, g1, g2, g3);
    const u32x4 q = {hi == 0 ? 0x3F803F80u : 0u, hi == 0 ? (0x3F80u | (g1 << 16)) : 0u, hi == 0 ? (g2 | (g3 << 16)) : 0u, 0u};
    w.qa = __builtin_bit_cast(bf16x8, q);
}
template <int MODE, int AOFF, int VOFF, int HB>
__device__ __forceinline__ void half_step(FA_LAS unsigned char* bb, FA_LAS unsigned char* vprev, FA_LAS float* wsf, WaveSt& w, f32x16& C, f32x16& P, int k0, int t, int qlo, int lane, int r32, int hi) {
    constexpr int W = MODE == 0 ? 0x40000000 : 128;
    FA_LAS unsigned char* kp = bb + hi * 1024 + r32 * 16 + HB * 512; FA_LAS unsigned char* ap = bb + AOFF + r32 * 16 + HB * 512;
    FA_LAS unsigned char* vp = (HB == 0 ? vprev + 2048 : bb) + VOFF + ((lane >> 4) & 1) * 32 + (lane & 3) * 8 + (4 * hi + ((lane & 15) >> 2)) * 64;
    bf16x8 kf0 = FA_LDK(kp), kf1 = FA_LDK(kp + 2048), kf2, kf3, ka;
    s16x4 vl0, vh0, vl1, vh1, vl2, vh2, vl3, vh3; u32x4 pw0, pw1; float sacc;
    FA_SBAR();
    if (MODE == 0) C = FA_MFMA(kf0, w.qr[0], ((f32x16){0.f, 0.f, 0.f, 0.f, 0.f, 0.f, 0.f, 0.f, 0.f, 0.f, 0.f, 0.f, 0.f, 0.f, 0.f, 0.f})); else C = FA_MFMA(kf0, w.qr[0], w.cinit);
    kf2 = FA_LDK(kp + 4096);
    sacc = (P[0] + P[1]) + (P[2] + P[3]); pw0.x = cvtpk(P[0], P[1]); pw0.y = cvtpk(P[2], P[3]); FA_PIN(sacc); FA_PIN(pw0.x); FA_PIN(pw0.y);
    FA_SBAR();
    C = FA_MFMA(kf1, w.qr[1], C); kf3 = FA_LDK(kp + 6144);
    sacc += P[4]; sacc += P[5]; sacc += P[6]; sacc += P[7]; pw0.z = cvtpk(P[4], P[5]); pw0.w = cvtpk(P[6], P[7]); FA_PIN(sacc); FA_PIN(pw0.z); FA_PIN(pw0.w);
    FA_SBAR();
    C = FA_MFMA(kf2, w.qr[2], C); if (MODE == 0) ka = FA_LDK(ap);
    sacc += P[8]; sacc += P[9]; sacc += P[10]; sacc += P[11]; pw1.x = cvtpk(P[8], P[9]); pw1.y = cvtpk(P[10], P[11]); FA_PIN(sacc); FA_PIN(pw1.x); FA_PIN(pw1.y); vl0 = vtr(vp); vh0 = vtr(vp + 512);
    FA_SBAR();
    C = FA_MFMA(kf3, w.qr[3], C);
    sacc += P[12]; sacc += P[13]; sacc += P[14]; sacc += P[15]; pw1.z = cvtpk(P[12], P[13]); pw1.w = cvtpk(P[14], P[15]); FA_PIN(sacc); FA_PIN(pw1.z); FA_PIN(pw1.w); vl1 = vtr(vp + 4096); vh1 = vtr(vp + 4096 + 512);
    FA_SBAR();
    if (MODE == 0) { C = FA_MFMA(ka, w.qa, C); FA_SBAR(); }
    w.lsum += sacc;
    const int kh = k0 + 32 * HB;
    if ((kh + 31 > qlo) || (MODE == 1 && kh <= qlo + 31 - W)) {
        const float NEG = -__builtin_inff(); const int dq = t - kh - 4 * hi;
#pragma unroll
        for (int r = 0; r < 16; ++r) { const int c = (r & 3) + 8 * (r >> 2); if ((unsigned)(dq - c) >= (unsigned)W) C[r] = NEG; }
    }
    float ma = FA_MX3(C[0], C[1], C[2]), mb = FA_MX3(C[3], C[4], C[5]);
    ma = FA_MX3(ma, C[6], C[7]); mb = FA_MX3(mb, C[8], C[9]); ma = FA_MX3(ma, C[10], C[11]); mb = FA_MX3(mb, C[12], C[13]); ma = FA_MX3(ma, C[14], C[15]);
    const float rm = swap_max(__builtin_fmaxf(ma, mb));
    if (MODE == 0) w.mrun = __builtin_fmaxf(w.mrun, rm + w.mhat);
    const bool resc = __any(rm > THR);
    if (resc) {
        const float dl = __builtin_fmaxf(rm, 0.f); w.mhat += dl;
#pragma unroll
        for (int r = 0; r < 16; ++r) C[r] -= dl;
        if (MODE == 0) set_qa(w, hi);
        else { const float ci = w.cq - w.mhat;
#pragma unroll
            for (int r = 0; r < 16; ++r) w.cinit[r] = ci; }
        const float f = __builtin_amdgcn_exp2f(-dl); w.lsum *= f;
        if (hi == 0) wsf[r32] = f;
    }
    FA_SBAR();
    { const bf16x8 pa0 = __builtin_bit_cast(bf16x8, pw0), pa1 = __builtin_bit_cast(bf16x8, pw1);
      vl2 = vtr(vp + 1024); vh2 = vtr(vp + 1024 + 512);
      w.o0 = FA_MFMA(pa0, FA_VF(vl0, vh0), w.o0); FA_EX4(C, 0); FA_PIN(C); vl3 = vtr(vp + 4096 + 1024); vh3 = vtr(vp + 4096 + 1024 + 512); FA_SBAR();
      w.o1 = FA_MFMA(pa0, FA_VF(vl1, vh1), w.o1); FA_EX4(C, 4); FA_PIN(C); FA_SBAR();
      w.o0 = FA_MFMA(pa1, FA_VF(vl2, vh2), w.o0); FA_EX4(C, 8); FA_PIN(C); FA_SBAR();
      w.o1 = FA_MFMA(pa1, FA_VF(vl3, vh3), w.o1); FA_EX4(C, 12); FA_PIN(C); FA_SBAR(); }
    if (resc) {
        asm volatile("s_waitcnt lgkmcnt(0)" ::: "memory");
#pragma unroll
        for (int g = 0; g < 4; ++g) { const f32x4 a4 = *(FA_LAS f32x4*)(wsf + 8 * g + 4 * hi);
#pragma unroll
            for (int i = 0; i < 4; ++i) { w.o0[4 * g + i] *= a4[i]; w.o1[4 * g + i] *= a4[i]; } }
    }
}
template <int MODE, int AOFF, int VOFF>
__device__ __forceinline__ void tile_step(FA_LAS unsigned char* bb, FA_LAS unsigned char* vprev, FA_LAS float* wsf, WaveSt& w, f32x16& pA, f32x16& pB, int k0, int t, int qlo, int lane, int r32, int hi) {
    half_step<MODE, AOFF, VOFF, 0>(bb, vprev, wsf, w, pA, pB, k0, t, qlo, lane, r32, hi);
    half_step<MODE, AOFF, VOFF, 1>(bb, vprev, wsf, w, pB, pA, k0, t, qlo, lane, r32, hi);
}
template <int VOFF>
__device__ __forceinline__ void tile_drain(FA_LAS unsigned char* vlast, WaveSt& w, f32x16& P, int lane, int hi) {
    FA_LAS unsigned char* vp = vlast + 2048 + VOFF + ((lane >> 4) & 1) * 32 + (lane & 3) * 8 + (4 * hi + ((lane & 15) >> 2)) * 64;
    float s0 = 0.f;
#pragma unroll
    for (int r = 0; r < 16; ++r) s0 += P[r];
    w.lsum += s0;
    const u32x4 w0 = {cvtpk(P[0], P[1]), cvtpk(P[2], P[3]), cvtpk(P[4], P[5]), cvtpk(P[6], P[7])};
    const u32x4 w1 = {cvtpk(P[8], P[9]), cvtpk(P[10], P[11]), cvtpk(P[12], P[13]), cvtpk(P[14], P[15])};
    const bf16x8 pa0 = __builtin_bit_cast(bf16x8, w0), pa1 = __builtin_bit_cast(bf16x8, w1);
    { const s16x4 l0 = vtr(vp), h0 = vtr(vp + 512), l1 = vtr(vp + 4096), h1 = vtr(vp + 4096 + 512); w.o0 = FA_MFMA(pa0, FA_VF(l0, h0), w.o0); w.o1 = FA_MFMA(pa0, FA_VF(l1, h1), w.o1); }
    { const s16x4 l0 = vtr(vp + 1024), h0 = vtr(vp + 1024 + 512), l1 = vtr(vp + 4096 + 1024), h1 = vtr(vp + 4096 + 1024 + 512); w.o0 = FA_MFMA(pa1, FA_VF(l0, h0), w.o0); w.o1 = FA_MFMA(pa1, FA_VF(l1, h1), w.o1); }
}
__device__ __forceinline__ void load_gate(u32x4 (&gq)[4], const bf16_t* G, size_t grow, int h, int lane) {
#pragma unroll
    for (int d0 = 0; d0 < 2; ++d0)
#pragma unroll
        for (int i = 0; i < 2; ++i) gq[2 * d0 + i] = *(const u32x4*)(G + (grow + i * 16 + (lane >> 2)) * DM + h * 64 + d0 * 32 + (lane & 3) * 8);
}
__device__ __forceinline__ void wave_epilogue(FA_LAS float* stg, FA_LAS float* wsf, WaveSt& w, const u32x4 (&gq)[4], bf16_t* O, size_t grow, int h, int lane, int r32, int hi) {
    const float l = swap_add(w.lsum);
    if (hi == 0) wsf[r32] = l;
    asm volatile("s_waitcnt lgkmcnt(0)" ::: "memory");
    float rl[16];
#pragma unroll
    for (int g = 0; g < 4; ++g) { const f32x4 l4 = *(FA_LAS f32x4*)(wsf + 8 * g + 4 * hi);
#pragma unroll
        for (int i = 0; i < 4; ++i) rl[4 * g + i] = 1.0f / l4[i]; }
#pragma unroll
    for (int d0 = 0; d0 < 2; ++d0) {
#pragma unroll
        for (int g = 0; g < 4; ++g)
#pragma unroll
            for (int i = 0; i < 4; ++i) stg[(8 * g + 4 * hi + i) * 32 + r32] = (d0 == 0 ? w.o0[4 * g + i] : w.o1[4 * g + i]) * rl[4 * g + i];
        asm volatile("s_waitcnt lgkmcnt(0)" ::: "memory");
#pragma unroll
        for (int i = 0; i < 2; ++i) { const int row = i * 16 + (lane >> 2), ch = lane & 3;
            const f32x4 x0 = *(FA_LAS f32x4*)(stg + row * 32 + ch * 8), x1 = *(FA_LAS f32x4*)(stg + row * 32 + ch * 8 + 4);
            const size_t ga = (grow + row) * DM + h * 64 + d0 * 32 + ch * 8; const u32x4 gv = gq[2 * d0 + i];
            u32x4 ov;
            ov.x = cvtpk(x0[0] * __uint_as_float(gv.x << 16), x0[1] * __uint_as_float(gv.x & 0xffff0000u)); ov.y = cvtpk(x0[2] * __uint_as_float(gv.y << 16), x0[3] * __uint_as_float(gv.y & 0xffff0000u));
            ov.z = cvtpk(x1[0] * __uint_as_float(gv.z << 16), x1[1] * __uint_as_float(gv.z & 0xffff0000u)); ov.w = cvtpk(x1[2] * __uint_as_float(gv.w << 16), x1[3] * __uint_as_float(gv.w & 0xffff0000u));
            *(u32x4*)(O + ga) = ov; }
        asm volatile("s_waitcnt lgkmcnt(0)" ::: "memory");
    }
}
template <int MODE> __device__ __forceinline__ void wave_init(WaveSt& w, int hi) {
#pragma unroll
    for (int r = 0; r < 16; ++r) { w.o0[r] = 0.f; w.o1[r] = 0.f; }
    if (MODE == 0) set_qa(w, hi);
    else { const float ci = w.cq - w.mhat;
#pragma unroll
        for (int r = 0; r < 16; ++r) w.cinit[r] = ci; }
}

__device__ __forceinline__ void fox_unit(FA_LAS unsigned char* lds, const Params& P, int b, int h, int qb) {
    const int tid = threadIdx.x, lane = tid & 63, r32 = lane & 31, hi = lane >> 5;
    const int wid = __builtin_amdgcn_readfirstlane(tid >> 6);
    const int q0 = qb * 256, qlo = q0 + wid * 32, t = qlo + r32;
    const size_t rowbase = (size_t)b * SEQ;
    const bf16_t* ksrc = P.K + (rowbase + lane) * DM + h * 64 + wid * 8;
    const bf16_t* vsrc = P.V + (rowbase + 16 * (wid & 3) + (lane >> 2)) * DM + h * 64 + (wid >> 2) * 32 + (lane & 3) * 8;
    const float* cum = P.CUM + (size_t)(b * NH + h) * SEQ;
    const int adst = F_AOFF + lane * 16;
    const int NT = (q0 + 256) / 64;
    WaveSt w; const bf16_t* Qw = P.Q + (rowbase + t) * DM + h * 64 + hi * 8; float qn = 0.f;
#pragma unroll
    for (int d0 = 0; d0 < 4; ++d0) { w.qr[d0] = *(const bf16x8*)(Qw + d0 * 16);
#pragma unroll
        for (int j = 0; j < 8; ++j) { const float qv = bf2f((bf16_t)w.qr[d0][j]); qn = fmaf(qv, qv, qn); } }
    const float cref = cum[q0];
    w.cq = cum[t] - cref; w.mhat = 0.f; w.lsum = 0.f; w.mrun = -1e30f;
    wave_init<0>(w, hi);
    u32x4 gq[4]; load_gate(gq, P.G, rowbase + qlo, h, lane);
    const float qkb = sqrtf(swap_add(qn) * __uint_as_float(P.KMAX[b * NH + h])) * 1.0001f + 1e-3f;
    FA_LAS float* wsf = (FA_LAS float*)(lds + F_WSF) + wid * 64;
    FA_LAS unsigned* votes = (FA_LAS unsigned*)(lds + F_FLAG);
    float sa = 0.f, cnew = 0.f;
#define FA_LOADT(j, bf) do { const size_t ko_ = (size_t)(j) * 64 * DM; FA_LAS unsigned char* bb_ = lds + (bf) * F_KBUF; \
        glds16(ksrc + ko_, (unsigned)__builtin_amdgcn_readfirstlane((int)(unsigned)(uintptr_t)(bb_ + wid * 1024))); \
        glds16(vsrc + ko_, (unsigned)__builtin_amdgcn_readfirstlane((int)(unsigned)(uintptr_t)(bb_ + F_VOFF + (wid >> 2) * 4096 + (wid & 3) * 1024))); \
        cnew = cum[(j) * 64 + 63]; if (wid == 0) sa = cum[(j) * 64 + lane]; } while (0)
#define FA_WRITET(bf) do { FA_LAS unsigned char* bb_ = lds + (bf) * F_KBUF; \
        if (wid == 0) { const float a_ = cref - sa; const bf16_t h1 = f2bf(a_); const float r1 = a_ - bf2f(h1); const bf16_t h2 = f2bf(r1); const float r2 = r1 - bf2f(h2); const bf16_t h3 = f2bf(r2); \
            *(FA_LAS u32x4*)(bb_ + adst) = (u32x4){(unsigned)h1 | ((unsigned)h2 << 16), (unsigned)h3 | 0x3F800000u, 0x3F803F80u, 0u}; } } while (0)
    FA_LOADT(NT - 1, 0); FA_WRITET(0); asm volatile("s_waitcnt vmcnt(0)" ::: "memory"); __syncthreads();
    bool wdone = false, pend = false; f32x16 pA, pB;
#pragma unroll
    for (int r = 0; r < 16; ++r) pB[r] = 0.f;
    int cur = 0;
    for (int tt = 0; tt < NT; ++tt) {
        const int j = NT - 1 - tt, k0 = j * 64; const int nxt = cur == 2 ? 0 : cur + 1, prv = cur == 0 ? 2 : cur - 1;
        if (j > 0) FA_LOADT(j - 1, nxt);
        if (!wdone && k0 <= qlo + 31) {
            FA_LAS unsigned char* bb = lds + cur * F_KBUF;
            tile_step<0, F_AOFF, F_VOFF>(bb, pend ? lds + prv * F_KBUF : bb, wsf, w, pA, pB, k0, t, qlo, lane, r32, hi);
            pend = true;
        }
        if (j > 0) {
            if (!wdone && pend && __all(qkb + w.cq + (cref - cnew) - w.mrun <= -TH_SKIP)) {
                wdone = true; tile_drain<F_VOFF>(lds + cur * F_KBUF, w, pB, lane, hi);
            }
            if (lane == 0) votes[(tt & 1) * 8 + wid] = wdone ? 1u : 0u;
            FA_WRITET(nxt);
        }
        asm volatile("s_waitcnt vmcnt(0)" ::: "memory");
        __syncthreads();
        if (j > 0) { const u32x4 v0 = *(FA_LAS u32x4*)(votes + (tt & 1) * 8), v1 = *(FA_LAS u32x4*)(votes + (tt & 1) * 8 + 4);
            if ((v0.x & v0.y & v0.z & v0.w & v1.x & v1.y & v1.z & v1.w) != 0u) break; }
        else if (!wdone) tile_drain<F_VOFF>(lds + cur * F_KBUF, w, pB, lane, hi);
        cur = nxt;
    }
#undef FA_LOADT
#undef FA_WRITET
    wave_epilogue((FA_LAS float*)(lds + F_OST + wid * 4096), wsf, w, gq, P.O, rowbase + qlo, h, lane, r32, hi);
    __syncthreads();
}
__device__ __forceinline__ void swa_unit(FA_LAS unsigned char* lds, const Params& P, int b, int kvh, int qb) {
    const int tid = threadIdx.x, lane = tid & 63, r32 = lane & 31, hi = lane >> 5;
    const int wid = __builtin_amdgcn_readfirstlane(tid >> 6);
    const int q0 = qb * 256, qlo = q0 + wid * 32, t = qlo + r32;
    const size_t rowbase = (size_t)b * SEQ;
    const int j_lo = q0 >= 128 ? (q0 - 128) / 64 : 0, NT = (q0 + 256) / 64 - j_lo;
    const bf16_t* ksrc = P.K + (rowbase + j_lo * 64 + lane) * KVW + kvh * 64 + wid * 8;
    const bf16_t* vsrc = P.V + (rowbase + j_lo * 64 + 16 * (wid & 3) + (lane >> 2)) * KVW + kvh * 64 + (wid >> 2) * 32 + (lane & 3) * 8;
    const int kdst = wid * 1024 + lane * 16, vdst = S_VOFF + (wid >> 2) * 4096 + (wid & 3) * 1024 + lane * 16;
    { u32x4 sk[6], sv[6];
#pragma unroll
      for (int i = 0; i < 6; ++i) if (i < NT) { sk[i] = *(const u32x4*)(ksrc + (size_t)i * 64 * KVW); sv[i] = *(const u32x4*)(vsrc + (size_t)i * 64 * KVW); }
#pragma unroll
      for (int i = 0; i < 6; ++i) if (i < NT) { *(FA_LAS u32x4*)(lds + i * S_KBUF + kdst) = sk[i]; *(FA_LAS u32x4*)(lds + i * S_KBUF + vdst) = sv[i]; } }
    __syncthreads();
    FA_LAS float* wsf = (FA_LAS float*)(lds + S_WSF) + wid * 64;
    const int ta = (qlo >= 127 ? (qlo - 127) / 64 : 0) - j_lo, tb = (qlo + 31) / 64 - j_lo;
    bf16x8 qn[4]; { const bf16_t* Qw = P.Q + (rowbase + t) * DM + (kvh * 8) * 64 + hi * 8;
#pragma unroll
      for (int d0 = 0; d0 < 4; ++d0) qn[d0] = *(const bf16x8*)(Qw + d0 * 16); }
    for (int hh = 0; hh < 8; ++hh) {
        const int h = kvh * 8 + hh;
        WaveSt w;
#pragma unroll
        for (int d0 = 0; d0 < 4; ++d0) w.qr[d0] = qn[d0];
        { const bf16_t* Qw = P.Q + (rowbase + t) * DM + (kvh * 8 + (hh < 7 ? hh + 1 : hh)) * 64 + hi * 8;
#pragma unroll
          for (int d0 = 0; d0 < 4; ++d0) qn[d0] = *(const bf16x8*)(Qw + d0 * 16); }
        u32x4 gq[4]; load_gate(gq, P.G, rowbase + qlo, h, lane);
        w.cq = 0.f; w.mhat = P.sinks[h] * LOG2E; w.lsum = 0.5f; w.mrun = 0.f;
        wave_init<1>(w, hi);
        f32x16 pA, pB;
#pragma unroll
        for (int r = 0; r < 16; ++r) pB[r] = 0.f;
        for (int ti = tb; ti >= ta; --ti) { FA_LAS unsigned char* bb = lds + ti * S_KBUF;
            tile_step<1, 0, S_VOFF>(bb, ti == tb ? bb : bb + S_KBUF, wsf, w, pA, pB, (j_lo + ti) * 64, t, qlo, lane, r32, hi); }
        tile_drain<S_VOFF>(lds + ta * S_KBUF, w, pB, lane, hi);
        wave_epilogue((FA_LAS float*)(lds + S_OST + wid * 4096), wsf, w, gq, P.O, rowbase + qlo, h, lane, r32, hi);
    }
    __syncthreads();
}
}
#define GAS __attribute__((address_space(1)))
#define LAS __attribute__((address_space(3)))
typedef unsigned short bf16;
typedef unsigned v4u __attribute__((ext_vector_type(4)));
typedef float f32x4 __attribute__((ext_vector_type(4)));
typedef short bf16x8 __attribute__((ext_vector_type(8)));
typedef GAS unsigned gu32;
typedef GAS unsigned long long gu64;
#define RLX_AGENT __ATOMIC_RELAXED, __HIP_MEMORY_SCOPE_AGENT
#define LDS_WAIT() asm volatile("s_waitcnt lgkmcnt(0)" ::: "memory")
#define VM_WAIT() asm volatile("s_waitcnt vmcnt(0)" ::: "memory")
__device__ __forceinline__ unsigned long long rt() { return __builtin_amdgcn_s_memrealtime(); }
__device__ __forceinline__ unsigned pk2(float lo, float hi) { return (unsigned)f2bf(lo) | ((unsigned)f2bf(hi) << 16); }
#define XB_TMO      128
#define XB_XCNT(j)  (256  + 64 * (j))
#define XB_XSUB(j)  (1280 + 64 * (j))
#define XB_XGEN(j)  (2304 + 64 * (j))
#define XB_TOP      3328
#define XB_TOPGEN   3392
#define XCD_BAR_WORDS 3456
#define XB_SPIN_CAP (1u << 18)

__device__ __forceinline__ unsigned xb_ld(unsigned* p)              { return __hip_atomic_load(p, __ATOMIC_RELAXED, __HIP_MEMORY_SCOPE_AGENT); }
__device__ __forceinline__ unsigned xb_add(unsigned* p, unsigned v) { return __hip_atomic_fetch_add(p, v, __ATOMIC_RELAXED, __HIP_MEMORY_SCOPE_AGENT); }
__device__ __forceinline__ unsigned xb_xcc_id() { return (unsigned)__builtin_amdgcn_s_getreg((3 << 11) | 20) & 0xFu; }
#define XB_SPIN(cond, bar) do { unsigned _sp = 0; while (cond) { __builtin_amdgcn_s_sleep(1); \
    if ((++_sp & 255u) == 0u) { if (xb_ld(&(bar)[XB_TMO])) break; if (_sp > XB_SPIN_CAP) { atomicAdd(&(bar)[XB_TMO], 1u); break; } } } } while (0)

struct XcdBarrier {
    unsigned* bar; unsigned x;
    volatile LAS unsigned* st;
};

__device__ __forceinline__ XcdBarrier xcd_barrier_post(unsigned* bar, volatile LAS unsigned* st) {
    XcdBarrier b; b.bar = bar; b.x = xb_xcc_id(); b.st = st;
    if (threadIdx.x == 0) (void)xb_add(&bar[XB_XCNT(b.x)], 1u);
    return b;
}
__device__ __forceinline__ void xcd_barrier_complete(unsigned* bar, unsigned x, unsigned& nloc, unsigned& nx) {
    const unsigned G = gridDim.x * gridDim.y * gridDim.z;
    unsigned sum, cnt, mine, sp = 0u;
    for (;;) {
        sum = 0u; cnt = 0u; mine = 0u;
#pragma unroll
        for (unsigned j = 0; j < 16; ++j) { const unsigned c = xb_ld(&bar[XB_XCNT(j)]); sum += c; cnt += (c > 0u) ? 1u : 0u; mine = (j == x) ? c : mine; }
        if (sum == G) break;
        __builtin_amdgcn_s_sleep(1);
        if ((++sp & 255u) == 0u) { if (xb_ld(&bar[XB_TMO])) break; if (sp > XB_SPIN_CAP) { atomicAdd(&bar[XB_TMO], 1u); break; } }
    }
    nloc = mine > 0u ? mine : 1u; nx = cnt > 0u ? cnt : 1u;
}

__device__ __forceinline__ void xcd_barrier(const XcdBarrier& b) {
    asm volatile("s_waitcnt vmcnt(0)" ::: "memory");
    __syncthreads();
    if (threadIdx.x == 0) {
        unsigned* bar = b.bar;
        __builtin_amdgcn_s_waitcnt(0);
        unsigned nloc = b.st[0], nx = b.st[1];
        if (nloc == 0u) { xcd_barrier_complete(bar, b.x, nloc, nx); b.st[0] = nloc; b.st[1] = nx; }
        const unsigned old = xb_add(&bar[XB_XSUB(b.x)], 1u);
        const unsigned gen = old / nloc;
        if (old + 1u == (gen + 1u) * nloc) {
            __builtin_amdgcn_fence(__ATOMIC_RELEASE, "agent");
            asm volatile("s_waitcnt vmcnt(0)" ::: "memory");
            const unsigned og = xb_add(&bar[XB_TOP], 1u);
            const unsigned tg = og / nx;
            if (og + 1u == (tg + 1u) * nx) xb_add(&bar[XB_TOPGEN], 1u);
            else XB_SPIN(xb_ld(&bar[XB_TOPGEN]) == tg, bar);
            __builtin_amdgcn_fence(__ATOMIC_ACQUIRE, "agent");
            xb_add(&bar[XB_XGEN(b.x)], 1u);
            asm volatile("s_waitcnt vmcnt(0)" ::: "memory");
        } else {
            XB_SPIN(xb_ld(&bar[XB_XGEN(b.x)]) == gen, bar);
            __builtin_amdgcn_fence(__ATOMIC_ACQUIRE, "agent");
            asm volatile("s_waitcnt vmcnt(0)" ::: "memory");
        }
    }
    __syncthreads();
}
constexpr int NWAVES = 8;
constexpr int N1P = 8448;
constexpr int RING_OFF = 0, RING_BYTES = 135168;
constexpr int LDSCTL_OFF = RING_BYTES, MISC_OFF = LDSCTL_OFF + 320;
constexpr int LDS_BYTES = 147456;
constexpr int CW_BAR = 4096;
static_assert(fa::F_LDS_BYTES <= RING_BYTES && fa::S_LDS_BYTES <= RING_BYTES && pg8::STAGE_BYTES <= RING_BYTES && MISC_OFF + 128 <= LDS_BYTES && (CW_BAR + XCD_BAR_WORDS) * 4 <= (int)WS_KMAX, "LDS / CTL map");

__device__ __forceinline__ void p0_transpose_item(const float* W, int K, int N, bf16* WT, LAS float* scr, int item, int lane, const float* gs) {
    const int nblk = N / 32, kb = item / nblk, nb = item % nblk, k0 = 64 * kb, n0 = 32 * nb;
    const int kr = lane >> 3, nc = 4 * (lane & 7);
    f32x4 wv[8];
#pragma unroll
    for (int i = 0; i < 8; ++i) wv[i] = *(const GAS f32x4*)(W + (size_t)(k0 + 8 * i + kr) * N + n0 + nc);
#pragma unroll
    for (int i = 0; i < 8; ++i) { const int kk = 8 * i + kr; f32x4 w = wv[i]; if (gs) w = w * gs[k0 + kk]; LAS float* d = scr + kk * 33 + nc; d[0] = w.x; d[1] = w.y; d[2] = w.z; d[3] = w.w; }
    LDS_WAIT(); asm volatile("" ::: "memory");
    const int c = lane & 7;
#pragma unroll
    for (int j = 0; j < 4; ++j) { const int n = (lane >> 3) + 8 * j; const LAS float* sp = scr + (8 * c) * 33 + n;
        v4u o; o.x = pk2(sp[0 * 33], sp[1 * 33]); o.y = pk2(sp[2 * 33], sp[3 * 33]); o.z = pk2(sp[4 * 33], sp[5 * 33]); o.w = pk2(sp[6 * 33], sp[7 * 33]);
        *(GAS v4u*)(WT + (size_t)(n0 + n) * K + k0 + 8 * c) = o; }
    LDS_WAIT(); asm volatile("" ::: "memory");
}
__device__ __forceinline__ float wave_sum(float v) {
#pragma unroll
    for (int o = 1; o < 64; o <<= 1) v += __shfl_xor(v, o);
    return v;
}

struct Args { const float* in[9]; float* out; unsigned char* ws; int ph_lo, ph_hi; };
constexpr int N_PHASES = 9;
__global__ void __launch_bounds__(NWAVES * 64, 2) mega_fwd(Args args) {
    extern __shared__ __attribute__((aligned(16))) unsigned char lds_raw[];
    LAS unsigned char* lds = (LAS unsigned char*)lds_raw;
    volatile LAS unsigned* MISC = (volatile LAS unsigned*)(lds + MISC_OFF);
    const int tid = threadIdx.x, lane = tid & 63, wave = __builtin_amdgcn_readfirstlane(tid >> 6);
    const int G = gridDim.x, bx = blockIdx.x, vcu = (G % 8 == 0) ? (bx % 8) * (G / 8) + bx / 8 : bx;
    unsigned char* ws = args.ws;
    const float* x = args.in[0]; const float* norm_g = args.in[1]; const float* fox_w_in = args.in[2]; const float* fox_b_f = args.in[3]; const float* fox_w_out = args.in[4];
    const float* swa_w_in = args.in[5]; const float* swa_sinks = args.in[6]; const float* swa_w_out = args.in[7]; const float* final_g = args.in[8];
    float* out = args.out;
    gu32* ctl = (gu32*)(ws + WS_CTL);
    unsigned* KMAX = (unsigned*)(ws + WS_KMAX); unsigned* TICKET = (unsigned*)(ws + WS_TICKET);
    float* SS1 = (float*)(ws + WS_SS1); float* R0 = (float*)(ws + WS_R0); float* ROPE = (float*)(ws + WS_ROPE); float* LOGF = (float*)(ws + WS_LOGF); float* CUM = (float*)(ws + WS_CUM);
    bf16* W1T = (bf16*)(ws + WS_W1T); bf16* W2T = (bf16*)(ws + WS_W2T); bf16* W3T = (bf16*)(ws + WS_W3T); bf16* W4T = (bf16*)(ws + WS_W4T);
    bf16* XB = (bf16*)(ws + WS_XB); bf16* Qb = (bf16*)(ws + WS_Q); bf16* Kb = (bf16*)(ws + WS_K); bf16* Vb = (bf16*)(ws + WS_V); bf16* Gb = (bf16*)(ws + WS_G); bf16* YG = (bf16*)(ws + WS_YG);
    for (int u = tid; u < (LDS_BYTES - LDSCTL_OFF) / 4; u += NWAVES * 64) ((LAS unsigned*)(lds + LDSCTL_OFF))[u] = 0u;
    __syncthreads();
    const int lo = args.ph_lo, hi = args.ph_hi;
    XcdBarrier bar; bar.bar = (unsigned*)(ctl + CW_BAR); bar.x = 0; bar.st = nullptr;
    if (hi - lo > 1) bar = xcd_barrier_post((unsigned*)(ctl + CW_BAR), MISC + 8);
#define IN(k) (lo <= (k) && (k) < hi)
#define REP(k) for (int rep_ = 0; rep_ < (((DUP_MASK >> (k)) & 1) ? 2 : 1); ++rep_)
#define SEAM(k) do { if (IN(k) && IN((k) + 1)) xcd_barrier(bar); } while (0)
    const int gw = vcu * NWAVES + wave, NGW = G * NWAVES;

    if (IN(0)) REP(0) {
        LAS float* scr = (LAS float*)(lds + RING_OFF + wave * 16384);
        constexpr int I1 = (DM / 64) * (FOX_IN / 32), IZ = N1P - FOX_IN;
        constexpr int NITEMS = I1 + IZ;
        for (int it = gw; it < NITEMS; it += NGW) {
            int r = it;
            if (r < I1) { p0_transpose_item(fox_w_in, DM, FOX_IN, W1T, scr, r, lane, norm_g); continue; } r -= I1;
            { GAS v4u* zp = (GAS v4u*)(W1T + (size_t)(FOX_IN + r) * DM) + lane;
#pragma unroll
              for (int j = 0; j < 4; ++j) zp[64 * j] = (v4u){0u, 0u, 0u, 0u}; }
        }
        for (int m = gw; m < MTOK; m += 2 * NGW) {
            const int m2 = m + NGW < MTOK ? m + NGW : m;
            const GAS f32x4* xr = (const GAS f32x4*)(x + (size_t)m * DM) + lane; const GAS f32x4* xr2 = (const GAS f32x4*)(x + (size_t)m2 * DM) + lane; f32x4 v[8], v2[8]; float s = 0.f, s2 = 0.f;
#pragma unroll
            for (int j = 0; j < 8; ++j) { v[j] = xr[64 * j]; v2[j] = xr2[64 * j]; }
#pragma unroll
            for (int j = 0; j < 8; ++j) { s += (v[j].x * v[j].x + v[j].y * v[j].y) + (v[j].z * v[j].z + v[j].w * v[j].w); s2 += (v2[j].x * v2[j].x + v2[j].y * v2[j].y) + (v2[j].z * v2[j].z + v2[j].w * v2[j].w); }
            s = wave_sum(s); s2 = wave_sum(s2);
            if (lane == 0) { R0[m] = 1.0f / sqrtf(s * (1.f / DM) + RMS_EPS); R0[m2] = 1.0f / sqrtf(s2 * (1.f / DM) + RMS_EPS); }
            GAS unsigned long long* o8 = (GAS unsigned long long*)(XB + (size_t)m * DM) + lane; GAS unsigned long long* o82 = (GAS unsigned long long*)(XB + (size_t)m2 * DM) + lane;
#pragma unroll
            for (int j = 0; j < 8; ++j) { o8[64 * j] = (unsigned long long)pk2(v[j].x, v[j].y) | ((unsigned long long)pk2(v[j].z, v[j].w) << 32);
                                          o82[64 * j] = (unsigned long long)pk2(v2[j].x, v2[j].y) | ((unsigned long long)pk2(v2[j].z, v2[j].w) << 32); }
        }
        { const int gt = gw * 64 + lane;
          if (gt < SEQ * 8) { const int pos = gt >> 3, i = gt & 7;
              const double invf[8] = {1.0, 0.19390220519133497, 0.037598065178462524, 0.0072903477503833845, 0.0014142135623730951, 0.00027421912901204056, 5.3171693730649086e-05, 1.0310108130908796e-05};
              double inv = invf[0];
#pragma unroll
              for (int k = 1; k < 8; ++k) inv = (i == k) ? invf[k] : inv;
              const double ang = (double)pos * inv; const double kk = __builtin_rint(ang * 0.15915494309189535); const float red = (float)(ang - kk * 6.283185307179586);
              ROPE[(size_t)pos * 16 + i] = cosf(red); ROPE[(size_t)pos * 16 + 8 + i] = sinf(red); } }
    }
    SEAM(0);
    if (IN(1)) {
        pg8::Gemm g{XB, W1T, MTOK, N1P, DM}; pg8::StaticOrder S; S.init(MTOK, N1P, G, bx, (DUP_MASK >> 1) & 1, (DUP_MASK >> 9) & 1);
        pg8::EpiFoxIn E{Qb, Kb, Vb, Gb, LOGF, R0, fox_b_f};
        pg8::gemm_phase<pg8::EpiFoxIn, pg8::StaticOrder, true, true>(lds + RING_OFF, g, S, E);
        { const int nwg = (MTOK / 256) * (N1P / 256), rem = nwg % G, nidle = rem ? G - rem : G, ii = rem ? bx - rem : bx;
          if (ii >= 0) { LAS float* scr = (LAS float*)(lds + RING_OFF + wave * 16384);
              constexpr int I2 = (DM / 64) * (DM / 32), I3 = (DM / 64) * (SWA_IN / 32);
              for (int it = ii * NWAVES + wave; it < I2 + I3 + I2; it += nidle * NWAVES) {
                  int r = it;
                  if (r < I2) { p0_transpose_item(fox_w_out, DM, DM, W2T, scr, r, lane, nullptr); continue; } r -= I2;
                  if (r < I3) { p0_transpose_item(swa_w_in, DM, SWA_IN, W3T, scr, r, lane, norm_g + DM); continue; } r -= I3;
                  p0_transpose_item(swa_w_out, DM, DM, W4T, scr, r, lane, nullptr); } } }
    }
    SEAM(1);
    if (IN(2)) REP(2) {
        for (int sq = gw; sq < NB * NH; sq += NGW) {
            const GAS f32x4* lf = (const GAS f32x4*)(LOGF + (size_t)sq * SEQ) + lane * 16; f32x4 v[16]; double tot = 0.0;
#pragma unroll
            for (int j = 0; j < 16; ++j) { v[j] = lf[j]; tot += ((double)v[j].x + (double)v[j].y) + ((double)v[j].z + (double)v[j].w); }
            double incl = tot;
#pragma unroll
            for (int o = 1; o < 64; o <<= 1) { const double up = __shfl_up(incl, o); if (lane >= o) incl += up; }
            double run = incl - tot;
            GAS f32x4* co = (GAS f32x4*)(CUM + (size_t)sq * SEQ) + lane * 16;
#pragma unroll
            for (int j = 0; j < 16; ++j) { f32x4 c; run += (double)v[j].x; c.x = (float)(run * 1.4426950408889634); run += (double)v[j].y; c.y = (float)(run * 1.4426950408889634);
                run += (double)v[j].z; c.z = (float)(run * 1.4426950408889634); run += (double)v[j].w; c.w = (float)(run * 1.4426950408889634); co[j] = c; }
        }
        for (int base = 8 * gw; base < MTOK; base += 8 * NGW) {
            float mx[4] = {0.f, 0.f, 0.f, 0.f};
            for (int rr = 0; rr < 8; ++rr) {
#pragma unroll
                for (int j = 0; j < 4; ++j) { const v4u kv = *(const GAS v4u*)(Kb + (size_t)(base + rr) * DM + (lane + 64 * j) * 8); float ss = 0.f;
                    const unsigned wv[4] = {kv.x, kv.y, kv.z, kv.w};
#pragma unroll
                    for (int e = 0; e < 4; ++e) { const float a = __uint_as_float(wv[e] << 16), c = __uint_as_float(wv[e] & 0xffff0000u); ss = fmaf(a, a, ss); ss = fmaf(c, c, ss); }
                    ss += __shfl_xor(ss, 1); ss += __shfl_xor(ss, 2); ss += __shfl_xor(ss, 4); mx[j] = fmaxf(mx[j], ss); } }
            if ((lane & 7) == 0) {
#pragma unroll
                for (int j = 0; j < 4; ++j) atomicMax(KMAX + (base >> 12) * NH + (lane >> 3) + 8 * j, __float_as_uint(mx[j])); }
        }
    }
    SEAM(2);
    if (IN(3)) {
        const fa::Params P{Qb, Kb, Vb, Gb, YG, CUM, nullptr, KMAX, TICKET};
        volatile LAS unsigned* slot = (volatile LAS unsigned*)(lds + RING_OFF + fa::F_FLAG + 128);
        if (tid == 0) slot[0] = atomicAdd(TICKET, 1u);
        __syncthreads();
        unsigned tk = slot[0]; int par = 0;
        while (tk < ((unsigned)(NB * NH * 16) << ((DUP_MASK >> 3) & 1))) {
            if (tid == 0) slot[par ^ 1] = atomicAdd(TICKET, 1u);
            const unsigned u = tk & (unsigned)(NB * NH * 16 - 1);
            const int bh = u & 127, qb = 15 - (int)(u >> 7);
            fa::fox_unit(lds + RING_OFF, P, bh >> 5, bh & 31, qb);
            par ^= 1; tk = slot[par];
        }
        __syncthreads();
    }
    SEAM(3);
    if (IN(4)) {
        pg8::Gemm g{YG, W2T, MTOK, DM, DM}; pg8::StaticOrder S; S.init(MTOK, DM, G, bx);
        pg8::EpiRes<true> E{x, out, XB, SS1};
        pg8::gemm_phase<pg8::EpiRes<true>, pg8::StaticOrder, true, true>(lds + RING_OFF, g, S, E);
    }
    SEAM(4);
    if (IN(5)) {
        pg8::Gemm g{XB, W3T, MTOK, SWA_IN, DM}; pg8::StaticOrder S; S.init(MTOK, SWA_IN, G, bx, (DUP_MASK >> 5) & 1);
        pg8::EpiSwaIn E{Qb, Kb, Vb, Gb, SS1, ROPE};
        pg8::gemm_phase<pg8::EpiSwaIn, pg8::StaticOrder, true, true>(lds + RING_OFF, g, S, E);
    }
    SEAM(5);
    if (IN(6)) REP(6) {
        const fa::Params P{Qb, Kb, Vb, Gb, YG, nullptr, swa_sinks, nullptr, nullptr};
        for (int u = (G == 256 ? vcu : bx); u < NB * 4 * 16; u += G) fa::swa_unit(lds + RING_OFF, P, u >> 6, (u >> 4) & 3, u & 15);
    }
    SEAM(6);
    if (IN(7)) {
        pg8::Gemm g{YG, W4T, MTOK, DM, DM}; pg8::StaticOrder S; S.init(MTOK, DM, G, bx);
        pg8::EpiRes<false> E{out, out, nullptr, nullptr};
        pg8::gemm_phase<pg8::EpiRes<false>, pg8::StaticOrder, true, true>(lds + RING_OFF, g, S, E);
    }
    SEAM(7);
    if (IN(8)) {
        f32x4 gq[8];
#pragma unroll
        for (int j = 0; j < 8; ++j) gq[j] = ((const GAS f32x4*)final_g)[lane + 64 * j];
        for (int m = gw; m < MTOK; m += NGW) {
            GAS f32x4* xr = (GAS f32x4*)(out + (size_t)m * DM) + lane; f32x4 v[8]; float s = 0.f;
#pragma unroll
            for (int j = 0; j < 8; ++j) { v[j] = xr[64 * j]; s += (v[j].x * v[j].x + v[j].y * v[j].y) + (v[j].z * v[j].z + v[j].w * v[j].w); }
            const float r = 1.0f / sqrtf(wave_sum(s) * (1.f / DM) + RMS_EPS);
#pragma unroll
            for (int j = 0; j < 8; ++j) xr[64 * j] = v[j] * r * gq[j];
        }
    }
#undef IN
#undef SEAM
}

extern "C" void kernel_launch(void* const* d_in, const int* in_sizes, int n_in, void* d_out, int out_size, void* d_ws, size_t ws_size, hipStream_t stream) {
    static int grid = 0;
    if (grid == 0) {
        if (n_in != 9 || in_sizes[0] != MTOK * DM || out_size != MTOK * DM || ws_size < WS_END) { fprintf(stderr, "kernel_launch: unexpected shapes (n_in %d, in0 %d, out %d, ws %zu)\n", n_in, n_in > 0 ? in_sizes[0] : -1, out_size, ws_size); grid = -1; return; }
        int dev = 0, cus = 0, per_cu = 0;
        if (hipGetDevice(&dev) != hipSuccess || hipDeviceGetAttribute(&cus, hipDeviceAttributeMultiprocessorCount, dev) != hipSuccess) { fprintf(stderr, "kernel_launch: device query failed\n"); grid = -1; return; }
        if (hipFuncSetAttribute((const void*)mega_fwd, hipFuncAttributeMaxDynamicSharedMemorySize, LDS_BYTES) != hipSuccess) { fprintf(stderr, "kernel_launch: hipFuncSetAttribute failed\n"); grid = -1; return; }
        if (hipOccupancyMaxActiveBlocksPerMultiprocessor(&per_cu, (const void*)mega_fwd, NWAVES * 64, LDS_BYTES) != hipSuccess || per_cu < 1) { fprintf(stderr, "kernel_launch: occupancy query reports %d workgroups per CU; nothing launched\n", per_cu); (void)hipGetLastError(); grid = -1; return; }
        grid = cus;
    }
    if (grid < 0) return;
    const float* x = (const float*)d_in[0]; const float* norm_g = (const float*)d_in[1]; const float* fox_w_in = (const float*)d_in[2]; const float* fox_b_f = (const float*)d_in[3];
    const float* fox_w_out = (const float*)d_in[4]; const float* swa_w_in = (const float*)d_in[5]; const float* swa_sinks = (const float*)d_in[6]; const float* swa_w_out = (const float*)d_in[7];
    const float* final_g = (const float*)d_in[8];
    float* out = (float*)d_out; unsigned char* ws = (unsigned char*)d_ws;
    float* SS1 = (float*)(ws + WS_SS1); float* R0 = (float*)(ws + WS_R0); float* LOGF = (float*)(ws + WS_LOGF); float* CUM = (float*)(ws + WS_CUM);
    bf16_t* XB = (bf16_t*)(ws + WS_XB); bf16_t* Q = (bf16_t*)(ws + WS_Q); bf16_t* K = (bf16_t*)(ws + WS_K); bf16_t* V = (bf16_t*)(ws + WS_V); bf16_t* Gt = (bf16_t*)(ws + WS_G); bf16_t* YG = (bf16_t*)(ws + WS_YG);
    (void)hipMemsetAsync(ws + WS_CTL, 0, CTL_ZERO_BYTES, stream);
    Args a{};
    for (int i = 0; i < 9; ++i) a.in[i] = (const float*)d_in[i];
    a.out = out; a.ws = ws;
    (void)x; (void)norm_g; (void)fox_w_in; (void)fox_b_f; (void)fox_w_out; (void)swa_w_in; (void)swa_sinks; (void)swa_w_out; (void)final_g; (void)SS1; (void)R0; (void)LOGF; (void)CUM; (void)XB; (void)Q; (void)K; (void)V; (void)Gt; (void)YG;
    int p = 0;
    while (p < N_PHASES) {
        if ((FAST_MASK >> p) & 1) {
            int e = p + 1; if (ONE_LAUNCH) while (e < N_PHASES && ((FAST_MASK >> e) & 1)) ++e;
            a.ph_lo = p; a.ph_hi = e;
            hipLaunchKernelGGL(mega_fwd, dim3(grid), dim3(NWAVES * 64), LDS_BYTES, stream, a);
            p = e; continue;
        }
#if FAST_MASK != 0x1FF
        switch (p) {
        case 0: n_rowrms<<<MTOK / 4, 256, 0, stream>>>(x, R0); break;
        case 1: n_gemm<float, NEpiFoxIn><<<dim3((FOX_IN + 63) / 64, MTOK / 64), 256, 0, stream>>>(x, DM, norm_g, fox_w_in, FOX_IN, DM, FOX_IN, NEpiFoxIn{Q, K, V, Gt, LOGF, R0, fox_b_f}); break;
        case 2: n_cumsum<<<2, 64, 0, stream>>>(LOGF, CUM); break;
        case 3: n_attn<0><<<dim3(SEQ / 256, NB * NH), 256, 0, stream>>>(Q, K, V, CUM, nullptr, Gt, YG); break;
        case 4: n_gemm<bf16_t, NEpiOut1><<<dim3(DM / 64, MTOK / 64), 256, 0, stream>>>(YG, DM, nullptr, fox_w_out, DM, DM, DM, NEpiOut1{x, out, XB, SS1}); break;
        case 5: n_gemm<float, NEpiSwaIn><<<dim3(SWA_IN / 64, MTOK / 64), 256, 0, stream>>>(out, DM, norm_g + DM, swa_w_in, SWA_IN, DM, SWA_IN, NEpiSwaIn{Q, K, V, Gt, SS1});
                n_rope<<<(MTOK * NH * 8 + 255) / 256, 256, 0, stream>>>(Q, DM, NH); n_rope<<<(MTOK * 4 * 8 + 255) / 256, 256, 0, stream>>>(K, KVW, 4); break;
        case 6: n_attn<1><<<dim3(SEQ / 256, NB * NH), 256, 0, stream>>>(Q, K, V, nullptr, swa_sinks, Gt, YG); break;
        case 7: n_gemm<bf16_t, NEpiOut2><<<dim3(DM / 64, MTOK / 64), 256, 0, stream>>>(YG, DM, nullptr, swa_w_out, DM, DM, DM, NEpiOut2{out}); break;
        case 8: n_finalnorm<<<MTOK / 4, 256, 0, stream>>>(out, final_g); break;
        }
#endif
        ++p;
    }
}
```

```cpp
#include <hip/hip_runtime.h>
#include <cstdio>
#include <cstdint>

constexpr int NB = 4, SEQ = 4096, DM = 2048, MTOK = NB * SEQ, NH = 32, HD = 64;
constexpr int FOX_IN = 8224, SWA_IN = 4608, KVW = 256;
constexpr float RMS_EPS = 1e-6f;
constexpr float LOG2E = 1.4426950408889634f;
constexpr float C2 = 0.125f * LOG2E;

typedef unsigned short bf16_t;
__device__ __forceinline__ float bf2f(bf16_t v) { return __uint_as_float((unsigned)v << 16); }
__device__ __forceinline__ bf16_t f2bf(float f) { unsigned u = __float_as_uint(f); return (bf16_t)((u + 0x7fffu + ((u >> 16) & 1u)) >> 16); }
__device__ __forceinline__ float logsigmoidf(float z) { return z < 0.f ? z - log1pf(expf(z)) : -log1pf(expf(-z)); }
__device__ __forceinline__ float siluf(float g) { return g / (1.f + expf(-g)); }

__host__ __device__ __forceinline__ size_t tiled_off(int row, int k) { return ((size_t)((row >> 8) * (DM / 64) + (k >> 6)) << 14) + (size_t)(((row & 255) << 6) + (k & 63)); }

constexpr size_t MiB = 1u << 20;
constexpr size_t WS_CTL = 0, CTL_ZERO_BYTES = 1 * MiB;
constexpr size_t WS_KMAX = 64 * 1024, WS_TICKET = 65 * 1024;
constexpr size_t WS_SS1 = 512 * 1024;
constexpr size_t WS_R0 = 1 * MiB;
constexpr size_t WS_ROPE = 1 * MiB + 512 * 1024;
constexpr size_t WS_LOGF = 2 * MiB;
constexpr size_t WS_CUM = 4 * MiB;
constexpr size_t WS_W1T = 8 * MiB, WS_W2T = 41 * MiB, WS_W3T = 49 * MiB, WS_W4T = 67 * MiB;
constexpr size_t WS_XB = 76 * MiB, WS_Q = 140 * MiB, WS_K = 204 * MiB, WS_V = 268 * MiB, WS_G = 332 * MiB, WS_YG = 396 * MiB, WS_END = 460 * MiB;

#ifndef FAST_MASK
#define FAST_MASK 0x1FF
#endif
#ifndef DUP_MASK
#define DUP_MASK 0x000
#endif
#ifndef ONE_LAUNCH
#define ONE_LAUNCH 1
#endif
#if FAST_MASK != 0x1FF
__global__ __launch_bounds__(256) void n_rowrms(const float* x, float* R) {
    const int row = blockIdx.x * 4 + (threadIdx.x >> 6), lane = threadIdx.x & 63;
    const float* xr = x + (size_t)row * DM; float s = 0.f;
    for (int i = lane; i < DM; i += 64) { const float v = xr[i]; s += v * v; }
#pragma unroll
    for (int o = 1; o < 64; o <<= 1) s += __shfl_xor(s, o);
    if (lane == 0) R[row] = 1.0f / sqrtf(s * (1.f / DM) + RMS_EPS);
}
__device__ __forceinline__ float toF(float v) { return v; }
__device__ __forceinline__ float toF(bf16_t v) { return bf2f(v); }

template <class AT, class Epi>
__global__ __launch_bounds__(256) void n_gemm(const AT* A, int lda, const float* kscale, const float* W, int ldw, int Kd, int N, Epi epi) {
    __shared__ float As[16][68]; __shared__ float Bs[16][68];
    const int tx = threadIdx.x & 15, ty = threadIdx.x >> 4;
    const int row0 = blockIdx.y * 64, col0 = blockIdx.x * 64;
    float acc[4][4];
#pragma unroll
    for (int i = 0; i < 4; ++i)
#pragma unroll
        for (int j = 0; j < 4; ++j) acc[i][j] = 0.f;
    for (int k0 = 0; k0 < Kd; k0 += 16) {
        for (int i = threadIdx.x; i < 1024; i += 256) { const int r = i >> 4, kk = i & 15; float a = toF(A[(size_t)(row0 + r) * lda + k0 + kk]); if (kscale) a *= kscale[k0 + kk]; As[kk][r] = a; }
        for (int i = threadIdx.x; i < 1024; i += 256) { const int kk = i >> 6, c = i & 63, col = col0 + c; Bs[kk][c] = col < N ? W[(size_t)(k0 + kk) * ldw + col] : 0.f; }
        __syncthreads();
#pragma unroll
        for (int kk = 0; kk < 16; ++kk) {
            const float4 a = *(const float4*)&As[kk][ty * 4]; const float4 b = *(const float4*)&Bs[kk][tx * 4];
            const float av[4] = {a.x, a.y, a.z, a.w}, bv[4] = {b.x, b.y, b.z, b.w};
#pragma unroll
            for (int i = 0; i < 4; ++i)
#pragma unroll
                for (int j = 0; j < 4; ++j) acc[i][j] = fmaf(av[i], bv[j], acc[i][j]);
        }
        __syncthreads();
    }
#pragma unroll
    for (int i = 0; i < 4; ++i)
#pragma unroll
        for (int j = 0; j < 4; ++j) { const int row = row0 + ty * 4 + i, col = col0 + tx * 4 + j; if (col < N) epi(row, col, acc[i][j]); }
}
struct NEpiFoxIn {
    bf16_t *Q, *K, *V, *G; float* LOGF; const float* R0; const float* bfb;
    __device__ void operator()(int row, int col, float v) const {
        v *= R0[row];
        if (col < 2048) Q[(size_t)row * DM + col] = f2bf(v * C2);
        else if (col < 4096) K[(size_t)row * DM + col - 2048] = f2bf(v);
        else if (col < 6144) V[(size_t)row * DM + col - 4096] = f2bf(v);
        else if (col < 8192) G[(size_t)row * DM + col - 6144] = f2bf(siluf(v));
        else { const int h = col - 8192, b = row >> 12, s = row & 4095; LOGF[((size_t)(b * NH + h) << 12) + s] = logsigmoidf(v + bfb[h]); }
    }
};
struct NEpiOut1 {
    const float* xin; float* xout; bf16_t* XB; float* SS;
    __device__ void operator()(int row, int col, float v) const {
        const size_t o = (size_t)row * DM + col; const float x1 = xin[o] + v; xout[o] = x1; XB[o] = f2bf(x1); atomicAdd(&SS[row], x1 * x1);
    }
};
struct NEpiSwaIn {
    bf16_t *Q, *K, *V, *G; const float* SS;
    __device__ void operator()(int row, int col, float v) const {
        v *= 1.0f / sqrtf(SS[row] * (1.f / DM) + RMS_EPS);
        if (col < 2048) Q[(size_t)row * DM + col] = f2bf(v * C2);
        else if (col < 2304) K[(size_t)row * KVW + col - 2048] = f2bf(v);
        else if (col < 2560) V[(size_t)row * KVW + col - 2304] = f2bf(v);
        else G[(size_t)row * DM + col - 2560] = f2bf(siluf(v));
    }
};
struct NEpiOut2 { float* xio; __device__ void operator()(int row, int col, float v) const { const size_t o = (size_t)row * DM + col; xio[o] = xio[o] + v; } };

__global__ void n_rope(bf16_t* T, int pitch, int nheads) {
    const long idx = (long)blockIdx.x * blockDim.x + threadIdx.x; const long total = (long)MTOK * nheads * 8; if (idx >= total) return;
    const int i = idx & 7; const long rh = idx >> 3; const int hh = rh % nheads; const long row = rh / nheads; const int pos = row & 4095;
    const double inv = pow(500000.0, -(double)i / 8.0); const float ang = (float)pos * (float)inv;
    const float c = cosf(ang), s = sinf(ang);
    bf16_t* p = T + (size_t)row * pitch + hh * 64 + i; const float x1 = bf2f(p[0]), x2 = bf2f(p[8]);
    p[0] = f2bf(x1 * c - x2 * s); p[8] = f2bf(x2 * c + x1 * s);
}
__global__ void n_cumsum(const float* LOGF, float* CUM) {
    const int sidx = blockIdx.x * blockDim.x + threadIdx.x; if (sidx >= NB * NH) return;
    const float* lf = LOGF + (size_t)sidx * SEQ; float* c = CUM + (size_t)sidx * SEQ; double a = 0.0;
    for (int s = 0; s < SEQ; ++s) { a += (double)lf[s]; c[s] = (float)(a * 1.4426950408889634); }
}
template <int MODE>
__global__ __launch_bounds__(256) void n_attn(const bf16_t* Q, const bf16_t* K, const bf16_t* V, const float* CUM, const float* sinks, const bf16_t* G, bf16_t* YG) {
    __shared__ float Ks[64][64]; __shared__ float Vs[64][64]; __shared__ float Cs[64];
    const int qb = blockIdx.x, bh = blockIdx.y, b = bh / NH, h = bh % NH, tid = threadIdx.x;
    const int t = qb * 256 + tid; const size_t row = (size_t)b * SEQ + t;
    const int kvh = MODE == 0 ? h : (h >> 3), kp = MODE == 0 ? DM : KVW;
    float q[64], o[64];
#pragma unroll
    for (int d = 0; d < 64; ++d) { q[d] = bf2f(Q[row * DM + h * 64 + d]); o[d] = 0.f; }
    const float ct = MODE == 0 ? CUM[(size_t)bh * SEQ + t] : 0.f;
    float m = MODE == 0 ? -1e30f : sinks[h] * LOG2E, l = MODE == 0 ? 0.f : 1.f;
    const int kstart = MODE == 0 ? 0 : (qb * 256 >= 128 ? qb * 256 - 128 : 0), kend = qb * 256 + 256;
    for (int k0 = kstart; k0 < kend; k0 += 64) {
        for (int i = tid; i < 4096; i += 256) { const int kk = i >> 6, d = i & 63; const size_t a = ((size_t)b * SEQ + k0 + kk) * kp + kvh * 64 + d; Ks[kk][d] = bf2f(K[a]); Vs[kk][d] = bf2f(V[a]); }
        if (MODE == 0 && tid < 64) Cs[tid] = CUM[(size_t)bh * SEQ + k0 + tid];
        __syncthreads();
        for (int kk = 0; kk < 64; ++kk) {
            const int s = k0 + kk; float sd = 0.f;
#pragma unroll
            for (int d = 0; d < 64; ++d) sd = fmaf(q[d], Ks[kk][d], sd);
            if (MODE == 0) sd += ct - Cs[kk];
            const bool ok = MODE == 0 ? (s <= t) : (s <= t && t - s < 128);
            if (!ok) sd = -INFINITY;
            const float mn = fmaxf(m, sd), a = exp2f(m - mn), p = exp2f(sd - mn);
            l = l * a + p;
#pragma unroll
            for (int d = 0; d < 64; ++d) o[d] = fmaf(p, Vs[kk][d], o[d] * a);
            m = mn;
        }
        __syncthreads();
    }
    const float rl = 1.f / l;
#pragma unroll
    for (int d = 0; d < 64; ++d) { const size_t a = row * DM + h * 64 + d; YG[a] = f2bf(o[d] * rl * bf2f(G[a])); }
}
__global__ __launch_bounds__(256) void n_finalnorm(float* xio, const float* g) {
    const int row = blockIdx.x * 4 + (threadIdx.x >> 6), lane = threadIdx.x & 63;
    float* xr = xio + (size_t)row * DM; float s = 0.f;
    for (int i = lane; i < DM; i += 64) { const float v = xr[i]; s += v * v; }
#pragma unroll
    for (int o = 1; o < 64; o <<= 1) s += __shfl_xor(s, o);
    const float r = 1.0f / sqrtf(s * (1.f / DM) + RMS_EPS);
    for (int i = lane; i < DM; i += 64) xr[i] = xr[i] * r * g[i];
}

#endif
namespace pg8 {
#define PG8_LAS __attribute__((address_space(3)))
typedef unsigned short bf16_t;
typedef short bf16x8 __attribute__((ext_vector_type(8)));
typedef float f32x4 __attribute__((ext_vector_type(4)));
typedef unsigned u32x4 __attribute__((ext_vector_type(4)));
constexpr int BM = 256, BK = 64, HALF = 128, HTB = HALF * BK * 2  , STAGE_BYTES = 8 * HTB, NXCD = 8, WGM = 8;

__host__ __device__ __forceinline__ int lds_byte(int r, int c) { const int st = (r >> 4) * 2 + (c >> 5), rr = r & 15, cc = c & 31, ob = rr * 64 + cc * 2; return st * 1024 + (ob ^ (((ob >> 9) & 1) << 5)); }
__host__ __device__ __forceinline__ void stage_rc(int b, int& R, int& C) { const int st = b / 1024, sb = b % 1024, swz = sb ^ (((sb >> 9) & 1) << 5); R = (st >> 1) * 16 + swz / 64; C = (st & 1) * 32 + (swz % 64) / 2; }
__host__ __device__ __forceinline__ int perm32(int rho) { const int n = rho >> 4, i = rho & 15; return 8 * (i >> 2) + 4 * n + (i & 3); }

struct Unit { int pm, pn, lm, ln; };
struct Gemm { const bf16_t* A; const bf16_t* Bt; int M, N, K; };

struct StaticOrder {
    int nM, nN, nwg, G, c, dup, epi2, same;
    __host__ __device__ void init(int M, int N, int G_, int c_, int dup_ = 0, int epi2_ = 0, int same_ = 0) { nM = M / BM; nN = N / BM; nwg = nM * nN; G = G_; c = c_; dup = dup_; epi2 = epi2_; same = same_; }
    __host__ __device__ bool next(int i, Unit& u) const {
        if (dup) i >>= 1;
        const long L = (long)i * G + c; if (L >= nwg) return false;
        int wgid = (int)L; { const int q = nwg / NXCD, r = nwg % NXCD, xcd = wgid % NXCD, off = wgid / NXCD; wgid = (xcd < r ? xcd * (q + 1) : r * (q + 1) + (xcd - r) * q) + off; }
        const int nig = WGM * nN, gid = wgid / nig, fm = gid * WGM, gsz = (nM - fm) < WGM ? (nM - fm) : WGM;
        u.pm = fm + ((wgid % nig) % gsz); u.pn = (wgid % nig) / gsz; u.lm = same ? 0 : u.pm; u.ln = same ? 0 : u.pn; return true;
    }
    __device__ __forceinline__ void a_ready(const Unit&) const {}
    __device__ __forceinline__ void done(const Unit&) const {}
};

__device__ __forceinline__ unsigned cvt_pk_bf16(float lo, float hi) { unsigned r; asm volatile("v_cvt_pk_bf16_f32 %0, %1, %2" : "=v"(r) : "v"(lo), "v"(hi)); return r; }
__device__ __forceinline__ float silu_fast(float g) { return g * __builtin_amdgcn_rcpf(1.0f + __builtin_amdgcn_exp2f(-g * 1.4426950408889634f)); }
__device__ __forceinline__ u32x4 pack8(const f32x4 v0, const f32x4 v1) { u32x4 w; w.x = cvt_pk_bf16(v0[0], v0[1]); w.y = cvt_pk_bf16(v0[2], v0[3]); w.z = cvt_pk_bf16(v1[0], v1[1]); w.w = cvt_pk_bf16(v1[2], v1[3]); return w; }
struct EpiFoxIn {
    static constexpr bool PERM = true, AFTER_DRAIN = false;
    bf16_t *Q, *K, *V, *G; float* LOGF; const float* R0; const float* bfb;
    __device__ __forceinline__ void operator()(const f32x4 (&acc)[2][2][4][2], const Unit& u, int wr, int wc, int fr, int fq) const {
        const int row0 = u.pm * BM + wr * 64 + fr, pn = u.pn;
        float rs[2][4];
#pragma unroll
        for (int ai = 0; ai < 2; ++ai)
#pragma unroll
            for (int m = 0; m < 4; ++m) rs[ai][m] = R0[row0 + ai * HALF + m * 16];
        if (pn < 32) {
            const int reg = pn >> 3; bf16_t* base = reg == 0 ? Q : reg == 1 ? K : reg == 2 ? V : G;
            const int col0 = (pn & 7) * BM + wc * 32 + 8 * fq;
#pragma unroll
            for (int ai = 0; ai < 2; ++ai)
#pragma unroll
                for (int m = 0; m < 4; ++m) { const int row = row0 + ai * HALF + m * 16; const float r = rs[ai][m]; const float sc = reg == 0 ? r * C2 : r; bf16_t* rowp = base + (size_t)row * DM + col0;
#pragma unroll
                    for (int bj = 0; bj < 2; ++bj) { f32x4 v0 = acc[ai][bj][m][0] * sc, v1 = acc[ai][bj][m][1] * sc;
                        if (reg == 3) {
#pragma unroll
                            for (int j = 0; j < 4; ++j) { v0[j] = silu_fast(v0[j]); v1[j] = silu_fast(v1[j]); } }
                        __builtin_nontemporal_store(pack8(v0, v1), (u32x4*)(rowp + bj * HALF)); } }
        } else if (wc == 0) {
#pragma unroll
            for (int ai = 0; ai < 2; ++ai)
#pragma unroll
                for (int m = 0; m < 4; ++m) { const int row = row0 + ai * HALF + m * 16; const float r = rs[ai][m]; const int b = row >> 12, s = row & 4095;
#pragma unroll
                    for (int n = 0; n < 2; ++n)
#pragma unroll
                        for (int j = 0; j < 4; ++j) { const int h = 8 * fq + 4 * n + j; LOGF[((size_t)(b * NH + h) << 12) + s] = logsigmoidf(acc[ai][0][m][n][j] * r + bfb[h]); } }
        }
    }
};
struct EpiSwaIn {
    static constexpr bool PERM = true, AFTER_DRAIN = false;
    bf16_t *Q, *K, *V, *G; const float* SS; const float* ROPE;
    __device__ __forceinline__ void operator()(const f32x4 (&acc)[2][2][4][2], const Unit& u, int wr, int wc, int fr, int fq) const {
        const int row0 = u.pm * BM + wr * 64 + fr, pn = u.pn;
        bf16_t* base; int pitch, colt; float osc = 1.f; const bool rope = pn <= 8, gate = pn >= 10;
        if (pn < 8) { base = Q; pitch = DM; colt = pn * BM; osc = C2; } else if (pn == 8) { base = K; pitch = KVW; colt = 0; } else if (pn == 9) { base = V; pitch = KVW; colt = 0; } else { base = G; pitch = DM; colt = (pn - 10) * BM; }
        const int col0 = colt + wc * 32 + 8 * fq; const bool rotw = rope && ((wc & 1) == 0); const float sgn = fq == 0 ? -1.f : 1.f; const bool rotl = fq < 2;
        float rs[2][4];
#pragma unroll
        for (int ai = 0; ai < 2; ++ai)
#pragma unroll
            for (int m = 0; m < 4; ++m) rs[ai][m] = SS[row0 + ai * HALF + m * 16];
        f32x4 nc0, nc1, ns0, ns1;
        if (rotw) { const float* rp = ROPE + (size_t)(row0 & 4095) * 16; nc0 = *(const f32x4*)rp; nc1 = *(const f32x4*)(rp + 4); ns0 = *(const f32x4*)(rp + 8); ns1 = *(const f32x4*)(rp + 12); }
#pragma unroll
        for (int ai = 0; ai < 2; ++ai)
#pragma unroll
            for (int m = 0; m < 4; ++m) { const int row = row0 + ai * HALF + m * 16; const float r = 1.0f / sqrtf(rs[ai][m] * (1.f / DM) + RMS_EPS); bf16_t* rowp = base + (size_t)row * pitch + col0;
                const f32x4 c0 = nc0, c1 = nc1, s0 = ns0, s1 = ns1;
                if (rotw && (ai * 4 + m) < 7) { const int nrow = row0 + ((ai * 4 + m + 1) >> 2) * HALF + ((ai * 4 + m + 1) & 3) * 16; const float* rp = ROPE + (size_t)(nrow & 4095) * 16; nc0 = *(const f32x4*)rp; nc1 = *(const f32x4*)(rp + 4); ns0 = *(const f32x4*)(rp + 8); ns1 = *(const f32x4*)(rp + 12); }
#pragma unroll
                for (int bj = 0; bj < 2; ++bj) { f32x4 v0 = acc[ai][bj][m][0] * r, v1 = acc[ai][bj][m][1] * r;
                    if (rotw) {
#pragma unroll
                        for (int j = 0; j < 4; ++j) { const float p0 = __shfl_xor(v0[j], 16), p1 = __shfl_xor(v1[j], 16);
                            const float n0 = v0[j] * c0[j] + sgn * p0 * s0[j], n1 = v1[j] * c1[j] + sgn * p1 * s1[j];
                            v0[j] = rotl ? n0 : v0[j]; v1[j] = rotl ? n1 : v1[j]; } }
                    if (gate) {
#pragma unroll
                        for (int j = 0; j < 4; ++j) { v0[j] = silu_fast(v0[j]); v1[j] = silu_fast(v1[j]); } }
                    v0 = v0 * osc; v1 = v1 * osc;
                    *(u32x4*)(rowp + bj * HALF) = pack8(v0, v1); } }
    }
};
template <bool FIRST> struct EpiRes {
    static constexpr bool PERM = false, AFTER_DRAIN = false;
    const float* xin; float* xout; bf16_t* XB; float* SS;
    __device__ __forceinline__ void operator()(const f32x4 (&acc)[2][2][4][2], const Unit& u, int wr, int wc, int fr, int fq) const {
        typedef unsigned u32x2v __attribute__((ext_vector_type(2)));
        const int row0 = u.pm * BM + wr * 64 + fr, col0 = u.pn * BM + wc * 32 + 4 * fq;
        f32x4 nx[2][2];
#pragma unroll
        for (int bj = 0; bj < 2; ++bj)
#pragma unroll
            for (int n = 0; n < 2; ++n) nx[bj][n] = *(const f32x4*)(xin + (size_t)row0 * DM + col0 + bj * HALF + n * 16);
#pragma unroll
        for (int ai = 0; ai < 2; ++ai)
#pragma unroll
            for (int m = 0; m < 4; ++m) { const int row = row0 + ai * HALF + m * 16; const size_t off = (size_t)row * DM + col0; float ss = 0.f;
                f32x4 cx[2][2];
#pragma unroll
                for (int bj = 0; bj < 2; ++bj)
#pragma unroll
                    for (int n = 0; n < 2; ++n) cx[bj][n] = nx[bj][n];
                if ((ai * 4 + m) < 7) { const int nrow = row0 + ((ai * 4 + m + 1) >> 2) * HALF + ((ai * 4 + m + 1) & 3) * 16;
#pragma unroll
                    for (int bj = 0; bj < 2; ++bj)
#pragma unroll
                        for (int n = 0; n < 2; ++n) nx[bj][n] = *(const f32x4*)(xin + (size_t)nrow * DM + col0 + bj * HALF + n * 16); }
#pragma unroll
                for (int bj = 0; bj < 2; ++bj)
#pragma unroll
                    for (int n = 0; n < 2; ++n) { const size_t o = off + bj * HALF + n * 16; const f32x4 x1 = cx[bj][n] + acc[ai][bj][m][n]; *(f32x4*)(xout + o) = x1;
                        if (FIRST) { u32x2v w; w.x = cvt_pk_bf16(x1[0], x1[1]); w.y = cvt_pk_bf16(x1[2], x1[3]); *(u32x2v*)(XB + tiled_off(row, col0 + bj * HALF + n * 16)) = w; ss += (x1[0] * x1[0] + x1[1] * x1[1]) + (x1[2] * x1[2] + x1[3] * x1[3]); } }
                if (FIRST) { ss += __shfl_xor(ss, 16); ss += __shfl_xor(ss, 32); if (fq == 0) atomicAdd(SS + row, ss); } }
    }
};
template <class Epi, class Sched, bool ALIGN_EPI = false, bool SP2 = false>
__device__ __forceinline__ void gemm_phase(PG8_LAS unsigned char* lds, const Gemm g, const Sched& S, const Epi& E) {
    const int tid = threadIdx.x, wid = __builtin_amdgcn_readfirstlane(tid >> 6), lane = tid & 63, wr = wid >> 2, wc = wid & 3, fr = lane & 15, fq = lane >> 4;
    const int K = g.K, nt = K / BK;
    unsigned voffA[2], voffB[2];
#pragma unroll
    for (int i = 0; i < 2; ++i) { int R, C; stage_rc(tid * 16 + i * 8192, R, C); const int Rb = Epi::PERM ? ((R & ~31) + perm32(R & 31)) : R;
        voffA[i] = (unsigned)(R * BK + C) * 2u; voffB[i] = (unsigned)(Rb * BK + C) * 2u; }
    const size_t kstep = (size_t)(BM * BK * 2);
    const size_t hstep = (size_t)(HALF * BK * 2);
    const size_t tstep = (size_t)BM * K * 2;
    const unsigned ldsw = (unsigned)wid * 1024u;
    const int aoff = lds_byte(wr * 64 + fr, fq * 8), boff = lds_byte(wc * 32 + fr, fq * 8);
#define PG8_SA(b, h) (((b) * 2 + (h)) * HTB)
#define PG8_SB(b, h) ((4 + (b) * 2 + (h)) * HTB)
#define PG8_STAGE(bufoff, gbase, voff) do { _Pragma("unroll") for (int _i = 0; _i < 2; ++_i) \
        __builtin_amdgcn_global_load_lds((const unsigned*)((const char*)(gbase) + (voff)[_i]), (PG8_LAS unsigned*)(lds + (bufoff) + ldsw + _i * 8192), 16, 0, 0); } while (0)
#define PG8_LDA(dst, b, h) do { _Pragma("unroll") for (int m = 0; m < 4; ++m) _Pragma("unroll") for (int k = 0; k < 2; ++k) dst[m][k] = *(const PG8_LAS bf16x8*)(lds + PG8_SA(b, h) + aoff + m * 2048 + k * 1024); } while (0)
#define PG8_LDB(dst, b, h) do { _Pragma("unroll") for (int n = 0; n < 2; ++n) _Pragma("unroll") for (int k = 0; k < 2; ++k) dst[n][k] = *(const PG8_LAS bf16x8*)(lds + PG8_SB(b, h) + boff + n * 2048 + k * 1024); } while (0)
#define PG8_MMA(ai, bj, At, Bt) do { __builtin_amdgcn_s_setprio(1); _Pragma("unroll") for (int m = 0; m < 4; ++m) _Pragma("unroll") for (int n = 0; n < 2; ++n) _Pragma("unroll") for (int k = 0; k < 2; ++k) \
        acc[ai][bj][m][n] = __builtin_amdgcn_mfma_f32_16x16x32_bf16(Bt[n][k], At[m][k], acc[ai][bj][m][n], 0, 0, 0); __builtin_amdgcn_s_setprio(0); } while (0)
#define PG8_WAIT_V(n) asm volatile("s_waitcnt vmcnt(" #n ")" ::: "memory")
#define PG8_WAIT_L(n) asm volatile("s_waitcnt lgkmcnt(" #n ")" ::: "memory")
#define PG8_BAR __builtin_amdgcn_s_barrier()
#define PG8_SCHED __builtin_amdgcn_sched_barrier(0)
    Unit cur, nxt; int ui = 0;
    if (!S.next(0, cur)) return;
    f32x4 acc[2][2][4][2];
#pragma unroll
    for (int a = 0; a < 2; ++a)
#pragma unroll
        for (int b = 0; b < 2; ++b)
#pragma unroll
            for (int m = 0; m < 4; ++m)
#pragma unroll
                for (int n = 0; n < 2; ++n) acc[a][b][m][n] = (f32x4){0.f, 0.f, 0.f, 0.f};
    bf16x8 At[4][2], B0[2][2], B1[2][2];
    const char* cA = (const char*)g.A + (size_t)cur.lm * tstep; const char* cB = (const char*)g.Bt + (size_t)cur.ln * tstep;
    S.a_ready(cur);
    if constexpr (SP2) {
        PG8_STAGE(PG8_SB(0, 0), cB, voffB); PG8_STAGE(PG8_SB(0, 1), cB + hstep, voffB); PG8_STAGE(PG8_SA(0, 0), cA, voffA); PG8_STAGE(PG8_SA(0, 1), cA + hstep, voffA);
        if (wr == 1) PG8_BAR;
        PG8_WAIT_V(2); PG8_BAR;
        PG8_STAGE(PG8_SB(1, 0), cB + kstep, voffB); PG8_STAGE(PG8_SA(1, 0), cA + kstep, voffA); PG8_STAGE(PG8_SB(1, 1), cB + hstep + kstep, voffB);
        PG8_WAIT_V(6); PG8_BAR;
    } else {
        PG8_STAGE(PG8_SB(0, 0), cB, voffB); PG8_STAGE(PG8_SA(0, 0), cA, voffA); PG8_STAGE(PG8_SB(0, 1), cB + hstep, voffB); PG8_STAGE(PG8_SA(0, 1), cA + hstep, voffA);
        if (wr == 1) PG8_BAR;
        PG8_WAIT_V(4); PG8_BAR;
        PG8_STAGE(PG8_SB(1, 0), cB + kstep, voffB); PG8_STAGE(PG8_SA(1, 0), cA + kstep, voffA); PG8_STAGE(PG8_SB(1, 1), cB + hstep + kstep, voffB);
        PG8_WAIT_V(6); PG8_BAR;
    }
    for (;;) {
        const bool has_next = S.next(ui + 1, nxt);
        const char* nA = has_next ? (const char*)g.A + (size_t)nxt.lm * tstep : cA; const char* nB = has_next ? (const char*)g.Bt + (size_t)nxt.ln * tstep : cB;
        for (int t = 0; t < nt; t += 2) {
            const bool last = (t == nt - 2);
            const char* a1 = cA + (size_t)(t + 1) * kstep;
            const char* a2 = last ? nA : cA + (size_t)(t + 2) * kstep; const char* b2 = last ? nB : cB + (size_t)(t + 2) * kstep;
            const char* a3 = a2 + kstep; const char* b3 = b2 + kstep;
            if (last && has_next) S.a_ready(nxt);
            if constexpr (SP2) {
            PG8_LDB(B0, 0, 0); PG8_LDB(B1, 0, 1); PG8_SCHED; PG8_LDA(At, 0, 0); PG8_STAGE(PG8_SA(1, 1), a1 + hstep, voffA);
            PG8_WAIT_V(8); PG8_WAIT_L(0); PG8_BAR; PG8_MMA(0, 0, At, B0); PG8_MMA(0, 1, At, B1); PG8_BAR; PG8_SCHED;
            PG8_LDA(At, 0, 1); PG8_STAGE(PG8_SB(0, 0), b2, voffB); PG8_STAGE(PG8_SB(0, 1), b2 + hstep, voffB); PG8_STAGE(PG8_SA(0, 0), a2, voffA);
            PG8_WAIT_V(8); PG8_WAIT_L(0); PG8_BAR; PG8_MMA(1, 0, At, B0); PG8_MMA(1, 1, At, B1); PG8_BAR; PG8_SCHED;
            PG8_LDB(B0, 1, 0); PG8_LDB(B1, 1, 1); PG8_SCHED; PG8_LDA(At, 1, 0); PG8_STAGE(PG8_SA(0, 1), a2 + hstep, voffA);
            PG8_WAIT_V(8); PG8_WAIT_L(0); PG8_BAR; PG8_MMA(0, 0, At, B0); PG8_MMA(0, 1, At, B1); PG8_BAR; PG8_SCHED;
            PG8_LDA(At, 1, 1); PG8_STAGE(PG8_SB(1, 0), b3, voffB); PG8_STAGE(PG8_SB(1, 1), b3 + hstep, voffB); PG8_STAGE(PG8_SA(1, 0), a3, voffA);
            PG8_WAIT_V(8); PG8_WAIT_L(0); PG8_BAR; PG8_MMA(1, 0, At, B0); PG8_MMA(1, 1, At, B1); PG8_BAR; PG8_SCHED;
            } else {
            PG8_LDB(B0, 0, 0); PG8_SCHED; PG8_LDA(At, 0, 0); PG8_STAGE(PG8_SA(1, 1), a1 + hstep, voffA);
            PG8_WAIT_L(8); PG8_BAR; PG8_WAIT_L(0); PG8_MMA(0, 0, At, B0); PG8_BAR; PG8_SCHED;
            PG8_LDB(B1, 0, 1); PG8_STAGE(PG8_SB(0, 0), b2, voffB);
            PG8_BAR; PG8_WAIT_L(0); PG8_MMA(0, 1, At, B1); PG8_BAR;
            PG8_LDA(At, 0, 1); PG8_STAGE(PG8_SA(0, 0), a2, voffA);
            PG8_BAR; PG8_WAIT_L(0); PG8_MMA(1, 0, At, B0); PG8_BAR; PG8_SCHED;
            PG8_STAGE(PG8_SB(0, 1), b2 + hstep, voffB);
            PG8_WAIT_V(6); PG8_BAR; PG8_MMA(1, 1, At, B1); PG8_BAR;
            PG8_LDB(B0, 1, 0); PG8_SCHED; PG8_LDA(At, 1, 0); PG8_STAGE(PG8_SA(0, 1), a2 + hstep, voffA);
            PG8_WAIT_L(8); PG8_BAR; PG8_WAIT_L(0); PG8_MMA(0, 0, At, B0); PG8_BAR; PG8_SCHED;
            PG8_LDB(B1, 1, 1); PG8_STAGE(PG8_SB(1, 0), b3, voffB);
            PG8_BAR; PG8_WAIT_L(0); PG8_MMA(0, 1, At, B1); PG8_BAR;
            PG8_LDA(At, 1, 1); PG8_STAGE(PG8_SA(1, 0), a3, voffA);
            PG8_BAR; PG8_WAIT_L(0); PG8_MMA(1, 0, At, B0); PG8_BAR; PG8_SCHED;
            PG8_STAGE(PG8_SB(1, 1), b3 + hstep, voffB);
            PG8_WAIT_V(6); PG8_BAR; PG8_MMA(1, 1, At, B1); PG8_BAR;
            }
        }
        if constexpr (ALIGN_EPI) { if (wr == 0) PG8_BAR; }
        if constexpr (!Epi::AFTER_DRAIN) { E(acc, cur, wr, wc, fr, fq); if (S.epi2) E(acc, cur, wr, wc, fr, fq); S.done(cur); }
        if (!has_next) break;
#pragma unroll
        for (int a = 0; a < 2; ++a)
#pragma unroll
            for (int b = 0; b < 2; ++b)
#pragma unroll
                for (int m = 0; m < 4; ++m)
#pragma unroll
                    for (int n = 0; n < 2; ++n) acc[a][b][m][n] = (f32x4){0.f, 0.f, 0.f, 0.f};
        cur = nxt; cA = nA; cB = nB; ++ui;
        if constexpr (ALIGN_EPI) { if (wr == 1) PG8_BAR; }
    }
    PG8_WAIT_V(0);
    if constexpr (!ALIGN_EPI) { if (wr == 0) PG8_BAR; }
    PG8_BAR;
    if constexpr (Epi::AFTER_DRAIN) { E.fused(acc, cur, wr, wc, fr, fq, lds, wid, lane); S.done(cur); }
#undef PG8_SA
#undef PG8_SB
#undef PG8_STAGE
#undef PG8_LDA
#undef PG8_LDB
#undef PG8_MMA
#undef PG8_WAIT_V
#undef PG8_WAIT_L
#undef PG8_BAR
#undef PG8_SCHED
}
}
namespace fa {
#define FA_LAS __attribute__((address_space(3)))
typedef short bf16x8 __attribute__((ext_vector_type(8)));
typedef short s16x4 __attribute__((ext_vector_type(4)));
typedef short v4i16_t __attribute__((ext_vector_type(4)));
typedef float f32x16 __attribute__((ext_vector_type(16)));
typedef float f32x4 __attribute__((ext_vector_type(4)));
typedef unsigned u32x4 __attribute__((ext_vector_type(4)));
typedef float f32x2_t __attribute__((ext_vector_type(2))); typedef __bf16 bf16x2_t __attribute__((ext_vector_type(2)));
constexpr float THR = 8.f, TH_SKIP = 40.f;
constexpr int F_KBUF = 18432, F_AOFF = 8192, F_VOFF = 10240, F_WSF = 3 * F_KBUF, F_FLAG = F_WSF + 8 * 256, F_OST = F_FLAG + 256, F_LDS_BYTES = F_OST + 8 * 4096;
constexpr int S_KBUF = 16384, S_VOFF = 8192, S_WSF = 6 * S_KBUF, S_OST = S_WSF + 8 * 256, S_LDS_BYTES = S_OST + 8 * 4096;
struct Params { const bf16_t* Q; const bf16_t* K; const bf16_t* V; const bf16_t* G; bf16_t* O; const float* CUM; const float* sinks; const unsigned* KMAX; unsigned* ticket; };
__device__ __forceinline__ unsigned cvtpk(float lo, float hi) { f32x2_t v = {lo, hi}; bf16x2_t b = __builtin_convertvector(v, bf16x2_t); return __builtin_bit_cast(unsigned, b); }
__device__ __forceinline__ s16x4 vtr(FA_LAS unsigned char* p) { return __builtin_bit_cast(s16x4, __builtin_amdgcn_ds_read_tr16_b64_v4i16((FA_LAS v4i16_t*)p)); }
__device__ __forceinline__ float swap_max(float v) { auto rr = __builtin_amdgcn_permlane32_swap(__float_as_uint(v), __float_as_uint(v), false, false); return __builtin_fmaxf(__uint_as_float(rr[0]), __uint_as_float(rr[1])); }
__device__ __forceinline__ float swap_add(float v) { auto rr = __builtin_amdgcn_permlane32_swap(__float_as_uint(v), __float_as_uint(v), false, false); return __uint_as_float(rr[0]) + __uint_as_float(rr[1]); }
__device__ __forceinline__ void glds16(const void* gsrc, unsigned lds_dst) { unsigned keep;
    asm volatile("s_mov_b32 %0, m0\n\ts_mov_b32 m0, %2\n\ts_nop 0\n\tglobal_load_lds_dwordx4 %1, off\n\ts_mov_b32 m0, %0" : "=&s"(keep) : "v"(gsrc), "s"(lds_dst) : "memory"); }
#define FA_MFMA(a, b, c) __builtin_amdgcn_mfma_f32_32x32x16_bf16((a), (b), (c), 0, 0, 0)
#define FA_MX3(a, b, c) __builtin_fmaxf(__builtin_fmaxf((a), (b)), (c))
struct WaveSt { bf16x8 qr[4]; bf16x8 qa; f32x16 cinit, o0, o1; float cq, mhat, lsum, mrun; };

#define FA_SBAR() __builtin_amdgcn_sched_barrier(0)
#define FA_PIN(x) asm volatile("" : "+v"(x))
#define FA_LDK(p) (*(FA_LAS bf16x8*)(p))
#define FA_VF(l, h) ((bf16x8){l[0], l[1], l[2], l[3], h[0], h[1], h[2], h[3]})
#define FA_EX4(X, B) do { X[B] = __builtin_amdgcn_exp2f(X[B]); X[B + 1] = __builtin_amdgcn_exp2f(X[B + 1]); X[B + 2] = __builtin_amdgcn_exp2f(X[B + 2]); X[B + 3] = __builtin_amdgcn_exp2f(X[B + 3]); } while (0)
__device__ __forceinline__ void split3(float v, unsigned& h1, unsigned& h2, unsigned& h3) { const bf16_t a = f2bf(v); const float r1 = v - bf2f(a); const bf16_t b = f2bf(r1); const float r2 = r1 - bf2f(b); h1 = a; h2 = b; h3 = f2bf(r2); }
__device__ __forceinline__ void set_qa(WaveSt& w, int hi) {
    unsigned g1, g2, g3; split3(w.cq - w.mhat, g1, g2, g3);
    const u32x4 q = {hi == 0 ? 0x3F803F80u : 0u, hi == 0 ? (0x3F80u | (g1 << 16)) : 0u, hi == 0 ? (g2 | (g3 << 16)) : 0u, 0u};
    w.qa = __builtin_bit_cast(bf16x8, q);
}
template <int MODE, int AOFF, int VOFF, int HB>
__device__ __forceinline__ void half_step(FA_LAS unsigned char* bb, FA_LAS unsigned char* vprev, FA_LAS float* wsf, WaveSt& w, f32x16& C, f32x16& P, int k0, int t, int qlo, int lane, int r32, int hi) {
    constexpr int W = MODE == 0 ? 0x40000000 : 128;
    FA_LAS unsigned char* kp = bb + hi * 1024 + r32 * 16 + HB * 512; FA_LAS unsigned char* ap = bb + AOFF + r32 * 16 + HB * 512;
    FA_LAS unsigned char* vp = (HB == 0 ? vprev + 2048 : bb) + VOFF + ((lane >> 4) & 1) * 32 + (lane & 3) * 8 + (4 * hi + ((lane & 15) >> 2)) * 64;
    bf16x8 kf0 = FA_LDK(kp), kf1 = FA_LDK(kp + 2048), kf2, kf3, ka;
    s16x4 vl0, vh0, vl1, vh1, vl2, vh2, vl3, vh3; u32x4 pw0, pw1; float sacc;
    FA_SBAR();
    if (MODE == 0) C = FA_MFMA(kf0, w.qr[0], ((f32x16){0.f, 0.f, 0.f, 0.f, 0.f, 0.f, 0.f, 0.f, 0.f, 0.f, 0.f, 0.f, 0.f, 0.f, 0.f, 0.f})); else C = FA_MFMA(kf0, w.qr[0], w.cinit);
    kf2 = FA_LDK(kp + 4096);
    sacc = (P[0] + P[1]) + (P[2] + P[3]); pw0.x = cvtpk(P[0], P[1]); pw0.y = cvtpk(P[2], P[3]); FA_PIN(sacc); FA_PIN(pw0.x); FA_PIN(pw0.y);
    FA_SBAR();
    C = FA_MFMA(kf1, w.qr[1], C); kf3 = FA_LDK(kp + 6144);
    sacc += P[4]; sacc += P[5]; sacc += P[6]; sacc += P[7]; pw0.z = cvtpk(P[4], P[5]); pw0.w = cvtpk(P[6], P[7]); FA_PIN(sacc); FA_PIN(pw0.z); FA_PIN(pw0.w);
    FA_SBAR();
    C = FA_MFMA(kf2, w.qr[2], C); if (MODE == 0) ka = FA_LDK(ap);
    sacc += P[8]; sacc += P[9]; sacc += P[10]; sacc += P[11]; pw1.x = cvtpk(P[8], P[9]); pw1.y = cvtpk(P[10], P[11]); FA_PIN(sacc); FA_PIN(pw1.x); FA_PIN(pw1.y); vl0 = vtr(vp); vh0 = vtr(vp + 512);
    FA_SBAR();
    C = FA_MFMA(kf3, w.qr[3], C);
    sacc += P[12]; sacc += P[13]; sacc += P[14]; sacc += P[15]; pw1.z = cvtpk(P[12], P[13]); pw1.w = cvtpk(P[14], P[15]); FA_PIN(sacc); FA_PIN(pw1.z); FA_PIN(pw1.w); vl1 = vtr(vp + 4096); vh1 = vtr(vp + 4096 + 512);
    FA_SBAR();
    if (MODE == 0) { C = FA_MFMA(ka, w.qa, C); FA_SBAR(); }
    w.lsum += sacc;
    const int kh = k0 + 32 * HB;
    if ((kh + 31 > qlo) || (MODE == 1 && kh <= qlo + 31 - W)) {
        const float NEG = -__builtin_inff(); const int dq = t - kh - 4 * hi;
#pragma unroll
        for (int r = 0; r < 16; ++r) { const int c = (r & 3) + 8 * (r >> 2); if ((unsigned)(dq - c) >= (unsigned)W) C[r] = NEG; }
    }
    float ma = FA_MX3(C[0], C[1], C[2]), mb = FA_MX3(C[3], C[4], C[5]);
    ma = FA_MX3(ma, C[6], C[7]); mb = FA_MX3(mb, C[8], C[9]); ma = FA_MX3(ma, C[10], C[11]); mb = FA_MX3(mb, C[12], C[13]); ma = FA_MX3(ma, C[14], C[15]);
    const float rm = swap_max(__builtin_fmaxf(ma, mb));
    if (MODE == 0) w.mrun = __builtin_fmaxf(w.mrun, rm + w.mhat);
    const bool resc = __any(rm > THR);
    if (resc) {
        const float dl = __builtin_fmaxf(rm, 0.f); w.mhat += dl;
#pragma unroll
        for (int r = 0; r < 16; ++r) C[r] -= dl;
        if (MODE == 0) set_qa(w, hi);
        else { const float ci = w.cq - w.mhat;
#pragma unroll
            for (int r = 0; r < 16; ++r) w.cinit[r] = ci; }
        const float f = __builtin_amdgcn_exp2f(-dl); w.lsum *= f;
        if (hi == 0) wsf[r32] = f;
    }
    FA_SBAR();
    { const bf16x8 pa0 = __builtin_bit_cast(bf16x8, pw0), pa1 = __builtin_bit_cast(bf16x8, pw1);
      vl2 = vtr(vp + 1024); vh2 = vtr(vp + 1024 + 512);
      w.o0 = FA_MFMA(pa0, FA_VF(vl0, vh0), w.o0); FA_EX4(C, 0); FA_PIN(C); vl3 = vtr(vp + 4096 + 1024); vh3 = vtr(vp + 4096 + 1024 + 512); FA_SBAR();
      w.o1 = FA_MFMA(pa0, FA_VF(vl1, vh1), w.o1); FA_EX4(C, 4); FA_PIN(C); FA_SBAR();
      w.o0 = FA_MFMA(pa1, FA_VF(vl2, vh2), w.o0); FA_EX4(C, 8); FA_PIN(C); FA_SBAR();
      w.o1 = FA_MFMA(pa1, FA_VF(vl3, vh3), w.o1); FA_EX4(C, 12); FA_PIN(C); FA_SBAR(); }
    if (resc) {
        asm volatile("s_waitcnt lgkmcnt(0)" ::: "memory");
#pragma unroll
        for (int g = 0; g < 4; ++g) { const f32x4 a4 = *(FA_LAS f32x4*)(wsf + 8 * g + 4 * hi);
#pragma unroll
            for (int i = 0; i < 4; ++i) { w.o0[4 * g + i] *= a4[i]; w.o1[4 * g + i] *= a4[i]; } }
    }
}
template <int MODE, int AOFF, int VOFF>
__device__ __forceinline__ void tile_step(FA_LAS unsigned char* bb, FA_LAS unsigned char* vprev, FA_LAS float* wsf, WaveSt& w, f32x16& pA, f32x16& pB, int k0, int t, int qlo, int lane, int r32, int hi) {
    half_step<MODE, AOFF, VOFF, 0>(bb, vprev, wsf, w, pA, pB, k0, t, qlo, lane, r32, hi);
    half_step<MODE, AOFF, VOFF, 1>(bb, vprev, wsf, w, pB, pA, k0, t, qlo, lane, r32, hi);
}
template <int VOFF>
__device__ __forceinline__ void tile_drain(FA_LAS unsigned char* vlast, WaveSt& w, f32x16& P, int lane, int hi) {
    FA_LAS unsigned char* vp = vlast + 2048 + VOFF + ((lane >> 4) & 1) * 32 + (lane & 3) * 8 + (4 * hi + ((lane & 15) >> 2)) * 64;
    float s0 = 0.f;
#pragma unroll
    for (int r = 0; r < 16; ++r) s0 += P[r];
    w.lsum += s0;
    const u32x4 w0 = {cvtpk(P[0], P[1]), cvtpk(P[2], P[3]), cvtpk(P[4], P[5]), cvtpk(P[6], P[7])};
    const u32x4 w1 = {cvtpk(P[8], P[9]), cvtpk(P[10], P[11]), cvtpk(P[12], P[13]), cvtpk(P[14], P[15])};
    const bf16x8 pa0 = __builtin_bit_cast(bf16x8, w0), pa1 = __builtin_bit_cast(bf16x8, w1);
    { const s16x4 l0 = vtr(vp), h0 = vtr(vp + 512), l1 = vtr(vp + 4096), h1 = vtr(vp + 4096 + 512); w.o0 = FA_MFMA(pa0, FA_VF(l0, h0), w.o0); w.o1 = FA_MFMA(pa0, FA_VF(l1, h1), w.o1); }
    { const s16x4 l0 = vtr(vp + 1024), h0 = vtr(vp + 1024 + 512), l1 = vtr(vp + 4096 + 1024), h1 = vtr(vp + 4096 + 1024 + 512); w.o0 = FA_MFMA(pa1, FA_VF(l0, h0), w.o0); w.o1 = FA_MFMA(pa1, FA_VF(l1, h1), w.o1); }
}
__device__ __forceinline__ void load_gate(u32x4 (&gq)[4], const bf16_t* G, size_t grow, int h, int lane) {
#pragma unroll
    for (int d0 = 0; d0 < 2; ++d0)
#pragma unroll
        for (int i = 0; i < 2; ++i) gq[2 * d0 + i] = *(const u32x4*)(G + (grow + i * 16 + (lane >> 2)) * DM + h * 64 + d0 * 32 + (lane & 3) * 8);
}
__device__ __forceinline__ void wave_epilogue(FA_LAS float* stg, FA_LAS float* wsf, WaveSt& w, const u32x4 (&gq)[4], bf16_t* O, size_t grow, int h, int lane, int r32, int hi) {
    const float l = swap_add(w.lsum);
    if (hi == 0) wsf[r32] = l;
    asm volatile("s_waitcnt lgkmcnt(0)" ::: "memory");
    float rl[16];
#pragma unroll
    for (int g = 0; g < 4; ++g) { const f32x4 l4 = *(FA_LAS f32x4*)(wsf + 8 * g + 4 * hi);
#pragma unroll
        for (int i = 0; i < 4; ++i) rl[4 * g + i] = 1.0f / l4[i]; }
#pragma unroll
    for (int d0 = 0; d0 < 2; ++d0) {
#pragma unroll
        for (int g = 0; g < 4; ++g)
#pragma unroll
            for (int i = 0; i < 4; ++i) stg[(8 * g + 4 * hi + i) * 32 + r32] = (d0 == 0 ? w.o0[4 * g + i] : w.o1[4 * g + i]) * rl[4 * g + i];
        asm volatile("s_waitcnt lgkmcnt(0)" ::: "memory");
#pragma unroll
        for (int i = 0; i < 2; ++i) { const int row = i * 16 + (lane >> 2), ch = lane & 3;
            const f32x4 x0 = *(FA_LAS f32x4*)(stg + row * 32 + ch * 8), x1 = *(FA_LAS f32x4*)(stg + row * 32 + ch * 8 + 4);
            const size_t ga = (grow + row) * DM + h * 64 + d0 * 32 + ch * 8; const u32x4 gv = gq[2 * d0 + i];
            u32x4 ov;
            ov.x = cvtpk(x0[0] * __uint_as_float(gv.x << 16), x0[1] * __uint_as_float(gv.x & 0xffff0000u)); ov.y = cvtpk(x0[2] * __uint_as_float(gv.y << 16), x0[3] * __uint_as_float(gv.y & 0xffff0000u));
            ov.z = cvtpk(x1[0] * __uint_as_float(gv.z << 16), x1[1] * __uint_as_float(gv.z & 0xffff0000u)); ov.w = cvtpk(x1[2] * __uint_as_float(gv.w << 16), x1[3] * __uint_as_float(gv.w & 0xffff0000u));
            *(u32x4*)(O + tiled_off((int)(grow + row), h * 64 + d0 * 32 + ch * 8)) = ov; }
        asm volatile("s_waitcnt lgkmcnt(0)" ::: "memory");
    }
}
template <int MODE> __device__ __forceinline__ void wave_init(WaveSt& w, int hi) {
#pragma unroll
    for (int r = 0; r < 16; ++r) { w.o0[r] = 0.f; w.o1[r] = 0.f; }
    if (MODE == 0) set_qa(w, hi);
    else { const float ci = w.cq - w.mhat;
#pragma unroll
        for (int r = 0; r < 16; ++r) w.cinit[r] = ci; }
}

__device__ __forceinline__ void fox_unit(FA_LAS unsigned char* lds, const Params& P, int b, int h, int qb) {
    const int tid = threadIdx.x, lane = tid & 63, r32 = lane & 31, hi = lane >> 5;
    const int wid = __builtin_amdgcn_readfirstlane(tid >> 6);
    const int q0 = qb * 256, qlo = q0 + wid * 32, t = qlo + r32;
    const size_t rowbase = (size_t)b * SEQ;
    const bf16_t* ksrc = P.K + (rowbase + lane) * DM + h * 64 + wid * 8;
    const bf16_t* vsrc = P.V + (rowbase + 16 * (wid & 3) + (lane >> 2)) * DM + h * 64 + (wid >> 2) * 32 + (lane & 3) * 8;
    const float* cum = P.CUM + (size_t)(b * NH + h) * SEQ;
    const int adst = F_AOFF + lane * 16;
    const int NT = (q0 + 256) / 64;
    WaveSt w; const bf16_t* Qw = P.Q + (rowbase + t) * DM + h * 64 + hi * 8; float qn = 0.f;
#pragma unroll
    for (int d0 = 0; d0 < 4; ++d0) { w.qr[d0] = *(const bf16x8*)(Qw + d0 * 16);
#pragma unroll
        for (int j = 0; j < 8; ++j) { const float qv = bf2f((bf16_t)w.qr[d0][j]); qn = fmaf(qv, qv, qn); } }
    const float cref = cum[q0];
    w.cq = cum[t] - cref; w.mhat = 0.f; w.lsum = 0.f; w.mrun = -1e30f;
    wave_init<0>(w, hi);
    u32x4 gq[4]; load_gate(gq, P.G, rowbase + qlo, h, lane);
    const float qkb = sqrtf(swap_add(qn) * __uint_as_float(P.KMAX[b * NH + h])) * 1.0001f + 1e-3f;
    FA_LAS float* wsf = (FA_LAS float*)(lds + F_WSF) + wid * 64;
    FA_LAS unsigned* votes = (FA_LAS unsigned*)(lds + F_FLAG);
    float sa = 0.f, cnew = 0.f;
#define FA_LOADT(j, bf) do { const size_t ko_ = (size_t)(j) * 64 * DM; FA_LAS unsigned char* bb_ = lds + (bf) * F_KBUF; \
        glds16(ksrc + ko_, (unsigned)__builtin_amdgcn_readfirstlane((int)(unsigned)(uintptr_t)(bb_ + wid * 1024))); \
        glds16(vsrc + ko_, (unsigned)__builtin_amdgcn_readfirstlane((int)(unsigned)(uintptr_t)(bb_ + F_VOFF + (wid >> 2) * 4096 + (wid & 3) * 1024))); \
        cnew = cum[(j) * 64 + 63]; if (wid == 0) sa = cum[(j) * 64 + lane]; } while (0)
#define FA_WRITET(bf) do { FA_LAS unsigned char* bb_ = lds + (bf) * F_KBUF; \
        if (wid == 0) { const float a_ = cref - sa; const bf16_t h1 = f2bf(a_); const float r1 = a_ - bf2f(h1); const bf16_t h2 = f2bf(r1); const float r2 = r1 - bf2f(h2); const bf16_t h3 = f2bf(r2); \
            *(FA_LAS u32x4*)(bb_ + adst) = (u32x4){(unsigned)h1 | ((unsigned)h2 << 16), (unsigned)h3 | 0x3F800000u, 0x3F803F80u, 0u}; } } while (0)
    FA_LOADT(NT - 1, 0); FA_WRITET(0); asm volatile("s_waitcnt vmcnt(0)" ::: "memory"); __syncthreads();
    bool wdone = false, pend = false; f32x16 pA, pB;
#pragma unroll
    for (int r = 0; r < 16; ++r) pB[r] = 0.f;
    int cur = 0;
    for (int tt = 0; tt < NT; ++tt) {
        const int j = NT - 1 - tt, k0 = j * 64; const int nxt = cur == 2 ? 0 : cur + 1, prv = cur == 0 ? 2 : cur - 1;
        if (j > 0) FA_LOADT(j - 1, nxt);
        if (!wdone && k0 <= qlo + 31) {
            FA_LAS unsigned char* bb = lds + cur * F_KBUF;
            tile_step<0, F_AOFF, F_VOFF>(bb, pend ? lds + prv * F_KBUF : bb, wsf, w, pA, pB, k0, t, qlo, lane, r32, hi);
            pend = true;
        }
        if (j > 0) {
            if (!wdone && pend && __all(qkb + w.cq + (cref - cnew) - w.mrun <= -TH_SKIP)) {
                wdone = true; tile_drain<F_VOFF>(lds + cur * F_KBUF, w, pB, lane, hi);
            }
            if (lane == 0) votes[(tt & 1) * 8 + wid] = wdone ? 1u : 0u;
            FA_WRITET(nxt);
        }
        asm volatile("s_waitcnt vmcnt(0)" ::: "memory");
        __syncthreads();
        if (j > 0) { const u32x4 v0 = *(FA_LAS u32x4*)(votes + (tt & 1) * 8), v1 = *(FA_LAS u32x4*)(votes + (tt & 1) * 8 + 4);
            if ((v0.x & v0.y & v0.z & v0.w & v1.x & v1.y & v1.z & v1.w) != 0u) break; }
        else if (!wdone) tile_drain<F_VOFF>(lds + cur * F_KBUF, w, pB, lane, hi);
        cur = nxt;
    }
#undef FA_LOADT
#undef FA_WRITET
    wave_epilogue((FA_LAS float*)(lds + F_OST + wid * 4096), wsf, w, gq, P.O, rowbase + qlo, h, lane, r32, hi);
    __syncthreads();
}
__device__ __forceinline__ void swa_unit(FA_LAS unsigned char* lds, const Params& P, int b, int kvh, int qb) {
    const int tid = threadIdx.x, lane = tid & 63, r32 = lane & 31, hi = lane >> 5;
    const int wid = __builtin_amdgcn_readfirstlane(tid >> 6);
    const int q0 = qb * 256, qlo = q0 + wid * 32, t = qlo + r32;
    const size_t rowbase = (size_t)b * SEQ;
    const int j_lo = q0 >= 128 ? (q0 - 128) / 64 : 0, NT = (q0 + 256) / 64 - j_lo;
    const bf16_t* ksrc = P.K + (rowbase + j_lo * 64 + lane) * KVW + kvh * 64 + wid * 8;
    const bf16_t* vsrc = P.V + (rowbase + j_lo * 64 + 16 * (wid & 3) + (lane >> 2)) * KVW + kvh * 64 + (wid >> 2) * 32 + (lane & 3) * 8;
    const int kdst = wid * 1024 + lane * 16, vdst = S_VOFF + (wid >> 2) * 4096 + (wid & 3) * 1024 + lane * 16;
    { u32x4 sk[6], sv[6];
#pragma unroll
      for (int i = 0; i < 6; ++i) if (i < NT) { sk[i] = *(const u32x4*)(ksrc + (size_t)i * 64 * KVW); sv[i] = *(const u32x4*)(vsrc + (size_t)i * 64 * KVW); }
#pragma unroll
      for (int i = 0; i < 6; ++i) if (i < NT) { *(FA_LAS u32x4*)(lds + i * S_KBUF + kdst) = sk[i]; *(FA_LAS u32x4*)(lds + i * S_KBUF + vdst) = sv[i]; } }
    __syncthreads();
    FA_LAS float* wsf = (FA_LAS float*)(lds + S_WSF) + wid * 64;
    const int ta = (qlo >= 127 ? (qlo - 127) / 64 : 0) - j_lo, tb = (qlo + 31) / 64 - j_lo;
    bf16x8 qn[4]; { const bf16_t* Qw = P.Q + (rowbase + t) * DM + (kvh * 8) * 64 + hi * 8;
#pragma unroll
      for (int d0 = 0; d0 < 4; ++d0) qn[d0] = *(const bf16x8*)(Qw + d0 * 16); }
    for (int hh = 0; hh < 8; ++hh) {
        const int h = kvh * 8 + hh;
        WaveSt w;
#pragma unroll
        for (int d0 = 0; d0 < 4; ++d0) w.qr[d0] = qn[d0];
        { const bf16_t* Qw = P.Q + (rowbase + t) * DM + (kvh * 8 + (hh < 7 ? hh + 1 : hh)) * 64 + hi * 8;
#pragma unroll
          for (int d0 = 0; d0 < 4; ++d0) qn[d0] = *(const bf16x8*)(Qw + d0 * 16); }
        u32x4 gq[4]; load_gate(gq, P.G, rowbase + qlo, h, lane);
        w.cq = 0.f; w.mhat = P.sinks[h] * LOG2E; w.lsum = 0.5f; w.mrun = 0.f;
        wave_init<1>(w, hi);
        f32x16 pA, pB;
#pragma unroll
        for (int r = 0; r < 16; ++r) pB[r] = 0.f;
        for (int ti = tb; ti >= ta; --ti) { FA_LAS unsigned char* bb = lds + ti * S_KBUF;
            tile_step<1, 0, S_VOFF>(bb, ti == tb ? bb : bb + S_KBUF, wsf, w, pA, pB, (j_lo + ti) * 64, t, qlo, lane, r32, hi); }
        tile_drain<S_VOFF>(lds + ta * S_KBUF, w, pB, lane, hi);
        wave_epilogue((FA_LAS float*)(lds + S_OST + wid * 4096), wsf, w, gq, P.O, rowbase + qlo, h, lane, r32, hi);
    }
    __syncthreads();
}
}
#define GAS __attribute__((address_space(1)))
#define LAS __attribute__((address_space(3)))
typedef unsigned short bf16;
typedef unsigned v4u __attribute__((ext_vector_type(4)));
typedef float f32x4 __attribute__((ext_vector_type(4)));
typedef short bf16x8 __attribute__((ext_vector_type(8)));
typedef GAS unsigned gu32;
typedef GAS unsigned long long gu64;
#define RLX_AGENT __ATOMIC_RELAXED, __HIP_MEMORY_SCOPE_AGENT
#define LDS_WAIT() asm volatile("s_waitcnt lgkmcnt(0)" ::: "memory")
#define VM_WAIT() asm volatile("s_waitcnt vmcnt(0)" ::: "memory")
__device__ __forceinline__ unsigned long long rt() { return __builtin_amdgcn_s_memrealtime(); }
__device__ __forceinline__ unsigned pk2(float lo, float hi) { return (unsigned)f2bf(lo) | ((unsigned)f2bf(hi) << 16); }
#define XB_TMO      128
#define XB_XCNT(j)  (256  + 64 * (j))
#define XB_XSUB(j)  (1280 + 64 * (j))
#define XB_XGEN(j)  (2304 + 64 * (j))
#define XB_TOP      3328
#define XB_TOPGEN   3392
#define XCD_BAR_WORDS 3456
#define XB_SPIN_CAP (1u << 18)

__device__ __forceinline__ unsigned xb_ld(unsigned* p)              { return __hip_atomic_load(p, __ATOMIC_RELAXED, __HIP_MEMORY_SCOPE_AGENT); }
__device__ __forceinline__ unsigned xb_add(unsigned* p, unsigned v) { return __hip_atomic_fetch_add(p, v, __ATOMIC_RELAXED, __HIP_MEMORY_SCOPE_AGENT); }
__device__ __forceinline__ unsigned xb_xcc_id() { return (unsigned)__builtin_amdgcn_s_getreg((3 << 11) | 20) & 0xFu; }
#define XB_SPIN(cond, bar) do { unsigned _sp = 0; while (cond) { __builtin_amdgcn_s_sleep(1); \
    if ((++_sp & 255u) == 0u) { if (xb_ld(&(bar)[XB_TMO])) break; if (_sp > XB_SPIN_CAP) { atomicAdd(&(bar)[XB_TMO], 1u); break; } } } } while (0)

struct XcdBarrier {
    unsigned* bar; unsigned x;
    volatile LAS unsigned* st;
};

__device__ __forceinline__ XcdBarrier xcd_barrier_post(unsigned* bar, volatile LAS unsigned* st) {
    XcdBarrier b; b.bar = bar; b.x = xb_xcc_id(); b.st = st;
    if (threadIdx.x == 0) (void)xb_add(&bar[XB_XCNT(b.x)], 1u);
    return b;
}
__device__ __forceinline__ void xcd_barrier_complete(unsigned* bar, unsigned x, unsigned& nloc, unsigned& nx) {
    const unsigned G = gridDim.x * gridDim.y * gridDim.z;
    unsigned sum, cnt, mine, sp = 0u;
    for (;;) {
        sum = 0u; cnt = 0u; mine = 0u;
#pragma unroll
        for (unsigned j = 0; j < 16; ++j) { const unsigned c = xb_ld(&bar[XB_XCNT(j)]); sum += c; cnt += (c > 0u) ? 1u : 0u; mine = (j == x) ? c : mine; }
        if (sum == G) break;
        __builtin_amdgcn_s_sleep(1);
        if ((++sp & 255u) == 0u) { if (xb_ld(&bar[XB_TMO])) break; if (sp > XB_SPIN_CAP) { atomicAdd(&bar[XB_TMO], 1u); break; } }
    }
    nloc = mine > 0u ? mine : 1u; nx = cnt > 0u ? cnt : 1u;
}

__device__ __forceinline__ void xcd_barrier(const XcdBarrier& b) {
    asm volatile("s_waitcnt vmcnt(0)" ::: "memory");
    __syncthreads();
    if (threadIdx.x == 0) {
        unsigned* bar = b.bar;
        __builtin_amdgcn_s_waitcnt(0);
        unsigned nloc = b.st[0], nx = b.st[1];
        if (nloc == 0u) { xcd_barrier_complete(bar, b.x, nloc, nx); b.st[0] = nloc; b.st[1] = nx; }
        const unsigned old = xb_add(&bar[XB_XSUB(b.x)], 1u);
        const unsigned gen = old / nloc;
        if (old + 1u == (gen + 1u) * nloc) {
            __builtin_amdgcn_fence(__ATOMIC_RELEASE, "agent");
            asm volatile("s_waitcnt vmcnt(0)" ::: "memory");
            const unsigned og = xb_add(&bar[XB_TOP], 1u);
            const unsigned tg = og / nx;
            if (og + 1u == (tg + 1u) * nx) xb_add(&bar[XB_TOPGEN], 1u);
            else XB_SPIN(xb_ld(&bar[XB_TOPGEN]) == tg, bar);
            __builtin_amdgcn_fence(__ATOMIC_ACQUIRE, "agent");
            xb_add(&bar[XB_XGEN(b.x)], 1u);
            asm volatile("s_waitcnt vmcnt(0)" ::: "memory");
        } else {
            XB_SPIN(xb_ld(&bar[XB_XGEN(b.x)]) == gen, bar);
            __builtin_amdgcn_fence(__ATOMIC_ACQUIRE, "agent");
            asm volatile("s_waitcnt vmcnt(0)" ::: "memory");
        }
    }
    __syncthreads();
}
constexpr int NWAVES = 8;
constexpr int N1P = 8448;
constexpr int RING_OFF = 0, RING_BYTES = 135168;
constexpr int LDSCTL_OFF = RING_BYTES, MISC_OFF = LDSCTL_OFF + 320;
constexpr int LDS_BYTES = 147456;
constexpr int CW_BAR = 4096;
static_assert(fa::F_LDS_BYTES <= RING_BYTES && fa::S_LDS_BYTES <= RING_BYTES && pg8::STAGE_BYTES <= RING_BYTES && MISC_OFF + 128 <= LDS_BYTES && (CW_BAR + XCD_BAR_WORDS) * 4 <= (int)WS_KMAX, "LDS / CTL map");

__device__ __forceinline__ void p0_transpose_item(const float* W, int K, int N, bf16* WT, LAS float* scr, int item, int lane, const float* gs) {
    const int nblk = N / 32, kb = item / nblk, nb = item % nblk, k0 = 64 * kb, n0 = 32 * nb;
    const int kr = lane >> 3, nc = 4 * (lane & 7);
    f32x4 wv[8];
#pragma unroll
    for (int i = 0; i < 8; ++i) wv[i] = *(const GAS f32x4*)(W + (size_t)(k0 + 8 * i + kr) * N + n0 + nc);
#pragma unroll
    for (int i = 0; i < 8; ++i) { const int kk = 8 * i + kr; f32x4 w = wv[i]; if (gs) w = w * gs[k0 + kk]; LAS float* d = scr + kk * 33 + nc; d[0] = w.x; d[1] = w.y; d[2] = w.z; d[3] = w.w; }
    LDS_WAIT(); asm volatile("" ::: "memory");
    const int c = lane & 7;
#pragma unroll
    for (int j = 0; j < 4; ++j) { const int n = (lane >> 3) + 8 * j; const LAS float* sp = scr + (8 * c) * 33 + n;
        v4u o; o.x = pk2(sp[0 * 33], sp[1 * 33]); o.y = pk2(sp[2 * 33], sp[3 * 33]); o.z = pk2(sp[4 * 33], sp[5 * 33]); o.w = pk2(sp[6 * 33], sp[7 * 33]);
        *(GAS v4u*)(WT + tiled_off(n0 + n, k0 + 8 * c)) = o; }
    LDS_WAIT(); asm volatile("" ::: "memory");
}
__device__ __forceinline__ float wave_sum(float v) {
#pragma unroll
    for (int o = 1; o < 64; o <<= 1) v += __shfl_xor(v, o);
    return v;
}

struct Args { const float* in[9]; float* out; unsigned char* ws; int ph_lo, ph_hi; };
constexpr int N_PHASES = 9;
__global__ void __launch_bounds__(NWAVES * 64, 2) mega_fwd(Args args) {
    extern __shared__ __attribute__((aligned(16))) unsigned char lds_raw[];
    LAS unsigned char* lds = (LAS unsigned char*)lds_raw;
    volatile LAS unsigned* MISC = (volatile LAS unsigned*)(lds + MISC_OFF);
    const int tid = threadIdx.x, lane = tid & 63, wave = __builtin_amdgcn_readfirstlane(tid >> 6);
    const int G = gridDim.x, bx = blockIdx.x, vcu = (G % 8 == 0) ? (bx % 8) * (G / 8) + bx / 8 : bx;
    unsigned char* ws = args.ws;
    const float* x = args.in[0]; const float* norm_g = args.in[1]; const float* fox_w_in = args.in[2]; const float* fox_b_f = args.in[3]; const float* fox_w_out = args.in[4];
    const float* swa_w_in = args.in[5]; const float* swa_sinks = args.in[6]; const float* swa_w_out = args.in[7]; const float* final_g = args.in[8];
    float* out = args.out;
    gu32* ctl = (gu32*)(ws + WS_CTL);
    unsigned* KMAX = (unsigned*)(ws + WS_KMAX); unsigned* TICKET = (unsigned*)(ws + WS_TICKET);
    float* SS1 = (float*)(ws + WS_SS1); float* R0 = (float*)(ws + WS_R0); float* ROPE = (float*)(ws + WS_ROPE); float* LOGF = (float*)(ws + WS_LOGF); float* CUM = (float*)(ws + WS_CUM);
    bf16* W1T = (bf16*)(ws + WS_W1T); bf16* W2T = (bf16*)(ws + WS_W2T); bf16* W3T = (bf16*)(ws + WS_W3T); bf16* W4T = (bf16*)(ws + WS_W4T);
    bf16* XB = (bf16*)(ws + WS_XB); bf16* Qb = (bf16*)(ws + WS_Q); bf16* Kb = (bf16*)(ws + WS_K); bf16* Vb = (bf16*)(ws + WS_V); bf16* Gb = (bf16*)(ws + WS_G); bf16* YG = (bf16*)(ws + WS_YG);
    for (int u = tid; u < (LDS_BYTES - LDSCTL_OFF) / 4; u += NWAVES * 64) ((LAS unsigned*)(lds + LDSCTL_OFF))[u] = 0u;
    __syncthreads();
    const int lo = args.ph_lo, hi = args.ph_hi;
    XcdBarrier bar; bar.bar = (unsigned*)(ctl + CW_BAR); bar.x = 0; bar.st = nullptr;
    if (hi - lo > 1) bar = xcd_barrier_post((unsigned*)(ctl + CW_BAR), MISC + 8);
#define IN(k) (lo <= (k) && (k) < hi)
#define REP(k) for (int rep_ = 0; rep_ < (((DUP_MASK >> (k)) & 1) ? 2 : 1); ++rep_)
#define SEAM(k) do { if (IN(k) && IN((k) + 1)) xcd_barrier(bar); } while (0)
    const int gw = vcu * NWAVES + wave, NGW = G * NWAVES;

    if (IN(0)) REP(0) {
        LAS float* scr = (LAS float*)(lds + RING_OFF + wave * 16384);
        constexpr int I1 = (DM / 64) * (FOX_IN / 32), IZ = N1P - FOX_IN;
        constexpr int NITEMS = I1 + IZ;
        for (int it = gw; it < NITEMS; it += NGW) {
            int r = it;
            if (r < I1) { p0_transpose_item(fox_w_in, DM, FOX_IN, W1T, scr, r, lane, norm_g); continue; } r -= I1;
            { GAS v4u* zp = (GAS v4u*)(W1T + tiled_off(FOX_IN + r, (lane >> 1) * 64 + (lane & 1) * 32));
#pragma unroll
              for (int j = 0; j < 4; ++j) zp[j] = (v4u){0u, 0u, 0u, 0u}; }
        }
        for (int m = gw; m < MTOK; m += 2 * NGW) {
            const int m2 = m + NGW < MTOK ? m + NGW : m;
            const GAS f32x4* xr = (const GAS f32x4*)(x + (size_t)m * DM) + lane; const GAS f32x4* xr2 = (const GAS f32x4*)(x + (size_t)m2 * DM) + lane; f32x4 v[8], v2[8]; float s = 0.f, s2 = 0.f;
#pragma unroll
            for (int j = 0; j < 8; ++j) { v[j] = xr[64 * j]; v2[j] = xr2[64 * j]; }
#pragma unroll
            for (int j = 0; j < 8; ++j) { s += (v[j].x * v[j].x + v[j].y * v[j].y) + (v[j].z * v[j].z + v[j].w * v[j].w); s2 += (v2[j].x * v2[j].x + v2[j].y * v2[j].y) + (v2[j].z * v2[j].z + v2[j].w * v2[j].w); }
            s = wave_sum(s); s2 = wave_sum(s2);
            if (lane == 0) { R0[m] = 1.0f / sqrtf(s * (1.f / DM) + RMS_EPS); R0[m2] = 1.0f / sqrtf(s2 * (1.f / DM) + RMS_EPS); }
#pragma unroll
            for (int j = 0; j < 8; ++j) { *(GAS unsigned long long*)(XB + tiled_off(m, 256 * j + 4 * lane)) = (unsigned long long)pk2(v[j].x, v[j].y) | ((unsigned long long)pk2(v[j].z, v[j].w) << 32);
                                          *(GAS unsigned long long*)(XB + tiled_off(m2, 256 * j + 4 * lane)) = (unsigned long long)pk2(v2[j].x, v2[j].y) | ((unsigned long long)pk2(v2[j].z, v2[j].w) << 32); }
        }
        { const int gt = gw * 64 + lane;
          if (gt < SEQ * 8) { const int pos = gt >> 3, i = gt & 7;
              const double invf[8] = {1.0, 0.19390220519133497, 0.037598065178462524, 0.0072903477503833845, 0.0014142135623730951, 0.00027421912901204056, 5.3171693730649086e-05, 1.0310108130908796e-05};
              double inv = invf[0];
#pragma unroll
              for (int k = 1; k < 8; ++k) inv = (i == k) ? invf[k] : inv;
              const double ang = (double)pos * inv; const double kk = __builtin_rint(ang * 0.15915494309189535); const float red = (float)(ang - kk * 6.283185307179586);
              ROPE[(size_t)pos * 16 + i] = cosf(red); ROPE[(size_t)pos * 16 + 8 + i] = sinf(red); } }
    }
    SEAM(0);
    if (IN(1)) {
        pg8::Gemm g{XB, W1T, MTOK, N1P, DM}; pg8::StaticOrder S; S.init(MTOK, N1P, G, bx, (DUP_MASK >> 1) & 1, (DUP_MASK >> 9) & 1);
        pg8::EpiFoxIn E{Qb, Kb, Vb, Gb, LOGF, R0, fox_b_f};
        if ((DUP_MASK >> 10) & 1) { pg8::StaticOrder SP; SP.init(MTOK, N1P, G, bx, 0, 0, 1); pg8::gemm_phase<pg8::EpiFoxIn, pg8::StaticOrder, true, true>(lds + RING_OFF, g, SP, E); }
        pg8::gemm_phase<pg8::EpiFoxIn, pg8::StaticOrder, true, true>(lds + RING_OFF, g, S, E);
        { const int nwg = (MTOK / 256) * (N1P / 256), rem = nwg % G, nidle = rem ? G - rem : G, ii = rem ? bx - rem : bx;
          if (ii >= 0) { LAS float* scr = (LAS float*)(lds + RING_OFF + wave * 16384);
              constexpr int I2 = (DM / 64) * (DM / 32), I3 = (DM / 64) * (SWA_IN / 32);
              for (int it = ii * NWAVES + wave; it < I2 + I3 + I2; it += nidle * NWAVES) {
                  int r = it;
                  if (r < I2) { p0_transpose_item(fox_w_out, DM, DM, W2T, scr, r, lane, nullptr); continue; } r -= I2;
                  if (r < I3) { p0_transpose_item(swa_w_in, DM, SWA_IN, W3T, scr, r, lane, norm_g + DM); continue; } r -= I3;
                  p0_transpose_item(swa_w_out, DM, DM, W4T, scr, r, lane, nullptr); } } }
    }
    SEAM(1);
    if (IN(2)) REP(2) {
        for (int sq = gw; sq < NB * NH; sq += NGW) {
            const GAS f32x4* lf = (const GAS f32x4*)(LOGF + (size_t)sq * SEQ) + lane * 16; f32x4 v[16]; double tot = 0.0;
#pragma unroll
            for (int j = 0; j < 16; ++j) { v[j] = lf[j]; tot += ((double)v[j].x + (double)v[j].y) + ((double)v[j].z + (double)v[j].w); }
            double incl = tot;
#pragma unroll
            for (int o = 1; o < 64; o <<= 1) { const double up = __shfl_up(incl, o); if (lane >= o) incl += up; }
            double run = incl - tot;
            GAS f32x4* co = (GAS f32x4*)(CUM + (size_t)sq * SEQ) + lane * 16;
#pragma unroll
            for (int j = 0; j < 16; ++j) { f32x4 c; run += (double)v[j].x; c.x = (float)(run * 1.4426950408889634); run += (double)v[j].y; c.y = (float)(run * 1.4426950408889634);
                run += (double)v[j].z; c.z = (float)(run * 1.4426950408889634); run += (double)v[j].w; c.w = (float)(run * 1.4426950408889634); co[j] = c; }
        }
        for (int base = 8 * gw; base < MTOK; base += 8 * NGW) {
            float mx[4] = {0.f, 0.f, 0.f, 0.f};
            for (int rr = 0; rr < 8; ++rr) {
#pragma unroll
                for (int j = 0; j < 4; ++j) { const v4u kv = *(const GAS v4u*)(Kb + (size_t)(base + rr) * DM + (lane + 64 * j) * 8); float ss = 0.f;
                    const unsigned wv[4] = {kv.x, kv.y, kv.z, kv.w};
#pragma unroll
                    for (int e = 0; e < 4; ++e) { const float a = __uint_as_float(wv[e] << 16), c = __uint_as_float(wv[e] & 0xffff0000u); ss = fmaf(a, a, ss); ss = fmaf(c, c, ss); }
                    ss += __shfl_xor(ss, 1); ss += __shfl_xor(ss, 2); ss += __shfl_xor(ss, 4); mx[j] = fmaxf(mx[j], ss); } }
            if ((lane & 7) == 0) {
#pragma unroll
                for (int j = 0; j < 4; ++j) atomicMax(KMAX + (base >> 12) * NH + (lane >> 3) + 8 * j, __float_as_uint(mx[j])); }
        }
    }
    SEAM(2);
    if (IN(3)) {
        const fa::Params P{Qb, Kb, Vb, Gb, YG, CUM, nullptr, KMAX, TICKET};
        volatile LAS unsigned* slot = (volatile LAS unsigned*)(lds + RING_OFF + fa::F_FLAG + 128);
        if (tid == 0) slot[0] = atomicAdd(TICKET, 1u);
        __syncthreads();
        unsigned tk = slot[0]; int par = 0;
        while (tk < ((unsigned)(NB * NH * 16) << ((DUP_MASK >> 3) & 1))) {
            if (tid == 0) slot[par ^ 1] = atomicAdd(TICKET, 1u);
            const unsigned u = tk & (unsigned)(NB * NH * 16 - 1);
            const int bh = u & 127, qb = 15 - (int)(u >> 7);
            fa::fox_unit(lds + RING_OFF, P, bh >> 5, bh & 31, qb);
            par ^= 1; tk = slot[par];
        }
        __syncthreads();
    }
    SEAM(3);
    if (IN(4)) {
        pg8::Gemm g{YG, W2T, MTOK, DM, DM}; pg8::StaticOrder S; S.init(MTOK, DM, G, bx);
        pg8::EpiRes<true> E{x, out, XB, SS1};
        pg8::gemm_phase<pg8::EpiRes<true>, pg8::StaticOrder, true, true>(lds + RING_OFF, g, S, E);
    }
    SEAM(4);
    if (IN(5)) {
        pg8::Gemm g{XB, W3T, MTOK, SWA_IN, DM}; pg8::StaticOrder S; S.init(MTOK, SWA_IN, G, bx, (DUP_MASK >> 5) & 1);
        pg8::EpiSwaIn E{Qb, Kb, Vb, Gb, SS1, ROPE};
        pg8::gemm_phase<pg8::EpiSwaIn, pg8::StaticOrder, true, true>(lds + RING_OFF, g, S, E);
    }
    SEAM(5);
    if (IN(6)) REP(6) {
        const fa::Params P{Qb, Kb, Vb, Gb, YG, nullptr, swa_sinks, nullptr, nullptr};
        for (int u = (G == 256 ? vcu : bx); u < NB * 4 * 16; u += G) fa::swa_unit(lds + RING_OFF, P, u >> 6, (u >> 4) & 3, u & 15);
    }
    SEAM(6);
    if (IN(7)) {
        pg8::Gemm g{YG, W4T, MTOK, DM, DM}; pg8::StaticOrder S; S.init(MTOK, DM, G, bx);
        pg8::EpiRes<false> E{out, out, nullptr, nullptr};
        pg8::gemm_phase<pg8::EpiRes<false>, pg8::StaticOrder, true, true>(lds + RING_OFF, g, S, E);
    }
    SEAM(7);
    if (IN(8)) {
        f32x4 gq[8];
#pragma unroll
        for (int j = 0; j < 8; ++j) gq[j] = ((const GAS f32x4*)final_g)[lane + 64 * j];
        for (int m = gw; m < MTOK; m += NGW) {
            GAS f32x4* xr = (GAS f32x4*)(out + (size_t)m * DM) + lane; f32x4 v[8]; float s = 0.f;
#pragma unroll
            for (int j = 0; j < 8; ++j) { v[j] = xr[64 * j]; s += (v[j].x * v[j].x + v[j].y * v[j].y) + (v[j].z * v[j].z + v[j].w * v[j].w); }
            const float r = 1.0f / sqrtf(wave_sum(s) * (1.f / DM) + RMS_EPS);
#pragma unroll
            for (int j = 0; j < 8; ++j) xr[64 * j] = v[j] * r * gq[j];
        }
    }
#undef IN
#undef SEAM
}

extern "C" void kernel_launch(void* const* d_in, const int* in_sizes, int n_in, void* d_out, int out_size, void* d_ws, size_t ws_size, hipStream_t stream) {
    static int grid = 0;
    if (grid == 0) {
        if (n_in != 9 || in_sizes[0] != MTOK * DM || out_size != MTOK * DM || ws_size < WS_END) { fprintf(stderr, "kernel_launch: unexpected shapes (n_in %d, in0 %d, out %d, ws %zu)\n", n_in, n_in > 0 ? in_sizes[0] : -1, out_size, ws_size); grid = -1; return; }
        int dev = 0, cus = 0, per_cu = 0;
        if (hipGetDevice(&dev) != hipSuccess || hipDeviceGetAttribute(&cus, hipDeviceAttributeMultiprocessorCount, dev) != hipSuccess) { fprintf(stderr, "kernel_launch: device query failed\n"); grid = -1; return; }
        if (hipFuncSetAttribute((const void*)mega_fwd, hipFuncAttributeMaxDynamicSharedMemorySize, LDS_BYTES) != hipSuccess) { fprintf(stderr, "kernel_launch: hipFuncSetAttribute failed\n"); grid = -1; return; }
        if (hipOccupancyMaxActiveBlocksPerMultiprocessor(&per_cu, (const void*)mega_fwd, NWAVES * 64, LDS_BYTES) != hipSuccess || per_cu < 1) { fprintf(stderr, "kernel_launch: occupancy query reports %d workgroups per CU; nothing launched\n", per_cu); (void)hipGetLastError(); grid = -1; return; }
        grid = cus;
    }
    if (grid < 0) return;
    const float* x = (const float*)d_in[0]; const float* norm_g = (const float*)d_in[1]; const float* fox_w_in = (const float*)d_in[2]; const float* fox_b_f = (const float*)d_in[3];
    const float* fox_w_out = (const float*)d_in[4]; const float* swa_w_in = (const float*)d_in[5]; const float* swa_sinks = (const float*)d_in[6]; const float* swa_w_out = (const float*)d_in[7];
    const float* final_g = (const float*)d_in[8];
    float* out = (float*)d_out; unsigned char* ws = (unsigned char*)d_ws;
    float* SS1 = (float*)(ws + WS_SS1); float* R0 = (float*)(ws + WS_R0); float* LOGF = (float*)(ws + WS_LOGF); float* CUM = (float*)(ws + WS_CUM);
    bf16_t* XB = (bf16_t*)(ws + WS_XB); bf16_t* Q = (bf16_t*)(ws + WS_Q); bf16_t* K = (bf16_t*)(ws + WS_K); bf16_t* V = (bf16_t*)(ws + WS_V); bf16_t* Gt = (bf16_t*)(ws + WS_G); bf16_t* YG = (bf16_t*)(ws + WS_YG);
    (void)hipMemsetAsync(ws + WS_CTL, 0, CTL_ZERO_BYTES, stream);
    Args a{};
    for (int i = 0; i < 9; ++i) a.in[i] = (const float*)d_in[i];
    a.out = out; a.ws = ws;
    (void)x; (void)norm_g; (void)fox_w_in; (void)fox_b_f; (void)fox_w_out; (void)swa_w_in; (void)swa_sinks; (void)swa_w_out; (void)final_g; (void)SS1; (void)R0; (void)LOGF; (void)CUM; (void)XB; (void)Q; (void)K; (void)V; (void)Gt; (void)YG;
    int p = 0;
    while (p < N_PHASES) {
        if ((FAST_MASK >> p) & 1) {
            int e = p + 1; if (ONE_LAUNCH) while (e < N_PHASES && ((FAST_MASK >> e) & 1)) ++e;
            a.ph_lo = p; a.ph_hi = e;
            hipLaunchKernelGGL(mega_fwd, dim3(grid), dim3(NWAVES * 64), LDS_BYTES, stream, a);
            p = e; continue;
        }
#if FAST_MASK != 0x1FF
        switch (p) {
        case 0: n_rowrms<<<MTOK / 4, 256, 0, stream>>>(x, R0); break;
        case 1: n_gemm<float, NEpiFoxIn><<<dim3((FOX_IN + 63) / 64, MTOK / 64), 256, 0, stream>>>(x, DM, norm_g, fox_w_in, FOX_IN, DM, FOX_IN, NEpiFoxIn{Q, K, V, Gt, LOGF, R0, fox_b_f}); break;
        case 2: n_cumsum<<<2, 64, 0, stream>>>(LOGF, CUM); break;
        case 3: n_attn<0><<<dim3(SEQ / 256, NB * NH), 256, 0, stream>>>(Q, K, V, CUM, nullptr, Gt, YG); break;
        case 4: n_gemm<bf16_t, NEpiOut1><<<dim3(DM / 64, MTOK / 64), 256, 0, stream>>>(YG, DM, nullptr, fox_w_out, DM, DM, DM, NEpiOut1{x, out, XB, SS1}); break;
        case 5: n_gemm<float, NEpiSwaIn><<<dim3(SWA_IN / 64, MTOK / 64), 256, 0, stream>>>(out, DM, norm_g + DM, swa_w_in, SWA_IN, DM, SWA_IN, NEpiSwaIn{Q, K, V, Gt, SS1});
                n_rope<<<(MTOK * NH * 8 + 255) / 256, 256, 0, stream>>>(Q, DM, NH); n_rope<<<(MTOK * 4 * 8 + 255) / 256, 256, 0, stream>>>(K, KVW, 4); break;
        case 6: n_attn<1><<<dim3(SEQ / 256, NB * NH), 256, 0, stream>>>(Q, K, V, nullptr, swa_sinks, Gt, YG); break;
        case 7: n_gemm<bf16_t, NEpiOut2><<<dim3(DM / 64, MTOK / 64), 256, 0, stream>>>(YG, DM, nullptr, swa_w_out, DM, DM, DM, NEpiOut2{out}); break;
        case 8: n_finalnorm<<<MTOK / 4, 256, 0, stream>>>(out, final_g); break;
        }
#endif
        ++p;
    }
}
```

```cpp
#include <hip/hip_runtime.h>
#include <cstdio>
#include <cstdint>

constexpr int NB = 4, SEQ = 4096, DM = 2048, MTOK = NB * SEQ, NH = 32, HD = 64;
constexpr int FOX_IN = 8224, SWA_IN = 4608, KVW = 256;
constexpr float RMS_EPS = 1e-6f;
constexpr float LOG2E = 1.4426950408889634f;
constexpr float C2 = 0.125f * LOG2E;

typedef unsigned short bf16_t;
__device__ __forceinline__ float bf2f(bf16_t v) { return __uint_as_float((unsigned)v << 16); }
__device__ __forceinline__ bf16_t f2bf(float f) { unsigned u = __float_as_uint(f); return (bf16_t)((u + 0x7fffu + ((u >> 16) & 1u)) >> 16); }
__device__ __forceinline__ float logsigmoidf(float z) { return z < 0.f ? z - log1pf(expf(z)) : -log1pf(expf(-z)); }
__device__ __forceinline__ float siluf(float g) { return g / (1.f + expf(-g)); }

__host__ __device__ __forceinline__ size_t tiled_off(int row, int k) { return ((size_t)((row >> 8) * (DM / 64) + (k >> 6)) << 14) + (size_t)(((row & 255) << 6) + (k & 63)); }

constexpr size_t MiB = 1u << 20;
constexpr size_t WS_CTL = 0, CTL_ZERO_BYTES = 1 * MiB;
constexpr size_t WS_KMAX = 64 * 1024, WS_TICKET = 65 * 1024;
constexpr size_t WS_SS1 = 512 * 1024;
constexpr size_t WS_R0 = 1 * MiB;
constexpr size_t WS_ROPE = 1 * MiB + 512 * 1024;
constexpr size_t WS_LOGF = 2 * MiB;
constexpr size_t WS_CUM = 4 * MiB;
constexpr size_t WS_W1T = 8 * MiB, WS_W2T = 41 * MiB, WS_W3T = 49 * MiB, WS_W4T = 67 * MiB;
constexpr size_t WS_XB = 76 * MiB, WS_Q = 140 * MiB, WS_K = 204 * MiB, WS_V = 268 * MiB, WS_G = 332 * MiB, WS_YG = 396 * MiB, WS_KAUG = 460 * MiB, WS_END = 468 * MiB;

#ifndef FAST_MASK
#define FAST_MASK 0x1FF
#endif
#ifndef DUP_MASK
#define DUP_MASK 0x000
#endif
#ifndef ONE_LAUNCH
#define ONE_LAUNCH 1
#endif
#if FAST_MASK != 0x1FF
__global__ __launch_bounds__(256) void n_rowrms(const float* x, float* R) {
    const int row = blockIdx.x * 4 + (threadIdx.x >> 6), lane = threadIdx.x & 63;
    const float* xr = x + (size_t)row * DM; float s = 0.f;
    for (int i = lane; i < DM; i += 64) { const float v = xr[i]; s += v * v; }
#pragma unroll
    for (int o = 1; o < 64; o <<= 1) s += __shfl_xor(s, o);
    if (lane == 0) R[row] = 1.0f / sqrtf(s * (1.f / DM) + RMS_EPS);
}
__device__ __forceinline__ float toF(float v) { return v; }
__device__ __forceinline__ float toF(bf16_t v) { return bf2f(v); }

template <class AT, class Epi>
__global__ __launch_bounds__(256) void n_gemm(const AT* A, int lda, const float* kscale, const float* W, int ldw, int Kd, int N, Epi epi) {
    __shared__ float As[16][68]; __shared__ float Bs[16][68];
    const int tx = threadIdx.x & 15, ty = threadIdx.x >> 4;
    const int row0 = blockIdx.y * 64, col0 = blockIdx.x * 64;
    float acc[4][4];
#pragma unroll
    for (int i = 0; i < 4; ++i)
#pragma unroll
        for (int j = 0; j < 4; ++j) acc[i][j] = 0.f;
    for (int k0 = 0; k0 < Kd; k0 += 16) {
        for (int i = threadIdx.x; i < 1024; i += 256) { const int r = i >> 4, kk = i & 15; float a = toF(A[(size_t)(row0 + r) * lda + k0 + kk]); if (kscale) a *= kscale[k0 + kk]; As[kk][r] = a; }
        for (int i = threadIdx.x; i < 1024; i += 256) { const int kk = i >> 6, c = i & 63, col = col0 + c; Bs[kk][c] = col < N ? W[(size_t)(k0 + kk) * ldw + col] : 0.f; }
        __syncthreads();
#pragma unroll
        for (int kk = 0; kk < 16; ++kk) {
            const float4 a = *(const float4*)&As[kk][ty * 4]; const float4 b = *(const float4*)&Bs[kk][tx * 4];
            const float av[4] = {a.x, a.y, a.z, a.w}, bv[4] = {b.x, b.y, b.z, b.w};
#pragma unroll
            for (int i = 0; i < 4; ++i)
#pragma unroll
                for (int j = 0; j < 4; ++j) acc[i][j] = fmaf(av[i], bv[j], acc[i][j]);
        }
        __syncthreads();
    }
#pragma unroll
    for (int i = 0; i < 4; ++i)
#pragma unroll
        for (int j = 0; j < 4; ++j) { const int row = row0 + ty * 4 + i, col = col0 + tx * 4 + j; if (col < N) epi(row, col, acc[i][j]); }
}
struct NEpiFoxIn {
    bf16_t *Q, *K, *V, *G; float* LOGF; const float* R0; const float* bfb;
    __device__ void operator()(int row, int col, float v) const {
        v *= R0[row];
        if (col < 2048) Q[(size_t)row * DM + col] = f2bf(v * C2);
        else if (col < 4096) K[(size_t)row * DM + col - 2048] = f2bf(v);
        else if (col < 6144) V[(size_t)row * DM + col - 4096] = f2bf(v);
        else if (col < 8192) G[(size_t)row * DM + col - 6144] = f2bf(siluf(v));
        else { const int h = col - 8192, b = row >> 12, s = row & 4095; LOGF[((size_t)(b * NH + h) << 12) + s] = logsigmoidf(v + bfb[h]); }
    }
};
struct NEpiOut1 {
    const float* xin; float* xout; bf16_t* XB; float* SS;
    __device__ void operator()(int row, int col, float v) const {
        const size_t o = (size_t)row * DM + col; const float x1 = xin[o] + v; xout[o] = x1; XB[o] = f2bf(x1); atomicAdd(&SS[row], x1 * x1);
    }
};
struct NEpiSwaIn {
    bf16_t *Q, *K, *V, *G; const float* SS;
    __device__ void operator()(int row, int col, float v) const {
        v *= 1.0f / sqrtf(SS[row] * (1.f / DM) + RMS_EPS);
        if (col < 2048) Q[(size_t)row * DM + col] = f2bf(v * C2);
        else if (col < 2304) K[(size_t)row * KVW + col - 2048] = f2bf(v);
        else if (col < 2560) V[(size_t)row * KVW + col - 2304] = f2bf(v);
        else G[(size_t)row * DM + col - 2560] = f2bf(siluf(v));
    }
};
struct NEpiOut2 { float* xio; __device__ void operator()(int row, int col, float v) const { const size_t o = (size_t)row * DM + col; xio[o] = xio[o] + v; } };

__global__ void n_rope(bf16_t* T, int pitch, int nheads) {
    const long idx = (long)blockIdx.x * blockDim.x + threadIdx.x; const long total = (long)MTOK * nheads * 8; if (idx >= total) return;
    const int i = idx & 7; const long rh = idx >> 3; const int hh = rh % nheads; const long row = rh / nheads; const int pos = row & 4095;
    const double inv = pow(500000.0, -(double)i / 8.0); const float ang = (float)pos * (float)inv;
    const float c = cosf(ang), s = sinf(ang);
    bf16_t* p = T + (size_t)row * pitch + hh * 64 + i; const float x1 = bf2f(p[0]), x2 = bf2f(p[8]);
    p[0] = f2bf(x1 * c - x2 * s); p[8] = f2bf(x2 * c + x1 * s);
}
__global__ void n_cumsum(const float* LOGF, float* CUM) {
    const int sidx = blockIdx.x * blockDim.x + threadIdx.x; if (sidx >= NB * NH) return;
    const float* lf = LOGF + (size_t)sidx * SEQ; float* c = CUM + (size_t)sidx * SEQ; double a = 0.0;
    for (int s = 0; s < SEQ; ++s) { a += (double)lf[s]; c[s] = (float)(a * 1.4426950408889634); }
}
template <int MODE>
__global__ __launch_bounds__(256) void n_attn(const bf16_t* Q, const bf16_t* K, const bf16_t* V, const float* CUM, const float* sinks, const bf16_t* G, bf16_t* YG) {
    __shared__ float Ks[64][64]; __shared__ float Vs[64][64]; __shared__ float Cs[64];
    const int qb = blockIdx.x, bh = blockIdx.y, b = bh / NH, h = bh % NH, tid = threadIdx.x;
    const int t = qb * 256 + tid; const size_t row = (size_t)b * SEQ + t;
    const int kvh = MODE == 0 ? h : (h >> 3), kp = MODE == 0 ? DM : KVW;
    float q[64], o[64];
#pragma unroll
    for (int d = 0; d < 64; ++d) { q[d] = bf2f(Q[row * DM + h * 64 + d]); o[d] = 0.f; }
    const float ct = MODE == 0 ? CUM[(size_t)bh * SEQ + t] : 0.f;
    float m = MODE == 0 ? -1e30f : sinks[h] * LOG2E, l = MODE == 0 ? 0.f : 1.f;
    const int kstart = MODE == 0 ? 0 : (qb * 256 >= 128 ? qb * 256 - 128 : 0), kend = qb * 256 + 256;
    for (int k0 = kstart; k0 < kend; k0 += 64) {
        for (int i = tid; i < 4096; i += 256) { const int kk = i >> 6, d = i & 63; const size_t a = ((size_t)b * SEQ + k0 + kk) * kp + kvh * 64 + d; Ks[kk][d] = bf2f(K[a]); Vs[kk][d] = bf2f(V[a]); }
        if (MODE == 0 && tid < 64) Cs[tid] = CUM[(size_t)bh * SEQ + k0 + tid];
        __syncthreads();
        for (int kk = 0; kk < 64; ++kk) {
            const int s = k0 + kk; float sd = 0.f;
#pragma unroll
            for (int d = 0; d < 64; ++d) sd = fmaf(q[d], Ks[kk][d], sd);
            if (MODE == 0) sd += ct - Cs[kk];
            const bool ok = MODE == 0 ? (s <= t) : (s <= t && t - s < 128);
            if (!ok) sd = -INFINITY;
            const float mn = fmaxf(m, sd), a = exp2f(m - mn), p = exp2f(sd - mn);
            l = l * a + p;
#pragma unroll
            for (int d = 0; d < 64; ++d) o[d] = fmaf(p, Vs[kk][d], o[d] * a);
            m = mn;
        }
        __syncthreads();
    }
    const float rl = 1.f / l;
#pragma unroll
    for (int d = 0; d < 64; ++d) { const size_t a = row * DM + h * 64 + d; YG[a] = f2bf(o[d] * rl * bf2f(G[a])); }
}
__global__ __launch_bounds__(256) void n_finalnorm(float* xio, const float* g) {
    const int row = blockIdx.x * 4 + (threadIdx.x >> 6), lane = threadIdx.x & 63;
    float* xr = xio + (size_t)row * DM; float s = 0.f;
    for (int i = lane; i < DM; i += 64) { const float v = xr[i]; s += v * v; }
#pragma unroll
    for (int o = 1; o < 64; o <<= 1) s += __shfl_xor(s, o);
    const float r = 1.0f / sqrtf(s * (1.f / DM) + RMS_EPS);
    for (int i = lane; i < DM; i += 64) xr[i] = xr[i] * r * g[i];
}

#endif
namespace pg8 {
#define PG8_LAS __attribute__((address_space(3)))
typedef unsigned short bf16_t;
typedef short bf16x8 __attribute__((ext_vector_type(8)));
typedef float f32x4 __attribute__((ext_vector_type(4)));
typedef unsigned u32x4 __attribute__((ext_vector_type(4)));
constexpr int BM = 256, BK = 64, HALF = 128, HTB = HALF * BK * 2  , STAGE_BYTES = 8 * HTB, NXCD = 8, WGM = 8;

__host__ __device__ __forceinline__ int lds_byte(int r, int c) { const int st = (r >> 4) * 2 + (c >> 5), rr = r & 15, cc = c & 31, ob = rr * 64 + cc * 2; return st * 1024 + (ob ^ (((ob >> 9) & 1) << 5)); }
__host__ __device__ __forceinline__ void stage_rc(int b, int& R, int& C) { const int st = b / 1024, sb = b % 1024, swz = sb ^ (((sb >> 9) & 1) << 5); R = (st >> 1) * 16 + swz / 64; C = (st & 1) * 32 + (swz % 64) / 2; }
__host__ __device__ __forceinline__ int perm32(int rho) { const int n = rho >> 4, i = rho & 15; return 8 * (i >> 2) + 4 * n + (i & 3); }

struct Unit { int pm, pn, lm, ln; };
struct Gemm { const bf16_t* A; const bf16_t* Bt; int M, N, K; };

struct StaticOrder {
    int nM, nN, nwg, G, c, dup, epi2, same;
    __host__ __device__ void init(int M, int N, int G_, int c_, int dup_ = 0, int epi2_ = 0, int same_ = 0) { nM = M / BM; nN = N / BM; nwg = nM * nN; G = G_; c = c_; dup = dup_; epi2 = epi2_; same = same_; }
    __host__ __device__ bool next(int i, Unit& u) const {
        if (dup) i >>= 1;
        const long L = (long)i * G + c; if (L >= nwg) return false;
        int wgid = (int)L; { const int q = nwg / NXCD, r = nwg % NXCD, xcd = wgid % NXCD, off = wgid / NXCD; wgid = (xcd < r ? xcd * (q + 1) : r * (q + 1) + (xcd - r) * q) + off; }
        const int nig = WGM * nN, gid = wgid / nig, fm = gid * WGM, gsz = (nM - fm) < WGM ? (nM - fm) : WGM;
        u.pm = fm + ((wgid % nig) % gsz); u.pn = (wgid % nig) / gsz; u.lm = same ? 0 : u.pm; u.ln = same ? 0 : u.pn; return true;
    }
    __device__ __forceinline__ void a_ready(const Unit&) const {}
    __device__ __forceinline__ void done(const Unit&) const {}
};

__device__ __forceinline__ unsigned cvt_pk_bf16(float lo, float hi) { unsigned r; asm volatile("v_cvt_pk_bf16_f32 %0, %1, %2" : "=v"(r) : "v"(lo), "v"(hi)); return r; }
__device__ __forceinline__ float silu_fast(float g) { return g * __builtin_amdgcn_rcpf(1.0f + __builtin_amdgcn_exp2f(-g * 1.4426950408889634f)); }
__device__ __forceinline__ u32x4 pack8(const f32x4 v0, const f32x4 v1) { u32x4 w; w.x = cvt_pk_bf16(v0[0], v0[1]); w.y = cvt_pk_bf16(v0[2], v0[3]); w.z = cvt_pk_bf16(v1[0], v1[1]); w.w = cvt_pk_bf16(v1[2], v1[3]); return w; }
struct EpiFoxIn {
    static constexpr bool PERM = true, AFTER_DRAIN = false;
    bf16_t *Q, *K, *V, *G; float* LOGF; const float* R0; const float* bfb;
    __device__ __forceinline__ void operator()(const f32x4 (&acc)[2][2][4][2], const Unit& u, int wr, int wc, int fr, int fq) const {
        const int row0 = u.pm * BM + wr * 64 + fr, pn = u.pn;
        float rs[2][4];
#pragma unroll
        for (int ai = 0; ai < 2; ++ai)
#pragma unroll
            for (int m = 0; m < 4; ++m) rs[ai][m] = R0[row0 + ai * HALF + m * 16];
        if (pn < 32) {
            const int reg = pn >> 3; bf16_t* base = reg == 0 ? Q : reg == 1 ? K : reg == 2 ? V : G;
            const int col0 = (pn & 7) * BM + wc * 32 + 8 * fq;
#pragma unroll
            for (int ai = 0; ai < 2; ++ai)
#pragma unroll
                for (int m = 0; m < 4; ++m) { const int row = row0 + ai * HALF + m * 16; const float r = rs[ai][m]; const float sc = reg == 0 ? r * C2 : r; bf16_t* rowp = base + (size_t)row * DM + col0;
#pragma unroll
                    for (int bj = 0; bj < 2; ++bj) { f32x4 v0 = acc[ai][bj][m][0] * sc, v1 = acc[ai][bj][m][1] * sc;
                        if (reg == 3) {
#pragma unroll
                            for (int j = 0; j < 4; ++j) { v0[j] = silu_fast(v0[j]); v1[j] = silu_fast(v1[j]); } }
                        __builtin_nontemporal_store(pack8(v0, v1), (u32x4*)(rowp + bj * HALF)); } }
        } else if (wc == 0) {
#pragma unroll
            for (int ai = 0; ai < 2; ++ai)
#pragma unroll
                for (int m = 0; m < 4; ++m) { const int row = row0 + ai * HALF + m * 16; const float r = rs[ai][m]; const int b = row >> 12, s = row & 4095;
#pragma unroll
                    for (int n = 0; n < 2; ++n)
#pragma unroll
                        for (int j = 0; j < 4; ++j) { const int h = 8 * fq + 4 * n + j; LOGF[((size_t)(b * NH + h) << 12) + s] = logsigmoidf(acc[ai][0][m][n][j] * r + bfb[h]); } }
        }
    }
};
struct EpiSwaIn {
    static constexpr bool PERM = true, AFTER_DRAIN = false;
    bf16_t *Q, *K, *V, *G; const float* SS; const float* ROPE;
    __device__ __forceinline__ void operator()(const f32x4 (&acc)[2][2][4][2], const Unit& u, int wr, int wc, int fr, int fq) const {
        const int row0 = u.pm * BM + wr * 64 + fr, pn = u.pn;
        bf16_t* base; int pitch, colt; float osc = 1.f; const bool rope = pn <= 8, gate = pn >= 10;
        if (pn < 8) { base = Q; pitch = DM; colt = pn * BM; osc = C2; } else if (pn == 8) { base = K; pitch = KVW; colt = 0; } else if (pn == 9) { base = V; pitch = KVW; colt = 0; } else { base = G; pitch = DM; colt = (pn - 10) * BM; }
        const int col0 = colt + wc * 32 + 8 * fq; const bool rotw = rope && ((wc & 1) == 0); const float sgn = fq == 0 ? -1.f : 1.f; const bool rotl = fq < 2;
        float rs[2][4];
#pragma unroll
        for (int ai = 0; ai < 2; ++ai)
#pragma unroll
            for (int m = 0; m < 4; ++m) rs[ai][m] = SS[row0 + ai * HALF + m * 16];
        f32x4 nc0, nc1, ns0, ns1;
        if (rotw) { const float* rp = ROPE + (size_t)(row0 & 4095) * 16; nc0 = *(const f32x4*)rp; nc1 = *(const f32x4*)(rp + 4); ns0 = *(const f32x4*)(rp + 8); ns1 = *(const f32x4*)(rp + 12); }
#pragma unroll
        for (int ai = 0; ai < 2; ++ai)
#pragma unroll
            for (int m = 0; m < 4; ++m) { const int row = row0 + ai * HALF + m * 16; const float r = 1.0f / sqrtf(rs[ai][m] * (1.f / DM) + RMS_EPS); bf16_t* rowp = base + (size_t)row * pitch + col0;
                const f32x4 c0 = nc0, c1 = nc1, s0 = ns0, s1 = ns1;
                if (rotw && (ai * 4 + m) < 7) { const int nrow = row0 + ((ai * 4 + m + 1) >> 2) * HALF + ((ai * 4 + m + 1) & 3) * 16; const float* rp = ROPE + (size_t)(nrow & 4095) * 16; nc0 = *(const f32x4*)rp; nc1 = *(const f32x4*)(rp + 4); ns0 = *(const f32x4*)(rp + 8); ns1 = *(const f32x4*)(rp + 12); }
#pragma unroll
                for (int bj = 0; bj < 2; ++bj) { f32x4 v0 = acc[ai][bj][m][0] * r, v1 = acc[ai][bj][m][1] * r;
                    if (rotw) {
#pragma unroll
                        for (int j = 0; j < 4; ++j) { const float p0 = __shfl_xor(v0[j], 16), p1 = __shfl_xor(v1[j], 16);
                            const float n0 = v0[j] * c0[j] + sgn * p0 * s0[j], n1 = v1[j] * c1[j] + sgn * p1 * s1[j];
                            v0[j] = rotl ? n0 : v0[j]; v1[j] = rotl ? n1 : v1[j]; } }
                    if (gate) {
#pragma unroll
                        for (int j = 0; j < 4; ++j) { v0[j] = silu_fast(v0[j]); v1[j] = silu_fast(v1[j]); } }
                    v0 = v0 * osc; v1 = v1 * osc;
                    *(u32x4*)(rowp + bj * HALF) = pack8(v0, v1); } }
    }
};
template <bool FIRST> struct EpiRes {
    static constexpr bool PERM = false, AFTER_DRAIN = false;
    const float* xin; float* xout; bf16_t* XB; float* SS;
    __device__ __forceinline__ void operator()(const f32x4 (&acc)[2][2][4][2], const Unit& u, int wr, int wc, int fr, int fq) const {
        typedef unsigned u32x2v __attribute__((ext_vector_type(2)));
        const int row0 = u.pm * BM + wr * 64 + fr, col0 = u.pn * BM + wc * 32 + 4 * fq;
        f32x4 nx[2][2];
#pragma unroll
        for (int bj = 0; bj < 2; ++bj)
#pragma unroll
            for (int n = 0; n < 2; ++n) nx[bj][n] = *(const f32x4*)(xin + (size_t)row0 * DM + col0 + bj * HALF + n * 16);
#pragma unroll
        for (int ai = 0; ai < 2; ++ai)
#pragma unroll
            for (int m = 0; m < 4; ++m) { const int row = row0 + ai * HALF + m * 16; const size_t off = (size_t)row * DM + col0; float ss = 0.f;
                f32x4 cx[2][2];
#pragma unroll
                for (int bj = 0; bj < 2; ++bj)
#pragma unroll
                    for (int n = 0; n < 2; ++n) cx[bj][n] = nx[bj][n];
                if ((ai * 4 + m) < 7) { const int nrow = row0 + ((ai * 4 + m + 1) >> 2) * HALF + ((ai * 4 + m + 1) & 3) * 16;
#pragma unroll
                    for (int bj = 0; bj < 2; ++bj)
#pragma unroll
                        for (int n = 0; n < 2; ++n) nx[bj][n] = *(const f32x4*)(xin + (size_t)nrow * DM + col0 + bj * HALF + n * 16); }
#pragma unroll
                for (int bj = 0; bj < 2; ++bj)
#pragma unroll
                    for (int n = 0; n < 2; ++n) { const size_t o = off + bj * HALF + n * 16; const f32x4 x1 = cx[bj][n] + acc[ai][bj][m][n]; *(f32x4*)(xout + o) = x1;
                        if (FIRST) { u32x2v w; w.x = cvt_pk_bf16(x1[0], x1[1]); w.y = cvt_pk_bf16(x1[2], x1[3]); *(u32x2v*)(XB + tiled_off(row, col0 + bj * HALF + n * 16)) = w; ss += (x1[0] * x1[0] + x1[1] * x1[1]) + (x1[2] * x1[2] + x1[3] * x1[3]); } }
                if (FIRST) { ss += __shfl_xor(ss, 16); ss += __shfl_xor(ss, 32); if (fq == 0) atomicAdd(SS + row, ss); } }
    }
};
template <class Epi, class Sched, bool ALIGN_EPI = false, bool SP2 = false>
__device__ __forceinline__ void gemm_phase(PG8_LAS unsigned char* lds, const Gemm g, const Sched& S, const Epi& E) {
    const int tid = threadIdx.x, wid = __builtin_amdgcn_readfirstlane(tid >> 6), lane = tid & 63, wr = wid >> 2, wc = wid & 3, fr = lane & 15, fq = lane >> 4;
    const int K = g.K, nt = K / BK;
    unsigned voffA[2], voffB[2];
#pragma unroll
    for (int i = 0; i < 2; ++i) { int R, C; stage_rc(tid * 16 + i * 8192, R, C); const int Rb = Epi::PERM ? ((R & ~31) + perm32(R & 31)) : R;
        voffA[i] = (unsigned)(R * BK + C) * 2u; voffB[i] = (unsigned)(Rb * BK + C) * 2u; }
    const size_t kstep = (size_t)(BM * BK * 2);
    const size_t hstep = (size_t)(HALF * BK * 2);
    const size_t tstep = (size_t)BM * K * 2;
    const unsigned ldsw = (unsigned)wid * 1024u;
    const int aoff = lds_byte(wr * 64 + fr, fq * 8), boff = lds_byte(wc * 32 + fr, fq * 8);
#define PG8_SA(b, h) (((b) * 2 + (h)) * HTB)
#define PG8_SB(b, h) ((4 + (b) * 2 + (h)) * HTB)
#define PG8_STAGE(bufoff, gbase, voff) do { _Pragma("unroll") for (int _i = 0; _i < 2; ++_i) \
        __builtin_amdgcn_global_load_lds((const unsigned*)((const char*)(gbase) + (voff)[_i]), (PG8_LAS unsigned*)(lds + (bufoff) + ldsw + _i * 8192), 16, 0, 0); } while (0)
#define PG8_LDA(dst, b, h) do { _Pragma("unroll") for (int m = 0; m < 4; ++m) _Pragma("unroll") for (int k = 0; k < 2; ++k) dst[m][k] = *(const PG8_LAS bf16x8*)(lds + PG8_SA(b, h) + aoff + m * 2048 + k * 1024); } while (0)
#define PG8_LDB(dst, b, h) do { _Pragma("unroll") for (int n = 0; n < 2; ++n) _Pragma("unroll") for (int k = 0; k < 2; ++k) dst[n][k] = *(const PG8_LAS bf16x8*)(lds + PG8_SB(b, h) + boff + n * 2048 + k * 1024); } while (0)
#define PG8_MMA(ai, bj, At, Bt) do { __builtin_amdgcn_s_setprio(1); _Pragma("unroll") for (int m = 0; m < 4; ++m) _Pragma("unroll") for (int n = 0; n < 2; ++n) _Pragma("unroll") for (int k = 0; k < 2; ++k) \
        acc[ai][bj][m][n] = __builtin_amdgcn_mfma_f32_16x16x32_bf16(Bt[n][k], At[m][k], acc[ai][bj][m][n], 0, 0, 0); __builtin_amdgcn_s_setprio(0); } while (0)
#define PG8_WAIT_V(n) asm volatile("s_waitcnt vmcnt(" #n ")" ::: "memory")
#define PG8_WAIT_L(n) asm volatile("s_waitcnt lgkmcnt(" #n ")" ::: "memory")
#define PG8_BAR __builtin_amdgcn_s_barrier()
#define PG8_SCHED __builtin_amdgcn_sched_barrier(0)
    Unit cur, nxt; int ui = 0;
    if (!S.next(0, cur)) return;
    f32x4 acc[2][2][4][2];
#pragma unroll
    for (int a = 0; a < 2; ++a)
#pragma unroll
        for (int b = 0; b < 2; ++b)
#pragma unroll
            for (int m = 0; m < 4; ++m)
#pragma unroll
                for (int n = 0; n < 2; ++n) acc[a][b][m][n] = (f32x4){0.f, 0.f, 0.f, 0.f};
    bf16x8 At[4][2], B0[2][2], B1[2][2];
    const char* cA = (const char*)g.A + (size_t)cur.lm * tstep; const char* cB = (const char*)g.Bt + (size_t)cur.ln * tstep;
    S.a_ready(cur);
    if constexpr (SP2) {
        PG8_STAGE(PG8_SB(0, 0), cB, voffB); PG8_STAGE(PG8_SB(0, 1), cB + hstep, voffB); PG8_STAGE(PG8_SA(0, 0), cA, voffA); PG8_STAGE(PG8_SA(0, 1), cA + hstep, voffA);
        if (wr == 1) PG8_BAR;
        PG8_WAIT_V(2); PG8_BAR;
        PG8_STAGE(PG8_SB(1, 0), cB + kstep, voffB); PG8_STAGE(PG8_SA(1, 0), cA + kstep, voffA); PG8_STAGE(PG8_SB(1, 1), cB + hstep + kstep, voffB);
        PG8_WAIT_V(6); PG8_BAR;
    } else {
        PG8_STAGE(PG8_SB(0, 0), cB, voffB); PG8_STAGE(PG8_SA(0, 0), cA, voffA); PG8_STAGE(PG8_SB(0, 1), cB + hstep, voffB); PG8_STAGE(PG8_SA(0, 1), cA + hstep, voffA);
        if (wr == 1) PG8_BAR;
        PG8_WAIT_V(4); PG8_BAR;
        PG8_STAGE(PG8_SB(1, 0), cB + kstep, voffB); PG8_STAGE(PG8_SA(1, 0), cA + kstep, voffA); PG8_STAGE(PG8_SB(1, 1), cB + hstep + kstep, voffB);
        PG8_WAIT_V(6); PG8_BAR;
    }
    for (;;) {
        const bool has_next = S.next(ui + 1, nxt);
        const char* nA = has_next ? (const char*)g.A + (size_t)nxt.lm * tstep : cA; const char* nB = has_next ? (const char*)g.Bt + (size_t)nxt.ln * tstep : cB;
        for (int t = 0; t < nt; t += 2) {
            const bool last = (t == nt - 2);
            const char* a1 = cA + (size_t)(t + 1) * kstep;
            const char* a2 = last ? nA : cA + (size_t)(t + 2) * kstep; const char* b2 = last ? nB : cB + (size_t)(t + 2) * kstep;
            const char* a3 = a2 + kstep; const char* b3 = b2 + kstep;
            if (last && has_next) S.a_ready(nxt);
            if constexpr (SP2) {
            PG8_LDB(B0, 0, 0); PG8_LDB(B1, 0, 1); PG8_SCHED; PG8_LDA(At, 0, 0); PG8_STAGE(PG8_SA(1, 1), a1 + hstep, voffA);
            PG8_WAIT_V(8); PG8_WAIT_L(0); PG8_BAR; PG8_MMA(0, 0, At, B0); PG8_MMA(0, 1, At, B1); PG8_BAR; PG8_SCHED;
            PG8_LDA(At, 0, 1); PG8_STAGE(PG8_SB(0, 0), b2, voffB); PG8_STAGE(PG8_SB(0, 1), b2 + hstep, voffB); PG8_STAGE(PG8_SA(0, 0), a2, voffA);
            PG8_WAIT_V(8); PG8_WAIT_L(0); PG8_BAR; PG8_MMA(1, 0, At, B0); PG8_MMA(1, 1, At, B1); PG8_BAR; PG8_SCHED;
            PG8_LDB(B0, 1, 0); PG8_LDB(B1, 1, 1); PG8_SCHED; PG8_LDA(At, 1, 0); PG8_STAGE(PG8_SA(0, 1), a2 + hstep, voffA);
            PG8_WAIT_V(8); PG8_WAIT_L(0); PG8_BAR; PG8_MMA(0, 0, At, B0); PG8_MMA(0, 1, At, B1); PG8_BAR; PG8_SCHED;
            PG8_LDA(At, 1, 1); PG8_STAGE(PG8_SB(1, 0), b3, voffB); PG8_STAGE(PG8_SB(1, 1), b3 + hstep, voffB); PG8_STAGE(PG8_SA(1, 0), a3, voffA);
            PG8_WAIT_V(8); PG8_WAIT_L(0); PG8_BAR; PG8_MMA(1, 0, At, B0); PG8_MMA(1, 1, At, B1); PG8_BAR; PG8_SCHED;
            } else {
            PG8_LDB(B0, 0, 0); PG8_SCHED; PG8_LDA(At, 0, 0); PG8_STAGE(PG8_SA(1, 1), a1 + hstep, voffA);
            PG8_WAIT_L(8); PG8_BAR; PG8_WAIT_L(0); PG8_MMA(0, 0, At, B0); PG8_BAR; PG8_SCHED;
            PG8_LDB(B1, 0, 1); PG8_STAGE(PG8_SB(0, 0), b2, voffB);
            PG8_BAR; PG8_WAIT_L(0); PG8_MMA(0, 1, At, B1); PG8_BAR;
            PG8_LDA(At, 0, 1); PG8_STAGE(PG8_SA(0, 0), a2, voffA);
            PG8_BAR; PG8_WAIT_L(0); PG8_MMA(1, 0, At, B0); PG8_BAR; PG8_SCHED;
            PG8_STAGE(PG8_SB(0, 1), b2 + hstep, voffB);
            PG8_WAIT_V(6); PG8_BAR; PG8_MMA(1, 1, At, B1); PG8_BAR;
            PG8_LDB(B0, 1, 0); PG8_SCHED; PG8_LDA(At, 1, 0); PG8_STAGE(PG8_SA(0, 1), a2 + hstep, voffA);
            PG8_WAIT_L(8); PG8_BAR; PG8_WAIT_L(0); PG8_MMA(0, 0, At, B0); PG8_BAR; PG8_SCHED;
            PG8_LDB(B1, 1, 1); PG8_STAGE(PG8_SB(1, 0), b3, voffB);
            PG8_BAR; PG8_WAIT_L(0); PG8_MMA(0, 1, At, B1); PG8_BAR;
            PG8_LDA(At, 1, 1); PG8_STAGE(PG8_SA(1, 0), a3, voffA);
            PG8_BAR; PG8_WAIT_L(0); PG8_MMA(1, 0, At, B0); PG8_BAR; PG8_SCHED;
            PG8_STAGE(PG8_SB(1, 1), b3 + hstep, voffB);
            PG8_WAIT_V(6); PG8_BAR; PG8_MMA(1, 1, At, B1); PG8_BAR;
            }
        }
        if constexpr (ALIGN_EPI) { if (wr == 0) PG8_BAR; }
        if constexpr (!Epi::AFTER_DRAIN) { E(acc, cur, wr, wc, fr, fq); if (S.epi2) E(acc, cur, wr, wc, fr, fq); S.done(cur); }
        if (!has_next) break;
#pragma unroll
        for (int a = 0; a < 2; ++a)
#pragma unroll
            for (int b = 0; b < 2; ++b)
#pragma unroll
                for (int m = 0; m < 4; ++m)
#pragma unroll
                    for (int n = 0; n < 2; ++n) acc[a][b][m][n] = (f32x4){0.f, 0.f, 0.f, 0.f};
        cur = nxt; cA = nA; cB = nB; ++ui;
        if constexpr (ALIGN_EPI) { if (wr == 1) PG8_BAR; }
    }
    PG8_WAIT_V(0);
    if constexpr (!ALIGN_EPI) { if (wr == 0) PG8_BAR; }
    PG8_BAR;
    if constexpr (Epi::AFTER_DRAIN) { E.fused(acc, cur, wr, wc, fr, fq, lds, wid, lane); S.done(cur); }
#undef PG8_SA
#undef PG8_SB
#undef PG8_STAGE
#undef PG8_LDA
#undef PG8_LDB
#undef PG8_MMA
#undef PG8_WAIT_V
#undef PG8_WAIT_L
#undef PG8_BAR
#undef PG8_SCHED
}
}
namespace fa {
#define FA_LAS __attribute__((address_space(3)))
typedef short bf16x8 __attribute__((ext_vector_type(8)));
typedef short s16x4 __attribute__((ext_vector_type(4)));
typedef short v4i16_t __attribute__((ext_vector_type(4)));
typedef float f32x16 __attribute__((ext_vector_type(16)));
typedef float f32x4 __attribute__((ext_vector_type(4)));
typedef unsigned u32x4 __attribute__((ext_vector_type(4)));
typedef float f32x2_t __attribute__((ext_vector_type(2))); typedef __bf16 bf16x2_t __attribute__((ext_vector_type(2)));
constexpr float THR = 8.f, TH_SKIP = 32.f;
constexpr int F_KBUF = 18432, F_AOFF = 8192, F_VOFF = 10240, F_WSF = 3 * F_KBUF, F_FLAG = F_WSF + 8 * 256, F_OST = F_FLAG + 256, F_LDS_BYTES = F_OST + 8 * 4096;
constexpr int S_KBUF = 16384, S_VOFF = 8192, S_WSF = 6 * S_KBUF, S_OST = S_WSF + 8 * 256, S_LDS_BYTES = S_OST + 8 * 4096;
struct Params { const bf16_t* Q; const bf16_t* K; const bf16_t* V; const bf16_t* G; bf16_t* O; const float* CUM; const float* sinks; const unsigned* KMAX; unsigned* ticket; const bf16_t* KAUG; };
__device__ __forceinline__ unsigned cvtpk(float lo, float hi) { f32x2_t v = {lo, hi}; bf16x2_t b = __builtin_convertvector(v, bf16x2_t); return __builtin_bit_cast(unsigned, b); }
__device__ __forceinline__ s16x4 vtr(FA_LAS unsigned char* p) { return __builtin_bit_cast(s16x4, __builtin_amdgcn_ds_read_tr16_b64_v4i16((FA_LAS v4i16_t*)p)); }
__device__ __forceinline__ float swap_max(float v) { auto rr = __builtin_amdgcn_permlane32_swap(__float_as_uint(v), __float_as_uint(v), false, false); return __builtin_fmaxf(__uint_as_float(rr[0]), __uint_as_float(rr[1])); }
__device__ __forceinline__ float swap_add(float v) { auto rr = __builtin_amdgcn_permlane32_swap(__float_as_uint(v), __float_as_uint(v), false, false); return __uint_as_float(rr[0]) + __uint_as_float(rr[1]); }
__device__ __forceinline__ void glds16(const void* gsrc, unsigned lds_dst) { unsigned keep;
    asm volatile("s_mov_b32 %0, m0\n\ts_mov_b32 m0, %2\n\ts_nop 0\n\tglobal_load_lds_dwordx4 %1, off\n\ts_mov_b32 m0, %0" : "=&s"(keep) : "v"(gsrc), "s"(lds_dst) : "memory"); }
#define FA_MFMA(a, b, c) __builtin_amdgcn_mfma_f32_32x32x16_bf16((a), (b), (c), 0, 0, 0)
#define FA_MX3(a, b, c) __builtin_fmaxf(__builtin_fmaxf((a), (b)), (c))
struct WaveSt { bf16x8 qr[4]; bf16x8 qa; f32x16 cinit, o0, o1; float cq, mhat, lsum, mrun; };

#define FA_SBAR() __builtin_amdgcn_sched_barrier(0)
#define FA_PIN(x) asm volatile("" : "+v"(x))
#define FA_LDK(p) (*(FA_LAS bf16x8*)(p))
#define FA_VF(l, h) ((bf16x8){l[0], l[1], l[2], l[3], h[0], h[1], h[2], h[3]})
#define FA_EX4(X, B) do { X[B] = __builtin_amdgcn_exp2f(X[B]); X[B + 1] = __builtin_amdgcn_exp2f(X[B + 1]); X[B + 2] = __builtin_amdgcn_exp2f(X[B + 2]); X[B + 3] = __builtin_amdgcn_exp2f(X[B + 3]); } while (0)
__device__ __forceinline__ void split3(float v, unsigned& h1, unsigned& h2, unsigned& h3) { const bf16_t a = f2bf(v); const float r1 = v - bf2f(a); const bf16_t b = f2bf(r1); const float r2 = r1 - bf2f(b); h1 = a; h2 = b; h3 = f2bf(r2); }
__device__ __forceinline__ void set_qa(WaveSt& w, int hi) {
    unsigned g1, g2, g3; split3(w.cq - w.mhat, g1, g2, g3);
    const u32x4 q = {hi == 0 ? 0x3F803F80u : 0u, hi == 0 ? (0x3F80u | (g1 << 16)) : 0u, hi == 0 ? (g2 | (g3 << 16)) : 0u, 0u};
    w.qa = __builtin_bit_cast(bf16x8, q);
}
template <int MODE, int AOFF, int VOFF, int HB>
__device__ __forceinline__ void half_step(FA_LAS unsigned char* bb, FA_LAS unsigned char* vprev, FA_LAS float* wsf, WaveSt& w, f32x16& C, f32x16& P, int k0, int t, int qlo, int lane, int r32, int hi) {
    constexpr int W = MODE == 0 ? 0x40000000 : 128;
    FA_LAS unsigned char* kp = bb + hi * 1024 + r32 * 16 + HB * 512; FA_LAS unsigned char* ap = bb + AOFF + r32 * 16 + HB * 512;
    FA_LAS unsigned char* vp = (HB == 0 ? vprev + 2048 : bb) + VOFF + ((lane >> 4) & 1) * 32 + (lane & 3) * 8 + (4 * hi + ((lane & 15) >> 2)) * 64;
    bf16x8 kf0 = FA_LDK(kp), kf1 = FA_LDK(kp + 2048), kf2, kf3, ka;
    s16x4 vl0, vh0, vl1, vh1, vl2, vh2, vl3, vh3; u32x4 pw0, pw1; float sacc;
    FA_SBAR();
    if (MODE == 0) C = FA_MFMA(kf0, w.qr[0], ((f32x16){0.f, 0.f, 0.f, 0.f, 0.f, 0.f, 0.f, 0.f, 0.f, 0.f, 0.f, 0.f, 0.f, 0.f, 0.f, 0.f})); else C = FA_MFMA(kf0, w.qr[0], w.cinit);
    kf2 = FA_LDK(kp + 4096);
    sacc = (P[0] + P[1]) + (P[2] + P[3]); pw0.x = cvtpk(P[0], P[1]); pw0.y = cvtpk(P[2], P[3]); FA_PIN(sacc); FA_PIN(pw0.x); FA_PIN(pw0.y);
    FA_SBAR();
    C = FA_MFMA(kf1, w.qr[1], C); kf3 = FA_LDK(kp + 6144);
    sacc += P[4]; sacc += P[5]; sacc += P[6]; sacc += P[7]; pw0.z = cvtpk(P[4], P[5]); pw0.w = cvtpk(P[6], P[7]); FA_PIN(sacc); FA_PIN(pw0.z); FA_PIN(pw0.w);
    FA_SBAR();
    C = FA_MFMA(kf2, w.qr[2], C); if (MODE == 0) ka = FA_LDK(ap);
    sacc += P[8]; sacc += P[9]; sacc += P[10]; sacc += P[11]; pw1.x = cvtpk(P[8], P[9]); pw1.y = cvtpk(P[10], P[11]); FA_PIN(sacc); FA_PIN(pw1.x); FA_PIN(pw1.y); vl0 = vtr(vp); vh0 = vtr(vp + 512);
    FA_SBAR();
    C = FA_MFMA(kf3, w.qr[3], C);
    sacc += P[12]; sacc += P[13]; sacc += P[14]; sacc += P[15]; pw1.z = cvtpk(P[12], P[13]); pw1.w = cvtpk(P[14], P[15]); FA_PIN(sacc); FA_PIN(pw1.z); FA_PIN(pw1.w); vl1 = vtr(vp + 4096); vh1 = vtr(vp + 4096 + 512);
    FA_SBAR();
    if (MODE == 0) { C = FA_MFMA(ka, w.qa, C); FA_SBAR(); }
    w.lsum += sacc;
    const bf16x8 pa0 = __builtin_bit_cast(bf16x8, pw0), pa1 = __builtin_bit_cast(bf16x8, pw1);
    vl2 = vtr(vp + 1024); vh2 = vtr(vp + 1024 + 512);
    w.o0 = FA_MFMA(pa0, FA_VF(vl0, vh0), w.o0); vl3 = vtr(vp + 4096 + 1024); vh3 = vtr(vp + 4096 + 1024 + 512);
    w.o1 = FA_MFMA(pa0, FA_VF(vl1, vh1), w.o1);
    FA_SBAR();
    const int kh = k0 + 32 * HB;
    if ((kh + 31 > qlo) || (MODE == 1 && kh <= qlo + 31 - W)) {
        const float NEG = -__builtin_inff(); const int dq = t - kh - 4 * hi;
#pragma unroll
        for (int r = 0; r < 16; ++r) { const int c = (r & 3) + 8 * (r >> 2); if ((unsigned)(dq - c) >= (unsigned)W) C[r] = NEG; }
    }
    float ma = FA_MX3(C[0], C[1], C[2]), mb = FA_MX3(C[3], C[4], C[5]);
    ma = FA_MX3(ma, C[6], C[7]); mb = FA_MX3(mb, C[8], C[9]); ma = FA_MX3(ma, C[10], C[11]); mb = FA_MX3(mb, C[12], C[13]); ma = FA_MX3(ma, C[14], C[15]);
    const float rm = swap_max(__builtin_fmaxf(ma, mb));
    if (MODE == 0) w.mrun = __builtin_fmaxf(w.mrun, rm + w.mhat);
    const bool resc = __any(rm > THR);
    if (resc) {
        const float dl = __builtin_fmaxf(rm, 0.f); w.mhat += dl;
#pragma unroll
        for (int r = 0; r < 16; ++r) C[r] -= dl;
        if (MODE == 0) set_qa(w, hi);
        else { const float ci = w.cq - w.mhat;
#pragma unroll
            for (int r = 0; r < 16; ++r) w.cinit[r] = ci; }
        const float f = __builtin_amdgcn_exp2f(-dl); w.lsum *= f;
        if (hi == 0) wsf[r32] = f;
    }
    FA_SBAR();
    FA_EX4(C, 0); FA_PIN(C);
    w.o0 = FA_MFMA(pa1, FA_VF(vl2, vh2), w.o0); FA_EX4(C, 4); FA_EX4(C, 8); FA_PIN(C); FA_SBAR();
    w.o1 = FA_MFMA(pa1, FA_VF(vl3, vh3), w.o1); FA_EX4(C, 12); FA_PIN(C); FA_SBAR();
    if (resc) {
        asm volatile("s_waitcnt lgkmcnt(0)" ::: "memory");
#pragma unroll
        for (int g = 0; g < 4; ++g) { const f32x4 a4 = *(FA_LAS f32x4*)(wsf + 8 * g + 4 * hi);
#pragma unroll
            for (int i = 0; i < 4; ++i) { w.o0[4 * g + i] *= a4[i]; w.o1[4 * g + i] *= a4[i]; } }
    }
}
template <int MODE, int AOFF, int VOFF>
__device__ __forceinline__ void tile_step(FA_LAS unsigned char* bb, FA_LAS unsigned char* vprev, FA_LAS float* wsf, WaveSt& w, f32x16& pA, f32x16& pB, int k0, int t, int qlo, int lane, int r32, int hi) {
    half_step<MODE, AOFF, VOFF, 0>(bb, vprev, wsf, w, pA, pB, k0, t, qlo, lane, r32, hi);
    half_step<MODE, AOFF, VOFF, 1>(bb, vprev, wsf, w, pB, pA, k0, t, qlo, lane, r32, hi);
}
template <int VOFF>
__device__ __forceinline__ void tile_drain(FA_LAS unsigned char* vlast, WaveSt& w, f32x16& P, int lane, int hi) {
    FA_LAS unsigned char* vp = vlast + 2048 + VOFF + ((lane >> 4) & 1) * 32 + (lane & 3) * 8 + (4 * hi + ((lane & 15) >> 2)) * 64;
    float s0 = 0.f;
#pragma unroll
    for (int r = 0; r < 16; ++r) s0 += P[r];
    w.lsum += s0;
    const u32x4 w0 = {cvtpk(P[0], P[1]), cvtpk(P[2], P[3]), cvtpk(P[4], P[5]), cvtpk(P[6], P[7])};
    const u32x4 w1 = {cvtpk(P[8], P[9]), cvtpk(P[10], P[11]), cvtpk(P[12], P[13]), cvtpk(P[14], P[15])};
    const bf16x8 pa0 = __builtin_bit_cast(bf16x8, w0), pa1 = __builtin_bit_cast(bf16x8, w1);
    { const s16x4 l0 = vtr(vp), h0 = vtr(vp + 512), l1 = vtr(vp + 4096), h1 = vtr(vp + 4096 + 512); w.o0 = FA_MFMA(pa0, FA_VF(l0, h0), w.o0); w.o1 = FA_MFMA(pa0, FA_VF(l1, h1), w.o1); }
    { const s16x4 l0 = vtr(vp + 1024), h0 = vtr(vp + 1024 + 512), l1 = vtr(vp + 4096 + 1024), h1 = vtr(vp + 4096 + 1024 + 512); w.o0 = FA_MFMA(pa1, FA_VF(l0, h0), w.o0); w.o1 = FA_MFMA(pa1, FA_VF(l1, h1), w.o1); }
}
__device__ __forceinline__ void load_gate(u32x4 (&gq)[4], const bf16_t* G, size_t grow, int h, int lane) {
#pragma unroll
    for (int d0 = 0; d0 < 2; ++d0)
#pragma unroll
        for (int i = 0; i < 2; ++i) gq[2 * d0 + i] = *(const u32x4*)(G + (grow + i * 16 + (lane >> 2)) * DM + h * 64 + d0 * 32 + (lane & 3) * 8);
}
__device__ __forceinline__ void wave_epilogue(FA_LAS float* stg, FA_LAS float* wsf, WaveSt& w, const u32x4 (&gq)[4], bf16_t* O, size_t grow, int h, int lane, int r32, int hi) {
    const float l = swap_add(w.lsum);
    if (hi == 0) wsf[r32] = l;
    asm volatile("s_waitcnt lgkmcnt(0)" ::: "memory");
    float rl[16];
#pragma unroll
    for (int g = 0; g < 4; ++g) { const f32x4 l4 = *(FA_LAS f32x4*)(wsf + 8 * g + 4 * hi);
#pragma unroll
        for (int i = 0; i < 4; ++i) rl[4 * g + i] = 1.0f / l4[i]; }
#pragma unroll
    for (int d0 = 0; d0 < 2; ++d0) {
#pragma unroll
        for (int g = 0; g < 4; ++g)
#pragma unroll
            for (int i = 0; i < 4; ++i) stg[(8 * g + 4 * hi + i) * 32 + r32] = (d0 == 0 ? w.o0[4 * g + i] : w.o1[4 * g + i]) * rl[4 * g + i];
        asm volatile("s_waitcnt lgkmcnt(0)" ::: "memory");
#pragma unroll
        for (int i = 0; i < 2; ++i) { const int row = i * 16 + (lane >> 2), ch = lane & 3;
            const f32x4 x0 = *(FA_LAS f32x4*)(stg + row * 32 + ch * 8), x1 = *(FA_LAS f32x4*)(stg + row * 32 + ch * 8 + 4);
            const size_t ga = (grow + row) * DM + h * 64 + d0 * 32 + ch * 8; const u32x4 gv = gq[2 * d0 + i];
            u32x4 ov;
            ov.x = cvtpk(x0[0] * __uint_as_float(gv.x << 16), x0[1] * __uint_as_float(gv.x & 0xffff0000u)); ov.y = cvtpk(x0[2] * __uint_as_float(gv.y << 16), x0[3] * __uint_as_float(gv.y & 0xffff0000u));
            ov.z = cvtpk(x1[0] * __uint_as_float(gv.z << 16), x1[1] * __uint_as_float(gv.z & 0xffff0000u)); ov.w = cvtpk(x1[2] * __uint_as_float(gv.w << 16), x1[3] * __uint_as_float(gv.w & 0xffff0000u));
            *(u32x4*)(O + tiled_off((int)(grow + row), h * 64 + d0 * 32 + ch * 8)) = ov; }
        asm volatile("s_waitcnt lgkmcnt(0)" ::: "memory");
    }
}
template <int MODE> __device__ __forceinline__ void wave_init(WaveSt& w, int hi) {
#pragma unroll
    for (int r = 0; r < 16; ++r) { w.o0[r] = 0.f; w.o1[r] = 0.f; }
    if (MODE == 0) set_qa(w, hi);
    else { const float ci = w.cq - w.mhat;
#pragma unroll
        for (int r = 0; r < 16; ++r) w.cinit[r] = ci; }
}

__device__ __forceinline__ void fox_unit(FA_LAS unsigned char* lds, const Params& P, int b, int h, int qb) {
    const int tid = threadIdx.x, lane = tid & 63, r32 = lane & 31, hi = lane >> 5;
    const int wid = __builtin_amdgcn_readfirstlane(tid >> 6);
    const int q0 = qb * 256, qlo = q0 + wid * 32, t = qlo + r32;
    const size_t rowbase = (size_t)b * SEQ;
    const bf16_t* ksrc = P.K + (rowbase + lane) * DM + h * 64 + wid * 8;
    const bf16_t* vsrc = P.V + (rowbase + 16 * (wid & 3) + (lane >> 2)) * DM + h * 64 + (wid >> 2) * 32 + (lane & 3) * 8;
    const float* cum = P.CUM + (size_t)(b * NH + h) * SEQ;
    const bf16_t* asrc = P.KAUG + ((size_t)(b * NH + h) * SEQ + lane) * 8;
    const int NT = (q0 + 256) / 64;
    WaveSt w; const bf16_t* Qw = P.Q + (rowbase + t) * DM + h * 64 + hi * 8; float qn = 0.f;
#pragma unroll
    for (int d0 = 0; d0 < 4; ++d0) { w.qr[d0] = *(const bf16x8*)(Qw + d0 * 16);
#pragma unroll
        for (int j = 0; j < 8; ++j) { const float qv = bf2f((bf16_t)w.qr[d0][j]); qn = fmaf(qv, qv, qn); } }
    w.cq = cum[t]; w.mhat = 0.f; w.lsum = 0.f; w.mrun = -1e30f;
    wave_init<0>(w, hi);
    u32x4 gq[4]; load_gate(gq, P.G, rowbase + qlo, h, lane);
    const float qkb = sqrtf(swap_add(qn) * __uint_as_float(P.KMAX[b * NH + h])) * 1.0001f + 1e-3f;
    FA_LAS float* wsf = (FA_LAS float*)(lds + F_WSF) + wid * 64;
    FA_LAS unsigned* votes = (FA_LAS unsigned*)(lds + F_FLAG);
    float cnew = 0.f;
#define FA_LOADT(j, bf) do { const size_t ko_ = (size_t)(j) * 64 * DM; FA_LAS unsigned char* bb_ = lds + (bf) * F_KBUF; \
        glds16(ksrc + ko_, (unsigned)__builtin_amdgcn_readfirstlane((int)(unsigned)(uintptr_t)(bb_ + wid * 1024))); \
        glds16(vsrc + ko_, (unsigned)__builtin_amdgcn_readfirstlane((int)(unsigned)(uintptr_t)(bb_ + F_VOFF + (wid >> 2) * 4096 + (wid & 3) * 1024))); \
        if (wid == 0) glds16(asrc + (size_t)(j) * 64 * 8, (unsigned)__builtin_amdgcn_readfirstlane((int)(unsigned)(uintptr_t)(bb_ + F_AOFF))); \
        cnew = cum[(j) * 64 + 63]; } while (0)
    FA_LOADT(NT - 1, 0); asm volatile("s_waitcnt vmcnt(0)" ::: "memory"); __syncthreads();
    bool wdone = false, pend = false; f32x16 pA, pB;
#pragma unroll
    for (int r = 0; r < 16; ++r) pB[r] = 0.f;
    int cur = 0;
    for (int tt = 0; tt < NT; ++tt) {
        const int j = NT - 1 - tt, k0 = j * 64; const int nxt = cur == 2 ? 0 : cur + 1, prv = cur == 0 ? 2 : cur - 1;
        if (j > 0) FA_LOADT(j - 1, nxt);
        if (!wdone && k0 <= qlo + 31) {
            FA_LAS unsigned char* bb = lds + cur * F_KBUF;
            tile_step<0, F_AOFF, F_VOFF>(bb, pend ? lds + prv * F_KBUF : bb, wsf, w, pA, pB, k0, t, qlo, lane, r32, hi);
            pend = true;
        }
        if (j > 0) {
            if (!wdone && pend && __all(qkb + w.cq - cnew - w.mrun <= -TH_SKIP)) {
                wdone = true; tile_drain<F_VOFF>(lds + cur * F_KBUF, w, pB, lane, hi);
            }
            if (lane == 0) votes[(tt & 1) * 8 + wid] = wdone ? 1u : 0u;
        }
        asm volatile("s_waitcnt vmcnt(0)" ::: "memory");
        __syncthreads();
        if (j > 0) { const u32x4 v0 = *(FA_LAS u32x4*)(votes + (tt & 1) * 8), v1 = *(FA_LAS u32x4*)(votes + (tt & 1) * 8 + 4);
            if ((v0.x & v0.y & v0.z & v0.w & v1.x & v1.y & v1.z & v1.w) != 0u) break; }
        else if (!wdone) tile_drain<F_VOFF>(lds + cur * F_KBUF, w, pB, lane, hi);
        cur = nxt;
    }
#undef FA_LOADT
    wave_epilogue((FA_LAS float*)(lds + F_OST + wid * 4096), wsf, w, gq, P.O, rowbase + qlo, h, lane, r32, hi);
    __syncthreads();
}
__device__ __forceinline__ void swa_unit(FA_LAS unsigned char* lds, const Params& P, int b, int kvh, int qb) {
    const int tid = threadIdx.x, lane = tid & 63, r32 = lane & 31, hi = lane >> 5;
    const int wid = __builtin_amdgcn_readfirstlane(tid >> 6);
    const int q0 = qb * 256, qlo = q0 + wid * 32, t = qlo + r32;
    const size_t rowbase = (size_t)b * SEQ;
    const int j_lo = q0 >= 128 ? (q0 - 128) / 64 : 0, NT = (q0 + 256) / 64 - j_lo;
    const bf16_t* ksrc = P.K + (rowbase + j_lo * 64 + lane) * KVW + kvh * 64 + wid * 8;
    const bf16_t* vsrc = P.V + (rowbase + j_lo * 64 + 16 * (wid & 3) + (lane >> 2)) * KVW + kvh * 64 + (wid >> 2) * 32 + (lane & 3) * 8;
    const int kdst = wid * 1024 + lane * 16, vdst = S_VOFF + (wid >> 2) * 4096 + (wid & 3) * 1024 + lane * 16;
    { u32x4 sk[6], sv[6];
#pragma unroll
      for (int i = 0; i < 6; ++i) if (i < NT) { sk[i] = *(const u32x4*)(ksrc + (size_t)i * 64 * KVW); sv[i] = *(const u32x4*)(vsrc + (size_t)i * 64 * KVW); }
#pragma unroll
      for (int i = 0; i < 6; ++i) if (i < NT) { *(FA_LAS u32x4*)(lds + i * S_KBUF + kdst) = sk[i]; *(FA_LAS u32x4*)(lds + i * S_KBUF + vdst) = sv[i]; } }
    __syncthreads();
    FA_LAS float* wsf = (FA_LAS float*)(lds + S_WSF) + wid * 64;
    const int ta = (qlo >= 127 ? (qlo - 127) / 64 : 0) - j_lo, tb = (qlo + 31) / 64 - j_lo;
    bf16x8 qn[4]; { const bf16_t* Qw = P.Q + (rowbase + t) * DM + (kvh * 8) * 64 + hi * 8;
#pragma unroll
      for (int d0 = 0; d0 < 4; ++d0) qn[d0] = *(const bf16x8*)(Qw + d0 * 16); }
    for (int hh = 0; hh < 8; ++hh) {
        const int h = kvh * 8 + hh;
        WaveSt w;
#pragma unroll
        for (int d0 = 0; d0 < 4; ++d0) w.qr[d0] = qn[d0];
        { const bf16_t* Qw = P.Q + (rowbase + t) * DM + (kvh * 8 + (hh < 7 ? hh + 1 : hh)) * 64 + hi * 8;
#pragma unroll
          for (int d0 = 0; d0 < 4; ++d0) qn[d0] = *(const bf16x8*)(Qw + d0 * 16); }
        u32x4 gq[4]; load_gate(gq, P.G, rowbase + qlo, h, lane);
        w.cq = 0.f; w.mhat = P.sinks[h] * LOG2E; w.lsum = 0.5f; w.mrun = 0.f;
        wave_init<1>(w, hi);
        f32x16 pA, pB;
#pragma unroll
        for (int r = 0; r < 16; ++r) pB[r] = 0.f;
        for (int ti = tb; ti >= ta; --ti) { FA_LAS unsigned char* bb = lds + ti * S_KBUF;
            tile_step<1, 0, S_VOFF>(bb, ti == tb ? bb : bb + S_KBUF, wsf, w, pA, pB, (j_lo + ti) * 64, t, qlo, lane, r32, hi); }
        tile_drain<S_VOFF>(lds + ta * S_KBUF, w, pB, lane, hi);
        wave_epilogue((FA_LAS float*)(lds + S_OST + wid * 4096), wsf, w, gq, P.O, rowbase + qlo, h, lane, r32, hi);
    }
    __syncthreads();
}
}
#define GAS __attribute__((address_space(1)))
#define LAS __attribute__((address_space(3)))
typedef unsigned short bf16;
typedef unsigned v4u __attribute__((ext_vector_type(4)));
typedef float f32x4 __attribute__((ext_vector_type(4)));
typedef short bf16x8 __attribute__((ext_vector_type(8)));
typedef GAS unsigned gu32;
typedef GAS unsigned long long gu64;
#define RLX_AGENT __ATOMIC_RELAXED, __HIP_MEMORY_SCOPE_AGENT
#define LDS_WAIT() asm volatile("s_waitcnt lgkmcnt(0)" ::: "memory")
#define VM_WAIT() asm volatile("s_waitcnt vmcnt(0)" ::: "memory")
__device__ __forceinline__ unsigned long long rt() { return __builtin_amdgcn_s_memrealtime(); }
__device__ __forceinline__ unsigned pk2(float lo, float hi) { return (unsigned)f2bf(lo) | ((unsigned)f2bf(hi) << 16); }
#define XB_TMO      128
#define XB_XCNT(j)  (256  + 64 * (j))
#define XB_XSUB(j)  (1280 + 64 * (j))
#define XB_XGEN(j)  (2304 + 64 * (j))
#define XB_TOP      3328
#define XB_TOPGEN   3392
#define XCD_BAR_WORDS 3456
#define XB_SPIN_CAP (1u << 18)

__device__ __forceinline__ unsigned xb_ld(unsigned* p)              { return __hip_atomic_load(p, __ATOMIC_RELAXED, __HIP_MEMORY_SCOPE_AGENT); }
__device__ __forceinline__ unsigned xb_add(unsigned* p, unsigned v) { return __hip_atomic_fetch_add(p, v, __ATOMIC_RELAXED, __HIP_MEMORY_SCOPE_AGENT); }
__device__ __forceinline__ unsigned xb_xcc_id() { return (unsigned)__builtin_amdgcn_s_getreg((3 << 11) | 20) & 0xFu; }
#define XB_SPIN(cond, bar) do { unsigned _sp = 0; while (cond) { __builtin_amdgcn_s_sleep(1); \
    if ((++_sp & 255u) == 0u) { if (xb_ld(&(bar)[XB_TMO])) break; if (_sp > XB_SPIN_CAP) { atomicAdd(&(bar)[XB_TMO], 1u); break; } } } } while (0)

struct XcdBarrier {
    unsigned* bar; unsigned x;
    volatile LAS unsigned* st;
};

__device__ __forceinline__ XcdBarrier xcd_barrier_post(unsigned* bar, volatile LAS unsigned* st) {
    XcdBarrier b; b.bar = bar; b.x = xb_xcc_id(); b.st = st;
    if (threadIdx.x == 0) (void)xb_add(&bar[XB_XCNT(b.x)], 1u);
    return b;
}
__device__ __forceinline__ void xcd_barrier_complete(unsigned* bar, unsigned x, unsigned& nloc, unsigned& nx) {
    const unsigned G = gridDim.x * gridDim.y * gridDim.z;
    unsigned sum, cnt, mine, sp = 0u;
    for (;;) {
        sum = 0u; cnt = 0u; mine = 0u;
#pragma unroll
        for (unsigned j = 0; j < 16; ++j) { const unsigned c = xb_ld(&bar[XB_XCNT(j)]); sum += c; cnt += (c > 0u) ? 1u : 0u; mine = (j == x) ? c : mine; }
        if (sum == G) break;
        __builtin_amdgcn_s_sleep(1);
        if ((++sp & 255u) == 0u) { if (xb_ld(&bar[XB_TMO])) break; if (sp > XB_SPIN_CAP) { atomicAdd(&bar[XB_TMO], 1u); break; } }
    }
    nloc = mine > 0u ? mine : 1u; nx = cnt > 0u ? cnt : 1u;
}

__device__ __forceinline__ void xcd_barrier(const XcdBarrier& b) {
    asm volatile("s_waitcnt vmcnt(0)" ::: "memory");
    __syncthreads();
    if (threadIdx.x == 0) {
        unsigned* bar = b.bar;
        __builtin_amdgcn_s_waitcnt(0);
        unsigned nloc = b.st[0], nx = b.st[1];
        if (nloc == 0u) { xcd_barrier_complete(bar, b.x, nloc, nx); b.st[0] = nloc; b.st[1] = nx; }
        const unsigned old = xb_add(&bar[XB_XSUB(b.x)], 1u);
        const unsigned gen = old / nloc;
        if (old + 1u == (gen + 1u) * nloc) {
            __builtin_amdgcn_fence(__ATOMIC_RELEASE, "agent");
            asm volatile("s_waitcnt vmcnt(0)" ::: "memory");
            const unsigned og = xb_add(&bar[XB_TOP], 1u);
            const unsigned tg = og / nx;
            if (og + 1u == (tg + 1u) * nx) xb_add(&bar[XB_TOPGEN], 1u);
            else XB_SPIN(xb_ld(&bar[XB_TOPGEN]) == tg, bar);
            __builtin_amdgcn_fence(__ATOMIC_ACQUIRE, "agent");
            xb_add(&bar[XB_XGEN(b.x)], 1u);
            asm volatile("s_waitcnt vmcnt(0)" ::: "memory");
        } else {
            XB_SPIN(xb_ld(&bar[XB_XGEN(b.x)]) == gen, bar);
            __builtin_amdgcn_fence(__ATOMIC_ACQUIRE, "agent");
            asm volatile("s_waitcnt vmcnt(0)" ::: "memory");
        }
    }
    __syncthreads();
}
constexpr int NWAVES = 8;
constexpr int N1P = 8448;
constexpr int RING_OFF = 0, RING_BYTES = 135168;
constexpr int LDSCTL_OFF = RING_BYTES, MISC_OFF = LDSCTL_OFF + 320;
constexpr int LDS_BYTES = 147456;
constexpr int CW_BAR = 4096;
static_assert(fa::F_LDS_BYTES <= RING_BYTES && fa::S_LDS_BYTES <= RING_BYTES && pg8::STAGE_BYTES <= RING_BYTES && MISC_OFF + 128 <= LDS_BYTES && (CW_BAR + XCD_BAR_WORDS) * 4 <= (int)WS_KMAX, "LDS / CTL map");

__device__ __forceinline__ void p0_transpose_item(const float* W, int K, int N, bf16* WT, LAS float* scr, int item, int lane, const float* gs) {
    const int nblk = N / 32, kb = item / nblk, nb = item % nblk, k0 = 64 * kb, n0 = 32 * nb;
    const int kr = lane >> 3, nc = 4 * (lane & 7);
    f32x4 wv[8];
#pragma unroll
    for (int i = 0; i < 8; ++i) wv[i] = *(const GAS f32x4*)(W + (size_t)(k0 + 8 * i + kr) * N + n0 + nc);
#pragma unroll
    for (int i = 0; i < 8; ++i) { const int kk = 8 * i + kr; f32x4 w = wv[i]; if (gs) w = w * gs[k0 + kk]; LAS float* d = scr + kk * 33 + nc; d[0] = w.x; d[1] = w.y; d[2] = w.z; d[3] = w.w; }
    LDS_WAIT(); asm volatile("" ::: "memory");
    const int c = lane & 7;
#pragma unroll
    for (int j = 0; j < 4; ++j) { const int n = (lane >> 3) + 8 * j; const LAS float* sp = scr + (8 * c) * 33 + n;
        v4u o; o.x = pk2(sp[0 * 33], sp[1 * 33]); o.y = pk2(sp[2 * 33], sp[3 * 33]); o.z = pk2(sp[4 * 33], sp[5 * 33]); o.w = pk2(sp[6 * 33], sp[7 * 33]);
        *(GAS v4u*)(WT + tiled_off(n0 + n, k0 + 8 * c)) = o; }
    LDS_WAIT(); asm volatile("" ::: "memory");
}
__device__ __forceinline__ float wave_sum(float v) {
#pragma unroll
    for (int o = 1; o < 64; o <<= 1) v += __shfl_xor(v, o);
    return v;
}

struct Args { const float* in[9]; float* out; unsigned char* ws; int ph_lo, ph_hi; };
constexpr int N_PHASES = 9;
__global__ void __launch_bounds__(NWAVES * 64, 2) mega_fwd(Args args) {
    extern __shared__ __attribute__((aligned(16))) unsigned char lds_raw[];
    LAS unsigned char* lds = (LAS unsigned char*)lds_raw;
    volatile LAS unsigned* MISC = (volatile LAS unsigned*)(lds + MISC_OFF);
    const int tid = threadIdx.x, lane = tid & 63, wave = __builtin_amdgcn_readfirstlane(tid >> 6);
    const int G = gridDim.x, bx = blockIdx.x, vcu = (G % 8 == 0) ? (bx % 8) * (G / 8) + bx / 8 : bx;
    unsigned char* ws = args.ws;
    const float* x = args.in[0]; const float* norm_g = args.in[1]; const float* fox_w_in = args.in[2]; const float* fox_b_f = args.in[3]; const float* fox_w_out = args.in[4];
    const float* swa_w_in = args.in[5]; const float* swa_sinks = args.in[6]; const float* swa_w_out = args.in[7]; const float* final_g = args.in[8];
    float* out = args.out;
    gu32* ctl = (gu32*)(ws + WS_CTL);
    unsigned* KMAX = (unsigned*)(ws + WS_KMAX); unsigned* TICKET = (unsigned*)(ws + WS_TICKET);
    float* SS1 = (float*)(ws + WS_SS1); float* R0 = (float*)(ws + WS_R0); float* ROPE = (float*)(ws + WS_ROPE); float* LOGF = (float*)(ws + WS_LOGF); float* CUM = (float*)(ws + WS_CUM);
    bf16* W1T = (bf16*)(ws + WS_W1T); bf16* W2T = (bf16*)(ws + WS_W2T); bf16* W3T = (bf16*)(ws + WS_W3T); bf16* W4T = (bf16*)(ws + WS_W4T);
    bf16* KAUG = (bf16*)(ws + WS_KAUG);
    bf16* XB = (bf16*)(ws + WS_XB); bf16* Qb = (bf16*)(ws + WS_Q); bf16* Kb = (bf16*)(ws + WS_K); bf16* Vb = (bf16*)(ws + WS_V); bf16* Gb = (bf16*)(ws + WS_G); bf16* YG = (bf16*)(ws + WS_YG);
    for (int u = tid; u < (LDS_BYTES - LDSCTL_OFF) / 4; u += NWAVES * 64) ((LAS unsigned*)(lds + LDSCTL_OFF))[u] = 0u;
    __syncthreads();
    const int lo = args.ph_lo, hi = args.ph_hi;
    XcdBarrier bar; bar.bar = (unsigned*)(ctl + CW_BAR); bar.x = 0; bar.st = nullptr;
    if (hi - lo > 1) bar = xcd_barrier_post((unsigned*)(ctl + CW_BAR), MISC + 8);
#define IN(k) (lo <= (k) && (k) < hi)
#define REP(k) for (int rep_ = 0; rep_ < (((DUP_MASK >> (k)) & 1) ? 2 : 1); ++rep_)
#define SEAM(k) do { if (IN(k) && IN((k) + 1)) xcd_barrier(bar); } while (0)
    const int gw = vcu * NWAVES + wave, NGW = G * NWAVES;

    if (IN(0)) REP(0) {
        LAS float* scr = (LAS float*)(lds + RING_OFF + wave * 16384);
        constexpr int I1 = (DM / 64) * (FOX_IN / 32), IZ = N1P - FOX_IN;
        constexpr int NITEMS = I1 + IZ;
        for (int it = gw; it < NITEMS; it += NGW) {
            int r = it;
            if (r < I1) { p0_transpose_item(fox_w_in, DM, FOX_IN, W1T, scr, r, lane, norm_g); continue; } r -= I1;
            { GAS v4u* zp = (GAS v4u*)(W1T + tiled_off(FOX_IN + r, (lane >> 1) * 64 + (lane & 1) * 32));
#pragma unroll
              for (int j = 0; j < 4; ++j) zp[j] = (v4u){0u, 0u, 0u, 0u}; }
        }
        for (int m = gw; m < MTOK; m += 2 * NGW) {
            const int m2 = m + NGW < MTOK ? m + NGW : m;
            const GAS f32x4* xr = (const GAS f32x4*)(x + (size_t)m * DM) + lane; const GAS f32x4* xr2 = (const GAS f32x4*)(x + (size_t)m2 * DM) + lane; f32x4 v[8], v2[8]; float s = 0.f, s2 = 0.f;
#pragma unroll
            for (int j = 0; j < 8; ++j) { v[j] = xr[64 * j]; v2[j] = xr2[64 * j]; }
#pragma unroll
            for (int j = 0; j < 8; ++j) { s += (v[j].x * v[j].x + v[j].y * v[j].y) + (v[j].z * v[j].z + v[j].w * v[j].w); s2 += (v2[j].x * v2[j].x + v2[j].y * v2[j].y) + (v2[j].z * v2[j].z + v2[j].w * v2[j].w); }
            s = wave_sum(s); s2 = wave_sum(s2);
            if (lane == 0) { R0[m] = 1.0f / sqrtf(s * (1.f / DM) + RMS_EPS); R0[m2] = 1.0f / sqrtf(s2 * (1.f / DM) + RMS_EPS); }
#pragma unroll
            for (int j = 0; j < 8; ++j) { *(GAS unsigned long long*)(XB + tiled_off(m, 256 * j + 4 * lane)) = (unsigned long long)pk2(v[j].x, v[j].y) | ((unsigned long long)pk2(v[j].z, v[j].w) << 32);
                                          *(GAS unsigned long long*)(XB + tiled_off(m2, 256 * j + 4 * lane)) = (unsigned long long)pk2(v2[j].x, v2[j].y) | ((unsigned long long)pk2(v2[j].z, v2[j].w) << 32); }
        }
        { const int gt = gw * 64 + lane;
          if (gt < SEQ * 8) { const int pos = gt >> 3, i = gt & 7;
              const double invf[8] = {1.0, 0.19390220519133497, 0.037598065178462524, 0.0072903477503833845, 0.0014142135623730951, 0.00027421912901204056, 5.3171693730649086e-05, 1.0310108130908796e-05};
              double inv = invf[0];
#pragma unroll
              for (int k = 1; k < 8; ++k) inv = (i == k) ? invf[k] : inv;
              const double ang = (double)pos * inv; const double kk = __builtin_rint(ang * 0.15915494309189535); const float red = (float)(ang - kk * 6.283185307179586);
              ROPE[(size_t)pos * 16 + i] = cosf(red); ROPE[(size_t)pos * 16 + 8 + i] = sinf(red); } }
    }
    SEAM(0);
    if (IN(1)) {
        pg8::Gemm g{XB, W1T, MTOK, N1P, DM}; pg8::StaticOrder S; S.init(MTOK, N1P, G, bx, (DUP_MASK >> 1) & 1, (DUP_MASK >> 9) & 1);
        pg8::EpiFoxIn E{Qb, Kb, Vb, Gb, LOGF, R0, fox_b_f};
        if ((DUP_MASK >> 10) & 1) { pg8::StaticOrder SP; SP.init(MTOK, N1P, G, bx, 0, 0, 1); pg8::gemm_phase<pg8::EpiFoxIn, pg8::StaticOrder, true, true>(lds + RING_OFF, g, SP, E); }
        pg8::gemm_phase<pg8::EpiFoxIn, pg8::StaticOrder, true, true>(lds + RING_OFF, g, S, E);
        { const int nwg = (MTOK / 256) * (N1P / 256), rem = nwg % G, nidle = rem ? G - rem : G, ii = rem ? bx - rem : bx;
          if (ii >= 0) { LAS float* scr = (LAS float*)(lds + RING_OFF + wave * 16384);
              constexpr int I2 = (DM / 64) * (DM / 32), I3 = (DM / 64) * (SWA_IN / 32);
              for (int it = ii * NWAVES + wave; it < I2 + I3 + I2; it += nidle * NWAVES) {
                  int r = it;
                  if (r < I2) { p0_transpose_item(fox_w_out, DM, DM, W2T, scr, r, lane, nullptr); continue; } r -= I2;
                  if (r < I3) { p0_transpose_item(swa_w_in, DM, SWA_IN, W3T, scr, r, lane, norm_g + DM); continue; } r -= I3;
                  p0_transpose_item(swa_w_out, DM, DM, W4T, scr, r, lane, nullptr); } } }
    }
    SEAM(1);
    if (IN(2)) REP(2) {
        for (int sq = vcu; sq < NB * NH; sq += G) {
            const GAS f32x4* lf = (const GAS f32x4*)(LOGF + (size_t)sq * SEQ + wave * 512) + lane * 2; const f32x4 v0 = lf[0], v1 = lf[1];
            const double tot = (((double)v0.x + (double)v0.y) + ((double)v0.z + (double)v0.w)) + (((double)v1.x + (double)v1.y) + ((double)v1.z + (double)v1.w));
            double incl = tot;
#pragma unroll
            for (int o = 1; o < 64; o <<= 1) { const double up = __shfl_up(incl, o); if (lane >= o) incl += up; }
            volatile LAS double* wt = (volatile LAS double*)(lds + RING_OFF);
            __syncthreads();
            if (lane == 63) wt[wave] = incl;
            __syncthreads();
            double run = incl - tot;
            for (int w2 = 0; w2 < wave; ++w2) run += wt[w2];
            const float vv[8] = {v0.x, v0.y, v0.z, v0.w, v1.x, v1.y, v1.z, v1.w}; float cv[8];
#pragma unroll
            for (int e = 0; e < 8; ++e) { run += (double)vv[e]; cv[e] = (float)(run * 1.4426950408889634); }
            GAS f32x4* co = (GAS f32x4*)(CUM + (size_t)sq * SEQ + wave * 512) + lane * 2; co[0] = (f32x4){cv[0], cv[1], cv[2], cv[3]}; co[1] = (f32x4){cv[4], cv[5], cv[6], cv[7]};
            GAS v4u* ka = (GAS v4u*)(KAUG + ((size_t)sq * SEQ + wave * 512 + lane * 8) * 8);
#pragma unroll
            for (int e = 0; e < 8; ++e) { unsigned h1, h2, h3; fa::split3(-cv[e], h1, h2, h3); ka[e] = (v4u){h1 | (h2 << 16), h3 | 0x3F800000u, 0x3F803F80u, 0u}; }
        }
        for (int base = 8 * gw; base < MTOK; base += 8 * NGW) {
            float mx[4] = {0.f, 0.f, 0.f, 0.f};
            for (int rr = 0; rr < 8; ++rr) {
#pragma unroll
                for (int j = 0; j < 4; ++j) { const v4u kv = *(const GAS v4u*)(Kb + (size_t)(base + rr) * DM + (lane + 64 * j) * 8); float ss = 0.f;
                    const unsigned wv[4] = {kv.x, kv.y, kv.z, kv.w};
#pragma unroll
                    for (int e = 0; e < 4; ++e) { const float a = __uint_as_float(wv[e] << 16), c = __uint_as_float(wv[e] & 0xffff0000u); ss = fmaf(a, a, ss); ss = fmaf(c, c, ss); }
                    ss += __shfl_xor(ss, 1); ss += __shfl_xor(ss, 2); ss += __shfl_xor(ss, 4); mx[j] = fmaxf(mx[j], ss); } }
            if ((lane & 7) == 0) {
#pragma unroll
                for (int j = 0; j < 4; ++j) atomicMax(KMAX + (base >> 12) * NH + (lane >> 3) + 8 * j, __float_as_uint(mx[j])); }
        }
    }
    SEAM(2);
    if (IN(3)) {
        const fa::Params P{Qb, Kb, Vb, Gb, YG, CUM, nullptr, KMAX, TICKET, KAUG};
        volatile LAS unsigned* slot = (volatile LAS unsigned*)(lds + RING_OFF + fa::F_FLAG + 128);
        if (tid == 0) slot[0] = atomicAdd(TICKET, 1u);
        __syncthreads();
        unsigned tk = slot[0]; int par = 0;
        while (tk < ((unsigned)(NB * NH * 16) << ((DUP_MASK >> 3) & 1))) {
            if (tid == 0) slot[par ^ 1] = atomicAdd(TICKET, 1u);
            const unsigned u = tk & (unsigned)(NB * NH * 16 - 1);
            const int bh = u & 127, qb = 15 - (int)(u >> 7);
            fa::fox_unit(lds + RING_OFF, P, bh >> 5, bh & 31, qb);
            par ^= 1; tk = slot[par];
        }
        __syncthreads();
    }
    SEAM(3);
    if (IN(4)) {
        pg8::Gemm g{YG, W2T, MTOK, DM, DM}; pg8::StaticOrder S; S.init(MTOK, DM, G, bx);
        pg8::EpiRes<true> E{x, out, XB, SS1};
        pg8::gemm_phase<pg8::EpiRes<true>, pg8::StaticOrder, true, true>(lds + RING_OFF, g, S, E);
    }
    SEAM(4);
    if (IN(5)) {
        pg8::Gemm g{XB, W3T, MTOK, SWA_IN, DM}; pg8::StaticOrder S; S.init(MTOK, SWA_IN, G, bx, (DUP_MASK >> 5) & 1);
        pg8::EpiSwaIn E{Qb, Kb, Vb, Gb, SS1, ROPE};
        pg8::gemm_phase<pg8::EpiSwaIn, pg8::StaticOrder, true, true>(lds + RING_OFF, g, S, E);
    }
    SEAM(5);
    if (IN(6)) REP(6) {
        const fa::Params P{Qb, Kb, Vb, Gb, YG, nullptr, swa_sinks, nullptr, nullptr, nullptr};
        for (int u = (G == 256 ? vcu : bx); u < NB * 4 * 16; u += G) fa::swa_unit(lds + RING_OFF, P, u >> 6, (u >> 4) & 3, u & 15);
    }
    SEAM(6);
    if (IN(7)) {
        pg8::Gemm g{YG, W4T, MTOK, DM, DM}; pg8::StaticOrder S; S.init(MTOK, DM, G, bx);
        pg8::EpiRes<false> E{out, out, nullptr, nullptr};
        pg8::gemm_phase<pg8::EpiRes<false>, pg8::StaticOrder, true, true>(lds + RING_OFF, g, S, E);
    }
    SEAM(7);
    if (IN(8)) {
        f32x4 gq[8];
#pragma unroll
        for (int j = 0; j < 8; ++j) gq[j] = ((const GAS f32x4*)final_g)[lane + 64 * j];
        for (int m = gw; m < MTOK; m += NGW) {
            GAS f32x4* xr = (GAS f32x4*)(out + (size_t)m * DM) + lane; f32x4 v[8]; float s = 0.f;
#pragma unroll
            for (int j = 0; j < 8; ++j) { v[j] = xr[64 * j]; s += (v[j].x * v[j].x + v[j].y * v[j].y) + (v[j].z * v[j].z + v[j].w * v[j].w); }
            const float r = 1.0f / sqrtf(wave_sum(s) * (1.f / DM) + RMS_EPS);
#pragma unroll
            for (int j = 0; j < 8; ++j) xr[64 * j] = v[j] * r * gq[j];
        }
    }
#undef IN
#undef SEAM
}

extern "C" void kernel_launch(void* const* d_in, const int* in_sizes, int n_in, void* d_out, int out_size, void* d_ws, size_t ws_size, hipStream_t stream) {
    static int grid = 0;
    if (grid == 0) {
        if (n_in != 9 || in_sizes[0] != MTOK * DM || out_size != MTOK * DM || ws_size < WS_END) { fprintf(stderr, "kernel_launch: unexpected shapes (n_in %d, in0 %d, out %d, ws %zu)\n", n_in, n_in > 0 ? in_sizes[0] : -1, out_size, ws_size); grid = -1; return; }
        int dev = 0, cus = 0, per_cu = 0;
        if (hipGetDevice(&dev) != hipSuccess || hipDeviceGetAttribute(&cus, hipDeviceAttributeMultiprocessorCount, dev) != hipSuccess) { fprintf(stderr, "kernel_launch: device query failed\n"); grid = -1; return; }
        if (hipFuncSetAttribute((const void*)mega_fwd, hipFuncAttributeMaxDynamicSharedMemorySize, LDS_BYTES) != hipSuccess) { fprintf(stderr, "kernel_launch: hipFuncSetAttribute failed\n"); grid = -1; return; }
        if (hipOccupancyMaxActiveBlocksPerMultiprocessor(&per_cu, (const void*)mega_fwd, NWAVES * 64, LDS_BYTES) != hipSuccess || per_cu < 1) { fprintf(stderr, "kernel_launch: occupancy query reports %d workgroups per CU; nothing launched\n", per_cu); (void)hipGetLastError(); grid = -1; return; }
        grid = cus;
    }
    if (grid < 0) return;
    const float* x = (const float*)d_in[0]; const float* norm_g = (const float*)d_in[1]; const float* fox_w_in = (const float*)d_in[2]; const float* fox_b_f = (const float*)d_in[3];
    const float* fox_w_out = (const float*)d_in[4]; const float* swa_w_in = (const float*)d_in[5]; const float* swa_sinks = (const float*)d_in[6]; const float* swa_w_out = (const float*)d_in[7];
    const float* final_g = (const float*)d_in[8];
    float* out = (float*)d_out; unsigned char* ws = (unsigned char*)d_ws;
    float* SS1 = (float*)(ws + WS_SS1); float* R0 = (float*)(ws + WS_R0); float* LOGF = (float*)(ws + WS_LOGF); float* CUM = (float*)(ws + WS_CUM);
    bf16_t* XB = (bf16_t*)(ws + WS_XB); bf16_t* Q = (bf16_t*)(ws + WS_Q); bf16_t* K = (bf16_t*)(ws + WS_K); bf16_t* V = (bf16_t*)(ws + WS_V); bf16_t* Gt = (bf16_t*)(ws + WS_G); bf16_t* YG = (bf16_t*)(ws + WS_YG);
    (void)hipMemsetAsync(ws + WS_CTL, 0, CTL_ZERO_BYTES, stream);
    Args a{};
    for (int i = 0; i < 9; ++i) a.in[i] = (const float*)d_in[i];
    a.out = out; a.ws = ws;
    (void)x; (void)norm_g; (void)fox_w_in; (void)fox_b_f; (void)fox_w_out; (void)swa_w_in; (void)swa_sinks; (void)swa_w_out; (void)final_g; (void)SS1; (void)R0; (void)LOGF; (void)CUM; (void)XB; (void)Q; (void)K; (void)V; (void)Gt; (void)YG;
    int p = 0;
    while (p < N_PHASES) {
        if ((FAST_MASK >> p) & 1) {
            int e = p + 1; if (ONE_LAUNCH) while (e < N_PHASES && ((FAST_MASK >> e) & 1)) ++e;
            a.ph_lo = p; a.ph_hi = e;
            hipLaunchKernelGGL(mega_fwd, dim3(grid), dim3(NWAVES * 64), LDS_BYTES, stream, a);
            p = e; continue;
        }
#if FAST_MASK != 0x1FF
        switch (p) {
        case 0: n_rowrms<<<MTOK / 4, 256, 0, stream>>>(x, R0); break;
        case 1: n_gemm<float, NEpiFoxIn><<<dim3((FOX_IN + 63) / 64, MTOK / 64), 256, 0, stream>>>(x, DM, norm_g, fox_w_in, FOX_IN, DM, FOX_IN, NEpiFoxIn{Q, K, V, Gt, LOGF, R0, fox_b_f}); break;
        case 2: n_cumsum<<<2, 64, 0, stream>>>(LOGF, CUM); break;
        case 3: n_attn<0><<<dim3(SEQ / 256, NB * NH), 256, 0, stream>>>(Q, K, V, CUM, nullptr, Gt, YG); break;
        case 4: n_gemm<bf16_t, NEpiOut1><<<dim3(DM / 64, MTOK / 64), 256, 0, stream>>>(YG, DM, nullptr, fox_w_out, DM, DM, DM, NEpiOut1{x, out, XB, SS1}); break;
        case 5: n_gemm<float, NEpiSwaIn><<<dim3(SWA_IN / 64, MTOK / 64), 256, 0, stream>>>(out, DM, norm_g + DM, swa_w_in, SWA_IN, DM, SWA_IN, NEpiSwaIn{Q, K, V, Gt, SS1});
                n_rope<<<(MTOK * NH * 8 + 255) / 256, 256, 0, stream>>>(Q, DM, NH); n_rope<<<(MTOK * 4 * 8 + 255) / 256, 256, 0, stream>>>(K, KVW, 4); break;
        case 6: n_attn<1><<<dim3(SEQ / 256, NB * NH), 256, 0, stream>>>(Q, K, V, nullptr, swa_sinks, Gt, YG); break;
        case 7: n_gemm<bf16_t, NEpiOut2><<<dim3(DM / 64, MTOK / 64), 256, 0, stream>>>(YG, DM, nullptr, swa_w_out, DM, DM, DM, NEpiOut2{out}); break;
        case 8: n_finalnorm<<<MTOK / 4, 256, 0, stream>>>(out, final_g); break;
        }
#endif
        ++p;
    }
}
```

```cpp
#include <hip/hip_runtime.h>
#include <cstdio>
#include <cstdint>

constexpr int NB = 4, SEQ = 4096, DM = 2048, MTOK = NB * SEQ, NH = 32, HD = 64;
constexpr int FOX_IN = 8224, SWA_IN = 4608, KVW = 256;
constexpr float RMS_EPS = 1e-6f;
constexpr float LOG2E = 1.4426950408889634f;
constexpr float C2 = 0.125f * LOG2E;

typedef unsigned short bf16_t;
__device__ __forceinline__ float bf2f(bf16_t v) { return __uint_as_float((unsigned)v << 16); }
__device__ __forceinline__ bf16_t f2bf(float f) { unsigned u = __float_as_uint(f); return (bf16_t)((u + 0x7fffu + ((u >> 16) & 1u)) >> 16); }
__device__ __forceinline__ float logsigmoidf(float z) { return z < 0.f ? z - log1pf(expf(z)) : -log1pf(expf(-z)); }
__device__ __forceinline__ float siluf(float g) { return g / (1.f + expf(-g)); }

__host__ __device__ __forceinline__ size_t tiled_off(int row, int k) { return ((size_t)((row >> 8) * (DM / 64) + (k >> 6)) << 14) + (size_t)(((row & 255) << 6) + (k & 63)); }

constexpr size_t MiB = 1u << 20;
constexpr size_t WS_CTL = 0, CTL_ZERO_BYTES = 1 * MiB;
constexpr size_t WS_KMAX = 64 * 1024, WS_TICKET = 65 * 1024;
constexpr size_t WS_SS1 = 512 * 1024;
constexpr size_t WS_R0 = 1 * MiB;
constexpr size_t WS_ROPE = 1 * MiB + 512 * 1024;
constexpr size_t WS_LOGF = 2 * MiB;
constexpr size_t WS_CUM = 4 * MiB;
constexpr size_t WS_W1T = 8 * MiB, WS_W2T = 41 * MiB, WS_W3T = 49 * MiB, WS_W4T = 67 * MiB;
constexpr size_t WS_XB = 76 * MiB, WS_Q = 140 * MiB, WS_K = 204 * MiB, WS_V = 268 * MiB, WS_G = 332 * MiB, WS_YG = 396 * MiB, WS_KAUG = 460 * MiB, WS_END = 468 * MiB;

#ifndef FAST_MASK
#define FAST_MASK 0x1FF
#endif
#ifndef DUP_MASK
#define DUP_MASK 0x000
#endif
#ifndef ONE_LAUNCH
#define ONE_LAUNCH 1
#endif
#if FAST_MASK != 0x1FF
__global__ __launch_bounds__(256) void n_rowrms(const float* x, float* R) {
    const int row = blockIdx.x * 4 + (threadIdx.x >> 6), lane = threadIdx.x & 63;
    const float* xr = x + (size_t)row * DM; float s = 0.f;
    for (int i = lane; i < DM; i += 64) { const float v = xr[i]; s += v * v; }
#pragma unroll
    for (int o = 1; o < 64; o <<= 1) s += __shfl_xor(s, o);
    if (lane == 0) R[row] = 1.0f / sqrtf(s * (1.f / DM) + RMS_EPS);
}
__device__ __forceinline__ float toF(float v) { return v; }
__device__ __forceinline__ float toF(bf16_t v) { return bf2f(v); }

template <class AT, class Epi>
__global__ __launch_bounds__(256) void n_gemm(const AT* A, int lda, const float* kscale, const float* W, int ldw, int Kd, int N, Epi epi) {
    __shared__ float As[16][68]; __shared__ float Bs[16][68];
    const int tx = threadIdx.x & 15, ty = threadIdx.x >> 4;
    const int row0 = blockIdx.y * 64, col0 = blockIdx.x * 64;
    float acc[4][4];
#pragma unroll
    for (int i = 0; i < 4; ++i)
#pragma unroll
        for (int j = 0; j < 4; ++j) acc[i][j] = 0.f;
    for (int k0 = 0; k0 < Kd; k0 += 16) {
        for (int i = threadIdx.x; i < 1024; i += 256) { const int r = i >> 4, kk = i & 15; float a = toF(A[(size_t)(row0 + r) * lda + k0 + kk]); if (kscale) a *= kscale[k0 + kk]; As[kk][r] = a; }
        for (int i = threadIdx.x; i < 1024; i += 256) { const int kk = i >> 6, c = i & 63, col = col0 + c; Bs[kk][c] = col < N ? W[(size_t)(k0 + kk) * ldw + col] : 0.f; }
        __syncthreads();
#pragma unroll
        for (int kk = 0; kk < 16; ++kk) {
            const float4 a = *(const float4*)&As[kk][ty * 4]; const float4 b = *(const float4*)&Bs[kk][tx * 4];
            const float av[4] = {a.x, a.y, a.z, a.w}, bv[4] = {b.x, b.y, b.z, b.w};
#pragma unroll
            for (int i = 0; i < 4; ++i)
#pragma unroll
                for (int j = 0; j < 4; ++j) acc[i][j] = fmaf(av[i], bv[j], acc[i][j]);
        }
        __syncthreads();
    }
#pragma unroll
    for (int i = 0; i < 4; ++i)
#pragma unroll
        for (int j = 0; j < 4; ++j) { const int row = row0 + ty * 4 + i, col = col0 + tx * 4 + j; if (col < N) epi(row, col, acc[i][j]); }
}
struct NEpiFoxIn {
    bf16_t *Q, *K, *V, *G; float* LOGF; const float* R0; const float* bfb;
    __device__ void operator()(int row, int col, float v) const {
        v *= R0[row];
        if (col < 2048) Q[(size_t)row * DM + col] = f2bf(v * C2);
        else if (col < 4096) K[(size_t)row * DM + col - 2048] = f2bf(v);
        else if (col < 6144) V[(size_t)row * DM + col - 4096] = f2bf(v);
        else if (col < 8192) G[(size_t)row * DM + col - 6144] = f2bf(siluf(v));
        else { const int h = col - 8192, b = row >> 12, s = row & 4095; LOGF[((size_t)(b * NH + h) << 12) + s] = logsigmoidf(v + bfb[h]); }
    }
};
struct NEpiOut1 {
    const float* xin; float* xout; bf16_t* XB; float* SS;
    __device__ void operator()(int row, int col, float v) const {
        const size_t o = (size_t)row * DM + col; const float x1 = xin[o] + v; xout[o] = x1; XB[o] = f2bf(x1); atomicAdd(&SS[row], x1 * x1);
    }
};
struct NEpiSwaIn {
    bf16_t *Q, *K, *V, *G; const float* SS;
    __device__ void operator()(int row, int col, float v) const {
        v *= 1.0f / sqrtf(SS[row] * (1.f / DM) + RMS_EPS);
        if (col < 2048) Q[(size_t)row * DM + col] = f2bf(v * C2);
        else if (col < 2304) K[(size_t)row * KVW + col - 2048] = f2bf(v);
        else if (col < 2560) V[(size_t)row * KVW + col - 2304] = f2bf(v);
        else G[(size_t)row * DM + col - 2560] = f2bf(siluf(v));
    }
};
struct NEpiOut2 { float* xio; __device__ void operator()(int row, int col, float v) const { const size_t o = (size_t)row * DM + col; xio[o] = xio[o] + v; } };

__global__ void n_rope(bf16_t* T, int pitch, int nheads) {
    const long idx = (long)blockIdx.x * blockDim.x + threadIdx.x; const long total = (long)MTOK * nheads * 8; if (idx >= total) return;
    const int i = idx & 7; const long rh = idx >> 3; const int hh = rh % nheads; const long row = rh / nheads; const int pos = row & 4095;
    const double inv = pow(500000.0, -(double)i / 8.0); const float ang = (float)pos * (float)inv;
    const float c = cosf(ang), s = sinf(ang);
    bf16_t* p = T + (size_t)row * pitch + hh * 64 + i; const float x1 = bf2f(p[0]), x2 = bf2f(p[8]);
    p[0] = f2bf(x1 * c - x2 * s); p[8] = f2bf(x2 * c + x1 * s);
}
__global__ void n_cumsum(const float* LOGF, float* CUM) {
    const int sidx = blockIdx.x * blockDim.x + threadIdx.x; if (sidx >= NB * NH) return;
    const float* lf = LOGF + (size_t)sidx * SEQ; float* c = CUM + (size_t)sidx * SEQ; double a = 0.0;
    for (int s = 0; s < SEQ; ++s) { a += (double)lf[s]; c[s] = (float)(a * 1.4426950408889634); }
}
template <int MODE>
__global__ __launch_bounds__(256) void n_attn(const bf16_t* Q, const bf16_t* K, const bf16_t* V, const float* CUM, const float* sinks, const bf16_t* G, bf16_t* YG) {
    __shared__ float Ks[64][64]; __shared__ float Vs[64][64]; __shared__ float Cs[64];
    const int qb = blockIdx.x, bh = blockIdx.y, b = bh / NH, h = bh % NH, tid = threadIdx.x;
    const int t = qb * 256 + tid; const size_t row = (size_t)b * SEQ + t;
    const int kvh = MODE == 0 ? h : (h >> 3), kp = MODE == 0 ? DM : KVW;
    float q[64], o[64];
#pragma unroll
    for (int d = 0; d < 64; ++d) { q[d] = bf2f(Q[row * DM + h * 64 + d]); o[d] = 0.f; }
    const float ct = MODE == 0 ? CUM[(size_t)bh * SEQ + t] : 0.f;
    float m = MODE == 0 ? -1e30f : sinks[h] * LOG2E, l = MODE == 0 ? 0.f : 1.f;
    const int kstart = MODE == 0 ? 0 : (qb * 256 >= 128 ? qb * 256 - 128 : 0), kend = qb * 256 + 256;
    for (int k0 = kstart; k0 < kend; k0 += 64) {
        for (int i = tid; i < 4096; i += 256) { const int kk = i >> 6, d = i & 63; const size_t a = ((size_t)b * SEQ + k0 + kk) * kp + kvh * 64 + d; Ks[kk][d] = bf2f(K[a]); Vs[kk][d] = bf2f(V[a]); }
        if (MODE == 0 && tid < 64) Cs[tid] = CUM[(size_t)bh * SEQ + k0 + tid];
        __syncthreads();
        for (int kk = 0; kk < 64; ++kk) {
            const int s = k0 + kk; float sd = 0.f;
#pragma unroll
            for (int d = 0; d < 64; ++d) sd = fmaf(q[d], Ks[kk][d], sd);
            if (MODE == 0) sd += ct - Cs[kk];
            const bool ok = MODE == 0 ? (s <= t) : (s <= t && t - s < 128);
            if (!ok) sd = -INFINITY;
            const float mn = fmaxf(m, sd), a = exp2f(m - mn), p = exp2f(sd - mn);
            l = l * a + p;
#pragma unroll
            for (int d = 0; d < 64; ++d) o[d] = fmaf(p, Vs[kk][d], o[d] * a);
            m = mn;
        }
        __syncthreads();
    }
    const float rl = 1.f / l;
#pragma unroll
    for (int d = 0; d < 64; ++d) { const size_t a = row * DM + h * 64 + d; YG[a] = f2bf(o[d] * rl * bf2f(G[a])); }
}
__global__ __launch_bounds__(256) void n_finalnorm(float* xio, const float* g) {
    const int row = blockIdx.x * 4 + (threadIdx.x >> 6), lane = threadIdx.x & 63;
    float* xr = xio + (size_t)row * DM; float s = 0.f;
    for (int i = lane; i < DM; i += 64) { const float v = xr[i]; s += v * v; }
#pragma unroll
    for (int o = 1; o < 64; o <<= 1) s += __shfl_xor(s, o);
    const float r = 1.0f / sqrtf(s * (1.f / DM) + RMS_EPS);
    for (int i = lane; i < DM; i += 64) xr[i] = xr[i] * r * g[i];
}

#endif
namespace pg8 {
#define PG8_LAS __attribute__((address_space(3)))
typedef unsigned short bf16_t;
typedef short bf16x8 __attribute__((ext_vector_type(8)));
typedef float f32x4 __attribute__((ext_vector_type(4)));
typedef unsigned u32x4 __attribute__((ext_vector_type(4)));
constexpr int BM = 256, BK = 64, HALF = 128, HTB = HALF * BK * 2  , STAGE_BYTES = 8 * HTB, NXCD = 8, WGM = 8;

__host__ __device__ __forceinline__ int lds_byte(int r, int c) { const int st = (r >> 4) * 2 + (c >> 5), rr = r & 15, cc = c & 31, ob = rr * 64 + cc * 2; return st * 1024 + (ob ^ (((ob >> 9) & 1) << 5)); }
__host__ __device__ __forceinline__ void stage_rc(int b, int& R, int& C) { const int st = b / 1024, sb = b % 1024, swz = sb ^ (((sb >> 9) & 1) << 5); R = (st >> 1) * 16 + swz / 64; C = (st & 1) * 32 + (swz % 64) / 2; }
__host__ __device__ __forceinline__ int perm32(int rho) { const int n = rho >> 4, i = rho & 15; return 8 * (i >> 2) + 4 * n + (i & 3); }

struct Unit { int pm, pn, lm, ln; };
struct Gemm { const bf16_t* A; const bf16_t* Bt; int M, N, K; };

struct StaticOrder {
    int nM, nN, nwg, G, c, dup, epi2, same;
    __host__ __device__ void init(int M, int N, int G_, int c_, int dup_ = 0, int epi2_ = 0, int same_ = 0) { nM = M / BM; nN = N / BM; nwg = nM * nN; G = G_; c = c_; dup = dup_; epi2 = epi2_; same = same_; }
    __host__ __device__ bool next(int i, Unit& u) const {
        if (dup) i >>= 1;
        const long L = (long)i * G + c; if (L >= nwg) return false;
        int wgid = (int)L; { const int q = nwg / NXCD, r = nwg % NXCD, xcd = wgid % NXCD, off = wgid / NXCD; wgid = (xcd < r ? xcd * (q + 1) : r * (q + 1) + (xcd - r) * q) + off; }
        const int nig = WGM * nN, gid = wgid / nig, fm = gid * WGM, gsz = (nM - fm) < WGM ? (nM - fm) : WGM;
        u.pm = fm + ((wgid % nig) % gsz); u.pn = (wgid % nig) / gsz; u.lm = same ? 0 : u.pm; u.ln = same ? 0 : u.pn; return true;
    }
    __device__ __forceinline__ void a_ready(const Unit&) const {}
    __device__ __forceinline__ void done(const Unit&) const {}
};

__device__ __forceinline__ unsigned cvt_pk_bf16(float lo, float hi) { unsigned r; asm volatile("v_cvt_pk_bf16_f32 %0, %1, %2" : "=v"(r) : "v"(lo), "v"(hi)); return r; }
__device__ __forceinline__ float silu_fast(float g) { return g * __builtin_amdgcn_rcpf(1.0f + __builtin_amdgcn_exp2f(-g * 1.4426950408889634f)); }
__device__ __forceinline__ u32x4 pack8(const f32x4 v0, const f32x4 v1) { u32x4 w; w.x = cvt_pk_bf16(v0[0], v0[1]); w.y = cvt_pk_bf16(v0[2], v0[3]); w.z = cvt_pk_bf16(v1[0], v1[1]); w.w = cvt_pk_bf16(v1[2], v1[3]); return w; }
struct EpiFoxIn {
    static constexpr bool PERM = true, AFTER_DRAIN = false;
    bf16_t *Q, *K, *V, *G; float* LOGF; const float* R0; const float* bfb;
    __device__ __forceinline__ void operator()(const f32x4 (&acc)[2][2][4][2], const Unit& u, int wr, int wc, int fr, int fq) const {
        const int row0 = u.pm * BM + wr * 64 + fr, pn = u.pn;
        float rs[2][4];
#pragma unroll
        for (int ai = 0; ai < 2; ++ai)
#pragma unroll
            for (int m = 0; m < 4; ++m) rs[ai][m] = R0[row0 + ai * HALF + m * 16];
        if (pn < 32) {
            const int reg = pn >> 3; bf16_t* base = reg == 0 ? Q : reg == 1 ? K : reg == 2 ? V : G;
            const int col0 = (pn & 7) * BM + wc * 32 + 8 * fq;
#pragma unroll
            for (int ai = 0; ai < 2; ++ai)
#pragma unroll
                for (int m = 0; m < 4; ++m) { const int row = row0 + ai * HALF + m * 16; const float r = rs[ai][m]; const float sc = reg == 0 ? r * C2 : r; bf16_t* rowp = base + (size_t)row * DM + col0;
#pragma unroll
                    for (int bj = 0; bj < 2; ++bj) { f32x4 v0 = acc[ai][bj][m][0] * sc, v1 = acc[ai][bj][m][1] * sc;
                        if (reg == 3) {
#pragma unroll
                            for (int j = 0; j < 4; ++j) { v0[j] = silu_fast(v0[j]); v1[j] = silu_fast(v1[j]); } }
                        __builtin_nontemporal_store(pack8(v0, v1), (u32x4*)(rowp + bj * HALF)); } }
        } else if (wc == 0) {
#pragma unroll
            for (int ai = 0; ai < 2; ++ai)
#pragma unroll
                for (int m = 0; m < 4; ++m) { const int row = row0 + ai * HALF + m * 16; const float r = rs[ai][m]; const int b = row >> 12, s = row & 4095;
#pragma unroll
                    for (int n = 0; n < 2; ++n)
#pragma unroll
                        for (int j = 0; j < 4; ++j) { const int h = 8 * fq + 4 * n + j; LOGF[((size_t)(b * NH + h) << 12) + s] = logsigmoidf(acc[ai][0][m][n][j] * r + bfb[h]); } }
        }
    }
};
struct EpiSwaIn {
    static constexpr bool PERM = true, AFTER_DRAIN = false;
    bf16_t *Q, *K, *V, *G; const float* SS; const float* ROPE;
    __device__ __forceinline__ void operator()(const f32x4 (&acc)[2][2][4][2], const Unit& u, int wr, int wc, int fr, int fq) const {
        const int row0 = u.pm * BM + wr * 64 + fr, pn = u.pn;
        bf16_t* base; int pitch, colt; float osc = 1.f; const bool rope = pn <= 8, gate = pn >= 10;
        if (pn < 8) { base = Q; pitch = DM; colt = pn * BM; osc = C2; } else if (pn == 8) { base = K; pitch = KVW; colt = 0; } else if (pn == 9) { base = V; pitch = KVW; colt = 0; } else { base = G; pitch = DM; colt = (pn - 10) * BM; }
        const int col0 = colt + wc * 32 + 8 * fq; const bool rotw = rope && ((wc & 1) == 0); const float sgn = fq == 0 ? -1.f : 1.f; const bool rotl = fq < 2;
        float rs[2][4];
#pragma unroll
        for (int ai = 0; ai < 2; ++ai)
#pragma unroll
            for (int m = 0; m < 4; ++m) rs[ai][m] = SS[row0 + ai * HALF + m * 16];
        f32x4 nc0, nc1, ns0, ns1;
        if (rotw) { const float* rp = ROPE + (size_t)(row0 & 4095) * 16; nc0 = *(const f32x4*)rp; nc1 = *(const f32x4*)(rp + 4); ns0 = *(const f32x4*)(rp + 8); ns1 = *(const f32x4*)(rp + 12); }
#pragma unroll
        for (int ai = 0; ai < 2; ++ai)
#pragma unroll
            for (int m = 0; m < 4; ++m) { const int row = row0 + ai * HALF + m * 16; const float r = 1.0f / sqrtf(rs[ai][m] * (1.f / DM) + RMS_EPS); bf16_t* rowp = base + (size_t)row * pitch + col0;
                const f32x4 c0 = nc0, c1 = nc1, s0 = ns0, s1 = ns1;
                if (rotw && (ai * 4 + m) < 7) { const int nrow = row0 + ((ai * 4 + m + 1) >> 2) * HALF + ((ai * 4 + m + 1) & 3) * 16; const float* rp = ROPE + (size_t)(nrow & 4095) * 16; nc0 = *(const f32x4*)rp; nc1 = *(const f32x4*)(rp + 4); ns0 = *(const f32x4*)(rp + 8); ns1 = *(const f32x4*)(rp + 12); }
#pragma unroll
                for (int bj = 0; bj < 2; ++bj) { f32x4 v0 = acc[ai][bj][m][0] * r, v1 = acc[ai][bj][m][1] * r;
                    if (rotw) {
#pragma unroll
                        for (int j = 0; j < 4; ++j) { const float p0 = __shfl_xor(v0[j], 16), p1 = __shfl_xor(v1[j], 16);
                            const float n0 = v0[j] * c0[j] + sgn * p0 * s0[j], n1 = v1[j] * c1[j] + sgn * p1 * s1[j];
                            v0[j] = rotl ? n0 : v0[j]; v1[j] = rotl ? n1 : v1[j]; } }
                    if (gate) {
#pragma unroll
                        for (int j = 0; j < 4; ++j) { v0[j] = silu_fast(v0[j]); v1[j] = silu_fast(v1[j]); } }
                    v0 = v0 * osc; v1 = v1 * osc;
                    *(u32x4*)(rowp + bj * HALF) = pack8(v0, v1); } }
    }
};
template <bool FIRST> struct EpiRes {
    static constexpr bool PERM = false, AFTER_DRAIN = false;
    const float* xin; bf16_t* XB; float* SS;
    __device__ __forceinline__ void operator()(const f32x4 (&acc)[2][2][4][2], const Unit& u, int wr, int wc, int fr, int fq) const {
        typedef unsigned u32x2v __attribute__((ext_vector_type(2)));
        const int row0 = u.pm * BM + wr * 64 + fr, col0 = u.pn * BM + wc * 32 + 4 * fq;
        if (FIRST) {
            f32x4 nx[2][2];
#pragma unroll
            for (int bj = 0; bj < 2; ++bj)
#pragma unroll
                for (int n = 0; n < 2; ++n) nx[bj][n] = *(const f32x4*)(xin + (size_t)row0 * DM + col0 + bj * HALF + n * 16);
#pragma unroll
            for (int ai = 0; ai < 2; ++ai)
#pragma unroll
                for (int m = 0; m < 4; ++m) { const int row = row0 + ai * HALF + m * 16; float ss = 0.f;
                    f32x4 cx[2][2];
#pragma unroll
                    for (int bj = 0; bj < 2; ++bj)
#pragma unroll
                        for (int n = 0; n < 2; ++n) cx[bj][n] = nx[bj][n];
                    if ((ai * 4 + m) < 7) { const int nrow = row0 + ((ai * 4 + m + 1) >> 2) * HALF + ((ai * 4 + m + 1) & 3) * 16;
#pragma unroll
                        for (int bj = 0; bj < 2; ++bj)
#pragma unroll
                            for (int n = 0; n < 2; ++n) nx[bj][n] = *(const f32x4*)(xin + (size_t)nrow * DM + col0 + bj * HALF + n * 16); }
#pragma unroll
                    for (int bj = 0; bj < 2; ++bj)
#pragma unroll
                        for (int n = 0; n < 2; ++n) { const f32x4 x1 = cx[bj][n] + acc[ai][bj][m][n];
                            u32x2v w; w.x = cvt_pk_bf16(x1[0], x1[1]); w.y = cvt_pk_bf16(x1[2], x1[3]); *(u32x2v*)(XB + tiled_off(row, col0 + bj * HALF + n * 16)) = w;
                            ss += (x1[0] * x1[0] + x1[1] * x1[1]) + (x1[2] * x1[2] + x1[3] * x1[3]); }
                    ss += __shfl_xor(ss, 16); ss += __shfl_xor(ss, 32); if (fq == 0) atomicAdd(SS + row, ss); }
        } else {
            u32x2v xv[2][4][2][2];
#pragma unroll
            for (int ai = 0; ai < 2; ++ai)
#pragma unroll
                for (int m = 0; m < 4; ++m)
#pragma unroll
                    for (int bj = 0; bj < 2; ++bj)
#pragma unroll
                        for (int n = 0; n < 2; ++n) xv[ai][m][bj][n] = *(const u32x2v*)(XB + tiled_off(row0 + ai * HALF + m * 16, col0 + bj * HALF + n * 16));
#pragma unroll
            for (int ai = 0; ai < 2; ++ai)
#pragma unroll
                for (int m = 0; m < 4; ++m)
#pragma unroll
                    for (int bj = 0; bj < 2; ++bj)
#pragma unroll
                        for (int n = 0; n < 2; ++n) { const u32x2v xw = xv[ai][m][bj][n]; const f32x4 a = acc[ai][bj][m][n];
                            u32x2v w; w.x = cvt_pk_bf16(__uint_as_float(xw.x << 16) + a[0], __uint_as_float(xw.x & 0xffff0000u) + a[1]); w.y = cvt_pk_bf16(__uint_as_float(xw.y << 16) + a[2], __uint_as_float(xw.y & 0xffff0000u) + a[3]);
                            *(u32x2v*)(XB + tiled_off(row0 + ai * HALF + m * 16, col0 + bj * HALF + n * 16)) = w; }
        }
    }
};
template <class Epi, class Sched, bool ALIGN_EPI = false, bool SP2 = false>
__device__ __forceinline__ void gemm_phase(PG8_LAS unsigned char* lds, const Gemm g, const Sched& S, const Epi& E) {
    const int tid = threadIdx.x, wid = __builtin_amdgcn_readfirstlane(tid >> 6), lane = tid & 63, wr = wid >> 2, wc = wid & 3, fr = lane & 15, fq = lane >> 4;
    const int K = g.K, nt = K / BK;
    unsigned voffA[2], voffB[2];
#pragma unroll
    for (int i = 0; i < 2; ++i) { int R, C; stage_rc(tid * 16 + i * 8192, R, C); const int Rb = Epi::PERM ? ((R & ~31) + perm32(R & 31)) : R;
        voffA[i] = (unsigned)(R * BK + C) * 2u; voffB[i] = (unsigned)(Rb * BK + C) * 2u; }
    const size_t kstep = (size_t)(BM * BK * 2);
    const size_t hstep = (size_t)(HALF * BK * 2);
    const size_t tstep = (size_t)BM * K * 2;
    const unsigned ldsw = (unsigned)wid * 1024u;
    const int aoff = lds_byte(wr * 64 + fr, fq * 8), boff = lds_byte(wc * 32 + fr, fq * 8);
#define PG8_SA(b, h) (((b) * 2 + (h)) * HTB)
#define PG8_SB(b, h) ((4 + (b) * 2 + (h)) * HTB)
#define PG8_STAGE(bufoff, gbase, voff) do { _Pragma("unroll") for (int _i = 0; _i < 2; ++_i) \
        __builtin_amdgcn_global_load_lds((const unsigned*)((const char*)(gbase) + (voff)[_i]), (PG8_LAS unsigned*)(lds + (bufoff) + ldsw + _i * 8192), 16, 0, 0); } while (0)
#define PG8_LDA(dst, b, h) do { _Pragma("unroll") for (int m = 0; m < 4; ++m) _Pragma("unroll") for (int k = 0; k < 2; ++k) dst[m][k] = *(const PG8_LAS bf16x8*)(lds + PG8_SA(b, h) + aoff + m * 2048 + k * 1024); } while (0)
#define PG8_LDB(dst, b, h) do { _Pragma("unroll") for (int n = 0; n < 2; ++n) _Pragma("unroll") for (int k = 0; k < 2; ++k) dst[n][k] = *(const PG8_LAS bf16x8*)(lds + PG8_SB(b, h) + boff + n * 2048 + k * 1024); } while (0)
#define PG8_MMA(ai, bj, At, Bt) do { __builtin_amdgcn_s_setprio(1); _Pragma("unroll") for (int m = 0; m < 4; ++m) _Pragma("unroll") for (int n = 0; n < 2; ++n) _Pragma("unroll") for (int k = 0; k < 2; ++k) \
        acc[ai][bj][m][n] = __builtin_amdgcn_mfma_f32_16x16x32_bf16(Bt[n][k], At[m][k], acc[ai][bj][m][n], 0, 0, 0); __builtin_amdgcn_s_setprio(0); } while (0)
#define PG8_WAIT_V(n) asm volatile("s_waitcnt vmcnt(" #n ")" ::: "memory")
#define PG8_WAIT_L(n) asm volatile("s_waitcnt lgkmcnt(" #n ")" ::: "memory")
#define PG8_BAR __builtin_amdgcn_s_barrier()
#define PG8_SCHED __builtin_amdgcn_sched_barrier(0)
    Unit cur, nxt; int ui = 0;
    if (!S.next(0, cur)) return;
    f32x4 acc[2][2][4][2];
#pragma unroll
    for (int a = 0; a < 2; ++a)
#pragma unroll
        for (int b = 0; b < 2; ++b)
#pragma unroll
            for (int m = 0; m < 4; ++m)
#pragma unroll
                for (int n = 0; n < 2; ++n) acc[a][b][m][n] = (f32x4){0.f, 0.f, 0.f, 0.f};
    bf16x8 At[4][2], B0[2][2], B1[2][2];
    const char* cA = (const char*)g.A + (size_t)cur.lm * tstep; const char* cB = (const char*)g.Bt + (size_t)cur.ln * tstep;
    S.a_ready(cur);
    if constexpr (SP2) {
        PG8_STAGE(PG8_SB(0, 0), cB, voffB); PG8_STAGE(PG8_SB(0, 1), cB + hstep, voffB); PG8_STAGE(PG8_SA(0, 0), cA, voffA); PG8_STAGE(PG8_SA(0, 1), cA + hstep, voffA);
        if (wr == 1) PG8_BAR;
        PG8_WAIT_V(2); PG8_BAR;
        PG8_STAGE(PG8_SB(1, 0), cB + kstep, voffB); PG8_STAGE(PG8_SA(1, 0), cA + kstep, voffA); PG8_STAGE(PG8_SB(1, 1), cB + hstep + kstep, voffB);
        PG8_WAIT_V(6); PG8_BAR;
    } else {
        PG8_STAGE(PG8_SB(0, 0), cB, voffB); PG8_STAGE(PG8_SA(0, 0), cA, voffA); PG8_STAGE(PG8_SB(0, 1), cB + hstep, voffB); PG8_STAGE(PG8_SA(0, 1), cA + hstep, voffA);
        if (wr == 1) PG8_BAR;
        PG8_WAIT_V(4); PG8_BAR;
        PG8_STAGE(PG8_SB(1, 0), cB + kstep, voffB); PG8_STAGE(PG8_SA(1, 0), cA + kstep, voffA); PG8_STAGE(PG8_SB(1, 1), cB + hstep + kstep, voffB);
        PG8_WAIT_V(6); PG8_BAR;
    }
    for (;;) {
        const bool has_next = S.next(ui + 1, nxt);
        const char* nA = has_next ? (const char*)g.A + (size_t)nxt.lm * tstep : cA; const char* nB = has_next ? (const char*)g.Bt + (size_t)nxt.ln * tstep : cB;
        for (int t = 0; t < nt; t += 2) {
            const bool last = (t == nt - 2);
            const char* a1 = cA + (size_t)(t + 1) * kstep;
            const char* a2 = last ? nA : cA + (size_t)(t + 2) * kstep; const char* b2 = last ? nB : cB + (size_t)(t + 2) * kstep;
            const char* a3 = a2 + kstep; const char* b3 = b2 + kstep;
            if (last && has_next) S.a_ready(nxt);
            if constexpr (SP2) {
            PG8_LDB(B0, 0, 0); PG8_LDB(B1, 0, 1); PG8_SCHED; PG8_LDA(At, 0, 0); PG8_STAGE(PG8_SA(1, 1), a1 + hstep, voffA);
            PG8_WAIT_V(8); PG8_WAIT_L(0); PG8_BAR; PG8_MMA(0, 0, At, B0); PG8_MMA(0, 1, At, B1); PG8_BAR; PG8_SCHED;
            PG8_LDA(At, 0, 1); PG8_STAGE(PG8_SB(0, 0), b2, voffB); PG8_STAGE(PG8_SB(0, 1), b2 + hstep, voffB); PG8_STAGE(PG8_SA(0, 0), a2, voffA);
            PG8_WAIT_V(8); PG8_WAIT_L(0); PG8_BAR; PG8_MMA(1, 0, At, B0); PG8_MMA(1, 1, At, B1); PG8_BAR; PG8_SCHED;
            PG8_LDB(B0, 1, 0); PG8_LDB(B1, 1, 1); PG8_SCHED; PG8_LDA(At, 1, 0); PG8_STAGE(PG8_SA(0, 1), a2 + hstep, voffA);
            PG8_WAIT_V(8); PG8_WAIT_L(0); PG8_BAR; PG8_MMA(0, 0, At, B0); PG8_MMA(0, 1, At, B1); PG8_BAR; PG8_SCHED;
            PG8_LDA(At, 1, 1); PG8_STAGE(PG8_SB(1, 0), b3, voffB); PG8_STAGE(PG8_SB(1, 1), b3 + hstep, voffB); PG8_STAGE(PG8_SA(1, 0), a3, voffA);
            PG8_WAIT_V(8); PG8_WAIT_L(0); PG8_BAR; PG8_MMA(1, 0, At, B0); PG8_MMA(1, 1, At, B1); PG8_BAR; PG8_SCHED;
            } else {
            PG8_LDB(B0, 0, 0); PG8_SCHED; PG8_LDA(At, 0, 0); PG8_STAGE(PG8_SA(1, 1), a1 + hstep, voffA);
            PG8_WAIT_L(8); PG8_BAR; PG8_WAIT_L(0); PG8_MMA(0, 0, At, B0); PG8_BAR; PG8_SCHED;
            PG8_LDB(B1, 0, 1); PG8_STAGE(PG8_SB(0, 0), b2, voffB);
            PG8_BAR; PG8_WAIT_L(0); PG8_MMA(0, 1, At, B1); PG8_BAR;
            PG8_LDA(At, 0, 1); PG8_STAGE(PG8_SA(0, 0), a2, voffA);
            PG8_BAR; PG8_WAIT_L(0); PG8_MMA(1, 0, At, B0); PG8_BAR; PG8_SCHED;
            PG8_STAGE(PG8_SB(0, 1), b2 + hstep, voffB);
            PG8_WAIT_V(6); PG8_BAR; PG8_MMA(1, 1, At, B1); PG8_BAR;
            PG8_LDB(B0, 1, 0); PG8_SCHED; PG8_LDA(At, 1, 0); PG8_STAGE(PG8_SA(0, 1), a2 + hstep, voffA);
            PG8_WAIT_L(8); PG8_BAR; PG8_WAIT_L(0); PG8_MMA(0, 0, At, B0); PG8_BAR; PG8_SCHED;
            PG8_LDB(B1, 1, 1); PG8_STAGE(PG8_SB(1, 0), b3, voffB);
            PG8_BAR; PG8_WAIT_L(0); PG8_MMA(0, 1, At, B1); PG8_BAR;
            PG8_LDA(At, 1, 1); PG8_STAGE(PG8_SA(1, 0), a3, voffA);
            PG8_BAR; PG8_WAIT_L(0); PG8_MMA(1, 0, At, B0); PG8_BAR; PG8_SCHED;
            PG8_STAGE(PG8_SB(1, 1), b3 + hstep, voffB);
            PG8_WAIT_V(6); PG8_BAR; PG8_MMA(1, 1, At, B1); PG8_BAR;
            }
        }
        if constexpr (ALIGN_EPI) { if (wr == 0) PG8_BAR; }
        if constexpr (!Epi::AFTER_DRAIN) { E(acc, cur, wr, wc, fr, fq); if (S.epi2) E(acc, cur, wr, wc, fr, fq); S.done(cur); }
        if (!has_next) break;
#pragma unroll
        for (int a = 0; a < 2; ++a)
#pragma unroll
            for (int b = 0; b < 2; ++b)
#pragma unroll
                for (int m = 0; m < 4; ++m)
#pragma unroll
                    for (int n = 0; n < 2; ++n) acc[a][b][m][n] = (f32x4){0.f, 0.f, 0.f, 0.f};
        cur = nxt; cA = nA; cB = nB; ++ui;
        if constexpr (ALIGN_EPI) { if (wr == 1) PG8_BAR; }
    }
    PG8_WAIT_V(0);
    if constexpr (!ALIGN_EPI) { if (wr == 0) PG8_BAR; }
    PG8_BAR;
    if constexpr (Epi::AFTER_DRAIN) { E.fused(acc, cur, wr, wc, fr, fq, lds, wid, lane); S.done(cur); }
#undef PG8_SA
#undef PG8_SB
#undef PG8_STAGE
#undef PG8_LDA
#undef PG8_LDB
#undef PG8_MMA
#undef PG8_WAIT_V
#undef PG8_WAIT_L
#undef PG8_BAR
#undef PG8_SCHED
}
}
namespace fa {
#define FA_LAS __attribute__((address_space(3)))
typedef short bf16x8 __attribute__((ext_vector_type(8)));
typedef short s16x4 __attribute__((ext_vector_type(4)));
typedef short v4i16_t __attribute__((ext_vector_type(4)));
typedef float f32x16 __attribute__((ext_vector_type(16)));
typedef float f32x4 __attribute__((ext_vector_type(4)));
typedef unsigned u32x4 __attribute__((ext_vector_type(4)));
typedef float f32x2_t __attribute__((ext_vector_type(2))); typedef __bf16 bf16x2_t __attribute__((ext_vector_type(2)));
constexpr float THR = 8.f, TH_SKIP = 32.f;
constexpr int F_KBUF = 18432, F_AOFF = 8192, F_VOFF = 10240, F_WSF = 3 * F_KBUF, F_FLAG = F_WSF + 8 * 256, F_OST = F_FLAG + 256, F_LDS_BYTES = F_OST + 8 * 4096;
constexpr int S_KBUF = 16384, S_VOFF = 8192, S_WSF = 6 * S_KBUF, S_OST = S_WSF + 8 * 256, S_LDS_BYTES = S_OST + 8 * 4096;
struct Params { const bf16_t* Q; const bf16_t* K; const bf16_t* V; const bf16_t* G; bf16_t* O; const float* CUM; const float* sinks; const unsigned* KMAX; unsigned* ticket; const bf16_t* KAUG; };
__device__ __forceinline__ unsigned cvtpk(float lo, float hi) { f32x2_t v = {lo, hi}; bf16x2_t b = __builtin_convertvector(v, bf16x2_t); return __builtin_bit_cast(unsigned, b); }
__device__ __forceinline__ s16x4 vtr(FA_LAS unsigned char* p) { return __builtin_bit_cast(s16x4, __builtin_amdgcn_ds_read_tr16_b64_v4i16((FA_LAS v4i16_t*)p)); }
__device__ __forceinline__ float swap_max(float v) { auto rr = __builtin_amdgcn_permlane32_swap(__float_as_uint(v), __float_as_uint(v), false, false); return __builtin_fmaxf(__uint_as_float(rr[0]), __uint_as_float(rr[1])); }
__device__ __forceinline__ float swap_add(float v) { auto rr = __builtin_amdgcn_permlane32_swap(__float_as_uint(v), __float_as_uint(v), false, false); return __uint_as_float(rr[0]) + __uint_as_float(rr[1]); }
__device__ __forceinline__ void glds16(const void* gsrc, unsigned lds_dst) { unsigned keep;
    asm volatile("s_mov_b32 %0, m0\n\ts_mov_b32 m0, %2\n\ts_nop 0\n\tglobal_load_lds_dwordx4 %1, off\n\ts_mov_b32 m0, %0" : "=&s"(keep) : "v"(gsrc), "s"(lds_dst) : "memory"); }
#define FA_MFMA(a, b, c) __builtin_amdgcn_mfma_f32_32x32x16_bf16((a), (b), (c), 0, 0, 0)
#define FA_MX3(a, b, c) __builtin_fmaxf(__builtin_fmaxf((a), (b)), (c))
struct WaveSt { bf16x8 qr[4]; bf16x8 qa; f32x16 cinit, o0, o1; float cq, mhat, lsum, mrun; };

#define FA_SBAR() __builtin_amdgcn_sched_barrier(0)
#define FA_PIN(x) asm volatile("" : "+v"(x))
#define FA_LDK(p) (*(FA_LAS bf16x8*)(p))
#define FA_VF(l, h) ((bf16x8){l[0], l[1], l[2], l[3], h[0], h[1], h[2], h[3]})
#define FA_EX4(X, B) do { X[B] = __builtin_amdgcn_exp2f(X[B]); X[B + 1] = __builtin_amdgcn_exp2f(X[B + 1]); X[B + 2] = __builtin_amdgcn_exp2f(X[B + 2]); X[B + 3] = __builtin_amdgcn_exp2f(X[B + 3]); } while (0)
__device__ __forceinline__ void split3(float v, unsigned& h1, unsigned& h2, unsigned& h3) { const bf16_t a = f2bf(v); const float r1 = v - bf2f(a); const bf16_t b = f2bf(r1); const float r2 = r1 - bf2f(b); h1 = a; h2 = b; h3 = f2bf(r2); }
__device__ __forceinline__ void set_qa(WaveSt& w, int hi) {
    unsigned g1, g2, g3; split3(w.cq - w.mhat, g1, g2, g3);
    const u32x4 q = {hi == 0 ? 0x3F803F80u : 0u, hi == 0 ? (0x3F80u | (g1 << 16)) : 0u, hi == 0 ? (g2 | (g3 << 16)) : 0u, 0u};
    w.qa = __builtin_bit_cast(bf16x8, q);
}
template <int MODE, int AOFF, int VOFF, int HB>
__device__ __forceinline__ void half_step(FA_LAS unsigned char* bb, FA_LAS unsigned char* vprev, FA_LAS float* wsf, WaveSt& w, f32x16& C, f32x16& P, int k0, int t, int qlo, int lane, int r32, int hi) {
    constexpr int W = MODE == 0 ? 0x40000000 : 128;
    FA_LAS unsigned char* kp = bb + hi * 1024 + r32 * 16 + HB * 512; FA_LAS unsigned char* ap = bb + AOFF + r32 * 16 + HB * 512;
    FA_LAS unsigned char* vp = (HB == 0 ? vprev + 2048 : bb) + VOFF + ((lane >> 4) & 1) * 32 + (lane & 3) * 8 + (4 * hi + ((lane & 15) >> 2)) * 64;
    bf16x8 kf0 = FA_LDK(kp), kf1 = FA_LDK(kp + 2048), kf2, kf3, ka;
    s16x4 vl0, vh0, vl1, vh1, vl2, vh2, vl3, vh3; u32x4 pw0, pw1; float sacc;
    FA_SBAR();
    if (MODE == 0) C = FA_MFMA(kf0, w.qr[0], ((f32x16){0.f, 0.f, 0.f, 0.f, 0.f, 0.f, 0.f, 0.f, 0.f, 0.f, 0.f, 0.f, 0.f, 0.f, 0.f, 0.f})); else C = FA_MFMA(kf0, w.qr[0], w.cinit);
    kf2 = FA_LDK(kp + 4096);
    sacc = (P[0] + P[1]) + (P[2] + P[3]); pw0.x = cvtpk(P[0], P[1]); pw0.y = cvtpk(P[2], P[3]); FA_PIN(sacc); FA_PIN(pw0.x); FA_PIN(pw0.y);
    FA_SBAR();
    C = FA_MFMA(kf1, w.qr[1], C); kf3 = FA_LDK(kp + 6144);
    sacc += P[4]; sacc += P[5]; sacc += P[6]; sacc += P[7]; pw0.z = cvtpk(P[4], P[5]); pw0.w = cvtpk(P[6], P[7]); FA_PIN(sacc); FA_PIN(pw0.z); FA_PIN(pw0.w);
    FA_SBAR();
    C = FA_MFMA(kf2, w.qr[2], C); if (MODE == 0) ka = FA_LDK(ap);
    sacc += P[8]; sacc += P[9]; sacc += P[10]; sacc += P[11]; pw1.x = cvtpk(P[8], P[9]); pw1.y = cvtpk(P[10], P[11]); FA_PIN(sacc); FA_PIN(pw1.x); FA_PIN(pw1.y); vl0 = vtr(vp); vh0 = vtr(vp + 512);
    FA_SBAR();
    C = FA_MFMA(kf3, w.qr[3], C);
    sacc += P[12]; sacc += P[13]; sacc += P[14]; sacc += P[15]; pw1.z = cvtpk(P[12], P[13]); pw1.w = cvtpk(P[14], P[15]); FA_PIN(sacc); FA_PIN(pw1.z); FA_PIN(pw1.w); vl1 = vtr(vp + 4096); vh1 = vtr(vp + 4096 + 512);
    FA_SBAR();
    if (MODE == 0) { C = FA_MFMA(ka, w.qa, C); FA_SBAR(); }
    w.lsum += sacc;
    const bf16x8 pa0 = __builtin_bit_cast(bf16x8, pw0), pa1 = __builtin_bit_cast(bf16x8, pw1);
    vl2 = vtr(vp + 1024); vh2 = vtr(vp + 1024 + 512);
    w.o0 = FA_MFMA(pa0, FA_VF(vl0, vh0), w.o0); vl3 = vtr(vp + 4096 + 1024); vh3 = vtr(vp + 4096 + 1024 + 512);
    w.o1 = FA_MFMA(pa0, FA_VF(vl1, vh1), w.o1);
    FA_SBAR();
    const int kh = k0 + 32 * HB;
    if ((kh + 31 > qlo) || (MODE == 1 && kh <= qlo + 31 - W)) {
        const float NEG = -__builtin_inff(); const int dq = t - kh - 4 * hi;
#pragma unroll
        for (int r = 0; r < 16; ++r) { const int c = (r & 3) + 8 * (r >> 2); if ((unsigned)(dq - c) >= (unsigned)W) C[r] = NEG; }
    }
    float ma = FA_MX3(C[0], C[1], C[2]), mb = FA_MX3(C[3], C[4], C[5]);
    ma = FA_MX3(ma, C[6], C[7]); mb = FA_MX3(mb, C[8], C[9]); ma = FA_MX3(ma, C[10], C[11]); mb = FA_MX3(mb, C[12], C[13]); ma = FA_MX3(ma, C[14], C[15]);
    const float rm = swap_max(__builtin_fmaxf(ma, mb));
    if (MODE == 0) w.mrun = __builtin_fmaxf(w.mrun, rm + w.mhat);
    const bool resc = __any(rm > THR);
    if (resc) {
        const float dl = __builtin_fmaxf(rm, 0.f); w.mhat += dl;
#pragma unroll
        for (int r = 0; r < 16; ++r) C[r] -= dl;
        if (MODE == 0) set_qa(w, hi);
        else { const float ci = w.cq - w.mhat;
#pragma unroll
            for (int r = 0; r < 16; ++r) w.cinit[r] = ci; }
        const float f = __builtin_amdgcn_exp2f(-dl); w.lsum *= f;
        if (hi == 0) wsf[r32] = f;
    }
    FA_SBAR();
    FA_EX4(C, 0); FA_PIN(C);
    w.o0 = FA_MFMA(pa1, FA_VF(vl2, vh2), w.o0); FA_EX4(C, 4); FA_EX4(C, 8); FA_PIN(C); FA_SBAR();
    w.o1 = FA_MFMA(pa1, FA_VF(vl3, vh3), w.o1); FA_EX4(C, 12); FA_PIN(C); FA_SBAR();
    if (resc) {
        asm volatile("s_waitcnt lgkmcnt(0)" ::: "memory");
#pragma unroll
        for (int g = 0; g < 4; ++g) { const f32x4 a4 = *(FA_LAS f32x4*)(wsf + 8 * g + 4 * hi);
#pragma unroll
            for (int i = 0; i < 4; ++i) { w.o0[4 * g + i] *= a4[i]; w.o1[4 * g + i] *= a4[i]; } }
    }
}
template <int MODE, int AOFF, int VOFF>
__device__ __forceinline__ void tile_step(FA_LAS unsigned char* bb, FA_LAS unsigned char* vprev, FA_LAS float* wsf, WaveSt& w, f32x16& pA, f32x16& pB, int k0, int t, int qlo, int lane, int r32, int hi) {
    half_step<MODE, AOFF, VOFF, 0>(bb, vprev, wsf, w, pA, pB, k0, t, qlo, lane, r32, hi);
    half_step<MODE, AOFF, VOFF, 1>(bb, vprev, wsf, w, pB, pA, k0, t, qlo, lane, r32, hi);
}
template <int VOFF>
__device__ __forceinline__ void tile_drain(FA_LAS unsigned char* vlast, WaveSt& w, f32x16& P, int lane, int hi) {
    FA_LAS unsigned char* vp = vlast + 2048 + VOFF + ((lane >> 4) & 1) * 32 + (lane & 3) * 8 + (4 * hi + ((lane & 15) >> 2)) * 64;
    float s0 = 0.f;
#pragma unroll
    for (int r = 0; r < 16; ++r) s0 += P[r];
    w.lsum += s0;
    const u32x4 w0 = {cvtpk(P[0], P[1]), cvtpk(P[2], P[3]), cvtpk(P[4], P[5]), cvtpk(P[6], P[7])};
    const u32x4 w1 = {cvtpk(P[8], P[9]), cvtpk(P[10], P[11]), cvtpk(P[12], P[13]), cvtpk(P[14], P[15])};
    const bf16x8 pa0 = __builtin_bit_cast(bf16x8, w0), pa1 = __builtin_bit_cast(bf16x8, w1);
    { const s16x4 l0 = vtr(vp), h0 = vtr(vp + 512), l1 = vtr(vp + 4096), h1 = vtr(vp + 4096 + 512); w.o0 = FA_MFMA(pa0, FA_VF(l0, h0), w.o0); w.o1 = FA_MFMA(pa0, FA_VF(l1, h1), w.o1); }
    { const s16x4 l0 = vtr(vp + 1024), h0 = vtr(vp + 1024 + 512), l1 = vtr(vp + 4096 + 1024), h1 = vtr(vp + 4096 + 1024 + 512); w.o0 = FA_MFMA(pa1, FA_VF(l0, h0), w.o0); w.o1 = FA_MFMA(pa1, FA_VF(l1, h1), w.o1); }
}
__device__ __forceinline__ void load_gate(u32x4 (&gq)[4], const bf16_t* G, size_t grow, int h, int lane) {
#pragma unroll
    for (int d0 = 0; d0 < 2; ++d0)
#pragma unroll
        for (int i = 0; i < 2; ++i) gq[2 * d0 + i] = *(const u32x4*)(G + (grow + i * 16 + (lane >> 2)) * DM + h * 64 + d0 * 32 + (lane & 3) * 8);
}
__device__ __forceinline__ void wave_epilogue(FA_LAS float* stg, FA_LAS float* wsf, WaveSt& w, const u32x4 (&gq)[4], bf16_t* O, size_t grow, int h, int lane, int r32, int hi) {
    const float l = swap_add(w.lsum);
    if (hi == 0) wsf[r32] = l;
    asm volatile("s_waitcnt lgkmcnt(0)" ::: "memory");
    float rl[16];
#pragma unroll
    for (int g = 0; g < 4; ++g) { const f32x4 l4 = *(FA_LAS f32x4*)(wsf + 8 * g + 4 * hi);
#pragma unroll
        for (int i = 0; i < 4; ++i) rl[4 * g + i] = 1.0f / l4[i]; }
#pragma unroll
    for (int d0 = 0; d0 < 2; ++d0) {
#pragma unroll
        for (int g = 0; g < 4; ++g)
#pragma unroll
            for (int i = 0; i < 4; ++i) stg[(8 * g + 4 * hi + i) * 32 + r32] = (d0 == 0 ? w.o0[4 * g + i] : w.o1[4 * g + i]) * rl[4 * g + i];
        asm volatile("s_waitcnt lgkmcnt(0)" ::: "memory");
#pragma unroll
        for (int i = 0; i < 2; ++i) { const int row = i * 16 + (lane >> 2), ch = lane & 3;
            const f32x4 x0 = *(FA_LAS f32x4*)(stg + row * 32 + ch * 8), x1 = *(FA_LAS f32x4*)(stg + row * 32 + ch * 8 + 4);
            const size_t ga = (grow + row) * DM + h * 64 + d0 * 32 + ch * 8; const u32x4 gv = gq[2 * d0 + i];
            u32x4 ov;
            ov.x = cvtpk(x0[0] * __uint_as_float(gv.x << 16), x0[1] * __uint_as_float(gv.x & 0xffff0000u)); ov.y = cvtpk(x0[2] * __uint_as_float(gv.y << 16), x0[3] * __uint_as_float(gv.y & 0xffff0000u));
            ov.z = cvtpk(x1[0] * __uint_as_float(gv.z << 16), x1[1] * __uint_as_float(gv.z & 0xffff0000u)); ov.w = cvtpk(x1[2] * __uint_as_float(gv.w << 16), x1[3] * __uint_as_float(gv.w & 0xffff0000u));
            *(u32x4*)(O + tiled_off((int)(grow + row), h * 64 + d0 * 32 + ch * 8)) = ov; }
        asm volatile("s_waitcnt lgkmcnt(0)" ::: "memory");
    }
}
template <int MODE> __device__ __forceinline__ void wave_init(WaveSt& w, int hi) {
#pragma unroll
    for (int r = 0; r < 16; ++r) { w.o0[r] = 0.f; w.o1[r] = 0.f; }
    if (MODE == 0) set_qa(w, hi);
    else { const float ci = w.cq - w.mhat;
#pragma unroll
        for (int r = 0; r < 16; ++r) w.cinit[r] = ci; }
}

__device__ __forceinline__ void fox_unit(FA_LAS unsigned char* lds, const Params& P, int b, int h, int qb) {
    const int tid = threadIdx.x, lane = tid & 63, r32 = lane & 31, hi = lane >> 5;
    const int wid = __builtin_amdgcn_readfirstlane(tid >> 6);
    const int q0 = qb * 256, qlo = q0 + wid * 32, t = qlo + r32;
    const size_t rowbase = (size_t)b * SEQ;
    const bf16_t* ksrc = P.K + (rowbase + lane) * DM + h * 64 + wid * 8;
    const bf16_t* vsrc = P.V + (rowbase + 16 * (wid & 3) + (lane >> 2)) * DM + h * 64 + (wid >> 2) * 32 + (lane & 3) * 8;
    const float* cum = P.CUM + (size_t)(b * NH + h) * SEQ;
    const bf16_t* asrc = P.KAUG + ((size_t)(b * NH + h) * SEQ + lane) * 8;
    const int NT = (q0 + 256) / 64;
    WaveSt w; const bf16_t* Qw = P.Q + (rowbase + t) * DM + h * 64 + hi * 8; float qn = 0.f;
#pragma unroll
    for (int d0 = 0; d0 < 4; ++d0) { w.qr[d0] = *(const bf16x8*)(Qw + d0 * 16);
#pragma unroll
        for (int j = 0; j < 8; ++j) { const float qv = bf2f((bf16_t)w.qr[d0][j]); qn = fmaf(qv, qv, qn); } }
    w.cq = cum[t]; w.mhat = 0.f; w.lsum = 0.f; w.mrun = -1e30f;
    wave_init<0>(w, hi);
    u32x4 gq[4]; load_gate(gq, P.G, rowbase + qlo, h, lane);
    const float qkb = sqrtf(swap_add(qn) * __uint_as_float(P.KMAX[b * NH + h])) * 1.0001f + 1e-3f;
    FA_LAS float* wsf = (FA_LAS float*)(lds + F_WSF) + wid * 64;
    FA_LAS unsigned* votes = (FA_LAS unsigned*)(lds + F_FLAG);
    float cnew = 0.f;
#define FA_LOADT(j, bf) do { const size_t ko_ = (size_t)(j) * 64 * DM; FA_LAS unsigned char* bb_ = lds + (bf) * F_KBUF; \
        glds16(ksrc + ko_, (unsigned)__builtin_amdgcn_readfirstlane((int)(unsigned)(uintptr_t)(bb_ + wid * 1024))); \
        glds16(vsrc + ko_, (unsigned)__builtin_amdgcn_readfirstlane((int)(unsigned)(uintptr_t)(bb_ + F_VOFF + (wid >> 2) * 4096 + (wid & 3) * 1024))); \
        if (wid == 0) glds16(asrc + (size_t)(j) * 64 * 8, (unsigned)__builtin_amdgcn_readfirstlane((int)(unsigned)(uintptr_t)(bb_ + F_AOFF))); \
        cnew = cum[(j) * 64 + 63]; } while (0)
    FA_LOADT(NT - 1, 0); asm volatile("s_waitcnt vmcnt(0)" ::: "memory"); __syncthreads();
    bool wdone = false, pend = false; f32x16 pA, pB;
#pragma unroll
    for (int r = 0; r < 16; ++r) pB[r] = 0.f;
    int cur = 0;
    for (int tt = 0; tt < NT; ++tt) {
        const int j = NT - 1 - tt, k0 = j * 64; const int nxt = cur == 2 ? 0 : cur + 1, prv = cur == 0 ? 2 : cur - 1;
        if (j > 0) FA_LOADT(j - 1, nxt);
        if (!wdone && k0 <= qlo + 31) {
            FA_LAS unsigned char* bb = lds + cur * F_KBUF;
            tile_step<0, F_AOFF, F_VOFF>(bb, pend ? lds + prv * F_KBUF : bb, wsf, w, pA, pB, k0, t, qlo, lane, r32, hi);
            pend = true;
        }
        if (j > 0) {
            if (!wdone && pend && __all(qkb + w.cq - cnew - w.mrun <= -TH_SKIP)) {
                wdone = true; tile_drain<F_VOFF>(lds + cur * F_KBUF, w, pB, lane, hi);
            }
            if (lane == 0) votes[(tt & 1) * 8 + wid] = wdone ? 1u : 0u;
        }
        asm volatile("s_waitcnt vmcnt(0)" ::: "memory");
        __syncthreads();
        if (j > 0) { const u32x4 v0 = *(FA_LAS u32x4*)(votes + (tt & 1) * 8), v1 = *(FA_LAS u32x4*)(votes + (tt & 1) * 8 + 4);
            if ((v0.x & v0.y & v0.z & v0.w & v1.x & v1.y & v1.z & v1.w) != 0u) break; }
        else if (!wdone) tile_drain<F_VOFF>(lds + cur * F_KBUF, w, pB, lane, hi);
        cur = nxt;
    }
#undef FA_LOADT
    wave_epilogue((FA_LAS float*)(lds + F_OST + wid * 4096), wsf, w, gq, P.O, rowbase + qlo, h, lane, r32, hi);
    __syncthreads();
}
__device__ __forceinline__ void swa_unit(FA_LAS unsigned char* lds, const Params& P, int b, int kvh, int qb) {
    const int tid = threadIdx.x, lane = tid & 63, r32 = lane & 31, hi = lane >> 5;
    const int wid = __builtin_amdgcn_readfirstlane(tid >> 6);
    const int q0 = qb * 256, qlo = q0 + wid * 32, t = qlo + r32;
    const size_t rowbase = (size_t)b * SEQ;
    const int j_lo = q0 >= 128 ? (q0 - 128) / 64 : 0, NT = (q0 + 256) / 64 - j_lo;
    const bf16_t* ksrc = P.K + (rowbase + j_lo * 64 + lane) * KVW + kvh * 64 + wid * 8;
    const bf16_t* vsrc = P.V + (rowbase + j_lo * 64 + 16 * (wid & 3) + (lane >> 2)) * KVW + kvh * 64 + (wid >> 2) * 32 + (lane & 3) * 8;
    const int kdst = wid * 1024 + lane * 16, vdst = S_VOFF + (wid >> 2) * 4096 + (wid & 3) * 1024 + lane * 16;
    { u32x4 sk[6], sv[6];
#pragma unroll
      for (int i = 0; i < 6; ++i) if (i < NT) { sk[i] = *(const u32x4*)(ksrc + (size_t)i * 64 * KVW); sv[i] = *(const u32x4*)(vsrc + (size_t)i * 64 * KVW); }
#pragma unroll
      for (int i = 0; i < 6; ++i) if (i < NT) { *(FA_LAS u32x4*)(lds + i * S_KBUF + kdst) = sk[i]; *(FA_LAS u32x4*)(lds + i * S_KBUF + vdst) = sv[i]; } }
    __syncthreads();
    FA_LAS float* wsf = (FA_LAS float*)(lds + S_WSF) + wid * 64;
    const int ta = (qlo >= 127 ? (qlo - 127) / 64 : 0) - j_lo, tb = (qlo + 31) / 64 - j_lo;
    bf16x8 qn[4]; { const bf16_t* Qw = P.Q + (rowbase + t) * DM + (kvh * 8) * 64 + hi * 8;
#pragma unroll
      for (int d0 = 0; d0 < 4; ++d0) qn[d0] = *(const bf16x8*)(Qw + d0 * 16); }
    for (int hh = 0; hh < 8; ++hh) {
        const int h = kvh * 8 + hh;
        WaveSt w;
#pragma unroll
        for (int d0 = 0; d0 < 4; ++d0) w.qr[d0] = qn[d0];
        { const bf16_t* Qw = P.Q + (rowbase + t) * DM + (kvh * 8 + (hh < 7 ? hh + 1 : hh)) * 64 + hi * 8;
#pragma unroll
          for (int d0 = 0; d0 < 4; ++d0) qn[d0] = *(const bf16x8*)(Qw + d0 * 16); }
        u32x4 gq[4]; load_gate(gq, P.G, rowbase + qlo, h, lane);
        w.cq = 0.f; w.mhat = P.sinks[h] * LOG2E; w.lsum = 0.5f; w.mrun = 0.f;
        wave_init<1>(w, hi);
        f32x16 pA, pB;
#pragma unroll
        for (int r = 0; r < 16; ++r) pB[r] = 0.f;
        for (int ti = tb; ti >= ta; --ti) { FA_LAS unsigned char* bb = lds + ti * S_KBUF;
            tile_step<1, 0, S_VOFF>(bb, ti == tb ? bb : bb + S_KBUF, wsf, w, pA, pB, (j_lo + ti) * 64, t, qlo, lane, r32, hi); }
        tile_drain<S_VOFF>(lds + ta * S_KBUF, w, pB, lane, hi);
        wave_epilogue((FA_LAS float*)(lds + S_OST + wid * 4096), wsf, w, gq, P.O, rowbase + qlo, h, lane, r32, hi);
    }
    __syncthreads();
}
}
#define GAS __attribute__((address_space(1)))
#define LAS __attribute__((address_space(3)))
typedef unsigned short bf16;
typedef unsigned v4u __attribute__((ext_vector_type(4)));
typedef float f32x4 __attribute__((ext_vector_type(4)));
typedef short bf16x8 __attribute__((ext_vector_type(8)));
typedef GAS unsigned gu32;
typedef GAS unsigned long long gu64;
#define RLX_AGENT __ATOMIC_RELAXED, __HIP_MEMORY_SCOPE_AGENT
#define LDS_WAIT() asm volatile("s_waitcnt lgkmcnt(0)" ::: "memory")
#define VM_WAIT() asm volatile("s_waitcnt vmcnt(0)" ::: "memory")
__device__ __forceinline__ unsigned long long rt() { return __builtin_amdgcn_s_memrealtime(); }
__device__ __forceinline__ unsigned pk2(float lo, float hi) { return (unsigned)f2bf(lo) | ((unsigned)f2bf(hi) << 16); }
#define XB_TMO      128
#define XB_XCNT(j)  (256  + 64 * (j))
#define XB_XSUB(j)  (1280 + 64 * (j))
#define XB_XGEN(j)  (2304 + 64 * (j))
#define XB_TOP      3328
#define XB_TOPGEN   3392
#define XCD_BAR_WORDS 3456
#define XB_SPIN_CAP (1u << 18)

__device__ __forceinline__ unsigned xb_ld(unsigned* p)              { return __hip_atomic_load(p, __ATOMIC_RELAXED, __HIP_MEMORY_SCOPE_AGENT); }
__device__ __forceinline__ unsigned xb_add(unsigned* p, unsigned v) { return __hip_atomic_fetch_add(p, v, __ATOMIC_RELAXED, __HIP_MEMORY_SCOPE_AGENT); }
__device__ __forceinline__ unsigned xb_xcc_id() { return (unsigned)__builtin_amdgcn_s_getreg((3 << 11) | 20) & 0xFu; }
#define XB_SPIN(cond, bar) do { unsigned _sp = 0; while (cond) { __builtin_amdgcn_s_sleep(1); \
    if ((++_sp & 255u) == 0u) { if (xb_ld(&(bar)[XB_TMO])) break; if (_sp > XB_SPIN_CAP) { atomicAdd(&(bar)[XB_TMO], 1u); break; } } } } while (0)

struct XcdBarrier {
    unsigned* bar; unsigned x;
    volatile LAS unsigned* st;
};

__device__ __forceinline__ XcdBarrier xcd_barrier_post(unsigned* bar, volatile LAS unsigned* st) {
    XcdBarrier b; b.bar = bar; b.x = xb_xcc_id(); b.st = st;
    if (threadIdx.x == 0) (void)xb_add(&bar[XB_XCNT(b.x)], 1u);
    return b;
}
__device__ __forceinline__ void xcd_barrier_complete(unsigned* bar, unsigned x, unsigned& nloc, unsigned& nx) {
    const unsigned G = gridDim.x * gridDim.y * gridDim.z;
    unsigned sum, cnt, mine, sp = 0u;
    for (;;) {
        sum = 0u; cnt = 0u; mine = 0u;
#pragma unroll
        for (unsigned j = 0; j < 16; ++j) { const unsigned c = xb_ld(&bar[XB_XCNT(j)]); sum += c; cnt += (c > 0u) ? 1u : 0u; mine = (j == x) ? c : mine; }
        if (sum == G) break;
        __builtin_amdgcn_s_sleep(1);
        if ((++sp & 255u) == 0u) { if (xb_ld(&bar[XB_TMO])) break; if (sp > XB_SPIN_CAP) { atomicAdd(&bar[XB_TMO], 1u); break; } }
    }
    nloc = mine > 0u ? mine : 1u; nx = cnt > 0u ? cnt : 1u;
}

__device__ __forceinline__ void xcd_barrier(const XcdBarrier& b) {
    asm volatile("s_waitcnt vmcnt(0)" ::: "memory");
    __syncthreads();
    if (threadIdx.x == 0) {
        unsigned* bar = b.bar;
        __builtin_amdgcn_s_waitcnt(0);
        unsigned nloc = b.st[0], nx = b.st[1];
        if (nloc == 0u) { xcd_barrier_complete(bar, b.x, nloc, nx); b.st[0] = nloc; b.st[1] = nx; }
        const unsigned old = xb_add(&bar[XB_XSUB(b.x)], 1u);
        const unsigned gen = old / nloc;
        if (old + 1u == (gen + 1u) * nloc) {
            __builtin_amdgcn_fence(__ATOMIC_RELEASE, "agent");
            asm volatile("s_waitcnt vmcnt(0)" ::: "memory");
            const unsigned og = xb_add(&bar[XB_TOP], 1u);
            const unsigned tg = og / nx;
            if (og + 1u == (tg + 1u) * nx) xb_add(&bar[XB_TOPGEN], 1u);
            else XB_SPIN(xb_ld(&bar[XB_TOPGEN]) == tg, bar);
            __builtin_amdgcn_fence(__ATOMIC_ACQUIRE, "agent");
            xb_add(&bar[XB_XGEN(b.x)], 1u);
            asm volatile("s_waitcnt vmcnt(0)" ::: "memory");
        } else {
            XB_SPIN(xb_ld(&bar[XB_XGEN(b.x)]) == gen, bar);
            __builtin_amdgcn_fence(__ATOMIC_ACQUIRE, "agent");
            asm volatile("s_waitcnt vmcnt(0)" ::: "memory");
        }
    }
    __syncthreads();
}
constexpr int NWAVES = 8;
constexpr int N1P = 8448;
constexpr int RING_OFF = 0, RING_BYTES = 135168;
constexpr int LDSCTL_OFF = RING_BYTES, MISC_OFF = LDSCTL_OFF + 320;
constexpr int LDS_BYTES = 147456;
constexpr int CW_BAR = 4096;
static_assert(fa::F_LDS_BYTES <= RING_BYTES && fa::S_LDS_BYTES <= RING_BYTES && pg8::STAGE_BYTES <= RING_BYTES && MISC_OFF + 128 <= LDS_BYTES && (CW_BAR + XCD_BAR_WORDS) * 4 <= (int)WS_KMAX, "LDS / CTL map");

__device__ __forceinline__ void p0_transpose_item(const float* W, int K, int N, bf16* WT, LAS float* scr, int item, int lane, const float* gs) {
    const int nblk = N / 32, kb = item / nblk, nb = item % nblk, k0 = 64 * kb, n0 = 32 * nb;
    const int kr = lane >> 3, nc = 4 * (lane & 7);
    f32x4 wv[8];
#pragma unroll
    for (int i = 0; i < 8; ++i) wv[i] = *(const GAS f32x4*)(W + (size_t)(k0 + 8 * i + kr) * N + n0 + nc);
#pragma unroll
    for (int i = 0; i < 8; ++i) { const int kk = 8 * i + kr; f32x4 w = wv[i]; if (gs) w = w * gs[k0 + kk]; LAS float* d = scr + kk * 33 + nc; d[0] = w.x; d[1] = w.y; d[2] = w.z; d[3] = w.w; }
    LDS_WAIT(); asm volatile("" ::: "memory");
    const int c = lane & 7;
#pragma unroll
    for (int j = 0; j < 4; ++j) { const int n = (lane >> 3) + 8 * j; const LAS float* sp = scr + (8 * c) * 33 + n;
        v4u o; o.x = pk2(sp[0 * 33], sp[1 * 33]); o.y = pk2(sp[2 * 33], sp[3 * 33]); o.z = pk2(sp[4 * 33], sp[5 * 33]); o.w = pk2(sp[6 * 33], sp[7 * 33]);
        *(GAS v4u*)(WT + tiled_off(n0 + n, k0 + 8 * c)) = o; }
    LDS_WAIT(); asm volatile("" ::: "memory");
}
__device__ __forceinline__ float wave_sum(float v) {
#pragma unroll
    for (int o = 1; o < 64; o <<= 1) v += __shfl_xor(v, o);
    return v;
}

struct Args { const float* in[9]; float* out; unsigned char* ws; int ph_lo, ph_hi; };
constexpr int N_PHASES = 9;
__global__ void __launch_bounds__(NWAVES * 64, 2) mega_fwd(Args args) {
    extern __shared__ __attribute__((aligned(16))) unsigned char lds_raw[];
    LAS unsigned char* lds = (LAS unsigned char*)lds_raw;
    volatile LAS unsigned* MISC = (volatile LAS unsigned*)(lds + MISC_OFF);
    const int tid = threadIdx.x, lane = tid & 63, wave = __builtin_amdgcn_readfirstlane(tid >> 6);
    const int G = gridDim.x, bx = blockIdx.x, vcu = (G % 8 == 0) ? (bx % 8) * (G / 8) + bx / 8 : bx;
    unsigned char* ws = args.ws;
    const float* x = args.in[0]; const float* norm_g = args.in[1]; const float* fox_w_in = args.in[2]; const float* fox_b_f = args.in[3]; const float* fox_w_out = args.in[4];
    const float* swa_w_in = args.in[5]; const float* swa_sinks = args.in[6]; const float* swa_w_out = args.in[7]; const float* final_g = args.in[8];
    float* out = args.out;
    gu32* ctl = (gu32*)(ws + WS_CTL);
    unsigned* KMAX = (unsigned*)(ws + WS_KMAX); unsigned* TICKET = (unsigned*)(ws + WS_TICKET);
    float* SS1 = (float*)(ws + WS_SS1); float* R0 = (float*)(ws + WS_R0); float* ROPE = (float*)(ws + WS_ROPE); float* LOGF = (float*)(ws + WS_LOGF); float* CUM = (float*)(ws + WS_CUM);
    bf16* W1T = (bf16*)(ws + WS_W1T); bf16* W2T = (bf16*)(ws + WS_W2T); bf16* W3T = (bf16*)(ws + WS_W3T); bf16* W4T = (bf16*)(ws + WS_W4T);
    bf16* KAUG = (bf16*)(ws + WS_KAUG);
    bf16* XB = (bf16*)(ws + WS_XB); bf16* Qb = (bf16*)(ws + WS_Q); bf16* Kb = (bf16*)(ws + WS_K); bf16* Vb = (bf16*)(ws + WS_V); bf16* Gb = (bf16*)(ws + WS_G); bf16* YG = (bf16*)(ws + WS_YG);
    for (int u = tid; u < (LDS_BYTES - LDSCTL_OFF) / 4; u += NWAVES * 64) ((LAS unsigned*)(lds + LDSCTL_OFF))[u] = 0u;
    __syncthreads();
    const int lo = args.ph_lo, hi = args.ph_hi;
    XcdBarrier bar; bar.bar = (unsigned*)(ctl + CW_BAR); bar.x = 0; bar.st = nullptr;
    if (hi - lo > 1) bar = xcd_barrier_post((unsigned*)(ctl + CW_BAR), MISC + 8);
#define IN(k) (lo <= (k) && (k) < hi)
#define REP(k) for (int rep_ = 0; rep_ < (((DUP_MASK >> (k)) & 1) ? 2 : 1); ++rep_)
#define SEAM(k) do { if (IN(k) && IN((k) + 1)) xcd_barrier(bar); } while (0)
    const int gw = vcu * NWAVES + wave, NGW = G * NWAVES;

    if (IN(0)) REP(0) {
        LAS float* scr = (LAS float*)(lds + RING_OFF + wave * 16384);
        constexpr int I1 = (DM / 64) * (FOX_IN / 32), IZ = N1P - FOX_IN;
        constexpr int NITEMS = I1 + IZ;
        for (int it = gw; it < NITEMS; it += NGW) {
            int r = it;
            if (r < I1) { p0_transpose_item(fox_w_in, DM, FOX_IN, W1T, scr, r, lane, norm_g); continue; } r -= I1;
            { GAS v4u* zp = (GAS v4u*)(W1T + tiled_off(FOX_IN + r, (lane >> 1) * 64 + (lane & 1) * 32));
#pragma unroll
              for (int j = 0; j < 4; ++j) zp[j] = (v4u){0u, 0u, 0u, 0u}; }
        }
        for (int m = gw; m < MTOK; m += 2 * NGW) {
            const int m2 = m + NGW < MTOK ? m + NGW : m;
            const GAS f32x4* xr = (const GAS f32x4*)(x + (size_t)m * DM) + lane; const GAS f32x4* xr2 = (const GAS f32x4*)(x + (size_t)m2 * DM) + lane; f32x4 v[8], v2[8]; float s = 0.f, s2 = 0.f;
#pragma unroll
            for (int j = 0; j < 8; ++j) { v[j] = xr[64 * j]; v2[j] = xr2[64 * j]; }
#pragma unroll
            for (int j = 0; j < 8; ++j) { s += (v[j].x * v[j].x + v[j].y * v[j].y) + (v[j].z * v[j].z + v[j].w * v[j].w); s2 += (v2[j].x * v2[j].x + v2[j].y * v2[j].y) + (v2[j].z * v2[j].z + v2[j].w * v2[j].w); }
            s = wave_sum(s); s2 = wave_sum(s2);
            if (lane == 0) { R0[m] = 1.0f / sqrtf(s * (1.f / DM) + RMS_EPS); R0[m2] = 1.0f / sqrtf(s2 * (1.f / DM) + RMS_EPS); }
#pragma unroll
            for (int j = 0; j < 8; ++j) { *(GAS unsigned long long*)(XB + tiled_off(m, 256 * j + 4 * lane)) = (unsigned long long)pk2(v[j].x, v[j].y) | ((unsigned long long)pk2(v[j].z, v[j].w) << 32);
                                          *(GAS unsigned long long*)(XB + tiled_off(m2, 256 * j + 4 * lane)) = (unsigned long long)pk2(v2[j].x, v2[j].y) | ((unsigned long long)pk2(v2[j].z, v2[j].w) << 32); }
        }
        { const int gt = gw * 64 + lane;
          if (gt < SEQ * 8) { const int pos = gt >> 3, i = gt & 7;
              const double invf[8] = {1.0, 0.19390220519133497, 0.037598065178462524, 0.0072903477503833845, 0.0014142135623730951, 0.00027421912901204056, 5.3171693730649086e-05, 1.0310108130908796e-05};
              double inv = invf[0];
#pragma unroll
              for (int k = 1; k < 8; ++k) inv = (i == k) ? invf[k] : inv;
              const double ang = (double)pos * inv; const double kk = __builtin_rint(ang * 0.15915494309189535); const float red = (float)(ang - kk * 6.283185307179586);
              ROPE[(size_t)pos * 16 + i] = cosf(red); ROPE[(size_t)pos * 16 + 8 + i] = sinf(red); } }
    }
    SEAM(0);
    if (IN(1)) {
        pg8::Gemm g{XB, W1T, MTOK, N1P, DM}; pg8::StaticOrder S; S.init(MTOK, N1P, G, bx, (DUP_MASK >> 1) & 1, (DUP_MASK >> 9) & 1);
        pg8::EpiFoxIn E{Qb, Kb, Vb, Gb, LOGF, R0, fox_b_f};
        if ((DUP_MASK >> 10) & 1) { pg8::StaticOrder SP; SP.init(MTOK, N1P, G, bx, 0, 0, 1); pg8::gemm_phase<pg8::EpiFoxIn, pg8::StaticOrder, true, true>(lds + RING_OFF, g, SP, E); }
        pg8::gemm_phase<pg8::EpiFoxIn, pg8::StaticOrder, true, true>(lds + RING_OFF, g, S, E);
        { const int nwg = (MTOK / 256) * (N1P / 256), rem = nwg % G, nidle = rem ? G - rem : G, ii = rem ? bx - rem : bx;
          if (ii >= 0) { LAS float* scr = (LAS float*)(lds + RING_OFF + wave * 16384);
              constexpr int I2 = (DM / 64) * (DM / 32), I3 = (DM / 64) * (SWA_IN / 32);
              for (int it = ii * NWAVES + wave; it < I2 + I3 + I2; it += nidle * NWAVES) {
                  int r = it;
                  if (r < I2) { p0_transpose_item(fox_w_out, DM, DM, W2T, scr, r, lane, nullptr); continue; } r -= I2;
                  if (r < I3) { p0_transpose_item(swa_w_in, DM, SWA_IN, W3T, scr, r, lane, norm_g + DM); continue; } r -= I3;
                  p0_transpose_item(swa_w_out, DM, DM, W4T, scr, r, lane, nullptr); } } }
    }
    SEAM(1);
    if (IN(2)) REP(2) {
        for (int sq = vcu; sq < NB * NH; sq += G) {
            const GAS f32x4* lf = (const GAS f32x4*)(LOGF + (size_t)sq * SEQ + wave * 512) + lane * 2; const f32x4 v0 = lf[0], v1 = lf[1];
            const double tot = (((double)v0.x + (double)v0.y) + ((double)v0.z + (double)v0.w)) + (((double)v1.x + (double)v1.y) + ((double)v1.z + (double)v1.w));
            double incl = tot;
#pragma unroll
            for (int o = 1; o < 64; o <<= 1) { const double up = __shfl_up(incl, o); if (lane >= o) incl += up; }
            volatile LAS double* wt = (volatile LAS double*)(lds + RING_OFF);
            __syncthreads();
            if (lane == 63) wt[wave] = incl;
            __syncthreads();
            double run = incl - tot;
            for (int w2 = 0; w2 < wave; ++w2) run += wt[w2];
            const float vv[8] = {v0.x, v0.y, v0.z, v0.w, v1.x, v1.y, v1.z, v1.w}; float cv[8];
#pragma unroll
            for (int e = 0; e < 8; ++e) { run += (double)vv[e]; cv[e] = (float)(run * 1.4426950408889634); }
            GAS f32x4* co = (GAS f32x4*)(CUM + (size_t)sq * SEQ + wave * 512) + lane * 2; co[0] = (f32x4){cv[0], cv[1], cv[2], cv[3]}; co[1] = (f32x4){cv[4], cv[5], cv[6], cv[7]};
            GAS v4u* ka = (GAS v4u*)(KAUG + ((size_t)sq * SEQ + wave * 512 + lane * 8) * 8);
#pragma unroll
            for (int e = 0; e < 8; ++e) { unsigned h1, h2, h3; fa::split3(-cv[e], h1, h2, h3); ka[e] = (v4u){h1 | (h2 << 16), h3 | 0x3F800000u, 0x3F803F80u, 0u}; }
        }
        for (int base = 8 * gw; base < MTOK; base += 8 * NGW) {
            float mx[4] = {0.f, 0.f, 0.f, 0.f};
            for (int rr = 0; rr < 8; ++rr) {
#pragma unroll
                for (int j = 0; j < 4; ++j) { const v4u kv = *(const GAS v4u*)(Kb + (size_t)(base + rr) * DM + (lane + 64 * j) * 8); float ss = 0.f;
                    const unsigned wv[4] = {kv.x, kv.y, kv.z, kv.w};
#pragma unroll
                    for (int e = 0; e < 4; ++e) { const float a = __uint_as_float(wv[e] << 16), c = __uint_as_float(wv[e] & 0xffff0000u); ss = fmaf(a, a, ss); ss = fmaf(c, c, ss); }
                    ss += __shfl_xor(ss, 1); ss += __shfl_xor(ss, 2); ss += __shfl_xor(ss, 4); mx[j] = fmaxf(mx[j], ss); } }
            if ((lane & 7) == 0) {
#pragma unroll
                for (int j = 0; j < 4; ++j) atomicMax(KMAX + (base >> 12) * NH + (lane >> 3) + 8 * j, __float_as_uint(mx[j])); }
        }
    }
    SEAM(2);
    if (IN(3)) {
        const fa::Params P{Qb, Kb, Vb, Gb, YG, CUM, nullptr, KMAX, TICKET, KAUG};
        volatile LAS unsigned* slot = (volatile LAS unsigned*)(lds + RING_OFF + fa::F_FLAG + 128);
        if (tid == 0) slot[0] = atomicAdd(TICKET, 1u);
        __syncthreads();
        unsigned tk = slot[0]; int par = 0;
        while (tk < ((unsigned)(NB * NH * 16) << ((DUP_MASK >> 3) & 1))) {
            if (tid == 0) slot[par ^ 1] = atomicAdd(TICKET, 1u);
            const unsigned u = tk & (unsigned)(NB * NH * 16 - 1);
            const int bh = u & 127, qb = 15 - (int)(u >> 7);
            fa::fox_unit(lds + RING_OFF, P, bh >> 5, bh & 31, qb);
            par ^= 1; tk = slot[par];
        }
        __syncthreads();
    }
    SEAM(3);
    if (IN(4)) {
        pg8::Gemm g{YG, W2T, MTOK, DM, DM}; pg8::StaticOrder S; S.init(MTOK, DM, G, bx);
        pg8::EpiRes<true> E{x, XB, SS1};
        pg8::gemm_phase<pg8::EpiRes<true>, pg8::StaticOrder, true, true>(lds + RING_OFF, g, S, E);
    }
    SEAM(4);
    if (IN(5)) {
        pg8::Gemm g{XB, W3T, MTOK, SWA_IN, DM}; pg8::StaticOrder S; S.init(MTOK, SWA_IN, G, bx, (DUP_MASK >> 5) & 1);
        pg8::EpiSwaIn E{Qb, Kb, Vb, Gb, SS1, ROPE};
        pg8::gemm_phase<pg8::EpiSwaIn, pg8::StaticOrder, true, true>(lds + RING_OFF, g, S, E);
    }
    SEAM(5);
    if (IN(6)) REP(6) {
        const fa::Params P{Qb, Kb, Vb, Gb, YG, nullptr, swa_sinks, nullptr, nullptr, nullptr};
        for (int u = (G == 256 ? vcu : bx); u < NB * 4 * 16; u += G) fa::swa_unit(lds + RING_OFF, P, u >> 6, (u >> 4) & 3, u & 15);
    }
    SEAM(6);
    if (IN(7)) {
        pg8::Gemm g{YG, W4T, MTOK, DM, DM}; pg8::StaticOrder S; S.init(MTOK, DM, G, bx);
        pg8::EpiRes<false> E{nullptr, XB, nullptr};
        pg8::gemm_phase<pg8::EpiRes<false>, pg8::StaticOrder, true, true>(lds + RING_OFF, g, S, E);
    }
    SEAM(7);
    if (IN(8)) {
        f32x4 gq[8];
#pragma unroll
        for (int j = 0; j < 8; ++j) gq[j] = ((const GAS f32x4*)final_g)[lane + 64 * j];
        for (int m = gw; m < MTOK; m += NGW) {
            f32x4 v[8]; float s = 0.f;
#pragma unroll
            for (int j = 0; j < 8; ++j) { const unsigned long long xw = *(const GAS unsigned long long*)(XB + tiled_off(m, 256 * j + 4 * lane)); const unsigned lo32 = (unsigned)xw, hi32 = (unsigned)(xw >> 32);
                v[j] = (f32x4){__uint_as_float(lo32 << 16), __uint_as_float(lo32 & 0xffff0000u), __uint_as_float(hi32 << 16), __uint_as_float(hi32 & 0xffff0000u)};
                s += (v[j].x * v[j].x + v[j].y * v[j].y) + (v[j].z * v[j].z + v[j].w * v[j].w); }
            const float r = 1.0f / sqrtf(wave_sum(s) * (1.f / DM) + RMS_EPS);
            GAS f32x4* xr = (GAS f32x4*)(out + (size_t)m * DM) + lane;
#pragma unroll
            for (int j = 0; j < 8; ++j) xr[64 * j] = v[j] * r * gq[j];
        }
    }
#undef IN
#undef SEAM
}

extern "C" void kernel_launch(void* const* d_in, const int* in_sizes, int n_in, void* d_out, int out_size, void* d_ws, size_t ws_size, hipStream_t stream) {
    static int grid = 0;
    if (grid == 0) {
        if (n_in != 9 || in_sizes[0] != MTOK * DM || out_size != MTOK * DM || ws_size < WS_END) { fprintf(stderr, "kernel_launch: unexpected shapes (n_in %d, in0 %d, out %d, ws %zu)\n", n_in, n_in > 0 ? in_sizes[0] : -1, out_size, ws_size); grid = -1; return; }
        int dev = 0, cus = 0, per_cu = 0;
        if (hipGetDevice(&dev) != hipSuccess || hipDeviceGetAttribute(&cus, hipDeviceAttributeMultiprocessorCount, dev) != hipSuccess) { fprintf(stderr, "kernel_launch: device query failed\n"); grid = -1; return; }
        if (hipFuncSetAttribute((const void*)mega_fwd, hipFuncAttributeMaxDynamicSharedMemorySize, LDS_BYTES) != hipSuccess) { fprintf(stderr, "kernel_launch: hipFuncSetAttribute failed\n"); grid = -1; return; }
        if (hipOccupancyMaxActiveBlocksPerMultiprocessor(&per_cu, (const void*)mega_fwd, NWAVES * 64, LDS_BYTES) != hipSuccess || per_cu < 1) { fprintf(stderr, "kernel_launch: occupancy query reports %d workgroups per CU; nothing launched\n", per_cu); (void)hipGetLastError(); grid = -1; return; }
        grid = cus;
    }
    if (grid < 0) return;
    const float* x = (const float*)d_in[0]; const float* norm_g = (const float*)d_in[1]; const float* fox_w_in = (const float*)d_in[2]; const float* fox_b_f = (const float*)d_in[3];
    const float* fox_w_out = (const float*)d_in[4]; const float* swa_w_in = (const float*)d_in[5]; const float* swa_sinks = (const float*)d_in[6]; const float* swa_w_out = (const float*)d_in[7];
    const float* final_g = (const float*)d_in[8];
    float* out = (float*)d_out; unsigned char* ws = (unsigned char*)d_ws;
    float* SS1 = (float*)(ws + WS_SS1); float* R0 = (float*)(ws + WS_R0); float* LOGF = (float*)(ws + WS_LOGF); float* CUM = (float*)(ws + WS_CUM);
    bf16_t* XB = (bf16_t*)(ws + WS_XB); bf16_t* Q = (bf16_t*)(ws + WS_Q); bf16_t* K = (bf16_t*)(ws + WS_K); bf16_t* V = (bf16_t*)(ws + WS_V); bf16_t* Gt = (bf16_t*)(ws + WS_G); bf16_t* YG = (bf16_t*)(ws + WS_YG);
    (void)hipMemsetAsync(ws + WS_CTL, 0, CTL_ZERO_BYTES, stream);
    Args a{};
    for (int i = 0; i < 9; ++i) a.in[i] = (const float*)d_in[i];
    a.out = out; a.ws = ws;
    (void)x; (void)norm_g; (void)fox_w_in; (void)fox_b_f; (void)fox_w_out; (void)swa_w_in; (void)swa_sinks; (void)swa_w_out; (void)final_g; (void)SS1; (void)R0; (void)LOGF; (void)CUM; (void)XB; (void)Q; (void)K; (void)V; (void)Gt; (void)YG;
    int p = 0;
    while (p < N_PHASES) {
        if ((FAST_MASK >> p) & 1) {
            int e = p + 1; if (ONE_LAUNCH) while (e < N_PHASES && ((FAST_MASK >> e) & 1)) ++e;
            a.ph_lo = p; a.ph_hi = e;
            hipLaunchKernelGGL(mega_fwd, dim3(grid), dim3(NWAVES * 64), LDS_BYTES, stream, a);
            p = e; continue;
        }
#if FAST_MASK != 0x1FF
        switch (p) {
        case 0: n_rowrms<<<MTOK / 4, 256, 0, stream>>>(x, R0); break;
        case 1: n_gemm<float, NEpiFoxIn><<<dim3((FOX_IN + 63) / 64, MTOK / 64), 256, 0, stream>>>(x, DM, norm_g, fox_w_in, FOX_IN, DM, FOX_IN, NEpiFoxIn{Q, K, V, Gt, LOGF, R0, fox_b_f}); break;
        case 2: n_cumsum<<<2, 64, 0, stream>>>(LOGF, CUM); break;
        case 3: n_attn<0><<<dim3(SEQ / 256, NB * NH), 256, 0, stream>>>(Q, K, V, CUM, nullptr, Gt, YG); break;
        case 4: n_gemm<bf16_t, NEpiOut1><<<dim3(DM / 64, MTOK / 64), 256, 0, stream>>>(YG, DM, nullptr, fox_w_out, DM, DM, DM, NEpiOut1{x, out, XB, SS1}); break;
        case 5: n_gemm<float, NEpiSwaIn><<<dim3(SWA_IN / 64, MTOK / 64), 256, 0, stream>>>(out, DM, norm_g + DM, swa_w_in, SWA_IN, DM, SWA_IN, NEpiSwaIn{Q, K, V, Gt, SS1});
                n_rope<<<(MTOK * NH * 8 + 255) / 256, 256, 0, stream>>>(Q, DM, NH); n_rope<<<(MTOK * 4 * 8 + 255) / 256, 256, 0, stream>>>(K, KVW, 4); break;
        case 6: n_attn<1><<<dim3(SEQ / 256, NB * NH), 256, 0, stream>>>(Q, K, V, nullptr, swa_sinks, Gt, YG); break;
        case 7: n_gemm<bf16_t, NEpiOut2><<<dim3(DM / 64, MTOK / 64), 256, 0, stream>>>(YG, DM, nullptr, swa_w_out, DM, DM, DM, NEpiOut2{out}); break;
        case 8: n_finalnorm<<<MTOK / 4, 256, 0, stream>>>(out, final_g); break;
        }
#endif
        ++p;
    }
}
```

```cpp
#include <hip/hip_runtime.h>
#include <cstdio>
#include <cstdint>

constexpr int NB = 4, SEQ = 4096, DM = 2048, MTOK = NB * SEQ, NH = 32, HD = 64;
constexpr int FOX_IN = 8224, SWA_IN = 4608, KVW = 256;
constexpr float RMS_EPS = 1e-6f;
constexpr float LOG2E = 1.4426950408889634f;
constexpr float C2 = 0.125f * LOG2E;

typedef unsigned short bf16_t;
__device__ __forceinline__ float bf2f(bf16_t v) { return __uint_as_float((unsigned)v << 16); }
__device__ __forceinline__ bf16_t f2bf(float f) { unsigned u = __float_as_uint(f); return (bf16_t)((u + 0x7fffu + ((u >> 16) & 1u)) >> 16); }
__device__ __forceinline__ float logsigmoidf(float z) { return z < 0.f ? z - log1pf(expf(z)) : -log1pf(expf(-z)); }
__device__ __forceinline__ float siluf(float g) { return g / (1.f + expf(-g)); }

__host__ __device__ __forceinline__ size_t tiled_off(int row, int k) { return ((size_t)((row >> 8) * (DM / 64) + (k >> 6)) << 14) + (size_t)(((row & 255) << 6) + (k & 63)); }

__host__ __device__ __forceinline__ size_t hm_off(int row  , int col  , int nheads) { return ((size_t)((row >> 12) * nheads + (col >> 6)) * SEQ + (row & 4095)) * 64 + (col & 63); }

constexpr size_t MiB = 1u << 20;
constexpr size_t WS_CTL = 0, CTL_ZERO_BYTES = 1 * MiB;
constexpr size_t WS_KMAX = 64 * 1024, WS_TICKET = 65 * 1024;
constexpr size_t WS_SS1 = 512 * 1024;
constexpr size_t WS_R0 = 1 * MiB;
constexpr size_t WS_ROPE = 1 * MiB + 512 * 1024;
constexpr size_t WS_LOGF = 2 * MiB;
constexpr size_t WS_CUM = 4 * MiB;
constexpr size_t WS_W1T = 8 * MiB, WS_W2T = 41 * MiB, WS_W3T = 49 * MiB, WS_W4T = 67 * MiB;
constexpr size_t WS_XB = 76 * MiB, WS_Q = 140 * MiB, WS_K = 204 * MiB, WS_V = 268 * MiB, WS_G = 332 * MiB, WS_YG = 396 * MiB, WS_KAUG = 460 * MiB, WS_END = 468 * MiB;

#ifndef FAST_MASK
#define FAST_MASK 0x1FF
#endif
#ifndef DUP_MASK
#define DUP_MASK 0x000
#endif
#ifndef ONE_LAUNCH
#define ONE_LAUNCH 1
#endif
#if FAST_MASK != 0x1FF
__global__ __launch_bounds__(256) void n_rowrms(const float* x, float* R) {
    const int row = blockIdx.x * 4 + (threadIdx.x >> 6), lane = threadIdx.x & 63;
    const float* xr = x + (size_t)row * DM; float s = 0.f;
    for (int i = lane; i < DM; i += 64) { const float v = xr[i]; s += v * v; }
#pragma unroll
    for (int o = 1; o < 64; o <<= 1) s += __shfl_xor(s, o);
    if (lane == 0) R[row] = 1.0f / sqrtf(s * (1.f / DM) + RMS_EPS);
}
__device__ __forceinline__ float toF(float v) { return v; }
__device__ __forceinline__ float toF(bf16_t v) { return bf2f(v); }

template <class AT, class Epi>
__global__ __launch_bounds__(256) void n_gemm(const AT* A, int lda, const float* kscale, const float* W, int ldw, int Kd, int N, Epi epi) {
    __shared__ float As[16][68]; __shared__ float Bs[16][68];
    const int tx = threadIdx.x & 15, ty = threadIdx.x >> 4;
    const int row0 = blockIdx.y * 64, col0 = blockIdx.x * 64;
    float acc[4][4];
#pragma unroll
    for (int i = 0; i < 4; ++i)
#pragma unroll
        for (int j = 0; j < 4; ++j) acc[i][j] = 0.f;
    for (int k0 = 0; k0 < Kd; k0 += 16) {
        for (int i = threadIdx.x; i < 1024; i += 256) { const int r = i >> 4, kk = i & 15; float a = toF(A[(size_t)(row0 + r) * lda + k0 + kk]); if (kscale) a *= kscale[k0 + kk]; As[kk][r] = a; }
        for (int i = threadIdx.x; i < 1024; i += 256) { const int kk = i >> 6, c = i & 63, col = col0 + c; Bs[kk][c] = col < N ? W[(size_t)(k0 + kk) * ldw + col] : 0.f; }
        __syncthreads();
#pragma unroll
        for (int kk = 0; kk < 16; ++kk) {
            const float4 a = *(const float4*)&As[kk][ty * 4]; const float4 b = *(const float4*)&Bs[kk][tx * 4];
            const float av[4] = {a.x, a.y, a.z, a.w}, bv[4] = {b.x, b.y, b.z, b.w};
#pragma unroll
            for (int i = 0; i < 4; ++i)
#pragma unroll
                for (int j = 0; j < 4; ++j) acc[i][j] = fmaf(av[i], bv[j], acc[i][j]);
        }
        __syncthreads();
    }
#pragma unroll
    for (int i = 0; i < 4; ++i)
#pragma unroll
        for (int j = 0; j < 4; ++j) { const int row = row0 + ty * 4 + i, col = col0 + tx * 4 + j; if (col < N) epi(row, col, acc[i][j]); }
}
struct NEpiFoxIn {
    bf16_t *Q, *K, *V, *G; float* LOGF; const float* R0; const float* bfb;
    __device__ void operator()(int row, int col, float v) const {
        v *= R0[row];
        if (col < 2048) Q[(size_t)row * DM + col] = f2bf(v * C2);
        else if (col < 4096) K[(size_t)row * DM + col - 2048] = f2bf(v);
        else if (col < 6144) V[(size_t)row * DM + col - 4096] = f2bf(v);
        else if (col < 8192) G[(size_t)row * DM + col - 6144] = f2bf(siluf(v));
        else { const int h = col - 8192, b = row >> 12, s = row & 4095; LOGF[((size_t)(b * NH + h) << 12) + s] = logsigmoidf(v + bfb[h]); }
    }
};
struct NEpiOut1 {
    const float* xin; float* xout; bf16_t* XB; float* SS;
    __device__ void operator()(int row, int col, float v) const {
        const size_t o = (size_t)row * DM + col; const float x1 = xin[o] + v; xout[o] = x1; XB[o] = f2bf(x1); atomicAdd(&SS[row], x1 * x1);
    }
};
struct NEpiSwaIn {
    bf16_t *Q, *K, *V, *G; const float* SS;
    __device__ void operator()(int row, int col, float v) const {
        v *= 1.0f / sqrtf(SS[row] * (1.f / DM) + RMS_EPS);
        if (col < 2048) Q[(size_t)row * DM + col] = f2bf(v * C2);
        else if (col < 2304) K[(size_t)row * KVW + col - 2048] = f2bf(v);
        else if (col < 2560) V[(size_t)row * KVW + col - 2304] = f2bf(v);
        else G[(size_t)row * DM + col - 2560] = f2bf(siluf(v));
    }
};
struct NEpiOut2 { float* xio; __device__ void operator()(int row, int col, float v) const { const size_t o = (size_t)row * DM + col; xio[o] = xio[o] + v; } };

__global__ void n_rope(bf16_t* T, int pitch, int nheads) {
    const long idx = (long)blockIdx.x * blockDim.x + threadIdx.x; const long total = (long)MTOK * nheads * 8; if (idx >= total) return;
    const int i = idx & 7; const long rh = idx >> 3; const int hh = rh % nheads; const long row = rh / nheads; const int pos = row & 4095;
    const double inv = pow(500000.0, -(double)i / 8.0); const float ang = (float)pos * (float)inv;
    const float c = cosf(ang), s = sinf(ang);
    bf16_t* p = T + (size_t)row * pitch + hh * 64 + i; const float x1 = bf2f(p[0]), x2 = bf2f(p[8]);
    p[0] = f2bf(x1 * c - x2 * s); p[8] = f2bf(x2 * c + x1 * s);
}
__global__ void n_cumsum(const float* LOGF, float* CUM) {
    const int sidx = blockIdx.x * blockDim.x + threadIdx.x; if (sidx >= NB * NH) return;
    const float* lf = LOGF + (size_t)sidx * SEQ; float* c = CUM + (size_t)sidx * SEQ; double a = 0.0;
    for (int s = 0; s < SEQ; ++s) { a += (double)lf[s]; c[s] = (float)(a * 1.4426950408889634); }
}
template <int MODE>
__global__ __launch_bounds__(256) void n_attn(const bf16_t* Q, const bf16_t* K, const bf16_t* V, const float* CUM, const float* sinks, const bf16_t* G, bf16_t* YG) {
    __shared__ float Ks[64][64]; __shared__ float Vs[64][64]; __shared__ float Cs[64];
    const int qb = blockIdx.x, bh = blockIdx.y, b = bh / NH, h = bh % NH, tid = threadIdx.x;
    const int t = qb * 256 + tid; const size_t row = (size_t)b * SEQ + t;
    const int kvh = MODE == 0 ? h : (h >> 3), kp = MODE == 0 ? DM : KVW;
    float q[64], o[64];
#pragma unroll
    for (int d = 0; d < 64; ++d) { q[d] = bf2f(Q[row * DM + h * 64 + d]); o[d] = 0.f; }
    const float ct = MODE == 0 ? CUM[(size_t)bh * SEQ + t] : 0.f;
    float m = MODE == 0 ? -1e30f : sinks[h] * LOG2E, l = MODE == 0 ? 0.f : 1.f;
    const int kstart = MODE == 0 ? 0 : (qb * 256 >= 128 ? qb * 256 - 128 : 0), kend = qb * 256 + 256;
    for (int k0 = kstart; k0 < kend; k0 += 64) {
        for (int i = tid; i < 4096; i += 256) { const int kk = i >> 6, d = i & 63; const size_t a = ((size_t)b * SEQ + k0 + kk) * kp + kvh * 64 + d; Ks[kk][d] = bf2f(K[a]); Vs[kk][d] = bf2f(V[a]); }
        if (MODE == 0 && tid < 64) Cs[tid] = CUM[(size_t)bh * SEQ + k0 + tid];
        __syncthreads();
        for (int kk = 0; kk < 64; ++kk) {
            const int s = k0 + kk; float sd = 0.f;
#pragma unroll
            for (int d = 0; d < 64; ++d) sd = fmaf(q[d], Ks[kk][d], sd);
            if (MODE == 0) sd += ct - Cs[kk];
            const bool ok = MODE == 0 ? (s <= t) : (s <= t && t - s < 128);
            if (!ok) sd = -INFINITY;
            const float mn = fmaxf(m, sd), a = exp2f(m - mn), p = exp2f(sd - mn);
            l = l * a + p;
#pragma unroll
            for (int d = 0; d < 64; ++d) o[d] = fmaf(p, Vs[kk][d], o[d] * a);
            m = mn;
        }
        __syncthreads();
    }
    const float rl = 1.f / l;
#pragma unroll
    for (int d = 0; d < 64; ++d) { const size_t a = row * DM + h * 64 + d; YG[a] = f2bf(o[d] * rl * bf2f(G[a])); }
}
__global__ __launch_bounds__(256) void n_finalnorm(float* xio, const float* g) {
    const int row = blockIdx.x * 4 + (threadIdx.x >> 6), lane = threadIdx.x & 63;
    float* xr = xio + (size_t)row * DM; float s = 0.f;
    for (int i = lane; i < DM; i += 64) { const float v = xr[i]; s += v * v; }
#pragma unroll
    for (int o = 1; o < 64; o <<= 1) s += __shfl_xor(s, o);
    const float r = 1.0f / sqrtf(s * (1.f / DM) + RMS_EPS);
    for (int i = lane; i < DM; i += 64) xr[i] = xr[i] * r * g[i];
}

#endif
namespace pg8 {
#define PG8_LAS __attribute__((address_space(3)))
typedef unsigned short bf16_t;
typedef short bf16x8 __attribute__((ext_vector_type(8)));
typedef float f32x4 __attribute__((ext_vector_type(4)));
typedef unsigned u32x4 __attribute__((ext_vector_type(4)));
constexpr int BM = 256, BK = 64, HALF = 128, HTB = HALF * BK * 2  , STAGE_BYTES = 8 * HTB, NXCD = 8, WGM = 8;

__host__ __device__ __forceinline__ int lds_byte(int r, int c) { const int st = (r >> 4) * 2 + (c >> 5), rr = r & 15, cc = c & 31, ob = rr * 64 + cc * 2; return st * 1024 + (ob ^ (((ob >> 9) & 1) << 5)); }
__host__ __device__ __forceinline__ void stage_rc(int b, int& R, int& C) { const int st = b / 1024, sb = b % 1024, swz = sb ^ (((sb >> 9) & 1) << 5); R = (st >> 1) * 16 + swz / 64; C = (st & 1) * 32 + (swz % 64) / 2; }
__host__ __device__ __forceinline__ int perm32(int rho) { const int n = rho >> 4, i = rho & 15; return 8 * (i >> 2) + 4 * n + (i & 3); }

struct Unit { int pm, pn, lm, ln; };
struct Gemm { const bf16_t* A; const bf16_t* Bt; int M, N, K; };

struct StaticOrder {
    int nM, nN, nwg, G, c, dup, epi2, same;
    __host__ __device__ void init(int M, int N, int G_, int c_, int dup_ = 0, int epi2_ = 0, int same_ = 0) { nM = M / BM; nN = N / BM; nwg = nM * nN; G = G_; c = c_; dup = dup_; epi2 = epi2_; same = same_; }
    __host__ __device__ bool next(int i, Unit& u) const {
        if (dup) i >>= 1;
        const long L = (long)i * G + c; if (L >= nwg) return false;
        int wgid = (int)L; { const int q = nwg / NXCD, r = nwg % NXCD, xcd = wgid % NXCD, off = wgid / NXCD; wgid = (xcd < r ? xcd * (q + 1) : r * (q + 1) + (xcd - r) * q) + off; }
        const int nig = WGM * nN, gid = wgid / nig, fm = gid * WGM, gsz = (nM - fm) < WGM ? (nM - fm) : WGM;
        u.pm = fm + ((wgid % nig) % gsz); u.pn = (wgid % nig) / gsz; u.lm = same ? 0 : u.pm; u.ln = same ? 0 : u.pn; return true;
    }
    __device__ __forceinline__ void a_ready(const Unit&) const {}
    __device__ __forceinline__ void done(const Unit&) const {}
};

__device__ __forceinline__ unsigned cvt_pk_bf16(float lo, float hi) { unsigned r; asm volatile("v_cvt_pk_bf16_f32 %0, %1, %2" : "=v"(r) : "v"(lo), "v"(hi)); return r; }
__device__ __forceinline__ float silu_fast(float g) { return g * __builtin_amdgcn_rcpf(1.0f + __builtin_amdgcn_exp2f(-g * 1.4426950408889634f)); }
__device__ __forceinline__ u32x4 pack8(const f32x4 v0, const f32x4 v1) { u32x4 w; w.x = cvt_pk_bf16(v0[0], v0[1]); w.y = cvt_pk_bf16(v0[2], v0[3]); w.z = cvt_pk_bf16(v1[0], v1[1]); w.w = cvt_pk_bf16(v1[2], v1[3]); return w; }
struct EpiFoxIn {
    static constexpr bool PERM = true, AFTER_DRAIN = false;
    bf16_t *Q, *K, *V, *G; float* LOGF; const float* R0; const float* bfb;
    __device__ __forceinline__ void operator()(const f32x4 (&acc)[2][2][4][2], const Unit& u, int wr, int wc, int fr, int fq) const {
        const int row0 = u.pm * BM + wr * 64 + fr, pn = u.pn;
        float rs[2][4];
#pragma unroll
        for (int ai = 0; ai < 2; ++ai)
#pragma unroll
            for (int m = 0; m < 4; ++m) rs[ai][m] = R0[row0 + ai * HALF + m * 16];
        if (pn < 32) {
            const int reg = pn >> 3; bf16_t* base = reg == 0 ? Q : reg == 1 ? K : reg == 2 ? V : G;
            const int col0 = (pn & 7) * BM + wc * 32 + 8 * fq;
#pragma unroll
            for (int ai = 0; ai < 2; ++ai)
#pragma unroll
                for (int m = 0; m < 4; ++m) { const int row = row0 + ai * HALF + m * 16; const float r = rs[ai][m]; const float sc = reg == 0 ? r * C2 : r;
#pragma unroll
                    for (int bj = 0; bj < 2; ++bj) { f32x4 v0 = acc[ai][bj][m][0] * sc, v1 = acc[ai][bj][m][1] * sc;
                        if (reg == 3) {
#pragma unroll
                            for (int j = 0; j < 4; ++j) { v0[j] = silu_fast(v0[j]); v1[j] = silu_fast(v1[j]); } }
                        __builtin_nontemporal_store(pack8(v0, v1), (u32x4*)(base + hm_off(row, col0 + bj * HALF, NH))); } }
        } else if (wc == 0) {
#pragma unroll
            for (int ai = 0; ai < 2; ++ai)
#pragma unroll
                for (int m = 0; m < 4; ++m) { const int row = row0 + ai * HALF + m * 16; const float r = rs[ai][m]; const int b = row >> 12, s = row & 4095;
#pragma unroll
                    for (int n = 0; n < 2; ++n)
#pragma unroll
                        for (int j = 0; j < 4; ++j) { const int h = 8 * fq + 4 * n + j; LOGF[((size_t)(b * NH + h) << 12) + s] = logsigmoidf(acc[ai][0][m][n][j] * r + bfb[h]); } }
        }
    }
};
struct EpiSwaIn {
    static constexpr bool PERM = true, AFTER_DRAIN = false;
    bf16_t *Q, *K, *V, *G; const float* SS; const float* ROPE;
    __device__ __forceinline__ void operator()(const f32x4 (&acc)[2][2][4][2], const Unit& u, int wr, int wc, int fr, int fq) const {
        const int row0 = u.pm * BM + wr * 64 + fr, pn = u.pn;
        bf16_t* base; int pitch, colt; float osc = 1.f; const bool rope = pn <= 8, gate = pn >= 10;
        if (pn < 8) { base = Q; pitch = DM; colt = pn * BM; osc = C2; } else if (pn == 8) { base = K; pitch = KVW; colt = 0; } else if (pn == 9) { base = V; pitch = KVW; colt = 0; } else { base = G; pitch = DM; colt = (pn - 10) * BM; }
        const int col0 = colt + wc * 32 + 8 * fq; const bool rotw = rope && ((wc & 1) == 0); const float sgn = fq == 0 ? -1.f : 1.f; const bool rotl = fq < 2;
        float rs[2][4];
#pragma unroll
        for (int ai = 0; ai < 2; ++ai)
#pragma unroll
            for (int m = 0; m < 4; ++m) rs[ai][m] = SS[row0 + ai * HALF + m * 16];
        f32x4 nc0, nc1, ns0, ns1;
        if (rotw) { const float* rp = ROPE + (size_t)(row0 & 4095) * 16; nc0 = *(const f32x4*)rp; nc1 = *(const f32x4*)(rp + 4); ns0 = *(const f32x4*)(rp + 8); ns1 = *(const f32x4*)(rp + 12); }
#pragma unroll
        for (int ai = 0; ai < 2; ++ai)
#pragma unroll
            for (int m = 0; m < 4; ++m) { const int row = row0 + ai * HALF + m * 16; const float r = 1.0f / sqrtf(rs[ai][m] * (1.f / DM) + RMS_EPS);
                const f32x4 c0 = nc0, c1 = nc1, s0 = ns0, s1 = ns1;
                if (rotw && (ai * 4 + m) < 7) { const int nrow = row0 + ((ai * 4 + m + 1) >> 2) * HALF + ((ai * 4 + m + 1) & 3) * 16; const float* rp = ROPE + (size_t)(nrow & 4095) * 16; nc0 = *(const f32x4*)rp; nc1 = *(const f32x4*)(rp + 4); ns0 = *(const f32x4*)(rp + 8); ns1 = *(const f32x4*)(rp + 12); }
#pragma unroll
                for (int bj = 0; bj < 2; ++bj) { f32x4 v0 = acc[ai][bj][m][0] * r, v1 = acc[ai][bj][m][1] * r;
                    if (rotw) {
#pragma unroll
                        for (int j = 0; j < 4; ++j) { const float p0 = __shfl_xor(v0[j], 16), p1 = __shfl_xor(v1[j], 16);
                            const float n0 = v0[j] * c0[j] + sgn * p0 * s0[j], n1 = v1[j] * c1[j] + sgn * p1 * s1[j];
                            v0[j] = rotl ? n0 : v0[j]; v1[j] = rotl ? n1 : v1[j]; } }
                    if (gate) {
#pragma unroll
                        for (int j = 0; j < 4; ++j) { v0[j] = silu_fast(v0[j]); v1[j] = silu_fast(v1[j]); } }
                    v0 = v0 * osc; v1 = v1 * osc;
                    *(u32x4*)(base + hm_off(row, col0 + bj * HALF, pitch >> 6)) = pack8(v0, v1); } }
    }
};
template <bool FIRST> struct EpiRes {
    static constexpr bool PERM = false, AFTER_DRAIN = false;
    const float* xin; bf16_t* XB; float* SS;
    __device__ __forceinline__ void operator()(const f32x4 (&acc)[2][2][4][2], const Unit& u, int wr, int wc, int fr, int fq) const {
        typedef unsigned u32x2v __attribute__((ext_vector_type(2)));
        const int row0 = u.pm * BM + wr * 64 + fr, col0 = u.pn * BM + wc * 32 + 4 * fq;
        if (FIRST) {
            f32x4 nx[2][2];
#pragma unroll
            for (int bj = 0; bj < 2; ++bj)
#pragma unroll
                for (int n = 0; n < 2; ++n) nx[bj][n] = *(const f32x4*)(xin + (size_t)row0 * DM + col0 + bj * HALF + n * 16);
#pragma unroll
            for (int ai = 0; ai < 2; ++ai)
#pragma unroll
                for (int m = 0; m < 4; ++m) { const int row = row0 + ai * HALF + m * 16; float ss = 0.f;
                    f32x4 cx[2][2];
#pragma unroll
                    for (int bj = 0; bj < 2; ++bj)
#pragma unroll
                        for (int n = 0; n < 2; ++n) cx[bj][n] = nx[bj][n];
                    if ((ai * 4 + m) < 7) { const int nrow = row0 + ((ai * 4 + m + 1) >> 2) * HALF + ((ai * 4 + m + 1) & 3) * 16;
#pragma unroll
                        for (int bj = 0; bj < 2; ++bj)
#pragma unroll
                            for (int n = 0; n < 2; ++n) nx[bj][n] = *(const f32x4*)(xin + (size_t)nrow * DM + col0 + bj * HALF + n * 16); }
#pragma unroll
                    for (int bj = 0; bj < 2; ++bj)
#pragma unroll
                        for (int n = 0; n < 2; ++n) { const f32x4 x1 = cx[bj][n] + acc[ai][bj][m][n];
                            u32x2v w; w.x = cvt_pk_bf16(x1[0], x1[1]); w.y = cvt_pk_bf16(x1[2], x1[3]); *(u32x2v*)(XB + tiled_off(row, col0 + bj * HALF + n * 16)) = w;
                            ss += (x1[0] * x1[0] + x1[1] * x1[1]) + (x1[2] * x1[2] + x1[3] * x1[3]); }
                    ss += __shfl_xor(ss, 16); ss += __shfl_xor(ss, 32); if (fq == 0) atomicAdd(SS + row, ss); }
        } else {
            u32x2v xv[2][4][2][2];
#pragma unroll
            for (int ai = 0; ai < 2; ++ai)
#pragma unroll
                for (int m = 0; m < 4; ++m)
#pragma unroll
                    for (int bj = 0; bj < 2; ++bj)
#pragma unroll
                        for (int n = 0; n < 2; ++n) xv[ai][m][bj][n] = *(const u32x2v*)(XB + tiled_off(row0 + ai * HALF + m * 16, col0 + bj * HALF + n * 16));
#pragma unroll
            for (int ai = 0; ai < 2; ++ai)
#pragma unroll
                for (int m = 0; m < 4; ++m)
#pragma unroll
                    for (int bj = 0; bj < 2; ++bj)
#pragma unroll
                        for (int n = 0; n < 2; ++n) { const u32x2v xw = xv[ai][m][bj][n]; const f32x4 a = acc[ai][bj][m][n];
                            u32x2v w; w.x = cvt_pk_bf16(__uint_as_float(xw.x << 16) + a[0], __uint_as_float(xw.x & 0xffff0000u) + a[1]); w.y = cvt_pk_bf16(__uint_as_float(xw.y << 16) + a[2], __uint_as_float(xw.y & 0xffff0000u) + a[3]);
                            *(u32x2v*)(XB + tiled_off(row0 + ai * HALF + m * 16, col0 + bj * HALF + n * 16)) = w; }
        }
    }
};
template <class Epi, class Sched, bool ALIGN_EPI = false, bool SP2 = false>
__device__ __forceinline__ void gemm_phase(PG8_LAS unsigned char* lds, const Gemm g, const Sched& S, const Epi& E) {
    const int tid = threadIdx.x, wid = __builtin_amdgcn_readfirstlane(tid >> 6), lane = tid & 63, wr = wid >> 2, wc = wid & 3, fr = lane & 15, fq = lane >> 4;
    const int K = g.K, nt = K / BK;
    unsigned voffA[2], voffB[2];
#pragma unroll
    for (int i = 0; i < 2; ++i) { int R, C; stage_rc(tid * 16 + i * 8192, R, C); const int Rb = Epi::PERM ? ((R & ~31) + perm32(R & 31)) : R;
        voffA[i] = (unsigned)(R * BK + C) * 2u; voffB[i] = (unsigned)(Rb * BK + C) * 2u; }
    const size_t kstep = (size_t)(BM * BK * 2);
    const size_t hstep = (size_t)(HALF * BK * 2);
    const size_t tstep = (size_t)BM * K * 2;
    const unsigned ldsw = (unsigned)wid * 1024u;
    const int aoff = lds_byte(wr * 64 + fr, fq * 8), boff = lds_byte(wc * 32 + fr, fq * 8);
#define PG8_SA(b, h) (((b) * 2 + (h)) * HTB)
#define PG8_SB(b, h) ((4 + (b) * 2 + (h)) * HTB)
#define PG8_STAGE(bufoff, gbase, voff) do { _Pragma("unroll") for (int _i = 0; _i < 2; ++_i) \
        __builtin_amdgcn_global_load_lds((const unsigned*)((const char*)(gbase) + (voff)[_i]), (PG8_LAS unsigned*)(lds + (bufoff) + ldsw + _i * 8192), 16, 0, 0); } while (0)
#define PG8_LDA(dst, b, h) do { _Pragma("unroll") for (int m = 0; m < 4; ++m) _Pragma("unroll") for (int k = 0; k < 2; ++k) dst[m][k] = *(const PG8_LAS bf16x8*)(lds + PG8_SA(b, h) + aoff + m * 2048 + k * 1024); } while (0)
#define PG8_LDB(dst, b, h) do { _Pragma("unroll") for (int n = 0; n < 2; ++n) _Pragma("unroll") for (int k = 0; k < 2; ++k) dst[n][k] = *(const PG8_LAS bf16x8*)(lds + PG8_SB(b, h) + boff + n * 2048 + k * 1024); } while (0)
#define PG8_MMA(ai, bj, At, Bt) do { __builtin_amdgcn_s_setprio(1); _Pragma("unroll") for (int m = 0; m < 4; ++m) _Pragma("unroll") for (int n = 0; n < 2; ++n) _Pragma("unroll") for (int k = 0; k < 2; ++k) \
        acc[ai][bj][m][n] = __builtin_amdgcn_mfma_f32_16x16x32_bf16(Bt[n][k], At[m][k], acc[ai][bj][m][n], 0, 0, 0); __builtin_amdgcn_s_setprio(0); } while (0)
#define PG8_WAIT_V(n) asm volatile("s_waitcnt vmcnt(" #n ")" ::: "memory")
#define PG8_WAIT_L(n) asm volatile("s_waitcnt lgkmcnt(" #n ")" ::: "memory")
#define PG8_BAR __builtin_amdgcn_s_barrier()
#define PG8_SCHED __builtin_amdgcn_sched_barrier(0)
    Unit cur, nxt; int ui = 0;
    if (!S.next(0, cur)) return;
    f32x4 acc[2][2][4][2];
#pragma unroll
    for (int a = 0; a < 2; ++a)
#pragma unroll
        for (int b = 0; b < 2; ++b)
#pragma unroll
            for (int m = 0; m < 4; ++m)
#pragma unroll
                for (int n = 0; n < 2; ++n) acc[a][b][m][n] = (f32x4){0.f, 0.f, 0.f, 0.f};
    bf16x8 At[4][2], B0[2][2], B1[2][2];
    const char* cA = (const char*)g.A + (size_t)cur.lm * tstep; const char* cB = (const char*)g.Bt + (size_t)cur.ln * tstep;
    S.a_ready(cur);
    if constexpr (SP2) {
        PG8_STAGE(PG8_SB(0, 0), cB, voffB); PG8_STAGE(PG8_SB(0, 1), cB + hstep, voffB); PG8_STAGE(PG8_SA(0, 0), cA, voffA); PG8_STAGE(PG8_SA(0, 1), cA + hstep, voffA);
        if (wr == 1) PG8_BAR;
        PG8_WAIT_V(2); PG8_BAR;
        PG8_STAGE(PG8_SB(1, 0), cB + kstep, voffB); PG8_STAGE(PG8_SA(1, 0), cA + kstep, voffA); PG8_STAGE(PG8_SB(1, 1), cB + hstep + kstep, voffB);
        PG8_WAIT_V(6); PG8_BAR;
    } else {
        PG8_STAGE(PG8_SB(0, 0), cB, voffB); PG8_STAGE(PG8_SA(0, 0), cA, voffA); PG8_STAGE(PG8_SB(0, 1), cB + hstep, voffB); PG8_STAGE(PG8_SA(0, 1), cA + hstep, voffA);
        if (wr == 1) PG8_BAR;
        PG8_WAIT_V(4); PG8_BAR;
        PG8_STAGE(PG8_SB(1, 0), cB + kstep, voffB); PG8_STAGE(PG8_SA(1, 0), cA + kstep, voffA); PG8_STAGE(PG8_SB(1, 1), cB + hstep + kstep, voffB);
        PG8_WAIT_V(6); PG8_BAR;
    }
    for (;;) {
        const bool has_next = S.next(ui + 1, nxt);
        const char* nA = has_next ? (const char*)g.A + (size_t)nxt.lm * tstep : cA; const char* nB = has_next ? (const char*)g.Bt + (size_t)nxt.ln * tstep : cB;
        for (int t = 0; t < nt; t += 2) {
            const bool last = (t == nt - 2);
            const char* a1 = cA + (size_t)(t + 1) * kstep;
            const char* a2 = last ? nA : cA + (size_t)(t + 2) * kstep; const char* b2 = last ? nB : cB + (size_t)(t + 2) * kstep;
            const char* a3 = a2 + kstep; const char* b3 = b2 + kstep;
            if (last && has_next) S.a_ready(nxt);
            if constexpr (SP2) {
            PG8_LDB(B0, 0, 0); PG8_LDB(B1, 0, 1); PG8_SCHED; PG8_LDA(At, 0, 0); PG8_STAGE(PG8_SA(1, 1), a1 + hstep, voffA);
            PG8_WAIT_V(8); PG8_WAIT_L(0); PG8_BAR; PG8_MMA(0, 0, At, B0); PG8_MMA(0, 1, At, B1); PG8_BAR; PG8_SCHED;
            PG8_LDA(At, 0, 1); PG8_STAGE(PG8_SB(0, 0), b2, voffB); PG8_STAGE(PG8_SB(0, 1), b2 + hstep, voffB); PG8_STAGE(PG8_SA(0, 0), a2, voffA);
            PG8_WAIT_V(8); PG8_WAIT_L(0); PG8_BAR; PG8_MMA(1, 0, At, B0); PG8_MMA(1, 1, At, B1); PG8_BAR; PG8_SCHED;
            PG8_LDB(B0, 1, 0); PG8_LDB(B1, 1, 1); PG8_SCHED; PG8_LDA(At, 1, 0); PG8_STAGE(PG8_SA(0, 1), a2 + hstep, voffA);
            PG8_WAIT_V(8); PG8_WAIT_L(0); PG8_BAR; PG8_MMA(0, 0, At, B0); PG8_MMA(0, 1, At, B1); PG8_BAR; PG8_SCHED;
            PG8_LDA(At, 1, 1); PG8_STAGE(PG8_SB(1, 0), b3, voffB); PG8_STAGE(PG8_SB(1, 1), b3 + hstep, voffB); PG8_STAGE(PG8_SA(1, 0), a3, voffA);
            PG8_WAIT_V(8); PG8_WAIT_L(0); PG8_BAR; PG8_MMA(1, 0, At, B0); PG8_MMA(1, 1, At, B1); PG8_BAR; PG8_SCHED;
            } else {
            PG8_LDB(B0, 0, 0); PG8_SCHED; PG8_LDA(At, 0, 0); PG8_STAGE(PG8_SA(1, 1), a1 + hstep, voffA);
            PG8_WAIT_L(8); PG8_BAR; PG8_WAIT_L(0); PG8_MMA(0, 0, At, B0); PG8_BAR; PG8_SCHED;
            PG8_LDB(B1, 0, 1); PG8_STAGE(PG8_SB(0, 0), b2, voffB);
            PG8_BAR; PG8_WAIT_L(0); PG8_MMA(0, 1, At, B1); PG8_BAR;
            PG8_LDA(At, 0, 1); PG8_STAGE(PG8_SA(0, 0), a2, voffA);
            PG8_BAR; PG8_WAIT_L(0); PG8_MMA(1, 0, At, B0); PG8_BAR; PG8_SCHED;
            PG8_STAGE(PG8_SB(0, 1), b2 + hstep, voffB);
            PG8_WAIT_V(6); PG8_BAR; PG8_MMA(1, 1, At, B1); PG8_BAR;
            PG8_LDB(B0, 1, 0); PG8_SCHED; PG8_LDA(At, 1, 0); PG8_STAGE(PG8_SA(0, 1), a2 + hstep, voffA);
            PG8_WAIT_L(8); PG8_BAR; PG8_WAIT_L(0); PG8_MMA(0, 0, At, B0); PG8_BAR; PG8_SCHED;
            PG8_LDB(B1, 1, 1); PG8_STAGE(PG8_SB(1, 0), b3, voffB);
            PG8_BAR; PG8_WAIT_L(0); PG8_MMA(0, 1, At, B1); PG8_BAR;
            PG8_LDA(At, 1, 1); PG8_STAGE(PG8_SA(1, 0), a3, voffA);
            PG8_BAR; PG8_WAIT_L(0); PG8_MMA(1, 0, At, B0); PG8_BAR; PG8_SCHED;
            PG8_STAGE(PG8_SB(1, 1), b3 + hstep, voffB);
            PG8_WAIT_V(6); PG8_BAR; PG8_MMA(1, 1, At, B1); PG8_BAR;
            }
        }
        if constexpr (ALIGN_EPI) { if (wr == 0) PG8_BAR; }
        if constexpr (!Epi::AFTER_DRAIN) { E(acc, cur, wr, wc, fr, fq); if (S.epi2) E(acc, cur, wr, wc, fr, fq); S.done(cur); }
        if (!has_next) break;
#pragma unroll
        for (int a = 0; a < 2; ++a)
#pragma unroll
            for (int b = 0; b < 2; ++b)
#pragma unroll
                for (int m = 0; m < 4; ++m)
#pragma unroll
                    for (int n = 0; n < 2; ++n) acc[a][b][m][n] = (f32x4){0.f, 0.f, 0.f, 0.f};
        cur = nxt; cA = nA; cB = nB; ++ui;
        if constexpr (ALIGN_EPI) { if (wr == 1) PG8_BAR; }
    }
    PG8_WAIT_V(0);
    if constexpr (!ALIGN_EPI) { if (wr == 0) PG8_BAR; }
    PG8_BAR;
    if constexpr (Epi::AFTER_DRAIN) { E.fused(acc, cur, wr, wc, fr, fq, lds, wid, lane); S.done(cur); }
#undef PG8_SA
#undef PG8_SB
#undef PG8_STAGE
#undef PG8_LDA
#undef PG8_LDB
#undef PG8_MMA
#undef PG8_WAIT_V
#undef PG8_WAIT_L
#undef PG8_BAR
#undef PG8_SCHED
}
}
namespace fa {
#define FA_LAS __attribute__((address_space(3)))
typedef short bf16x8 __attribute__((ext_vector_type(8)));
typedef short s16x4 __attribute__((ext_vector_type(4)));
typedef short v4i16_t __attribute__((ext_vector_type(4)));
typedef float f32x16 __attribute__((ext_vector_type(16)));
typedef float f32x4 __attribute__((ext_vector_type(4)));
typedef unsigned u32x4 __attribute__((ext_vector_type(4)));
typedef float f32x2_t __attribute__((ext_vector_type(2))); typedef __bf16 bf16x2_t __attribute__((ext_vector_type(2)));
constexpr float THR = 8.f, TH_SKIP = 32.f;
constexpr int F_KBUF = 18432, F_AOFF = 8192, F_VOFF = 10240, F_WSF = 3 * F_KBUF, F_FLAG = F_WSF + 8 * 256, F_OST = F_FLAG + 256, F_LDS_BYTES = F_OST + 8 * 4096;
constexpr int S_KBUF = 16384, S_VOFF = 8192, S_WSF = 6 * S_KBUF, S_OST = S_WSF + 8 * 256, S_LDS_BYTES = S_OST + 8 * 4096;
struct Params { const bf16_t* Q; const bf16_t* K; const bf16_t* V; const bf16_t* G; bf16_t* O; const float* CUM; const float* sinks; const unsigned* KMAX; unsigned* ticket; const bf16_t* KAUG; };
__device__ __forceinline__ unsigned cvtpk(float lo, float hi) { f32x2_t v = {lo, hi}; bf16x2_t b = __builtin_convertvector(v, bf16x2_t); return __builtin_bit_cast(unsigned, b); }
__device__ __forceinline__ s16x4 vtr(FA_LAS unsigned char* p) { return __builtin_bit_cast(s16x4, __builtin_amdgcn_ds_read_tr16_b64_v4i16((FA_LAS v4i16_t*)p)); }
__device__ __forceinline__ float swap_max(float v) { auto rr = __builtin_amdgcn_permlane32_swap(__float_as_uint(v), __float_as_uint(v), false, false); return __builtin_fmaxf(__uint_as_float(rr[0]), __uint_as_float(rr[1])); }
__device__ __forceinline__ float swap_add(float v) { auto rr = __builtin_amdgcn_permlane32_swap(__float_as_uint(v), __float_as_uint(v), false, false); return __uint_as_float(rr[0]) + __uint_as_float(rr[1]); }
__device__ __forceinline__ void glds16(const void* gsrc, unsigned lds_dst) { unsigned keep;
    asm volatile("s_mov_b32 %0, m0\n\ts_mov_b32 m0, %2\n\ts_nop 0\n\tglobal_load_lds_dwordx4 %1, off\n\ts_mov_b32 m0, %0" : "=&s"(keep) : "v"(gsrc), "s"(lds_dst) : "memory"); }
#define FA_MFMA(a, b, c) __builtin_amdgcn_mfma_f32_32x32x16_bf16((a), (b), (c), 0, 0, 0)
#define FA_MX3(a, b, c) __builtin_fmaxf(__builtin_fmaxf((a), (b)), (c))
struct WaveSt { bf16x8 qr[4]; bf16x8 qa; f32x16 cinit, o0, o1; float cq, mhat, lsum, mrun; };

#define FA_SBAR() __builtin_amdgcn_sched_barrier(0)
#define FA_PIN(x) asm volatile("" : "+v"(x))
#define FA_LDK(p) (*(FA_LAS bf16x8*)(p))
#define FA_VF(l, h) ((bf16x8){l[0], l[1], l[2], l[3], h[0], h[1], h[2], h[3]})
#define FA_EX4(X, B) do { X[B] = __builtin_amdgcn_exp2f(X[B]); X[B + 1] = __builtin_amdgcn_exp2f(X[B + 1]); X[B + 2] = __builtin_amdgcn_exp2f(X[B + 2]); X[B + 3] = __builtin_amdgcn_exp2f(X[B + 3]); } while (0)
__device__ __forceinline__ void split3(float v, unsigned& h1, unsigned& h2, unsigned& h3) { const bf16_t a = f2bf(v); const float r1 = v - bf2f(a); const bf16_t b = f2bf(r1); const float r2 = r1 - bf2f(b); h1 = a; h2 = b; h3 = f2bf(r2); }
__device__ __forceinline__ void set_qa(WaveSt& w, int hi) {
    unsigned g1, g2, g3; split3(w.cq - w.mhat, g1, g2, g3);
    const u32x4 q = {hi == 0 ? 0x3F803F80u : 0u, hi == 0 ? (0x3F80u | (g1 << 16)) : 0u, hi == 0 ? (g2 | (g3 << 16)) : 0u, 0u};
    w.qa = __builtin_bit_cast(bf16x8, q);
}
template <int MODE, int AOFF, int VOFF, int HB>
__device__ __forceinline__ void half_step(FA_LAS unsigned char* bb, FA_LAS unsigned char* vprev, FA_LAS float* wsf, WaveSt& w, f32x16& C, f32x16& P, int k0, int t, int qlo, int lane, int r32, int hi) {
    constexpr int W = MODE == 0 ? 0x40000000 : 128;
    FA_LAS unsigned char* kp = bb + hi * 1024 + r32 * 16 + HB * 512; FA_LAS unsigned char* ap = bb + AOFF + r32 * 16 + HB * 512;
    FA_LAS unsigned char* vp = (HB == 0 ? vprev + 2048 : bb) + VOFF + ((lane >> 4) & 1) * 32 + (lane & 3) * 8 + (4 * hi + ((lane & 15) >> 2)) * 64;
    bf16x8 kf0 = FA_LDK(kp), kf1 = FA_LDK(kp + 2048), kf2, kf3, ka;
    s16x4 vl0, vh0, vl1, vh1, vl2, vh2, vl3, vh3; u32x4 pw0, pw1; float sacc;
    FA_SBAR();
    if (MODE == 0) C = FA_MFMA(kf0, w.qr[0], ((f32x16){0.f, 0.f, 0.f, 0.f, 0.f, 0.f, 0.f, 0.f, 0.f, 0.f, 0.f, 0.f, 0.f, 0.f, 0.f, 0.f})); else C = FA_MFMA(kf0, w.qr[0], w.cinit);
    kf2 = FA_LDK(kp + 4096);
    sacc = (P[0] + P[1]) + (P[2] + P[3]); pw0.x = cvtpk(P[0], P[1]); pw0.y = cvtpk(P[2], P[3]); FA_PIN(sacc); FA_PIN(pw0.x); FA_PIN(pw0.y);
    FA_SBAR();
    C = FA_MFMA(kf1, w.qr[1], C); kf3 = FA_LDK(kp + 6144);
    sacc += P[4]; sacc += P[5]; sacc += P[6]; sacc += P[7]; pw0.z = cvtpk(P[4], P[5]); pw0.w = cvtpk(P[6], P[7]); FA_PIN(sacc); FA_PIN(pw0.z); FA_PIN(pw0.w);
    FA_SBAR();
    C = FA_MFMA(kf2, w.qr[2], C); if (MODE == 0) ka = FA_LDK(ap);
    sacc += P[8]; sacc += P[9]; sacc += P[10]; sacc += P[11]; pw1.x = cvtpk(P[8], P[9]); pw1.y = cvtpk(P[10], P[11]); FA_PIN(sacc); FA_PIN(pw1.x); FA_PIN(pw1.y); vl0 = vtr(vp); vh0 = vtr(vp + 512);
    FA_SBAR();
    C = FA_MFMA(kf3, w.qr[3], C);
    sacc += P[12]; sacc += P[13]; sacc += P[14]; sacc += P[15]; pw1.z = cvtpk(P[12], P[13]); pw1.w = cvtpk(P[14], P[15]); FA_PIN(sacc); FA_PIN(pw1.z); FA_PIN(pw1.w); vl1 = vtr(vp + 4096); vh1 = vtr(vp + 4096 + 512);
    FA_SBAR();
    if (MODE == 0) { C = FA_MFMA(ka, w.qa, C); FA_SBAR(); }
    w.lsum += sacc;
    const bf16x8 pa0 = __builtin_bit_cast(bf16x8, pw0), pa1 = __builtin_bit_cast(bf16x8, pw1);
    vl2 = vtr(vp + 1024); vh2 = vtr(vp + 1024 + 512);
    w.o0 = FA_MFMA(pa0, FA_VF(vl0, vh0), w.o0); vl3 = vtr(vp + 4096 + 1024); vh3 = vtr(vp + 4096 + 1024 + 512);
    w.o1 = FA_MFMA(pa0, FA_VF(vl1, vh1), w.o1);
    FA_SBAR();
    const int kh = k0 + 32 * HB;
    if ((kh + 31 > qlo) || (MODE == 1 && kh <= qlo + 31 - W)) {
        const float NEG = -__builtin_inff(); const int dq = t - kh - 4 * hi;
#pragma unroll
        for (int r = 0; r < 16; ++r) { const int c = (r & 3) + 8 * (r >> 2); if ((unsigned)(dq - c) >= (unsigned)W) C[r] = NEG; }
    }
    float ma = FA_MX3(C[0], C[1], C[2]), mb = FA_MX3(C[3], C[4], C[5]);
    ma = FA_MX3(ma, C[6], C[7]); mb = FA_MX3(mb, C[8], C[9]); ma = FA_MX3(ma, C[10], C[11]); mb = FA_MX3(mb, C[12], C[13]); ma = FA_MX3(ma, C[14], C[15]);
    const float rm = swap_max(__builtin_fmaxf(ma, mb));
    if (MODE == 0) w.mrun = __builtin_fmaxf(w.mrun, rm + w.mhat);
    const bool resc = __any(rm > THR);
    if (resc) {
        const float dl = __builtin_fmaxf(rm, 0.f); w.mhat += dl;
#pragma unroll
        for (int r = 0; r < 16; ++r) C[r] -= dl;
        if (MODE == 0) set_qa(w, hi);
        else { const float ci = w.cq - w.mhat;
#pragma unroll
            for (int r = 0; r < 16; ++r) w.cinit[r] = ci; }
        const float f = __builtin_amdgcn_exp2f(-dl); w.lsum *= f;
        if (hi == 0) wsf[r32] = f;
    }
    FA_SBAR();
    FA_EX4(C, 0); FA_PIN(C);
    w.o0 = FA_MFMA(pa1, FA_VF(vl2, vh2), w.o0); FA_EX4(C, 4); FA_EX4(C, 8); FA_PIN(C); FA_SBAR();
    w.o1 = FA_MFMA(pa1, FA_VF(vl3, vh3), w.o1); FA_EX4(C, 12); FA_PIN(C); FA_SBAR();
    if (resc) {
        asm volatile("s_waitcnt lgkmcnt(0)" ::: "memory");
#pragma unroll
        for (int g = 0; g < 4; ++g) { const f32x4 a4 = *(FA_LAS f32x4*)(wsf + 8 * g + 4 * hi);
#pragma unroll
            for (int i = 0; i < 4; ++i) { w.o0[4 * g + i] *= a4[i]; w.o1[4 * g + i] *= a4[i]; } }
    }
}
template <int MODE, int AOFF, int VOFF>
__device__ __forceinline__ void tile_step(FA_LAS unsigned char* bb, FA_LAS unsigned char* vprev, FA_LAS float* wsf, WaveSt& w, f32x16& pA, f32x16& pB, int k0, int t, int qlo, int lane, int r32, int hi) {
    half_step<MODE, AOFF, VOFF, 0>(bb, vprev, wsf, w, pA, pB, k0, t, qlo, lane, r32, hi);
    half_step<MODE, AOFF, VOFF, 1>(bb, vprev, wsf, w, pB, pA, k0, t, qlo, lane, r32, hi);
}
template <int VOFF>
__device__ __forceinline__ void tile_drain(FA_LAS unsigned char* vlast, WaveSt& w, f32x16& P, int lane, int hi) {
    FA_LAS unsigned char* vp = vlast + 2048 + VOFF + ((lane >> 4) & 1) * 32 + (lane & 3) * 8 + (4 * hi + ((lane & 15) >> 2)) * 64;
    float s0 = 0.f;
#pragma unroll
    for (int r = 0; r < 16; ++r) s0 += P[r];
    w.lsum += s0;
    const u32x4 w0 = {cvtpk(P[0], P[1]), cvtpk(P[2], P[3]), cvtpk(P[4], P[5]), cvtpk(P[6], P[7])};
    const u32x4 w1 = {cvtpk(P[8], P[9]), cvtpk(P[10], P[11]), cvtpk(P[12], P[13]), cvtpk(P[14], P[15])};
    const bf16x8 pa0 = __builtin_bit_cast(bf16x8, w0), pa1 = __builtin_bit_cast(bf16x8, w1);
    { const s16x4 l0 = vtr(vp), h0 = vtr(vp + 512), l1 = vtr(vp + 4096), h1 = vtr(vp + 4096 + 512); w.o0 = FA_MFMA(pa0, FA_VF(l0, h0), w.o0); w.o1 = FA_MFMA(pa0, FA_VF(l1, h1), w.o1); }
    { const s16x4 l0 = vtr(vp + 1024), h0 = vtr(vp + 1024 + 512), l1 = vtr(vp + 4096 + 1024), h1 = vtr(vp + 4096 + 1024 + 512); w.o0 = FA_MFMA(pa1, FA_VF(l0, h0), w.o0); w.o1 = FA_MFMA(pa1, FA_VF(l1, h1), w.o1); }
}
__device__ __forceinline__ void load_gate(u32x4 (&gq)[4], const bf16_t* G, size_t grow, int h, int lane) {
#pragma unroll
    for (int d0 = 0; d0 < 2; ++d0)
#pragma unroll
        for (int i = 0; i < 2; ++i) gq[2 * d0 + i] = *(const u32x4*)(G + hm_off((int)grow + i * 16 + (lane >> 2), h * 64 + d0 * 32 + (lane & 3) * 8, NH));
}
__device__ __forceinline__ void wave_epilogue(FA_LAS float* stg, FA_LAS float* wsf, WaveSt& w, const u32x4 (&gq)[4], bf16_t* O, size_t grow, int h, int lane, int r32, int hi) {
    const float l = swap_add(w.lsum);
    if (hi == 0) wsf[r32] = l;
    asm volatile("s_waitcnt lgkmcnt(0)" ::: "memory");
    float rl[16];
#pragma unroll
    for (int g = 0; g < 4; ++g) { const f32x4 l4 = *(FA_LAS f32x4*)(wsf + 8 * g + 4 * hi);
#pragma unroll
        for (int i = 0; i < 4; ++i) rl[4 * g + i] = 1.0f / l4[i]; }
#pragma unroll
    for (int d0 = 0; d0 < 2; ++d0) {
#pragma unroll
        for (int g = 0; g < 4; ++g)
#pragma unroll
            for (int i = 0; i < 4; ++i) stg[(8 * g + 4 * hi + i) * 32 + r32] = (d0 == 0 ? w.o0[4 * g + i] : w.o1[4 * g + i]) * rl[4 * g + i];
        asm volatile("s_waitcnt lgkmcnt(0)" ::: "memory");
#pragma unroll
        for (int i = 0; i < 2; ++i) { const int row = i * 16 + (lane >> 2), ch = lane & 3;
            const f32x4 x0 = *(FA_LAS f32x4*)(stg + row * 32 + ch * 8), x1 = *(FA_LAS f32x4*)(stg + row * 32 + ch * 8 + 4);
            const size_t ga = (grow + row) * DM + h * 64 + d0 * 32 + ch * 8; const u32x4 gv = gq[2 * d0 + i];
            u32x4 ov;
            ov.x = cvtpk(x0[0] * __uint_as_float(gv.x << 16), x0[1] * __uint_as_float(gv.x & 0xffff0000u)); ov.y = cvtpk(x0[2] * __uint_as_float(gv.y << 16), x0[3] * __uint_as_float(gv.y & 0xffff0000u));
            ov.z = cvtpk(x1[0] * __uint_as_float(gv.z << 16), x1[1] * __uint_as_float(gv.z & 0xffff0000u)); ov.w = cvtpk(x1[2] * __uint_as_float(gv.w << 16), x1[3] * __uint_as_float(gv.w & 0xffff0000u));
            *(u32x4*)(O + tiled_off((int)(grow + row), h * 64 + d0 * 32 + ch * 8)) = ov; }
        asm volatile("s_waitcnt lgkmcnt(0)" ::: "memory");
    }
}
template <int MODE> __device__ __forceinline__ void wave_init(WaveSt& w, int hi) {
#pragma unroll
    for (int r = 0; r < 16; ++r) { w.o0[r] = 0.f; w.o1[r] = 0.f; }
    if (MODE == 0) set_qa(w, hi);
    else { const float ci = w.cq - w.mhat;
#pragma unroll
        for (int r = 0; r < 16; ++r) w.cinit[r] = ci; }
}

__device__ __forceinline__ void fox_unit(FA_LAS unsigned char* lds, const Params& P, int b, int h, int qb) {
    const int tid = threadIdx.x, lane = tid & 63, r32 = lane & 31, hi = lane >> 5;
    const int wid = __builtin_amdgcn_readfirstlane(tid >> 6);
    const int q0 = qb * 256, qlo = q0 + wid * 32, t = qlo + r32;
    const size_t rowbase = (size_t)b * SEQ;
    const bf16_t* ksrc = P.K + hm_off((int)rowbase + lane, h * 64 + wid * 8, NH);
    const bf16_t* vsrc = P.V + hm_off((int)rowbase + 16 * (wid & 3) + (lane >> 2), h * 64 + (wid >> 2) * 32 + (lane & 3) * 8, NH);
    const float* cum = P.CUM + (size_t)(b * NH + h) * SEQ;
    const bf16_t* asrc = P.KAUG + ((size_t)(b * NH + h) * SEQ + lane) * 8;
    const int NT = (q0 + 256) / 64;
    WaveSt w; const bf16_t* Qw = P.Q + hm_off((int)rowbase + t, h * 64 + hi * 8, NH); float qn = 0.f;
#pragma unroll
    for (int d0 = 0; d0 < 4; ++d0) { w.qr[d0] = *(const bf16x8*)(Qw + d0 * 16);
#pragma unroll
        for (int j = 0; j < 8; ++j) { const float qv = bf2f((bf16_t)w.qr[d0][j]); qn = fmaf(qv, qv, qn); } }
    w.cq = cum[t]; w.mhat = 0.f; w.lsum = 0.f; w.mrun = -1e30f;
    wave_init<0>(w, hi);
    u32x4 gq[4]; load_gate(gq, P.G, rowbase + qlo, h, lane);
    const float qkb = sqrtf(swap_add(qn) * __uint_as_float(P.KMAX[b * NH + h])) * 1.0001f + 1e-3f;
    FA_LAS float* wsf = (FA_LAS float*)(lds + F_WSF) + wid * 64;
    FA_LAS unsigned* votes = (FA_LAS unsigned*)(lds + F_FLAG);
    float cnew = 0.f;
#define FA_LOADT(j, bf) do { const size_t ko_ = (size_t)(j) * 64 * 64; FA_LAS unsigned char* bb_ = lds + (bf) * F_KBUF; \
        glds16(ksrc + ko_, (unsigned)__builtin_amdgcn_readfirstlane((int)(unsigned)(uintptr_t)(bb_ + wid * 1024))); \
        glds16(vsrc + ko_, (unsigned)__builtin_amdgcn_readfirstlane((int)(unsigned)(uintptr_t)(bb_ + F_VOFF + (wid >> 2) * 4096 + (wid & 3) * 1024))); \
        if (wid == 0) glds16(asrc + (size_t)(j) * 64 * 8, (unsigned)__builtin_amdgcn_readfirstlane((int)(unsigned)(uintptr_t)(bb_ + F_AOFF))); \
        cnew = cum[(j) * 64 + 63]; } while (0)
    FA_LOADT(NT - 1, 0); asm volatile("s_waitcnt vmcnt(0)" ::: "memory"); __syncthreads();
    bool wdone = false, pend = false; f32x16 pA, pB;
#pragma unroll
    for (int r = 0; r < 16; ++r) pB[r] = 0.f;
    int cur = 0;
    for (int tt = 0; tt < NT; ++tt) {
        const int j = NT - 1 - tt, k0 = j * 64; const int nxt = cur == 2 ? 0 : cur + 1, prv = cur == 0 ? 2 : cur - 1;
        if (j > 0) FA_LOADT(j - 1, nxt);
        if (!wdone && k0 <= qlo + 31) {
            FA_LAS unsigned char* bb = lds + cur * F_KBUF;
            tile_step<0, F_AOFF, F_VOFF>(bb, pend ? lds + prv * F_KBUF : bb, wsf, w, pA, pB, k0, t, qlo, lane, r32, hi);
            pend = true;
        }
        if (j > 0) {
            if (!wdone && pend && __all(qkb + w.cq - cnew - w.mrun <= -TH_SKIP)) {
                wdone = true; tile_drain<F_VOFF>(lds + cur * F_KBUF, w, pB, lane, hi);
            }
            if (lane == 0) votes[(tt & 1) * 8 + wid] = wdone ? 1u : 0u;
        }
        asm volatile("s_waitcnt vmcnt(0)" ::: "memory");
        __syncthreads();
        if (j > 0) { const u32x4 v0 = *(FA_LAS u32x4*)(votes + (tt & 1) * 8), v1 = *(FA_LAS u32x4*)(votes + (tt & 1) * 8 + 4);
            if ((v0.x & v0.y & v0.z & v0.w & v1.x & v1.y & v1.z & v1.w) != 0u) break; }
        else if (!wdone) tile_drain<F_VOFF>(lds + cur * F_KBUF, w, pB, lane, hi);
        cur = nxt;
    }
#undef FA_LOADT
    wave_epilogue((FA_LAS float*)(lds + F_OST + wid * 4096), wsf, w, gq, P.O, rowbase + qlo, h, lane, r32, hi);
    __syncthreads();
}
__device__ __forceinline__ void swa_unit(FA_LAS unsigned char* lds, const Params& P, int b, int kvh, int qb) {
    const int tid = threadIdx.x, lane = tid & 63, r32 = lane & 31, hi = lane >> 5;
    const int wid = __builtin_amdgcn_readfirstlane(tid >> 6);
    const int q0 = qb * 256, qlo = q0 + wid * 32, t = qlo + r32;
    const size_t rowbase = (size_t)b * SEQ;
    const int j_lo = q0 >= 128 ? (q0 - 128) / 64 : 0, NT = (q0 + 256) / 64 - j_lo;
    const bf16_t* ksrc = P.K + hm_off((int)rowbase + j_lo * 64 + lane, kvh * 64 + wid * 8, 4);
    const bf16_t* vsrc = P.V + hm_off((int)rowbase + j_lo * 64 + 16 * (wid & 3) + (lane >> 2), kvh * 64 + (wid >> 2) * 32 + (lane & 3) * 8, 4);
    const int kdst = wid * 1024 + lane * 16, vdst = S_VOFF + (wid >> 2) * 4096 + (wid & 3) * 1024 + lane * 16;
    { u32x4 sk[6], sv[6];
#pragma unroll
      for (int i = 0; i < 6; ++i) if (i < NT) { sk[i] = *(const u32x4*)(ksrc + (size_t)i * 64 * 64); sv[i] = *(const u32x4*)(vsrc + (size_t)i * 64 * 64); }
#pragma unroll
      for (int i = 0; i < 6; ++i) if (i < NT) { *(FA_LAS u32x4*)(lds + i * S_KBUF + kdst) = sk[i]; *(FA_LAS u32x4*)(lds + i * S_KBUF + vdst) = sv[i]; } }
    __syncthreads();
    FA_LAS float* wsf = (FA_LAS float*)(lds + S_WSF) + wid * 64;
    const int ta = (qlo >= 127 ? (qlo - 127) / 64 : 0) - j_lo, tb = (qlo + 31) / 64 - j_lo;
    bf16x8 qn[4]; { const bf16_t* Qw = P.Q + hm_off((int)rowbase + t, (kvh * 8) * 64 + hi * 8, NH);
#pragma unroll
      for (int d0 = 0; d0 < 4; ++d0) qn[d0] = *(const bf16x8*)(Qw + d0 * 16); }
    for (int hh = 0; hh < 8; ++hh) {
        const int h = kvh * 8 + hh;
        WaveSt w;
#pragma unroll
        for (int d0 = 0; d0 < 4; ++d0) w.qr[d0] = qn[d0];
        { const bf16_t* Qw = P.Q + hm_off((int)rowbase + t, (kvh * 8 + (hh < 7 ? hh + 1 : hh)) * 64 + hi * 8, NH);
#pragma unroll
          for (int d0 = 0; d0 < 4; ++d0) qn[d0] = *(const bf16x8*)(Qw + d0 * 16); }
        u32x4 gq[4]; load_gate(gq, P.G, rowbase + qlo, h, lane);
        w.cq = 0.f; w.mhat = P.sinks[h] * LOG2E; w.lsum = 0.5f; w.mrun = 0.f;
        wave_init<1>(w, hi);
        f32x16 pA, pB;
#pragma unroll
        for (int r = 0; r < 16; ++r) pB[r] = 0.f;
        for (int ti = tb; ti >= ta; --ti) { FA_LAS unsigned char* bb = lds + ti * S_KBUF;
            tile_step<1, 0, S_VOFF>(bb, ti == tb ? bb : bb + S_KBUF, wsf, w, pA, pB, (j_lo + ti) * 64, t, qlo, lane, r32, hi); }
        tile_drain<S_VOFF>(lds + ta * S_KBUF, w, pB, lane, hi);
        wave_epilogue((FA_LAS float*)(lds + S_OST + wid * 4096), wsf, w, gq, P.O, rowbase + qlo, h, lane, r32, hi);
    }
    __syncthreads();
}
}
#define GAS __attribute__((address_space(1)))
#define LAS __attribute__((address_space(3)))
typedef unsigned short bf16;
typedef unsigned v4u __attribute__((ext_vector_type(4)));
typedef float f32x4 __attribute__((ext_vector_type(4)));
typedef short bf16x8 __attribute__((ext_vector_type(8)));
typedef GAS unsigned gu32;
typedef GAS unsigned long long gu64;
#define RLX_AGENT __ATOMIC_RELAXED, __HIP_MEMORY_SCOPE_AGENT
#define LDS_WAIT() asm volatile("s_waitcnt lgkmcnt(0)" ::: "memory")
#define VM_WAIT() asm volatile("s_waitcnt vmcnt(0)" ::: "memory")
__device__ __forceinline__ unsigned long long rt() { return __builtin_amdgcn_s_memrealtime(); }
__device__ __forceinline__ unsigned pk2(float lo, float hi) { return (unsigned)f2bf(lo) | ((unsigned)f2bf(hi) << 16); }
#define XB_TMO      128
#define XB_XCNT(j)  (256  + 64 * (j))
#define XB_XSUB(j)  (1280 + 64 * (j))
#define XB_XGEN(j)  (2304 + 64 * (j))
#define XB_TOP      3328
#define XB_TOPGEN   3392
#define XCD_BAR_WORDS 3456
#define XB_SPIN_CAP (1u << 18)

__device__ __forceinline__ unsigned xb_ld(unsigned* p)              { return __hip_atomic_load(p, __ATOMIC_RELAXED, __HIP_MEMORY_SCOPE_AGENT); }
__device__ __forceinline__ unsigned xb_add(unsigned* p, unsigned v) { return __hip_atomic_fetch_add(p, v, __ATOMIC_RELAXED, __HIP_MEMORY_SCOPE_AGENT); }
__device__ __forceinline__ unsigned xb_xcc_id() { return (unsigned)__builtin_amdgcn_s_getreg((3 << 11) | 20) & 0xFu; }
#define XB_SPIN(cond, bar) do { unsigned _sp = 0; while (cond) { __builtin_amdgcn_s_sleep(1); \
    if ((++_sp & 255u) == 0u) { if (xb_ld(&(bar)[XB_TMO])) break; if (_sp > XB_SPIN_CAP) { atomicAdd(&(bar)[XB_TMO], 1u); break; } } } } while (0)

struct XcdBarrier {
    unsigned* bar; unsigned x;
    volatile LAS unsigned* st;
};

__device__ __forceinline__ XcdBarrier xcd_barrier_post(unsigned* bar, volatile LAS unsigned* st) {
    XcdBarrier b; b.bar = bar; b.x = xb_xcc_id(); b.st = st;
    if (threadIdx.x == 0) (void)xb_add(&bar[XB_XCNT(b.x)], 1u);
    return b;
}
__device__ __forceinline__ void xcd_barrier_complete(unsigned* bar, unsigned x, unsigned& nloc, unsigned& nx) {
    const unsigned G = gridDim.x * gridDim.y * gridDim.z;
    unsigned sum, cnt, mine, sp = 0u;
    for (;;) {
        sum = 0u; cnt = 0u; mine = 0u;
#pragma unroll
        for (unsigned j = 0; j < 16; ++j) { const unsigned c = xb_ld(&bar[XB_XCNT(j)]); sum += c; cnt += (c > 0u) ? 1u : 0u; mine = (j == x) ? c : mine; }
        if (sum == G) break;
        __builtin_amdgcn_s_sleep(1);
        if ((++sp & 255u) == 0u) { if (xb_ld(&bar[XB_TMO])) break; if (sp > XB_SPIN_CAP) { atomicAdd(&bar[XB_TMO], 1u); break; } }
    }
    nloc = mine > 0u ? mine : 1u; nx = cnt > 0u ? cnt : 1u;
}

__device__ __forceinline__ void xcd_barrier(const XcdBarrier& b) {
    asm volatile("s_waitcnt vmcnt(0)" ::: "memory");
    __syncthreads();
    if (threadIdx.x == 0) {
        unsigned* bar = b.bar;
        __builtin_amdgcn_s_waitcnt(0);
        unsigned nloc = b.st[0], nx = b.st[1];
        if (nloc == 0u) { xcd_barrier_complete(bar, b.x, nloc, nx); b.st[0] = nloc; b.st[1] = nx; }
        const unsigned old = xb_add(&bar[XB_XSUB(b.x)], 1u);
        const unsigned gen = old / nloc;
        if (old + 1u == (gen + 1u) * nloc) {
            __builtin_amdgcn_fence(__ATOMIC_RELEASE, "agent");
            asm volatile("s_waitcnt vmcnt(0)" ::: "memory");
            const unsigned og = xb_add(&bar[XB_TOP], 1u);
            const unsigned tg = og / nx;
            if (og + 1u == (tg + 1u) * nx) xb_add(&bar[XB_TOPGEN], 1u);
            else XB_SPIN(xb_ld(&bar[XB_TOPGEN]) == tg, bar);
            __builtin_amdgcn_fence(__ATOMIC_ACQUIRE, "agent");
            xb_add(&bar[XB_XGEN(b.x)], 1u);
            asm volatile("s_waitcnt vmcnt(0)" ::: "memory");
        } else {
            XB_SPIN(xb_ld(&bar[XB_XGEN(b.x)]) == gen, bar);
            __builtin_amdgcn_fence(__ATOMIC_ACQUIRE, "agent");
            asm volatile("s_waitcnt vmcnt(0)" ::: "memory");
        }
    }
    __syncthreads();
}
constexpr int NWAVES = 8;
constexpr int N1P = 8448;
constexpr int RING_OFF = 0, RING_BYTES = 135168;
constexpr int LDSCTL_OFF = RING_BYTES, MISC_OFF = LDSCTL_OFF + 320;
constexpr int LDS_BYTES = 147456;
constexpr int CW_BAR = 4096;
static_assert(fa::F_LDS_BYTES <= RING_BYTES && fa::S_LDS_BYTES <= RING_BYTES && pg8::STAGE_BYTES <= RING_BYTES && MISC_OFF + 128 <= LDS_BYTES && (CW_BAR + XCD_BAR_WORDS) * 4 <= (int)WS_KMAX, "LDS / CTL map");

__device__ __forceinline__ void p0_transpose_item(const float* W, int K, int N, bf16* WT, LAS float* scr, int item, int lane, const float* gs) {
    const int nblk = N / 32, kb = item / nblk, nb = item % nblk, k0 = 64 * kb, n0 = 32 * nb;
    const int kr = lane >> 3, nc = 4 * (lane & 7);
    f32x4 wv[8];
#pragma unroll
    for (int i = 0; i < 8; ++i) wv[i] = *(const GAS f32x4*)(W + (size_t)(k0 + 8 * i + kr) * N + n0 + nc);
#pragma unroll
    for (int i = 0; i < 8; ++i) { const int kk = 8 * i + kr; f32x4 w = wv[i]; if (gs) w = w * gs[k0 + kk]; LAS float* d = scr + kk * 33 + nc; d[0] = w.x; d[1] = w.y; d[2] = w.z; d[3] = w.w; }
    LDS_WAIT(); asm volatile("" ::: "memory");
    const int c = lane & 7;
#pragma unroll
    for (int j = 0; j < 4; ++j) { const int n = (lane >> 3) + 8 * j; const LAS float* sp = scr + (8 * c) * 33 + n;
        v4u o; o.x = pk2(sp[0 * 33], sp[1 * 33]); o.y = pk2(sp[2 * 33], sp[3 * 33]); o.z = pk2(sp[4 * 33], sp[5 * 33]); o.w = pk2(sp[6 * 33], sp[7 * 33]);
        *(GAS v4u*)(WT + tiled_off(n0 + n, k0 + 8 * c)) = o; }
    LDS_WAIT(); asm volatile("" ::: "memory");
}
__device__ __forceinline__ float wave_sum(float v) {
#pragma unroll
    for (int o = 1; o < 64; o <<= 1) v += __shfl_xor(v, o);
    return v;
}

struct Args { const float* in[9]; float* out; unsigned char* ws; int ph_lo, ph_hi; };
constexpr int N_PHASES = 9;
__global__ void __launch_bounds__(NWAVES * 64, 2) mega_fwd(Args args) {
    extern __shared__ __attribute__((aligned(16))) unsigned char lds_raw[];
    LAS unsigned char* lds = (LAS unsigned char*)lds_raw;
    volatile LAS unsigned* MISC = (volatile LAS unsigned*)(lds + MISC_OFF);
    const int tid = threadIdx.x, lane = tid & 63, wave = __builtin_amdgcn_readfirstlane(tid >> 6);
    const int G = gridDim.x, bx = blockIdx.x, vcu = (G % 8 == 0) ? (bx % 8) * (G / 8) + bx / 8 : bx;
    unsigned char* ws = args.ws;
    const float* x = args.in[0]; const float* norm_g = args.in[1]; const float* fox_w_in = args.in[2]; const float* fox_b_f = args.in[3]; const float* fox_w_out = args.in[4];
    const float* swa_w_in = args.in[5]; const float* swa_sinks = args.in[6]; const float* swa_w_out = args.in[7]; const float* final_g = args.in[8];
    float* out = args.out;
    gu32* ctl = (gu32*)(ws + WS_CTL);
    unsigned* KMAX = (unsigned*)(ws + WS_KMAX); unsigned* TICKET = (unsigned*)(ws + WS_TICKET);
    float* SS1 = (float*)(ws + WS_SS1); float* R0 = (float*)(ws + WS_R0); float* ROPE = (float*)(ws + WS_ROPE); float* LOGF = (float*)(ws + WS_LOGF); float* CUM = (float*)(ws + WS_CUM);
    bf16* W1T = (bf16*)(ws + WS_W1T); bf16* W2T = (bf16*)(ws + WS_W2T); bf16* W3T = (bf16*)(ws + WS_W3T); bf16* W4T = (bf16*)(ws + WS_W4T);
    bf16* KAUG = (bf16*)(ws + WS_KAUG);
    bf16* XB = (bf16*)(ws + WS_XB); bf16* Qb = (bf16*)(ws + WS_Q); bf16* Kb = (bf16*)(ws + WS_K); bf16* Vb = (bf16*)(ws + WS_V); bf16* Gb = (bf16*)(ws + WS_G); bf16* YG = (bf16*)(ws + WS_YG);
    for (int u = tid; u < (LDS_BYTES - LDSCTL_OFF) / 4; u += NWAVES * 64) ((LAS unsigned*)(lds + LDSCTL_OFF))[u] = 0u;
    __syncthreads();
    const int lo = args.ph_lo, hi = args.ph_hi;
    XcdBarrier bar; bar.bar = (unsigned*)(ctl + CW_BAR); bar.x = 0; bar.st = nullptr;
    if (hi - lo > 1) bar = xcd_barrier_post((unsigned*)(ctl + CW_BAR), MISC + 8);
#define IN(k) (lo <= (k) && (k) < hi)
#define REP(k) for (int rep_ = 0; rep_ < (((DUP_MASK >> (k)) & 1) ? 2 : 1); ++rep_)
#define SEAM(k) do { if (IN(k) && IN((k) + 1)) xcd_barrier(bar); } while (0)
    const int gw = vcu * NWAVES + wave, NGW = G * NWAVES;

    if (IN(0)) REP(0) {
        LAS float* scr = (LAS float*)(lds + RING_OFF + wave * 16384);
        constexpr int I1 = (DM / 64) * (FOX_IN / 32), IZ = N1P - FOX_IN;
        constexpr int NITEMS = I1 + IZ;
        for (int it = gw; it < NITEMS; it += NGW) {
            int r = it;
            if (r < I1) { p0_transpose_item(fox_w_in, DM, FOX_IN, W1T, scr, r, lane, norm_g); continue; } r -= I1;
            { GAS v4u* zp = (GAS v4u*)(W1T + tiled_off(FOX_IN + r, (lane >> 1) * 64 + (lane & 1) * 32));
#pragma unroll
              for (int j = 0; j < 4; ++j) zp[j] = (v4u){0u, 0u, 0u, 0u}; }
        }
        for (int m = gw; m < MTOK; m += 2 * NGW) {
            const int m2 = m + NGW < MTOK ? m + NGW : m;
            const GAS f32x4* xr = (const GAS f32x4*)(x + (size_t)m * DM) + lane; const GAS f32x4* xr2 = (const GAS f32x4*)(x + (size_t)m2 * DM) + lane; f32x4 v[8], v2[8]; float s = 0.f, s2 = 0.f;
#pragma unroll
            for (int j = 0; j < 8; ++j) { v[j] = xr[64 * j]; v2[j] = xr2[64 * j]; }
#pragma unroll
            for (int j = 0; j < 8; ++j) { s += (v[j].x * v[j].x + v[j].y * v[j].y) + (v[j].z * v[j].z + v[j].w * v[j].w); s2 += (v2[j].x * v2[j].x + v2[j].y * v2[j].y) + (v2[j].z * v2[j].z + v2[j].w * v2[j].w); }
            s = wave_sum(s); s2 = wave_sum(s2);
            if (lane == 0) { R0[m] = 1.0f / sqrtf(s * (1.f / DM) + RMS_EPS); R0[m2] = 1.0f / sqrtf(s2 * (1.f / DM) + RMS_EPS); }
#pragma unroll
            for (int j = 0; j < 8; ++j) { *(GAS unsigned long long*)(XB + tiled_off(m, 256 * j + 4 * lane)) = (unsigned long long)pk2(v[j].x, v[j].y) | ((unsigned long long)pk2(v[j].z, v[j].w) << 32);
                                          *(GAS unsigned long long*)(XB + tiled_off(m2, 256 * j + 4 * lane)) = (unsigned long long)pk2(v2[j].x, v2[j].y) | ((unsigned long long)pk2(v2[j].z, v2[j].w) << 32); }
        }
        { const int gt = gw * 64 + lane;
          if (gt < SEQ * 8) { const int pos = gt >> 3, i = gt & 7;
              const double invf[8] = {1.0, 0.19390220519133497, 0.037598065178462524, 0.0072903477503833845, 0.0014142135623730951, 0.00027421912901204056, 5.3171693730649086e-05, 1.0310108130908796e-05};
              double inv = invf[0];
#pragma unroll
              for (int k = 1; k < 8; ++k) inv = (i == k) ? invf[k] : inv;
              const double ang = (double)pos * inv; const double kk = __builtin_rint(ang * 0.15915494309189535); const float red = (float)(ang - kk * 6.283185307179586);
              ROPE[(size_t)pos * 16 + i] = cosf(red); ROPE[(size_t)pos * 16 + 8 + i] = sinf(red); } }
    }
    SEAM(0);
    if (IN(1)) {
        pg8::Gemm g{XB, W1T, MTOK, N1P, DM}; pg8::StaticOrder S; S.init(MTOK, N1P, G, bx, (DUP_MASK >> 1) & 1, (DUP_MASK >> 9) & 1);
        pg8::EpiFoxIn E{Qb, Kb, Vb, Gb, LOGF, R0, fox_b_f};
        if ((DUP_MASK >> 10) & 1) { pg8::StaticOrder SP; SP.init(MTOK, N1P, G, bx, 0, 0, 1); pg8::gemm_phase<pg8::EpiFoxIn, pg8::StaticOrder, true, true>(lds + RING_OFF, g, SP, E); }
        pg8::gemm_phase<pg8::EpiFoxIn, pg8::StaticOrder, true, true>(lds + RING_OFF, g, S, E);
        { const int nwg = (MTOK / 256) * (N1P / 256), rem = nwg % G, nidle = rem ? G - rem : G, ii = rem ? bx - rem : bx;
          if (ii >= 0) { LAS float* scr = (LAS float*)(lds + RING_OFF + wave * 16384);
              constexpr int I2 = (DM / 64) * (DM / 32), I3 = (DM / 64) * (SWA_IN / 32);
              for (int it = ii * NWAVES + wave; it < I2 + I3 + I2; it += nidle * NWAVES) {
                  int r = it;
                  if (r < I2) { p0_transpose_item(fox_w_out, DM, DM, W2T, scr, r, lane, nullptr); continue; } r -= I2;
                  if (r < I3) { p0_transpose_item(swa_w_in, DM, SWA_IN, W3T, scr, r, lane, norm_g + DM); continue; } r -= I3;
                  p0_transpose_item(swa_w_out, DM, DM, W4T, scr, r, lane, nullptr); } } }
    }
    SEAM(1);
    if (IN(2)) REP(2) {
        for (int sq = vcu; sq < NB * NH; sq += G) {
            const GAS f32x4* lf = (const GAS f32x4*)(LOGF + (size_t)sq * SEQ + wave * 512) + lane * 2; const f32x4 v0 = lf[0], v1 = lf[1];
            const double tot = (((double)v0.x + (double)v0.y) + ((double)v0.z + (double)v0.w)) + (((double)v1.x + (double)v1.y) + ((double)v1.z + (double)v1.w));
            double incl = tot;
#pragma unroll
            for (int o = 1; o < 64; o <<= 1) { const double up = __shfl_up(incl, o); if (lane >= o) incl += up; }
            volatile LAS double* wt = (volatile LAS double*)(lds + RING_OFF);
            __syncthreads();
            if (lane == 63) wt[wave] = incl;
            __syncthreads();
            double run = incl - tot;
            for (int w2 = 0; w2 < wave; ++w2) run += wt[w2];
            const float vv[8] = {v0.x, v0.y, v0.z, v0.w, v1.x, v1.y, v1.z, v1.w}; float cv[8];
#pragma unroll
            for (int e = 0; e < 8; ++e) { run += (double)vv[e]; cv[e] = (float)(run * 1.4426950408889634); }
            GAS f32x4* co = (GAS f32x4*)(CUM + (size_t)sq * SEQ + wave * 512) + lane * 2; co[0] = (f32x4){cv[0], cv[1], cv[2], cv[3]}; co[1] = (f32x4){cv[4], cv[5], cv[6], cv[7]};
            GAS v4u* ka = (GAS v4u*)(KAUG + ((size_t)sq * SEQ + wave * 512 + lane * 8) * 8);
#pragma unroll
            for (int e = 0; e < 8; ++e) { unsigned h1, h2, h3; fa::split3(-cv[e], h1, h2, h3); ka[e] = (v4u){h1 | (h2 << 16), h3 | 0x3F800000u, 0x3F803F80u, 0u}; }
        }
        for (int bh = gw >> 4; bh < NB * NH; bh += NGW >> 4) {
            const GAS v4u* kp = (const GAS v4u*)(Kb + ((size_t)bh * SEQ + (gw & 15) * 256) * 64) + lane; float mx = 0.f;
            for (int it = 0; it < 32; ++it) { const v4u kv = kp[it * 64]; float ss = 0.f;
                const unsigned wv[4] = {kv.x, kv.y, kv.z, kv.w};
#pragma unroll
                for (int e = 0; e < 4; ++e) { const float a = __uint_as_float(wv[e] << 16), c = __uint_as_float(wv[e] & 0xffff0000u); ss = fmaf(a, a, ss); ss = fmaf(c, c, ss); }
                ss += __shfl_xor(ss, 1); ss += __shfl_xor(ss, 2); ss += __shfl_xor(ss, 4); mx = fmaxf(mx, ss); }
#pragma unroll
            for (int o = 8; o < 64; o <<= 1) mx = fmaxf(mx, __shfl_xor(mx, o));
            if (lane == 0) atomicMax(KMAX + bh, __float_as_uint(mx));
        }
    }
    SEAM(2);
    if (IN(3)) {
        const fa::Params P{Qb, Kb, Vb, Gb, YG, CUM, nullptr, KMAX, TICKET, KAUG};
        volatile LAS unsigned* slot = (volatile LAS unsigned*)(lds + RING_OFF + fa::F_FLAG + 128);
        if (tid == 0) slot[0] = atomicAdd(TICKET, 1u);
        __syncthreads();
        unsigned tk = slot[0]; int par = 0;
        while (tk < ((unsigned)(NB * NH * 16) << ((DUP_MASK >> 3) & 1))) {
            if (tid == 0) slot[par ^ 1] = atomicAdd(TICKET, 1u);
            const unsigned u = tk & (unsigned)(NB * NH * 16 - 1);
            const int bh = u & 127, qb = 15 - (int)(u >> 7);
            fa::fox_unit(lds + RING_OFF, P, bh >> 5, bh & 31, qb);
            par ^= 1; tk = slot[par];
        }
        __syncthreads();
    }
    SEAM(3);
    if (IN(4)) {
        pg8::Gemm g{YG, W2T, MTOK, DM, DM}; pg8::StaticOrder S; S.init(MTOK, DM, G, bx);
        pg8::EpiRes<true> E{x, XB, SS1};
        pg8::gemm_phase<pg8::EpiRes<true>, pg8::StaticOrder, true, true>(lds + RING_OFF, g, S, E);
    }
    SEAM(4);
    if (IN(5)) {
        pg8::Gemm g{XB, W3T, MTOK, SWA_IN, DM}; pg8::StaticOrder S; S.init(MTOK, SWA_IN, G, bx, (DUP_MASK >> 5) & 1);
        pg8::EpiSwaIn E{Qb, Kb, Vb, Gb, SS1, ROPE};
        pg8::gemm_phase<pg8::EpiSwaIn, pg8::StaticOrder, true, true>(lds + RING_OFF, g, S, E);
    }
    SEAM(5);
    if (IN(6)) REP(6) {
        const fa::Params P{Qb, Kb, Vb, Gb, YG, nullptr, swa_sinks, nullptr, nullptr, nullptr};
        for (int u = (G == 256 ? vcu : bx); u < NB * 4 * 16; u += G) fa::swa_unit(lds + RING_OFF, P, u >> 6, (u >> 4) & 3, u & 15);
    }
    SEAM(6);
    if (IN(7)) {
        pg8::Gemm g{YG, W4T, MTOK, DM, DM}; pg8::StaticOrder S; S.init(MTOK, DM, G, bx);
        pg8::EpiRes<false> E{nullptr, XB, nullptr};
        pg8::gemm_phase<pg8::EpiRes<false>, pg8::StaticOrder, true, true>(lds + RING_OFF, g, S, E);
    }
    SEAM(7);
    if (IN(8)) {
        f32x4 gq[8];
#pragma unroll
        for (int j = 0; j < 8; ++j) gq[j] = ((const GAS f32x4*)final_g)[lane + 64 * j];
        for (int m = gw; m < MTOK; m += NGW) {
            f32x4 v[8]; float s = 0.f;
#pragma unroll
            for (int j = 0; j < 8; ++j) { const unsigned long long xw = *(const GAS unsigned long long*)(XB + tiled_off(m, 256 * j + 4 * lane)); const unsigned lo32 = (unsigned)xw, hi32 = (unsigned)(xw >> 32);
                v[j] = (f32x4){__uint_as_float(lo32 << 16), __uint_as_float(lo32 & 0xffff0000u), __uint_as_float(hi32 << 16), __uint_as_float(hi32 & 0xffff0000u)};
                s += (v[j].x * v[j].x + v[j].y * v[j].y) + (v[j].z * v[j].z + v[j].w * v[j].w); }
            const float r = 1.0f / sqrtf(wave_sum(s) * (1.f / DM) + RMS_EPS);
            GAS f32x4* xr = (GAS f32x4*)(out + (size_t)m * DM) + lane;
#pragma unroll
            for (int j = 0; j < 8; ++j) xr[64 * j] = v[j] * r * gq[j];
        }
    }
#undef IN
#undef SEAM
}

extern "C" void kernel_launch(void* const* d_in, const int* in_sizes, int n_in, void* d_out, int out_size, void* d_ws, size_t ws_size, hipStream_t stream) {
    static int grid = 0;
    if (grid == 0) {
        if (n_in != 9 || in_sizes[0] != MTOK * DM || out_size != MTOK * DM || ws_size < WS_END) { fprintf(stderr, "kernel_launch: unexpected shapes (n_in %d, in0 %d, out %d, ws %zu)\n", n_in, n_in > 0 ? in_sizes[0] : -1, out_size, ws_size); grid = -1; return; }
        int dev = 0, cus = 0, per_cu = 0;
        if (hipGetDevice(&dev) != hipSuccess || hipDeviceGetAttribute(&cus, hipDeviceAttributeMultiprocessorCount, dev) != hipSuccess) { fprintf(stderr, "kernel_launch: device query failed\n"); grid = -1; return; }
        if (hipFuncSetAttribute((const void*)mega_fwd, hipFuncAttributeMaxDynamicSharedMemorySize, LDS_BYTES) != hipSuccess) { fprintf(stderr, "kernel_launch: hipFuncSetAttribute failed\n"); grid = -1; return; }
        if (hipOccupancyMaxActiveBlocksPerMultiprocessor(&per_cu, (const void*)mega_fwd, NWAVES * 64, LDS_BYTES) != hipSuccess || per_cu < 1) { fprintf(stderr, "kernel_launch: occupancy query reports %d workgroups per CU; nothing launched\n", per_cu); (void)hipGetLastError(); grid = -1; return; }
        grid = cus;
    }
    if (grid < 0) return;
    const float* x = (const float*)d_in[0]; const float* norm_g = (const float*)d_in[1]; const float* fox_w_in = (const float*)d_in[2]; const float* fox_b_f = (const float*)d_in[3];
    const float* fox_w_out = (const float*)d_in[4]; const float* swa_w_in = (const float*)d_in[5]; const float* swa_sinks = (const float*)d_in[6]; const float* swa_w_out = (const float*)d_in[7];
    const float* final_g = (const float*)d_in[8];
    float* out = (float*)d_out; unsigned char* ws = (unsigned char*)d_ws;
    float* SS1 = (float*)(ws + WS_SS1); float* R0 = (float*)(ws + WS_R0); float* LOGF = (float*)(ws + WS_LOGF); float* CUM = (float*)(ws + WS_CUM);
    bf16_t* XB = (bf16_t*)(ws + WS_XB); bf16_t* Q = (bf16_t*)(ws + WS_Q); bf16_t* K = (bf16_t*)(ws + WS_K); bf16_t* V = (bf16_t*)(ws + WS_V); bf16_t* Gt = (bf16_t*)(ws + WS_G); bf16_t* YG = (bf16_t*)(ws + WS_YG);
    (void)hipMemsetAsync(ws + WS_CTL, 0, CTL_ZERO_BYTES, stream);
    Args a{};
    for (int i = 0; i < 9; ++i) a.in[i] = (const float*)d_in[i];
    a.out = out; a.ws = ws;
    (void)x; (void)norm_g; (void)fox_w_in; (void)fox_b_f; (void)fox_w_out; (void)swa_w_in; (void)swa_sinks; (void)swa_w_out; (void)final_g; (void)SS1; (void)R0; (void)LOGF; (void)CUM; (void)XB; (void)Q; (void)K; (void)V; (void)Gt; (void)YG;
    int p = 0;
    while (p < N_PHASES) {
        if ((FAST_MASK >> p) & 1) {
            int e = p + 1; if (ONE_LAUNCH) while (e < N_PHASES && ((FAST_MASK >> e) & 1)) ++e;
            a.ph_lo = p; a.ph_hi = e;
            hipLaunchKernelGGL(mega_fwd, dim3(grid), dim3(NWAVES * 64), LDS_BYTES, stream, a);
            p = e; continue;
        }
#if FAST_MASK != 0x1FF
        switch (p) {
        case 0: n_rowrms<<<MTOK / 4, 256, 0, stream>>>(x, R0); break;
        case 1: n_gemm<float, NEpiFoxIn><<<dim3((FOX_IN + 63) / 64, MTOK / 64), 256, 0, stream>>>(x, DM, norm_g, fox_w_in, FOX_IN, DM, FOX_IN, NEpiFoxIn{Q, K, V, Gt, LOGF, R0, fox_b_f}); break;
        case 2: n_cumsum<<<2, 64, 0, stream>>>(LOGF, CUM); break;
        case 3: n_attn<0><<<dim3(SEQ / 256, NB * NH), 256, 0, stream>>>(Q, K, V, CUM, nullptr, Gt, YG); break;
        case 4: n_gemm<bf16_t, NEpiOut1><<<dim3(DM / 64, MTOK / 64), 256, 0, stream>>>(YG, DM, nullptr, fox_w_out, DM, DM, DM, NEpiOut1{x, out, XB, SS1}); break;
        case 5: n_gemm<float, NEpiSwaIn><<<dim3(SWA_IN / 64, MTOK / 64), 256, 0, stream>>>(out, DM, norm_g + DM, swa_w_in, SWA_IN, DM, SWA_IN, NEpiSwaIn{Q, K, V, Gt, SS1});
                n_rope<<<(MTOK * NH * 8 + 255) / 256, 256, 0, stream>>>(Q, DM, NH); n_rope<<<(MTOK * 4 * 8 + 255) / 256, 256, 0, stream>>>(K, KVW, 4); break;
        case 6: n_attn<1><<<dim3(SEQ / 256, NB * NH), 256, 0, stream>>>(Q, K, V, nullptr, swa_sinks, Gt, YG); break;
        case 7: n_gemm<bf16_t, NEpiOut2><<<dim3(DM / 64, MTOK / 64), 256, 0, stream>>>(YG, DM, nullptr, swa_w_out, DM, DM, DM, NEpiOut2{out}); break;
        case 8: n_finalnorm<<<MTOK / 4, 256, 0, stream>>>(out, final_g); break;
        }
#endif
        ++p;
    }
}
```

```cpp
#include <hip/hip_runtime.h>
#include <cstdio>
#include <cstdint>

constexpr int NB = 4, SEQ = 4096, DM = 2048, MTOK = NB * SEQ, NH = 32, HD = 64;
constexpr int FOX_IN = 8224, SWA_IN = 4608, KVW = 256;
constexpr float RMS_EPS = 1e-6f;
constexpr float LOG2E = 1.4426950408889634f;
constexpr float C2 = 0.125f * LOG2E;

typedef unsigned short bf16_t;
__device__ __forceinline__ float bf2f(bf16_t v) { return __uint_as_float((unsigned)v << 16); }
__device__ __forceinline__ bf16_t f2bf(float f) { unsigned u = __float_as_uint(f); return (bf16_t)((u + 0x7fffu + ((u >> 16) & 1u)) >> 16); }
__device__ __forceinline__ float logsigmoidf(float z) { return z < 0.f ? z - log1pf(expf(z)) : -log1pf(expf(-z)); }
__device__ __forceinline__ float siluf(float g) { return g / (1.f + expf(-g)); }

__host__ __device__ __forceinline__ size_t tiled_off(int row, int k) { return ((size_t)((row >> 8) * (DM / 64) + (k >> 6)) << 14) + (size_t)(((row & 255) << 6) + (k & 63)); }

__host__ __device__ __forceinline__ size_t hm_off(int row  , int col  , int nheads) { return ((size_t)((row >> 12) * nheads + (col >> 6)) * SEQ + (row & 4095)) * 64 + (col & 63); }

constexpr size_t MiB = 1u << 20;
constexpr size_t WS_CTL = 0, CTL_ZERO_BYTES = 1 * MiB;
constexpr size_t WS_KMAX = 64 * 1024, WS_TICKET = 66 * 1024;
constexpr size_t WS_SS1 = 512 * 1024;
constexpr size_t WS_R0 = 1 * MiB;
constexpr size_t WS_ROPE = 1 * MiB + 512 * 1024;
constexpr size_t WS_LOGF = 2 * MiB;
constexpr size_t WS_CUM = 4 * MiB;
constexpr size_t WS_W1T = 8 * MiB, WS_W2T = 41 * MiB, WS_W3T = 49 * MiB, WS_W4T = 67 * MiB;
constexpr size_t WS_XB = 76 * MiB, WS_Q = 140 * MiB, WS_K = 204 * MiB, WS_V = 268 * MiB, WS_G = 332 * MiB, WS_YG = 396 * MiB, WS_KAUG = 460 * MiB, WS_END = 468 * MiB;

#ifndef FAST_MASK
#define FAST_MASK 0x1FF
#endif
#ifndef DUP_MASK
#define DUP_MASK 0x000
#endif
#ifndef ONE_LAUNCH
#define ONE_LAUNCH 1
#endif
#if FAST_MASK != 0x1FF
__global__ __launch_bounds__(256) void n_rowrms(const float* x, float* R) {
    const int row = blockIdx.x * 4 + (threadIdx.x >> 6), lane = threadIdx.x & 63;
    const float* xr = x + (size_t)row * DM; float s = 0.f;
    for (int i = lane; i < DM; i += 64) { const float v = xr[i]; s += v * v; }
#pragma unroll
    for (int o = 1; o < 64; o <<= 1) s += __shfl_xor(s, o);
    if (lane == 0) R[row] = 1.0f / sqrtf(s * (1.f / DM) + RMS_EPS);
}
__device__ __forceinline__ float toF(float v) { return v; }
__device__ __forceinline__ float toF(bf16_t v) { return bf2f(v); }

template <class AT, class Epi>
__global__ __launch_bounds__(256) void n_gemm(const AT* A, int lda, const float* kscale, const float* W, int ldw, int Kd, int N, Epi epi) {
    __shared__ float As[16][68]; __shared__ float Bs[16][68];
    const int tx = threadIdx.x & 15, ty = threadIdx.x >> 4;
    const int row0 = blockIdx.y * 64, col0 = blockIdx.x * 64;
    float acc[4][4];
#pragma unroll
    for (int i = 0; i < 4; ++i)
#pragma unroll
        for (int j = 0; j < 4; ++j) acc[i][j] = 0.f;
    for (int k0 = 0; k0 < Kd; k0 += 16) {
        for (int i = threadIdx.x; i < 1024; i += 256) { const int r = i >> 4, kk = i & 15; float a = toF(A[(size_t)(row0 + r) * lda + k0 + kk]); if (kscale) a *= kscale[k0 + kk]; As[kk][r] = a; }
        for (int i = threadIdx.x; i < 1024; i += 256) { const int kk = i >> 6, c = i & 63, col = col0 + c; Bs[kk][c] = col < N ? W[(size_t)(k0 + kk) * ldw + col] : 0.f; }
        __syncthreads();
#pragma unroll
        for (int kk = 0; kk < 16; ++kk) {
            const float4 a = *(const float4*)&As[kk][ty * 4]; const float4 b = *(const float4*)&Bs[kk][tx * 4];
            const float av[4] = {a.x, a.y, a.z, a.w}, bv[4] = {b.x, b.y, b.z, b.w};
#pragma unroll
            for (int i = 0; i < 4; ++i)
#pragma unroll
                for (int j = 0; j < 4; ++j) acc[i][j] = fmaf(av[i], bv[j], acc[i][j]);
        }
        __syncthreads();
    }
#pragma unroll
    for (int i = 0; i < 4; ++i)
#pragma unroll
        for (int j = 0; j < 4; ++j) { const int row = row0 + ty * 4 + i, col = col0 + tx * 4 + j; if (col < N) epi(row, col, acc[i][j]); }
}
struct NEpiFoxIn {
    bf16_t *Q, *K, *V, *G; float* LOGF; const float* R0; const float* bfb;
    __device__ void operator()(int row, int col, float v) const {
        v *= R0[row];
        if (col < 2048) Q[(size_t)row * DM + col] = f2bf(v * C2);
        else if (col < 4096) K[(size_t)row * DM + col - 2048] = f2bf(v);
        else if (col < 6144) V[(size_t)row * DM + col - 4096] = f2bf(v);
        else if (col < 8192) G[(size_t)row * DM + col - 6144] = f2bf(siluf(v));
        else { const int h = col - 8192, b = row >> 12, s = row & 4095; LOGF[((size_t)(b * NH + h) << 12) + s] = logsigmoidf(v + bfb[h]); }
    }
};
struct NEpiOut1 {
    const float* xin; float* xout; bf16_t* XB; float* SS;
    __device__ void operator()(int row, int col, float v) const {
        const size_t o = (size_t)row * DM + col; const float x1 = xin[o] + v; xout[o] = x1; XB[o] = f2bf(x1); atomicAdd(&SS[row], x1 * x1);
    }
};
struct NEpiSwaIn {
    bf16_t *Q, *K, *V, *G; const float* SS;
    __device__ void operator()(int row, int col, float v) const {
        v *= 1.0f / sqrtf(SS[row] * (1.f / DM) + RMS_EPS);
        if (col < 2048) Q[(size_t)row * DM + col] = f2bf(v * C2);
        else if (col < 2304) K[(size_t)row * KVW + col - 2048] = f2bf(v);
        else if (col < 2560) V[(size_t)row * KVW + col - 2304] = f2bf(v);
        else G[(size_t)row * DM + col - 2560] = f2bf(siluf(v));
    }
};
struct NEpiOut2 { float* xio; __device__ void operator()(int row, int col, float v) const { const size_t o = (size_t)row * DM + col; xio[o] = xio[o] + v; } };

__global__ void n_rope(bf16_t* T, int pitch, int nheads) {
    const long idx = (long)blockIdx.x * blockDim.x + threadIdx.x; const long total = (long)MTOK * nheads * 8; if (idx >= total) return;
    const int i = idx & 7; const long rh = idx >> 3; const int hh = rh % nheads; const long row = rh / nheads; const int pos = row & 4095;
    const double inv = pow(500000.0, -(double)i / 8.0); const float ang = (float)pos * (float)inv;
    const float c = cosf(ang), s = sinf(ang);
    bf16_t* p = T + (size_t)row * pitch + hh * 64 + i; const float x1 = bf2f(p[0]), x2 = bf2f(p[8]);
    p[0] = f2bf(x1 * c - x2 * s); p[8] = f2bf(x2 * c + x1 * s);
}
__global__ void n_cumsum(const float* LOGF, float* CUM) {
    const int sidx = blockIdx.x * blockDim.x + threadIdx.x; if (sidx >= NB * NH) return;
    const float* lf = LOGF + (size_t)sidx * SEQ; float* c = CUM + (size_t)sidx * SEQ; double a = 0.0;
    for (int s = 0; s < SEQ; ++s) { a += (double)lf[s]; c[s] = (float)(a * 1.4426950408889634); }
}
template <int MODE>
__global__ __launch_bounds__(256) void n_attn(const bf16_t* Q, const bf16_t* K, const bf16_t* V, const float* CUM, const float* sinks, const bf16_t* G, bf16_t* YG) {
    __shared__ float Ks[64][64]; __shared__ float Vs[64][64]; __shared__ float Cs[64];
    const int qb = blockIdx.x, bh = blockIdx.y, b = bh / NH, h = bh % NH, tid = threadIdx.x;
    const int t = qb * 256 + tid; const size_t row = (size_t)b * SEQ + t;
    const int kvh = MODE == 0 ? h : (h >> 3), kp = MODE == 0 ? DM : KVW;
    float q[64], o[64];
#pragma unroll
    for (int d = 0; d < 64; ++d) { q[d] = bf2f(Q[row * DM + h * 64 + d]); o[d] = 0.f; }
    const float ct = MODE == 0 ? CUM[(size_t)bh * SEQ + t] : 0.f;
    float m = MODE == 0 ? -1e30f : sinks[h] * LOG2E, l = MODE == 0 ? 0.f : 1.f;
    const int kstart = MODE == 0 ? 0 : (qb * 256 >= 128 ? qb * 256 - 128 : 0), kend = qb * 256 + 256;
    for (int k0 = kstart; k0 < kend; k0 += 64) {
        for (int i = tid; i < 4096; i += 256) { const int kk = i >> 6, d = i & 63; const size_t a = ((size_t)b * SEQ + k0 + kk) * kp + kvh * 64 + d; Ks[kk][d] = bf2f(K[a]); Vs[kk][d] = bf2f(V[a]); }
        if (MODE == 0 && tid < 64) Cs[tid] = CUM[(size_t)bh * SEQ + k0 + tid];
        __syncthreads();
        for (int kk = 0; kk < 64; ++kk) {
            const int s = k0 + kk; float sd = 0.f;
#pragma unroll
            for (int d = 0; d < 64; ++d) sd = fmaf(q[d], Ks[kk][d], sd);
            if (MODE == 0) sd += ct - Cs[kk];
            const bool ok = MODE == 0 ? (s <= t) : (s <= t && t - s < 128);
            if (!ok) sd = -INFINITY;
            const float mn = fmaxf(m, sd), a = exp2f(m - mn), p = exp2f(sd - mn);
            l = l * a + p;
#pragma unroll
            for (int d = 0; d < 64; ++d) o[d] = fmaf(p, Vs[kk][d], o[d] * a);
            m = mn;
        }
        __syncthreads();
    }
    const float rl = 1.f / l;
#pragma unroll
    for (int d = 0; d < 64; ++d) { const size_t a = row * DM + h * 64 + d; YG[a] = f2bf(o[d] * rl * bf2f(G[a])); }
}
__global__ __launch_bounds__(256) void n_finalnorm(float* xio, const float* g) {
    const int row = blockIdx.x * 4 + (threadIdx.x >> 6), lane = threadIdx.x & 63;
    float* xr = xio + (size_t)row * DM; float s = 0.f;
    for (int i = lane; i < DM; i += 64) { const float v = xr[i]; s += v * v; }
#pragma unroll
    for (int o = 1; o < 64; o <<= 1) s += __shfl_xor(s, o);
    const float r = 1.0f / sqrtf(s * (1.f / DM) + RMS_EPS);
    for (int i = lane; i < DM; i += 64) xr[i] = xr[i] * r * g[i];
}

#endif
namespace pg8 {
#define PG8_LAS __attribute__((address_space(3)))
typedef unsigned short bf16_t;
typedef short bf16x8 __attribute__((ext_vector_type(8)));
typedef float f32x4 __attribute__((ext_vector_type(4)));
typedef unsigned u32x4 __attribute__((ext_vector_type(4)));
constexpr int BM = 256, BK = 64, HALF = 128, HTB = HALF * BK * 2  , STAGE_BYTES = 8 * HTB, NXCD = 8, WGM = 8;

__host__ __device__ __forceinline__ int lds_byte(int r, int c) { const int st = (r >> 4) * 2 + (c >> 5), rr = r & 15, cc = c & 31, ob = rr * 64 + cc * 2; return st * 1024 + (ob ^ (((ob >> 9) & 1) << 5)); }
__host__ __device__ __forceinline__ void stage_rc(int b, int& R, int& C) { const int st = b / 1024, sb = b % 1024, swz = sb ^ (((sb >> 9) & 1) << 5); R = (st >> 1) * 16 + swz / 64; C = (st & 1) * 32 + (swz % 64) / 2; }
__host__ __device__ __forceinline__ int perm32(int rho) { const int n = rho >> 4, i = rho & 15; return 8 * (i >> 2) + 4 * n + (i & 3); }

struct Unit { int pm, pn, lm, ln; };
struct Gemm { const bf16_t* A; const bf16_t* Bt; int M, N, K; };

struct StaticOrder {
    int nM, nN, nwg, G, c, dup, epi2, same;
    __host__ __device__ void init(int M, int N, int G_, int c_, int dup_ = 0, int epi2_ = 0, int same_ = 0) { nM = M / BM; nN = N / BM; nwg = nM * nN; G = G_; c = c_; dup = dup_; epi2 = epi2_; same = same_; }
    __host__ __device__ bool next(int i, Unit& u) const {
        if (dup) i >>= 1;
        const long L = (long)i * G + c; if (L >= nwg) return false;
        int wgid = (int)L; { const int q = nwg / NXCD, r = nwg % NXCD, xcd = wgid % NXCD, off = wgid / NXCD; wgid = (xcd < r ? xcd * (q + 1) : r * (q + 1) + (xcd - r) * q) + off; }
        const int nig = WGM * nN, gid = wgid / nig, fm = gid * WGM, gsz = (nM - fm) < WGM ? (nM - fm) : WGM;
        u.pm = fm + ((wgid % nig) % gsz); u.pn = (wgid % nig) / gsz; u.lm = same ? 0 : u.pm; u.ln = same ? 0 : u.pn; return true;
    }
    __device__ __forceinline__ void a_ready(const Unit&) const {}
    __device__ __forceinline__ void done(const Unit&) const {}
};

__device__ __forceinline__ unsigned cvt_pk_bf16(float lo, float hi) { unsigned r; asm volatile("v_cvt_pk_bf16_f32 %0, %1, %2" : "=v"(r) : "v"(lo), "v"(hi)); return r; }
__device__ __forceinline__ float silu_fast(float g) { return g * __builtin_amdgcn_rcpf(1.0f + __builtin_amdgcn_exp2f(-g * 1.4426950408889634f)); }
__device__ __forceinline__ u32x4 pack8(const f32x4 v0, const f32x4 v1) { u32x4 w; w.x = cvt_pk_bf16(v0[0], v0[1]); w.y = cvt_pk_bf16(v0[2], v0[3]); w.z = cvt_pk_bf16(v1[0], v1[1]); w.w = cvt_pk_bf16(v1[2], v1[3]); return w; }
struct EpiFoxIn {
    static constexpr bool PERM = true, AFTER_DRAIN = false;
    bf16_t *Q, *K, *V, *G; float* LOGF; const float* R0; const float* bfb; unsigned* KMAX;
    __device__ __forceinline__ void operator()(const f32x4 (&acc)[2][2][4][2], const Unit& u, int wr, int wc, int fr, int fq) const {
        const int row0 = u.pm * BM + wr * 64 + fr, pn = u.pn;
        float rs[2][4];
#pragma unroll
        for (int ai = 0; ai < 2; ++ai)
#pragma unroll
            for (int m = 0; m < 4; ++m) rs[ai][m] = R0[row0 + ai * HALF + m * 16];
        if (pn < 32) {
            const int reg = pn >> 3; bf16_t* base = reg == 0 ? Q : reg == 1 ? K : reg == 2 ? V : G; float kmx[2] = {0.f, 0.f};
            const int col0 = (pn & 7) * BM + wc * 32 + 8 * fq;
#pragma unroll
            for (int ai = 0; ai < 2; ++ai)
#pragma unroll
                for (int m = 0; m < 4; ++m) { const int row = row0 + ai * HALF + m * 16; const float r = rs[ai][m]; const float sc = reg == 0 ? r * C2 : r;
#pragma unroll
                    for (int bj = 0; bj < 2; ++bj) { f32x4 v0 = acc[ai][bj][m][0] * sc, v1 = acc[ai][bj][m][1] * sc;
                        if (reg == 3) {
#pragma unroll
                            for (int j = 0; j < 4; ++j) { v0[j] = silu_fast(v0[j]); v1[j] = silu_fast(v1[j]); } }
                        if (reg == 1) { float ss = ((v0[0] * v0[0] + v0[1] * v0[1]) + (v0[2] * v0[2] + v0[3] * v0[3])) + ((v1[0] * v1[0] + v1[1] * v1[1]) + (v1[2] * v1[2] + v1[3] * v1[3]));
                            ss += __shfl_xor(ss, 16); ss += __shfl_xor(ss, 32); kmx[bj] = fmaxf(kmx[bj], ss); }
                        __builtin_nontemporal_store(pack8(v0, v1), (u32x4*)(base + hm_off(row, col0 + bj * HALF, NH))); } }
            if (reg == 1) {
#pragma unroll
                for (int bj = 0; bj < 2; ++bj) { float mx = kmx[bj];
#pragma unroll
                    for (int o = 1; o < 16; o <<= 1) mx = fmaxf(mx, __shfl_xor(mx, o));
                    if (fr == 0 && fq == 0) atomicMax(KMAX + ((row0 >> 12) * NH + (pn & 7) * 4 + bj * 2 + (wc >> 1)) * 2 + (wc & 1), __float_as_uint(mx)); } }
        } else if (wc == 0) {
#pragma unroll
            for (int ai = 0; ai < 2; ++ai)
#pragma unroll
                for (int m = 0; m < 4; ++m) { const int row = row0 + ai * HALF + m * 16; const float r = rs[ai][m]; const int b = row >> 12, s = row & 4095;
#pragma unroll
                    for (int n = 0; n < 2; ++n)
#pragma unroll
                        for (int j = 0; j < 4; ++j) { const int h = 8 * fq + 4 * n + j; LOGF[((size_t)(b * NH + h) << 12) + s] = logsigmoidf(acc[ai][0][m][n][j] * r + bfb[h]); } }
        }
    }
};
struct EpiSwaIn {
    static constexpr bool PERM = true, AFTER_DRAIN = false;
    bf16_t *Q, *K, *V, *G; const float* SS; const float* ROPE;
    __device__ __forceinline__ void operator()(const f32x4 (&acc)[2][2][4][2], const Unit& u, int wr, int wc, int fr, int fq) const {
        const int row0 = u.pm * BM + wr * 64 + fr, pn = u.pn;
        bf16_t* base; int pitch, colt; float osc = 1.f; const bool rope = pn <= 8, gate = pn >= 10;
        if (pn < 8) { base = Q; pitch = DM; colt = pn * BM; osc = C2; } else if (pn == 8) { base = K; pitch = KVW; colt = 0; } else if (pn == 9) { base = V; pitch = KVW; colt = 0; } else { base = G; pitch = DM; colt = (pn - 10) * BM; }
        const int col0 = colt + wc * 32 + 8 * fq; const bool rotw = rope && ((wc & 1) == 0); const float sgn = fq == 0 ? -1.f : 1.f; const bool rotl = fq < 2;
        float rs[2][4];
#pragma unroll
        for (int ai = 0; ai < 2; ++ai)
#pragma unroll
            for (int m = 0; m < 4; ++m) rs[ai][m] = SS[row0 + ai * HALF + m * 16];
        f32x4 nc0, nc1, ns0, ns1;
        if (rotw) { const float* rp = ROPE + (size_t)(row0 & 4095) * 16; nc0 = *(const f32x4*)rp; nc1 = *(const f32x4*)(rp + 4); ns0 = *(const f32x4*)(rp + 8); ns1 = *(const f32x4*)(rp + 12); }
#pragma unroll
        for (int ai = 0; ai < 2; ++ai)
#pragma unroll
            for (int m = 0; m < 4; ++m) { const int row = row0 + ai * HALF + m * 16; const float r = 1.0f / sqrtf(rs[ai][m] * (1.f / DM) + RMS_EPS);
                const f32x4 c0 = nc0, c1 = nc1, s0 = ns0, s1 = ns1;
                if (rotw && (ai * 4 + m) < 7) { const int nrow = row0 + ((ai * 4 + m + 1) >> 2) * HALF + ((ai * 4 + m + 1) & 3) * 16; const float* rp = ROPE + (size_t)(nrow & 4095) * 16; nc0 = *(const f32x4*)rp; nc1 = *(const f32x4*)(rp + 4); ns0 = *(const f32x4*)(rp + 8); ns1 = *(const f32x4*)(rp + 12); }
#pragma unroll
                for (int bj = 0; bj < 2; ++bj) { f32x4 v0 = acc[ai][bj][m][0] * r, v1 = acc[ai][bj][m][1] * r;
                    if (rotw) {
#pragma unroll
                        for (int j = 0; j < 4; ++j) { const float p0 = __shfl_xor(v0[j], 16), p1 = __shfl_xor(v1[j], 16);
                            const float n0 = v0[j] * c0[j] + sgn * p0 * s0[j], n1 = v1[j] * c1[j] + sgn * p1 * s1[j];
                            v0[j] = rotl ? n0 : v0[j]; v1[j] = rotl ? n1 : v1[j]; } }
                    if (gate) {
#pragma unroll
                        for (int j = 0; j < 4; ++j) { v0[j] = silu_fast(v0[j]); v1[j] = silu_fast(v1[j]); } }
                    v0 = v0 * osc; v1 = v1 * osc;
                    *(u32x4*)(base + hm_off(row, col0 + bj * HALF, pitch >> 6)) = pack8(v0, v1); } }
    }
};
template <bool FIRST> struct EpiRes {
    static constexpr bool PERM = false, AFTER_DRAIN = false;
    const float* xin; bf16_t* XB; float* SS;
    __device__ __forceinline__ void operator()(const f32x4 (&acc)[2][2][4][2], const Unit& u, int wr, int wc, int fr, int fq) const {
        typedef unsigned u32x2v __attribute__((ext_vector_type(2)));
        const int row0 = u.pm * BM + wr * 64 + fr, col0 = u.pn * BM + wc * 32 + 4 * fq;
        if (FIRST) {
            f32x4 nx[2][2];
#pragma unroll
            for (int bj = 0; bj < 2; ++bj)
#pragma unroll
                for (int n = 0; n < 2; ++n) nx[bj][n] = *(const f32x4*)(xin + (size_t)row0 * DM + col0 + bj * HALF + n * 16);
#pragma unroll
            for (int ai = 0; ai < 2; ++ai)
#pragma unroll
                for (int m = 0; m < 4; ++m) { const int row = row0 + ai * HALF + m * 16; float ss = 0.f;
                    f32x4 cx[2][2];
#pragma unroll
                    for (int bj = 0; bj < 2; ++bj)
#pragma unroll
                        for (int n = 0; n < 2; ++n) cx[bj][n] = nx[bj][n];
                    if ((ai * 4 + m) < 7) { const int nrow = row0 + ((ai * 4 + m + 1) >> 2) * HALF + ((ai * 4 + m + 1) & 3) * 16;
#pragma unroll
                        for (int bj = 0; bj < 2; ++bj)
#pragma unroll
                            for (int n = 0; n < 2; ++n) nx[bj][n] = *(const f32x4*)(xin + (size_t)nrow * DM + col0 + bj * HALF + n * 16); }
#pragma unroll
                    for (int bj = 0; bj < 2; ++bj)
#pragma unroll
                        for (int n = 0; n < 2; ++n) { const f32x4 x1 = cx[bj][n] + acc[ai][bj][m][n];
                            u32x2v w; w.x = cvt_pk_bf16(x1[0], x1[1]); w.y = cvt_pk_bf16(x1[2], x1[3]); *(u32x2v*)(XB + tiled_off(row, col0 + bj * HALF + n * 16)) = w;
                            ss += (x1[0] * x1[0] + x1[1] * x1[1]) + (x1[2] * x1[2] + x1[3] * x1[3]); }
                    ss += __shfl_xor(ss, 16); ss += __shfl_xor(ss, 32); if (fq == 0) atomicAdd(SS + row, ss); }
        } else {
            u32x2v xv[2][4][2][2];
#pragma unroll
            for (int ai = 0; ai < 2; ++ai)
#pragma unroll
                for (int m = 0; m < 4; ++m)
#pragma unroll
                    for (int bj = 0; bj < 2; ++bj)
#pragma unroll
                        for (int n = 0; n < 2; ++n) xv[ai][m][bj][n] = *(const u32x2v*)(XB + tiled_off(row0 + ai * HALF + m * 16, col0 + bj * HALF + n * 16));
#pragma unroll
            for (int ai = 0; ai < 2; ++ai)
#pragma unroll
                for (int m = 0; m < 4; ++m)
#pragma unroll
                    for (int bj = 0; bj < 2; ++bj)
#pragma unroll
                        for (int n = 0; n < 2; ++n) { const u32x2v xw = xv[ai][m][bj][n]; const f32x4 a = acc[ai][bj][m][n];
                            u32x2v w; w.x = cvt_pk_bf16(__uint_as_float(xw.x << 16) + a[0], __uint_as_float(xw.x & 0xffff0000u) + a[1]); w.y = cvt_pk_bf16(__uint_as_float(xw.y << 16) + a[2], __uint_as_float(xw.y & 0xffff0000u) + a[3]);
                            *(u32x2v*)(XB + tiled_off(row0 + ai * HALF + m * 16, col0 + bj * HALF + n * 16)) = w; }
        }
    }
};
template <class Epi, class Sched, bool ALIGN_EPI = false, bool SP2 = false>
__device__ __forceinline__ void gemm_phase(PG8_LAS unsigned char* lds, const Gemm g, const Sched& S, const Epi& E) {
    const int tid = threadIdx.x, wid = __builtin_amdgcn_readfirstlane(tid >> 6), lane = tid & 63, wr = wid >> 2, wc = wid & 3, fr = lane & 15, fq = lane >> 4;
    const int K = g.K, nt = K / BK;
    unsigned voffA[2], voffB[2];
#pragma unroll
    for (int i = 0; i < 2; ++i) { int R, C; stage_rc(tid * 16 + i * 8192, R, C); const int Rb = Epi::PERM ? ((R & ~31) + perm32(R & 31)) : R;
        voffA[i] = (unsigned)(R * BK + C) * 2u; voffB[i] = (unsigned)(Rb * BK + C) * 2u; }
    const size_t kstep = (size_t)(BM * BK * 2);
    const size_t hstep = (size_t)(HALF * BK * 2);
    const size_t tstep = (size_t)BM * K * 2;
    const unsigned ldsw = (unsigned)wid * 1024u;
    const int aoff = lds_byte(wr * 64 + fr, fq * 8), boff = lds_byte(wc * 32 + fr, fq * 8);
#define PG8_SA(b, h) (((b) * 2 + (h)) * HTB)
#define PG8_SB(b, h) ((4 + (b) * 2 + (h)) * HTB)
#define PG8_STAGE(bufoff, gbase, voff) do { _Pragma("unroll") for (int _i = 0; _i < 2; ++_i) \
        __builtin_amdgcn_global_load_lds((const unsigned*)((const char*)(gbase) + (voff)[_i]), (PG8_LAS unsigned*)(lds + (bufoff) + ldsw + _i * 8192), 16, 0, 0); } while (0)
#define PG8_LDA(dst, b, h) do { _Pragma("unroll") for (int m = 0; m < 4; ++m) _Pragma("unroll") for (int k = 0; k < 2; ++k) dst[m][k] = *(const PG8_LAS bf16x8*)(lds + PG8_SA(b, h) + aoff + m * 2048 + k * 1024); } while (0)
#define PG8_LDB(dst, b, h) do { _Pragma("unroll") for (int n = 0; n < 2; ++n) _Pragma("unroll") for (int k = 0; k < 2; ++k) dst[n][k] = *(const PG8_LAS bf16x8*)(lds + PG8_SB(b, h) + boff + n * 2048 + k * 1024); } while (0)
#define PG8_MMA(ai, bj, At, Bt) do { __builtin_amdgcn_s_setprio(1); _Pragma("unroll") for (int m = 0; m < 4; ++m) _Pragma("unroll") for (int n = 0; n < 2; ++n) _Pragma("unroll") for (int k = 0; k < 2; ++k) \
        acc[ai][bj][m][n] = __builtin_amdgcn_mfma_f32_16x16x32_bf16(Bt[n][k], At[m][k], acc[ai][bj][m][n], 0, 0, 0); __builtin_amdgcn_s_setprio(0); } while (0)
#define PG8_WAIT_V(n) asm volatile("s_waitcnt vmcnt(" #n ")" ::: "memory")
#define PG8_WAIT_L(n) asm volatile("s_waitcnt lgkmcnt(" #n ")" ::: "memory")
#define PG8_BAR __builtin_amdgcn_s_barrier()
#define PG8_SCHED __builtin_amdgcn_sched_barrier(0)
    Unit cur, nxt; int ui = 0;
    if (!S.next(0, cur)) return;
    f32x4 acc[2][2][4][2];
#pragma unroll
    for (int a = 0; a < 2; ++a)
#pragma unroll
        for (int b = 0; b < 2; ++b)
#pragma unroll
            for (int m = 0; m < 4; ++m)
#pragma unroll
                for (int n = 0; n < 2; ++n) acc[a][b][m][n] = (f32x4){0.f, 0.f, 0.f, 0.f};
    bf16x8 At[4][2], B0[2][2], B1[2][2];
    const char* cA = (const char*)g.A + (size_t)cur.lm * tstep; const char* cB = (const char*)g.Bt + (size_t)cur.ln * tstep;
    S.a_ready(cur);
    if constexpr (SP2) {
        PG8_STAGE(PG8_SB(0, 0), cB, voffB); PG8_STAGE(PG8_SB(0, 1), cB + hstep, voffB); PG8_STAGE(PG8_SA(0, 0), cA, voffA); PG8_STAGE(PG8_SA(0, 1), cA + hstep, voffA);
        if (wr == 1) PG8_BAR;
        PG8_WAIT_V(2); PG8_BAR;
        PG8_STAGE(PG8_SB(1, 0), cB + kstep, voffB); PG8_STAGE(PG8_SA(1, 0), cA + kstep, voffA); PG8_STAGE(PG8_SB(1, 1), cB + hstep + kstep, voffB);
        PG8_WAIT_V(6); PG8_BAR;
    } else {
        PG8_STAGE(PG8_SB(0, 0), cB, voffB); PG8_STAGE(PG8_SA(0, 0), cA, voffA); PG8_STAGE(PG8_SB(0, 1), cB + hstep, voffB); PG8_STAGE(PG8_SA(0, 1), cA + hstep, voffA);
        if (wr == 1) PG8_BAR;
        PG8_WAIT_V(4); PG8_BAR;
        PG8_STAGE(PG8_SB(1, 0), cB + kstep, voffB); PG8_STAGE(PG8_SA(1, 0), cA + kstep, voffA); PG8_STAGE(PG8_SB(1, 1), cB + hstep + kstep, voffB);
        PG8_WAIT_V(6); PG8_BAR;
    }
    for (;;) {
        const bool has_next = S.next(ui + 1, nxt);
        const char* nA = has_next ? (const char*)g.A + (size_t)nxt.lm * tstep : cA; const char* nB = has_next ? (const char*)g.Bt + (size_t)nxt.ln * tstep : cB;
        for (int t = 0; t < nt; t += 2) {
            const bool last = (t == nt - 2);
            const char* a1 = cA + (size_t)(t + 1) * kstep;
            const char* a2 = last ? nA : cA + (size_t)(t + 2) * kstep; const char* b2 = last ? nB : cB + (size_t)(t + 2) * kstep;
            const char* a3 = a2 + kstep; const char* b3 = b2 + kstep;
            if (last && has_next) S.a_ready(nxt);
            if constexpr (SP2) {
            PG8_LDB(B0, 0, 0); PG8_LDB(B1, 0, 1); PG8_SCHED; PG8_LDA(At, 0, 0); PG8_STAGE(PG8_SA(1, 1), a1 + hstep, voffA);
            PG8_WAIT_V(8); PG8_WAIT_L(0); PG8_BAR; PG8_MMA(0, 0, At, B0); PG8_MMA(0, 1, At, B1); PG8_BAR; PG8_SCHED;
            PG8_LDA(At, 0, 1); PG8_STAGE(PG8_SB(0, 0), b2, voffB); PG8_STAGE(PG8_SB(0, 1), b2 + hstep, voffB); PG8_STAGE(PG8_SA(0, 0), a2, voffA);
            PG8_WAIT_V(8); PG8_WAIT_L(0); PG8_BAR; PG8_MMA(1, 0, At, B0); PG8_MMA(1, 1, At, B1); PG8_BAR; PG8_SCHED;
            PG8_LDB(B0, 1, 0); PG8_LDB(B1, 1, 1); PG8_SCHED; PG8_LDA(At, 1, 0); PG8_STAGE(PG8_SA(0, 1), a2 + hstep, voffA);
            PG8_WAIT_V(8); PG8_WAIT_L(0); PG8_BAR; PG8_MMA(0, 0, At, B0); PG8_MMA(0, 1, At, B1); PG8_BAR; PG8_SCHED;
            PG8_LDA(At, 1, 1); PG8_STAGE(PG8_SB(1, 0), b3, voffB); PG8_STAGE(PG8_SB(1, 1), b3 + hstep, voffB); PG8_STAGE(PG8_SA(1, 0), a3, voffA);
            PG8_WAIT_V(8); PG8_WAIT_L(0); PG8_BAR; PG8_MMA(1, 0, At, B0); PG8_MMA(1, 1, At, B1); PG8_BAR; PG8_SCHED;
            } else {
            PG8_LDB(B0, 0, 0); PG8_SCHED; PG8_LDA(At, 0, 0); PG8_STAGE(PG8_SA(1, 1), a1 + hstep, voffA);
            PG8_WAIT_L(8); PG8_BAR; PG8_WAIT_L(0); PG8_MMA(0, 0, At, B0); PG8_BAR; PG8_SCHED;
            PG8_LDB(B1, 0, 1); PG8_STAGE(PG8_SB(0, 0), b2, voffB);
            PG8_BAR; PG8_WAIT_L(0); PG8_MMA(0, 1, At, B1); PG8_BAR;
            PG8_LDA(At, 0, 1); PG8_STAGE(PG8_SA(0, 0), a2, voffA);
            PG8_BAR; PG8_WAIT_L(0); PG8_MMA(1, 0, At, B0); PG8_BAR; PG8_SCHED;
            PG8_STAGE(PG8_SB(0, 1), b2 + hstep, voffB);
            PG8_WAIT_V(6); PG8_BAR; PG8_MMA(1, 1, At, B1); PG8_BAR;
            PG8_LDB(B0, 1, 0); PG8_SCHED; PG8_LDA(At, 1, 0); PG8_STAGE(PG8_SA(0, 1), a2 + hstep, voffA);
            PG8_WAIT_L(8); PG8_BAR; PG8_WAIT_L(0); PG8_MMA(0, 0, At, B0); PG8_BAR; PG8_SCHED;
            PG8_LDB(B1, 1, 1); PG8_STAGE(PG8_SB(1, 0), b3, voffB);
            PG8_BAR; PG8_WAIT_L(0); PG8_MMA(0, 1, At, B1); PG8_BAR;
            PG8_LDA(At, 1, 1); PG8_STAGE(PG8_SA(1, 0), a3, voffA);
            PG8_BAR; PG8_WAIT_L(0); PG8_MMA(1, 0, At, B0); PG8_BAR; PG8_SCHED;
            PG8_STAGE(PG8_SB(1, 1), b3 + hstep, voffB);
            PG8_WAIT_V(6); PG8_BAR; PG8_MMA(1, 1, At, B1); PG8_BAR;
            }
        }
        if constexpr (ALIGN_EPI) { if (wr == 0) PG8_BAR; }
        if constexpr (!Epi::AFTER_DRAIN) { E(acc, cur, wr, wc, fr, fq); if (S.epi2) E(acc, cur, wr, wc, fr, fq); S.done(cur); }
        if (!has_next) break;
#pragma unroll
        for (int a = 0; a < 2; ++a)
#pragma unroll
            for (int b = 0; b < 2; ++b)
#pragma unroll
                for (int m = 0; m < 4; ++m)
#pragma unroll
                    for (int n = 0; n < 2; ++n) acc[a][b][m][n] = (f32x4){0.f, 0.f, 0.f, 0.f};
        cur = nxt; cA = nA; cB = nB; ++ui;
        if constexpr (ALIGN_EPI) { if (wr == 1) PG8_BAR; }
    }
    PG8_WAIT_V(0);
    if constexpr (!ALIGN_EPI) { if (wr == 0) PG8_BAR; }
    PG8_BAR;
    if constexpr (Epi::AFTER_DRAIN) { E.fused(acc, cur, wr, wc, fr, fq, lds, wid, lane); S.done(cur); }
#undef PG8_SA
#undef PG8_SB
#undef PG8_STAGE
#undef PG8_LDA
#undef PG8_LDB
#undef PG8_MMA
#undef PG8_WAIT_V
#undef PG8_WAIT_L
#undef PG8_BAR
#undef PG8_SCHED
}
}
namespace fa {
#define FA_LAS __attribute__((address_space(3)))
typedef short bf16x8 __attribute__((ext_vector_type(8)));
typedef short s16x4 __attribute__((ext_vector_type(4)));
typedef short v4i16_t __attribute__((ext_vector_type(4)));
typedef float f32x16 __attribute__((ext_vector_type(16)));
typedef float f32x4 __attribute__((ext_vector_type(4)));
typedef unsigned u32x4 __attribute__((ext_vector_type(4)));
typedef float f32x2_t __attribute__((ext_vector_type(2))); typedef __bf16 bf16x2_t __attribute__((ext_vector_type(2)));
constexpr float THR = 8.f, TH_SKIP = 32.f;
constexpr int F_KBUF = 18432, F_AOFF = 8192, F_VOFF = 10240, F_WSF = 3 * F_KBUF, F_FLAG = F_WSF + 8 * 256, F_OST = F_FLAG + 256, F_LDS_BYTES = F_OST + 8 * 4096;
constexpr int S_KBUF = 16384, S_VOFF = 8192, S_WSF = 6 * S_KBUF, S_OST = S_WSF + 8 * 256, S_LDS_BYTES = S_OST + 8 * 4096;
struct Params { const bf16_t* Q; const bf16_t* K; const bf16_t* V; const bf16_t* G; bf16_t* O; const float* CUM; const float* sinks; const unsigned* KMAX; unsigned* ticket; const bf16_t* KAUG; };
__device__ __forceinline__ unsigned cvtpk(float lo, float hi) { f32x2_t v = {lo, hi}; bf16x2_t b = __builtin_convertvector(v, bf16x2_t); return __builtin_bit_cast(unsigned, b); }
__device__ __forceinline__ s16x4 vtr(FA_LAS unsigned char* p) { return __builtin_bit_cast(s16x4, __builtin_amdgcn_ds_read_tr16_b64_v4i16((FA_LAS v4i16_t*)p)); }
__device__ __forceinline__ float swap_max(float v) { auto rr = __builtin_amdgcn_permlane32_swap(__float_as_uint(v), __float_as_uint(v), false, false); return __builtin_fmaxf(__uint_as_float(rr[0]), __uint_as_float(rr[1])); }
__device__ __forceinline__ float swap_add(float v) { auto rr = __builtin_amdgcn_permlane32_swap(__float_as_uint(v), __float_as_uint(v), false, false); return __uint_as_float(rr[0]) + __uint_as_float(rr[1]); }
__device__ __forceinline__ void glds16(const void* gsrc, unsigned lds_dst) { unsigned keep;
    asm volatile("s_mov_b32 %0, m0\n\ts_mov_b32 m0, %2\n\ts_nop 0\n\tglobal_load_lds_dwordx4 %1, off\n\ts_mov_b32 m0, %0" : "=&s"(keep) : "v"(gsrc), "s"(lds_dst) : "memory"); }
#define FA_MFMA(a, b, c) __builtin_amdgcn_mfma_f32_32x32x16_bf16((a), (b), (c), 0, 0, 0)
#define FA_MX3(a, b, c) __builtin_fmaxf(__builtin_fmaxf((a), (b)), (c))
struct WaveSt { bf16x8 qr[4]; bf16x8 qa; f32x16 cinit, o0, o1; float cq, mhat, lsum, mrun; };

#define FA_SBAR() __builtin_amdgcn_sched_barrier(0)
#define FA_PIN(x) asm volatile("" : "+v"(x))
#define FA_LDK(p) (*(FA_LAS bf16x8*)(p))
#define FA_VF(l, h) ((bf16x8){l[0], l[1], l[2], l[3], h[0], h[1], h[2], h[3]})
#define FA_EX4(X, B) do { X[B] = __builtin_amdgcn_exp2f(X[B]); X[B + 1] = __builtin_amdgcn_exp2f(X[B + 1]); X[B + 2] = __builtin_amdgcn_exp2f(X[B + 2]); X[B + 3] = __builtin_amdgcn_exp2f(X[B + 3]); } while (0)
__device__ __forceinline__ void split3(float v, unsigned& h1, unsigned& h2, unsigned& h3) { const bf16_t a = f2bf(v); const float r1 = v - bf2f(a); const bf16_t b = f2bf(r1); const float r2 = r1 - bf2f(b); h1 = a; h2 = b; h3 = f2bf(r2); }
__device__ __forceinline__ void set_qa(WaveSt& w, int hi) {
    unsigned g1, g2, g3; split3(w.cq - w.mhat, g1, g2, g3);
    const u32x4 q = {hi == 0 ? 0x3F803F80u : 0u, hi == 0 ? (0x3F80u | (g1 << 16)) : 0u, hi == 0 ? (g2 | (g3 << 16)) : 0u, 0u};
    w.qa = __builtin_bit_cast(bf16x8, q);
}
template <int MODE, int AOFF, int VOFF, int HB>
__device__ __forceinline__ void half_step(FA_LAS unsigned char* bb, FA_LAS unsigned char* vprev, FA_LAS float* wsf, WaveSt& w, f32x16& C, f32x16& P, int k0, int t, int qlo, int lane, int r32, int hi) {
    constexpr int W = MODE == 0 ? 0x40000000 : 128;
    FA_LAS unsigned char* kp = bb + hi * 1024 + r32 * 16 + HB * 512; FA_LAS unsigned char* ap = bb + AOFF + r32 * 16 + HB * 512;
    FA_LAS unsigned char* vp = (HB == 0 ? vprev + 2048 : bb) + VOFF + ((lane >> 4) & 1) * 32 + (lane & 3) * 8 + (4 * hi + ((lane & 15) >> 2)) * 64;
    bf16x8 kf0 = FA_LDK(kp), kf1 = FA_LDK(kp + 2048), kf2, kf3, ka;
    s16x4 vl0, vh0, vl1, vh1, vl2, vh2, vl3, vh3; u32x4 pw0, pw1; float sacc;
    FA_SBAR();
    if (MODE == 0) C = FA_MFMA(kf0, w.qr[0], ((f32x16){0.f, 0.f, 0.f, 0.f, 0.f, 0.f, 0.f, 0.f, 0.f, 0.f, 0.f, 0.f, 0.f, 0.f, 0.f, 0.f})); else C = FA_MFMA(kf0, w.qr[0], w.cinit);
    kf2 = FA_LDK(kp + 4096);
    sacc = (P[0] + P[1]) + (P[2] + P[3]); pw0.x = cvtpk(P[0], P[1]); pw0.y = cvtpk(P[2], P[3]); FA_PIN(sacc); FA_PIN(pw0.x); FA_PIN(pw0.y);
    FA_SBAR();
    C = FA_MFMA(kf1, w.qr[1], C); kf3 = FA_LDK(kp + 6144);
    sacc += P[4]; sacc += P[5]; sacc += P[6]; sacc += P[7]; pw0.z = cvtpk(P[4], P[5]); pw0.w = cvtpk(P[6], P[7]); FA_PIN(sacc); FA_PIN(pw0.z); FA_PIN(pw0.w);
    FA_SBAR();
    C = FA_MFMA(kf2, w.qr[2], C); if (MODE == 0) ka = FA_LDK(ap);
    sacc += P[8]; sacc += P[9]; sacc += P[10]; sacc += P[11]; pw1.x = cvtpk(P[8], P[9]); pw1.y = cvtpk(P[10], P[11]); FA_PIN(sacc); FA_PIN(pw1.x); FA_PIN(pw1.y); vl0 = vtr(vp); vh0 = vtr(vp + 512);
    FA_SBAR();
    C = FA_MFMA(kf3, w.qr[3], C);
    sacc += P[12]; sacc += P[13]; sacc += P[14]; sacc += P[15]; pw1.z = cvtpk(P[12], P[13]); pw1.w = cvtpk(P[14], P[15]); FA_PIN(sacc); FA_PIN(pw1.z); FA_PIN(pw1.w); vl1 = vtr(vp + 4096); vh1 = vtr(vp + 4096 + 512);
    FA_SBAR();
    if (MODE == 0) { C = FA_MFMA(ka, w.qa, C); FA_SBAR(); }
    w.lsum += sacc;
    const bf16x8 pa0 = __builtin_bit_cast(bf16x8, pw0), pa1 = __builtin_bit_cast(bf16x8, pw1);
    vl2 = vtr(vp + 1024); vh2 = vtr(vp + 1024 + 512);
    w.o0 = FA_MFMA(pa0, FA_VF(vl0, vh0), w.o0); vl3 = vtr(vp + 4096 + 1024); vh3 = vtr(vp + 4096 + 1024 + 512);
    w.o1 = FA_MFMA(pa0, FA_VF(vl1, vh1), w.o1);
    FA_SBAR();
    const int kh = k0 + 32 * HB;
    if ((kh + 31 > qlo) || (MODE == 1 && kh <= qlo + 31 - W)) {
        const float NEG = -__builtin_inff(); const int dq = t - kh - 4 * hi;
#pragma unroll
        for (int r = 0; r < 16; ++r) { const int c = (r & 3) + 8 * (r >> 2); if ((unsigned)(dq - c) >= (unsigned)W) C[r] = NEG; }
    }
    float ma = FA_MX3(C[0], C[1], C[2]), mb = FA_MX3(C[3], C[4], C[5]);
    ma = FA_MX3(ma, C[6], C[7]); mb = FA_MX3(mb, C[8], C[9]); ma = FA_MX3(ma, C[10], C[11]); mb = FA_MX3(mb, C[12], C[13]); ma = FA_MX3(ma, C[14], C[15]);
    const float rm = swap_max(__builtin_fmaxf(ma, mb));
    if (MODE == 0) w.mrun = __builtin_fmaxf(w.mrun, rm + w.mhat);
    const bool resc = __any(rm > THR);
    if (resc) {
        const float dl = __builtin_fmaxf(rm, 0.f); w.mhat += dl;
#pragma unroll
        for (int r = 0; r < 16; ++r) C[r] -= dl;
        if (MODE == 0) set_qa(w, hi);
        else { const float ci = w.cq - w.mhat;
#pragma unroll
            for (int r = 0; r < 16; ++r) w.cinit[r] = ci; }
        const float f = __builtin_amdgcn_exp2f(-dl); w.lsum *= f;
        if (hi == 0) wsf[r32] = f;
    }
    FA_SBAR();
    FA_EX4(C, 0); FA_PIN(C);
    w.o0 = FA_MFMA(pa1, FA_VF(vl2, vh2), w.o0); FA_EX4(C, 4); FA_EX4(C, 8); FA_PIN(C); FA_SBAR();
    w.o1 = FA_MFMA(pa1, FA_VF(vl3, vh3), w.o1); FA_EX4(C, 12); FA_PIN(C); FA_SBAR();
    if (resc) {
        asm volatile("s_waitcnt lgkmcnt(0)" ::: "memory");
#pragma unroll
        for (int g = 0; g < 4; ++g) { const f32x4 a4 = *(FA_LAS f32x4*)(wsf + 8 * g + 4 * hi);
#pragma unroll
            for (int i = 0; i < 4; ++i) { w.o0[4 * g + i] *= a4[i]; w.o1[4 * g + i] *= a4[i]; } }
    }
}
template <int MODE, int AOFF, int VOFF>
__device__ __forceinline__ void tile_step(FA_LAS unsigned char* bb, FA_LAS unsigned char* vprev, FA_LAS float* wsf, WaveSt& w, f32x16& pA, f32x16& pB, int k0, int t, int qlo, int lane, int r32, int hi) {
    half_step<MODE, AOFF, VOFF, 0>(bb, vprev, wsf, w, pA, pB, k0, t, qlo, lane, r32, hi);
    half_step<MODE, AOFF, VOFF, 1>(bb, vprev, wsf, w, pB, pA, k0, t, qlo, lane, r32, hi);
}
template <int VOFF>
__device__ __forceinline__ void tile_drain(FA_LAS unsigned char* vlast, WaveSt& w, f32x16& P, int lane, int hi) {
    FA_LAS unsigned char* vp = vlast + 2048 + VOFF + ((lane >> 4) & 1) * 32 + (lane & 3) * 8 + (4 * hi + ((lane & 15) >> 2)) * 64;
    float s0 = 0.f;
#pragma unroll
    for (int r = 0; r < 16; ++r) s0 += P[r];
    w.lsum += s0;
    const u32x4 w0 = {cvtpk(P[0], P[1]), cvtpk(P[2], P[3]), cvtpk(P[4], P[5]), cvtpk(P[6], P[7])};
    const u32x4 w1 = {cvtpk(P[8], P[9]), cvtpk(P[10], P[11]), cvtpk(P[12], P[13]), cvtpk(P[14], P[15])};
    const bf16x8 pa0 = __builtin_bit_cast(bf16x8, w0), pa1 = __builtin_bit_cast(bf16x8, w1);
    { const s16x4 l0 = vtr(vp), h0 = vtr(vp + 512), l1 = vtr(vp + 4096), h1 = vtr(vp + 4096 + 512); w.o0 = FA_MFMA(pa0, FA_VF(l0, h0), w.o0); w.o1 = FA_MFMA(pa0, FA_VF(l1, h1), w.o1); }
    { const s16x4 l0 = vtr(vp + 1024), h0 = vtr(vp + 1024 + 512), l1 = vtr(vp + 4096 + 1024), h1 = vtr(vp + 4096 + 1024 + 512); w.o0 = FA_MFMA(pa1, FA_VF(l0, h0), w.o0); w.o1 = FA_MFMA(pa1, FA_VF(l1, h1), w.o1); }
}
__device__ __forceinline__ void load_gate(u32x4 (&gq)[4], const bf16_t* G, size_t grow, int h, int lane) {
#pragma unroll
    for (int d0 = 0; d0 < 2; ++d0)
#pragma unroll
        for (int i = 0; i < 2; ++i) gq[2 * d0 + i] = *(const u32x4*)(G + hm_off((int)grow + i * 16 + (lane >> 2), h * 64 + d0 * 32 + (lane & 3) * 8, NH));
}
__device__ __forceinline__ void wave_epilogue(FA_LAS float* stg, FA_LAS float* wsf, WaveSt& w, const u32x4 (&gq)[4], bf16_t* O, size_t grow, int h, int lane, int r32, int hi) {
    const float l = swap_add(w.lsum);
    if (hi == 0) wsf[r32] = l;
    asm volatile("s_waitcnt lgkmcnt(0)" ::: "memory");
    float rl[16];
#pragma unroll
    for (int g = 0; g < 4; ++g) { const f32x4 l4 = *(FA_LAS f32x4*)(wsf + 8 * g + 4 * hi);
#pragma unroll
        for (int i = 0; i < 4; ++i) rl[4 * g + i] = 1.0f / l4[i]; }
#pragma unroll
    for (int d0 = 0; d0 < 2; ++d0) {
#pragma unroll
        for (int g = 0; g < 4; ++g)
#pragma unroll
            for (int i = 0; i < 4; ++i) stg[(8 * g + 4 * hi + i) * 32 + r32] = (d0 == 0 ? w.o0[4 * g + i] : w.o1[4 * g + i]) * rl[4 * g + i];
        asm volatile("s_waitcnt lgkmcnt(0)" ::: "memory");
#pragma unroll
        for (int i = 0; i < 2; ++i) { const int row = i * 16 + (lane >> 2), ch = lane & 3;
            const f32x4 x0 = *(FA_LAS f32x4*)(stg + row * 32 + ch * 8), x1 = *(FA_LAS f32x4*)(stg + row * 32 + ch * 8 + 4);
            const size_t ga = (grow + row) * DM + h * 64 + d0 * 32 + ch * 8; const u32x4 gv = gq[2 * d0 + i];
            u32x4 ov;
            ov.x = cvtpk(x0[0] * __uint_as_float(gv.x << 16), x0[1] * __uint_as_float(gv.x & 0xffff0000u)); ov.y = cvtpk(x0[2] * __uint_as_float(gv.y << 16), x0[3] * __uint_as_float(gv.y & 0xffff0000u));
            ov.z = cvtpk(x1[0] * __uint_as_float(gv.z << 16), x1[1] * __uint_as_float(gv.z & 0xffff0000u)); ov.w = cvtpk(x1[2] * __uint_as_float(gv.w << 16), x1[3] * __uint_as_float(gv.w & 0xffff0000u));
            *(u32x4*)(O + tiled_off((int)(grow + row), h * 64 + d0 * 32 + ch * 8)) = ov; }
        asm volatile("s_waitcnt lgkmcnt(0)" ::: "memory");
    }
}
template <int MODE> __device__ __forceinline__ void wave_init(WaveSt& w, int hi) {
#pragma unroll
    for (int r = 0; r < 16; ++r) { w.o0[r] = 0.f; w.o1[r] = 0.f; }
    if (MODE == 0) set_qa(w, hi);
    else { const float ci = w.cq - w.mhat;
#pragma unroll
        for (int r = 0; r < 16; ++r) w.cinit[r] = ci; }
}

__device__ __forceinline__ void fox_unit(FA_LAS unsigned char* lds, const Params& P, int b, int h, int qb) {
    const int tid = threadIdx.x, lane = tid & 63, r32 = lane & 31, hi = lane >> 5;
    const int wid = __builtin_amdgcn_readfirstlane(tid >> 6);
    const int q0 = qb * 256, qlo = q0 + wid * 32, t = qlo + r32;
    const size_t rowbase = (size_t)b * SEQ;
    const bf16_t* ksrc = P.K + hm_off((int)rowbase + lane, h * 64 + wid * 8, NH);
    const bf16_t* vsrc = P.V + hm_off((int)rowbase + 16 * (wid & 3) + (lane >> 2), h * 64 + (wid >> 2) * 32 + (lane & 3) * 8, NH);
    const float* cum = P.CUM + (size_t)(b * NH + h) * SEQ;
    const bf16_t* asrc = P.KAUG + ((size_t)(b * NH + h) * SEQ + lane) * 8;
    const int NT = (q0 + 256) / 64;
    WaveSt w; const bf16_t* Qw = P.Q + hm_off((int)rowbase + t, h * 64 + hi * 8, NH); float qn = 0.f;
#pragma unroll
    for (int d0 = 0; d0 < 4; ++d0) { w.qr[d0] = *(const bf16x8*)(Qw + d0 * 16);
#pragma unroll
        for (int j = 0; j < 8; ++j) { const float qv = bf2f((bf16_t)w.qr[d0][j]); qn = fmaf(qv, qv, qn); } }
    w.cq = cum[t]; w.mhat = 0.f; w.lsum = 0.f; w.mrun = -1e30f;
    wave_init<0>(w, hi);
    u32x4 gq[4]; load_gate(gq, P.G, rowbase + qlo, h, lane);
    const float qkb = sqrtf(swap_add(qn) * (__uint_as_float(P.KMAX[(b * NH + h) * 2]) + __uint_as_float(P.KMAX[(b * NH + h) * 2 + 1]))) * 1.01f + 1e-3f;
    FA_LAS float* wsf = (FA_LAS float*)(lds + F_WSF) + wid * 64;
    FA_LAS unsigned* votes = (FA_LAS unsigned*)(lds + F_FLAG);
    float cnew = 0.f;
#define FA_LOADT(j, bf) do { const size_t ko_ = (size_t)(j) * 64 * 64; FA_LAS unsigned char* bb_ = lds + (bf) * F_KBUF; \
        glds16(ksrc + ko_, (unsigned)__builtin_amdgcn_readfirstlane((int)(unsigned)(uintptr_t)(bb_ + wid * 1024))); \
        glds16(vsrc + ko_, (unsigned)__builtin_amdgcn_readfirstlane((int)(unsigned)(uintptr_t)(bb_ + F_VOFF + (wid >> 2) * 4096 + (wid & 3) * 1024))); \
        if (wid == 0) glds16(asrc + (size_t)(j) * 64 * 8, (unsigned)__builtin_amdgcn_readfirstlane((int)(unsigned)(uintptr_t)(bb_ + F_AOFF))); \
        cnew = cum[(j) * 64 + 63]; } while (0)
    FA_LOADT(NT - 1, 0); asm volatile("s_waitcnt vmcnt(0)" ::: "memory"); __syncthreads();
    bool wdone = false, pend = false; f32x16 pA, pB;
#pragma unroll
    for (int r = 0; r < 16; ++r) pB[r] = 0.f;
    int cur = 0;
    for (int tt = 0; tt < NT; ++tt) {
        const int j = NT - 1 - tt, k0 = j * 64; const int nxt = cur == 2 ? 0 : cur + 1, prv = cur == 0 ? 2 : cur - 1;
        if (j > 0) FA_LOADT(j - 1, nxt);
        if (!wdone && k0 <= qlo + 31) {
            FA_LAS unsigned char* bb = lds + cur * F_KBUF;
            tile_step<0, F_AOFF, F_VOFF>(bb, pend ? lds + prv * F_KBUF : bb, wsf, w, pA, pB, k0, t, qlo, lane, r32, hi);
            pend = true;
        }
        if (j > 0) {
            if (!wdone && pend && __all(qkb + w.cq - cnew - w.mrun <= -TH_SKIP)) {
                wdone = true; tile_drain<F_VOFF>(lds + cur * F_KBUF, w, pB, lane, hi);
            }
            if (lane == 0) votes[(tt & 1) * 8 + wid] = wdone ? 1u : 0u;
        }
        asm volatile("s_waitcnt vmcnt(0)" ::: "memory");
        __syncthreads();
        if (j > 0) { const u32x4 v0 = *(FA_LAS u32x4*)(votes + (tt & 1) * 8), v1 = *(FA_LAS u32x4*)(votes + (tt & 1) * 8 + 4);
            if ((v0.x & v0.y & v0.z & v0.w & v1.x & v1.y & v1.z & v1.w) != 0u) break; }
        else if (!wdone) tile_drain<F_VOFF>(lds + cur * F_KBUF, w, pB, lane, hi);
        cur = nxt;
    }
#undef FA_LOADT
    wave_epilogue((FA_LAS float*)(lds + F_OST + wid * 4096), wsf, w, gq, P.O, rowbase + qlo, h, lane, r32, hi);
    __syncthreads();
}
__device__ __forceinline__ void swa_unit(FA_LAS unsigned char* lds, const Params& P, int b, int kvh, int qb) {
    const int tid = threadIdx.x, lane = tid & 63, r32 = lane & 31, hi = lane >> 5;
    const int wid = __builtin_amdgcn_readfirstlane(tid >> 6);
    const int q0 = qb * 256, qlo = q0 + wid * 32, t = qlo + r32;
    const size_t rowbase = (size_t)b * SEQ;
    const int j_lo = q0 >= 128 ? (q0 - 128) / 64 : 0, NT = (q0 + 256) / 64 - j_lo;
    const bf16_t* ksrc = P.K + hm_off((int)rowbase + j_lo * 64 + lane, kvh * 64 + wid * 8, 4);
    const bf16_t* vsrc = P.V + hm_off((int)rowbase + j_lo * 64 + 16 * (wid & 3) + (lane >> 2), kvh * 64 + (wid >> 2) * 32 + (lane & 3) * 8, 4);
    const int kdst = wid * 1024 + lane * 16, vdst = S_VOFF + (wid >> 2) * 4096 + (wid & 3) * 1024 + lane * 16;
    { u32x4 sk[6], sv[6];
#pragma unroll
      for (int i = 0; i < 6; ++i) if (i < NT) { sk[i] = *(const u32x4*)(ksrc + (size_t)i * 64 * 64); sv[i] = *(const u32x4*)(vsrc + (size_t)i * 64 * 64); }
#pragma unroll
      for (int i = 0; i < 6; ++i) if (i < NT) { *(FA_LAS u32x4*)(lds + i * S_KBUF + kdst) = sk[i]; *(FA_LAS u32x4*)(lds + i * S_KBUF + vdst) = sv[i]; } }
    __syncthreads();
    FA_LAS float* wsf = (FA_LAS float*)(lds + S_WSF) + wid * 64;
    const int ta = (qlo >= 127 ? (qlo - 127) / 64 : 0) - j_lo, tb = (qlo + 31) / 64 - j_lo;
    bf16x8 qn[4]; { const bf16_t* Qw = P.Q + hm_off((int)rowbase + t, (kvh * 8) * 64 + hi * 8, NH);
#pragma unroll
      for (int d0 = 0; d0 < 4; ++d0) qn[d0] = *(const bf16x8*)(Qw + d0 * 16); }
    for (int hh = 0; hh < 8; ++hh) {
        const int h = kvh * 8 + hh;
        WaveSt w;
#pragma unroll
        for (int d0 = 0; d0 < 4; ++d0) w.qr[d0] = qn[d0];
        { const bf16_t* Qw = P.Q + hm_off((int)rowbase + t, (kvh * 8 + (hh < 7 ? hh + 1 : hh)) * 64 + hi * 8, NH);
#pragma unroll
          for (int d0 = 0; d0 < 4; ++d0) qn[d0] = *(const bf16x8*)(Qw + d0 * 16); }
        u32x4 gq[4]; load_gate(gq, P.G, rowbase + qlo, h, lane);
        w.cq = 0.f; w.mhat = P.sinks[h] * LOG2E; w.lsum = 0.5f; w.mrun = 0.f;
        wave_init<1>(w, hi);
        f32x16 pA, pB;
#pragma unroll
        for (int r = 0; r < 16; ++r) pB[r] = 0.f;
        for (int ti = tb; ti >= ta; --ti) { FA_LAS unsigned char* bb = lds + ti * S_KBUF;
            tile_step<1, 0, S_VOFF>(bb, ti == tb ? bb : bb + S_KBUF, wsf, w, pA, pB, (j_lo + ti) * 64, t, qlo, lane, r32, hi); }
        tile_drain<S_VOFF>(lds + ta * S_KBUF, w, pB, lane, hi);
        wave_epilogue((FA_LAS float*)(lds + S_OST + wid * 4096), wsf, w, gq, P.O, rowbase + qlo, h, lane, r32, hi);
    }
    __syncthreads();
}
}
#define GAS __attribute__((address_space(1)))
#define LAS __attribute__((address_space(3)))
typedef unsigned short bf16;
typedef unsigned v4u __attribute__((ext_vector_type(4)));
typedef float f32x4 __attribute__((ext_vector_type(4)));
typedef short bf16x8 __attribute__((ext_vector_type(8)));
typedef GAS unsigned gu32;
typedef GAS unsigned long long gu64;
#define RLX_AGENT __ATOMIC_RELAXED, __HIP_MEMORY_SCOPE_AGENT
#define LDS_WAIT() asm volatile("s_waitcnt lgkmcnt(0)" ::: "memory")
#define VM_WAIT() asm volatile("s_waitcnt vmcnt(0)" ::: "memory")
__device__ __forceinline__ unsigned long long rt() { return __builtin_amdgcn_s_memrealtime(); }
__device__ __forceinline__ unsigned pk2(float lo, float hi) { return (unsigned)f2bf(lo) | ((unsigned)f2bf(hi) << 16); }
#define XB_TMO      128
#define XB_XCNT(j)  (256  + 64 * (j))
#define XB_XSUB(j)  (1280 + 64 * (j))
#define XB_XGEN(j)  (2304 + 64 * (j))
#define XB_TOP      3328
#define XB_TOPGEN   3392
#define XCD_BAR_WORDS 3456
#define XB_SPIN_CAP (1u << 18)

__device__ __forceinline__ unsigned xb_ld(unsigned* p)              { return __hip_atomic_load(p, __ATOMIC_RELAXED, __HIP_MEMORY_SCOPE_AGENT); }
__device__ __forceinline__ unsigned xb_add(unsigned* p, unsigned v) { return __hip_atomic_fetch_add(p, v, __ATOMIC_RELAXED, __HIP_MEMORY_SCOPE_AGENT); }
__device__ __forceinline__ unsigned xb_xcc_id() { return (unsigned)__builtin_amdgcn_s_getreg((3 << 11) | 20) & 0xFu; }
#define XB_SPIN(cond, bar) do { unsigned _sp = 0; while (cond) { __builtin_amdgcn_s_sleep(1); \
    if ((++_sp & 255u) == 0u) { if (xb_ld(&(bar)[XB_TMO])) break; if (_sp > XB_SPIN_CAP) { atomicAdd(&(bar)[XB_TMO], 1u); break; } } } } while (0)

struct XcdBarrier {
    unsigned* bar; unsigned x;
    volatile LAS unsigned* st;
};

__device__ __forceinline__ XcdBarrier xcd_barrier_post(unsigned* bar, volatile LAS unsigned* st) {
    XcdBarrier b; b.bar = bar; b.x = xb_xcc_id(); b.st = st;
    if (threadIdx.x == 0) (void)xb_add(&bar[XB_XCNT(b.x)], 1u);
    return b;
}
__device__ __forceinline__ void xcd_barrier_complete(unsigned* bar, unsigned x, unsigned& nloc, unsigned& nx) {
    const unsigned G = gridDim.x * gridDim.y * gridDim.z;
    unsigned sum, cnt, mine, sp = 0u;
    for (;;) {
        sum = 0u; cnt = 0u; mine = 0u;
#pragma unroll
        for (unsigned j = 0; j < 16; ++j) { const unsigned c = xb_ld(&bar[XB_XCNT(j)]); sum += c; cnt += (c > 0u) ? 1u : 0u; mine = (j == x) ? c : mine; }
        if (sum == G) break;
        __builtin_amdgcn_s_sleep(1);
        if ((++sp & 255u) == 0u) { if (xb_ld(&bar[XB_TMO])) break; if (sp > XB_SPIN_CAP) { atomicAdd(&bar[XB_TMO], 1u); break; } }
    }
    nloc = mine > 0u ? mine : 1u; nx = cnt > 0u ? cnt : 1u;
}

__device__ __forceinline__ void xcd_barrier(const XcdBarrier& b) {
    asm volatile("s_waitcnt vmcnt(0)" ::: "memory");
    __syncthreads();
    if (threadIdx.x == 0) {
        unsigned* bar = b.bar;
        __builtin_amdgcn_s_waitcnt(0);
        unsigned nloc = b.st[0], nx = b.st[1];
        if (nloc == 0u) { xcd_barrier_complete(bar, b.x, nloc, nx); b.st[0] = nloc; b.st[1] = nx; }
        const unsigned old = xb_add(&bar[XB_XSUB(b.x)], 1u);
        const unsigned gen = old / nloc;
        if (old + 1u == (gen + 1u) * nloc) {
            __builtin_amdgcn_fence(__ATOMIC_RELEASE, "agent");
            asm volatile("s_waitcnt vmcnt(0)" ::: "memory");
            const unsigned og = xb_add(&bar[XB_TOP], 1u);
            const unsigned tg = og / nx;
            if (og + 1u == (tg + 1u) * nx) xb_add(&bar[XB_TOPGEN], 1u);
            else XB_SPIN(xb_ld(&bar[XB_TOPGEN]) == tg, bar);
            __builtin_amdgcn_fence(__ATOMIC_ACQUIRE, "agent");
            xb_add(&bar[XB_XGEN(b.x)], 1u);
            asm volatile("s_waitcnt vmcnt(0)" ::: "memory");
        } else {
            XB_SPIN(xb_ld(&bar[XB_XGEN(b.x)]) == gen, bar);
            __builtin_amdgcn_fence(__ATOMIC_ACQUIRE, "agent");
            asm volatile("s_waitcnt vmcnt(0)" ::: "memory");
        }
    }
    __syncthreads();
}
constexpr int NWAVES = 8;
constexpr int N1P = 8448;
constexpr int RING_OFF = 0, RING_BYTES = 135168;
constexpr int LDSCTL_OFF = RING_BYTES, MISC_OFF = LDSCTL_OFF + 320;
constexpr int LDS_BYTES = 147456;
constexpr int CW_BAR = 4096;
static_assert(fa::F_LDS_BYTES <= RING_BYTES && fa::S_LDS_BYTES <= RING_BYTES && pg8::STAGE_BYTES <= RING_BYTES && MISC_OFF + 128 <= LDS_BYTES && (CW_BAR + XCD_BAR_WORDS) * 4 <= (int)WS_KMAX, "LDS / CTL map");

__device__ __forceinline__ void p0_transpose_item(const float* W, int K, int N, bf16* WT, LAS float* scr, int item, int lane, const float* gs) {
    const int nblk = N / 32, kb = item / nblk, nb = item % nblk, k0 = 64 * kb, n0 = 32 * nb;
    const int kr = lane >> 3, nc = 4 * (lane & 7);
    f32x4 wv[8];
#pragma unroll
    for (int i = 0; i < 8; ++i) wv[i] = *(const GAS f32x4*)(W + (size_t)(k0 + 8 * i + kr) * N + n0 + nc);
#pragma unroll
    for (int i = 0; i < 8; ++i) { const int kk = 8 * i + kr; f32x4 w = wv[i]; if (gs) w = w * gs[k0 + kk]; LAS float* d = scr + kk * 33 + nc; d[0] = w.x; d[1] = w.y; d[2] = w.z; d[3] = w.w; }
    LDS_WAIT(); asm volatile("" ::: "memory");
    const int c = lane & 7;
#pragma unroll
    for (int j = 0; j < 4; ++j) { const int n = (lane >> 3) + 8 * j; const LAS float* sp = scr + (8 * c) * 33 + n;
        v4u o; o.x = pk2(sp[0 * 33], sp[1 * 33]); o.y = pk2(sp[2 * 33], sp[3 * 33]); o.z = pk2(sp[4 * 33], sp[5 * 33]); o.w = pk2(sp[6 * 33], sp[7 * 33]);
        *(GAS v4u*)(WT + tiled_off(n0 + n, k0 + 8 * c)) = o; }
    LDS_WAIT(); asm volatile("" ::: "memory");
}
__device__ __forceinline__ float wave_sum(float v) {
#pragma unroll
    for (int o = 1; o < 64; o <<= 1) v += __shfl_xor(v, o);
    return v;
}

struct Args { const float* in[9]; float* out; unsigned char* ws; int ph_lo, ph_hi; };
constexpr int N_PHASES = 9;
__global__ void __launch_bounds__(NWAVES * 64, 2) mega_fwd(Args args) {
    extern __shared__ __attribute__((aligned(16))) unsigned char lds_raw[];
    LAS unsigned char* lds = (LAS unsigned char*)lds_raw;
    volatile LAS unsigned* MISC = (volatile LAS unsigned*)(lds + MISC_OFF);
    const int tid = threadIdx.x, lane = tid & 63, wave = __builtin_amdgcn_readfirstlane(tid >> 6);
    const int G = gridDim.x, bx = blockIdx.x, vcu = (G % 8 == 0) ? (bx % 8) * (G / 8) + bx / 8 : bx;
    unsigned char* ws = args.ws;
    const float* x = args.in[0]; const float* norm_g = args.in[1]; const float* fox_w_in = args.in[2]; const float* fox_b_f = args.in[3]; const float* fox_w_out = args.in[4];
    const float* swa_w_in = args.in[5]; const float* swa_sinks = args.in[6]; const float* swa_w_out = args.in[7]; const float* final_g = args.in[8];
    float* out = args.out;
    gu32* ctl = (gu32*)(ws + WS_CTL);
    unsigned* KMAX = (unsigned*)(ws + WS_KMAX); unsigned* TICKET = (unsigned*)(ws + WS_TICKET);
    float* SS1 = (float*)(ws + WS_SS1); float* R0 = (float*)(ws + WS_R0); float* ROPE = (float*)(ws + WS_ROPE); float* LOGF = (float*)(ws + WS_LOGF); float* CUM = (float*)(ws + WS_CUM);
    bf16* W1T = (bf16*)(ws + WS_W1T); bf16* W2T = (bf16*)(ws + WS_W2T); bf16* W3T = (bf16*)(ws + WS_W3T); bf16* W4T = (bf16*)(ws + WS_W4T);
    bf16* KAUG = (bf16*)(ws + WS_KAUG);
    bf16* XB = (bf16*)(ws + WS_XB); bf16* Qb = (bf16*)(ws + WS_Q); bf16* Kb = (bf16*)(ws + WS_K); bf16* Vb = (bf16*)(ws + WS_V); bf16* Gb = (bf16*)(ws + WS_G); bf16* YG = (bf16*)(ws + WS_YG);
    for (int u = tid; u < (LDS_BYTES - LDSCTL_OFF) / 4; u += NWAVES * 64) ((LAS unsigned*)(lds + LDSCTL_OFF))[u] = 0u;
    __syncthreads();
    const int lo = args.ph_lo, hi = args.ph_hi;
    XcdBarrier bar; bar.bar = (unsigned*)(ctl + CW_BAR); bar.x = 0; bar.st = nullptr;
    if (hi - lo > 1) bar = xcd_barrier_post((unsigned*)(ctl + CW_BAR), MISC + 8);
#define IN(k) (lo <= (k) && (k) < hi)
#define REP(k) for (int rep_ = 0; rep_ < (((DUP_MASK >> (k)) & 1) ? 2 : 1); ++rep_)
#define SEAM(k) do { if (IN(k) && IN((k) + 1)) xcd_barrier(bar); } while (0)
    const int gw = vcu * NWAVES + wave, NGW = G * NWAVES;

    if (IN(0)) REP(0) {
        LAS float* scr = (LAS float*)(lds + RING_OFF + wave * 16384);
        constexpr int I1 = (DM / 64) * (FOX_IN / 32), IZ = N1P - FOX_IN;
        constexpr int NITEMS = I1 + IZ;
        for (int it = gw; it < NITEMS; it += NGW) {
            int r = it;
            if (r < I1) { p0_transpose_item(fox_w_in, DM, FOX_IN, W1T, scr, r, lane, norm_g); continue; } r -= I1;
            { GAS v4u* zp = (GAS v4u*)(W1T + tiled_off(FOX_IN + r, (lane >> 1) * 64 + (lane & 1) * 32));
#pragma unroll
              for (int j = 0; j < 4; ++j) zp[j] = (v4u){0u, 0u, 0u, 0u}; }
        }
        for (int m = gw; m < MTOK; m += 2 * NGW) {
            const int m2 = m + NGW < MTOK ? m + NGW : m;
            const GAS f32x4* xr = (const GAS f32x4*)(x + (size_t)m * DM) + lane; const GAS f32x4* xr2 = (const GAS f32x4*)(x + (size_t)m2 * DM) + lane; f32x4 v[8], v2[8]; float s = 0.f, s2 = 0.f;
#pragma unroll
            for (int j = 0; j < 8; ++j) { v[j] = xr[64 * j]; v2[j] = xr2[64 * j]; }
#pragma unroll
            for (int j = 0; j < 8; ++j) { s += (v[j].x * v[j].x + v[j].y * v[j].y) + (v[j].z * v[j].z + v[j].w * v[j].w); s2 += (v2[j].x * v2[j].x + v2[j].y * v2[j].y) + (v2[j].z * v2[j].z + v2[j].w * v2[j].w); }
            s = wave_sum(s); s2 = wave_sum(s2);
            if (lane == 0) { R0[m] = 1.0f / sqrtf(s * (1.f / DM) + RMS_EPS); R0[m2] = 1.0f / sqrtf(s2 * (1.f / DM) + RMS_EPS); }
#pragma unroll
            for (int j = 0; j < 8; ++j) { *(GAS unsigned long long*)(XB + tiled_off(m, 256 * j + 4 * lane)) = (unsigned long long)pk2(v[j].x, v[j].y) | ((unsigned long long)pk2(v[j].z, v[j].w) << 32);
                                          *(GAS unsigned long long*)(XB + tiled_off(m2, 256 * j + 4 * lane)) = (unsigned long long)pk2(v2[j].x, v2[j].y) | ((unsigned long long)pk2(v2[j].z, v2[j].w) << 32); }
        }
        { const int gt = gw * 64 + lane;
          if (gt < SEQ * 8) { const int pos = gt >> 3, i = gt & 7;
              const double invf[8] = {1.0, 0.19390220519133497, 0.037598065178462524, 0.0072903477503833845, 0.0014142135623730951, 0.00027421912901204056, 5.3171693730649086e-05, 1.0310108130908796e-05};
              double inv = invf[0];
#pragma unroll
              for (int k = 1; k < 8; ++k) inv = (i == k) ? invf[k] : inv;
              const double ang = (double)pos * inv; const double kk = __builtin_rint(ang * 0.15915494309189535); const float red = (float)(ang - kk * 6.283185307179586);
              ROPE[(size_t)pos * 16 + i] = cosf(red); ROPE[(size_t)pos * 16 + 8 + i] = sinf(red); } }
    }
    SEAM(0);
    if (IN(1)) {
        pg8::Gemm g{XB, W1T, MTOK, N1P, DM}; pg8::StaticOrder S; S.init(MTOK, N1P, G, bx, (DUP_MASK >> 1) & 1, (DUP_MASK >> 9) & 1);
        pg8::EpiFoxIn E{Qb, Kb, Vb, Gb, LOGF, R0, fox_b_f, KMAX};
        if ((DUP_MASK >> 10) & 1) { pg8::StaticOrder SP; SP.init(MTOK, N1P, G, bx, 0, 0, 1); pg8::gemm_phase<pg8::EpiFoxIn, pg8::StaticOrder, true, true>(lds + RING_OFF, g, SP, E); }
        pg8::gemm_phase<pg8::EpiFoxIn, pg8::StaticOrder, true, true>(lds + RING_OFF, g, S, E);
        { const int nwg = (MTOK / 256) * (N1P / 256), rem = nwg % G, nidle = rem ? G - rem : G, ii = rem ? bx - rem : bx;
          if (ii >= 0) { LAS float* scr = (LAS float*)(lds + RING_OFF + wave * 16384);
              constexpr int I2 = (DM / 64) * (DM / 32), I3 = (DM / 64) * (SWA_IN / 32);
              for (int it = ii * NWAVES + wave; it < I2 + I3 + I2; it += nidle * NWAVES) {
                  int r = it;
                  if (r < I2) { p0_transpose_item(fox_w_out, DM, DM, W2T, scr, r, lane, nullptr); continue; } r -= I2;
                  if (r < I3) { p0_transpose_item(swa_w_in, DM, SWA_IN, W3T, scr, r, lane, norm_g + DM); continue; } r -= I3;
                  p0_transpose_item(swa_w_out, DM, DM, W4T, scr, r, lane, nullptr); } } }
    }
    SEAM(1);
    if (IN(2)) REP(2) {
        for (int sq = vcu; sq < NB * NH; sq += G) {
            const GAS f32x4* lf = (const GAS f32x4*)(LOGF + (size_t)sq * SEQ + wave * 512) + lane * 2; const f32x4 v0 = lf[0], v1 = lf[1];
            const double tot = (((double)v0.x + (double)v0.y) + ((double)v0.z + (double)v0.w)) + (((double)v1.x + (double)v1.y) + ((double)v1.z + (double)v1.w));
            double incl = tot;
#pragma unroll
            for (int o = 1; o < 64; o <<= 1) { const double up = __shfl_up(incl, o); if (lane >= o) incl += up; }
            volatile LAS double* wt = (volatile LAS double*)(lds + RING_OFF);
            __syncthreads();
            if (lane == 63) wt[wave] = incl;
            __syncthreads();
            double run = incl - tot;
            for (int w2 = 0; w2 < wave; ++w2) run += wt[w2];
            const float vv[8] = {v0.x, v0.y, v0.z, v0.w, v1.x, v1.y, v1.z, v1.w}; float cv[8];
#pragma unroll
            for (int e = 0; e < 8; ++e) { run += (double)vv[e]; cv[e] = (float)(run * 1.4426950408889634); }
            GAS f32x4* co = (GAS f32x4*)(CUM + (size_t)sq * SEQ + wave * 512) + lane * 2; co[0] = (f32x4){cv[0], cv[1], cv[2], cv[3]}; co[1] = (f32x4){cv[4], cv[5], cv[6], cv[7]};
            GAS v4u* ka = (GAS v4u*)(KAUG + ((size_t)sq * SEQ + wave * 512 + lane * 8) * 8);
#pragma unroll
            for (int e = 0; e < 8; ++e) { unsigned h1, h2, h3; fa::split3(-cv[e], h1, h2, h3); ka[e] = (v4u){h1 | (h2 << 16), h3 | 0x3F800000u, 0x3F803F80u, 0u}; }
        }
    }
    SEAM(2);
    if (IN(3)) {
        const fa::Params P{Qb, Kb, Vb, Gb, YG, CUM, nullptr, KMAX, TICKET, KAUG};
        volatile LAS unsigned* slot = (volatile LAS unsigned*)(lds + RING_OFF + fa::F_FLAG + 128);
#define FOX_FETCH(dst) do { unsigned code_ = 0xFFFFFFFFu; for (int k_ = 0; k_ < 8; ++k_) { const unsigned q_ = (unsigned)((bx + k_) & 7); const unsigned t_ = atomicAdd(TICKET + q_ * 64, 1u); \
            if (t_ < 256u) { code_ = q_ * 256u + t_; break; } } (dst) = code_; } while (0)
        if (tid == 0) FOX_FETCH(slot[0]);
        __syncthreads();
        unsigned tk = slot[0]; int par = 0;
        while (tk != 0xFFFFFFFFu) {
            if (tid == 0) FOX_FETCH(slot[par ^ 1]);
            const int q = (int)(tk >> 8), tq = (int)(tk & 255u), pi = tq >> 4, hs = 3 - (pi >> 2);
            const int h = hs == 0 ? q : hs == 1 ? 15 - q : hs == 2 ? 16 + q : 31 - q;
            fa::fox_unit(lds + RING_OFF, P, pi & 3, h, 15 - (tq & 15));
            par ^= 1; tk = slot[par];
        }
#undef FOX_FETCH
        __syncthreads();
    }
    SEAM(3);
    if (IN(4)) {
        pg8::Gemm g{YG, W2T, MTOK, DM, DM}; pg8::StaticOrder S; S.init(MTOK, DM, G, bx);
        pg8::EpiRes<true> E{x, XB, SS1};
        pg8::gemm_phase<pg8::EpiRes<true>, pg8::StaticOrder, true, true>(lds + RING_OFF, g, S, E);
    }
    SEAM(4);
    if (IN(5)) {
        pg8::Gemm g{XB, W3T, MTOK, SWA_IN, DM}; pg8::StaticOrder S; S.init(MTOK, SWA_IN, G, bx, (DUP_MASK >> 5) & 1);
        pg8::EpiSwaIn E{Qb, Kb, Vb, Gb, SS1, ROPE};
        pg8::gemm_phase<pg8::EpiSwaIn, pg8::StaticOrder, true, true>(lds + RING_OFF, g, S, E);
    }
    SEAM(5);
    if (IN(6)) REP(6) {
        const fa::Params P{Qb, Kb, Vb, Gb, YG, nullptr, swa_sinks, nullptr, nullptr, nullptr};
        for (int u = (G == 256 ? vcu : bx); u < NB * 4 * 16; u += G) fa::swa_unit(lds + RING_OFF, P, u >> 6, (u >> 4) & 3, u & 15);
    }
    SEAM(6);
    if (IN(7)) {
        pg8::Gemm g{YG, W4T, MTOK, DM, DM}; pg8::StaticOrder S; S.init(MTOK, DM, G, bx);
        pg8::EpiRes<false> E{nullptr, XB, nullptr};
        pg8::gemm_phase<pg8::EpiRes<false>, pg8::StaticOrder, true, true>(lds + RING_OFF, g, S, E);
    }
    SEAM(7);
    if (IN(8)) {
        f32x4 gq[8];
#pragma unroll
        for (int j = 0; j < 8; ++j) gq[j] = ((const GAS f32x4*)final_g)[lane + 64 * j];
        for (int m = gw; m < MTOK; m += NGW) {
            f32x4 v[8]; float s = 0.f;
#pragma unroll
            for (int j = 0; j < 8; ++j) { const unsigned long long xw = *(const GAS unsigned long long*)(XB + tiled_off(m, 256 * j + 4 * lane)); const unsigned lo32 = (unsigned)xw, hi32 = (unsigned)(xw >> 32);
                v[j] = (f32x4){__uint_as_float(lo32 << 16), __uint_as_float(lo32 & 0xffff0000u), __uint_as_float(hi32 << 16), __uint_as_float(hi32 & 0xffff0000u)};
                s += (v[j].x * v[j].x + v[j].y * v[j].y) + (v[j].z * v[j].z + v[j].w * v[j].w); }
            const float r = 1.0f / sqrtf(wave_sum(s) * (1.f / DM) + RMS_EPS);
            GAS f32x4* xr = (GAS f32x4*)(out + (size_t)m * DM) + lane;
#pragma unroll
            for (int j = 0; j < 8; ++j) xr[64 * j] = v[j] * r * gq[j];
        }
    }
#undef IN
#undef SEAM
}

extern "C" void kernel_launch(void* const* d_in, const int* in_sizes, int n_in, void* d_out, int out_size, void* d_ws, size_t ws_size, hipStream_t stream) {
    static int grid = 0;
    if (grid == 0) {
        if (n_in != 9 || in_sizes[0] != MTOK * DM || out_size != MTOK * DM || ws_size < WS_END) { fprintf(stderr, "kernel_launch: unexpected shapes (n_in %d, in0 %d, out %d, ws %zu)\n", n_in, n_in > 0 ? in_sizes[0] : -1, out_size, ws_size); grid = -1; return; }
        int dev = 0, cus = 0, per_cu = 0;
        if (hipGetDevice(&dev) != hipSuccess || hipDeviceGetAttribute(&cus, hipDeviceAttributeMultiprocessorCount, dev) != hipSuccess) { fprintf(stderr, "kernel_launch: device query failed\n"); grid = -1; return; }
        if (hipFuncSetAttribute((const void*)mega_fwd, hipFuncAttributeMaxDynamicSharedMemorySize, LDS_BYTES) != hipSuccess) { fprintf(stderr, "kernel_launch: hipFuncSetAttribute failed\n"); grid = -1; return; }
        if (hipOccupancyMaxActiveBlocksPerMultiprocessor(&per_cu, (const void*)mega_fwd, NWAVES * 64, LDS_BYTES) != hipSuccess || per_cu < 1) { fprintf(stderr, "kernel_launch: occupancy query reports %d workgroups per CU; nothing launched\n", per_cu); (void)hipGetLastError(); grid = -1; return; }
        grid = cus;
    }
    if (grid < 0) return;
    const float* x = (const float*)d_in[0]; const float* norm_g = (const float*)d_in[1]; const float* fox_w_in = (const float*)d_in[2]; const float* fox_b_f = (const float*)d_in[3];
    const float* fox_w_out = (const float*)d_in[4]; const float* swa_w_in = (const float*)d_in[5]; const float* swa_sinks = (const float*)d_in[6]; const float* swa_w_out = (const float*)d_in[7];
    const float* final_g = (const float*)d_in[8];
    float* out = (float*)d_out; unsigned char* ws = (unsigned char*)d_ws;
    float* SS1 = (float*)(ws + WS_SS1); float* R0 = (float*)(ws + WS_R0); float* LOGF = (float*)(ws + WS_LOGF); float* CUM = (float*)(ws + WS_CUM);
    bf16_t* XB = (bf16_t*)(ws + WS_XB); bf16_t* Q = (bf16_t*)(ws + WS_Q); bf16_t* K = (bf16_t*)(ws + WS_K); bf16_t* V = (bf16_t*)(ws + WS_V); bf16_t* Gt = (bf16_t*)(ws + WS_G); bf16_t* YG = (bf16_t*)(ws + WS_YG);
    (void)hipMemsetAsync(ws + WS_CTL, 0, CTL_ZERO_BYTES, stream);
    Args a{};
    for (int i = 0; i < 9; ++i) a.in[i] = (const float*)d_in[i];
    a.out = out; a.ws = ws;
    (void)x; (void)norm_g; (void)fox_w_in; (void)fox_b_f; (void)fox_w_out; (void)swa_w_in; (void)swa_sinks; (void)swa_w_out; (void)final_g; (void)SS1; (void)R0; (void)LOGF; (void)CUM; (void)XB; (void)Q; (void)K; (void)V; (void)Gt; (void)YG;
    int p = 0;
    while (p < N_PHASES) {
        if ((FAST_MASK >> p) & 1) {
            int e = p + 1; if (ONE_LAUNCH) while (e < N_PHASES && ((FAST_MASK >> e) & 1)) ++e;
            a.ph_lo = p; a.ph_hi = e;
            hipLaunchKernelGGL(mega_fwd, dim3(grid), dim3(NWAVES * 64), LDS_BYTES, stream, a);
            p = e; continue;
        }
#if FAST_MASK != 0x1FF
        switch (p) {
        case 0: n_rowrms<<<MTOK / 4, 256, 0, stream>>>(x, R0); break;
        case 1: n_gemm<float, NEpiFoxIn><<<dim3((FOX_IN + 63) / 64, MTOK / 64), 256, 0, stream>>>(x, DM, norm_g, fox_w_in, FOX_IN, DM, FOX_IN, NEpiFoxIn{Q, K, V, Gt, LOGF, R0, fox_b_f}); break;
        case 2: n_cumsum<<<2, 64, 0, stream>>>(LOGF, CUM); break;
        case 3: n_attn<0><<<dim3(SEQ / 256, NB * NH), 256, 0, stream>>>(Q, K, V, CUM, nullptr, Gt, YG); break;
        case 4: n_gemm<bf16_t, NEpiOut1><<<dim3(DM / 64, MTOK / 64), 256, 0, stream>>>(YG, DM, nullptr, fox_w_out, DM, DM, DM, NEpiOut1{x, out, XB, SS1}); break;
        case 5: n_gemm<float, NEpiSwaIn><<<dim3(SWA_IN / 64, MTOK / 64), 256, 0, stream>>>(out, DM, norm_g + DM, swa_w_in, SWA_IN, DM, SWA_IN, NEpiSwaIn{Q, K, V, Gt, SS1});
                n_rope<<<(MTOK * NH * 8 + 255) / 256, 256, 0, stream>>>(Q, DM, NH); n_rope<<<(MTOK * 4 * 8 + 255) / 256, 256, 0, stream>>>(K, KVW, 4); break;
        case 6: n_attn<1><<<dim3(SEQ / 256, NB * NH), 256, 0, stream>>>(Q, K, V, nullptr, swa_sinks, Gt, YG); break;
        case 7: n_gemm<bf16_t, NEpiOut2><<<dim3(DM / 64, MTOK / 64), 256, 0, stream>>>(YG, DM, nullptr, swa_w_out, DM, DM, DM, NEpiOut2{out}); break;
        case 8: n_finalnorm<<<MTOK / 4, 256, 0, stream>>>(out, final_g); break;
        }
#endif
        ++p;
    }
}
```

```cpp
#include <hip/hip_runtime.h>
#include <cstdio>
#include <cstdint>

constexpr int NB = 4, SEQ = 4096, DM = 2048, MTOK = NB * SEQ, NH = 32, HD = 64;
constexpr int FOX_IN = 8224, SWA_IN = 4608, KVW = 256;
constexpr float RMS_EPS = 1e-6f;
constexpr float LOG2E = 1.4426950408889634f;
constexpr float C2 = 0.125f * LOG2E;

typedef unsigned short bf16_t;
__device__ __forceinline__ float bf2f(bf16_t v) { return __uint_as_float((unsigned)v << 16); }
__device__ __forceinline__ bf16_t f2bf(float f) { unsigned u = __float_as_uint(f); return (bf16_t)((u + 0x7fffu + ((u >> 16) & 1u)) >> 16); }
__device__ __forceinline__ float logsigmoidf(float z) { return z < 0.f ? z - log1pf(expf(z)) : -log1pf(expf(-z)); }
__device__ __forceinline__ float siluf(float g) { return g / (1.f + expf(-g)); }

__host__ __device__ __forceinline__ size_t tiled_off(int row, int k) { return ((size_t)((row >> 8) * (DM / 64) + (k >> 6)) << 14) + (size_t)(((row & 255) << 6) + (k & 63)); }

__host__ __device__ __forceinline__ size_t hm_off(int row  , int col  , int nheads) { return ((size_t)((row >> 12) * nheads + (col >> 6)) * SEQ + (row & 4095)) * 64 + (col & 63); }

constexpr size_t MiB = 1u << 20;
constexpr size_t WS_CTL = 0, CTL_ZERO_BYTES = 1 * MiB;
constexpr size_t WS_KMAX = 64 * 1024, WS_TICKET = 66 * 1024;
constexpr size_t WS_SS1 = 512 * 1024;
constexpr size_t WS_R0 = 1 * MiB;
constexpr size_t WS_ROPE = 1 * MiB + 512 * 1024;
constexpr size_t WS_LOGF = 2 * MiB;
constexpr size_t WS_CUM = 4 * MiB;
constexpr size_t WS_W1T = 8 * MiB, WS_W2T = 41 * MiB, WS_W3T = 49 * MiB, WS_W4T = 67 * MiB;
constexpr size_t WS_XB = 76 * MiB, WS_Q = 140 * MiB, WS_K = 204 * MiB, WS_V = 268 * MiB, WS_G = 332 * MiB, WS_YG = 396 * MiB, WS_KAUG = 460 * MiB, WS_END = 468 * MiB;

#ifndef FAST_MASK
#define FAST_MASK 0x1FF
#endif
#ifndef DUP_MASK
#define DUP_MASK 0x000
#endif
#ifndef ONE_LAUNCH
#define ONE_LAUNCH 1
#endif
namespace pg8 {
#define PG8_LAS __attribute__((address_space(3)))
typedef unsigned short bf16_t;
typedef short bf16x8 __attribute__((ext_vector_type(8)));
typedef float f32x4 __attribute__((ext_vector_type(4)));
typedef unsigned u32x4 __attribute__((ext_vector_type(4)));
constexpr int BM = 256, BK = 64, HALF = 128, HTB = HALF * BK * 2  , STAGE_BYTES = 8 * HTB, NXCD = 8, WGM = 8;

__host__ __device__ __forceinline__ int lds_byte(int r, int c) { const int st = (r >> 4) * 2 + (c >> 5), rr = r & 15, cc = c & 31, ob = rr * 64 + cc * 2; return st * 1024 + (ob ^ (((ob >> 9) & 1) << 5)); }
__host__ __device__ __forceinline__ void stage_rc(int b, int& R, int& C) { const int st = b / 1024, sb = b % 1024, swz = sb ^ (((sb >> 9) & 1) << 5); R = (st >> 1) * 16 + swz / 64; C = (st & 1) * 32 + (swz % 64) / 2; }
__host__ __device__ __forceinline__ int perm32(int rho) { const int n = rho >> 4, i = rho & 15; return 8 * (i >> 2) + 4 * n + (i & 3); }

struct Unit { int pm, pn, lm, ln; };
struct Gemm { const bf16_t* A; const bf16_t* Bt; int M, N, K; };

struct StaticOrder {
    int nM, nN, nwg, G, c, dup, epi2, same;
    __host__ __device__ void init(int M, int N, int G_, int c_, int dup_ = 0, int epi2_ = 0, int same_ = 0) { nM = M / BM; nN = N / BM; nwg = nM * nN; G = G_; c = c_; dup = dup_; epi2 = epi2_; same = same_; }
    __host__ __device__ bool next(int i, Unit& u) const {
        if (dup) i >>= 1;
        const long L = (long)i * G + c; if (L >= nwg) return false;
        int wgid = (int)L; { const int q = nwg / NXCD, r = nwg % NXCD, xcd = wgid % NXCD, off = wgid / NXCD; wgid = (xcd < r ? xcd * (q + 1) : r * (q + 1) + (xcd - r) * q) + off; }
        const int nig = WGM * nN, gid = wgid / nig, fm = gid * WGM, gsz = (nM - fm) < WGM ? (nM - fm) : WGM;
        u.pm = fm + ((wgid % nig) % gsz); u.pn = (wgid % nig) / gsz; u.lm = same ? 0 : u.pm; u.ln = same ? 0 : u.pn; return true;
    }
    __device__ __forceinline__ void a_ready(const Unit&) const {}
    __device__ __forceinline__ void done(const Unit&) const {}
};

__device__ __forceinline__ unsigned cvt_pk_bf16(float lo, float hi) { unsigned r; asm volatile("v_cvt_pk_bf16_f32 %0, %1, %2" : "=v"(r) : "v"(lo), "v"(hi)); return r; }
__device__ __forceinline__ float silu_fast(float g) { return g * __builtin_amdgcn_rcpf(1.0f + __builtin_amdgcn_exp2f(-g * 1.4426950408889634f)); }
__device__ __forceinline__ u32x4 pack8(const f32x4 v0, const f32x4 v1) { u32x4 w; w.x = cvt_pk_bf16(v0[0], v0[1]); w.y = cvt_pk_bf16(v0[2], v0[3]); w.z = cvt_pk_bf16(v1[0], v1[1]); w.w = cvt_pk_bf16(v1[2], v1[3]); return w; }
struct EpiFoxIn {
    static constexpr bool PERM = true, AFTER_DRAIN = false;
    bf16_t *Q, *K, *V, *G; float* LOGF; const float* R0; const float* bfb; unsigned* KMAX;
    __device__ __forceinline__ void operator()(const f32x4 (&acc)[2][2][4][2], const Unit& u, int wr, int wc, int fr, int fq) const {
        const int row0 = u.pm * BM + wr * 64 + fr, pn = u.pn;
        float rs[2][4];
#pragma unroll
        for (int ai = 0; ai < 2; ++ai)
#pragma unroll
            for (int m = 0; m < 4; ++m) rs[ai][m] = R0[row0 + ai * HALF + m * 16];
        if (pn < 32) {
            const int reg = pn >> 3; bf16_t* base = reg == 0 ? Q : reg == 1 ? K : reg == 2 ? V : G; float kmx[2] = {0.f, 0.f};
            const int col0 = (pn & 7) * BM + wc * 32 + 8 * fq;
#pragma unroll
            for (int ai = 0; ai < 2; ++ai)
#pragma unroll
                for (int m = 0; m < 4; ++m) { const int row = row0 + ai * HALF + m * 16; const float r = rs[ai][m]; const float sc = reg == 0 ? r * C2 : r;
#pragma unroll
                    for (int bj = 0; bj < 2; ++bj) { f32x4 v0 = acc[ai][bj][m][0] * sc, v1 = acc[ai][bj][m][1] * sc;
                        if (reg == 3) {
#pragma unroll
                            for (int j = 0; j < 4; ++j) { v0[j] = silu_fast(v0[j]); v1[j] = silu_fast(v1[j]); } }
                        if (reg == 1) { float ss = ((v0[0] * v0[0] + v0[1] * v0[1]) + (v0[2] * v0[2] + v0[3] * v0[3])) + ((v1[0] * v1[0] + v1[1] * v1[1]) + (v1[2] * v1[2] + v1[3] * v1[3]));
                            ss += __shfl_xor(ss, 16); ss += __shfl_xor(ss, 32); kmx[bj] = fmaxf(kmx[bj], ss); }
                        __builtin_nontemporal_store(pack8(v0, v1), (u32x4*)(base + hm_off(row, col0 + bj * HALF, NH))); } }
            if (reg == 1) {
#pragma unroll
                for (int bj = 0; bj < 2; ++bj) { float mx = kmx[bj];
#pragma unroll
                    for (int o = 1; o < 16; o <<= 1) mx = fmaxf(mx, __shfl_xor(mx, o));
                    if (fr == 0 && fq == 0) atomicMax(KMAX + ((row0 >> 12) * NH + (pn & 7) * 4 + bj * 2 + (wc >> 1)) * 2 + (wc & 1), __float_as_uint(mx)); } }
        } else if (wc == 0) {
#pragma unroll
            for (int ai = 0; ai < 2; ++ai)
#pragma unroll
                for (int m = 0; m < 4; ++m) { const int row = row0 + ai * HALF + m * 16; const float r = rs[ai][m]; const int b = row >> 12, s = row & 4095;
#pragma unroll
                    for (int n = 0; n < 2; ++n)
#pragma unroll
                        for (int j = 0; j < 4; ++j) { const int h = 8 * fq + 4 * n + j; LOGF[((size_t)(b * NH + h) << 12) + s] = logsigmoidf(acc[ai][0][m][n][j] * r + bfb[h]); } }
        }
    }
};
struct EpiSwaIn {
    static constexpr bool PERM = true, AFTER_DRAIN = false;
    bf16_t *Q, *K, *V, *G; const float* SS; const float* ROPE;
    __device__ __forceinline__ void operator()(const f32x4 (&acc)[2][2][4][2], const Unit& u, int wr, int wc, int fr, int fq) const {
        const int row0 = u.pm * BM + wr * 64 + fr, pn = u.pn;
        bf16_t* base; int pitch, colt; float osc = 1.f; const bool rope = pn <= 8, gate = pn >= 10;
        if (pn < 8) { base = Q; pitch = DM; colt = pn * BM; osc = C2; } else if (pn == 8) { base = K; pitch = KVW; colt = 0; } else if (pn == 9) { base = V; pitch = KVW; colt = 0; } else { base = G; pitch = DM; colt = (pn - 10) * BM; }
        const int col0 = colt + wc * 32 + 8 * fq; const bool rotw = rope && ((wc & 1) == 0); const float sgn = fq == 0 ? -1.f : 1.f; const bool rotl = fq < 2;
        float rs[2][4];
#pragma unroll
        for (int ai = 0; ai < 2; ++ai)
#pragma unroll
            for (int m = 0; m < 4; ++m) rs[ai][m] = SS[row0 + ai * HALF + m * 16];
        f32x4 nc0, nc1, ns0, ns1;
        if (rotw) { const float* rp = ROPE + (size_t)(row0 & 4095) * 16; nc0 = *(const f32x4*)rp; nc1 = *(const f32x4*)(rp + 4); ns0 = *(const f32x4*)(rp + 8); ns1 = *(const f32x4*)(rp + 12); }
#pragma unroll
        for (int ai = 0; ai < 2; ++ai)
#pragma unroll
            for (int m = 0; m < 4; ++m) { const int row = row0 + ai * HALF + m * 16; const float r = 1.0f / sqrtf(rs[ai][m] * (1.f / DM) + RMS_EPS);
                const f32x4 c0 = nc0, c1 = nc1, s0 = ns0, s1 = ns1;
                if (rotw && (ai * 4 + m) < 7) { const int nrow = row0 + ((ai * 4 + m + 1) >> 2) * HALF + ((ai * 4 + m + 1) & 3) * 16; const float* rp = ROPE + (size_t)(nrow & 4095) * 16; nc0 = *(const f32x4*)rp; nc1 = *(const f32x4*)(rp + 4); ns0 = *(const f32x4*)(rp + 8); ns1 = *(const f32x4*)(rp + 12); }
#pragma unroll
                for (int bj = 0; bj < 2; ++bj) { f32x4 v0 = acc[ai][bj][m][0] * r, v1 = acc[ai][bj][m][1] * r;
                    if (rotw) {
#pragma unroll
                        for (int j = 0; j < 4; ++j) { const float p0 = __shfl_xor(v0[j], 16), p1 = __shfl_xor(v1[j], 16);
                            const float n0 = v0[j] * c0[j] + sgn * p0 * s0[j], n1 = v1[j] * c1[j] + sgn * p1 * s1[j];
                            v0[j] = rotl ? n0 : v0[j]; v1[j] = rotl ? n1 : v1[j]; } }
                    if (gate) {
#pragma unroll
                        for (int j = 0; j < 4; ++j) { v0[j] = silu_fast(v0[j]); v1[j] = silu_fast(v1[j]); } }
                    v0 = v0 * osc; v1 = v1 * osc;
                    *(u32x4*)(base + hm_off(row, col0 + bj * HALF, pitch >> 6)) = pack8(v0, v1); } }
    }
};
template <bool FIRST> struct EpiRes {
    static constexpr bool PERM = false, AFTER_DRAIN = false;
    const float* xin; bf16_t* XB; float* SS;
    __device__ __forceinline__ void operator()(const f32x4 (&acc)[2][2][4][2], const Unit& u, int wr, int wc, int fr, int fq) const {
        typedef unsigned u32x2v __attribute__((ext_vector_type(2)));
        const int row0 = u.pm * BM + wr * 64 + fr, col0 = u.pn * BM + wc * 32 + 4 * fq;
        if (FIRST) {
            f32x4 nx[2][2];
#pragma unroll
            for (int bj = 0; bj < 2; ++bj)
#pragma unroll
                for (int n = 0; n < 2; ++n) nx[bj][n] = *(const f32x4*)(xin + (size_t)row0 * DM + col0 + bj * HALF + n * 16);
#pragma unroll
            for (int ai = 0; ai < 2; ++ai)
#pragma unroll
                for (int m = 0; m < 4; ++m) { const int row = row0 + ai * HALF + m * 16; float ss = 0.f;
                    f32x4 cx[2][2];
#pragma unroll
                    for (int bj = 0; bj < 2; ++bj)
#pragma unroll
                        for (int n = 0; n < 2; ++n) cx[bj][n] = nx[bj][n];
                    if ((ai * 4 + m) < 7) { const int nrow = row0 + ((ai * 4 + m + 1) >> 2) * HALF + ((ai * 4 + m + 1) & 3) * 16;
#pragma unroll
                        for (int bj = 0; bj < 2; ++bj)
#pragma unroll
                            for (int n = 0; n < 2; ++n) nx[bj][n] = *(const f32x4*)(xin + (size_t)nrow * DM + col0 + bj * HALF + n * 16); }
#pragma unroll
                    for (int bj = 0; bj < 2; ++bj)
#pragma unroll
                        for (int n = 0; n < 2; ++n) { const f32x4 x1 = cx[bj][n] + acc[ai][bj][m][n];
                            u32x2v w; w.x = cvt_pk_bf16(x1[0], x1[1]); w.y = cvt_pk_bf16(x1[2], x1[3]); *(u32x2v*)(XB + tiled_off(row, col0 + bj * HALF + n * 16)) = w;
                            ss += (x1[0] * x1[0] + x1[1] * x1[1]) + (x1[2] * x1[2] + x1[3] * x1[3]); }
                    ss += __shfl_xor(ss, 16); ss += __shfl_xor(ss, 32); if (fq == 0) atomicAdd(SS + row, ss); }
        } else {
            u32x2v xv[2][4][2][2];
#pragma unroll
            for (int ai = 0; ai < 2; ++ai)
#pragma unroll
                for (int m = 0; m < 4; ++m)
#pragma unroll
                    for (int bj = 0; bj < 2; ++bj)
#pragma unroll
                        for (int n = 0; n < 2; ++n) xv[ai][m][bj][n] = *(const u32x2v*)(XB + tiled_off(row0 + ai * HALF + m * 16, col0 + bj * HALF + n * 16));
#pragma unroll
            for (int ai = 0; ai < 2; ++ai)
#pragma unroll
                for (int m = 0; m < 4; ++m)
#pragma unroll
                    for (int bj = 0; bj < 2; ++bj)
#pragma unroll
                        for (int n = 0; n < 2; ++n) { const u32x2v xw = xv[ai][m][bj][n]; const f32x4 a = acc[ai][bj][m][n];
                            u32x2v w; w.x = cvt_pk_bf16(__uint_as_float(xw.x << 16) + a[0], __uint_as_float(xw.x & 0xffff0000u) + a[1]); w.y = cvt_pk_bf16(__uint_as_float(xw.y << 16) + a[2], __uint_as_float(xw.y & 0xffff0000u) + a[3]);
                            *(u32x2v*)(XB + tiled_off(row0 + ai * HALF + m * 16, col0 + bj * HALF + n * 16)) = w; }
        }
    }
};
template <class Epi, class Sched, bool ALIGN_EPI = false, bool SP2 = false>
__device__ __forceinline__ void gemm_phase(PG8_LAS unsigned char* lds, const Gemm g, const Sched& S, const Epi& E) {
    const int tid = threadIdx.x, wid = __builtin_amdgcn_readfirstlane(tid >> 6), lane = tid & 63, wr = wid >> 2, wc = wid & 3, fr = lane & 15, fq = lane >> 4;
    const int K = g.K, nt = K / BK;
    unsigned voffA[2], voffB[2];
#pragma unroll
    for (int i = 0; i < 2; ++i) { int R, C; stage_rc(tid * 16 + i * 8192, R, C); const int Rb = Epi::PERM ? ((R & ~31) + perm32(R & 31)) : R;
        voffA[i] = (unsigned)(R * BK + C) * 2u; voffB[i] = (unsigned)(Rb * BK + C) * 2u; }
    const size_t kstep = (size_t)(BM * BK * 2);
    const size_t hstep = (size_t)(HALF * BK * 2);
    const size_t tstep = (size_t)BM * K * 2;
    const unsigned ldsw = (unsigned)wid * 1024u;
    const int aoff = lds_byte(wr * 64 + fr, fq * 8), boff = lds_byte(wc * 32 + fr, fq * 8);
#define PG8_SA(b, h) (((b) * 2 + (h)) * HTB)
#define PG8_SB(b, h) ((4 + (b) * 2 + (h)) * HTB)
#define PG8_STAGE(bufoff, gbase, voff) do { _Pragma("unroll") for (int _i = 0; _i < 2; ++_i) \
        __builtin_amdgcn_global_load_lds((const unsigned*)((const char*)(gbase) + (voff)[_i]), (PG8_LAS unsigned*)(lds + (bufoff) + ldsw + _i * 8192), 16, 0, 0); } while (0)
#define PG8_LDA(dst, b, h) do { _Pragma("unroll") for (int m = 0; m < 4; ++m) _Pragma("unroll") for (int k = 0; k < 2; ++k) dst[m][k] = *(const PG8_LAS bf16x8*)(lds + PG8_SA(b, h) + aoff + m * 2048 + k * 1024); } while (0)
#define PG8_LDB(dst, b, h) do { _Pragma("unroll") for (int n = 0; n < 2; ++n) _Pragma("unroll") for (int k = 0; k < 2; ++k) dst[n][k] = *(const PG8_LAS bf16x8*)(lds + PG8_SB(b, h) + boff + n * 2048 + k * 1024); } while (0)
#define PG8_MMA(ai, bj, At, Bt) do { __builtin_amdgcn_s_setprio(1); _Pragma("unroll") for (int m = 0; m < 4; ++m) _Pragma("unroll") for (int n = 0; n < 2; ++n) _Pragma("unroll") for (int k = 0; k < 2; ++k) \
        acc[ai][bj][m][n] = __builtin_amdgcn_mfma_f32_16x16x32_bf16(Bt[n][k], At[m][k], acc[ai][bj][m][n], 0, 0, 0); __builtin_amdgcn_s_setprio(0); } while (0)
#define PG8_WAIT_V(n) asm volatile("s_waitcnt vmcnt(" #n ")" ::: "memory")
#define PG8_WAIT_L(n) asm volatile("s_waitcnt lgkmcnt(" #n ")" ::: "memory")
#define PG8_BAR __builtin_amdgcn_s_barrier()
#define PG8_SCHED __builtin_amdgcn_sched_barrier(0)
    Unit cur, nxt; int ui = 0;
    if (!S.next(0, cur)) return;
    f32x4 acc[2][2][4][2];
#pragma unroll
    for (int a = 0; a < 2; ++a)
#pragma unroll
        for (int b = 0; b < 2; ++b)
#pragma unroll
            for (int m = 0; m < 4; ++m)
#pragma unroll
                for (int n = 0; n < 2; ++n) acc[a][b][m][n] = (f32x4){0.f, 0.f, 0.f, 0.f};
    bf16x8 At[4][2], B0[2][2], B1[2][2];
    const char* cA = (const char*)g.A + (size_t)cur.lm * tstep; const char* cB = (const char*)g.Bt + (size_t)cur.ln * tstep;
    S.a_ready(cur);
    if constexpr (SP2) {
        PG8_STAGE(PG8_SB(0, 0), cB, voffB); PG8_STAGE(PG8_SB(0, 1), cB + hstep, voffB); PG8_STAGE(PG8_SA(0, 0), cA, voffA); PG8_STAGE(PG8_SA(0, 1), cA + hstep, voffA);
        if (wr == 1) PG8_BAR;
        PG8_WAIT_V(2); PG8_BAR;
        PG8_STAGE(PG8_SB(1, 0), cB + kstep, voffB); PG8_STAGE(PG8_SA(1, 0), cA + kstep, voffA); PG8_STAGE(PG8_SB(1, 1), cB + hstep + kstep, voffB);
        PG8_WAIT_V(6); PG8_BAR;
    } else {
        PG8_STAGE(PG8_SB(0, 0), cB, voffB); PG8_STAGE(PG8_SA(0, 0), cA, voffA); PG8_STAGE(PG8_SB(0, 1), cB + hstep, voffB); PG8_STAGE(PG8_SA(0, 1), cA + hstep, voffA);
        if (wr == 1) PG8_BAR;
        PG8_WAIT_V(4); PG8_BAR;
        PG8_STAGE(PG8_SB(1, 0), cB + kstep, voffB); PG8_STAGE(PG8_SA(1, 0), cA + kstep, voffA); PG8_STAGE(PG8_SB(1, 1), cB + hstep + kstep, voffB);
        PG8_WAIT_V(6); PG8_BAR;
    }
    for (;;) {
        const bool has_next = S.next(ui + 1, nxt);
        const char* nA = has_next ? (const char*)g.A + (size_t)nxt.lm * tstep : cA; const char* nB = has_next ? (const char*)g.Bt + (size_t)nxt.ln * tstep : cB;
        for (int t = 0; t < nt; t += 2) {
            const bool last = (t == nt - 2);
            const char* a1 = cA + (size_t)(t + 1) * kstep;
            const char* a2 = last ? nA : cA + (size_t)(t + 2) * kstep; const char* b2 = last ? nB : cB + (size_t)(t + 2) * kstep;
            const char* a3 = a2 + kstep; const char* b3 = b2 + kstep;
            if (last && has_next) S.a_ready(nxt);
            if constexpr (SP2) {
            PG8_LDB(B0, 0, 0); PG8_LDB(B1, 0, 1); PG8_SCHED; PG8_LDA(At, 0, 0); PG8_STAGE(PG8_SA(1, 1), a1 + hstep, voffA);
            PG8_WAIT_V(8); PG8_WAIT_L(0); PG8_BAR; PG8_MMA(0, 0, At, B0); PG8_MMA(0, 1, At, B1); PG8_BAR; PG8_SCHED;
            PG8_LDA(At, 0, 1); PG8_STAGE(PG8_SB(0, 0), b2, voffB); PG8_STAGE(PG8_SB(0, 1), b2 + hstep, voffB); PG8_STAGE(PG8_SA(0, 0), a2, voffA);
            PG8_WAIT_V(8); PG8_WAIT_L(0); PG8_BAR; PG8_MMA(1, 0, At, B0); PG8_MMA(1, 1, At, B1); PG8_BAR; PG8_SCHED;
            PG8_LDB(B0, 1, 0); PG8_LDB(B1, 1, 1); PG8_SCHED; PG8_LDA(At, 1, 0); PG8_STAGE(PG8_SA(0, 1), a2 + hstep, voffA);
            PG8_WAIT_V(8); PG8_WAIT_L(0); PG8_BAR; PG8_MMA(0, 0, At, B0); PG8_MMA(0, 1, At, B1); PG8_BAR; PG8_SCHED;
            PG8_LDA(At, 1, 1); PG8_STAGE(PG8_SB(1, 0), b3, voffB); PG8_STAGE(PG8_SB(1, 1), b3 + hstep, voffB); PG8_STAGE(PG8_SA(1, 0), a3, voffA);
            PG8_WAIT_V(8); PG8_WAIT_L(0); PG8_BAR; PG8_MMA(1, 0, At, B0); PG8_MMA(1, 1, At, B1); PG8_BAR; PG8_SCHED;
            } else {
            PG8_LDB(B0, 0, 0); PG8_SCHED; PG8_LDA(At, 0, 0); PG8_STAGE(PG8_SA(1, 1), a1 + hstep, voffA);
            PG8_WAIT_L(8); PG8_BAR; PG8_WAIT_L(0); PG8_MMA(0, 0, At, B0); PG8_BAR; PG8_SCHED;
            PG8_LDB(B1, 0, 1); PG8_STAGE(PG8_SB(0, 0), b2, voffB);
            PG8_BAR; PG8_WAIT_L(0); PG8_MMA(0, 1, At, B1); PG8_BAR;
            PG8_LDA(At, 0, 1); PG8_STAGE(PG8_SA(0, 0), a2, voffA);
            PG8_BAR; PG8_WAIT_L(0); PG8_MMA(1, 0, At, B0); PG8_BAR; PG8_SCHED;
            PG8_STAGE(PG8_SB(0, 1), b2 + hstep, voffB);
            PG8_WAIT_V(6); PG8_BAR; PG8_MMA(1, 1, At, B1); PG8_BAR;
            PG8_LDB(B0, 1, 0); PG8_SCHED; PG8_LDA(At, 1, 0); PG8_STAGE(PG8_SA(0, 1), a2 + hstep, voffA);
            PG8_WAIT_L(8); PG8_BAR; PG8_WAIT_L(0); PG8_MMA(0, 0, At, B0); PG8_BAR; PG8_SCHED;
            PG8_LDB(B1, 1, 1); PG8_STAGE(PG8_SB(1, 0), b3, voffB);
            PG8_BAR; PG8_WAIT_L(0); PG8_MMA(0, 1, At, B1); PG8_BAR;
            PG8_LDA(At, 1, 1); PG8_STAGE(PG8_SA(1, 0), a3, voffA);
            PG8_BAR; PG8_WAIT_L(0); PG8_MMA(1, 0, At, B0); PG8_BAR; PG8_SCHED;
            PG8_STAGE(PG8_SB(1, 1), b3 + hstep, voffB);
            PG8_WAIT_V(6); PG8_BAR; PG8_MMA(1, 1, At, B1); PG8_BAR;
            }
        }
        if constexpr (ALIGN_EPI) { if (wr == 0) PG8_BAR; }
        if constexpr (!Epi::AFTER_DRAIN) { E(acc, cur, wr, wc, fr, fq); if (S.epi2) E(acc, cur, wr, wc, fr, fq); S.done(cur); }
        if (!has_next) break;
#pragma unroll
        for (int a = 0; a < 2; ++a)
#pragma unroll
            for (int b = 0; b < 2; ++b)
#pragma unroll
                for (int m = 0; m < 4; ++m)
#pragma unroll
                    for (int n = 0; n < 2; ++n) acc[a][b][m][n] = (f32x4){0.f, 0.f, 0.f, 0.f};
        cur = nxt; cA = nA; cB = nB; ++ui;
        if constexpr (ALIGN_EPI) { if (wr == 1) PG8_BAR; }
    }
    PG8_WAIT_V(0);
    if constexpr (!ALIGN_EPI) { if (wr == 0) PG8_BAR; }
    PG8_BAR;
    if constexpr (Epi::AFTER_DRAIN) { E.fused(acc, cur, wr, wc, fr, fq, lds, wid, lane); S.done(cur); }
#undef PG8_SA
#undef PG8_SB
#undef PG8_STAGE
#undef PG8_LDA
#undef PG8_LDB
#undef PG8_MMA
#undef PG8_WAIT_V
#undef PG8_WAIT_L
#undef PG8_BAR
#undef PG8_SCHED
}
}
namespace fa {
#define FA_LAS __attribute__((address_space(3)))
typedef short bf16x8 __attribute__((ext_vector_type(8)));
typedef short s16x4 __attribute__((ext_vector_type(4)));
typedef short v4i16_t __attribute__((ext_vector_type(4)));
typedef float f32x16 __attribute__((ext_vector_type(16)));
typedef float f32x4 __attribute__((ext_vector_type(4)));
typedef unsigned u32x4 __attribute__((ext_vector_type(4)));
typedef float f32x2_t __attribute__((ext_vector_type(2))); typedef __bf16 bf16x2_t __attribute__((ext_vector_type(2)));
constexpr float THR = 8.f, TH_SKIP = 32.f;
constexpr int F_KBUF = 18432, F_AOFF = 8192, F_VOFF = 10240, F_WSF = 3 * F_KBUF, F_FLAG = F_WSF + 8 * 256, F_OST = F_FLAG + 256, F_LDS_BYTES = F_OST + 8 * 4096;
constexpr int S_KBUF = 16384, S_VOFF = 8192, S_WSF = 6 * S_KBUF, S_OST = S_WSF + 8 * 256, S_LDS_BYTES = S_OST + 8 * 4096;
struct Params { const bf16_t* Q; const bf16_t* K; const bf16_t* V; const bf16_t* G; bf16_t* O; const float* CUM; const float* sinks; const unsigned* KMAX; unsigned* ticket; const bf16_t* KAUG; };
__device__ __forceinline__ unsigned cvtpk(float lo, float hi) { f32x2_t v = {lo, hi}; bf16x2_t b = __builtin_convertvector(v, bf16x2_t); return __builtin_bit_cast(unsigned, b); }
__device__ __forceinline__ s16x4 vtr(FA_LAS unsigned char* p) { return __builtin_bit_cast(s16x4, __builtin_amdgcn_ds_read_tr16_b64_v4i16((FA_LAS v4i16_t*)p)); }
__device__ __forceinline__ float swap_max(float v) { auto rr = __builtin_amdgcn_permlane32_swap(__float_as_uint(v), __float_as_uint(v), false, false); return __builtin_fmaxf(__uint_as_float(rr[0]), __uint_as_float(rr[1])); }
__device__ __forceinline__ float swap_add(float v) { auto rr = __builtin_amdgcn_permlane32_swap(__float_as_uint(v), __float_as_uint(v), false, false); return __uint_as_float(rr[0]) + __uint_as_float(rr[1]); }
__device__ __forceinline__ void glds16(const void* gsrc, unsigned lds_dst) { unsigned keep;
    asm volatile("s_mov_b32 %0, m0\n\ts_mov_b32 m0, %2\n\ts_nop 0\n\tglobal_load_lds_dwordx4 %1, off\n\ts_mov_b32 m0, %0" : "=&s"(keep) : "v"(gsrc), "s"(lds_dst) : "memory"); }
#define FA_MFMA(a, b, c) __builtin_amdgcn_mfma_f32_32x32x16_bf16((a), (b), (c), 0, 0, 0)
#define FA_MX3(a, b, c) __builtin_fmaxf(__builtin_fmaxf((a), (b)), (c))
struct WaveSt { bf16x8 qr[4]; bf16x8 qa; f32x16 cinit, o0, o1; float cq, mhat, lsum, mrun; };

#define FA_SBAR() __builtin_amdgcn_sched_barrier(0)
#define FA_PIN(x) asm volatile("" : "+v"(x))
#define FA_LDK(p) (*(FA_LAS bf16x8*)(p))
#define FA_VF(l, h) ((bf16x8){l[0], l[1], l[2], l[3], h[0], h[1], h[2], h[3]})
#define FA_EX4(X, B) do { X[B] = __builtin_amdgcn_exp2f(X[B]); X[B + 1] = __builtin_amdgcn_exp2f(X[B + 1]); X[B + 2] = __builtin_amdgcn_exp2f(X[B + 2]); X[B + 3] = __builtin_amdgcn_exp2f(X[B + 3]); } while (0)
__device__ __forceinline__ void split3(float v, unsigned& h1, unsigned& h2, unsigned& h3) { const bf16_t a = f2bf(v); const float r1 = v - bf2f(a); const bf16_t b = f2bf(r1); const float r2 = r1 - bf2f(b); h1 = a; h2 = b; h3 = f2bf(r2); }
__device__ __forceinline__ void set_qa(WaveSt& w, int hi) {
    unsigned g1, g2, g3; split3(w.cq - w.mhat, g1, g2, g3);
    const u32x4 q = {hi == 0 ? 0x3F803F80u : 0u, hi == 0 ? (0x3F80u | (g1 << 16)) : 0u, hi == 0 ? (g2 | (g3 << 16)) : 0u, 0u};
    w.qa = __builtin_bit_cast(bf16x8, q);
}
template <int MODE, int AOFF, int VOFF, int HB>
__device__ __forceinline__ void half_step(FA_LAS unsigned char* bb, FA_LAS unsigned char* vprev, FA_LAS float* wsf, WaveSt& w, f32x16& C, f32x16& P, int k0, int t, int qlo, int lane, int r32, int hi) {
    constexpr int W = MODE == 0 ? 0x40000000 : 128;
    FA_LAS unsigned char* kp = bb + hi * 1024 + r32 * 16 + HB * 512; FA_LAS unsigned char* ap = bb + AOFF + r32 * 16 + HB * 512;
    FA_LAS unsigned char* vp = (HB == 0 ? vprev + 2048 : bb) + VOFF + ((lane >> 4) & 1) * 32 + (lane & 3) * 8 + (4 * hi + ((lane & 15) >> 2)) * 64;
    bf16x8 kf0 = FA_LDK(kp), kf1 = FA_LDK(kp + 2048), kf2, kf3, ka;
    s16x4 vl0, vh0, vl1, vh1, vl2, vh2, vl3, vh3; u32x4 pw0, pw1; float sacc;
    FA_SBAR();
    if (MODE == 0) C = FA_MFMA(kf0, w.qr[0], ((f32x16){0.f, 0.f, 0.f, 0.f, 0.f, 0.f, 0.f, 0.f, 0.f, 0.f, 0.f, 0.f, 0.f, 0.f, 0.f, 0.f})); else C = FA_MFMA(kf0, w.qr[0], w.cinit);
    kf2 = FA_LDK(kp + 4096);
    sacc = (P[0] + P[1]) + (P[2] + P[3]); pw0.x = cvtpk(P[0], P[1]); pw0.y = cvtpk(P[2], P[3]); FA_PIN(sacc); FA_PIN(pw0.x); FA_PIN(pw0.y);
    FA_SBAR();
    C = FA_MFMA(kf1, w.qr[1], C); kf3 = FA_LDK(kp + 6144);
    sacc += P[4]; sacc += P[5]; sacc += P[6]; sacc += P[7]; pw0.z = cvtpk(P[4], P[5]); pw0.w = cvtpk(P[6], P[7]); FA_PIN(sacc); FA_PIN(pw0.z); FA_PIN(pw0.w);
    FA_SBAR();
    C = FA_MFMA(kf2, w.qr[2], C); if (MODE == 0) ka = FA_LDK(ap);
    sacc += P[8]; sacc += P[9]; sacc += P[10]; sacc += P[11]; pw1.x = cvtpk(P[8], P[9]); pw1.y = cvtpk(P[10], P[11]); FA_PIN(sacc); FA_PIN(pw1.x); FA_PIN(pw1.y); vl0 = vtr(vp); vh0 = vtr(vp + 512);
    FA_SBAR();
    C = FA_MFMA(kf3, w.qr[3], C);
    sacc += P[12]; sacc += P[13]; sacc += P[14]; sacc += P[15]; pw1.z = cvtpk(P[12], P[13]); pw1.w = cvtpk(P[14], P[15]); FA_PIN(sacc); FA_PIN(pw1.z); FA_PIN(pw1.w); vl1 = vtr(vp + 4096); vh1 = vtr(vp + 4096 + 512);
    FA_SBAR();
    if (MODE == 0) { C = FA_MFMA(ka, w.qa, C); FA_SBAR(); }
    w.lsum += sacc;
    const bf16x8 pa0 = __builtin_bit_cast(bf16x8, pw0), pa1 = __builtin_bit_cast(bf16x8, pw1);
    vl2 = vtr(vp + 1024); vh2 = vtr(vp + 1024 + 512);
    w.o0 = FA_MFMA(pa0, FA_VF(vl0, vh0), w.o0); vl3 = vtr(vp + 4096 + 1024); vh3 = vtr(vp + 4096 + 1024 + 512);
    w.o1 = FA_MFMA(pa0, FA_VF(vl1, vh1), w.o1);
    FA_SBAR();
    const int kh = k0 + 32 * HB;
    if ((kh + 31 > qlo) || (MODE == 1 && kh <= qlo + 31 - W)) {
        const float NEG = -__builtin_inff(); const int dq = t - kh - 4 * hi;
#pragma unroll
        for (int r = 0; r < 16; ++r) { const int c = (r & 3) + 8 * (r >> 2); if ((unsigned)(dq - c) >= (unsigned)W) C[r] = NEG; }
    }
    float ma = FA_MX3(C[0], C[1], C[2]), mb = FA_MX3(C[3], C[4], C[5]);
    ma = FA_MX3(ma, C[6], C[7]); mb = FA_MX3(mb, C[8], C[9]); ma = FA_MX3(ma, C[10], C[11]); mb = FA_MX3(mb, C[12], C[13]); ma = FA_MX3(ma, C[14], C[15]);
    const float rm = swap_max(__builtin_fmaxf(ma, mb));
    if (MODE == 0) w.mrun = __builtin_fmaxf(w.mrun, rm + w.mhat);
    const bool resc = __any(rm > THR);
    if (resc) {
        const float dl = __builtin_fmaxf(rm, 0.f); w.mhat += dl;
#pragma unroll
        for (int r = 0; r < 16; ++r) C[r] -= dl;
        if (MODE == 0) set_qa(w, hi);
        else { const float ci = w.cq - w.mhat;
#pragma unroll
            for (int r = 0; r < 16; ++r) w.cinit[r] = ci; }
        const float f = __builtin_amdgcn_exp2f(-dl); w.lsum *= f;
        if (hi == 0) wsf[r32] = f;
    }
    FA_SBAR();
    FA_EX4(C, 0); FA_PIN(C);
    w.o0 = FA_MFMA(pa1, FA_VF(vl2, vh2), w.o0); FA_EX4(C, 4); FA_EX4(C, 8); FA_PIN(C); FA_SBAR();
    w.o1 = FA_MFMA(pa1, FA_VF(vl3, vh3), w.o1); FA_EX4(C, 12); FA_PIN(C); FA_SBAR();
    if (resc) {
        asm volatile("s_waitcnt lgkmcnt(0)" ::: "memory");
#pragma unroll
        for (int g = 0; g < 4; ++g) { const f32x4 a4 = *(FA_LAS f32x4*)(wsf + 8 * g + 4 * hi);
#pragma unroll
            for (int i = 0; i < 4; ++i) { w.o0[4 * g + i] *= a4[i]; w.o1[4 * g + i] *= a4[i]; } }
    }
}
template <int MODE, int AOFF, int VOFF>
__device__ __forceinline__ void tile_step(FA_LAS unsigned char* bb, FA_LAS unsigned char* vprev, FA_LAS float* wsf, WaveSt& w, f32x16& pA, f32x16& pB, int k0, int t, int qlo, int lane, int r32, int hi) {
    half_step<MODE, AOFF, VOFF, 0>(bb, vprev, wsf, w, pA, pB, k0, t, qlo, lane, r32, hi);
    half_step<MODE, AOFF, VOFF, 1>(bb, vprev, wsf, w, pB, pA, k0, t, qlo, lane, r32, hi);
}
template <int VOFF>
__device__ __forceinline__ void tile_drain(FA_LAS unsigned char* vlast, WaveSt& w, f32x16& P, int lane, int hi) {
    FA_LAS unsigned char* vp = vlast + 2048 + VOFF + ((lane >> 4) & 1) * 32 + (lane & 3) * 8 + (4 * hi + ((lane & 15) >> 2)) * 64;
    float s0 = 0.f;
#pragma unroll
    for (int r = 0; r < 16; ++r) s0 += P[r];
    w.lsum += s0;
    const u32x4 w0 = {cvtpk(P[0], P[1]), cvtpk(P[2], P[3]), cvtpk(P[4], P[5]), cvtpk(P[6], P[7])};
    const u32x4 w1 = {cvtpk(P[8], P[9]), cvtpk(P[10], P[11]), cvtpk(P[12], P[13]), cvtpk(P[14], P[15])};
    const bf16x8 pa0 = __builtin_bit_cast(bf16x8, w0), pa1 = __builtin_bit_cast(bf16x8, w1);
    { const s16x4 l0 = vtr(vp), h0 = vtr(vp + 512), l1 = vtr(vp + 4096), h1 = vtr(vp + 4096 + 512); w.o0 = FA_MFMA(pa0, FA_VF(l0, h0), w.o0); w.o1 = FA_MFMA(pa0, FA_VF(l1, h1), w.o1); }
    { const s16x4 l0 = vtr(vp + 1024), h0 = vtr(vp + 1024 + 512), l1 = vtr(vp + 4096 + 1024), h1 = vtr(vp + 4096 + 1024 + 512); w.o0 = FA_MFMA(pa1, FA_VF(l0, h0), w.o0); w.o1 = FA_MFMA(pa1, FA_VF(l1, h1), w.o1); }
}
__device__ __forceinline__ void load_gate(u32x4 (&gq)[4], const bf16_t* G, size_t grow, int h, int lane) {
#pragma unroll
    for (int d0 = 0; d0 < 2; ++d0)
#pragma unroll
        for (int i = 0; i < 2; ++i) gq[2 * d0 + i] = *(const u32x4*)(G + hm_off((int)grow + i * 16 + (lane >> 2), h * 64 + d0 * 32 + (lane & 3) * 8, NH));
}
__device__ __forceinline__ void wave_epilogue(FA_LAS float* stg, FA_LAS float* wsf, WaveSt& w, const u32x4 (&gq)[4], bf16_t* O, size_t grow, int h, int lane, int r32, int hi) {
    const float l = swap_add(w.lsum);
    if (hi == 0) wsf[r32] = l;
    asm volatile("s_waitcnt lgkmcnt(0)" ::: "memory");
    float rl[16];
#pragma unroll
    for (int g = 0; g < 4; ++g) { const f32x4 l4 = *(FA_LAS f32x4*)(wsf + 8 * g + 4 * hi);
#pragma unroll
        for (int i = 0; i < 4; ++i) rl[4 * g + i] = 1.0f / l4[i]; }
#pragma unroll
    for (int d0 = 0; d0 < 2; ++d0) {
#pragma unroll
        for (int g = 0; g < 4; ++g)
#pragma unroll
            for (int i = 0; i < 4; ++i) stg[(8 * g + 4 * hi + i) * 32 + r32] = (d0 == 0 ? w.o0[4 * g + i] : w.o1[4 * g + i]) * rl[4 * g + i];
        asm volatile("s_waitcnt lgkmcnt(0)" ::: "memory");
#pragma unroll
        for (int i = 0; i < 2; ++i) { const int row = i * 16 + (lane >> 2), ch = lane & 3;
            const f32x4 x0 = *(FA_LAS f32x4*)(stg + row * 32 + ch * 8), x1 = *(FA_LAS f32x4*)(stg + row * 32 + ch * 8 + 4);
            const size_t ga = (grow + row) * DM + h * 64 + d0 * 32 + ch * 8; const u32x4 gv = gq[2 * d0 + i];
            u32x4 ov;
            ov.x = cvtpk(x0[0] * __uint_as_float(gv.x << 16), x0[1] * __uint_as_float(gv.x & 0xffff0000u)); ov.y = cvtpk(x0[2] * __uint_as_float(gv.y << 16), x0[3] * __uint_as_float(gv.y & 0xffff0000u));
            ov.z = cvtpk(x1[0] * __uint_as_float(gv.z << 16), x1[1] * __uint_as_float(gv.z & 0xffff0000u)); ov.w = cvtpk(x1[2] * __uint_as_float(gv.w << 16), x1[3] * __uint_as_float(gv.w & 0xffff0000u));
            *(u32x4*)(O + tiled_off((int)(grow + row), h * 64 + d0 * 32 + ch * 8)) = ov; }
        asm volatile("s_waitcnt lgkmcnt(0)" ::: "memory");
    }
}
template <int MODE> __device__ __forceinline__ void wave_init(WaveSt& w, int hi) {
#pragma unroll
    for (int r = 0; r < 16; ++r) { w.o0[r] = 0.f; w.o1[r] = 0.f; }
    if (MODE == 0) set_qa(w, hi);
    else { const float ci = w.cq - w.mhat;
#pragma unroll
        for (int r = 0; r < 16; ++r) w.cinit[r] = ci; }
}

__device__ __forceinline__ void fox_unit(FA_LAS unsigned char* lds, const Params& P, int b, int h, int qb) {
    const int tid = threadIdx.x, lane = tid & 63, r32 = lane & 31, hi = lane >> 5;
    const int wid = __builtin_amdgcn_readfirstlane(tid >> 6);
    const int q0 = qb * 256, qlo = q0 + wid * 32, t = qlo + r32;
    const size_t rowbase = (size_t)b * SEQ;
    const bf16_t* ksrc = P.K + hm_off((int)rowbase + lane, h * 64 + wid * 8, NH);
    const bf16_t* vsrc = P.V + hm_off((int)rowbase + 16 * (wid & 3) + (lane >> 2), h * 64 + (wid >> 2) * 32 + (lane & 3) * 8, NH);
    const float* cum = P.CUM + (size_t)(b * NH + h) * SEQ;
    const bf16_t* asrc = P.KAUG + ((size_t)(b * NH + h) * SEQ + lane) * 8;
    const int NT = (q0 + 256) / 64;
    WaveSt w; const bf16_t* Qw = P.Q + hm_off((int)rowbase + t, h * 64 + hi * 8, NH); float qn = 0.f;
#pragma unroll
    for (int d0 = 0; d0 < 4; ++d0) { w.qr[d0] = *(const bf16x8*)(Qw + d0 * 16);
#pragma unroll
        for (int j = 0; j < 8; ++j) { const float qv = bf2f((bf16_t)w.qr[d0][j]); qn = fmaf(qv, qv, qn); } }
    w.cq = cum[t]; w.mhat = 0.f; w.lsum = 0.f; w.mrun = -1e30f;
    wave_init<0>(w, hi);
    u32x4 gq[4]; load_gate(gq, P.G, rowbase + qlo, h, lane);
    const float qkb = sqrtf(swap_add(qn) * (__uint_as_float(P.KMAX[(b * NH + h) * 2]) + __uint_as_float(P.KMAX[(b * NH + h) * 2 + 1]))) * 1.01f + 1e-3f;
    FA_LAS float* wsf = (FA_LAS float*)(lds + F_WSF) + wid * 64;
    FA_LAS unsigned* votes = (FA_LAS unsigned*)(lds + F_FLAG);
    float cnew = 0.f;
#define FA_LOADT(j, bf) do { const size_t ko_ = (size_t)(j) * 64 * 64; FA_LAS unsigned char* bb_ = lds + (bf) * F_KBUF; \
        glds16(ksrc + ko_, (unsigned)__builtin_amdgcn_readfirstlane((int)(unsigned)(uintptr_t)(bb_ + wid * 1024))); \
        glds16(vsrc + ko_, (unsigned)__builtin_amdgcn_readfirstlane((int)(unsigned)(uintptr_t)(bb_ + F_VOFF + (wid >> 2) * 4096 + (wid & 3) * 1024))); \
        if (wid == 0) glds16(asrc + (size_t)(j) * 64 * 8, (unsigned)__builtin_amdgcn_readfirstlane((int)(unsigned)(uintptr_t)(bb_ + F_AOFF))); \
        cnew = cum[(j) * 64 + 63]; } while (0)
    FA_LOADT(NT - 1, 0); asm volatile("s_waitcnt vmcnt(0)" ::: "memory"); __syncthreads();
    bool wdone = false, pend = false; f32x16 pA, pB;
#pragma unroll
    for (int r = 0; r < 16; ++r) pB[r] = 0.f;
    int cur = 0;
    for (int tt = 0; tt < NT; ++tt) {
        const int j = NT - 1 - tt, k0 = j * 64; const int nxt = cur == 2 ? 0 : cur + 1, prv = cur == 0 ? 2 : cur - 1;
        if (j > 0) FA_LOADT(j - 1, nxt);
        if (!wdone && k0 <= qlo + 31) {
            FA_LAS unsigned char* bb = lds + cur * F_KBUF;
            tile_step<0, F_AOFF, F_VOFF>(bb, pend ? lds + prv * F_KBUF : bb, wsf, w, pA, pB, k0, t, qlo, lane, r32, hi);
            pend = true;
        }
        if (j > 0) {
            if (!wdone && pend && __all(qkb + w.cq - cnew - w.mrun <= -TH_SKIP)) {
                wdone = true; tile_drain<F_VOFF>(lds + cur * F_KBUF, w, pB, lane, hi);
            }
            if (lane == 0) votes[(tt & 1) * 8 + wid] = wdone ? 1u : 0u;
        }
        asm volatile("s_waitcnt vmcnt(0)" ::: "memory");
        __syncthreads();
        if (j > 0) { const u32x4 v0 = *(FA_LAS u32x4*)(votes + (tt & 1) * 8), v1 = *(FA_LAS u32x4*)(votes + (tt & 1) * 8 + 4);
            if ((v0.x & v0.y & v0.z & v0.w & v1.x & v1.y & v1.z & v1.w) != 0u) break; }
        else if (!wdone) tile_drain<F_VOFF>(lds + cur * F_KBUF, w, pB, lane, hi);
        cur = nxt;
    }
#undef FA_LOADT
    wave_epilogue((FA_LAS float*)(lds + F_OST + wid * 4096), wsf, w, gq, P.O, rowbase + qlo, h, lane, r32, hi);
    __syncthreads();
}
__device__ __forceinline__ void swa_unit(FA_LAS unsigned char* lds, const Params& P, int b, int kvh, int qb) {
    const int tid = threadIdx.x, lane = tid & 63, r32 = lane & 31, hi = lane >> 5;
    const int wid = __builtin_amdgcn_readfirstlane(tid >> 6);
    const int q0 = qb * 256, qlo = q0 + wid * 32, t = qlo + r32;
    const size_t rowbase = (size_t)b * SEQ;
    const int j_lo = q0 >= 128 ? (q0 - 128) / 64 : 0, NT = (q0 + 256) / 64 - j_lo;
    const bf16_t* ksrc = P.K + hm_off((int)rowbase + j_lo * 64 + lane, kvh * 64 + wid * 8, 4);
    const bf16_t* vsrc = P.V + hm_off((int)rowbase + j_lo * 64 + 16 * (wid & 3) + (lane >> 2), kvh * 64 + (wid >> 2) * 32 + (lane & 3) * 8, 4);
    const int kdst = wid * 1024 + lane * 16, vdst = S_VOFF + (wid >> 2) * 4096 + (wid & 3) * 1024 + lane * 16;
    { u32x4 sk[6], sv[6];
#pragma unroll
      for (int i = 0; i < 6; ++i) if (i < NT) { sk[i] = *(const u32x4*)(ksrc + (size_t)i * 64 * 64); sv[i] = *(const u32x4*)(vsrc + (size_t)i * 64 * 64); }
#pragma unroll
      for (int i = 0; i < 6; ++i) if (i < NT) { *(FA_LAS u32x4*)(lds + i * S_KBUF + kdst) = sk[i]; *(FA_LAS u32x4*)(lds + i * S_KBUF + vdst) = sv[i]; } }
    __syncthreads();
    FA_LAS float* wsf = (FA_LAS float*)(lds + S_WSF) + wid * 64;
    const int ta = (qlo >= 127 ? (qlo - 127) / 64 : 0) - j_lo, tb = (qlo + 31) / 64 - j_lo;
    bf16x8 qn[4]; { const bf16_t* Qw = P.Q + hm_off((int)rowbase + t, (kvh * 8) * 64 + hi * 8, NH);
#pragma unroll
      for (int d0 = 0; d0 < 4; ++d0) qn[d0] = *(const bf16x8*)(Qw + d0 * 16); }
    for (int hh = 0; hh < 8; ++hh) {
        const int h = kvh * 8 + hh;
        WaveSt w;
#pragma unroll
        for (int d0 = 0; d0 < 4; ++d0) w.qr[d0] = qn[d0];
        { const bf16_t* Qw = P.Q + hm_off((int)rowbase + t, (kvh * 8 + (hh < 7 ? hh + 1 : hh)) * 64 + hi * 8, NH);
#pragma unroll
          for (int d0 = 0; d0 < 4; ++d0) qn[d0] = *(const bf16x8*)(Qw + d0 * 16); }
        u32x4 gq[4]; load_gate(gq, P.G, rowbase + qlo, h, lane);
        w.cq = 0.f; w.mhat = P.sinks[h] * LOG2E; w.lsum = 0.5f; w.mrun = 0.f;
        wave_init<1>(w, hi);
        f32x16 pA, pB;
#pragma unroll
        for (int r = 0; r < 16; ++r) pB[r] = 0.f;
        for (int ti = tb; ti >= ta; --ti) { FA_LAS unsigned char* bb = lds + ti * S_KBUF;
            tile_step<1, 0, S_VOFF>(bb, ti == tb ? bb : bb + S_KBUF, wsf, w, pA, pB, (j_lo + ti) * 64, t, qlo, lane, r32, hi); }
        tile_drain<S_VOFF>(lds + ta * S_KBUF, w, pB, lane, hi);
        wave_epilogue((FA_LAS float*)(lds + S_OST + wid * 4096), wsf, w, gq, P.O, rowbase + qlo, h, lane, r32, hi);
    }
    __syncthreads();
}
}
#define GAS __attribute__((address_space(1)))
#define LAS __attribute__((address_space(3)))
typedef unsigned short bf16;
typedef unsigned v4u __attribute__((ext_vector_type(4)));
typedef float f32x4 __attribute__((ext_vector_type(4)));
typedef short bf16x8 __attribute__((ext_vector_type(8)));
typedef GAS unsigned gu32;
typedef GAS unsigned long long gu64;
#define RLX_AGENT __ATOMIC_RELAXED, __HIP_MEMORY_SCOPE_AGENT
#define LDS_WAIT() asm volatile("s_waitcnt lgkmcnt(0)" ::: "memory")
#define VM_WAIT() asm volatile("s_waitcnt vmcnt(0)" ::: "memory")
__device__ __forceinline__ unsigned long long rt() { return __builtin_amdgcn_s_memrealtime(); }
__device__ __forceinline__ unsigned pk2(float lo, float hi) { return (unsigned)f2bf(lo) | ((unsigned)f2bf(hi) << 16); }
#define XB_TMO      128
#define XB_XCNT(j)  (256  + 64 * (j))
#define XB_XSUB(j)  (1280 + 64 * (j))
#define XB_XGEN(j)  (2304 + 64 * (j))
#define XB_TOP      3328
#define XB_TOPGEN   3392
#define XCD_BAR_WORDS 3456
#define XB_SPIN_CAP (1u << 18)

__device__ __forceinline__ unsigned xb_ld(unsigned* p)              { return __hip_atomic_load(p, __ATOMIC_RELAXED, __HIP_MEMORY_SCOPE_AGENT); }
__device__ __forceinline__ unsigned xb_add(unsigned* p, unsigned v) { return __hip_atomic_fetch_add(p, v, __ATOMIC_RELAXED, __HIP_MEMORY_SCOPE_AGENT); }
__device__ __forceinline__ unsigned xb_xcc_id() { return (unsigned)__builtin_amdgcn_s_getreg((3 << 11) | 20) & 0xFu; }
#define XB_SPIN(cond, bar) do { unsigned _sp = 0; while (cond) { __builtin_amdgcn_s_sleep(1); \
    if ((++_sp & 255u) == 0u) { if (xb_ld(&(bar)[XB_TMO])) break; if (_sp > XB_SPIN_CAP) { atomicAdd(&(bar)[XB_TMO], 1u); break; } } } } while (0)

struct XcdBarrier {
    unsigned* bar; unsigned x;
    volatile LAS unsigned* st;
};

__device__ __forceinline__ XcdBarrier xcd_barrier_post(unsigned* bar, volatile LAS unsigned* st) {
    XcdBarrier b; b.bar = bar; b.x = xb_xcc_id(); b.st = st;
    if (threadIdx.x == 0) (void)xb_add(&bar[XB_XCNT(b.x)], 1u);
    return b;
}
__device__ __forceinline__ void xcd_barrier_complete(unsigned* bar, unsigned x, unsigned& nloc, unsigned& nx) {
    const unsigned G = gridDim.x * gridDim.y * gridDim.z;
    unsigned sum, cnt, mine, sp = 0u;
    for (;;) {
        sum = 0u; cnt = 0u; mine = 0u;
#pragma unroll
        for (unsigned j = 0; j < 16; ++j) { const unsigned c = xb_ld(&bar[XB_XCNT(j)]); sum += c; cnt += (c > 0u) ? 1u : 0u; mine = (j == x) ? c : mine; }
        if (sum == G) break;
        __builtin_amdgcn_s_sleep(1);
        if ((++sp & 255u) == 0u) { if (xb_ld(&bar[XB_TMO])) break; if (sp > XB_SPIN_CAP) { atomicAdd(&bar[XB_TMO], 1u); break; } }
    }
    nloc = mine > 0u ? mine : 1u; nx = cnt > 0u ? cnt : 1u;
}

__device__ __forceinline__ void xcd_barrier(const XcdBarrier& b) {
    asm volatile("s_waitcnt vmcnt(0)" ::: "memory");
    __syncthreads();
    if (threadIdx.x == 0) {
        unsigned* bar = b.bar;
        __builtin_amdgcn_s_waitcnt(0);
        unsigned nloc = b.st[0], nx = b.st[1];
        if (nloc == 0u) { xcd_barrier_complete(bar, b.x, nloc, nx); b.st[0] = nloc; b.st[1] = nx; }
        const unsigned old = xb_add(&bar[XB_XSUB(b.x)], 1u);
        const unsigned gen = old / nloc;
        if (old + 1u == (gen + 1u) * nloc) {
            __builtin_amdgcn_fence(__ATOMIC_RELEASE, "agent");
            asm volatile("s_waitcnt vmcnt(0)" ::: "memory");
            const unsigned og = xb_add(&bar[XB_TOP], 1u);
            const unsigned tg = og / nx;
            if (og + 1u == (tg + 1u) * nx) xb_add(&bar[XB_TOPGEN], 1u);
            else XB_SPIN(xb_ld(&bar[XB_TOPGEN]) == tg, bar);
            __builtin_amdgcn_fence(__ATOMIC_ACQUIRE, "agent");
            xb_add(&bar[XB_XGEN(b.x)], 1u);
            asm volatile("s_waitcnt vmcnt(0)" ::: "memory");
        } else {
            XB_SPIN(xb_ld(&bar[XB_XGEN(b.x)]) == gen, bar);
            __builtin_amdgcn_fence(__ATOMIC_ACQUIRE, "agent");
            asm volatile("s_waitcnt vmcnt(0)" ::: "memory");
        }
    }
    __syncthreads();
}
constexpr int NWAVES = 8;
constexpr int N1P = 8448;
constexpr int RING_OFF = 0, RING_BYTES = 135168;
constexpr int LDSCTL_OFF = RING_BYTES, MISC_OFF = LDSCTL_OFF + 320;
constexpr int LDS_BYTES = 147456;
constexpr int CW_BAR = 4096;
static_assert(fa::F_LDS_BYTES <= RING_BYTES && fa::S_LDS_BYTES <= RING_BYTES && pg8::STAGE_BYTES <= RING_BYTES && MISC_OFF + 128 <= LDS_BYTES && (CW_BAR + XCD_BAR_WORDS) * 4 <= (int)WS_KMAX, "LDS / CTL map");

__device__ __forceinline__ void p0_transpose_item(const float* W, int K, int N, bf16* WT, LAS float* scr, int item, int lane, const float* gs) {
    const int nblk = N / 32, kb = item / nblk, nb = item % nblk, k0 = 64 * kb, n0 = 32 * nb;
    const int kr = lane >> 3, nc = 4 * (lane & 7);
    f32x4 wv[8];
#pragma unroll
    for (int i = 0; i < 8; ++i) wv[i] = *(const GAS f32x4*)(W + (size_t)(k0 + 8 * i + kr) * N + n0 + nc);
#pragma unroll
    for (int i = 0; i < 8; ++i) { const int kk = 8 * i + kr; f32x4 w = wv[i]; if (gs) w = w * gs[k0 + kk]; LAS float* d = scr + kk * 33 + nc; d[0] = w.x; d[1] = w.y; d[2] = w.z; d[3] = w.w; }
    LDS_WAIT(); asm volatile("" ::: "memory");
    const int c = lane & 7;
#pragma unroll
    for (int j = 0; j < 4; ++j) { const int n = (lane >> 3) + 8 * j; const LAS float* sp = scr + (8 * c) * 33 + n;
        v4u o; o.x = pk2(sp[0 * 33], sp[1 * 33]); o.y = pk2(sp[2 * 33], sp[3 * 33]); o.z = pk2(sp[4 * 33], sp[5 * 33]); o.w = pk2(sp[6 * 33], sp[7 * 33]);
        *(GAS v4u*)(WT + tiled_off(n0 + n, k0 + 8 * c)) = o; }
    LDS_WAIT(); asm volatile("" ::: "memory");
}
__device__ __forceinline__ float wave_sum(float v) {
#pragma unroll
    for (int o = 1; o < 64; o <<= 1) v += __shfl_xor(v, o);
    return v;
}

struct Args { const float* in[9]; float* out; unsigned char* ws; int ph_lo, ph_hi; };
constexpr int N_PHASES = 9;
__global__ void __launch_bounds__(NWAVES * 64, 2) mega_fwd(Args args) {
    extern __shared__ __attribute__((aligned(16))) unsigned char lds_raw[];
    LAS unsigned char* lds = (LAS unsigned char*)lds_raw;
    volatile LAS unsigned* MISC = (volatile LAS unsigned*)(lds + MISC_OFF);
    const int tid = threadIdx.x, lane = tid & 63, wave = __builtin_amdgcn_readfirstlane(tid >> 6);
    const int G = gridDim.x, bx = blockIdx.x, vcu = (G % 8 == 0) ? (bx % 8) * (G / 8) + bx / 8 : bx;
    unsigned char* ws = args.ws;
    const float* x = args.in[0]; const float* norm_g = args.in[1]; const float* fox_w_in = args.in[2]; const float* fox_b_f = args.in[3]; const float* fox_w_out = args.in[4];
    const float* swa_w_in = args.in[5]; const float* swa_sinks = args.in[6]; const float* swa_w_out = args.in[7]; const float* final_g = args.in[8];
    float* out = args.out;
    gu32* ctl = (gu32*)(ws + WS_CTL);
    unsigned* KMAX = (unsigned*)(ws + WS_KMAX); unsigned* TICKET = (unsigned*)(ws + WS_TICKET);
    float* SS1 = (float*)(ws + WS_SS1); float* R0 = (float*)(ws + WS_R0); float* ROPE = (float*)(ws + WS_ROPE); float* LOGF = (float*)(ws + WS_LOGF); float* CUM = (float*)(ws + WS_CUM);
    bf16* W1T = (bf16*)(ws + WS_W1T); bf16* W2T = (bf16*)(ws + WS_W2T); bf16* W3T = (bf16*)(ws + WS_W3T); bf16* W4T = (bf16*)(ws + WS_W4T);
    bf16* KAUG = (bf16*)(ws + WS_KAUG);
    bf16* XB = (bf16*)(ws + WS_XB); bf16* Qb = (bf16*)(ws + WS_Q); bf16* Kb = (bf16*)(ws + WS_K); bf16* Vb = (bf16*)(ws + WS_V); bf16* Gb = (bf16*)(ws + WS_G); bf16* YG = (bf16*)(ws + WS_YG);
    for (int u = tid; u < (LDS_BYTES - LDSCTL_OFF) / 4; u += NWAVES * 64) ((LAS unsigned*)(lds + LDSCTL_OFF))[u] = 0u;
    __syncthreads();
    const int lo = args.ph_lo, hi = args.ph_hi;
    XcdBarrier bar; bar.bar = (unsigned*)(ctl + CW_BAR); bar.x = 0; bar.st = nullptr;
    if (hi - lo > 1) bar = xcd_barrier_post((unsigned*)(ctl + CW_BAR), MISC + 8);
#define IN(k) (lo <= (k) && (k) < hi)
#define REP(k) for (int rep_ = 0; rep_ < (((DUP_MASK >> (k)) & 1) ? 2 : 1); ++rep_)
#define SEAM(k) do { if (IN(k) && IN((k) + 1)) xcd_barrier(bar); } while (0)
    const int gw = vcu * NWAVES + wave, NGW = G * NWAVES;

    if (IN(0)) REP(0) {
        LAS float* scr = (LAS float*)(lds + RING_OFF + wave * 16384);
        constexpr int I1 = (DM / 64) * (FOX_IN / 32), IZ = N1P - FOX_IN;
        constexpr int NITEMS = I1 + IZ;
        for (int it = gw; it < NITEMS; it += NGW) {
            int r = it;
            if (r < I1) { p0_transpose_item(fox_w_in, DM, FOX_IN, W1T, scr, r, lane, norm_g); continue; } r -= I1;
            { GAS v4u* zp = (GAS v4u*)(W1T + tiled_off(FOX_IN + r, (lane >> 1) * 64 + (lane & 1) * 32));
#pragma unroll
              for (int j = 0; j < 4; ++j) zp[j] = (v4u){0u, 0u, 0u, 0u}; }
        }
        for (int m = gw; m < MTOK; m += 2 * NGW) {
            const int m2 = m + NGW < MTOK ? m + NGW : m;
            const GAS f32x4* xr = (const GAS f32x4*)(x + (size_t)m * DM) + lane; const GAS f32x4* xr2 = (const GAS f32x4*)(x + (size_t)m2 * DM) + lane; f32x4 v[8], v2[8]; float s = 0.f, s2 = 0.f;
#pragma unroll
            for (int j = 0; j < 8; ++j) { v[j] = xr[64 * j]; v2[j] = xr2[64 * j]; }
#pragma unroll
            for (int j = 0; j < 8; ++j) { s += (v[j].x * v[j].x + v[j].y * v[j].y) + (v[j].z * v[j].z + v[j].w * v[j].w); s2 += (v2[j].x * v2[j].x + v2[j].y * v2[j].y) + (v2[j].z * v2[j].z + v2[j].w * v2[j].w); }
            s = wave_sum(s); s2 = wave_sum(s2);
            if (lane == 0) { R0[m] = 1.0f / sqrtf(s * (1.f / DM) + RMS_EPS); R0[m2] = 1.0f / sqrtf(s2 * (1.f / DM) + RMS_EPS); }
#pragma unroll
            for (int j = 0; j < 8; ++j) { *(GAS unsigned long long*)(XB + tiled_off(m, 256 * j + 4 * lane)) = (unsigned long long)pk2(v[j].x, v[j].y) | ((unsigned long long)pk2(v[j].z, v[j].w) << 32);
                                          *(GAS unsigned long long*)(XB + tiled_off(m2, 256 * j + 4 * lane)) = (unsigned long long)pk2(v2[j].x, v2[j].y) | ((unsigned long long)pk2(v2[j].z, v2[j].w) << 32); }
        }
        { const int gt = gw * 64 + lane;
          if (gt < SEQ * 8) { const int pos = gt >> 3, i = gt & 7;
              const double invf[8] = {1.0, 0.19390220519133497, 0.037598065178462524, 0.0072903477503833845, 0.0014142135623730951, 0.00027421912901204056, 5.3171693730649086e-05, 1.0310108130908796e-05};
              double inv = invf[0];
#pragma unroll
              for (int k = 1; k < 8; ++k) inv = (i == k) ? invf[k] : inv;
              const double ang = (double)pos * inv; const double kk = __builtin_rint(ang * 0.15915494309189535); const float red = (float)(ang - kk * 6.283185307179586);
              ROPE[(size_t)pos * 16 + i] = cosf(red); ROPE[(size_t)pos * 16 + 8 + i] = sinf(red); } }
    }
    SEAM(0);
    if (IN(1)) {
        pg8::Gemm g{XB, W1T, MTOK, N1P, DM}; pg8::StaticOrder S; S.init(MTOK, N1P, G, bx, (DUP_MASK >> 1) & 1, (DUP_MASK >> 9) & 1);
        pg8::EpiFoxIn E{Qb, Kb, Vb, Gb, LOGF, R0, fox_b_f, KMAX};
        if ((DUP_MASK >> 10) & 1) { pg8::StaticOrder SP; SP.init(MTOK, N1P, G, bx, 0, 0, 1); pg8::gemm_phase<pg8::EpiFoxIn, pg8::StaticOrder, true, true>(lds + RING_OFF, g, SP, E); }
        pg8::gemm_phase<pg8::EpiFoxIn, pg8::StaticOrder, true, true>(lds + RING_OFF, g, S, E);
        { const int nwg = (MTOK / 256) * (N1P / 256), rem = nwg % G, nidle = rem ? G - rem : G, ii = rem ? bx - rem : bx;
          if (ii >= 0) { LAS float* scr = (LAS float*)(lds + RING_OFF + wave * 16384);
              constexpr int I2 = (DM / 64) * (DM / 32), I3 = (DM / 64) * (SWA_IN / 32);
              for (int it = ii * NWAVES + wave; it < I2 + I3 + I2; it += nidle * NWAVES) {
                  int r = it;
                  if (r < I2) { p0_transpose_item(fox_w_out, DM, DM, W2T, scr, r, lane, nullptr); continue; } r -= I2;
                  if (r < I3) { p0_transpose_item(swa_w_in, DM, SWA_IN, W3T, scr, r, lane, norm_g + DM); continue; } r -= I3;
                  p0_transpose_item(swa_w_out, DM, DM, W4T, scr, r, lane, nullptr); } } }
    }
    SEAM(1);
    if (IN(2)) REP(2) {
        for (int sq = vcu; sq < NB * NH; sq += G) {
            const GAS f32x4* lf = (const GAS f32x4*)(LOGF + (size_t)sq * SEQ + wave * 512) + lane * 2; const f32x4 v0 = lf[0], v1 = lf[1];
            const double tot = (((double)v0.x + (double)v0.y) + ((double)v0.z + (double)v0.w)) + (((double)v1.x + (double)v1.y) + ((double)v1.z + (double)v1.w));
            double incl = tot;
#pragma unroll
            for (int o = 1; o < 64; o <<= 1) { const double up = __shfl_up(incl, o); if (lane >= o) incl += up; }
            volatile LAS double* wt = (volatile LAS double*)(lds + RING_OFF);
            __syncthreads();
            if (lane == 63) wt[wave] = incl;
            __syncthreads();
            double run = incl - tot;
            for (int w2 = 0; w2 < wave; ++w2) run += wt[w2];
            const float vv[8] = {v0.x, v0.y, v0.z, v0.w, v1.x, v1.y, v1.z, v1.w}; float cv[8];
#pragma unroll
            for (int e = 0; e < 8; ++e) { run += (double)vv[e]; cv[e] = (float)(run * 1.4426950408889634); }
            GAS f32x4* co = (GAS f32x4*)(CUM + (size_t)sq * SEQ + wave * 512) + lane * 2; co[0] = (f32x4){cv[0], cv[1], cv[2], cv[3]}; co[1] = (f32x4){cv[4], cv[5], cv[6], cv[7]};
            GAS v4u* ka = (GAS v4u*)(KAUG + ((size_t)sq * SEQ + wave * 512 + lane * 8) * 8);
#pragma unroll
            for (int e = 0; e < 8; ++e) { unsigned h1, h2, h3; fa::split3(-cv[e], h1, h2, h3); ka[e] = (v4u){h1 | (h2 << 16), h3 | 0x3F800000u, 0x3F803F80u, 0u}; }
        }
    }
    SEAM(2);
    if (IN(3)) {
        const fa::Params P{Qb, Kb, Vb, Gb, YG, CUM, nullptr, KMAX, TICKET, KAUG};
        volatile LAS unsigned* slot = (volatile LAS unsigned*)(lds + RING_OFF + fa::F_FLAG + 128);
#define FOX_FETCH(dst) do { unsigned code_ = 0xFFFFFFFFu; for (int k_ = 0; k_ < 8; ++k_) { const unsigned q_ = (unsigned)((bx + k_) & 7); const unsigned t_ = atomicAdd(TICKET + q_ * 64, 1u); \
            if (t_ < 256u) { code_ = q_ * 256u + t_; break; } } (dst) = code_; } while (0)
        if (tid == 0) FOX_FETCH(slot[0]);
        __syncthreads();
        unsigned tk = slot[0]; int par = 0;
        while (tk != 0xFFFFFFFFu) {
            if (tid == 0) FOX_FETCH(slot[par ^ 1]);
            const int q = (int)(tk >> 8), tq = (int)(tk & 255u), pi = tq >> 4, hs = 3 - (pi >> 2);
            const int h = hs == 0 ? q : hs == 1 ? 15 - q : hs == 2 ? 16 + q : 31 - q;
            fa::fox_unit(lds + RING_OFF, P, pi & 3, h, 15 - (tq & 15));
            par ^= 1; tk = slot[par];
        }
#undef FOX_FETCH
        __syncthreads();
    }
    SEAM(3);
    if (IN(4)) {
        pg8::Gemm g{YG, W2T, MTOK, DM, DM}; pg8::StaticOrder S; S.init(MTOK, DM, G, bx);
        pg8::EpiRes<true> E{x, XB, SS1};
        pg8::gemm_phase<pg8::EpiRes<true>, pg8::StaticOrder, true, true>(lds + RING_OFF, g, S, E);
    }
    SEAM(4);
    if (IN(5)) {
        pg8::Gemm g{XB, W3T, MTOK, SWA_IN, DM}; pg8::StaticOrder S; S.init(MTOK, SWA_IN, G, bx, (DUP_MASK >> 5) & 1);
        pg8::EpiSwaIn E{Qb, Kb, Vb, Gb, SS1, ROPE};
        pg8::gemm_phase<pg8::EpiSwaIn, pg8::StaticOrder, true, true>(lds + RING_OFF, g, S, E);
    }
    SEAM(5);
    if (IN(6)) REP(6) {
        const fa::Params P{Qb, Kb, Vb, Gb, YG, nullptr, swa_sinks, nullptr, nullptr, nullptr};
        for (int u = (G == 256 ? vcu : bx); u < NB * 4 * 16; u += G) fa::swa_unit(lds + RING_OFF, P, u >> 6, (u >> 4) & 3, u & 15);
    }
    SEAM(6);
    if (IN(7)) {
        pg8::Gemm g{YG, W4T, MTOK, DM, DM}; pg8::StaticOrder S; S.init(MTOK, DM, G, bx);
        pg8::EpiRes<false> E{nullptr, XB, nullptr};
        pg8::gemm_phase<pg8::EpiRes<false>, pg8::StaticOrder, true, true>(lds + RING_OFF, g, S, E);
    }
    SEAM(7);
    if (IN(8)) {
        f32x4 gq[8];
#pragma unroll
        for (int j = 0; j < 8; ++j) gq[j] = ((const GAS f32x4*)final_g)[lane + 64 * j];
        for (int m = gw; m < MTOK; m += NGW) {
            f32x4 v[8]; float s = 0.f;
#pragma unroll
            for (int j = 0; j < 8; ++j) { const unsigned long long xw = *(const GAS unsigned long long*)(XB + tiled_off(m, 256 * j + 4 * lane)); const unsigned lo32 = (unsigned)xw, hi32 = (unsigned)(xw >> 32);
                v[j] = (f32x4){__uint_as_float(lo32 << 16), __uint_as_float(lo32 & 0xffff0000u), __uint_as_float(hi32 << 16), __uint_as_float(hi32 & 0xffff0000u)};
                s += (v[j].x * v[j].x + v[j].y * v[j].y) + (v[j].z * v[j].z + v[j].w * v[j].w); }
            const float r = 1.0f / sqrtf(wave_sum(s) * (1.f / DM) + RMS_EPS);
            GAS f32x4* xr = (GAS f32x4*)(out + (size_t)m * DM) + lane;
#pragma unroll
            for (int j = 0; j < 8; ++j) xr[64 * j] = v[j] * r * gq[j];
        }
    }
#undef IN
#undef SEAM
}

extern "C" void kernel_launch(void* const* d_in, const int* in_sizes, int n_in, void* d_out, int out_size, void* d_ws, size_t ws_size, hipStream_t stream) {
    static int grid = 0;
    if (grid == 0) {
        if (n_in != 9 || in_sizes[0] != MTOK * DM || out_size != MTOK * DM || ws_size < WS_END) { fprintf(stderr, "kernel_launch: unexpected shapes (n_in %d, in0 %d, out %d, ws %zu)\n", n_in, n_in > 0 ? in_sizes[0] : -1, out_size, ws_size); grid = -1; return; }
        int dev = 0, cus = 0, per_cu = 0;
        if (hipGetDevice(&dev) != hipSuccess || hipDeviceGetAttribute(&cus, hipDeviceAttributeMultiprocessorCount, dev) != hipSuccess) { fprintf(stderr, "kernel_launch: device query failed\n"); grid = -1; return; }
        if (hipFuncSetAttribute((const void*)mega_fwd, hipFuncAttributeMaxDynamicSharedMemorySize, LDS_BYTES) != hipSuccess) { fprintf(stderr, "kernel_launch: hipFuncSetAttribute failed\n"); grid = -1; return; }
        if (hipOccupancyMaxActiveBlocksPerMultiprocessor(&per_cu, (const void*)mega_fwd, NWAVES * 64, LDS_BYTES) != hipSuccess || per_cu < 1) { fprintf(stderr, "kernel_launch: occupancy query reports %d workgroups per CU; nothing launched\n", per_cu); (void)hipGetLastError(); grid = -1; return; }
        grid = cus;
    }
    if (grid < 0) return;
    (void)hipMemsetAsync((unsigned char*)d_ws + WS_CTL, 0, CTL_ZERO_BYTES, stream);
    Args a{};
    for (int i = 0; i < 9; ++i) a.in[i] = (const float*)d_in[i];
    a.out = (float*)d_out; a.ws = (unsigned char*)d_ws;
    int p = 0;
    while (p < N_PHASES) {
        if (!((FAST_MASK >> p) & 1)) { ++p; continue; }
        int e = p + 1; if (ONE_LAUNCH) while (e < N_PHASES && ((FAST_MASK >> e) & 1)) ++e;
        a.ph_lo = p; a.ph_hi = e;
        hipLaunchKernelGGL(mega_fwd, dim3(grid), dim3(NWAVES * 64), LDS_BYTES, stream, a);
        p = e;
    }
}
```

```cpp
#include <hip/hip_runtime.h>
#include <cstdio>
#include <cstdint>

constexpr int NB = 4, SEQ = 4096, DM = 2048, MTOK = NB * SEQ, NH = 32, HD = 64;
constexpr int FOX_IN = 8224, SWA_IN = 4608, KVW = 256;
constexpr float RMS_EPS = 1e-6f;
constexpr float LOG2E = 1.4426950408889634f;
constexpr float C2 = 0.125f * LOG2E;

typedef unsigned short bf16_t;
__device__ __forceinline__ float bf2f(bf16_t v) { return __uint_as_float((unsigned)v << 16); }
__device__ __forceinline__ bf16_t f2bf(float f) { unsigned u = __float_as_uint(f); return (bf16_t)((u + 0x7fffu + ((u >> 16) & 1u)) >> 16); }
__device__ __forceinline__ float logsigmoidf(float z) { return z < 0.f ? z - log1pf(expf(z)) : -log1pf(expf(-z)); }
__device__ __forceinline__ float siluf(float g) { return g / (1.f + expf(-g)); }

__host__ __device__ __forceinline__ size_t tiled_off(int row, int k) { return ((size_t)(((row >> 8) * (DM / 64) + (k >> 6)) * 2 + ((k >> 5) & 1)) << 13) + (size_t)(((row & 255) << 5) + (k & 31)); }

__host__ __device__ __forceinline__ size_t hm_off(int row  , int col  , int nheads) { return ((size_t)(((row >> 12) * nheads + (col >> 6)) * 2 + ((col >> 5) & 1)) * SEQ + (row & 4095)) * 32 + (col & 31); }

constexpr size_t MiB = 1u << 20;
constexpr size_t WS_CTL = 0, CTL_ZERO_BYTES = 1 * MiB;
constexpr size_t WS_KMAX = 64 * 1024, WS_TICKET = 66 * 1024;
constexpr size_t WS_SS1 = 512 * 1024;
constexpr size_t WS_R0 = 1 * MiB;
constexpr size_t WS_ROPE = 1 * MiB + 512 * 1024;
constexpr size_t WS_LOGF = 2 * MiB;
constexpr size_t WS_CUM = 4 * MiB;
constexpr size_t WS_W1T = 8 * MiB, WS_W2T = 41 * MiB, WS_W3T = 49 * MiB, WS_W4T = 67 * MiB;
constexpr size_t WS_XB = 76 * MiB, WS_Q = 140 * MiB, WS_K = 204 * MiB, WS_V = 268 * MiB, WS_G = 332 * MiB, WS_YG = 396 * MiB, WS_KAUG = 460 * MiB, WS_END = 468 * MiB;

#ifndef FAST_MASK
#define FAST_MASK 0x1FF
#endif
#ifndef DUP_MASK
#define DUP_MASK 0x000
#endif
#ifndef ONE_LAUNCH
#define ONE_LAUNCH 1
#endif
namespace pg8 {
#define PG8_LAS __attribute__((address_space(3)))
typedef unsigned short bf16_t;
typedef short bf16x8 __attribute__((ext_vector_type(8)));
typedef float f32x4 __attribute__((ext_vector_type(4)));
typedef unsigned u32x4 __attribute__((ext_vector_type(4)));
constexpr int BM = 256, BK = 64, HALF = 128, HTB = HALF * BK * 2  , STAGE_BYTES = 8 * HTB, NXCD = 8, WGM = 8;

__host__ __device__ __forceinline__ int lds_byte(int r, int c) { const int st = (r >> 4) * 2 + (c >> 5), rr = r & 15, cc = c & 31, ob = rr * 64 + cc * 2; return st * 1024 + (ob ^ (((ob >> 9) & 1) << 5)); }
__host__ __device__ __forceinline__ void stage_rc(int b, int& R, int& C) { const int st = b / 1024, sb = b % 1024, swz = sb ^ (((sb >> 9) & 1) << 5); R = (st >> 1) * 16 + swz / 64; C = (st & 1) * 32 + (swz % 64) / 2; }
__host__ __device__ __forceinline__ int perm32(int rho) { const int n = rho >> 4, i = rho & 15; return 8 * (i >> 2) + 4 * n + (i & 3); }

struct Unit { int pm, pn, lm, ln; };
struct Gemm { const bf16_t* A; const bf16_t* Bt; int M, N, K; };

struct StaticOrder {
    int nM, nN, nwg, G, c, dup, epi2, same;
    __host__ __device__ void init(int M, int N, int G_, int c_, int dup_ = 0, int epi2_ = 0, int same_ = 0) { nM = M / BM; nN = N / BM; nwg = nM * nN; G = G_; c = c_; dup = dup_; epi2 = epi2_; same = same_; }
    __host__ __device__ bool next(int i, Unit& u) const {
        if (dup) i >>= 1;
        const long L = (long)i * G + c; if (L >= nwg) return false;
        int wgid = (int)L; { const int q = nwg / NXCD, r = nwg % NXCD, xcd = wgid % NXCD, off = wgid / NXCD; wgid = (xcd < r ? xcd * (q + 1) : r * (q + 1) + (xcd - r) * q) + off; }
        const int nig = WGM * nN, gid = wgid / nig, fm = gid * WGM, gsz = (nM - fm) < WGM ? (nM - fm) : WGM;
        u.pm = fm + ((wgid % nig) % gsz); u.pn = (wgid % nig) / gsz; u.lm = same ? 0 : u.pm; u.ln = same ? 0 : u.pn; return true;
    }
    __device__ __forceinline__ void a_ready(const Unit&) const {}
    __device__ __forceinline__ void done(const Unit&) const {}
};

__device__ __forceinline__ unsigned cvt_pk_bf16(float lo, float hi) { unsigned r; asm volatile("v_cvt_pk_bf16_f32 %0, %1, %2" : "=v"(r) : "v"(lo), "v"(hi)); return r; }
__device__ __forceinline__ float silu_fast(float g) { return g * __builtin_amdgcn_rcpf(1.0f + __builtin_amdgcn_exp2f(-g * 1.4426950408889634f)); }
__device__ __forceinline__ u32x4 pack8(const f32x4 v0, const f32x4 v1) { u32x4 w; w.x = cvt_pk_bf16(v0[0], v0[1]); w.y = cvt_pk_bf16(v0[2], v0[3]); w.z = cvt_pk_bf16(v1[0], v1[1]); w.w = cvt_pk_bf16(v1[2], v1[3]); return w; }
struct EpiFoxIn {
    static constexpr bool PERM = true, AFTER_DRAIN = false;
    bf16_t *Q, *K, *V, *G; float* LOGF; const float* R0; const float* bfb; unsigned* KMAX;
    __device__ __forceinline__ void operator()(const f32x4 (&acc)[2][2][4][2], const Unit& u, int wr, int wc, int fr, int fq) const {
        const int row0 = u.pm * BM + wr * 64 + fr, pn = u.pn;
        float rs[2][4];
#pragma unroll
        for (int ai = 0; ai < 2; ++ai)
#pragma unroll
            for (int m = 0; m < 4; ++m) rs[ai][m] = R0[row0 + ai * HALF + m * 16];
        if (pn < 32) {
            const int reg = pn >> 3; bf16_t* base = reg == 0 ? Q : reg == 1 ? K : reg == 2 ? V : G; float kmx[2] = {0.f, 0.f};
            const int col0 = (pn & 7) * BM + wc * 32 + 8 * fq;
#pragma unroll
            for (int ai = 0; ai < 2; ++ai)
#pragma unroll
                for (int m = 0; m < 4; ++m) { const int row = row0 + ai * HALF + m * 16; const float r = rs[ai][m]; const float sc = reg == 0 ? r * C2 : r;
#pragma unroll
                    for (int bj = 0; bj < 2; ++bj) { f32x4 v0 = acc[ai][bj][m][0] * sc, v1 = acc[ai][bj][m][1] * sc;
                        if (reg == 3) {
#pragma unroll
                            for (int j = 0; j < 4; ++j) { v0[j] = silu_fast(v0[j]); v1[j] = silu_fast(v1[j]); } }
                        if (reg == 1) { float ss = ((v0[0] * v0[0] + v0[1] * v0[1]) + (v0[2] * v0[2] + v0[3] * v0[3])) + ((v1[0] * v1[0] + v1[1] * v1[1]) + (v1[2] * v1[2] + v1[3] * v1[3]));
                            ss += __shfl_xor(ss, 16); ss += __shfl_xor(ss, 32); kmx[bj] = fmaxf(kmx[bj], ss); }
                        __builtin_nontemporal_store(pack8(v0, v1), (u32x4*)(base + hm_off(row, col0 + bj * HALF, NH))); } }
            if (reg == 1) {
#pragma unroll
                for (int bj = 0; bj < 2; ++bj) { float mx = kmx[bj];
#pragma unroll
                    for (int o = 1; o < 16; o <<= 1) mx = fmaxf(mx, __shfl_xor(mx, o));
                    if (fr == 0 && fq == 0) atomicMax(KMAX + ((row0 >> 12) * NH + (pn & 7) * 4 + bj * 2 + (wc >> 1)) * 2 + (wc & 1), __float_as_uint(mx)); } }
        } else if (wc == 0) {
#pragma unroll
            for (int ai = 0; ai < 2; ++ai)
#pragma unroll
                for (int m = 0; m < 4; ++m) { const int row = row0 + ai * HALF + m * 16; const float r = rs[ai][m]; const int b = row >> 12, s = row & 4095;
#pragma unroll
                    for (int n = 0; n < 2; ++n)
#pragma unroll
                        for (int j = 0; j < 4; ++j) { const int h = 8 * fq + 4 * n + j; LOGF[((size_t)(b * NH + h) << 12) + s] = logsigmoidf(acc[ai][0][m][n][j] * r + bfb[h]); } }
        }
    }
};
struct EpiSwaIn {
    static constexpr bool PERM = true, AFTER_DRAIN = false;
    bf16_t *Q, *K, *V, *G; const float* SS; const float* ROPE;
    __device__ __forceinline__ void operator()(const f32x4 (&acc)[2][2][4][2], const Unit& u, int wr, int wc, int fr, int fq) const {
        const int row0 = u.pm * BM + wr * 64 + fr, pn = u.pn;
        bf16_t* base; int pitch, colt; float osc = 1.f; const bool rope = pn <= 8, gate = pn >= 10;
        if (pn < 8) { base = Q; pitch = DM; colt = pn * BM; osc = C2; } else if (pn == 8) { base = K; pitch = KVW; colt = 0; } else if (pn == 9) { base = V; pitch = KVW; colt = 0; } else { base = G; pitch = DM; colt = (pn - 10) * BM; }
        const int col0 = colt + wc * 32 + 8 * fq; const bool rotw = rope && ((wc & 1) == 0); const float sgn = fq == 0 ? -1.f : 1.f; const bool rotl = fq < 2;
        float rs[2][4];
#pragma unroll
        for (int ai = 0; ai < 2; ++ai)
#pragma unroll
            for (int m = 0; m < 4; ++m) rs[ai][m] = SS[row0 + ai * HALF + m * 16];
        f32x4 nc0, nc1, ns0, ns1;
        if (rotw) { const float* rp = ROPE + (size_t)(row0 & 4095) * 16; nc0 = *(const f32x4*)rp; nc1 = *(const f32x4*)(rp + 4); ns0 = *(const f32x4*)(rp + 8); ns1 = *(const f32x4*)(rp + 12); }
#pragma unroll
        for (int ai = 0; ai < 2; ++ai)
#pragma unroll
            for (int m = 0; m < 4; ++m) { const int row = row0 + ai * HALF + m * 16; const float r = 1.0f / sqrtf(rs[ai][m] * (1.f / DM) + RMS_EPS);
                const f32x4 c0 = nc0, c1 = nc1, s0 = ns0, s1 = ns1;
                if (rotw && (ai * 4 + m) < 7) { const int nrow = row0 + ((ai * 4 + m + 1) >> 2) * HALF + ((ai * 4 + m + 1) & 3) * 16; const float* rp = ROPE + (size_t)(nrow & 4095) * 16; nc0 = *(const f32x4*)rp; nc1 = *(const f32x4*)(rp + 4); ns0 = *(const f32x4*)(rp + 8); ns1 = *(const f32x4*)(rp + 12); }
#pragma unroll
                for (int bj = 0; bj < 2; ++bj) { f32x4 v0 = acc[ai][bj][m][0] * r, v1 = acc[ai][bj][m][1] * r;
                    if (rotw) {
#pragma unroll
                        for (int j = 0; j < 4; ++j) { const float p0 = __shfl_xor(v0[j], 16), p1 = __shfl_xor(v1[j], 16);
                            const float n0 = v0[j] * c0[j] + sgn * p0 * s0[j], n1 = v1[j] * c1[j] + sgn * p1 * s1[j];
                            v0[j] = rotl ? n0 : v0[j]; v1[j] = rotl ? n1 : v1[j]; } }
                    if (gate) {
#pragma unroll
                        for (int j = 0; j < 4; ++j) { v0[j] = silu_fast(v0[j]); v1[j] = silu_fast(v1[j]); } }
                    v0 = v0 * osc; v1 = v1 * osc;
                    *(u32x4*)(base + hm_off(row, col0 + bj * HALF, pitch >> 6)) = pack8(v0, v1); } }
    }
};
template <bool FIRST> struct EpiRes {
    static constexpr bool PERM = true, AFTER_DRAIN = false;
    const float* xin; bf16_t* XB; float* SS;
    __device__ __forceinline__ void operator()(const f32x4 (&acc)[2][2][4][2], const Unit& u, int wr, int wc, int fr, int fq) const {
        const int row0 = u.pm * BM + wr * 64 + fr, col0 = u.pn * BM + wc * 32 + 8 * fq;
        if (FIRST) {
            f32x4 nx[2][2];
#pragma unroll
            for (int bj = 0; bj < 2; ++bj)
#pragma unroll
                for (int n = 0; n < 2; ++n) nx[bj][n] = *(const f32x4*)(xin + (size_t)row0 * DM + col0 + bj * HALF + n * 4);
#pragma unroll
            for (int ai = 0; ai < 2; ++ai)
#pragma unroll
                for (int m = 0; m < 4; ++m) { const int row = row0 + ai * HALF + m * 16; float ss = 0.f;
                    f32x4 cx[2][2];
#pragma unroll
                    for (int bj = 0; bj < 2; ++bj)
#pragma unroll
                        for (int n = 0; n < 2; ++n) cx[bj][n] = nx[bj][n];
                    if ((ai * 4 + m) < 7) { const int nrow = row0 + ((ai * 4 + m + 1) >> 2) * HALF + ((ai * 4 + m + 1) & 3) * 16;
#pragma unroll
                        for (int bj = 0; bj < 2; ++bj)
#pragma unroll
                            for (int n = 0; n < 2; ++n) nx[bj][n] = *(const f32x4*)(xin + (size_t)nrow * DM + col0 + bj * HALF + n * 4); }
#pragma unroll
                    for (int bj = 0; bj < 2; ++bj) { const f32x4 x0 = cx[bj][0] + acc[ai][bj][m][0], x1 = cx[bj][1] + acc[ai][bj][m][1];
                        *(u32x4*)(XB + tiled_off(row, col0 + bj * HALF)) = pack8(x0, x1);
                        ss += ((x0[0] * x0[0] + x0[1] * x0[1]) + (x0[2] * x0[2] + x0[3] * x0[3])) + ((x1[0] * x1[0] + x1[1] * x1[1]) + (x1[2] * x1[2] + x1[3] * x1[3])); }
                    ss += __shfl_xor(ss, 16); ss += __shfl_xor(ss, 32); if (fq == 0) atomicAdd(SS + row, ss); }
        } else {
            u32x4 xv[2][4][2];
#pragma unroll
            for (int ai = 0; ai < 2; ++ai)
#pragma unroll
                for (int m = 0; m < 4; ++m)
#pragma unroll
                    for (int bj = 0; bj < 2; ++bj) xv[ai][m][bj] = *(const u32x4*)(XB + tiled_off(row0 + ai * HALF + m * 16, col0 + bj * HALF));
#pragma unroll
            for (int ai = 0; ai < 2; ++ai)
#pragma unroll
                for (int m = 0; m < 4; ++m)
#pragma unroll
                    for (int bj = 0; bj < 2; ++bj) { const u32x4 xw = xv[ai][m][bj]; const f32x4 a0 = acc[ai][bj][m][0], a1 = acc[ai][bj][m][1];
                        const f32x4 y0 = {__uint_as_float(xw.x << 16) + a0[0], __uint_as_float(xw.x & 0xffff0000u) + a0[1], __uint_as_float(xw.y << 16) + a0[2], __uint_as_float(xw.y & 0xffff0000u) + a0[3]};
                        const f32x4 y1 = {__uint_as_float(xw.z << 16) + a1[0], __uint_as_float(xw.z & 0xffff0000u) + a1[1], __uint_as_float(xw.w << 16) + a1[2], __uint_as_float(xw.w & 0xffff0000u) + a1[3]};
                        *(u32x4*)(XB + tiled_off(row0 + ai * HALF + m * 16, col0 + bj * HALF)) = pack8(y0, y1); }
        }
    }
};
template <class Epi, class Sched, bool ALIGN_EPI = false, bool SP2 = false>
__device__ __forceinline__ void gemm_phase(PG8_LAS unsigned char* lds, const Gemm g, const Sched& S, const Epi& E) {
    const int tid = threadIdx.x, wid = __builtin_amdgcn_readfirstlane(tid >> 6), lane = tid & 63, wr = wid >> 2, wc = wid & 3, fr = lane & 15, fq = lane >> 4;
    const int K = g.K, nt = K / BK;
    unsigned voffA[2], voffB[2];
#pragma unroll
    for (int i = 0; i < 2; ++i) { int R, C; stage_rc(tid * 16 + i * 8192, R, C); const int Rb = Epi::PERM ? ((R & ~31) + perm32(R & 31)) : R;
        voffA[i] = (unsigned)((C >> 5) * (BM * 32) + R * 32 + (C & 31)) * 2u; voffB[i] = (unsigned)((C >> 5) * (BM * 32) + Rb * 32 + (C & 31)) * 2u; }
    const size_t kstep = (size_t)(BM * BK * 2);
    const size_t hstep = (size_t)(HALF * 32 * 2);
    const size_t tstep = (size_t)BM * K * 2;
    const unsigned ldsw = (unsigned)wid * 1024u;
    const int aoff = lds_byte(wr * 64 + fr, fq * 8), boff = lds_byte(wc * 32 + fr, fq * 8);
#define PG8_SA(b, h) (((b) * 2 + (h)) * HTB)
#define PG8_SB(b, h) ((4 + (b) * 2 + (h)) * HTB)
#define PG8_STAGE(bufoff, gbase, voff) do { _Pragma("unroll") for (int _i = 0; _i < 2; ++_i) \
        __builtin_amdgcn_global_load_lds((const unsigned*)((const char*)(gbase) + (voff)[_i]), (PG8_LAS unsigned*)(lds + (bufoff) + ldsw + _i * 8192), 16, 0, 0); } while (0)
#define PG8_LDA(dst, b, h) do { _Pragma("unroll") for (int m = 0; m < 4; ++m) _Pragma("unroll") for (int k = 0; k < 2; ++k) dst[m][k] = *(const PG8_LAS bf16x8*)(lds + PG8_SA(b, h) + aoff + m * 2048 + k * 1024); } while (0)
#define PG8_LDB(dst, b, h) do { _Pragma("unroll") for (int n = 0; n < 2; ++n) _Pragma("unroll") for (int k = 0; k < 2; ++k) dst[n][k] = *(const PG8_LAS bf16x8*)(lds + PG8_SB(b, h) + boff + n * 2048 + k * 1024); } while (0)
#define PG8_MMA(ai, bj, At, Bt) do { __builtin_amdgcn_s_setprio(1); _Pragma("unroll") for (int m = 0; m < 4; ++m) _Pragma("unroll") for (int n = 0; n < 2; ++n) _Pragma("unroll") for (int k = 0; k < 2; ++k) \
        acc[ai][bj][m][n] = __builtin_amdgcn_mfma_f32_16x16x32_bf16(Bt[n][k], At[m][k], acc[ai][bj][m][n], 0, 0, 0); __builtin_amdgcn_s_setprio(0); } while (0)
#define PG8_WAIT_V(n) asm volatile("s_waitcnt vmcnt(" #n ")" ::: "memory")
#define PG8_WAIT_L(n) asm volatile("s_waitcnt lgkmcnt(" #n ")" ::: "memory")
#define PG8_BAR __builtin_amdgcn_s_barrier()
#define PG8_SCHED __builtin_amdgcn_sched_barrier(0)
    Unit cur, nxt; int ui = 0;
    if (!S.next(0, cur)) return;
    f32x4 acc[2][2][4][2];
#pragma unroll
    for (int a = 0; a < 2; ++a)
#pragma unroll
        for (int b = 0; b < 2; ++b)
#pragma unroll
            for (int m = 0; m < 4; ++m)
#pragma unroll
                for (int n = 0; n < 2; ++n) acc[a][b][m][n] = (f32x4){0.f, 0.f, 0.f, 0.f};
    bf16x8 At[4][2], B0[2][2], B1[2][2];
    const char* cA = (const char*)g.A + (size_t)cur.lm * tstep; const char* cB = (const char*)g.Bt + (size_t)cur.ln * tstep;
    S.a_ready(cur);
    if constexpr (SP2) {
        PG8_STAGE(PG8_SB(0, 0), cB, voffB); PG8_STAGE(PG8_SB(0, 1), cB + hstep, voffB); PG8_STAGE(PG8_SA(0, 0), cA, voffA); PG8_STAGE(PG8_SA(0, 1), cA + hstep, voffA);
        if (wr == 1) PG8_BAR;
        PG8_WAIT_V(2); PG8_BAR;
        PG8_STAGE(PG8_SB(1, 0), cB + kstep, voffB); PG8_STAGE(PG8_SA(1, 0), cA + kstep, voffA); PG8_STAGE(PG8_SB(1, 1), cB + hstep + kstep, voffB);
        PG8_WAIT_V(6); PG8_BAR;
    } else {
        PG8_STAGE(PG8_SB(0, 0), cB, voffB); PG8_STAGE(PG8_SA(0, 0), cA, voffA); PG8_STAGE(PG8_SB(0, 1), cB + hstep, voffB); PG8_STAGE(PG8_SA(0, 1), cA + hstep, voffA);
        if (wr == 1) PG8_BAR;
        PG8_WAIT_V(4); PG8_BAR;
        PG8_STAGE(PG8_SB(1, 0), cB + kstep, voffB); PG8_STAGE(PG8_SA(1, 0), cA + kstep, voffA); PG8_STAGE(PG8_SB(1, 1), cB + hstep + kstep, voffB);
        PG8_WAIT_V(6); PG8_BAR;
    }
    for (;;) {
        const bool has_next = S.next(ui + 1, nxt);
        const char* nA = has_next ? (const char*)g.A + (size_t)nxt.lm * tstep : cA; const char* nB = has_next ? (const char*)g.Bt + (size_t)nxt.ln * tstep : cB;
        for (int t = 0; t < nt; t += 2) {
            const bool last = (t == nt - 2);
            const char* a1 = cA + (size_t)(t + 1) * kstep;
            const char* a2 = last ? nA : cA + (size_t)(t + 2) * kstep; const char* b2 = last ? nB : cB + (size_t)(t + 2) * kstep;
            const char* a3 = a2 + kstep; const char* b3 = b2 + kstep;
            if (last && has_next) S.a_ready(nxt);
            if constexpr (SP2) {
            PG8_LDB(B0, 0, 0); PG8_LDB(B1, 0, 1); PG8_SCHED; PG8_LDA(At, 0, 0); PG8_STAGE(PG8_SA(1, 1), a1 + hstep, voffA);
            PG8_WAIT_V(8); PG8_WAIT_L(0); PG8_BAR; PG8_MMA(0, 0, At, B0); PG8_MMA(0, 1, At, B1); PG8_BAR; PG8_SCHED;
            PG8_LDA(At, 0, 1); PG8_STAGE(PG8_SB(0, 0), b2, voffB); PG8_STAGE(PG8_SB(0, 1), b2 + hstep, voffB); PG8_STAGE(PG8_SA(0, 0), a2, voffA);
            PG8_WAIT_V(8); PG8_WAIT_L(0); PG8_BAR; PG8_MMA(1, 0, At, B0); PG8_MMA(1, 1, At, B1); PG8_BAR; PG8_SCHED;
            PG8_LDB(B0, 1, 0); PG8_LDB(B1, 1, 1); PG8_SCHED; PG8_LDA(At, 1, 0); PG8_STAGE(PG8_SA(0, 1), a2 + hstep, voffA);
            PG8_WAIT_V(8); PG8_WAIT_L(0); PG8_BAR; PG8_MMA(0, 0, At, B0); PG8_MMA(0, 1, At, B1); PG8_BAR; PG8_SCHED;
            PG8_LDA(At, 1, 1); PG8_STAGE(PG8_SB(1, 0), b3, voffB); PG8_STAGE(PG8_SB(1, 1), b3 + hstep, voffB); PG8_STAGE(PG8_SA(1, 0), a3, voffA);
            PG8_WAIT_V(8); PG8_WAIT_L(0); PG8_BAR; PG8_MMA(1, 0, At, B0); PG8_MMA(1, 1, At, B1); PG8_BAR; PG8_SCHED;
            } else {
            PG8_LDB(B0, 0, 0); PG8_SCHED; PG8_LDA(At, 0, 0); PG8_STAGE(PG8_SA(1, 1), a1 + hstep, voffA);
            PG8_WAIT_L(8); PG8_BAR; PG8_WAIT_L(0); PG8_MMA(0, 0, At, B0); PG8_BAR; PG8_SCHED;
            PG8_LDB(B1, 0, 1); PG8_STAGE(PG8_SB(0, 0), b2, voffB);
            PG8_BAR; PG8_WAIT_L(0); PG8_MMA(0, 1, At, B1); PG8_BAR;
            PG8_LDA(At, 0, 1); PG8_STAGE(PG8_SA(0, 0), a2, voffA);
            PG8_BAR; PG8_WAIT_L(0); PG8_MMA(1, 0, At, B0); PG8_BAR; PG8_SCHED;
            PG8_STAGE(PG8_SB(0, 1), b2 + hstep, voffB);
            PG8_WAIT_V(6); PG8_BAR; PG8_MMA(1, 1, At, B1); PG8_BAR;
            PG8_LDB(B0, 1, 0); PG8_SCHED; PG8_LDA(At, 1, 0); PG8_STAGE(PG8_SA(0, 1), a2 + hstep, voffA);
            PG8_WAIT_L(8); PG8_BAR; PG8_WAIT_L(0); PG8_MMA(0, 0, At, B0); PG8_BAR; PG8_SCHED;
            PG8_LDB(B1, 1, 1); PG8_STAGE(PG8_SB(1, 0), b3, voffB);
            PG8_BAR; PG8_WAIT_L(0); PG8_MMA(0, 1, At, B1); PG8_BAR;
            PG8_LDA(At, 1, 1); PG8_STAGE(PG8_SA(1, 0), a3, voffA);
            PG8_BAR; PG8_WAIT_L(0); PG8_MMA(1, 0, At, B0); PG8_BAR; PG8_SCHED;
            PG8_STAGE(PG8_SB(1, 1), b3 + hstep, voffB);
            PG8_WAIT_V(6); PG8_BAR; PG8_MMA(1, 1, At, B1); PG8_BAR;
            }
        }
        if constexpr (ALIGN_EPI) { if (wr == 0) PG8_BAR; }
        if constexpr (!Epi::AFTER_DRAIN) { E(acc, cur, wr, wc, fr, fq); if (S.epi2) E(acc, cur, wr, wc, fr, fq); S.done(cur); }
        if (!has_next) break;
#pragma unroll
        for (int a = 0; a < 2; ++a)
#pragma unroll
            for (int b = 0; b < 2; ++b)
#pragma unroll
                for (int m = 0; m < 4; ++m)
#pragma unroll
                    for (int n = 0; n < 2; ++n) acc[a][b][m][n] = (f32x4){0.f, 0.f, 0.f, 0.f};
        cur = nxt; cA = nA; cB = nB; ++ui;
        if constexpr (ALIGN_EPI) { if (wr == 1) PG8_BAR; }
    }
    PG8_WAIT_V(0);
    if constexpr (!ALIGN_EPI) { if (wr == 0) PG8_BAR; }
    PG8_BAR;
    if constexpr (Epi::AFTER_DRAIN) { E.fused(acc, cur, wr, wc, fr, fq, lds, wid, lane); S.done(cur); }
#undef PG8_SA
#undef PG8_SB
#undef PG8_STAGE
#undef PG8_LDA
#undef PG8_LDB
#undef PG8_MMA
#undef PG8_WAIT_V
#undef PG8_WAIT_L
#undef PG8_BAR
#undef PG8_SCHED
}
}
namespace fa {
#define FA_LAS __attribute__((address_space(3)))
typedef short bf16x8 __attribute__((ext_vector_type(8)));
typedef short s16x4 __attribute__((ext_vector_type(4)));
typedef short v4i16_t __attribute__((ext_vector_type(4)));
typedef float f32x16 __attribute__((ext_vector_type(16)));
typedef float f32x4 __attribute__((ext_vector_type(4)));
typedef unsigned u32x4 __attribute__((ext_vector_type(4)));
typedef float f32x2_t __attribute__((ext_vector_type(2))); typedef __bf16 bf16x2_t __attribute__((ext_vector_type(2)));
constexpr float THR = 8.f, TH_SKIP = 32.f;
constexpr int F_KBUF = 18432, F_AOFF = 8192, F_VOFF = 10240, F_WSF = 3 * F_KBUF, F_FLAG = F_WSF + 8 * 256, F_OST = F_FLAG + 256, F_LDS_BYTES = F_OST + 8 * 4096;
constexpr int S_KBUF = 16384, S_VOFF = 8192, S_WSF = 6 * S_KBUF, S_OST = S_WSF + 8 * 256, S_LDS_BYTES = S_OST + 8 * 4096;
struct Params { const bf16_t* Q; const bf16_t* K; const bf16_t* V; const bf16_t* G; bf16_t* O; const float* CUM; const float* sinks; const unsigned* KMAX; unsigned* ticket; const bf16_t* KAUG; };
__device__ __forceinline__ unsigned cvtpk(float lo, float hi) { f32x2_t v = {lo, hi}; bf16x2_t b = __builtin_convertvector(v, bf16x2_t); return __builtin_bit_cast(unsigned, b); }
__device__ __forceinline__ s16x4 vtr(FA_LAS unsigned char* p) { return __builtin_bit_cast(s16x4, __builtin_amdgcn_ds_read_tr16_b64_v4i16((FA_LAS v4i16_t*)p)); }
__device__ __forceinline__ float swap_max(float v) { auto rr = __builtin_amdgcn_permlane32_swap(__float_as_uint(v), __float_as_uint(v), false, false); return __builtin_fmaxf(__uint_as_float(rr[0]), __uint_as_float(rr[1])); }
__device__ __forceinline__ float swap_add(float v) { auto rr = __builtin_amdgcn_permlane32_swap(__float_as_uint(v), __float_as_uint(v), false, false); return __uint_as_float(rr[0]) + __uint_as_float(rr[1]); }
__device__ __forceinline__ void glds16(const void* gsrc, unsigned lds_dst) { unsigned keep;
    asm volatile("s_mov_b32 %0, m0\n\ts_mov_b32 m0, %2\n\ts_nop 0\n\tglobal_load_lds_dwordx4 %1, off\n\ts_mov_b32 m0, %0" : "=&s"(keep) : "v"(gsrc), "s"(lds_dst) : "memory"); }
#define FA_MFMA(a, b, c) __builtin_amdgcn_mfma_f32_32x32x16_bf16((a), (b), (c), 0, 0, 0)
#define FA_MX3(a, b, c) __builtin_fmaxf(__builtin_fmaxf((a), (b)), (c))
struct WaveSt { bf16x8 qr[4]; bf16x8 qa; f32x16 cinit, o0, o1; float cq, mhat, lsum, mrun; };

#define FA_SBAR() __builtin_amdgcn_sched_barrier(0)
#define FA_PIN(x) asm volatile("" : "+v"(x))
#define FA_LDK(p) (*(FA_LAS bf16x8*)(p))
#define FA_VF(l, h) ((bf16x8){l[0], l[1], l[2], l[3], h[0], h[1], h[2], h[3]})
#define FA_EX4(X, B) do { X[B] = __builtin_amdgcn_exp2f(X[B]); X[B + 1] = __builtin_amdgcn_exp2f(X[B + 1]); X[B + 2] = __builtin_amdgcn_exp2f(X[B + 2]); X[B + 3] = __builtin_amdgcn_exp2f(X[B + 3]); } while (0)
__device__ __forceinline__ void split3(float v, unsigned& h1, unsigned& h2, unsigned& h3) { const bf16_t a = f2bf(v); const float r1 = v - bf2f(a); const bf16_t b = f2bf(r1); const float r2 = r1 - bf2f(b); h1 = a; h2 = b; h3 = f2bf(r2); }
__device__ __forceinline__ void set_qa(WaveSt& w, int hi) {
    unsigned g1, g2, g3; split3(w.cq - w.mhat, g1, g2, g3);
    const u32x4 q = {hi == 0 ? 0x3F803F80u : 0u, hi == 0 ? (0x3F80u | (g1 << 16)) : 0u, hi == 0 ? (g2 | (g3 << 16)) : 0u, 0u};
    w.qa = __builtin_bit_cast(bf16x8, q);
}
template <int MODE, int AOFF, int VOFF, int HB>
__device__ __forceinline__ void half_step(FA_LAS unsigned char* bb, FA_LAS unsigned char* vprev, FA_LAS float* wsf, WaveSt& w, f32x16& C, f32x16& P, int k0, int t, int qlo, int lane, int r32, int hi) {
    constexpr int W = MODE == 0 ? 0x40000000 : 128;
    FA_LAS unsigned char* kp = bb + hi * 1024 + r32 * 16 + HB * 512; FA_LAS unsigned char* ap = bb + AOFF + r32 * 16 + HB * 512;
    FA_LAS unsigned char* vp = (HB == 0 ? vprev + 2048 : bb) + VOFF + ((lane >> 4) & 1) * 32 + (lane & 3) * 8 + (4 * hi + ((lane & 15) >> 2)) * 64;
    bf16x8 kf0 = FA_LDK(kp), kf1 = FA_LDK(kp + 2048), kf2, kf3, ka;
    s16x4 vl0, vh0, vl1, vh1, vl2, vh2, vl3, vh3; u32x4 pw0, pw1; float sacc;
    FA_SBAR();
    if (MODE == 0) C = FA_MFMA(kf0, w.qr[0], ((f32x16){0.f, 0.f, 0.f, 0.f, 0.f, 0.f, 0.f, 0.f, 0.f, 0.f, 0.f, 0.f, 0.f, 0.f, 0.f, 0.f})); else C = FA_MFMA(kf0, w.qr[0], w.cinit);
    kf2 = FA_LDK(kp + 4096);
    sacc = (P[0] + P[1]) + (P[2] + P[3]); pw0.x = cvtpk(P[0], P[1]); pw0.y = cvtpk(P[2], P[3]); FA_PIN(sacc); FA_PIN(pw0.x); FA_PIN(pw0.y);
    FA_SBAR();
    C = FA_MFMA(kf1, w.qr[1], C); kf3 = FA_LDK(kp + 6144);
    sacc += P[4]; sacc += P[5]; sacc += P[6]; sacc += P[7]; pw0.z = cvtpk(P[4], P[5]); pw0.w = cvtpk(P[6], P[7]); FA_PIN(sacc); FA_PIN(pw0.z); FA_PIN(pw0.w);
    FA_SBAR();
    C = FA_MFMA(kf2, w.qr[2], C); if (MODE == 0) ka = FA_LDK(ap);
    sacc += P[8]; sacc += P[9]; sacc += P[10]; sacc += P[11]; pw1.x = cvtpk(P[8], P[9]); pw1.y = cvtpk(P[10], P[11]); FA_PIN(sacc); FA_PIN(pw1.x); FA_PIN(pw1.y); vl0 = vtr(vp); vh0 = vtr(vp + 512);
    FA_SBAR();
    C = FA_MFMA(kf3, w.qr[3], C);
    sacc += P[12]; sacc += P[13]; sacc += P[14]; sacc += P[15]; pw1.z = cvtpk(P[12], P[13]); pw1.w = cvtpk(P[14], P[15]); FA_PIN(sacc); FA_PIN(pw1.z); FA_PIN(pw1.w); vl1 = vtr(vp + 4096); vh1 = vtr(vp + 4096 + 512);
    FA_SBAR();
    if (MODE == 0) { C = FA_MFMA(ka, w.qa, C); FA_SBAR(); }
    w.lsum += sacc;
    const bf16x8 pa0 = __builtin_bit_cast(bf16x8, pw0), pa1 = __builtin_bit_cast(bf16x8, pw1);
    vl2 = vtr(vp + 1024); vh2 = vtr(vp + 1024 + 512);
    w.o0 = FA_MFMA(pa0, FA_VF(vl0, vh0), w.o0); vl3 = vtr(vp + 4096 + 1024); vh3 = vtr(vp + 4096 + 1024 + 512);
    w.o1 = FA_MFMA(pa0, FA_VF(vl1, vh1), w.o1);
    FA_SBAR();
    const int kh = k0 + 32 * HB;
    if ((kh + 31 > qlo) || (MODE == 1 && kh <= qlo + 31 - W)) {
        const float NEG = -__builtin_inff(); const int dq = t - kh - 4 * hi;
#pragma unroll
        for (int r = 0; r < 16; ++r) { const int c = (r & 3) + 8 * (r >> 2); if ((unsigned)(dq - c) >= (unsigned)W) C[r] = NEG; }
    }
    float ma = FA_MX3(C[0], C[1], C[2]), mb = FA_MX3(C[3], C[4], C[5]);
    ma = FA_MX3(ma, C[6], C[7]); mb = FA_MX3(mb, C[8], C[9]); ma = FA_MX3(ma, C[10], C[11]); mb = FA_MX3(mb, C[12], C[13]); ma = FA_MX3(ma, C[14], C[15]);
    const float rm = swap_max(__builtin_fmaxf(ma, mb));
    if (MODE == 0) w.mrun = __builtin_fmaxf(w.mrun, rm + w.mhat);
    const bool resc = __any(rm > THR);
    if (resc) {
        const float dl = __builtin_fmaxf(rm, 0.f); w.mhat += dl;
#pragma unroll
        for (int r = 0; r < 16; ++r) C[r] -= dl;
        if (MODE == 0) set_qa(w, hi);
        else { const float ci = w.cq - w.mhat;
#pragma unroll
            for (int r = 0; r < 16; ++r) w.cinit[r] = ci; }
        const float f = __builtin_amdgcn_exp2f(-dl); w.lsum *= f;
        if (hi == 0) wsf[r32] = f;
    }
    FA_SBAR();
    FA_EX4(C, 0); FA_PIN(C);
    w.o0 = FA_MFMA(pa1, FA_VF(vl2, vh2), w.o0); FA_EX4(C, 4); FA_EX4(C, 8); FA_PIN(C); FA_SBAR();
    w.o1 = FA_MFMA(pa1, FA_VF(vl3, vh3), w.o1); FA_EX4(C, 12); FA_PIN(C); FA_SBAR();
    if (resc) {
        asm volatile("s_waitcnt lgkmcnt(0)" ::: "memory");
#pragma unroll
        for (int g = 0; g < 4; ++g) { const f32x4 a4 = *(FA_LAS f32x4*)(wsf + 8 * g + 4 * hi);
#pragma unroll
            for (int i = 0; i < 4; ++i) { w.o0[4 * g + i] *= a4[i]; w.o1[4 * g + i] *= a4[i]; } }
    }
}
template <int MODE, int AOFF, int VOFF>
__device__ __forceinline__ void tile_step(FA_LAS unsigned char* bb, FA_LAS unsigned char* vprev, FA_LAS float* wsf, WaveSt& w, f32x16& pA, f32x16& pB, int k0, int t, int qlo, int lane, int r32, int hi) {
    half_step<MODE, AOFF, VOFF, 0>(bb, vprev, wsf, w, pA, pB, k0, t, qlo, lane, r32, hi);
    half_step<MODE, AOFF, VOFF, 1>(bb, vprev, wsf, w, pB, pA, k0, t, qlo, lane, r32, hi);
}
template <int VOFF>
__device__ __forceinline__ void tile_drain(FA_LAS unsigned char* vlast, WaveSt& w, f32x16& P, int lane, int hi) {
    FA_LAS unsigned char* vp = vlast + 2048 + VOFF + ((lane >> 4) & 1) * 32 + (lane & 3) * 8 + (4 * hi + ((lane & 15) >> 2)) * 64;
    float s0 = 0.f;
#pragma unroll
    for (int r = 0; r < 16; ++r) s0 += P[r];
    w.lsum += s0;
    const u32x4 w0 = {cvtpk(P[0], P[1]), cvtpk(P[2], P[3]), cvtpk(P[4], P[5]), cvtpk(P[6], P[7])};
    const u32x4 w1 = {cvtpk(P[8], P[9]), cvtpk(P[10], P[11]), cvtpk(P[12], P[13]), cvtpk(P[14], P[15])};
    const bf16x8 pa0 = __builtin_bit_cast(bf16x8, w0), pa1 = __builtin_bit_cast(bf16x8, w1);
    { const s16x4 l0 = vtr(vp), h0 = vtr(vp + 512), l1 = vtr(vp + 4096), h1 = vtr(vp + 4096 + 512); w.o0 = FA_MFMA(pa0, FA_VF(l0, h0), w.o0); w.o1 = FA_MFMA(pa0, FA_VF(l1, h1), w.o1); }
    { const s16x4 l0 = vtr(vp + 1024), h0 = vtr(vp + 1024 + 512), l1 = vtr(vp + 4096 + 1024), h1 = vtr(vp + 4096 + 1024 + 512); w.o0 = FA_MFMA(pa1, FA_VF(l0, h0), w.o0); w.o1 = FA_MFMA(pa1, FA_VF(l1, h1), w.o1); }
}
__device__ __forceinline__ void load_gate(u32x4 (&gq)[4], const bf16_t* G, size_t grow, int h, int lane) {
#pragma unroll
    for (int d0 = 0; d0 < 2; ++d0)
#pragma unroll
        for (int i = 0; i < 2; ++i) gq[2 * d0 + i] = *(const u32x4*)(G + hm_off((int)grow + i * 16 + (lane >> 2), h * 64 + d0 * 32 + (lane & 3) * 8, NH));
}
__device__ __forceinline__ void wave_epilogue(FA_LAS float* stg, FA_LAS float* wsf, WaveSt& w, const u32x4 (&gq)[4], bf16_t* O, size_t grow, int h, int lane, int r32, int hi) {
    const float l = swap_add(w.lsum);
    if (hi == 0) wsf[r32] = l;
    asm volatile("s_waitcnt lgkmcnt(0)" ::: "memory");
    float rl[16];
#pragma unroll
    for (int g = 0; g < 4; ++g) { const f32x4 l4 = *(FA_LAS f32x4*)(wsf + 8 * g + 4 * hi);
#pragma unroll
        for (int i = 0; i < 4; ++i) rl[4 * g + i] = 1.0f / l4[i]; }
#pragma unroll
    for (int d0 = 0; d0 < 2; ++d0) {
#pragma unroll
        for (int g = 0; g < 4; ++g)
#pragma unroll
            for (int i = 0; i < 4; ++i) stg[(8 * g + 4 * hi + i) * 32 + r32] = (d0 == 0 ? w.o0[4 * g + i] : w.o1[4 * g + i]) * rl[4 * g + i];
        asm volatile("s_waitcnt lgkmcnt(0)" ::: "memory");
#pragma unroll
        for (int i = 0; i < 2; ++i) { const int row = i * 16 + (lane >> 2), ch = lane & 3;
            const f32x4 x0 = *(FA_LAS f32x4*)(stg + row * 32 + ch * 8), x1 = *(FA_LAS f32x4*)(stg + row * 32 + ch * 8 + 4);
            const size_t ga = (grow + row) * DM + h * 64 + d0 * 32 + ch * 8; const u32x4 gv = gq[2 * d0 + i];
            u32x4 ov;
            ov.x = cvtpk(x0[0] * __uint_as_float(gv.x << 16), x0[1] * __uint_as_float(gv.x & 0xffff0000u)); ov.y = cvtpk(x0[2] * __uint_as_float(gv.y << 16), x0[3] * __uint_as_float(gv.y & 0xffff0000u));
            ov.z = cvtpk(x1[0] * __uint_as_float(gv.z << 16), x1[1] * __uint_as_float(gv.z & 0xffff0000u)); ov.w = cvtpk(x1[2] * __uint_as_float(gv.w << 16), x1[3] * __uint_as_float(gv.w & 0xffff0000u));
            *(u32x4*)(O + tiled_off((int)(grow + row), h * 64 + d0 * 32 + ch * 8)) = ov; }
        asm volatile("s_waitcnt lgkmcnt(0)" ::: "memory");
    }
}
template <int MODE> __device__ __forceinline__ void wave_init(WaveSt& w, int hi) {
#pragma unroll
    for (int r = 0; r < 16; ++r) { w.o0[r] = 0.f; w.o1[r] = 0.f; }
    if (MODE == 0) set_qa(w, hi);
    else { const float ci = w.cq - w.mhat;
#pragma unroll
        for (int r = 0; r < 16; ++r) w.cinit[r] = ci; }
}

__device__ __forceinline__ void fox_unit(FA_LAS unsigned char* lds, const Params& P, int b, int h, int qb) {
    const int tid = threadIdx.x, lane = tid & 63, r32 = lane & 31, hi = lane >> 5;
    const int wid = __builtin_amdgcn_readfirstlane(tid >> 6);
    const int q0 = qb * 256, qlo = q0 + wid * 32, t = qlo + r32;
    const size_t rowbase = (size_t)b * SEQ;
    const bf16_t* ksrc = P.K + hm_off((int)rowbase + lane, h * 64 + wid * 8, NH);
    const bf16_t* vsrc = P.V + hm_off((int)rowbase + 16 * (wid & 3) + (lane >> 2), h * 64 + (wid >> 2) * 32 + (lane & 3) * 8, NH);
    const float* cum = P.CUM + (size_t)(b * NH + h) * SEQ;
    const bf16_t* asrc = P.KAUG + ((size_t)(b * NH + h) * SEQ + lane) * 8;
    const int NT = (q0 + 256) / 64;
    WaveSt w; float qn = 0.f;
#pragma unroll
    for (int d0 = 0; d0 < 4; ++d0) { w.qr[d0] = *(const bf16x8*)(P.Q + hm_off((int)rowbase + t, h * 64 + d0 * 16 + hi * 8, NH));
#pragma unroll
        for (int j = 0; j < 8; ++j) { const float qv = bf2f((bf16_t)w.qr[d0][j]); qn = fmaf(qv, qv, qn); } }
    w.cq = cum[t]; w.mhat = 0.f; w.lsum = 0.f; w.mrun = -1e30f;
    wave_init<0>(w, hi);
    u32x4 gq[4]; load_gate(gq, P.G, rowbase + qlo, h, lane);
    const float qkb = sqrtf(swap_add(qn) * (__uint_as_float(P.KMAX[(b * NH + h) * 2]) + __uint_as_float(P.KMAX[(b * NH + h) * 2 + 1]))) * 1.01f + 1e-3f;
    FA_LAS float* wsf = (FA_LAS float*)(lds + F_WSF) + wid * 64;
    FA_LAS unsigned* votes = (FA_LAS unsigned*)(lds + F_FLAG);
    float cnew = 0.f;
#define FA_LOADT(j, bf) do { const size_t ko_ = (size_t)(j) * 64 * 32; FA_LAS unsigned char* bb_ = lds + (bf) * F_KBUF; \
        glds16(ksrc + ko_, (unsigned)__builtin_amdgcn_readfirstlane((int)(unsigned)(uintptr_t)(bb_ + wid * 1024))); \
        glds16(vsrc + ko_, (unsigned)__builtin_amdgcn_readfirstlane((int)(unsigned)(uintptr_t)(bb_ + F_VOFF + (wid >> 2) * 4096 + (wid & 3) * 1024))); \
        if (wid == 0) glds16(asrc + (size_t)(j) * 64 * 8, (unsigned)__builtin_amdgcn_readfirstlane((int)(unsigned)(uintptr_t)(bb_ + F_AOFF))); \
        cnew = cum[(j) * 64 + 63]; } while (0)
    FA_LOADT(NT - 1, 0); asm volatile("s_waitcnt vmcnt(0)" ::: "memory"); __syncthreads();
    bool wdone = false, pend = false; f32x16 pA, pB;
#pragma unroll
    for (int r = 0; r < 16; ++r) pB[r] = 0.f;
    int cur = 0;
    for (int tt = 0; tt < NT; ++tt) {
        const int j = NT - 1 - tt, k0 = j * 64; const int nxt = cur == 2 ? 0 : cur + 1, prv = cur == 0 ? 2 : cur - 1;
        if (j > 0) FA_LOADT(j - 1, nxt);
        if (!wdone && k0 <= qlo + 31) {
            FA_LAS unsigned char* bb = lds + cur * F_KBUF;
            tile_step<0, F_AOFF, F_VOFF>(bb, pend ? lds + prv * F_KBUF : bb, wsf, w, pA, pB, k0, t, qlo, lane, r32, hi);
            pend = true;
        }
        if (j > 0) {
            if (!wdone && pend && __all(qkb + w.cq - cnew - w.mrun <= -TH_SKIP)) {
                wdone = true; tile_drain<F_VOFF>(lds + cur * F_KBUF, w, pB, lane, hi);
            }
            if (lane == 0) votes[(tt & 1) * 8 + wid] = wdone ? 1u : 0u;
        }
        asm volatile("s_waitcnt vmcnt(0)" ::: "memory");
        __syncthreads();
        if (j > 0) { const u32x4 v0 = *(FA_LAS u32x4*)(votes + (tt & 1) * 8), v1 = *(FA_LAS u32x4*)(votes + (tt & 1) * 8 + 4);
            if ((v0.x & v0.y & v0.z & v0.w & v1.x & v1.y & v1.z & v1.w) != 0u) break; }
        else if (!wdone) tile_drain<F_VOFF>(lds + cur * F_KBUF, w, pB, lane, hi);
        cur = nxt;
    }
#undef FA_LOADT
    wave_epilogue((FA_LAS float*)(lds + F_OST + wid * 4096), wsf, w, gq, P.O, rowbase + qlo, h, lane, r32, hi);
    __syncthreads();
}
__device__ __forceinline__ void swa_unit(FA_LAS unsigned char* lds, const Params& P, int b, int kvh, int qb) {
    const int tid = threadIdx.x, lane = tid & 63, r32 = lane & 31, hi = lane >> 5;
    const int wid = __builtin_amdgcn_readfirstlane(tid >> 6);
    const int q0 = qb * 256, qlo = q0 + wid * 32, t = qlo + r32;
    const size_t rowbase = (size_t)b * SEQ;
    const int j_lo = q0 >= 128 ? (q0 - 128) / 64 : 0, NT = (q0 + 256) / 64 - j_lo;
    const bf16_t* ksrc = P.K + hm_off((int)rowbase + j_lo * 64 + lane, kvh * 64 + wid * 8, 4);
    const bf16_t* vsrc = P.V + hm_off((int)rowbase + j_lo * 64 + 16 * (wid & 3) + (lane >> 2), kvh * 64 + (wid >> 2) * 32 + (lane & 3) * 8, 4);
    const int kdst = wid * 1024 + lane * 16, vdst = S_VOFF + (wid >> 2) * 4096 + (wid & 3) * 1024 + lane * 16;
    { u32x4 sk[6], sv[6];
#pragma unroll
      for (int i = 0; i < 6; ++i) if (i < NT) { sk[i] = *(const u32x4*)(ksrc + (size_t)i * 64 * 32); sv[i] = *(const u32x4*)(vsrc + (size_t)i * 64 * 32); }
#pragma unroll
      for (int i = 0; i < 6; ++i) if (i < NT) { *(FA_LAS u32x4*)(lds + i * S_KBUF + kdst) = sk[i]; *(FA_LAS u32x4*)(lds + i * S_KBUF + vdst) = sv[i]; } }
    __syncthreads();
    FA_LAS float* wsf = (FA_LAS float*)(lds + S_WSF) + wid * 64;
    const int ta = (qlo >= 127 ? (qlo - 127) / 64 : 0) - j_lo, tb = (qlo + 31) / 64 - j_lo;
    bf16x8 qn[4];
#pragma unroll
    for (int d0 = 0; d0 < 4; ++d0) qn[d0] = *(const bf16x8*)(P.Q + hm_off((int)rowbase + t, (kvh * 8) * 64 + d0 * 16 + hi * 8, NH));
    for (int hh = 0; hh < 8; ++hh) {
        const int h = kvh * 8 + hh;
        WaveSt w;
#pragma unroll
        for (int d0 = 0; d0 < 4; ++d0) w.qr[d0] = qn[d0];
#pragma unroll
        for (int d0 = 0; d0 < 4; ++d0) qn[d0] = *(const bf16x8*)(P.Q + hm_off((int)rowbase + t, (kvh * 8 + (hh < 7 ? hh + 1 : hh)) * 64 + d0 * 16 + hi * 8, NH));
        u32x4 gq[4]; load_gate(gq, P.G, rowbase + qlo, h, lane);
        w.cq = 0.f; w.mhat = P.sinks[h] * LOG2E; w.lsum = 0.5f; w.mrun = 0.f;
        wave_init<1>(w, hi);
        f32x16 pA, pB;
#pragma unroll
        for (int r = 0; r < 16; ++r) pB[r] = 0.f;
        for (int ti = tb; ti >= ta; --ti) { FA_LAS unsigned char* bb = lds + ti * S_KBUF;
            tile_step<1, 0, S_VOFF>(bb, ti == tb ? bb : bb + S_KBUF, wsf, w, pA, pB, (j_lo + ti) * 64, t, qlo, lane, r32, hi); }
        tile_drain<S_VOFF>(lds + ta * S_KBUF, w, pB, lane, hi);
        wave_epilogue((FA_LAS float*)(lds + S_OST + wid * 4096), wsf, w, gq, P.O, rowbase + qlo, h, lane, r32, hi);
    }
    __syncthreads();
}
}
#define GAS __attribute__((address_space(1)))
#define LAS __attribute__((address_space(3)))
typedef unsigned short bf16;
typedef unsigned v4u __attribute__((ext_vector_type(4)));
typedef float f32x4 __attribute__((ext_vector_type(4)));
typedef short bf16x8 __attribute__((ext_vector_type(8)));
typedef GAS unsigned gu32;
typedef GAS unsigned long long gu64;
#define RLX_AGENT __ATOMIC_RELAXED, __HIP_MEMORY_SCOPE_AGENT
#define LDS_WAIT() asm volatile("s_waitcnt lgkmcnt(0)" ::: "memory")
#define VM_WAIT() asm volatile("s_waitcnt vmcnt(0)" ::: "memory")
__device__ __forceinline__ unsigned long long rt() { return __builtin_amdgcn_s_memrealtime(); }
__device__ __forceinline__ unsigned pk2(float lo, float hi) { return (unsigned)f2bf(lo) | ((unsigned)f2bf(hi) << 16); }
#define XB_TMO      128
#define XB_XCNT(j)  (256  + 64 * (j))
#define XB_XSUB(j)  (1280 + 64 * (j))
#define XB_XGEN(j)  (2304 + 64 * (j))
#define XB_TOP      3328
#define XB_TOPGEN   3392
#define XCD_BAR_WORDS 3456
#define XB_SPIN_CAP (1u << 18)

__device__ __forceinline__ unsigned xb_ld(unsigned* p)              { return __hip_atomic_load(p, __ATOMIC_RELAXED, __HIP_MEMORY_SCOPE_AGENT); }
__device__ __forceinline__ unsigned xb_add(unsigned* p, unsigned v) { return __hip_atomic_fetch_add(p, v, __ATOMIC_RELAXED, __HIP_MEMORY_SCOPE_AGENT); }
__device__ __forceinline__ unsigned xb_xcc_id() { return (unsigned)__builtin_amdgcn_s_getreg((3 << 11) | 20) & 0xFu; }
#define XB_SPIN(cond, bar) do { unsigned _sp = 0; while (cond) { __builtin_amdgcn_s_sleep(1); \
    if ((++_sp & 255u) == 0u) { if (xb_ld(&(bar)[XB_TMO])) break; if (_sp > XB_SPIN_CAP) { atomicAdd(&(bar)[XB_TMO], 1u); break; } } } } while (0)

struct XcdBarrier {
    unsigned* bar; unsigned x;
    volatile LAS unsigned* st;
};

__device__ __forceinline__ XcdBarrier xcd_barrier_post(unsigned* bar, volatile LAS unsigned* st) {
    XcdBarrier b; b.bar = bar; b.x = xb_xcc_id(); b.st = st;
    if (threadIdx.x == 0) (void)xb_add(&bar[XB_XCNT(b.x)], 1u);
    return b;
}
__device__ __forceinline__ void xcd_barrier_complete(unsigned* bar, unsigned x, unsigned& nloc, unsigned& nx) {
    const unsigned G = gridDim.x * gridDim.y * gridDim.z;
    unsigned sum, cnt, mine, sp = 0u;
    for (;;) {
        sum = 0u; cnt = 0u; mine = 0u;
#pragma unroll
        for (unsigned j = 0; j < 16; ++j) { const unsigned c = xb_ld(&bar[XB_XCNT(j)]); sum += c; cnt += (c > 0u) ? 1u : 0u; mine = (j == x) ? c : mine; }
        if (sum == G) break;
        __builtin_amdgcn_s_sleep(1);
        if ((++sp & 255u) == 0u) { if (xb_ld(&bar[XB_TMO])) break; if (sp > XB_SPIN_CAP) { atomicAdd(&bar[XB_TMO], 1u); break; } }
    }
    nloc = mine > 0u ? mine : 1u; nx = cnt > 0u ? cnt : 1u;
}

__device__ __forceinline__ void xcd_barrier(const XcdBarrier& b) {
    asm volatile("s_waitcnt vmcnt(0)" ::: "memory");
    __syncthreads();
    if (threadIdx.x == 0) {
        unsigned* bar = b.bar;
        __builtin_amdgcn_s_waitcnt(0);
        unsigned nloc = b.st[0], nx = b.st[1];
        if (nloc == 0u) { xcd_barrier_complete(bar, b.x, nloc, nx); b.st[0] = nloc; b.st[1] = nx; }
        const unsigned old = xb_add(&bar[XB_XSUB(b.x)], 1u);
        const unsigned gen = old / nloc;
        if (old + 1u == (gen + 1u) * nloc) {
            __builtin_amdgcn_fence(__ATOMIC_RELEASE, "agent");
            asm volatile("s_waitcnt vmcnt(0)" ::: "memory");
            const unsigned og = xb_add(&bar[XB_TOP], 1u);
            const unsigned tg = og / nx;
            if (og + 1u == (tg + 1u) * nx) xb_add(&bar[XB_TOPGEN], 1u);
            else XB_SPIN(xb_ld(&bar[XB_TOPGEN]) == tg, bar);
            __builtin_amdgcn_fence(__ATOMIC_ACQUIRE, "agent");
            xb_add(&bar[XB_XGEN(b.x)], 1u);
            asm volatile("s_waitcnt vmcnt(0)" ::: "memory");
        } else {
            XB_SPIN(xb_ld(&bar[XB_XGEN(b.x)]) == gen, bar);
            __builtin_amdgcn_fence(__ATOMIC_ACQUIRE, "agent");
            asm volatile("s_waitcnt vmcnt(0)" ::: "memory");
        }
    }
    __syncthreads();
}
constexpr int NWAVES = 8;
constexpr int N1P = 8448;
constexpr int RING_OFF = 0, RING_BYTES = 135168;
constexpr int LDSCTL_OFF = RING_BYTES, MISC_OFF = LDSCTL_OFF + 320;
constexpr int LDS_BYTES = 147456;
constexpr int CW_BAR = 4096;
static_assert(fa::F_LDS_BYTES <= RING_BYTES && fa::S_LDS_BYTES <= RING_BYTES && pg8::STAGE_BYTES <= RING_BYTES && MISC_OFF + 128 <= LDS_BYTES && (CW_BAR + XCD_BAR_WORDS) * 4 <= (int)WS_KMAX, "LDS / CTL map");

__device__ __forceinline__ void p0_transpose_item(const float* W, int K, int N, bf16* WT, LAS float* scr, int item, int lane, const float* gs) {
    const int nblk = N / 32, kb = item / nblk, nb = item % nblk, k0 = 64 * kb, n0 = 32 * nb;
    const int kr = lane >> 3, nc = 4 * (lane & 7);
    f32x4 wv[8];
#pragma unroll
    for (int i = 0; i < 8; ++i) wv[i] = *(const GAS f32x4*)(W + (size_t)(k0 + 8 * i + kr) * N + n0 + nc);
#pragma unroll
    for (int i = 0; i < 8; ++i) { const int kk = 8 * i + kr; f32x4 w = wv[i]; if (gs) w = w * gs[k0 + kk]; LAS float* d = scr + kk * 33 + nc; d[0] = w.x; d[1] = w.y; d[2] = w.z; d[3] = w.w; }
    LDS_WAIT(); asm volatile("" ::: "memory");
    const int c = lane & 7;
#pragma unroll
    for (int j = 0; j < 4; ++j) { const int n = (lane >> 3) + 8 * j; const LAS float* sp = scr + (8 * c) * 33 + n;
        v4u o; o.x = pk2(sp[0 * 33], sp[1 * 33]); o.y = pk2(sp[2 * 33], sp[3 * 33]); o.z = pk2(sp[4 * 33], sp[5 * 33]); o.w = pk2(sp[6 * 33], sp[7 * 33]);
        *(GAS v4u*)(WT + tiled_off(n0 + n, k0 + 8 * c)) = o; }
    LDS_WAIT(); asm volatile("" ::: "memory");
}
__device__ __forceinline__ float wave_sum(float v) {
#pragma unroll
    for (int o = 1; o < 64; o <<= 1) v += __shfl_xor(v, o);
    return v;
}

struct Args { const float* in[9]; float* out; unsigned char* ws; int ph_lo, ph_hi; };
constexpr int N_PHASES = 9;
__global__ void __launch_bounds__(NWAVES * 64, 2) mega_fwd(Args args) {
    extern __shared__ __attribute__((aligned(16))) unsigned char lds_raw[];
    LAS unsigned char* lds = (LAS unsigned char*)lds_raw;
    volatile LAS unsigned* MISC = (volatile LAS unsigned*)(lds + MISC_OFF);
    const int tid = threadIdx.x, lane = tid & 63, wave = __builtin_amdgcn_readfirstlane(tid >> 6);
    const int G = gridDim.x, bx = blockIdx.x, vcu = (G % 8 == 0) ? (bx % 8) * (G / 8) + bx / 8 : bx;
    unsigned char* ws = args.ws;
    const float* x = args.in[0]; const float* norm_g = args.in[1]; const float* fox_w_in = args.in[2]; const float* fox_b_f = args.in[3]; const float* fox_w_out = args.in[4];
    const float* swa_w_in = args.in[5]; const float* swa_sinks = args.in[6]; const float* swa_w_out = args.in[7]; const float* final_g = args.in[8];
    float* out = args.out;
    gu32* ctl = (gu32*)(ws + WS_CTL);
    unsigned* KMAX = (unsigned*)(ws + WS_KMAX); unsigned* TICKET = (unsigned*)(ws + WS_TICKET);
    float* SS1 = (float*)(ws + WS_SS1); float* R0 = (float*)(ws + WS_R0); float* ROPE = (float*)(ws + WS_ROPE); float* LOGF = (float*)(ws + WS_LOGF); float* CUM = (float*)(ws + WS_CUM);
    bf16* W1T = (bf16*)(ws + WS_W1T); bf16* W2T = (bf16*)(ws + WS_W2T); bf16* W3T = (bf16*)(ws + WS_W3T); bf16* W4T = (bf16*)(ws + WS_W4T);
    bf16* KAUG = (bf16*)(ws + WS_KAUG);
    bf16* XB = (bf16*)(ws + WS_XB); bf16* Qb = (bf16*)(ws + WS_Q); bf16* Kb = (bf16*)(ws + WS_K); bf16* Vb = (bf16*)(ws + WS_V); bf16* Gb = (bf16*)(ws + WS_G); bf16* YG = (bf16*)(ws + WS_YG);
    for (int u = tid; u < (LDS_BYTES - LDSCTL_OFF) / 4; u += NWAVES * 64) ((LAS unsigned*)(lds + LDSCTL_OFF))[u] = 0u;
    __syncthreads();
    const int lo = args.ph_lo, hi = args.ph_hi;
    XcdBarrier bar; bar.bar = (unsigned*)(ctl + CW_BAR); bar.x = 0; bar.st = nullptr;
    if (hi - lo > 1) bar = xcd_barrier_post((unsigned*)(ctl + CW_BAR), MISC + 8);
#define IN(k) (lo <= (k) && (k) < hi)
#define REP(k) for (int rep_ = 0; rep_ < (((DUP_MASK >> (k)) & 1) ? 2 : 1); ++rep_)
#define SEAM(k) do { if (IN(k) && IN((k) + 1)) xcd_barrier(bar); } while (0)
    const int gw = vcu * NWAVES + wave, NGW = G * NWAVES;

    if (IN(0)) REP(0) {
        LAS float* scr = (LAS float*)(lds + RING_OFF + wave * 16384);
        constexpr int I1 = (DM / 64) * (FOX_IN / 32), IZ = N1P - FOX_IN;
        constexpr int NITEMS = I1 + IZ;
        for (int it = gw; it < NITEMS; it += NGW) {
            int r = it;
            if (r < I1) { p0_transpose_item(fox_w_in, DM, FOX_IN, W1T, scr, r, lane, norm_g); continue; } r -= I1;
            { GAS v4u* zp = (GAS v4u*)(W1T + tiled_off(FOX_IN + r, (lane >> 1) * 64 + (lane & 1) * 32));
#pragma unroll
              for (int j = 0; j < 4; ++j) zp[j] = (v4u){0u, 0u, 0u, 0u}; }
        }
        for (int m = gw; m < MTOK; m += 2 * NGW) {
            const int m2 = m + NGW < MTOK ? m + NGW : m;
            const GAS f32x4* xr = (const GAS f32x4*)(x + (size_t)m * DM) + lane; const GAS f32x4* xr2 = (const GAS f32x4*)(x + (size_t)m2 * DM) + lane; f32x4 v[8], v2[8]; float s = 0.f, s2 = 0.f;
#pragma unroll
            for (int j = 0; j < 8; ++j) { v[j] = xr[64 * j]; v2[j] = xr2[64 * j]; }
#pragma unroll
            for (int j = 0; j < 8; ++j) { s += (v[j].x * v[j].x + v[j].y * v[j].y) + (v[j].z * v[j].z + v[j].w * v[j].w); s2 += (v2[j].x * v2[j].x + v2[j].y * v2[j].y) + (v2[j].z * v2[j].z + v2[j].w * v2[j].w); }
            s = wave_sum(s); s2 = wave_sum(s2);
            if (lane == 0) { R0[m] = 1.0f / sqrtf(s * (1.f / DM) + RMS_EPS); R0[m2] = 1.0f / sqrtf(s2 * (1.f / DM) + RMS_EPS); }
#pragma unroll
            for (int j = 0; j < 8; ++j) { *(GAS unsigned long long*)(XB + tiled_off(m, 256 * j + 4 * lane)) = (unsigned long long)pk2(v[j].x, v[j].y) | ((unsigned long long)pk2(v[j].z, v[j].w) << 32);
                                          *(GAS unsigned long long*)(XB + tiled_off(m2, 256 * j + 4 * lane)) = (unsigned long long)pk2(v2[j].x, v2[j].y) | ((unsigned long long)pk2(v2[j].z, v2[j].w) << 32); }
        }
        { const int gt = gw * 64 + lane;
          if (gt < SEQ * 8) { const int pos = gt >> 3, i = gt & 7;
              const double invf[8] = {1.0, 0.19390220519133497, 0.037598065178462524, 0.0072903477503833845, 0.0014142135623730951, 0.00027421912901204056, 5.3171693730649086e-05, 1.0310108130908796e-05};
              double inv = invf[0];
#pragma unroll
              for (int k = 1; k < 8; ++k) inv = (i == k) ? invf[k] : inv;
              const double ang = (double)pos * inv; const double kk = __builtin_rint(ang * 0.15915494309189535); const float red = (float)(ang - kk * 6.283185307179586);
              ROPE[(size_t)pos * 16 + i] = cosf(red); ROPE[(size_t)pos * 16 + 8 + i] = sinf(red); } }
    }
    SEAM(0);
    if (IN(1)) {
        pg8::Gemm g{XB, W1T, MTOK, N1P, DM}; pg8::StaticOrder S; S.init(MTOK, N1P, G, bx, (DUP_MASK >> 1) & 1, (DUP_MASK >> 9) & 1);
        pg8::EpiFoxIn E{Qb, Kb, Vb, Gb, LOGF, R0, fox_b_f, KMAX};
        if ((DUP_MASK >> 10) & 1) { pg8::StaticOrder SP; SP.init(MTOK, N1P, G, bx, 0, 0, 1); pg8::gemm_phase<pg8::EpiFoxIn, pg8::StaticOrder, true, true>(lds + RING_OFF, g, SP, E); }
        pg8::gemm_phase<pg8::EpiFoxIn, pg8::StaticOrder, true, true>(lds + RING_OFF, g, S, E);
        { const int nwg = (MTOK / 256) * (N1P / 256), rem = nwg % G, nidle = rem ? G - rem : G, ii = rem ? bx - rem : bx;
          if (ii >= 0) { LAS float* scr = (LAS float*)(lds + RING_OFF + wave * 16384);
              constexpr int I2 = (DM / 64) * (DM / 32), I3 = (DM / 64) * (SWA_IN / 32);
              for (int it = ii * NWAVES + wave; it < I2 + I3 + I2; it += nidle * NWAVES) {
                  int r = it;
                  if (r < I2) { p0_transpose_item(fox_w_out, DM, DM, W2T, scr, r, lane, nullptr); continue; } r -= I2;
                  if (r < I3) { p0_transpose_item(swa_w_in, DM, SWA_IN, W3T, scr, r, lane, norm_g + DM); continue; } r -= I3;
                  p0_transpose_item(swa_w_out, DM, DM, W4T, scr, r, lane, nullptr); } } }
    }
    SEAM(1);
    if (IN(2)) REP(2) {
        for (int sq = vcu; sq < NB * NH; sq += G) {
            const GAS f32x4* lf = (const GAS f32x4*)(LOGF + (size_t)sq * SEQ + wave * 512) + lane * 2; const f32x4 v0 = lf[0], v1 = lf[1];
            const double tot = (((double)v0.x + (double)v0.y) + ((double)v0.z + (double)v0.w)) + (((double)v1.x + (double)v1.y) + ((double)v1.z + (double)v1.w));
            double incl = tot;
#pragma unroll
            for (int o = 1; o < 64; o <<= 1) { const double up = __shfl_up(incl, o); if (lane >= o) incl += up; }
            volatile LAS double* wt = (volatile LAS double*)(lds + RING_OFF);
            __syncthreads();
            if (lane == 63) wt[wave] = incl;
            __syncthreads();
            double run = incl - tot;
            for (int w2 = 0; w2 < wave; ++w2) run += wt[w2];
            const float vv[8] = {v0.x, v0.y, v0.z, v0.w, v1.x, v1.y, v1.z, v1.w}; float cv[8];
#pragma unroll
            for (int e = 0; e < 8; ++e) { run += (double)vv[e]; cv[e] = (float)(run * 1.4426950408889634); }
            GAS f32x4* co = (GAS f32x4*)(CUM + (size_t)sq * SEQ + wave * 512) + lane * 2; co[0] = (f32x4){cv[0], cv[1], cv[2], cv[3]}; co[1] = (f32x4){cv[4], cv[5], cv[6], cv[7]};
            GAS v4u* ka = (GAS v4u*)(KAUG + ((size_t)sq * SEQ + wave * 512 + lane * 8) * 8);
#pragma unroll
            for (int e = 0; e < 8; ++e) { unsigned h1, h2, h3; fa::split3(-cv[e], h1, h2, h3); ka[e] = (v4u){h1 | (h2 << 16), h3 | 0x3F800000u, 0x3F803F80u, 0u}; }
        }
    }
    SEAM(2);
    if (IN(3)) {
        const fa::Params P{Qb, Kb, Vb, Gb, YG, CUM, nullptr, KMAX, TICKET, KAUG};
        volatile LAS unsigned* slot = (volatile LAS unsigned*)(lds + RING_OFF + fa::F_FLAG + 128);
#define FOX_FETCH(dst) do { unsigned code_ = 0xFFFFFFFFu; for (int k_ = 0; k_ < 8; ++k_) { const unsigned q_ = (unsigned)((bx + k_) & 7); const unsigned t_ = atomicAdd(TICKET + q_ * 64, 1u); \
            if (t_ < 256u) { code_ = q_ * 256u + t_; break; } } (dst) = code_; } while (0)
        if (tid == 0) FOX_FETCH(slot[0]);
        __syncthreads();
        unsigned tk = slot[0]; int par = 0;
        while (tk != 0xFFFFFFFFu) {
            if (tid == 0) FOX_FETCH(slot[par ^ 1]);
            const int q = (int)(tk >> 8), tq = (int)(tk & 255u), pi = tq >> 4, hs = 3 - (pi >> 2);
            const int h = hs == 0 ? q : hs == 1 ? 15 - q : hs == 2 ? 16 + q : 31 - q;
            fa::fox_unit(lds + RING_OFF, P, pi & 3, h, 15 - (tq & 15));
            par ^= 1; tk = slot[par];
        }
#undef FOX_FETCH
        __syncthreads();
    }
    SEAM(3);
    if (IN(4)) {
        pg8::Gemm g{YG, W2T, MTOK, DM, DM}; pg8::StaticOrder S; S.init(MTOK, DM, G, bx);
        pg8::EpiRes<true> E{x, XB, SS1};
        pg8::gemm_phase<pg8::EpiRes<true>, pg8::StaticOrder, true, true>(lds + RING_OFF, g, S, E);
    }
    SEAM(4);
    if (IN(5)) {
        pg8::Gemm g{XB, W3T, MTOK, SWA_IN, DM}; pg8::StaticOrder S; S.init(MTOK, SWA_IN, G, bx, (DUP_MASK >> 5) & 1);
        pg8::EpiSwaIn E{Qb, Kb, Vb, Gb, SS1, ROPE};
        pg8::gemm_phase<pg8::EpiSwaIn, pg8::StaticOrder, true, true>(lds + RING_OFF, g, S, E);
    }
    SEAM(5);
    if (IN(6)) REP(6) {
        const fa::Params P{Qb, Kb, Vb, Gb, YG, nullptr, swa_sinks, nullptr, nullptr, nullptr};
        for (int u = (G == 256 ? vcu : bx); u < NB * 4 * 16; u += G) fa::swa_unit(lds + RING_OFF, P, u >> 6, (u >> 4) & 3, u & 15);
    }
    SEAM(6);
    if (IN(7)) {
        pg8::Gemm g{YG, W4T, MTOK, DM, DM}; pg8::StaticOrder S; S.init(MTOK, DM, G, bx);
        pg8::EpiRes<false> E{nullptr, XB, nullptr};
        pg8::gemm_phase<pg8::EpiRes<false>, pg8::StaticOrder, true, true>(lds + RING_OFF, g, S, E);
    }
    SEAM(7);
    if (IN(8)) {
        f32x4 gq[8];
#pragma unroll
        for (int j = 0; j < 8; ++j) gq[j] = ((const GAS f32x4*)final_g)[lane + 64 * j];
        for (int m = gw; m < MTOK; m += NGW) {
            f32x4 v[8]; float s = 0.f;
#pragma unroll
            for (int j = 0; j < 8; ++j) { const unsigned long long xw = *(const GAS unsigned long long*)(XB + tiled_off(m, 256 * j + 4 * lane)); const unsigned lo32 = (unsigned)xw, hi32 = (unsigned)(xw >> 32);
                v[j] = (f32x4){__uint_as_float(lo32 << 16), __uint_as_float(lo32 & 0xffff0000u), __uint_as_float(hi32 << 16), __uint_as_float(hi32 & 0xffff0000u)};
                s += (v[j].x * v[j].x + v[j].y * v[j].y) + (v[j].z * v[j].z + v[j].w * v[j].w); }
            const float r = 1.0f / sqrtf(wave_sum(s) * (1.f / DM) + RMS_EPS);
            GAS f32x4* xr = (GAS f32x4*)(out + (size_t)m * DM) + lane;
#pragma unroll
            for (int j = 0; j < 8; ++j) xr[64 * j] = v[j] * r * gq[j];
        }
    }
#undef IN
#undef SEAM
}

extern "C" void kernel_launch(void* const* d_in, const int* in_sizes, int n_in, void* d_out, int out_size, void* d_ws, size_t ws_size, hipStream_t stream) {
    static int grid = 0;
    if (grid == 0) {
        if (n_in != 9 || in_sizes[0] != MTOK * DM || out_size != MTOK * DM || ws_size < WS_END) { fprintf(stderr, "kernel_launch: unexpected shapes (n_in %d, in0 %d, out %d, ws %zu)\n", n_in, n_in > 0 ? in_sizes[0] : -1, out_size, ws_size); grid = -1; return; }
        int dev = 0, cus = 0, per_cu = 0;
        if (hipGetDevice(&dev) != hipSuccess || hipDeviceGetAttribute(&cus, hipDeviceAttributeMultiprocessorCount, dev) != hipSuccess) { fprintf(stderr, "kernel_launch: device query failed\n"); grid = -1; return; }
        if (hipFuncSetAttribute((const void*)mega_fwd, hipFuncAttributeMaxDynamicSharedMemorySize, LDS_BYTES) != hipSuccess) { fprintf(stderr, "kernel_launch: hipFuncSetAttribute failed\n"); grid = -1; return; }
        if (hipOccupancyMaxActiveBlocksPerMultiprocessor(&per_cu, (const void*)mega_fwd, NWAVES * 64, LDS_BYTES) != hipSuccess || per_cu < 1) { fprintf(stderr, "kernel_launch: occupancy query reports %d workgroups per CU; nothing launched\n", per_cu); (void)hipGetLastError(); grid = -1; return; }
        grid = cus;
    }
    if (grid < 0) return;
    (void)hipMemsetAsync((unsigned char*)d_ws + WS_CTL, 0, CTL_ZERO_BYTES, stream);
    Args a{};
    for (int i = 0; i < 9; ++i) a.in[i] = (const float*)d_in[i];
    a.out = (float*)d_out; a.ws = (unsigned char*)d_ws;
    int p = 0;
    while (p < N_PHASES) {
        if (!((FAST_MASK >> p) & 1)) { ++p; continue; }
        int e = p + 1; if (ONE_LAUNCH) while (e < N_PHASES && ((FAST_MASK >> e) & 1)) ++e;
        a.ph_lo = p; a.ph_hi = e;
        hipLaunchKernelGGL(mega_fwd, dim3(grid), dim3(NWAVES * 64), LDS_BYTES, stream, a);
        p = e;
    }
}
```

```cpp
#include <hip/hip_runtime.h>
#include <cstdio>
#include <cstdint>

constexpr int NB = 4, SEQ = 4096, DM = 2048, MTOK = NB * SEQ, NH = 32, HD = 64;
constexpr int FOX_IN = 8224, SWA_IN = 4608, KVW = 256;
constexpr float RMS_EPS = 1e-6f;
constexpr float LOG2E = 1.4426950408889634f;
constexpr float C2 = 0.125f * LOG2E;

typedef unsigned short bf16_t;
__device__ __forceinline__ float bf2f(bf16_t v) { return __uint_as_float((unsigned)v << 16); }
__device__ __forceinline__ bf16_t f2bf(float f) { unsigned u = __float_as_uint(f); return (bf16_t)((u + 0x7fffu + ((u >> 16) & 1u)) >> 16); }
__device__ __forceinline__ float logsigmoidf(float z) { return z < 0.f ? z - log1pf(expf(z)) : -log1pf(expf(-z)); }
__device__ __forceinline__ float siluf(float g) { return g / (1.f + expf(-g)); }

__host__ __device__ __forceinline__ size_t tiled_off(int row, int k) { return ((size_t)(((row >> 8) * (DM / 64) + (k >> 6)) * 2 + ((k >> 5) & 1)) << 13) + (size_t)(((row & 255) << 5) + (k & 31)); }

__host__ __device__ __forceinline__ size_t hm_off(int row  , int col  , int nheads) { return ((size_t)(((row >> 12) * nheads + (col >> 6)) * 2 + ((col >> 5) & 1)) * SEQ + (row & 4095)) * 32 + (col & 31); }

constexpr size_t MiB = 1u << 20;
constexpr size_t WS_CTL = 0, CTL_ZERO_BYTES = 1 * MiB;
constexpr size_t WS_KMAX = 64 * 1024, WS_TICKET = 66 * 1024;
constexpr size_t WS_SS1 = 512 * 1024;
constexpr size_t WS_R0 = 1 * MiB;
constexpr size_t WS_ROPE = 1 * MiB + 512 * 1024;
constexpr size_t WS_LOGF = 2 * MiB;
constexpr size_t WS_CUM = 4 * MiB;
constexpr size_t WS_W1T = 8 * MiB, WS_W2T = 41 * MiB, WS_W3T = 49 * MiB, WS_W4T = 67 * MiB;
constexpr size_t WS_XB = 76 * MiB, WS_Q = 140 * MiB, WS_K = 204 * MiB, WS_V = 268 * MiB, WS_G = 332 * MiB, WS_YG = 396 * MiB, WS_KAUG = 460 * MiB, WS_END = 468 * MiB;

#ifndef FAST_MASK
#define FAST_MASK 0x1FF
#endif
#ifndef DUP_MASK
#define DUP_MASK 0x000
#endif
#ifndef ONE_LAUNCH
#define ONE_LAUNCH 1
#endif
namespace pg8 {
#define PG8_LAS __attribute__((address_space(3)))
typedef unsigned short bf16_t;
typedef short bf16x8 __attribute__((ext_vector_type(8)));
typedef float f32x4 __attribute__((ext_vector_type(4)));
typedef unsigned u32x4 __attribute__((ext_vector_type(4)));
constexpr int BM = 256, BK = 64, HALF = 128, HTB = HALF * BK * 2  , STAGE_BYTES = 8 * HTB, NXCD = 8, WGM = 8;

__host__ __device__ __forceinline__ int lds_byte(int r, int c) { const int st = (r >> 4) * 2 + (c >> 5), rr = r & 15, cc = c & 31, ob = rr * 64 + cc * 2; return st * 1024 + (ob ^ (((ob >> 9) & 1) << 5)); }
__host__ __device__ __forceinline__ void stage_rc(int b, int& R, int& C) { const int st = b / 1024, sb = b % 1024, swz = sb ^ (((sb >> 9) & 1) << 5); R = (st >> 1) * 16 + swz / 64; C = (st & 1) * 32 + (swz % 64) / 2; }
__host__ __device__ __forceinline__ int perm32(int rho) { const int n = rho >> 4, i = rho & 15; return 8 * (i >> 2) + 4 * n + (i & 3); }

struct Unit { int pm, pn, lm, ln; };
struct Gemm { const bf16_t* A; const bf16_t* Bt; int M, N, K; };

struct StaticOrder {
    int nM, nN, nwg, G, c, dup, epi2, same;
    __host__ __device__ void init(int M, int N, int G_, int c_, int dup_ = 0, int epi2_ = 0, int same_ = 0) { nM = M / BM; nN = N / BM; nwg = nM * nN; G = G_; c = c_; dup = dup_; epi2 = epi2_; same = same_; }
    __host__ __device__ bool next(int i, Unit& u) const {
        if (dup) i >>= 1;
        const long L = (long)i * G + c; if (L >= nwg) return false;
        int wgid = (int)L; { const int q = nwg / NXCD, r = nwg % NXCD, xcd = wgid % NXCD, off = wgid / NXCD; wgid = (xcd < r ? xcd * (q + 1) : r * (q + 1) + (xcd - r) * q) + off; }
        const int nig = WGM * nN, gid = wgid / nig, fm = gid * WGM, gsz = (nM - fm) < WGM ? (nM - fm) : WGM;
        u.pm = fm + ((wgid % nig) % gsz); u.pn = (wgid % nig) / gsz; u.lm = same ? 0 : u.pm; u.ln = same ? 0 : u.pn; return true;
    }
    __device__ __forceinline__ void a_ready(const Unit&) const {}
    __device__ __forceinline__ void done(const Unit&) const {}
};

__device__ __forceinline__ unsigned cvt_pk_bf16(float lo, float hi) { unsigned r; asm volatile("v_cvt_pk_bf16_f32 %0, %1, %2" : "=v"(r) : "v"(lo), "v"(hi)); return r; }
__device__ __forceinline__ float silu_fast(float g) { return g * __builtin_amdgcn_rcpf(1.0f + __builtin_amdgcn_exp2f(-g * 1.4426950408889634f)); }
__device__ __forceinline__ u32x4 pack8(const f32x4 v0, const f32x4 v1) { u32x4 w; w.x = cvt_pk_bf16(v0[0], v0[1]); w.y = cvt_pk_bf16(v0[2], v0[3]); w.z = cvt_pk_bf16(v1[0], v1[1]); w.w = cvt_pk_bf16(v1[2], v1[3]); return w; }
struct EpiFoxIn {
    static constexpr bool PERM = true, AFTER_DRAIN = false;
    bf16_t *Q, *K, *V, *G; float* LOGF; const float* R0; const float* bfb; unsigned* KMAX;
    __device__ __forceinline__ void operator()(const f32x4 (&acc)[2][2][4][2], const Unit& u, int wr, int wc, int fr, int fq) const {
        const int row0 = u.pm * BM + wr * 64 + fr, pn = u.pn;
        float rs[2][4];
#pragma unroll
        for (int ai = 0; ai < 2; ++ai)
#pragma unroll
            for (int m = 0; m < 4; ++m) rs[ai][m] = R0[row0 + ai * HALF + m * 16];
        if (pn < 32) {
            const int reg = pn >> 3; bf16_t* base = reg == 0 ? Q : reg == 1 ? K : reg == 2 ? V : G; float kmx[2] = {0.f, 0.f};
            const int col0 = (pn & 7) * BM + wc * 32 + 8 * fq;
#pragma unroll
            for (int ai = 0; ai < 2; ++ai)
#pragma unroll
                for (int m = 0; m < 4; ++m) { const int row = row0 + ai * HALF + m * 16; const float r = rs[ai][m]; const float sc = reg == 0 ? r * C2 : r;
#pragma unroll
                    for (int bj = 0; bj < 2; ++bj) { f32x4 v0 = acc[ai][bj][m][0] * sc, v1 = acc[ai][bj][m][1] * sc;
                        if (reg == 3) {
#pragma unroll
                            for (int j = 0; j < 4; ++j) { v0[j] = silu_fast(v0[j]); v1[j] = silu_fast(v1[j]); } }
                        if (reg == 1) { float ss = ((v0[0] * v0[0] + v0[1] * v0[1]) + (v0[2] * v0[2] + v0[3] * v0[3])) + ((v1[0] * v1[0] + v1[1] * v1[1]) + (v1[2] * v1[2] + v1[3] * v1[3]));
                            ss += __shfl_xor(ss, 16); ss += __shfl_xor(ss, 32); kmx[bj] = fmaxf(kmx[bj], ss); }
                        __builtin_nontemporal_store(pack8(v0, v1), (u32x4*)(base + hm_off(row, col0 + bj * HALF, NH))); } }
            if (reg == 1) {
#pragma unroll
                for (int bj = 0; bj < 2; ++bj) { float mx = kmx[bj];
#pragma unroll
                    for (int o = 1; o < 16; o <<= 1) mx = fmaxf(mx, __shfl_xor(mx, o));
                    if (fr == 0 && fq == 0) atomicMax(KMAX + ((row0 >> 12) * NH + (pn & 7) * 4 + bj * 2 + (wc >> 1)) * 2 + (wc & 1), __float_as_uint(mx)); } }
        } else if (wc == 0) {
#pragma unroll
            for (int ai = 0; ai < 2; ++ai)
#pragma unroll
                for (int m = 0; m < 4; ++m) { const int row = row0 + ai * HALF + m * 16; const float r = rs[ai][m]; const int b = row >> 12, s = row & 4095;
#pragma unroll
                    for (int n = 0; n < 2; ++n)
#pragma unroll
                        for (int j = 0; j < 4; ++j) { const int h = 8 * fq + 4 * n + j; LOGF[((size_t)(b * NH + h) << 12) + s] = logsigmoidf(acc[ai][0][m][n][j] * r + bfb[h]); } }
        }
    }
};
struct EpiSwaIn {
    static constexpr bool PERM = true, AFTER_DRAIN = false;
    bf16_t *Q, *K, *V, *G; const float* SS; const float* ROPE;
    __device__ __forceinline__ void operator()(const f32x4 (&acc)[2][2][4][2], const Unit& u, int wr, int wc, int fr, int fq) const {
        const int row0 = u.pm * BM + wr * 64 + fr, pn = u.pn;
        bf16_t* base; int pitch, colt; float osc = 1.f; const bool rope = pn <= 8, gate = pn >= 10;
        if (pn < 8) { base = Q; pitch = DM; colt = pn * BM; osc = C2; } else if (pn == 8) { base = K; pitch = KVW; colt = 0; } else if (pn == 9) { base = V; pitch = KVW; colt = 0; } else { base = G; pitch = DM; colt = (pn - 10) * BM; }
        const int col0 = colt + wc * 32 + 8 * fq; const bool rotw = rope && ((wc & 1) == 0); const float sgn = fq == 0 ? -1.f : 1.f; const bool rotl = fq < 2;
        float rs[2][4];
#pragma unroll
        for (int ai = 0; ai < 2; ++ai)
#pragma unroll
            for (int m = 0; m < 4; ++m) rs[ai][m] = SS[row0 + ai * HALF + m * 16];
        f32x4 nc0, nc1, ns0, ns1;
        if (rotw) { const float* rp = ROPE + (size_t)(row0 & 4095) * 16; nc0 = *(const f32x4*)rp; nc1 = *(const f32x4*)(rp + 4); ns0 = *(const f32x4*)(rp + 8); ns1 = *(const f32x4*)(rp + 12); }
#pragma unroll
        for (int ai = 0; ai < 2; ++ai)
#pragma unroll
            for (int m = 0; m < 4; ++m) { const int row = row0 + ai * HALF + m * 16; const float r = 1.0f / sqrtf(rs[ai][m] * (1.f / DM) + RMS_EPS);
                const f32x4 c0 = nc0, c1 = nc1, s0 = ns0, s1 = ns1;
                if (rotw && (ai * 4 + m) < 7) { const int nrow = row0 + ((ai * 4 + m + 1) >> 2) * HALF + ((ai * 4 + m + 1) & 3) * 16; const float* rp = ROPE + (size_t)(nrow & 4095) * 16; nc0 = *(const f32x4*)rp; nc1 = *(const f32x4*)(rp + 4); ns0 = *(const f32x4*)(rp + 8); ns1 = *(const f32x4*)(rp + 12); }
#pragma unroll
                for (int bj = 0; bj < 2; ++bj) { f32x4 v0 = acc[ai][bj][m][0] * r, v1 = acc[ai][bj][m][1] * r;
                    if (rotw) {
#pragma unroll
                        for (int j = 0; j < 4; ++j) { const float p0 = __shfl_xor(v0[j], 16), p1 = __shfl_xor(v1[j], 16);
                            const float n0 = v0[j] * c0[j] + sgn * p0 * s0[j], n1 = v1[j] * c1[j] + sgn * p1 * s1[j];
                            v0[j] = rotl ? n0 : v0[j]; v1[j] = rotl ? n1 : v1[j]; } }
                    if (gate) {
#pragma unroll
                        for (int j = 0; j < 4; ++j) { v0[j] = silu_fast(v0[j]); v1[j] = silu_fast(v1[j]); } }
                    v0 = v0 * osc; v1 = v1 * osc;
                    *(u32x4*)(base + hm_off(row, col0 + bj * HALF, pitch >> 6)) = pack8(v0, v1); } }
    }
};
template <bool FIRST> struct EpiRes {
    static constexpr bool PERM = true, AFTER_DRAIN = false;
    const float* xin; bf16_t* XB; float* SS;
    __device__ __forceinline__ void operator()(const f32x4 (&acc)[2][2][4][2], const Unit& u, int wr, int wc, int fr, int fq) const {
        const int row0 = u.pm * BM + wr * 64 + fr, col0 = u.pn * BM + wc * 32 + 8 * fq;
        if (FIRST) {
            f32x4 nx[2][2];
#pragma unroll
            for (int bj = 0; bj < 2; ++bj)
#pragma unroll
                for (int n = 0; n < 2; ++n) nx[bj][n] = *(const f32x4*)(xin + (size_t)row0 * DM + col0 + bj * HALF + n * 4);
#pragma unroll
            for (int ai = 0; ai < 2; ++ai)
#pragma unroll
                for (int m = 0; m < 4; ++m) { const int row = row0 + ai * HALF + m * 16; float ss = 0.f;
                    f32x4 cx[2][2];
#pragma unroll
                    for (int bj = 0; bj < 2; ++bj)
#pragma unroll
                        for (int n = 0; n < 2; ++n) cx[bj][n] = nx[bj][n];
                    if ((ai * 4 + m) < 7) { const int nrow = row0 + ((ai * 4 + m + 1) >> 2) * HALF + ((ai * 4 + m + 1) & 3) * 16;
#pragma unroll
                        for (int bj = 0; bj < 2; ++bj)
#pragma unroll
                            for (int n = 0; n < 2; ++n) nx[bj][n] = *(const f32x4*)(xin + (size_t)nrow * DM + col0 + bj * HALF + n * 4); }
#pragma unroll
                    for (int bj = 0; bj < 2; ++bj) { const f32x4 x0 = cx[bj][0] + acc[ai][bj][m][0], x1 = cx[bj][1] + acc[ai][bj][m][1];
                        *(u32x4*)(XB + tiled_off(row, col0 + bj * HALF)) = pack8(x0, x1);
                        ss += ((x0[0] * x0[0] + x0[1] * x0[1]) + (x0[2] * x0[2] + x0[3] * x0[3])) + ((x1[0] * x1[0] + x1[1] * x1[1]) + (x1[2] * x1[2] + x1[3] * x1[3])); }
                    ss += __shfl_xor(ss, 16); ss += __shfl_xor(ss, 32); if (fq == 0) atomicAdd(SS + row, ss); }
        } else {
            u32x4 xv[2][4][2];
#pragma unroll
            for (int ai = 0; ai < 2; ++ai)
#pragma unroll
                for (int m = 0; m < 4; ++m)
#pragma unroll
                    for (int bj = 0; bj < 2; ++bj) xv[ai][m][bj] = *(const u32x4*)(XB + tiled_off(row0 + ai * HALF + m * 16, col0 + bj * HALF));
#pragma unroll
            for (int ai = 0; ai < 2; ++ai)
#pragma unroll
                for (int m = 0; m < 4; ++m)
#pragma unroll
                    for (int bj = 0; bj < 2; ++bj) { const u32x4 xw = xv[ai][m][bj]; const f32x4 a0 = acc[ai][bj][m][0], a1 = acc[ai][bj][m][1];
                        const f32x4 y0 = {__uint_as_float(xw.x << 16) + a0[0], __uint_as_float(xw.x & 0xffff0000u) + a0[1], __uint_as_float(xw.y << 16) + a0[2], __uint_as_float(xw.y & 0xffff0000u) + a0[3]};
                        const f32x4 y1 = {__uint_as_float(xw.z << 16) + a1[0], __uint_as_float(xw.z & 0xffff0000u) + a1[1], __uint_as_float(xw.w << 16) + a1[2], __uint_as_float(xw.w & 0xffff0000u) + a1[3]};
                        *(u32x4*)(XB + tiled_off(row0 + ai * HALF + m * 16, col0 + bj * HALF)) = pack8(y0, y1); }
        }
    }
};
template <class Epi, class Sched, bool ALIGN_EPI = false, bool SP2 = false>
__device__ __forceinline__ void gemm_phase(PG8_LAS unsigned char* lds, const Gemm g, const Sched& S, const Epi& E) {
    const int tid = threadIdx.x, wid = __builtin_amdgcn_readfirstlane(tid >> 6), lane = tid & 63, wr = wid >> 2, wc = wid & 3, fr = lane & 15, fq = lane >> 4;
    const int K = g.K, nt = K / BK;
    unsigned voffA[2], voffB[2];
#pragma unroll
    for (int i = 0; i < 2; ++i) { int R, C; stage_rc(tid * 16 + i * 8192, R, C); const int Rb = Epi::PERM ? ((R & ~31) + perm32(R & 31)) : R;
        voffA[i] = (unsigned)((C >> 5) * (BM * 32) + R * 32 + (C & 31)) * 2u; voffB[i] = (unsigned)((C >> 5) * (BM * 32) + Rb * 32 + (C & 31)) * 2u; }
    const size_t kstep = (size_t)(BM * BK * 2);
    const size_t hstep = (size_t)(HALF * 32 * 2);
    const size_t tstep = (size_t)BM * K * 2;
    const unsigned ldsw = (unsigned)wid * 1024u;
    const int aoff = lds_byte(wr * 64 + fr, fq * 8), boff = lds_byte(wc * 32 + fr, fq * 8);
#define PG8_SA(b, h) (((b) * 2 + (h)) * HTB)
#define PG8_SB(b, h) ((4 + (b) * 2 + (h)) * HTB)
#define PG8_STAGE(bufoff, gbase, voff) do { _Pragma("unroll") for (int _i = 0; _i < 2; ++_i) \
        __builtin_amdgcn_global_load_lds((const unsigned*)((const char*)(gbase) + (voff)[_i]), (PG8_LAS unsigned*)(lds + (bufoff) + ldsw + _i * 8192), 16, 0, 0); } while (0)
#define PG8_LDA(dst, b, h) do { _Pragma("unroll") for (int m = 0; m < 4; ++m) _Pragma("unroll") for (int k = 0; k < 2; ++k) dst[m][k] = *(const PG8_LAS bf16x8*)(lds + PG8_SA(b, h) + aoff + m * 2048 + k * 1024); } while (0)
#define PG8_LDB(dst, b, h) do { _Pragma("unroll") for (int n = 0; n < 2; ++n) _Pragma("unroll") for (int k = 0; k < 2; ++k) dst[n][k] = *(const PG8_LAS bf16x8*)(lds + PG8_SB(b, h) + boff + n * 2048 + k * 1024); } while (0)
#define PG8_MMA(ai, bj, At, Bt) do { __builtin_amdgcn_s_setprio(1); _Pragma("unroll") for (int m = 0; m < 4; ++m) _Pragma("unroll") for (int n = 0; n < 2; ++n) _Pragma("unroll") for (int k = 0; k < 2; ++k) \
        acc[ai][bj][m][n] = __builtin_amdgcn_mfma_f32_16x16x32_bf16(Bt[n][k], At[m][k], acc[ai][bj][m][n], 0, 0, 0); __builtin_amdgcn_s_setprio(0); } while (0)
#define PG8_WAIT_V(n) asm volatile("s_waitcnt vmcnt(" #n ")" ::: "memory")
#define PG8_WAIT_L(n) asm volatile("s_waitcnt lgkmcnt(" #n ")" ::: "memory")
#define PG8_BAR __builtin_amdgcn_s_barrier()
#define PG8_SCHED __builtin_amdgcn_sched_barrier(0)
    Unit cur, nxt; int ui = 0;
    if (!S.next(0, cur)) return;
    f32x4 acc[2][2][4][2];
#pragma unroll
    for (int a = 0; a < 2; ++a)
#pragma unroll
        for (int b = 0; b < 2; ++b)
#pragma unroll
            for (int m = 0; m < 4; ++m)
#pragma unroll
                for (int n = 0; n < 2; ++n) acc[a][b][m][n] = (f32x4){0.f, 0.f, 0.f, 0.f};
    bf16x8 At[4][2], B0[2][2], B1[2][2];
    const char* cA = (const char*)g.A + (size_t)cur.lm * tstep; const char* cB = (const char*)g.Bt + (size_t)cur.ln * tstep;
    S.a_ready(cur);
    if constexpr (SP2) {
        PG8_STAGE(PG8_SB(0, 0), cB, voffB); PG8_STAGE(PG8_SB(0, 1), cB + hstep, voffB); PG8_STAGE(PG8_SA(0, 0), cA, voffA); PG8_STAGE(PG8_SA(0, 1), cA + hstep, voffA);
        if (wr == 1) PG8_BAR;
        PG8_WAIT_V(2); PG8_BAR;
        PG8_STAGE(PG8_SB(1, 0), cB + kstep, voffB); PG8_STAGE(PG8_SA(1, 0), cA + kstep, voffA); PG8_STAGE(PG8_SB(1, 1), cB + hstep + kstep, voffB);
        PG8_WAIT_V(6); PG8_BAR;
    } else {
        PG8_STAGE(PG8_SB(0, 0), cB, voffB); PG8_STAGE(PG8_SA(0, 0), cA, voffA); PG8_STAGE(PG8_SB(0, 1), cB + hstep, voffB); PG8_STAGE(PG8_SA(0, 1), cA + hstep, voffA);
        if (wr == 1) PG8_BAR;
        PG8_WAIT_V(4); PG8_BAR;
        PG8_STAGE(PG8_SB(1, 0), cB + kstep, voffB); PG8_STAGE(PG8_SA(1, 0), cA + kstep, voffA); PG8_STAGE(PG8_SB(1, 1), cB + hstep + kstep, voffB);
        PG8_WAIT_V(6); PG8_BAR;
    }
    for (;;) {
        const bool has_next = S.next(ui + 1, nxt);
        const char* nA = has_next ? (const char*)g.A + (size_t)nxt.lm * tstep : cA; const char* nB = has_next ? (const char*)g.Bt + (size_t)nxt.ln * tstep : cB;
        for (int t = 0; t < nt; t += 2) {
            const bool last = (t == nt - 2);
            const char* a1 = cA + (size_t)(t + 1) * kstep;
            const char* a2 = last ? nA : cA + (size_t)(t + 2) * kstep; const char* b2 = last ? nB : cB + (size_t)(t + 2) * kstep;
            const char* a3 = a2 + kstep; const char* b3 = b2 + kstep;
            if (last && has_next) S.a_ready(nxt);
            if constexpr (SP2) {
            PG8_LDB(B0, 0, 0); PG8_LDB(B1, 0, 1); PG8_SCHED; PG8_LDA(At, 0, 0); PG8_STAGE(PG8_SA(1, 1), a1 + hstep, voffA);
            PG8_WAIT_V(8); PG8_WAIT_L(0); PG8_BAR; PG8_MMA(0, 0, At, B0); PG8_MMA(0, 1, At, B1); PG8_BAR; PG8_SCHED;
            PG8_LDA(At, 0, 1); PG8_STAGE(PG8_SB(0, 0), b2, voffB); PG8_STAGE(PG8_SB(0, 1), b2 + hstep, voffB); PG8_STAGE(PG8_SA(0, 0), a2, voffA);
            PG8_WAIT_V(8); PG8_WAIT_L(0); PG8_BAR; PG8_MMA(1, 0, At, B0); PG8_MMA(1, 1, At, B1); PG8_BAR; PG8_SCHED;
            PG8_LDB(B0, 1, 0); PG8_LDB(B1, 1, 1); PG8_SCHED; PG8_LDA(At, 1, 0); PG8_STAGE(PG8_SA(0, 1), a2 + hstep, voffA);
            PG8_WAIT_V(8); PG8_WAIT_L(0); PG8_BAR; PG8_MMA(0, 0, At, B0); PG8_MMA(0, 1, At, B1); PG8_BAR; PG8_SCHED;
            PG8_LDA(At, 1, 1); PG8_STAGE(PG8_SB(1, 0), b3, voffB); PG8_STAGE(PG8_SB(1, 1), b3 + hstep, voffB); PG8_STAGE(PG8_SA(1, 0), a3, voffA);
            PG8_WAIT_V(8); PG8_WAIT_L(0); PG8_BAR; PG8_MMA(1, 0, At, B0); PG8_MMA(1, 1, At, B1); PG8_BAR; PG8_SCHED;
            } else {
            PG8_LDB(B0, 0, 0); PG8_SCHED; PG8_LDA(At, 0, 0); PG8_STAGE(PG8_SA(1, 1), a1 + hstep, voffA);
            PG8_WAIT_L(8); PG8_BAR; PG8_WAIT_L(0); PG8_MMA(0, 0, At, B0); PG8_BAR; PG8_SCHED;
            PG8_LDB(B1, 0, 1); PG8_STAGE(PG8_SB(0, 0), b2, voffB);
            PG8_BAR; PG8_WAIT_L(0); PG8_MMA(0, 1, At, B1); PG8_BAR;
            PG8_LDA(At, 0, 1); PG8_STAGE(PG8_SA(0, 0), a2, voffA);
            PG8_BAR; PG8_WAIT_L(0); PG8_MMA(1, 0, At, B0); PG8_BAR; PG8_SCHED;
            PG8_STAGE(PG8_SB(0, 1), b2 + hstep, voffB);
            PG8_WAIT_V(6); PG8_BAR; PG8_MMA(1, 1, At, B1); PG8_BAR;
            PG8_LDB(B0, 1, 0); PG8_SCHED; PG8_LDA(At, 1, 0); PG8_STAGE(PG8_SA(0, 1), a2 + hstep, voffA);
            PG8_WAIT_L(8); PG8_BAR; PG8_WAIT_L(0); PG8_MMA(0, 0, At, B0); PG8_BAR; PG8_SCHED;
            PG8_LDB(B1, 1, 1); PG8_STAGE(PG8_SB(1, 0), b3, voffB);
            PG8_BAR; PG8_WAIT_L(0); PG8_MMA(0, 1, At, B1); PG8_BAR;
            PG8_LDA(At, 1, 1); PG8_STAGE(PG8_SA(1, 0), a3, voffA);
            PG8_BAR; PG8_WAIT_L(0); PG8_MMA(1, 0, At, B0); PG8_BAR; PG8_SCHED;
            PG8_STAGE(PG8_SB(1, 1), b3 + hstep, voffB);
            PG8_WAIT_V(6); PG8_BAR; PG8_MMA(1, 1, At, B1); PG8_BAR;
            }
        }
        if constexpr (ALIGN_EPI) { if (wr == 0) PG8_BAR; }
        if constexpr (!Epi::AFTER_DRAIN) { E(acc, cur, wr, wc, fr, fq); if (S.epi2) E(acc, cur, wr, wc, fr, fq); S.done(cur); }
        if (!has_next) break;
#pragma unroll
        for (int a = 0; a < 2; ++a)
#pragma unroll
            for (int b = 0; b < 2; ++b)
#pragma unroll
                for (int m = 0; m < 4; ++m)
#pragma unroll
                    for (int n = 0; n < 2; ++n) acc[a][b][m][n] = (f32x4){0.f, 0.f, 0.f, 0.f};
        cur = nxt; cA = nA; cB = nB; ++ui;
        if constexpr (ALIGN_EPI) { if (wr == 1) PG8_BAR; }
    }
    PG8_WAIT_V(0);
    if constexpr (!ALIGN_EPI) { if (wr == 0) PG8_BAR; }
    PG8_BAR;
    if constexpr (Epi::AFTER_DRAIN) { E.fused(acc, cur, wr, wc, fr, fq, lds, wid, lane); S.done(cur); }
#undef PG8_SA
#undef PG8_SB
#undef PG8_STAGE
#undef PG8_LDA
#undef PG8_LDB
#undef PG8_MMA
#undef PG8_WAIT_V
#undef PG8_WAIT_L
#undef PG8_BAR
#undef PG8_SCHED
}
}
namespace fa {
#define FA_LAS __attribute__((address_space(3)))
typedef short bf16x8 __attribute__((ext_vector_type(8)));
typedef short s16x4 __attribute__((ext_vector_type(4)));
typedef short v4i16_t __attribute__((ext_vector_type(4)));
typedef float f32x16 __attribute__((ext_vector_type(16)));
typedef float f32x4 __attribute__((ext_vector_type(4)));
typedef unsigned u32x4 __attribute__((ext_vector_type(4)));
typedef float f32x2_t __attribute__((ext_vector_type(2))); typedef __bf16 bf16x2_t __attribute__((ext_vector_type(2)));
constexpr float THR = 8.f, TH_SKIP = 32.f;
constexpr int F_KBUF = 18432, F_AOFF = 8192, F_VOFF = 10240, F_WSF = 3 * F_KBUF, F_FLAG = F_WSF + 8 * 256, F_OST = F_FLAG + 256, F_LDS_BYTES = F_OST + 8 * 4096;
constexpr int S_KBUF = 16384, S_VOFF = 8192, S_WSF = 6 * S_KBUF, S_OST = S_WSF + 8 * 256, S_LDS_BYTES = S_OST + 8 * 4096;
struct Params { const bf16_t* Q; const bf16_t* K; const bf16_t* V; const bf16_t* G; bf16_t* O; const float* CUM; const float* sinks; const unsigned* KMAX; unsigned* ticket; const bf16_t* KAUG; };
__device__ __forceinline__ unsigned cvtpk(float lo, float hi) { f32x2_t v = {lo, hi}; bf16x2_t b = __builtin_convertvector(v, bf16x2_t); return __builtin_bit_cast(unsigned, b); }
__device__ __forceinline__ s16x4 vtr(FA_LAS unsigned char* p) { return __builtin_bit_cast(s16x4, __builtin_amdgcn_ds_read_tr16_b64_v4i16((FA_LAS v4i16_t*)p)); }
__device__ __forceinline__ float swap_max(float v) { auto rr = __builtin_amdgcn_permlane32_swap(__float_as_uint(v), __float_as_uint(v), false, false); return __builtin_fmaxf(__uint_as_float(rr[0]), __uint_as_float(rr[1])); }
__device__ __forceinline__ float swap_add(float v) { auto rr = __builtin_amdgcn_permlane32_swap(__float_as_uint(v), __float_as_uint(v), false, false); return __uint_as_float(rr[0]) + __uint_as_float(rr[1]); }
__device__ __forceinline__ void glds16(const void* gsrc, unsigned lds_dst) { unsigned keep;
    asm volatile("s_mov_b32 %0, m0\n\ts_mov_b32 m0, %2\n\ts_nop 0\n\tglobal_load_lds_dwordx4 %1, off\n\ts_mov_b32 m0, %0" : "=&s"(keep) : "v"(gsrc), "s"(lds_dst) : "memory"); }
#define FA_MFMA(a, b, c) __builtin_amdgcn_mfma_f32_32x32x16_bf16((a), (b), (c), 0, 0, 0)
#define FA_MX3(a, b, c) __builtin_fmaxf(__builtin_fmaxf((a), (b)), (c))
struct WaveSt { bf16x8 qr[4]; bf16x8 qa; f32x16 cinit, o0, o1; float cq, mhat, lsum, mrun; };

#define FA_SBAR() __builtin_amdgcn_sched_barrier(0)
#define FA_PIN(x) asm volatile("" : "+v"(x))
#define FA_LDK(p) (*(FA_LAS bf16x8*)(p))
#define FA_VF(l, h) ((bf16x8){l[0], l[1], l[2], l[3], h[0], h[1], h[2], h[3]})
#define FA_EX4(X, B) do { X[B] = __builtin_amdgcn_exp2f(X[B]); X[B + 1] = __builtin_amdgcn_exp2f(X[B + 1]); X[B + 2] = __builtin_amdgcn_exp2f(X[B + 2]); X[B + 3] = __builtin_amdgcn_exp2f(X[B + 3]); } while (0)
__device__ __forceinline__ void split3(float v, unsigned& h1, unsigned& h2, unsigned& h3) { const bf16_t a = f2bf(v); const float r1 = v - bf2f(a); const bf16_t b = f2bf(r1); const float r2 = r1 - bf2f(b); h1 = a; h2 = b; h3 = f2bf(r2); }
__device__ __forceinline__ void set_qa(WaveSt& w, int hi) {
    unsigned g1, g2, g3; split3(w.cq - w.mhat, g1, g2, g3);
    const u32x4 q = {hi == 0 ? 0x3F803F80u : 0u, hi == 0 ? (0x3F80u | (g1 << 16)) : 0u, hi == 0 ? (g2 | (g3 << 16)) : 0u, 0u};
    w.qa = __builtin_bit_cast(bf16x8, q);
}
template <int MODE, int AOFF, int VOFF, int HB>
__device__ __forceinline__ void half_step(FA_LAS unsigned char* bb, FA_LAS unsigned char* vprev, FA_LAS float* wsf, WaveSt& w, f32x16& C, f32x16& P, int k0, int t, int qlo, int lane, int r32, int hi) {
    constexpr int W = MODE == 0 ? 0x40000000 : 128;
    FA_LAS unsigned char* kp = bb + hi * 1024 + r32 * 16 + HB * 512; FA_LAS unsigned char* ap = bb + AOFF + r32 * 16 + HB * 512;
    FA_LAS unsigned char* vp = (HB == 0 ? vprev + 2048 : bb) + VOFF + ((lane >> 4) & 1) * 32 + (lane & 3) * 8 + (4 * hi + ((lane & 15) >> 2)) * 64;
    bf16x8 kf0 = FA_LDK(kp), kf1 = FA_LDK(kp + 2048), kf2, kf3, ka;
    s16x4 vl0, vh0, vl1, vh1, vl2, vh2, vl3, vh3; u32x4 pw0, pw1; float sacc;
    FA_SBAR();
    if (MODE == 0) C = FA_MFMA(kf0, w.qr[0], ((f32x16){0.f, 0.f, 0.f, 0.f, 0.f, 0.f, 0.f, 0.f, 0.f, 0.f, 0.f, 0.f, 0.f, 0.f, 0.f, 0.f})); else C = FA_MFMA(kf0, w.qr[0], w.cinit);
    kf2 = FA_LDK(kp + 4096);
    sacc = (P[0] + P[1]) + (P[2] + P[3]); pw0.x = cvtpk(P[0], P[1]); pw0.y = cvtpk(P[2], P[3]); FA_PIN(sacc); FA_PIN(pw0.x); FA_PIN(pw0.y);
    FA_SBAR();
    C = FA_MFMA(kf1, w.qr[1], C); kf3 = FA_LDK(kp + 6144);
    sacc += P[4]; sacc += P[5]; sacc += P[6]; sacc += P[7]; pw0.z = cvtpk(P[4], P[5]); pw0.w = cvtpk(P[6], P[7]); FA_PIN(sacc); FA_PIN(pw0.z); FA_PIN(pw0.w);
    FA_SBAR();
    C = FA_MFMA(kf2, w.qr[2], C); if (MODE == 0) ka = FA_LDK(ap);
    sacc += P[8]; sacc += P[9]; sacc += P[10]; sacc += P[11]; pw1.x = cvtpk(P[8], P[9]); pw1.y = cvtpk(P[10], P[11]); FA_PIN(sacc); FA_PIN(pw1.x); FA_PIN(pw1.y); vl0 = vtr(vp); vh0 = vtr(vp + 512);
    FA_SBAR();
    C = FA_MFMA(kf3, w.qr[3], C);
    sacc += P[12]; sacc += P[13]; sacc += P[14]; sacc += P[15]; pw1.z = cvtpk(P[12], P[13]); pw1.w = cvtpk(P[14], P[15]); FA_PIN(sacc); FA_PIN(pw1.z); FA_PIN(pw1.w); vl1 = vtr(vp + 4096); vh1 = vtr(vp + 4096 + 512);
    FA_SBAR();
    if (MODE == 0) { C = FA_MFMA(ka, w.qa, C); FA_SBAR(); }
    w.lsum += sacc;
    const bf16x8 pa0 = __builtin_bit_cast(bf16x8, pw0), pa1 = __builtin_bit_cast(bf16x8, pw1);
    vl2 = vtr(vp + 1024); vh2 = vtr(vp + 1024 + 512);
    w.o0 = FA_MFMA(pa0, FA_VF(vl0, vh0), w.o0); vl3 = vtr(vp + 4096 + 1024); vh3 = vtr(vp + 4096 + 1024 + 512);
    w.o1 = FA_MFMA(pa0, FA_VF(vl1, vh1), w.o1);
    FA_SBAR();
    const int kh = k0 + 32 * HB;
    if ((kh + 31 > qlo) || (MODE == 1 && kh <= qlo + 31 - W)) {
        const float NEG = -__builtin_inff(); const int dq = t - kh - 4 * hi;
#pragma unroll
        for (int r = 0; r < 16; ++r) { const int c = (r & 3) + 8 * (r >> 2); if ((unsigned)(dq - c) >= (unsigned)W) C[r] = NEG; }
    }
    float ma = FA_MX3(C[0], C[1], C[2]), mb = FA_MX3(C[3], C[4], C[5]);
    ma = FA_MX3(ma, C[6], C[7]); mb = FA_MX3(mb, C[8], C[9]); ma = FA_MX3(ma, C[10], C[11]); mb = FA_MX3(mb, C[12], C[13]); ma = FA_MX3(ma, C[14], C[15]);
    const float rm = swap_max(__builtin_fmaxf(ma, mb));
    if (MODE == 0) w.mrun = __builtin_fmaxf(w.mrun, rm + w.mhat);
    const bool resc = __any(rm > THR);
    if (resc) {
        const float dl = __builtin_fmaxf(rm, 0.f); w.mhat += dl;
#pragma unroll
        for (int r = 0; r < 16; ++r) C[r] -= dl;
        if (MODE == 0) set_qa(w, hi);
        else { const float ci = w.cq - w.mhat;
#pragma unroll
            for (int r = 0; r < 16; ++r) w.cinit[r] = ci; }
        const float f = __builtin_amdgcn_exp2f(-dl); w.lsum *= f;
        if (hi == 0) wsf[r32] = f;
    }
    FA_SBAR();
    FA_EX4(C, 0); FA_PIN(C);
    w.o0 = FA_MFMA(pa1, FA_VF(vl2, vh2), w.o0); FA_EX4(C, 4); FA_EX4(C, 8); FA_PIN(C); FA_SBAR();
    w.o1 = FA_MFMA(pa1, FA_VF(vl3, vh3), w.o1); FA_EX4(C, 12); FA_PIN(C); FA_SBAR();
    if (resc) {
        asm volatile("s_waitcnt lgkmcnt(0)" ::: "memory");
#pragma unroll
        for (int g = 0; g < 4; ++g) { const f32x4 a4 = *(FA_LAS f32x4*)(wsf + 8 * g + 4 * hi);
#pragma unroll
            for (int i = 0; i < 4; ++i) { w.o0[4 * g + i] *= a4[i]; w.o1[4 * g + i] *= a4[i]; } }
    }
}
template <int MODE, int AOFF, int VOFF>
__device__ __forceinline__ void tile_step(FA_LAS unsigned char* bb, FA_LAS unsigned char* vprev, FA_LAS float* wsf, WaveSt& w, f32x16& pA, f32x16& pB, int k0, int t, int qlo, int lane, int r32, int hi) {
    half_step<MODE, AOFF, VOFF, 0>(bb, vprev, wsf, w, pA, pB, k0, t, qlo, lane, r32, hi);
    half_step<MODE, AOFF, VOFF, 1>(bb, vprev, wsf, w, pB, pA, k0, t, qlo, lane, r32, hi);
}
template <int VOFF>
__device__ __forceinline__ void tile_drain(FA_LAS unsigned char* vlast, WaveSt& w, f32x16& P, int lane, int hi) {
    FA_LAS unsigned char* vp = vlast + 2048 + VOFF + ((lane >> 4) & 1) * 32 + (lane & 3) * 8 + (4 * hi + ((lane & 15) >> 2)) * 64;
    float s0 = 0.f;
#pragma unroll
    for (int r = 0; r < 16; ++r) s0 += P[r];
    w.lsum += s0;
    const u32x4 w0 = {cvtpk(P[0], P[1]), cvtpk(P[2], P[3]), cvtpk(P[4], P[5]), cvtpk(P[6], P[7])};
    const u32x4 w1 = {cvtpk(P[8], P[9]), cvtpk(P[10], P[11]), cvtpk(P[12], P[13]), cvtpk(P[14], P[15])};
    const bf16x8 pa0 = __builtin_bit_cast(bf16x8, w0), pa1 = __builtin_bit_cast(bf16x8, w1);
    { const s16x4 l0 = vtr(vp), h0 = vtr(vp + 512), l1 = vtr(vp + 4096), h1 = vtr(vp + 4096 + 512); w.o0 = FA_MFMA(pa0, FA_VF(l0, h0), w.o0); w.o1 = FA_MFMA(pa0, FA_VF(l1, h1), w.o1); }
    { const s16x4 l0 = vtr(vp + 1024), h0 = vtr(vp + 1024 + 512), l1 = vtr(vp + 4096 + 1024), h1 = vtr(vp + 4096 + 1024 + 512); w.o0 = FA_MFMA(pa1, FA_VF(l0, h0), w.o0); w.o1 = FA_MFMA(pa1, FA_VF(l1, h1), w.o1); }
}
__device__ __forceinline__ void load_gate(u32x4 (&gq)[4], const bf16_t* G, size_t grow, int h, int lane) {
#pragma unroll
    for (int d0 = 0; d0 < 2; ++d0)
#pragma unroll
        for (int i = 0; i < 2; ++i) gq[2 * d0 + i] = *(const u32x4*)(G + hm_off((int)grow + i * 16 + (lane >> 2), h * 64 + d0 * 32 + (lane & 3) * 8, NH));
}
__device__ __forceinline__ void wave_epilogue(FA_LAS float* stg, FA_LAS float* wsf, WaveSt& w, const u32x4 (&gq)[4], bf16_t* O, size_t grow, int h, int lane, int r32, int hi) {
    const float l = swap_add(w.lsum);
    if (hi == 0) wsf[r32] = l;
    asm volatile("s_waitcnt lgkmcnt(0)" ::: "memory");
    float rl[16];
#pragma unroll
    for (int g = 0; g < 4; ++g) { const f32x4 l4 = *(FA_LAS f32x4*)(wsf + 8 * g + 4 * hi);
#pragma unroll
        for (int i = 0; i < 4; ++i) rl[4 * g + i] = 1.0f / l4[i]; }
#pragma unroll
    for (int d0 = 0; d0 < 2; ++d0) {
#pragma unroll
        for (int g = 0; g < 4; ++g)
#pragma unroll
            for (int i = 0; i < 4; ++i) stg[(8 * g + 4 * hi + i) * 32 + r32] = (d0 == 0 ? w.o0[4 * g + i] : w.o1[4 * g + i]) * rl[4 * g + i];
        asm volatile("s_waitcnt lgkmcnt(0)" ::: "memory");
#pragma unroll
        for (int i = 0; i < 2; ++i) { const int row = i * 16 + (lane >> 2), ch = lane & 3;
            const f32x4 x0 = *(FA_LAS f32x4*)(stg + row * 32 + ch * 8), x1 = *(FA_LAS f32x4*)(stg + row * 32 + ch * 8 + 4);
            const size_t ga = (grow + row) * DM + h * 64 + d0 * 32 + ch * 8; const u32x4 gv = gq[2 * d0 + i];
            u32x4 ov;
            ov.x = cvtpk(x0[0] * __uint_as_float(gv.x << 16), x0[1] * __uint_as_float(gv.x & 0xffff0000u)); ov.y = cvtpk(x0[2] * __uint_as_float(gv.y << 16), x0[3] * __uint_as_float(gv.y & 0xffff0000u));
            ov.z = cvtpk(x1[0] * __uint_as_float(gv.z << 16), x1[1] * __uint_as_float(gv.z & 0xffff0000u)); ov.w = cvtpk(x1[2] * __uint_as_float(gv.w << 16), x1[3] * __uint_as_float(gv.w & 0xffff0000u));
            *(u32x4*)(O + tiled_off((int)(grow + row), h * 64 + d0 * 32 + ch * 8)) = ov; }
        asm volatile("s_waitcnt lgkmcnt(0)" ::: "memory");
    }
}
template <int MODE> __device__ __forceinline__ void wave_init(WaveSt& w, int hi) {
#pragma unroll
    for (int r = 0; r < 16; ++r) { w.o0[r] = 0.f; w.o1[r] = 0.f; }
    if (MODE == 0) set_qa(w, hi);
    else { const float ci = w.cq - w.mhat;
#pragma unroll
        for (int r = 0; r < 16; ++r) w.cinit[r] = ci; }
}

__device__ __forceinline__ void fox_unit(FA_LAS unsigned char* lds, const Params& P, int b, int h, int qb) {
    const int tid = threadIdx.x, lane = tid & 63, r32 = lane & 31, hi = lane >> 5;
    const int wid = __builtin_amdgcn_readfirstlane(tid >> 6);
    const int q0 = qb * 256, qlo = q0 + wid * 32, t = qlo + r32;
    const size_t rowbase = (size_t)b * SEQ;
    const bf16_t* ksrc = P.K + hm_off((int)rowbase + lane, h * 64 + wid * 8, NH);
    const bf16_t* vsrc = P.V + hm_off((int)rowbase + 16 * (wid & 3) + (lane >> 2), h * 64 + (wid >> 2) * 32 + (lane & 3) * 8, NH);
    const float* cum = P.CUM + (size_t)(b * NH + h) * SEQ;
    const bf16_t* asrc = P.KAUG + ((size_t)(b * NH + h) * SEQ + lane) * 8;
    const int NT = (q0 + 256) / 64;
    WaveSt w; float qn = 0.f;
#pragma unroll
    for (int d0 = 0; d0 < 4; ++d0) { w.qr[d0] = *(const bf16x8*)(P.Q + hm_off((int)rowbase + t, h * 64 + d0 * 16 + hi * 8, NH));
#pragma unroll
        for (int j = 0; j < 8; ++j) { const float qv = bf2f((bf16_t)w.qr[d0][j]); qn = fmaf(qv, qv, qn); } }
    w.cq = cum[t]; w.mhat = 0.f; w.lsum = 0.f; w.mrun = -1e30f;
    wave_init<0>(w, hi);
    u32x4 gq[4]; load_gate(gq, P.G, rowbase + qlo, h, lane);
    const float qkb = sqrtf(swap_add(qn) * (__uint_as_float(P.KMAX[(b * NH + h) * 2]) + __uint_as_float(P.KMAX[(b * NH + h) * 2 + 1]))) * 1.01f + 1e-3f;
    FA_LAS float* wsf = (FA_LAS float*)(lds + F_WSF) + wid * 64;
    FA_LAS unsigned* votes = (FA_LAS unsigned*)(lds + F_FLAG);
    float cnew = 0.f;
#define FA_LOADT(j, bf) do { const size_t ko_ = (size_t)(j) * 64 * 32; FA_LAS unsigned char* bb_ = lds + (bf) * F_KBUF; \
        glds16(ksrc + ko_, (unsigned)__builtin_amdgcn_readfirstlane((int)(unsigned)(uintptr_t)(bb_ + wid * 1024))); \
        glds16(vsrc + ko_, (unsigned)__builtin_amdgcn_readfirstlane((int)(unsigned)(uintptr_t)(bb_ + F_VOFF + (wid >> 2) * 4096 + (wid & 3) * 1024))); \
        if (wid == 0) glds16(asrc + (size_t)(j) * 64 * 8, (unsigned)__builtin_amdgcn_readfirstlane((int)(unsigned)(uintptr_t)(bb_ + F_AOFF))); \
        cnew = cum[(j) * 64 + 63]; } while (0)
    FA_LOADT(NT - 1, 0); asm volatile("s_waitcnt vmcnt(0)" ::: "memory"); __syncthreads();
    bool wdone = false, pend = false; f32x16 pA, pB;
#pragma unroll
    for (int r = 0; r < 16; ++r) pB[r] = 0.f;
    int cur = 0;
    for (int tt = 0; tt < NT; ++tt) {
        const int j = NT - 1 - tt, k0 = j * 64; const int nxt = cur == 2 ? 0 : cur + 1, prv = cur == 0 ? 2 : cur - 1;
        if (j > 0) FA_LOADT(j - 1, nxt);
        if (!wdone && k0 <= qlo + 31) {
            FA_LAS unsigned char* bb = lds + cur * F_KBUF;
            tile_step<0, F_AOFF, F_VOFF>(bb, pend ? lds + prv * F_KBUF : bb, wsf, w, pA, pB, k0, t, qlo, lane, r32, hi);
            pend = true;
        }
        if (j > 0) {
            if (!wdone && pend && __all(qkb + w.cq - cnew - w.mrun <= -TH_SKIP)) {
                wdone = true; tile_drain<F_VOFF>(lds + cur * F_KBUF, w, pB, lane, hi);
            }
            if (lane == 0) votes[(tt & 1) * 8 + wid] = wdone ? 1u : 0u;
        }
        asm volatile("s_waitcnt vmcnt(0)" ::: "memory");
        __syncthreads();
        if (j > 0) { const u32x4 v0 = *(FA_LAS u32x4*)(votes + (tt & 1) * 8), v1 = *(FA_LAS u32x4*)(votes + (tt & 1) * 8 + 4);
            if ((v0.x & v0.y & v0.z & v0.w & v1.x & v1.y & v1.z & v1.w) != 0u) break; }
        else if (!wdone) tile_drain<F_VOFF>(lds + cur * F_KBUF, w, pB, lane, hi);
        cur = nxt;
    }
#undef FA_LOADT
    wave_epilogue((FA_LAS float*)(lds + F_OST + wid * 4096), wsf, w, gq, P.O, rowbase + qlo, h, lane, r32, hi);
    __syncthreads();
}
__device__ __forceinline__ void swa_unit(FA_LAS unsigned char* lds, const Params& P, int b, int kvh, int qb) {
    const int tid = threadIdx.x, lane = tid & 63, r32 = lane & 31, hi = lane >> 5;
    const int wid = __builtin_amdgcn_readfirstlane(tid >> 6);
    const int q0 = qb * 256, qlo = q0 + wid * 32, t = qlo + r32;
    const size_t rowbase = (size_t)b * SEQ;
    const int j_lo = q0 >= 128 ? (q0 - 128) / 64 : 0, NT = (q0 + 256) / 64 - j_lo;
    const bf16_t* ksrc = P.K + hm_off((int)rowbase + j_lo * 64 + lane, kvh * 64 + wid * 8, 4);
    const bf16_t* vsrc = P.V + hm_off((int)rowbase + j_lo * 64 + 16 * (wid & 3) + (lane >> 2), kvh * 64 + (wid >> 2) * 32 + (lane & 3) * 8, 4);
    const int kdst = wid * 1024 + lane * 16, vdst = S_VOFF + (wid >> 2) * 4096 + (wid & 3) * 1024 + lane * 16;
    { u32x4 sk[6], sv[6];
#pragma unroll
      for (int i = 0; i < 6; ++i) if (i < NT) { sk[i] = *(const u32x4*)(ksrc + (size_t)i * 64 * 32); sv[i] = *(const u32x4*)(vsrc + (size_t)i * 64 * 32); }
#pragma unroll
      for (int i = 0; i < 6; ++i) if (i < NT) { *(FA_LAS u32x4*)(lds + i * S_KBUF + kdst) = sk[i]; *(FA_LAS u32x4*)(lds + i * S_KBUF + vdst) = sv[i]; } }
    __syncthreads();
    FA_LAS float* wsf = (FA_LAS float*)(lds + S_WSF) + wid * 64;
    const int ta = (qlo >= 127 ? (qlo - 127) / 64 : 0) - j_lo, tb = (qlo + 31) / 64 - j_lo;
    bf16x8 qn[4];
#pragma unroll
    for (int d0 = 0; d0 < 4; ++d0) qn[d0] = *(const bf16x8*)(P.Q + hm_off((int)rowbase + t, (kvh * 8) * 64 + d0 * 16 + hi * 8, NH));
    for (int hh = 0; hh < 8; ++hh) {
        const int h = kvh * 8 + hh;
        WaveSt w;
#pragma unroll
        for (int d0 = 0; d0 < 4; ++d0) w.qr[d0] = qn[d0];
#pragma unroll
        for (int d0 = 0; d0 < 4; ++d0) qn[d0] = *(const bf16x8*)(P.Q + hm_off((int)rowbase + t, (kvh * 8 + (hh < 7 ? hh + 1 : hh)) * 64 + d0 * 16 + hi * 8, NH));
        u32x4 gq[4]; load_gate(gq, P.G, rowbase + qlo, h, lane);
        w.cq = 0.f; w.mhat = P.sinks[h] * LOG2E; w.lsum = 0.5f; w.mrun = 0.f;
        wave_init<1>(w, hi);
        f32x16 pA, pB;
#pragma unroll
        for (int r = 0; r < 16; ++r) pB[r] = 0.f;
        for (int ti = tb; ti >= ta; --ti) { FA_LAS unsigned char* bb = lds + ti * S_KBUF;
            tile_step<1, 0, S_VOFF>(bb, ti == tb ? bb : bb + S_KBUF, wsf, w, pA, pB, (j_lo + ti) * 64, t, qlo, lane, r32, hi); }
        tile_drain<S_VOFF>(lds + ta * S_KBUF, w, pB, lane, hi);
        wave_epilogue((FA_LAS float*)(lds + S_OST + wid * 4096), wsf, w, gq, P.O, rowbase + qlo, h, lane, r32, hi);
    }
    __syncthreads();
}
}
#define GAS __attribute__((address_space(1)))
#define LAS __attribute__((address_space(3)))
typedef unsigned short bf16;
typedef unsigned v4u __attribute__((ext_vector_type(4)));
typedef float f32x4 __attribute__((ext_vector_type(4)));
typedef short bf16x8 __attribute__((ext_vector_type(8)));
typedef GAS unsigned gu32;
typedef GAS unsigned long long gu64;
#define RLX_AGENT __ATOMIC_RELAXED, __HIP_MEMORY_SCOPE_AGENT
#define LDS_WAIT() asm volatile("s_waitcnt lgkmcnt(0)" ::: "memory")
#define VM_WAIT() asm volatile("s_waitcnt vmcnt(0)" ::: "memory")
__device__ __forceinline__ unsigned long long rt() { return __builtin_amdgcn_s_memrealtime(); }
__device__ __forceinline__ unsigned pk2(float lo, float hi) { return (unsigned)f2bf(lo) | ((unsigned)f2bf(hi) << 16); }
#define XB_TMO      128
#define XB_XCNT(j)  (256  + 64 * (j))
#define XB_XSUB(j)  (1280 + 64 * (j))
#define XB_XGEN(j)  (2304 + 64 * (j))
#define XB_TOP      3328
#define XB_TOPGEN   3392
#define XCD_BAR_WORDS 3456
#define XB_SPIN_CAP (1u << 18)

__device__ __forceinline__ unsigned xb_ld(unsigned* p)              { return __hip_atomic_load(p, __ATOMIC_RELAXED, __HIP_MEMORY_SCOPE_AGENT); }
__device__ __forceinline__ unsigned xb_add(unsigned* p, unsigned v) { return __hip_atomic_fetch_add(p, v, __ATOMIC_RELAXED, __HIP_MEMORY_SCOPE_AGENT); }
__device__ __forceinline__ unsigned xb_xcc_id() { return (unsigned)__builtin_amdgcn_s_getreg((3 << 11) | 20) & 0xFu; }
#define XB_SPIN(cond, bar) do { unsigned _sp = 0; while (cond) { __builtin_amdgcn_s_sleep(1); \
    if ((++_sp & 255u) == 0u) { if (xb_ld(&(bar)[XB_TMO])) break; if (_sp > XB_SPIN_CAP) { atomicAdd(&(bar)[XB_TMO], 1u); break; } } } } while (0)

struct XcdBarrier {
    unsigned* bar; unsigned x;
    volatile LAS unsigned* st;
};

__device__ __forceinline__ XcdBarrier xcd_barrier_post(unsigned* bar, volatile LAS unsigned* st) {
    XcdBarrier b; b.bar = bar; b.x = xb_xcc_id(); b.st = st;
    if (threadIdx.x == 0) (void)xb_add(&bar[XB_XCNT(b.x)], 1u);
    return b;
}
__device__ __forceinline__ void xcd_barrier_complete(unsigned* bar, unsigned x, unsigned& nloc, unsigned& nx) {
    const unsigned G = gridDim.x * gridDim.y * gridDim.z;
    unsigned sum, cnt, mine, sp = 0u;
    for (;;) {
        sum = 0u; cnt = 0u; mine = 0u;
#pragma unroll
        for (unsigned j = 0; j < 16; ++j) { const unsigned c = xb_ld(&bar[XB_XCNT(j)]); sum += c; cnt += (c > 0u) ? 1u : 0u; mine = (j == x) ? c : mine; }
        if (sum == G) break;
        __builtin_amdgcn_s_sleep(1);
        if ((++sp & 255u) == 0u) { if (xb_ld(&bar[XB_TMO])) break; if (sp > XB_SPIN_CAP) { atomicAdd(&bar[XB_TMO], 1u); break; } }
    }
    nloc = mine > 0u ? mine : 1u; nx = cnt > 0u ? cnt : 1u;
}

__device__ __forceinline__ void xcd_barrier(const XcdBarrier& b) {
    asm volatile("s_waitcnt vmcnt(0)" ::: "memory");
    __syncthreads();
    if (threadIdx.x == 0) {
        unsigned* bar = b.bar;
        __builtin_amdgcn_s_waitcnt(0);
        unsigned nloc = b.st[0], nx = b.st[1];
        if (nloc == 0u) { xcd_barrier_complete(bar, b.x, nloc, nx); b.st[0] = nloc; b.st[1] = nx; }
        const unsigned old = xb_add(&bar[XB_XSUB(b.x)], 1u);
        const unsigned gen = old / nloc;
        if (old + 1u == (gen + 1u) * nloc) {
            __builtin_amdgcn_fence(__ATOMIC_RELEASE, "agent");
            asm volatile("s_waitcnt vmcnt(0)" ::: "memory");
            const unsigned og = xb_add(&bar[XB_TOP], 1u);
            const unsigned tg = og / nx;
            if (og + 1u == (tg + 1u) * nx) xb_add(&bar[XB_TOPGEN], 1u);
            else XB_SPIN(xb_ld(&bar[XB_TOPGEN]) == tg, bar);
            __builtin_amdgcn_fence(__ATOMIC_ACQUIRE, "agent");
            xb_add(&bar[XB_XGEN(b.x)], 1u);
            asm volatile("s_waitcnt vmcnt(0)" ::: "memory");
        } else {
            XB_SPIN(xb_ld(&bar[XB_XGEN(b.x)]) == gen, bar);
            __builtin_amdgcn_fence(__ATOMIC_ACQUIRE, "agent");
            asm volatile("s_waitcnt vmcnt(0)" ::: "memory");
        }
    }
    __syncthreads();
}
constexpr int NWAVES = 8;
constexpr int N1P = 8448;
constexpr int RING_OFF = 0, RING_BYTES = 135168;
constexpr int LDSCTL_OFF = RING_BYTES, MISC_OFF = LDSCTL_OFF + 320;
constexpr int LDS_BYTES = 147456;
constexpr int CW_BAR = 4096;
static_assert(fa::F_LDS_BYTES <= RING_BYTES && fa::S_LDS_BYTES <= RING_BYTES && pg8::STAGE_BYTES <= RING_BYTES && MISC_OFF + 128 <= LDS_BYTES && (CW_BAR + XCD_BAR_WORDS) * 4 <= (int)WS_KMAX, "LDS / CTL map");

__device__ __forceinline__ void p0_transpose_item(const float* W, int K, int N, bf16* WT, LAS float* scr, int item, int lane, const float* gs) {
    const int nblk = N / 32, kb = item / nblk, nb = item % nblk, k0 = 64 * kb, n0 = 32 * nb;
    const int kr = lane >> 3, nc = 4 * (lane & 7);
    f32x4 wv[8];
#pragma unroll
    for (int i = 0; i < 8; ++i) wv[i] = *(const GAS f32x4*)(W + (size_t)(k0 + 8 * i + kr) * N + n0 + nc);
#pragma unroll
    for (int i = 0; i < 8; ++i) { const int kk = 8 * i + kr; f32x4 w = wv[i]; if (gs) w = w * gs[k0 + kk]; LAS float* d = scr + kk * 33 + nc; d[0] = w.x; d[1] = w.y; d[2] = w.z; d[3] = w.w; }
    LDS_WAIT(); asm volatile("" ::: "memory");
    const int c = lane & 7;
#pragma unroll
    for (int j = 0; j < 4; ++j) { const int n = (lane >> 3) + 8 * j; const LAS float* sp = scr + (8 * c) * 33 + n;
        v4u o; o.x = pk2(sp[0 * 33], sp[1 * 33]); o.y = pk2(sp[2 * 33], sp[3 * 33]); o.z = pk2(sp[4 * 33], sp[5 * 33]); o.w = pk2(sp[6 * 33], sp[7 * 33]);
        *(GAS v4u*)(WT + tiled_off(n0 + n, k0 + 8 * c)) = o; }
    LDS_WAIT(); asm volatile("" ::: "memory");
}
__device__ __forceinline__ float wave_sum(float v) {
#pragma unroll
    for (int o = 1; o < 64; o <<= 1) v += __shfl_xor(v, o);
    return v;
}

struct Args { const float* in[9]; float* out; unsigned char* ws; int ph_lo, ph_hi; };
constexpr int N_PHASES = 9;
__global__ void __launch_bounds__(NWAVES * 64, 2) mega_fwd(Args args) {
    extern __shared__ __attribute__((aligned(16))) unsigned char lds_raw[];
    LAS unsigned char* lds = (LAS unsigned char*)lds_raw;
    volatile LAS unsigned* MISC = (volatile LAS unsigned*)(lds + MISC_OFF);
    const int tid = threadIdx.x, lane = tid & 63, wave = __builtin_amdgcn_readfirstlane(tid >> 6);
    const int G = gridDim.x, bx = blockIdx.x, vcu = (G % 8 == 0) ? (bx % 8) * (G / 8) + bx / 8 : bx;
    unsigned char* ws = args.ws;
    const float* x = args.in[0]; const float* norm_g = args.in[1]; const float* fox_w_in = args.in[2]; const float* fox_b_f = args.in[3]; const float* fox_w_out = args.in[4];
    const float* swa_w_in = args.in[5]; const float* swa_sinks = args.in[6]; const float* swa_w_out = args.in[7]; const float* final_g = args.in[8];
    float* out = args.out;
    gu32* ctl = (gu32*)(ws + WS_CTL);
    unsigned* KMAX = (unsigned*)(ws + WS_KMAX); unsigned* TICKET = (unsigned*)(ws + WS_TICKET);
    float* SS1 = (float*)(ws + WS_SS1); float* R0 = (float*)(ws + WS_R0); float* ROPE = (float*)(ws + WS_ROPE); float* LOGF = (float*)(ws + WS_LOGF); float* CUM = (float*)(ws + WS_CUM);
    bf16* W1T = (bf16*)(ws + WS_W1T); bf16* W2T = (bf16*)(ws + WS_W2T); bf16* W3T = (bf16*)(ws + WS_W3T); bf16* W4T = (bf16*)(ws + WS_W4T);
    bf16* KAUG = (bf16*)(ws + WS_KAUG);
    bf16* XB = (bf16*)(ws + WS_XB); bf16* Qb = (bf16*)(ws + WS_Q); bf16* Kb = (bf16*)(ws + WS_K); bf16* Vb = (bf16*)(ws + WS_V); bf16* Gb = (bf16*)(ws + WS_G); bf16* YG = (bf16*)(ws + WS_YG);
    for (int u = tid; u < (LDS_BYTES - LDSCTL_OFF) / 4; u += NWAVES * 64) ((LAS unsigned*)(lds + LDSCTL_OFF))[u] = 0u;
    __syncthreads();
    const int lo = args.ph_lo, hi = args.ph_hi;
    XcdBarrier bar; bar.bar = (unsigned*)(ctl + CW_BAR); bar.x = 0; bar.st = nullptr;
    if (hi - lo > 1) bar = xcd_barrier_post((unsigned*)(ctl + CW_BAR), MISC + 8);
#define IN(k) (lo <= (k) && (k) < hi)
#define REP(k) for (int rep_ = 0; rep_ < (((DUP_MASK >> (k)) & 1) ? 2 : 1); ++rep_)
#define SEAM(k) do { if (IN(k) && IN((k) + 1)) xcd_barrier(bar); } while (0)
    const int gw = vcu * NWAVES + wave, NGW = G * NWAVES;

    if (IN(0)) REP(0) {
        LAS float* scr = (LAS float*)(lds + RING_OFF + wave * 16384);
        constexpr int I1 = (DM / 64) * (FOX_IN / 32), IZ = N1P - FOX_IN;
        constexpr int NITEMS = I1 + IZ;
        for (int it = gw; it < NITEMS; it += NGW) {
            int r = it;
            if (r < I1) { p0_transpose_item(fox_w_in, DM, FOX_IN, W1T, scr, r, lane, norm_g); continue; } r -= I1;
            { GAS v4u* zp = (GAS v4u*)(W1T + tiled_off(FOX_IN + r, (lane >> 1) * 64 + (lane & 1) * 32));
#pragma unroll
              for (int j = 0; j < 4; ++j) zp[j] = (v4u){0u, 0u, 0u, 0u}; }
        }
        for (int m = 2 * gw; m < MTOK; m += 2 * NGW) {
            const int m2 = m + 1;
            const GAS f32x4* xr = (const GAS f32x4*)(x + (size_t)m * DM) + lane; const GAS f32x4* xr2 = (const GAS f32x4*)(x + (size_t)m2 * DM) + lane; f32x4 v[8], v2[8]; float s = 0.f, s2 = 0.f;
#pragma unroll
            for (int j = 0; j < 8; ++j) { v[j] = xr[64 * j]; v2[j] = xr2[64 * j]; }
#pragma unroll
            for (int j = 0; j < 8; ++j) { s += (v[j].x * v[j].x + v[j].y * v[j].y) + (v[j].z * v[j].z + v[j].w * v[j].w); s2 += (v2[j].x * v2[j].x + v2[j].y * v2[j].y) + (v2[j].z * v2[j].z + v2[j].w * v2[j].w); }
            s = wave_sum(s); s2 = wave_sum(s2);
            if (lane == 0) { R0[m] = 1.0f / sqrtf(s * (1.f / DM) + RMS_EPS); R0[m2] = 1.0f / sqrtf(s2 * (1.f / DM) + RMS_EPS); }
#pragma unroll
            for (int j = 0; j < 8; ++j) { *(GAS unsigned long long*)(XB + tiled_off(m, 256 * j + 4 * lane)) = (unsigned long long)pk2(v[j].x, v[j].y) | ((unsigned long long)pk2(v[j].z, v[j].w) << 32);
                                          *(GAS unsigned long long*)(XB + tiled_off(m2, 256 * j + 4 * lane)) = (unsigned long long)pk2(v2[j].x, v2[j].y) | ((unsigned long long)pk2(v2[j].z, v2[j].w) << 32); }
        }
        { const int gt = gw * 64 + lane;
          if (gt < SEQ * 8) { const int pos = gt >> 3, i = gt & 7;
              const double invf[8] = {1.0, 0.19390220519133497, 0.037598065178462524, 0.0072903477503833845, 0.0014142135623730951, 0.00027421912901204056, 5.3171693730649086e-05, 1.0310108130908796e-05};
              double inv = invf[0];
#pragma unroll
              for (int k = 1; k < 8; ++k) inv = (i == k) ? invf[k] : inv;
              const double ang = (double)pos * inv; const double kk = __builtin_rint(ang * 0.15915494309189535); const float red = (float)(ang - kk * 6.283185307179586);
              ROPE[(size_t)pos * 16 + i] = cosf(red); ROPE[(size_t)pos * 16 + 8 + i] = sinf(red); } }
    }
    SEAM(0);
    if (IN(1)) {
        pg8::Gemm g{XB, W1T, MTOK, N1P, DM}; pg8::StaticOrder S; S.init(MTOK, N1P, G, bx, (DUP_MASK >> 1) & 1, (DUP_MASK >> 9) & 1);
        pg8::EpiFoxIn E{Qb, Kb, Vb, Gb, LOGF, R0, fox_b_f, KMAX};
        if ((DUP_MASK >> 10) & 1) { pg8::StaticOrder SP; SP.init(MTOK, N1P, G, bx, 0, 0, 1); pg8::gemm_phase<pg8::EpiFoxIn, pg8::StaticOrder, true, true>(lds + RING_OFF, g, SP, E); }
        pg8::gemm_phase<pg8::EpiFoxIn, pg8::StaticOrder, true, true>(lds + RING_OFF, g, S, E);
        { const int nwg = (MTOK / 256) * (N1P / 256), rem = nwg % G, nidle = rem ? G - rem : G, ii = rem ? bx - rem : bx;
          if (ii >= 0) { LAS float* scr = (LAS float*)(lds + RING_OFF + wave * 16384);
              constexpr int I2 = (DM / 64) * (DM / 32), I3 = (DM / 64) * (SWA_IN / 32);
              for (int it = ii * NWAVES + wave; it < I2 + I3 + I2; it += nidle * NWAVES) {
                  int r = it;
                  if (r < I2) { p0_transpose_item(fox_w_out, DM, DM, W2T, scr, r, lane, nullptr); continue; } r -= I2;
                  if (r < I3) { p0_transpose_item(swa_w_in, DM, SWA_IN, W3T, scr, r, lane, norm_g + DM); continue; } r -= I3;
                  p0_transpose_item(swa_w_out, DM, DM, W4T, scr, r, lane, nullptr); } } }
    }
    SEAM(1);
    if (IN(2)) REP(2) {
        for (int sq = vcu; sq < NB * NH; sq += G) {
            const GAS f32x4* lf = (const GAS f32x4*)(LOGF + (size_t)sq * SEQ + wave * 512) + lane * 2; const f32x4 v0 = lf[0], v1 = lf[1];
            const double tot = (((double)v0.x + (double)v0.y) + ((double)v0.z + (double)v0.w)) + (((double)v1.x + (double)v1.y) + ((double)v1.z + (double)v1.w));
            double incl = tot;
#pragma unroll
            for (int o = 1; o < 64; o <<= 1) { const double up = __shfl_up(incl, o); if (lane >= o) incl += up; }
            volatile LAS double* wt = (volatile LAS double*)(lds + RING_OFF);
            __syncthreads();
            if (lane == 63) wt[wave] = incl;
            __syncthreads();
            double run = incl - tot;
            for (int w2 = 0; w2 < wave; ++w2) run += wt[w2];
            const float vv[8] = {v0.x, v0.y, v0.z, v0.w, v1.x, v1.y, v1.z, v1.w}; float cv[8];
#pragma unroll
            for (int e = 0; e < 8; ++e) { run += (double)vv[e]; cv[e] = (float)(run * 1.4426950408889634); }
            GAS f32x4* co = (GAS f32x4*)(CUM + (size_t)sq * SEQ + wave * 512) + lane * 2; co[0] = (f32x4){cv[0], cv[1], cv[2], cv[3]}; co[1] = (f32x4){cv[4], cv[5], cv[6], cv[7]};
            GAS v4u* ka = (GAS v4u*)(KAUG + ((size_t)sq * SEQ + wave * 512 + lane * 8) * 8);
#pragma unroll
            for (int e = 0; e < 8; ++e) { unsigned h1, h2, h3; fa::split3(-cv[e], h1, h2, h3); ka[e] = (v4u){h1 | (h2 << 16), h3 | 0x3F800000u, 0x3F803F80u, 0u}; }
        }
    }
    SEAM(2);
    if (IN(3)) {
        const fa::Params P{Qb, Kb, Vb, Gb, YG, CUM, nullptr, KMAX, TICKET, KAUG};
        volatile LAS unsigned* slot = (volatile LAS unsigned*)(lds + RING_OFF + fa::F_FLAG + 128);
#define FOX_FETCH(dst) do { unsigned code_ = 0xFFFFFFFFu; for (int k_ = 0; k_ < 8; ++k_) { const unsigned q_ = (unsigned)((bx + k_) & 7); const unsigned t_ = atomicAdd(TICKET + q_ * 64, 1u); \
            if (t_ < 256u) { code_ = q_ * 256u + t_; break; } } (dst) = code_; } while (0)
        if (tid == 0) FOX_FETCH(slot[0]);
        __syncthreads();
        unsigned tk = slot[0]; int par = 0;
        while (tk != 0xFFFFFFFFu) {
            if (tid == 0) FOX_FETCH(slot[par ^ 1]);
            const int q = (int)(tk >> 8), tq = (int)(tk & 255u), pi = tq >> 4, hs = 3 - (pi >> 2);
            const int h = hs == 0 ? q : hs == 1 ? 15 - q : hs == 2 ? 16 + q : 31 - q;
            fa::fox_unit(lds + RING_OFF, P, pi & 3, h, 15 - (tq & 15));
            par ^= 1; tk = slot[par];
        }
#undef FOX_FETCH
        __syncthreads();
    }
    SEAM(3);
    if (IN(4)) {
        pg8::Gemm g{YG, W2T, MTOK, DM, DM}; pg8::StaticOrder S; S.init(MTOK, DM, G, bx);
        pg8::EpiRes<true> E{x, XB, SS1};
        pg8::gemm_phase<pg8::EpiRes<true>, pg8::StaticOrder, true, true>(lds + RING_OFF, g, S, E);
    }
    SEAM(4);
    if (IN(5)) {
        pg8::Gemm g{XB, W3T, MTOK, SWA_IN, DM}; pg8::StaticOrder S; S.init(MTOK, SWA_IN, G, bx, (DUP_MASK >> 5) & 1);
        pg8::EpiSwaIn E{Qb, Kb, Vb, Gb, SS1, ROPE};
        pg8::gemm_phase<pg8::EpiSwaIn, pg8::StaticOrder, true, true>(lds + RING_OFF, g, S, E);
    }
    SEAM(5);
    if (IN(6)) REP(6) {
        const fa::Params P{Qb, Kb, Vb, Gb, YG, nullptr, swa_sinks, nullptr, nullptr, nullptr};
        for (int u = (G == 256 ? vcu : bx); u < NB * 4 * 16; u += G) fa::swa_unit(lds + RING_OFF, P, u >> 6, (u >> 4) & 3, u & 15);
    }
    SEAM(6);
    if (IN(7)) {
        pg8::Gemm g{YG, W4T, MTOK, DM, DM}; pg8::StaticOrder S; S.init(MTOK, DM, G, bx);
        pg8::EpiRes<false> E{nullptr, XB, nullptr};
        pg8::gemm_phase<pg8::EpiRes<false>, pg8::StaticOrder, true, true>(lds + RING_OFF, g, S, E);
    }
    SEAM(7);
    if (IN(8)) {
        f32x4 gq[8];
#pragma unroll
        for (int j = 0; j < 8; ++j) gq[j] = ((const GAS f32x4*)final_g)[lane + 64 * j];
        for (int m = 2 * gw; m < MTOK; m += 2 * NGW) {
            f32x4 v[8], v2[8]; float s = 0.f, s2 = 0.f; unsigned long long xw[8], xw2[8];
#pragma unroll
            for (int j = 0; j < 8; ++j) { xw[j] = *(const GAS unsigned long long*)(XB + tiled_off(m, 256 * j + 4 * lane)); xw2[j] = *(const GAS unsigned long long*)(XB + tiled_off(m + 1, 256 * j + 4 * lane)); }
#pragma unroll
            for (int j = 0; j < 8; ++j) { const unsigned lo32 = (unsigned)xw[j], hi32 = (unsigned)(xw[j] >> 32), lo2 = (unsigned)xw2[j], hi2 = (unsigned)(xw2[j] >> 32);
                v[j] = (f32x4){__uint_as_float(lo32 << 16), __uint_as_float(lo32 & 0xffff0000u), __uint_as_float(hi32 << 16), __uint_as_float(hi32 & 0xffff0000u)};
                v2[j] = (f32x4){__uint_as_float(lo2 << 16), __uint_as_float(lo2 & 0xffff0000u), __uint_as_float(hi2 << 16), __uint_as_float(hi2 & 0xffff0000u)};
                s += (v[j].x * v[j].x + v[j].y * v[j].y) + (v[j].z * v[j].z + v[j].w * v[j].w); s2 += (v2[j].x * v2[j].x + v2[j].y * v2[j].y) + (v2[j].z * v2[j].z + v2[j].w * v2[j].w); }
            const float r = 1.0f / sqrtf(wave_sum(s) * (1.f / DM) + RMS_EPS), r2 = 1.0f / sqrtf(wave_sum(s2) * (1.f / DM) + RMS_EPS);
            GAS f32x4* xr = (GAS f32x4*)(out + (size_t)m * DM) + lane; GAS f32x4* xr2 = (GAS f32x4*)(out + (size_t)(m + 1) * DM) + lane;
#pragma unroll
            for (int j = 0; j < 8; ++j) { xr[64 * j] = v[j] * r * gq[j]; xr2[64 * j] = v2[j] * r2 * gq[j]; }
        }
    }
#undef IN
#undef SEAM
}

extern "C" void kernel_launch(void* const* d_in, const int* in_sizes, int n_in, void* d_out, int out_size, void* d_ws, size_t ws_size, hipStream_t stream) {
    static int grid = 0;
    if (grid == 0) {
        if (n_in != 9 || in_sizes[0] != MTOK * DM || out_size != MTOK * DM || ws_size < WS_END) { fprintf(stderr, "kernel_launch: unexpected shapes (n_in %d, in0 %d, out %d, ws %zu)\n", n_in, n_in > 0 ? in_sizes[0] : -1, out_size, ws_size); grid = -1; return; }
        int dev = 0, cus = 0, per_cu = 0;
        if (hipGetDevice(&dev) != hipSuccess || hipDeviceGetAttribute(&cus, hipDeviceAttributeMultiprocessorCount, dev) != hipSuccess) { fprintf(stderr, "kernel_launch: device query failed\n"); grid = -1; return; }
        if (hipFuncSetAttribute((const void*)mega_fwd, hipFuncAttributeMaxDynamicSharedMemorySize, LDS_BYTES) != hipSuccess) { fprintf(stderr, "kernel_launch: hipFuncSetAttribute failed\n"); grid = -1; return; }
        if (hipOccupancyMaxActiveBlocksPerMultiprocessor(&per_cu, (const void*)mega_fwd, NWAVES * 64, LDS_BYTES) != hipSuccess || per_cu < 1) { fprintf(stderr, "kernel_launch: occupancy query reports %d workgroups per CU; nothing launched\n", per_cu); (void)hipGetLastError(); grid = -1; return; }
        grid = cus;
    }
    if (grid < 0) return;
    (void)hipMemsetAsync((unsigned char*)d_ws + WS_CTL, 0, CTL_ZERO_BYTES, stream);
    Args a{};
    for (int i = 0; i < 9; ++i) a.in[i] = (const float*)d_in[i];
    a.out = (float*)d_out; a.ws = (unsigned char*)d_ws;
    int p = 0;
    while (p < N_PHASES) {
        if (!((FAST_MASK >> p) & 1)) { ++p; continue; }
        int e = p + 1; if (ONE_LAUNCH) while (e < N_PHASES && ((FAST_MASK >> e) & 1)) ++e;
        a.ph_lo = p; a.ph_hi = e;
        hipLaunchKernelGGL(mega_fwd, dim3(grid), dim3(NWAVES * 64), LDS_BYTES, stream, a);
        p = e;
    }
}
```

```cpp
#include <hip/hip_runtime.h>
#include <cstdio>
#include <cstdint>

constexpr int NB = 4, SEQ = 4096, DM = 2048, MTOK = NB * SEQ, NH = 32, HD = 64;
constexpr int FOX_IN = 8224, SWA_IN = 4608, KVW = 256;
constexpr float RMS_EPS = 1e-6f;
constexpr float LOG2E = 1.4426950408889634f;
constexpr float C2 = 0.125f * LOG2E;

typedef unsigned short bf16_t;
__device__ __forceinline__ float bf2f(bf16_t v) { return __uint_as_float((unsigned)v << 16); }
__device__ __forceinline__ bf16_t f2bf(float f) { unsigned u = __float_as_uint(f); return (bf16_t)((u + 0x7fffu + ((u >> 16) & 1u)) >> 16); }
__device__ __forceinline__ float logsigmoidf(float z) { return z < 0.f ? z - log1pf(expf(z)) : -log1pf(expf(-z)); }
__device__ __forceinline__ float siluf(float g) { return g / (1.f + expf(-g)); }

__host__ __device__ __forceinline__ size_t tiled_off(int row, int k) { return ((size_t)(((row >> 8) * (DM / 64) + (k >> 6)) * 2 + ((k >> 5) & 1)) << 13) + (size_t)(((row & 255) << 5) + (k & 31)); }

__host__ __device__ __forceinline__ size_t hm_off(int row  , int col  , int nheads) { return ((size_t)(((row >> 12) * nheads + (col >> 6)) * 2 + ((col >> 5) & 1)) * SEQ + (row & 4095)) * 32 + (col & 31); }

constexpr size_t MiB = 1u << 20;
constexpr size_t WS_CTL = 0, CTL_ZERO_BYTES = 1 * MiB;
constexpr size_t WS_KMAX = 64 * 1024, WS_TICKET = 66 * 1024;
constexpr size_t WS_SS1 = 512 * 1024;
constexpr size_t WS_R0 = 1 * MiB;
constexpr size_t WS_ROPE = 1 * MiB + 512 * 1024;
constexpr size_t WS_LOGF = 2 * MiB;
constexpr size_t WS_CUM = 4 * MiB;
constexpr size_t WS_W1T = 8 * MiB, WS_W2T = 41 * MiB, WS_W3T = 49 * MiB, WS_W4T = 67 * MiB;
constexpr size_t WS_XB = 76 * MiB, WS_Q = 140 * MiB, WS_K = 204 * MiB, WS_V = 268 * MiB, WS_G = 332 * MiB, WS_YG = 396 * MiB, WS_KAUG = 460 * MiB, WS_END = 468 * MiB;

#ifndef FAST_MASK
#define FAST_MASK 0x1FF
#endif
#ifndef DUP_MASK
#define DUP_MASK 0x000
#endif
#ifndef ONE_LAUNCH
#define ONE_LAUNCH 1
#endif
namespace pg8 {
#define PG8_LAS __attribute__((address_space(3)))
typedef unsigned short bf16_t;
typedef short bf16x8 __attribute__((ext_vector_type(8)));
typedef float f32x4 __attribute__((ext_vector_type(4)));
typedef unsigned u32x4 __attribute__((ext_vector_type(4)));
constexpr int BM = 256, BK = 64, HALF = 128, HTB = HALF * BK * 2  , STAGE_BYTES = 8 * HTB, NXCD = 8, WGM = 8;

__host__ __device__ __forceinline__ int lds_byte(int r, int c) { const int st = (r >> 4) * 2 + (c >> 5), rr = r & 15, cc = c & 31, ob = rr * 64 + cc * 2; return st * 1024 + (ob ^ (((ob >> 9) & 1) << 5)); }
__host__ __device__ __forceinline__ void stage_rc(int b, int& R, int& C) { const int st = b / 1024, sb = b % 1024, swz = sb ^ (((sb >> 9) & 1) << 5); R = (st >> 1) * 16 + swz / 64; C = (st & 1) * 32 + (swz % 64) / 2; }
__host__ __device__ __forceinline__ int perm32(int rho) { const int n = rho >> 4, i = rho & 15; return 8 * (i >> 2) + 4 * n + (i & 3); }

struct Unit { int pm, pn, lm, ln; };
struct Gemm { const bf16_t* A; const bf16_t* Bt; int M, N, K; };

struct StaticOrder {
    int nM, nN, nwg, G, c, dup, epi2, same;
    __host__ __device__ void init(int M, int N, int G_, int c_, int dup_ = 0, int epi2_ = 0, int same_ = 0) { nM = M / BM; nN = N / BM; nwg = nM * nN; G = G_; c = c_; dup = dup_; epi2 = epi2_; same = same_; }
    __host__ __device__ bool next(int i, Unit& u) const {
        if (dup) i >>= 1;
        const long L = (long)i * G + c; if (L >= nwg) return false;
        int wgid = (int)L; { const int q = nwg / NXCD, r = nwg % NXCD, xcd = wgid % NXCD, off = wgid / NXCD; wgid = (xcd < r ? xcd * (q + 1) : r * (q + 1) + (xcd - r) * q) + off; }
        const int nig = WGM * nN, gid = wgid / nig, fm = gid * WGM, gsz = (nM - fm) < WGM ? (nM - fm) : WGM;
        u.pm = fm + ((wgid % nig) % gsz); u.pn = (wgid % nig) / gsz; u.lm = same ? 0 : u.pm; u.ln = same ? 0 : u.pn; return true;
    }
    __device__ __forceinline__ void a_ready(const Unit&) const {}
    __device__ __forceinline__ void done(const Unit&) const {}
};

__device__ __forceinline__ unsigned cvt_pk_bf16(float lo, float hi) { unsigned r; asm volatile("v_cvt_pk_bf16_f32 %0, %1, %2" : "=v"(r) : "v"(lo), "v"(hi)); return r; }
__device__ __forceinline__ float silu_fast(float g) { return g * __builtin_amdgcn_rcpf(1.0f + __builtin_amdgcn_exp2f(-g * 1.4426950408889634f)); }
__device__ __forceinline__ u32x4 pack8(const f32x4 v0, const f32x4 v1) { u32x4 w; w.x = cvt_pk_bf16(v0[0], v0[1]); w.y = cvt_pk_bf16(v0[2], v0[3]); w.z = cvt_pk_bf16(v1[0], v1[1]); w.w = cvt_pk_bf16(v1[2], v1[3]); return w; }
struct EpiFoxIn {
    static constexpr bool PERM = true, AFTER_DRAIN = false;
    bf16_t *Q, *K, *V, *G; float* LOGF; const float* R0; const float* bfb; unsigned* KMAX;
    __device__ __forceinline__ void operator()(const f32x4 (&acc)[2][2][4][2], const Unit& u, int wr, int wc, int fr, int fq) const {
        const int row0 = u.pm * BM + wr * 64 + fr, pn = u.pn;
        float rs[2][4];
#pragma unroll
        for (int ai = 0; ai < 2; ++ai)
#pragma unroll
            for (int m = 0; m < 4; ++m) rs[ai][m] = R0[row0 + ai * HALF + m * 16];
        {
            const int reg = pn >> 3; bf16_t* base = reg == 0 ? Q : reg == 1 ? K : reg == 2 ? V : G; float kmx[2] = {0.f, 0.f};
            const int col0 = (pn & 7) * BM + wc * 32 + 8 * fq;
#pragma unroll
            for (int ai = 0; ai < 2; ++ai)
#pragma unroll
                for (int m = 0; m < 4; ++m) { const int row = row0 + ai * HALF + m * 16; const float r = rs[ai][m]; const float sc = reg == 0 ? r * C2 : r;
#pragma unroll
                    for (int bj = 0; bj < 2; ++bj) { f32x4 v0 = acc[ai][bj][m][0] * sc, v1 = acc[ai][bj][m][1] * sc;
                        if (reg == 3) {
#pragma unroll
                            for (int j = 0; j < 4; ++j) { v0[j] = silu_fast(v0[j]); v1[j] = silu_fast(v1[j]); } }
                        if (reg == 1) { float ss = ((v0[0] * v0[0] + v0[1] * v0[1]) + (v0[2] * v0[2] + v0[3] * v0[3])) + ((v1[0] * v1[0] + v1[1] * v1[1]) + (v1[2] * v1[2] + v1[3] * v1[3]));
                            ss += __shfl_xor(ss, 16); ss += __shfl_xor(ss, 32); kmx[bj] = fmaxf(kmx[bj], ss); }
                        __builtin_nontemporal_store(pack8(v0, v1), (u32x4*)(base + hm_off(row, col0 + bj * HALF, NH))); } }
            if (reg == 1) {
#pragma unroll
                for (int bj = 0; bj < 2; ++bj) { float mx = kmx[bj];
#pragma unroll
                    for (int o = 1; o < 16; o <<= 1) mx = fmaxf(mx, __shfl_xor(mx, o));
                    if (fr == 0 && fq == 0) atomicMax(KMAX + ((row0 >> 12) * NH + (pn & 7) * 4 + bj * 2 + (wc >> 1)) * 2 + (wc & 1), __float_as_uint(mx)); } }
        }
    }
};
struct EpiSwaIn {
    static constexpr bool PERM = true, AFTER_DRAIN = false;
    bf16_t *Q, *K, *V, *G; const float* SS; const float* ROPE;
    __device__ __forceinline__ void operator()(const f32x4 (&acc)[2][2][4][2], const Unit& u, int wr, int wc, int fr, int fq) const {
        const int row0 = u.pm * BM + wr * 64 + fr, pn = u.pn;
        bf16_t* base; int pitch, colt; float osc = 1.f; const bool rope = pn <= 8, gate = pn >= 10;
        if (pn < 8) { base = Q; pitch = DM; colt = pn * BM; osc = C2; } else if (pn == 8) { base = K; pitch = KVW; colt = 0; } else if (pn == 9) { base = V; pitch = KVW; colt = 0; } else { base = G; pitch = DM; colt = (pn - 10) * BM; }
        const int col0 = colt + wc * 32 + 8 * fq; const bool rotw = rope && ((wc & 1) == 0); const float sgn = fq == 0 ? -1.f : 1.f; const bool rotl = fq < 2;
        float rs[2][4];
#pragma unroll
        for (int ai = 0; ai < 2; ++ai)
#pragma unroll
            for (int m = 0; m < 4; ++m) rs[ai][m] = SS[row0 + ai * HALF + m * 16];
        f32x4 nc0, nc1, ns0, ns1;
        if (rotw) { const float* rp = ROPE + (size_t)(row0 & 4095) * 16; nc0 = *(const f32x4*)rp; nc1 = *(const f32x4*)(rp + 4); ns0 = *(const f32x4*)(rp + 8); ns1 = *(const f32x4*)(rp + 12); }
#pragma unroll
        for (int ai = 0; ai < 2; ++ai)
#pragma unroll
            for (int m = 0; m < 4; ++m) { const int row = row0 + ai * HALF + m * 16; const float r = 1.0f / sqrtf(rs[ai][m] * (1.f / DM) + RMS_EPS);
                const f32x4 c0 = nc0, c1 = nc1, s0 = ns0, s1 = ns1;
                if (rotw && (ai * 4 + m) < 7) { const int nrow = row0 + ((ai * 4 + m + 1) >> 2) * HALF + ((ai * 4 + m + 1) & 3) * 16; const float* rp = ROPE + (size_t)(nrow & 4095) * 16; nc0 = *(const f32x4*)rp; nc1 = *(const f32x4*)(rp + 4); ns0 = *(const f32x4*)(rp + 8); ns1 = *(const f32x4*)(rp + 12); }
#pragma unroll
                for (int bj = 0; bj < 2; ++bj) { f32x4 v0 = acc[ai][bj][m][0] * r, v1 = acc[ai][bj][m][1] * r;
                    if (rotw) {
#pragma unroll
                        for (int j = 0; j < 4; ++j) { const float p0 = __shfl_xor(v0[j], 16), p1 = __shfl_xor(v1[j], 16);
                            const float n0 = v0[j] * c0[j] + sgn * p0 * s0[j], n1 = v1[j] * c1[j] + sgn * p1 * s1[j];
                            v0[j] = rotl ? n0 : v0[j]; v1[j] = rotl ? n1 : v1[j]; } }
                    if (gate) {
#pragma unroll
                        for (int j = 0; j < 4; ++j) { v0[j] = silu_fast(v0[j]); v1[j] = silu_fast(v1[j]); } }
                    v0 = v0 * osc; v1 = v1 * osc;
                    *(u32x4*)(base + hm_off(row, col0 + bj * HALF, pitch >> 6)) = pack8(v0, v1); } }
    }
};
template <bool FIRST> struct EpiRes {
    static constexpr bool PERM = true, AFTER_DRAIN = false;
    const float* xin; bf16_t* XB; float* SS;
    __device__ __forceinline__ void operator()(const f32x4 (&acc)[2][2][4][2], const Unit& u, int wr, int wc, int fr, int fq) const {
        const int row0 = u.pm * BM + wr * 64 + fr, col0 = u.pn * BM + wc * 32 + 8 * fq;
        if (FIRST) {
            f32x4 nx[2][2];
#pragma unroll
            for (int bj = 0; bj < 2; ++bj)
#pragma unroll
                for (int n = 0; n < 2; ++n) nx[bj][n] = *(const f32x4*)(xin + (size_t)row0 * DM + col0 + bj * HALF + n * 4);
#pragma unroll
            for (int ai = 0; ai < 2; ++ai)
#pragma unroll
                for (int m = 0; m < 4; ++m) { const int row = row0 + ai * HALF + m * 16; float ss = 0.f;
                    f32x4 cx[2][2];
#pragma unroll
                    for (int bj = 0; bj < 2; ++bj)
#pragma unroll
                        for (int n = 0; n < 2; ++n) cx[bj][n] = nx[bj][n];
                    if ((ai * 4 + m) < 7) { const int nrow = row0 + ((ai * 4 + m + 1) >> 2) * HALF + ((ai * 4 + m + 1) & 3) * 16;
#pragma unroll
                        for (int bj = 0; bj < 2; ++bj)
#pragma unroll
                            for (int n = 0; n < 2; ++n) nx[bj][n] = *(const f32x4*)(xin + (size_t)nrow * DM + col0 + bj * HALF + n * 4); }
#pragma unroll
                    for (int bj = 0; bj < 2; ++bj) { const f32x4 x0 = cx[bj][0] + acc[ai][bj][m][0], x1 = cx[bj][1] + acc[ai][bj][m][1];
                        *(u32x4*)(XB + tiled_off(row, col0 + bj * HALF)) = pack8(x0, x1);
                        ss += ((x0[0] * x0[0] + x0[1] * x0[1]) + (x0[2] * x0[2] + x0[3] * x0[3])) + ((x1[0] * x1[0] + x1[1] * x1[1]) + (x1[2] * x1[2] + x1[3] * x1[3])); }
                    ss += __shfl_xor(ss, 16); ss += __shfl_xor(ss, 32); if (fq == 0) atomicAdd(SS + row, ss); }
        } else {
            u32x4 xv[2][4][2];
#pragma unroll
            for (int ai = 0; ai < 2; ++ai)
#pragma unroll
                for (int m = 0; m < 4; ++m)
#pragma unroll
                    for (int bj = 0; bj < 2; ++bj) xv[ai][m][bj] = *(const u32x4*)(XB + tiled_off(row0 + ai * HALF + m * 16, col0 + bj * HALF));
#pragma unroll
            for (int ai = 0; ai < 2; ++ai)
#pragma unroll
                for (int m = 0; m < 4; ++m)
#pragma unroll
                    for (int bj = 0; bj < 2; ++bj) { const u32x4 xw = xv[ai][m][bj]; const f32x4 a0 = acc[ai][bj][m][0], a1 = acc[ai][bj][m][1];
                        const f32x4 y0 = {__uint_as_float(xw.x << 16) + a0[0], __uint_as_float(xw.x & 0xffff0000u) + a0[1], __uint_as_float(xw.y << 16) + a0[2], __uint_as_float(xw.y & 0xffff0000u) + a0[3]};
                        const f32x4 y1 = {__uint_as_float(xw.z << 16) + a1[0], __uint_as_float(xw.z & 0xffff0000u) + a1[1], __uint_as_float(xw.w << 16) + a1[2], __uint_as_float(xw.w & 0xffff0000u) + a1[3]};
                        *(u32x4*)(XB + tiled_off(row0 + ai * HALF + m * 16, col0 + bj * HALF)) = pack8(y0, y1); }
        }
    }
};
template <class Epi, class Sched, bool ALIGN_EPI = false, bool SP2 = false>
__device__ __forceinline__ void gemm_phase(PG8_LAS unsigned char* lds, const Gemm g, const Sched& S, const Epi& E) {
    const int tid = threadIdx.x, wid = __builtin_amdgcn_readfirstlane(tid >> 6), lane = tid & 63, wr = wid >> 2, wc = wid & 3, fr = lane & 15, fq = lane >> 4;
    const int K = g.K, nt = K / BK;
    unsigned voffA[2], voffB[2];
#pragma unroll
    for (int i = 0; i < 2; ++i) { int R, C; stage_rc(tid * 16 + i * 8192, R, C); const int Rb = Epi::PERM ? ((R & ~31) + perm32(R & 31)) : R;
        voffA[i] = (unsigned)((C >> 5) * (BM * 32) + R * 32 + (C & 31)) * 2u; voffB[i] = (unsigned)((C >> 5) * (BM * 32) + Rb * 32 + (C & 31)) * 2u; }
    const size_t kstep = (size_t)(BM * BK * 2);
    const size_t hstep = (size_t)(HALF * 32 * 2);
    const size_t tstep = (size_t)BM * K * 2;
    const unsigned ldsw = (unsigned)wid * 1024u;
    const int aoff = lds_byte(wr * 64 + fr, fq * 8), boff = lds_byte(wc * 32 + fr, fq * 8);
#define PG8_SA(b, h) (((b) * 2 + (h)) * HTB)
#define PG8_SB(b, h) ((4 + (b) * 2 + (h)) * HTB)
#define PG8_STAGE(bufoff, gbase, voff) do { _Pragma("unroll") for (int _i = 0; _i < 2; ++_i) \
        __builtin_amdgcn_global_load_lds((const unsigned*)((const char*)(gbase) + (voff)[_i]), (PG8_LAS unsigned*)(lds + (bufoff) + ldsw + _i * 8192), 16, 0, 0); } while (0)
#define PG8_LDA(dst, b, h) do { _Pragma("unroll") for (int m = 0; m < 4; ++m) _Pragma("unroll") for (int k = 0; k < 2; ++k) dst[m][k] = *(const PG8_LAS bf16x8*)(lds + PG8_SA(b, h) + aoff + m * 2048 + k * 1024); } while (0)
#define PG8_LDB(dst, b, h) do { _Pragma("unroll") for (int n = 0; n < 2; ++n) _Pragma("unroll") for (int k = 0; k < 2; ++k) dst[n][k] = *(const PG8_LAS bf16x8*)(lds + PG8_SB(b, h) + boff + n * 2048 + k * 1024); } while (0)
#define PG8_MMA(ai, bj, At, Bt) do { __builtin_amdgcn_s_setprio(1); _Pragma("unroll") for (int m = 0; m < 4; ++m) _Pragma("unroll") for (int n = 0; n < 2; ++n) _Pragma("unroll") for (int k = 0; k < 2; ++k) \
        acc[ai][bj][m][n] = __builtin_amdgcn_mfma_f32_16x16x32_bf16(Bt[n][k], At[m][k], acc[ai][bj][m][n], 0, 0, 0); __builtin_amdgcn_s_setprio(0); } while (0)
#define PG8_WAIT_V(n) asm volatile("s_waitcnt vmcnt(" #n ")" ::: "memory")
#define PG8_WAIT_L(n) asm volatile("s_waitcnt lgkmcnt(" #n ")" ::: "memory")
#define PG8_BAR __builtin_amdgcn_s_barrier()
#define PG8_SCHED __builtin_amdgcn_sched_barrier(0)
    Unit cur, nxt; int ui = 0;
    if (!S.next(0, cur)) return;
    f32x4 acc[2][2][4][2];
#pragma unroll
    for (int a = 0; a < 2; ++a)
#pragma unroll
        for (int b = 0; b < 2; ++b)
#pragma unroll
            for (int m = 0; m < 4; ++m)
#pragma unroll
                for (int n = 0; n < 2; ++n) acc[a][b][m][n] = (f32x4){0.f, 0.f, 0.f, 0.f};
    bf16x8 At[4][2], B0[2][2], B1[2][2];
    const char* cA = (const char*)g.A + (size_t)cur.lm * tstep; const char* cB = (const char*)g.Bt + (size_t)cur.ln * tstep;
    S.a_ready(cur);
    if constexpr (SP2) {
        PG8_STAGE(PG8_SB(0, 0), cB, voffB); PG8_STAGE(PG8_SB(0, 1), cB + hstep, voffB); PG8_STAGE(PG8_SA(0, 0), cA, voffA); PG8_STAGE(PG8_SA(0, 1), cA + hstep, voffA);
        if (wr == 1) PG8_BAR;
        PG8_WAIT_V(2); PG8_BAR;
        PG8_STAGE(PG8_SB(1, 0), cB + kstep, voffB); PG8_STAGE(PG8_SA(1, 0), cA + kstep, voffA); PG8_STAGE(PG8_SB(1, 1), cB + hstep + kstep, voffB);
        PG8_WAIT_V(6); PG8_BAR;
    } else {
        PG8_STAGE(PG8_SB(0, 0), cB, voffB); PG8_STAGE(PG8_SA(0, 0), cA, voffA); PG8_STAGE(PG8_SB(0, 1), cB + hstep, voffB); PG8_STAGE(PG8_SA(0, 1), cA + hstep, voffA);
        if (wr == 1) PG8_BAR;
        PG8_WAIT_V(4); PG8_BAR;
        PG8_STAGE(PG8_SB(1, 0), cB + kstep, voffB); PG8_STAGE(PG8_SA(1, 0), cA + kstep, voffA); PG8_STAGE(PG8_SB(1, 1), cB + hstep + kstep, voffB);
        PG8_WAIT_V(6); PG8_BAR;
    }
    for (;;) {
        const bool has_next = S.next(ui + 1, nxt);
        const char* nA = has_next ? (const char*)g.A + (size_t)nxt.lm * tstep : cA; const char* nB = has_next ? (const char*)g.Bt + (size_t)nxt.ln * tstep : cB;
        for (int t = 0; t < nt; t += 2) {
            const bool last = (t == nt - 2);
            const char* a1 = cA + (size_t)(t + 1) * kstep;
            const char* a2 = last ? nA : cA + (size_t)(t + 2) * kstep; const char* b2 = last ? nB : cB + (size_t)(t + 2) * kstep;
            const char* a3 = a2 + kstep; const char* b3 = b2 + kstep;
            if (last && has_next) S.a_ready(nxt);
            if constexpr (SP2) {
            PG8_LDB(B0, 0, 0); PG8_LDB(B1, 0, 1); PG8_SCHED; PG8_LDA(At, 0, 0); PG8_STAGE(PG8_SA(1, 1), a1 + hstep, voffA);
            PG8_WAIT_V(8); PG8_WAIT_L(0); PG8_BAR; PG8_MMA(0, 0, At, B0); PG8_MMA(0, 1, At, B1); PG8_BAR; PG8_SCHED;
            PG8_LDA(At, 0, 1); PG8_STAGE(PG8_SB(0, 0), b2, voffB); PG8_STAGE(PG8_SB(0, 1), b2 + hstep, voffB); PG8_STAGE(PG8_SA(0, 0), a2, voffA);
            PG8_WAIT_V(8); PG8_WAIT_L(0); PG8_BAR; PG8_MMA(1, 0, At, B0); PG8_MMA(1, 1, At, B1); PG8_BAR; PG8_SCHED;
            PG8_LDB(B0, 1, 0); PG8_LDB(B1, 1, 1); PG8_SCHED; PG8_LDA(At, 1, 0); PG8_STAGE(PG8_SA(0, 1), a2 + hstep, voffA);
            PG8_WAIT_V(8); PG8_WAIT_L(0); PG8_BAR; PG8_MMA(0, 0, At, B0); PG8_MMA(0, 1, At, B1); PG8_BAR; PG8_SCHED;
            PG8_LDA(At, 1, 1); PG8_STAGE(PG8_SB(1, 0), b3, voffB); PG8_STAGE(PG8_SB(1, 1), b3 + hstep, voffB); PG8_STAGE(PG8_SA(1, 0), a3, voffA);
            PG8_WAIT_V(8); PG8_WAIT_L(0); PG8_BAR; PG8_MMA(1, 0, At, B0); PG8_MMA(1, 1, At, B1); PG8_BAR; PG8_SCHED;
            } else {
            PG8_LDB(B0, 0, 0); PG8_SCHED; PG8_LDA(At, 0, 0); PG8_STAGE(PG8_SA(1, 1), a1 + hstep, voffA);
            PG8_WAIT_L(8); PG8_BAR; PG8_WAIT_L(0); PG8_MMA(0, 0, At, B0); PG8_BAR; PG8_SCHED;
            PG8_LDB(B1, 0, 1); PG8_STAGE(PG8_SB(0, 0), b2, voffB);
            PG8_BAR; PG8_WAIT_L(0); PG8_MMA(0, 1, At, B1); PG8_BAR;
            PG8_LDA(At, 0, 1); PG8_STAGE(PG8_SA(0, 0), a2, voffA);
            PG8_BAR; PG8_WAIT_L(0); PG8_MMA(1, 0, At, B0); PG8_BAR; PG8_SCHED;
            PG8_STAGE(PG8_SB(0, 1), b2 + hstep, voffB);
            PG8_WAIT_V(6); PG8_BAR; PG8_MMA(1, 1, At, B1); PG8_BAR;
            PG8_LDB(B0, 1, 0); PG8_SCHED; PG8_LDA(At, 1, 0); PG8_STAGE(PG8_SA(0, 1), a2 + hstep, voffA);
            PG8_WAIT_L(8); PG8_BAR; PG8_WAIT_L(0); PG8_MMA(0, 0, At, B0); PG8_BAR; PG8_SCHED;
            PG8_LDB(B1, 1, 1); PG8_STAGE(PG8_SB(1, 0), b3, voffB);
            PG8_BAR; PG8_WAIT_L(0); PG8_MMA(0, 1, At, B1); PG8_BAR;
            PG8_LDA(At, 1, 1); PG8_STAGE(PG8_SA(1, 0), a3, voffA);
            PG8_BAR; PG8_WAIT_L(0); PG8_MMA(1, 0, At, B0); PG8_BAR; PG8_SCHED;
            PG8_STAGE(PG8_SB(1, 1), b3 + hstep, voffB);
            PG8_WAIT_V(6); PG8_BAR; PG8_MMA(1, 1, At, B1); PG8_BAR;
            }
        }
        if constexpr (ALIGN_EPI) { if (wr == 0) PG8_BAR; }
        if constexpr (!Epi::AFTER_DRAIN) { E(acc, cur, wr, wc, fr, fq); if (S.epi2) E(acc, cur, wr, wc, fr, fq); S.done(cur); }
        if (!has_next) break;
#pragma unroll
        for (int a = 0; a < 2; ++a)
#pragma unroll
            for (int b = 0; b < 2; ++b)
#pragma unroll
                for (int m = 0; m < 4; ++m)
#pragma unroll
                    for (int n = 0; n < 2; ++n) acc[a][b][m][n] = (f32x4){0.f, 0.f, 0.f, 0.f};
        cur = nxt; cA = nA; cB = nB; ++ui;
        if constexpr (ALIGN_EPI) { if (wr == 1) PG8_BAR; }
    }
    PG8_WAIT_V(0);
    if constexpr (!ALIGN_EPI) { if (wr == 0) PG8_BAR; }
    PG8_BAR;
    if constexpr (Epi::AFTER_DRAIN) { E.fused(acc, cur, wr, wc, fr, fq, lds, wid, lane); S.done(cur); }
#undef PG8_SA
#undef PG8_SB
#undef PG8_STAGE
#undef PG8_LDA
#undef PG8_LDB
#undef PG8_MMA
#undef PG8_WAIT_V
#undef PG8_WAIT_L
#undef PG8_BAR
#undef PG8_SCHED
}
}
namespace fa {
#define FA_LAS __attribute__((address_space(3)))
typedef short bf16x8 __attribute__((ext_vector_type(8)));
typedef short s16x4 __attribute__((ext_vector_type(4)));
typedef short v4i16_t __attribute__((ext_vector_type(4)));
typedef float f32x16 __attribute__((ext_vector_type(16)));
typedef float f32x4 __attribute__((ext_vector_type(4)));
typedef unsigned u32x4 __attribute__((ext_vector_type(4)));
typedef float f32x2_t __attribute__((ext_vector_type(2))); typedef __bf16 bf16x2_t __attribute__((ext_vector_type(2)));
constexpr float THR = 8.f, TH_SKIP = 32.f;
constexpr int F_KBUF = 18432, F_AOFF = 8192, F_VOFF = 10240, F_WSF = 3 * F_KBUF, F_FLAG = F_WSF + 8 * 256, F_OST = F_FLAG + 256, F_LDS_BYTES = F_OST + 8 * 4096;
constexpr int S_KBUF = 16384, S_VOFF = 8192, S_WSF = 6 * S_KBUF, S_OST = S_WSF + 8 * 256, S_LDS_BYTES = S_OST + 8 * 4096;
struct Params { const bf16_t* Q; const bf16_t* K; const bf16_t* V; const bf16_t* G; bf16_t* O; const float* CUM; const float* sinks; const unsigned* KMAX; unsigned* ticket; const bf16_t* KAUG; };
__device__ __forceinline__ unsigned cvtpk(float lo, float hi) { f32x2_t v = {lo, hi}; bf16x2_t b = __builtin_convertvector(v, bf16x2_t); return __builtin_bit_cast(unsigned, b); }
__device__ __forceinline__ s16x4 vtr(FA_LAS unsigned char* p) { return __builtin_bit_cast(s16x4, __builtin_amdgcn_ds_read_tr16_b64_v4i16((FA_LAS v4i16_t*)p)); }
__device__ __forceinline__ float swap_max(float v) { auto rr = __builtin_amdgcn_permlane32_swap(__float_as_uint(v), __float_as_uint(v), false, false); return __builtin_fmaxf(__uint_as_float(rr[0]), __uint_as_float(rr[1])); }
__device__ __forceinline__ float swap_add(float v) { auto rr = __builtin_amdgcn_permlane32_swap(__float_as_uint(v), __float_as_uint(v), false, false); return __uint_as_float(rr[0]) + __uint_as_float(rr[1]); }
__device__ __forceinline__ void glds16(const void* gsrc, unsigned lds_dst) { unsigned keep;
    asm volatile("s_mov_b32 %0, m0\n\ts_mov_b32 m0, %2\n\ts_nop 0\n\tglobal_load_lds_dwordx4 %1, off\n\ts_mov_b32 m0, %0" : "=&s"(keep) : "v"(gsrc), "s"(lds_dst) : "memory"); }
#define FA_MFMA(a, b, c) __builtin_amdgcn_mfma_f32_32x32x16_bf16((a), (b), (c), 0, 0, 0)
#define FA_MX3(a, b, c) __builtin_fmaxf(__builtin_fmaxf((a), (b)), (c))
struct WaveSt { bf16x8 qr[4]; bf16x8 qa; f32x16 cinit, o0, o1; float cq, mhat, lsum, mrun; };

#define FA_SBAR() __builtin_amdgcn_sched_barrier(0)
#define FA_PIN(x) asm volatile("" : "+v"(x))
#define FA_LDK(p) (*(FA_LAS bf16x8*)(p))
#define FA_VF(l, h) ((bf16x8){l[0], l[1], l[2], l[3], h[0], h[1], h[2], h[3]})
#define FA_EX4(X, B) do { X[B] = __builtin_amdgcn_exp2f(X[B]); X[B + 1] = __builtin_amdgcn_exp2f(X[B + 1]); X[B + 2] = __builtin_amdgcn_exp2f(X[B + 2]); X[B + 3] = __builtin_amdgcn_exp2f(X[B + 3]); } while (0)
__device__ __forceinline__ void split3(float v, unsigned& h1, unsigned& h2, unsigned& h3) { const bf16_t a = f2bf(v); const float r1 = v - bf2f(a); const bf16_t b = f2bf(r1); const float r2 = r1 - bf2f(b); h1 = a; h2 = b; h3 = f2bf(r2); }
__device__ __forceinline__ void set_qa(WaveSt& w, int hi) {
    unsigned g1, g2, g3; split3(w.cq - w.mhat, g1, g2, g3);
    const u32x4 q = {hi == 0 ? 0x3F803F80u : 0u, hi == 0 ? (0x3F80u | (g1 << 16)) : 0u, hi == 0 ? (g2 | (g3 << 16)) : 0u, 0u};
    w.qa = __builtin_bit_cast(bf16x8, q);
}
template <int MODE, int AOFF, int VOFF, int HB>
__device__ __forceinline__ void half_step(FA_LAS unsigned char* bb, FA_LAS unsigned char* vprev, FA_LAS float* wsf, WaveSt& w, f32x16& C, f32x16& P, int k0, int t, int qlo, int lane, int r32, int hi) {
    constexpr int W = MODE == 0 ? 0x40000000 : 128;
    FA_LAS unsigned char* kp = bb + hi * 1024 + r32 * 16 + HB * 512; FA_LAS unsigned char* ap = bb + AOFF + r32 * 16 + HB * 512;
    FA_LAS unsigned char* vp = (HB == 0 ? vprev + 2048 : bb) + VOFF + ((lane >> 4) & 1) * 32 + (lane & 3) * 8 + (4 * hi + ((lane & 15) >> 2)) * 64;
    bf16x8 kf0 = FA_LDK(kp), kf1 = FA_LDK(kp + 2048), kf2, kf3, ka;
    s16x4 vl0, vh0, vl1, vh1, vl2, vh2, vl3, vh3; u32x4 pw0, pw1; float sacc;
    FA_SBAR();
    if (MODE == 0) C = FA_MFMA(kf0, w.qr[0], ((f32x16){0.f, 0.f, 0.f, 0.f, 0.f, 0.f, 0.f, 0.f, 0.f, 0.f, 0.f, 0.f, 0.f, 0.f, 0.f, 0.f})); else C = FA_MFMA(kf0, w.qr[0], w.cinit);
    kf2 = FA_LDK(kp + 4096);
    sacc = (P[0] + P[1]) + (P[2] + P[3]); pw0.x = cvtpk(P[0], P[1]); pw0.y = cvtpk(P[2], P[3]); FA_PIN(sacc); FA_PIN(pw0.x); FA_PIN(pw0.y);
    FA_SBAR();
    C = FA_MFMA(kf1, w.qr[1], C); kf3 = FA_LDK(kp + 6144);
    sacc += P[4]; sacc += P[5]; sacc += P[6]; sacc += P[7]; pw0.z = cvtpk(P[4], P[5]); pw0.w = cvtpk(P[6], P[7]); FA_PIN(sacc); FA_PIN(pw0.z); FA_PIN(pw0.w);
    FA_SBAR();
    C = FA_MFMA(kf2, w.qr[2], C); if (MODE == 0) ka = FA_LDK(ap);
    sacc += P[8]; sacc += P[9]; sacc += P[10]; sacc += P[11]; pw1.x = cvtpk(P[8], P[9]); pw1.y = cvtpk(P[10], P[11]); FA_PIN(sacc); FA_PIN(pw1.x); FA_PIN(pw1.y); vl0 = vtr(vp); vh0 = vtr(vp + 512);
    FA_SBAR();
    C = FA_MFMA(kf3, w.qr[3], C);
    sacc += P[12]; sacc += P[13]; sacc += P[14]; sacc += P[15]; pw1.z = cvtpk(P[12], P[13]); pw1.w = cvtpk(P[14], P[15]); FA_PIN(sacc); FA_PIN(pw1.z); FA_PIN(pw1.w); vl1 = vtr(vp + 4096); vh1 = vtr(vp + 4096 + 512);
    FA_SBAR();
    if (MODE == 0) { C = FA_MFMA(ka, w.qa, C); FA_SBAR(); }
    w.lsum += sacc;
    const bf16x8 pa0 = __builtin_bit_cast(bf16x8, pw0), pa1 = __builtin_bit_cast(bf16x8, pw1);
    vl2 = vtr(vp + 1024); vh2 = vtr(vp + 1024 + 512);
    w.o0 = FA_MFMA(pa0, FA_VF(vl0, vh0), w.o0); vl3 = vtr(vp + 4096 + 1024); vh3 = vtr(vp + 4096 + 1024 + 512);
    w.o1 = FA_MFMA(pa0, FA_VF(vl1, vh1), w.o1);
    FA_SBAR();
    const int kh = k0 + 32 * HB;
    if ((kh + 31 > qlo) || (MODE == 1 && kh <= qlo + 31 - W)) {
        const float NEG = -__builtin_inff(); const int dq = t - kh - 4 * hi;
#pragma unroll
        for (int r = 0; r < 16; ++r) { const int c = (r & 3) + 8 * (r >> 2); if ((unsigned)(dq - c) >= (unsigned)W) C[r] = NEG; }
    }
    float ma = FA_MX3(C[0], C[1], C[2]), mb = FA_MX3(C[3], C[4], C[5]);
    ma = FA_MX3(ma, C[6], C[7]); mb = FA_MX3(mb, C[8], C[9]); ma = FA_MX3(ma, C[10], C[11]); mb = FA_MX3(mb, C[12], C[13]); ma = FA_MX3(ma, C[14], C[15]);
    const float rm = swap_max(__builtin_fmaxf(ma, mb));
    if (MODE == 0) w.mrun = __builtin_fmaxf(w.mrun, rm + w.mhat);
    const bool resc = __any(rm > THR);
    if (resc) {
        const float dl = __builtin_fmaxf(rm, 0.f); w.mhat += dl;
#pragma unroll
        for (int r = 0; r < 16; ++r) C[r] -= dl;
        if (MODE == 0) set_qa(w, hi);
        else { const float ci = w.cq - w.mhat;
#pragma unroll
            for (int r = 0; r < 16; ++r) w.cinit[r] = ci; }
        const float f = __builtin_amdgcn_exp2f(-dl); w.lsum *= f;
        if (hi == 0) wsf[r32] = f;
    }
    FA_SBAR();
    FA_EX4(C, 0); FA_PIN(C);
    w.o0 = FA_MFMA(pa1, FA_VF(vl2, vh2), w.o0); FA_EX4(C, 4); FA_EX4(C, 8); FA_PIN(C); FA_SBAR();
    w.o1 = FA_MFMA(pa1, FA_VF(vl3, vh3), w.o1); FA_EX4(C, 12); FA_PIN(C); FA_SBAR();
    if (resc) {
        asm volatile("s_waitcnt lgkmcnt(0)" ::: "memory");
#pragma unroll
        for (int g = 0; g < 4; ++g) { const f32x4 a4 = *(FA_LAS f32x4*)(wsf + 8 * g + 4 * hi);
#pragma unroll
            for (int i = 0; i < 4; ++i) { w.o0[4 * g + i] *= a4[i]; w.o1[4 * g + i] *= a4[i]; } }
    }
}
template <int MODE, int AOFF, int VOFF>
__device__ __forceinline__ void tile_step(FA_LAS unsigned char* bb, FA_LAS unsigned char* vprev, FA_LAS float* wsf, WaveSt& w, f32x16& pA, f32x16& pB, int k0, int t, int qlo, int lane, int r32, int hi) {
    half_step<MODE, AOFF, VOFF, 0>(bb, vprev, wsf, w, pA, pB, k0, t, qlo, lane, r32, hi);
    half_step<MODE, AOFF, VOFF, 1>(bb, vprev, wsf, w, pB, pA, k0, t, qlo, lane, r32, hi);
}
template <int VOFF>
__device__ __forceinline__ void tile_drain(FA_LAS unsigned char* vlast, WaveSt& w, f32x16& P, int lane, int hi) {
    FA_LAS unsigned char* vp = vlast + 2048 + VOFF + ((lane >> 4) & 1) * 32 + (lane & 3) * 8 + (4 * hi + ((lane & 15) >> 2)) * 64;
    float s0 = 0.f;
#pragma unroll
    for (int r = 0; r < 16; ++r) s0 += P[r];
    w.lsum += s0;
    const u32x4 w0 = {cvtpk(P[0], P[1]), cvtpk(P[2], P[3]), cvtpk(P[4], P[5]), cvtpk(P[6], P[7])};
    const u32x4 w1 = {cvtpk(P[8], P[9]), cvtpk(P[10], P[11]), cvtpk(P[12], P[13]), cvtpk(P[14], P[15])};
    const bf16x8 pa0 = __builtin_bit_cast(bf16x8, w0), pa1 = __builtin_bit_cast(bf16x8, w1);
    { const s16x4 l0 = vtr(vp), h0 = vtr(vp + 512), l1 = vtr(vp + 4096), h1 = vtr(vp + 4096 + 512); w.o0 = FA_MFMA(pa0, FA_VF(l0, h0), w.o0); w.o1 = FA_MFMA(pa0, FA_VF(l1, h1), w.o1); }
    { const s16x4 l0 = vtr(vp + 1024), h0 = vtr(vp + 1024 + 512), l1 = vtr(vp + 4096 + 1024), h1 = vtr(vp + 4096 + 1024 + 512); w.o0 = FA_MFMA(pa1, FA_VF(l0, h0), w.o0); w.o1 = FA_MFMA(pa1, FA_VF(l1, h1), w.o1); }
}
__device__ __forceinline__ void load_gate(u32x4 (&gq)[4], const bf16_t* G, size_t grow, int h, int lane) {
#pragma unroll
    for (int d0 = 0; d0 < 2; ++d0)
#pragma unroll
        for (int i = 0; i < 2; ++i) gq[2 * d0 + i] = *(const u32x4*)(G + hm_off((int)grow + i * 16 + (lane >> 2), h * 64 + d0 * 32 + (lane & 3) * 8, NH));
}
__device__ __forceinline__ void wave_epilogue(FA_LAS float* stg, FA_LAS float* wsf, WaveSt& w, const u32x4 (&gq)[4], bf16_t* O, size_t grow, int h, int lane, int r32, int hi) {
    const float l = swap_add(w.lsum);
    if (hi == 0) wsf[r32] = l;
    asm volatile("s_waitcnt lgkmcnt(0)" ::: "memory");
    float rl[16];
#pragma unroll
    for (int g = 0; g < 4; ++g) { const f32x4 l4 = *(FA_LAS f32x4*)(wsf + 8 * g + 4 * hi);
#pragma unroll
        for (int i = 0; i < 4; ++i) rl[4 * g + i] = 1.0f / l4[i]; }
#pragma unroll
    for (int d0 = 0; d0 < 2; ++d0) {
#pragma unroll
        for (int g = 0; g < 4; ++g)
#pragma unroll
            for (int i = 0; i < 4; ++i) stg[(8 * g + 4 * hi + i) * 32 + r32] = (d0 == 0 ? w.o0[4 * g + i] : w.o1[4 * g + i]) * rl[4 * g + i];
        asm volatile("s_waitcnt lgkmcnt(0)" ::: "memory");
#pragma unroll
        for (int i = 0; i < 2; ++i) { const int row = i * 16 + (lane >> 2), ch = lane & 3;
            const f32x4 x0 = *(FA_LAS f32x4*)(stg + row * 32 + ch * 8), x1 = *(FA_LAS f32x4*)(stg + row * 32 + ch * 8 + 4);
            const size_t ga = (grow + row) * DM + h * 64 + d0 * 32 + ch * 8; const u32x4 gv = gq[2 * d0 + i];
            u32x4 ov;
            ov.x = cvtpk(x0[0] * __uint_as_float(gv.x << 16), x0[1] * __uint_as_float(gv.x & 0xffff0000u)); ov.y = cvtpk(x0[2] * __uint_as_float(gv.y << 16), x0[3] * __uint_as_float(gv.y & 0xffff0000u));
            ov.z = cvtpk(x1[0] * __uint_as_float(gv.z << 16), x1[1] * __uint_as_float(gv.z & 0xffff0000u)); ov.w = cvtpk(x1[2] * __uint_as_float(gv.w << 16), x1[3] * __uint_as_float(gv.w & 0xffff0000u));
            *(u32x4*)(O + tiled_off((int)(grow + row), h * 64 + d0 * 32 + ch * 8)) = ov; }
        asm volatile("s_waitcnt lgkmcnt(0)" ::: "memory");
    }
}
template <int MODE> __device__ __forceinline__ void wave_init(WaveSt& w, int hi) {
#pragma unroll
    for (int r = 0; r < 16; ++r) { w.o0[r] = 0.f; w.o1[r] = 0.f; }
    if (MODE == 0) set_qa(w, hi);
    else { const float ci = w.cq - w.mhat;
#pragma unroll
        for (int r = 0; r < 16; ++r) w.cinit[r] = ci; }
}

__device__ __forceinline__ void fox_unit(FA_LAS unsigned char* lds, const Params& P, int b, int h, int qb) {
    const int tid = threadIdx.x, lane = tid & 63, r32 = lane & 31, hi = lane >> 5;
    const int wid = __builtin_amdgcn_readfirstlane(tid >> 6);
    const int q0 = qb * 256, qlo = q0 + wid * 32, t = qlo + r32;
    const size_t rowbase = (size_t)b * SEQ;
    const bf16_t* ksrc = P.K + hm_off((int)rowbase + lane, h * 64 + wid * 8, NH);
    const bf16_t* vsrc = P.V + hm_off((int)rowbase + 16 * (wid & 3) + (lane >> 2), h * 64 + (wid >> 2) * 32 + (lane & 3) * 8, NH);
    const float* cum = P.CUM + (size_t)(b * NH + h) * SEQ;
    const bf16_t* asrc = P.KAUG + ((size_t)(b * NH + h) * SEQ + lane) * 8;
    const int NT = (q0 + 256) / 64;
    WaveSt w; float qn = 0.f;
#pragma unroll
    for (int d0 = 0; d0 < 4; ++d0) { w.qr[d0] = *(const bf16x8*)(P.Q + hm_off((int)rowbase + t, h * 64 + d0 * 16 + hi * 8, NH));
#pragma unroll
        for (int j = 0; j < 8; ++j) { const float qv = bf2f((bf16_t)w.qr[d0][j]); qn = fmaf(qv, qv, qn); } }
    w.cq = cum[t]; w.mhat = 0.f; w.lsum = 0.f; w.mrun = -1e30f;
    wave_init<0>(w, hi);
    u32x4 gq[4]; load_gate(gq, P.G, rowbase + qlo, h, lane);
    const float qkb = sqrtf(swap_add(qn) * (__uint_as_float(P.KMAX[(b * NH + h) * 2]) + __uint_as_float(P.KMAX[(b * NH + h) * 2 + 1]))) * 1.01f + 1e-3f;
    FA_LAS float* wsf = (FA_LAS float*)(lds + F_WSF) + wid * 64;
    FA_LAS unsigned* votes = (FA_LAS unsigned*)(lds + F_FLAG);
    float cnew = 0.f;
#define FA_LOADT(j, bf) do { const size_t ko_ = (size_t)(j) * 64 * 32; FA_LAS unsigned char* bb_ = lds + (bf) * F_KBUF; \
        glds16(ksrc + ko_, (unsigned)__builtin_amdgcn_readfirstlane((int)(unsigned)(uintptr_t)(bb_ + wid * 1024))); \
        glds16(vsrc + ko_, (unsigned)__builtin_amdgcn_readfirstlane((int)(unsigned)(uintptr_t)(bb_ + F_VOFF + (wid >> 2) * 4096 + (wid & 3) * 1024))); \
        if (wid == 0) glds16(asrc + (size_t)(j) * 64 * 8, (unsigned)__builtin_amdgcn_readfirstlane((int)(unsigned)(uintptr_t)(bb_ + F_AOFF))); \
        cnew = cum[(j) * 64 + 63]; } while (0)
    FA_LOADT(NT - 1, 0); asm volatile("s_waitcnt vmcnt(0)" ::: "memory"); __syncthreads();
    bool wdone = false, pend = false; f32x16 pA, pB;
#pragma unroll
    for (int r = 0; r < 16; ++r) pB[r] = 0.f;
    int cur = 0;
    for (int tt = 0; tt < NT; ++tt) {
        const int j = NT - 1 - tt, k0 = j * 64; const int nxt = cur == 2 ? 0 : cur + 1, prv = cur == 0 ? 2 : cur - 1;
        if (j > 0) FA_LOADT(j - 1, nxt);
        if (!wdone && k0 <= qlo + 31) {
            FA_LAS unsigned char* bb = lds + cur * F_KBUF;
            tile_step<0, F_AOFF, F_VOFF>(bb, pend ? lds + prv * F_KBUF : bb, wsf, w, pA, pB, k0, t, qlo, lane, r32, hi);
            pend = true;
        }
        if (j > 0) {
            if (!wdone && pend && __all(qkb + w.cq - cnew - w.mrun <= -TH_SKIP)) {
                wdone = true; tile_drain<F_VOFF>(lds + cur * F_KBUF, w, pB, lane, hi);
            }
            if (lane == 0) votes[(tt & 1) * 8 + wid] = wdone ? 1u : 0u;
        }
        asm volatile("s_waitcnt vmcnt(0)" ::: "memory");
        __syncthreads();
        if (j > 0) { const u32x4 v0 = *(FA_LAS u32x4*)(votes + (tt & 1) * 8), v1 = *(FA_LAS u32x4*)(votes + (tt & 1) * 8 + 4);
            if ((v0.x & v0.y & v0.z & v0.w & v1.x & v1.y & v1.z & v1.w) != 0u) break; }
        else if (!wdone) tile_drain<F_VOFF>(lds + cur * F_KBUF, w, pB, lane, hi);
        cur = nxt;
    }
#undef FA_LOADT
    wave_epilogue((FA_LAS float*)(lds + F_OST + wid * 4096), wsf, w, gq, P.O, rowbase + qlo, h, lane, r32, hi);
    __syncthreads();
}
__device__ __forceinline__ void swa_unit(FA_LAS unsigned char* lds, const Params& P, int b, int kvh, int qb) {
    const int tid = threadIdx.x, lane = tid & 63, r32 = lane & 31, hi = lane >> 5;
    const int wid = __builtin_amdgcn_readfirstlane(tid >> 6);
    const int q0 = qb * 256, qlo = q0 + wid * 32, t = qlo + r32;
    const size_t rowbase = (size_t)b * SEQ;
    const int j_lo = q0 >= 128 ? (q0 - 128) / 64 : 0, NT = (q0 + 256) / 64 - j_lo;
    const bf16_t* ksrc = P.K + hm_off((int)rowbase + j_lo * 64 + lane, kvh * 64 + wid * 8, 4);
    const bf16_t* vsrc = P.V + hm_off((int)rowbase + j_lo * 64 + 16 * (wid & 3) + (lane >> 2), kvh * 64 + (wid >> 2) * 32 + (lane & 3) * 8, 4);
    const int kdst = wid * 1024 + lane * 16, vdst = S_VOFF + (wid >> 2) * 4096 + (wid & 3) * 1024 + lane * 16;
    { u32x4 sk[6], sv[6];
#pragma unroll
      for (int i = 0; i < 6; ++i) if (i < NT) { sk[i] = *(const u32x4*)(ksrc + (size_t)i * 64 * 32); sv[i] = *(const u32x4*)(vsrc + (size_t)i * 64 * 32); }
#pragma unroll
      for (int i = 0; i < 6; ++i) if (i < NT) { *(FA_LAS u32x4*)(lds + i * S_KBUF + kdst) = sk[i]; *(FA_LAS u32x4*)(lds + i * S_KBUF + vdst) = sv[i]; } }
    __syncthreads();
    FA_LAS float* wsf = (FA_LAS float*)(lds + S_WSF) + wid * 64;
    const int ta = (qlo >= 127 ? (qlo - 127) / 64 : 0) - j_lo, tb = (qlo + 31) / 64 - j_lo;
    bf16x8 qn[4];
#pragma unroll
    for (int d0 = 0; d0 < 4; ++d0) qn[d0] = *(const bf16x8*)(P.Q + hm_off((int)rowbase + t, (kvh * 8) * 64 + d0 * 16 + hi * 8, NH));
    for (int hh = 0; hh < 8; ++hh) {
        const int h = kvh * 8 + hh;
        WaveSt w;
#pragma unroll
        for (int d0 = 0; d0 < 4; ++d0) w.qr[d0] = qn[d0];
#pragma unroll
        for (int d0 = 0; d0 < 4; ++d0) qn[d0] = *(const bf16x8*)(P.Q + hm_off((int)rowbase + t, (kvh * 8 + (hh < 7 ? hh + 1 : hh)) * 64 + d0 * 16 + hi * 8, NH));
        u32x4 gq[4]; load_gate(gq, P.G, rowbase + qlo, h, lane);
        w.cq = 0.f; w.mhat = P.sinks[h] * LOG2E; w.lsum = 0.5f; w.mrun = 0.f;
        wave_init<1>(w, hi);
        f32x16 pA, pB;
#pragma unroll
        for (int r = 0; r < 16; ++r) pB[r] = 0.f;
        for (int ti = tb; ti >= ta; --ti) { FA_LAS unsigned char* bb = lds + ti * S_KBUF;
            tile_step<1, 0, S_VOFF>(bb, ti == tb ? bb : bb + S_KBUF, wsf, w, pA, pB, (j_lo + ti) * 64, t, qlo, lane, r32, hi); }
        tile_drain<S_VOFF>(lds + ta * S_KBUF, w, pB, lane, hi);
        wave_epilogue((FA_LAS float*)(lds + S_OST + wid * 4096), wsf, w, gq, P.O, rowbase + qlo, h, lane, r32, hi);
    }
    __syncthreads();
}
}
#define GAS __attribute__((address_space(1)))
#define LAS __attribute__((address_space(3)))
typedef unsigned short bf16;
typedef unsigned v4u __attribute__((ext_vector_type(4)));
typedef float f32x4 __attribute__((ext_vector_type(4)));
typedef short bf16x8 __attribute__((ext_vector_type(8)));
typedef GAS unsigned gu32;
typedef GAS unsigned long long gu64;
#define RLX_AGENT __ATOMIC_RELAXED, __HIP_MEMORY_SCOPE_AGENT
#define LDS_WAIT() asm volatile("s_waitcnt lgkmcnt(0)" ::: "memory")
#define VM_WAIT() asm volatile("s_waitcnt vmcnt(0)" ::: "memory")
__device__ __forceinline__ unsigned long long rt() { return __builtin_amdgcn_s_memrealtime(); }
__device__ __forceinline__ unsigned pk2(float lo, float hi) { return (unsigned)f2bf(lo) | ((unsigned)f2bf(hi) << 16); }
#define XB_TMO      128
#define XB_XCNT(j)  (256  + 64 * (j))
#define XB_XSUB(j)  (1280 + 64 * (j))
#define XB_XGEN(j)  (2304 + 64 * (j))
#define XB_TOP      3328
#define XB_TOPGEN   3392
#define XCD_BAR_WORDS 3456
#define XB_SPIN_CAP (1u << 18)

__device__ __forceinline__ unsigned xb_ld(unsigned* p)              { return __hip_atomic_load(p, __ATOMIC_RELAXED, __HIP_MEMORY_SCOPE_AGENT); }
__device__ __forceinline__ unsigned xb_add(unsigned* p, unsigned v) { return __hip_atomic_fetch_add(p, v, __ATOMIC_RELAXED, __HIP_MEMORY_SCOPE_AGENT); }
__device__ __forceinline__ unsigned xb_xcc_id() { return (unsigned)__builtin_amdgcn_s_getreg((3 << 11) | 20) & 0xFu; }
#define XB_SPIN(cond, bar) do { unsigned _sp = 0; while (cond) { __builtin_amdgcn_s_sleep(1); \
    if ((++_sp & 255u) == 0u) { if (xb_ld(&(bar)[XB_TMO])) break; if (_sp > XB_SPIN_CAP) { atomicAdd(&(bar)[XB_TMO], 1u); break; } } } } while (0)

struct XcdBarrier {
    unsigned* bar; unsigned x;
    volatile LAS unsigned* st;
};

__device__ __forceinline__ XcdBarrier xcd_barrier_post(unsigned* bar, volatile LAS unsigned* st) {
    XcdBarrier b; b.bar = bar; b.x = xb_xcc_id(); b.st = st;
    if (threadIdx.x == 0) (void)xb_add(&bar[XB_XCNT(b.x)], 1u);
    return b;
}
__device__ __forceinline__ void xcd_barrier_complete(unsigned* bar, unsigned x, unsigned& nloc, unsigned& nx) {
    const unsigned G = gridDim.x * gridDim.y * gridDim.z;
    unsigned sum, cnt, mine, sp = 0u;
    for (;;) {
        sum = 0u; cnt = 0u; mine = 0u;
#pragma unroll
        for (unsigned j = 0; j < 16; ++j) { const unsigned c = xb_ld(&bar[XB_XCNT(j)]); sum += c; cnt += (c > 0u) ? 1u : 0u; mine = (j == x) ? c : mine; }
        if (sum == G) break;
        __builtin_amdgcn_s_sleep(1);
        if ((++sp & 255u) == 0u) { if (xb_ld(&bar[XB_TMO])) break; if (sp > XB_SPIN_CAP) { atomicAdd(&bar[XB_TMO], 1u); break; } }
    }
    nloc = mine > 0u ? mine : 1u; nx = cnt > 0u ? cnt : 1u;
}

__device__ __forceinline__ void xcd_barrier(const XcdBarrier& b) {
    asm volatile("s_waitcnt vmcnt(0)" ::: "memory");
    __syncthreads();
    if (threadIdx.x == 0) {
        unsigned* bar = b.bar;
        __builtin_amdgcn_s_waitcnt(0);
        unsigned nloc = b.st[0], nx = b.st[1];
        if (nloc == 0u) { xcd_barrier_complete(bar, b.x, nloc, nx); b.st[0] = nloc; b.st[1] = nx; }
        const unsigned old = xb_add(&bar[XB_XSUB(b.x)], 1u);
        const unsigned gen = old / nloc;
        if (old + 1u == (gen + 1u) * nloc) {
            __builtin_amdgcn_fence(__ATOMIC_RELEASE, "agent");
            asm volatile("s_waitcnt vmcnt(0)" ::: "memory");
            const unsigned og = xb_add(&bar[XB_TOP], 1u);
            const unsigned tg = og / nx;
            if (og + 1u == (tg + 1u) * nx) xb_add(&bar[XB_TOPGEN], 1u);
            else XB_SPIN(xb_ld(&bar[XB_TOPGEN]) == tg, bar);
            __builtin_amdgcn_fence(__ATOMIC_ACQUIRE, "agent");
            xb_add(&bar[XB_XGEN(b.x)], 1u);
            asm volatile("s_waitcnt vmcnt(0)" ::: "memory");
        } else {
            XB_SPIN(xb_ld(&bar[XB_XGEN(b.x)]) == gen, bar);
            __builtin_amdgcn_fence(__ATOMIC_ACQUIRE, "agent");
            asm volatile("s_waitcnt vmcnt(0)" ::: "memory");
        }
    }
    __syncthreads();
}
constexpr int NWAVES = 8;
constexpr int N1P = 8448;
constexpr int RING_OFF = 0, RING_BYTES = 135168;
constexpr int LDSCTL_OFF = RING_BYTES, MISC_OFF = LDSCTL_OFF + 320;
constexpr int LDS_BYTES = 147456;
constexpr int CW_BAR = 4096;
static_assert(fa::F_LDS_BYTES <= RING_BYTES && fa::S_LDS_BYTES <= RING_BYTES && pg8::STAGE_BYTES <= RING_BYTES && MISC_OFF + 128 <= LDS_BYTES && (CW_BAR + XCD_BAR_WORDS) * 4 <= (int)WS_KMAX, "LDS / CTL map");

__device__ __forceinline__ void p0_transpose_item(const float* W, int K, int N, bf16* WT, LAS float* scr, int item, int lane, const float* gs) {
    const int nblk = N / 32, kb = item / nblk, nb = item % nblk, k0 = 64 * kb, n0 = 32 * nb;
    const int kr = lane >> 3, nc = 4 * (lane & 7);
    f32x4 wv[8];
#pragma unroll
    for (int i = 0; i < 8; ++i) wv[i] = *(const GAS f32x4*)(W + (size_t)(k0 + 8 * i + kr) * N + n0 + nc);
#pragma unroll
    for (int i = 0; i < 8; ++i) { const int kk = 8 * i + kr; f32x4 w = wv[i]; if (gs) w = w * gs[k0 + kk]; LAS float* d = scr + kk * 33 + nc; d[0] = w.x; d[1] = w.y; d[2] = w.z; d[3] = w.w; }
    LDS_WAIT(); asm volatile("" ::: "memory");
    const int c = lane & 7;
#pragma unroll
    for (int j = 0; j < 4; ++j) { const int n = (lane >> 3) + 8 * j; const LAS float* sp = scr + (8 * c) * 33 + n;
        v4u o; o.x = pk2(sp[0 * 33], sp[1 * 33]); o.y = pk2(sp[2 * 33], sp[3 * 33]); o.z = pk2(sp[4 * 33], sp[5 * 33]); o.w = pk2(sp[6 * 33], sp[7 * 33]);
        *(GAS v4u*)(WT + tiled_off(n0 + n, k0 + 8 * c)) = o; }
    LDS_WAIT(); asm volatile("" ::: "memory");
}
__device__ __forceinline__ float wave_sum(float v) {
#pragma unroll
    for (int o = 1; o < 64; o <<= 1) v += __shfl_xor(v, o);
    return v;
}

struct Args { const float* in[9]; float* out; unsigned char* ws; int ph_lo, ph_hi; };
constexpr int N_PHASES = 9;
__global__ void __launch_bounds__(NWAVES * 64, 2) mega_fwd(Args args) {
    extern __shared__ __attribute__((aligned(16))) unsigned char lds_raw[];
    LAS unsigned char* lds = (LAS unsigned char*)lds_raw;
    volatile LAS unsigned* MISC = (volatile LAS unsigned*)(lds + MISC_OFF);
    const int tid = threadIdx.x, lane = tid & 63, wave = __builtin_amdgcn_readfirstlane(tid >> 6);
    const int G = gridDim.x, bx = blockIdx.x, vcu = (G % 8 == 0) ? (bx % 8) * (G / 8) + bx / 8 : bx;
    unsigned char* ws = args.ws;
    const float* x = args.in[0]; const float* norm_g = args.in[1]; const float* fox_w_in = args.in[2]; const float* fox_b_f = args.in[3]; const float* fox_w_out = args.in[4];
    const float* swa_w_in = args.in[5]; const float* swa_sinks = args.in[6]; const float* swa_w_out = args.in[7]; const float* final_g = args.in[8];
    float* out = args.out;
    gu32* ctl = (gu32*)(ws + WS_CTL);
    unsigned* KMAX = (unsigned*)(ws + WS_KMAX); unsigned* TICKET = (unsigned*)(ws + WS_TICKET);
    float* SS1 = (float*)(ws + WS_SS1); float* R0 = (float*)(ws + WS_R0); float* ROPE = (float*)(ws + WS_ROPE); float* LOGF = (float*)(ws + WS_LOGF); float* CUM = (float*)(ws + WS_CUM);
    bf16* W1T = (bf16*)(ws + WS_W1T); bf16* W2T = (bf16*)(ws + WS_W2T); bf16* W3T = (bf16*)(ws + WS_W3T); bf16* W4T = (bf16*)(ws + WS_W4T);
    bf16* KAUG = (bf16*)(ws + WS_KAUG);
    bf16* XB = (bf16*)(ws + WS_XB); bf16* Qb = (bf16*)(ws + WS_Q); bf16* Kb = (bf16*)(ws + WS_K); bf16* Vb = (bf16*)(ws + WS_V); bf16* Gb = (bf16*)(ws + WS_G); bf16* YG = (bf16*)(ws + WS_YG);
    for (int u = tid; u < (LDS_BYTES - LDSCTL_OFF) / 4; u += NWAVES * 64) ((LAS unsigned*)(lds + LDSCTL_OFF))[u] = 0u;
    __syncthreads();
    const int lo = args.ph_lo, hi = args.ph_hi;
    XcdBarrier bar; bar.bar = (unsigned*)(ctl + CW_BAR); bar.x = 0; bar.st = nullptr;
    if (hi - lo > 1) bar = xcd_barrier_post((unsigned*)(ctl + CW_BAR), MISC + 8);
#define IN(k) (lo <= (k) && (k) < hi)
#define REP(k) for (int rep_ = 0; rep_ < (((DUP_MASK >> (k)) & 1) ? 2 : 1); ++rep_)
#define SEAM(k) do { if (IN(k) && IN((k) + 1)) xcd_barrier(bar); } while (0)
    const int gw = vcu * NWAVES + wave, NGW = G * NWAVES;

    if (IN(0)) REP(0) {
        LAS float* scr = (LAS float*)(lds + RING_OFF + wave * 16384);
        constexpr int I1 = (DM / 64) * (FOX_IN / 32);
        for (int it = gw; it < I1; it += NGW) p0_transpose_item(fox_w_in, DM, FOX_IN, W1T, scr, it, lane, norm_g);
        for (int m = 2 * gw; m < MTOK; m += 2 * NGW) {
            const int m2 = m + 1;
            const GAS f32x4* xr = (const GAS f32x4*)(x + (size_t)m * DM) + lane; const GAS f32x4* xr2 = (const GAS f32x4*)(x + (size_t)m2 * DM) + lane; f32x4 v[8], v2[8]; float s = 0.f, s2 = 0.f;
#pragma unroll
            for (int j = 0; j < 8; ++j) { v[j] = xr[64 * j]; v2[j] = xr2[64 * j]; }
#pragma unroll
            for (int j = 0; j < 8; ++j) { s += (v[j].x * v[j].x + v[j].y * v[j].y) + (v[j].z * v[j].z + v[j].w * v[j].w); s2 += (v2[j].x * v2[j].x + v2[j].y * v2[j].y) + (v2[j].z * v2[j].z + v2[j].w * v2[j].w); }
            s = wave_sum(s); s2 = wave_sum(s2);
            if (lane == 0) { R0[m] = 1.0f / sqrtf(s * (1.f / DM) + RMS_EPS); R0[m2] = 1.0f / sqrtf(s2 * (1.f / DM) + RMS_EPS); }
#pragma unroll
            for (int j = 0; j < 8; ++j) { *(GAS unsigned long long*)(XB + tiled_off(m, 256 * j + 4 * lane)) = (unsigned long long)pk2(v[j].x, v[j].y) | ((unsigned long long)pk2(v[j].z, v[j].w) << 32);
                                          *(GAS unsigned long long*)(XB + tiled_off(m2, 256 * j + 4 * lane)) = (unsigned long long)pk2(v2[j].x, v2[j].y) | ((unsigned long long)pk2(v2[j].z, v2[j].w) << 32); }
        }
        { const int gt = gw * 64 + lane;
          if (gt < SEQ * 8) { const int pos = gt >> 3, i = gt & 7;
              const double invf[8] = {1.0, 0.19390220519133497, 0.037598065178462524, 0.0072903477503833845, 0.0014142135623730951, 0.00027421912901204056, 5.3171693730649086e-05, 1.0310108130908796e-05};
              double inv = invf[0];
#pragma unroll
              for (int k = 1; k < 8; ++k) inv = (i == k) ? invf[k] : inv;
              const double ang = (double)pos * inv; const double kk = __builtin_rint(ang * 0.15915494309189535); const float red = (float)(ang - kk * 6.283185307179586);
              ROPE[(size_t)pos * 16 + i] = cosf(red); ROPE[(size_t)pos * 16 + 8 + i] = sinf(red); } }
    }
    SEAM(0);
    if (IN(1)) {
        pg8::Gemm g{XB, W1T, MTOK, 4 * DM, DM}; pg8::StaticOrder S; S.init(MTOK, 4 * DM, G, bx, (DUP_MASK >> 1) & 1, (DUP_MASK >> 9) & 1);
        pg8::EpiFoxIn E{Qb, Kb, Vb, Gb, LOGF, R0, fox_b_f, KMAX};
        if ((DUP_MASK >> 10) & 1) { pg8::StaticOrder SP; SP.init(MTOK, 4 * DM, G, bx, 0, 0, 1); pg8::gemm_phase<pg8::EpiFoxIn, pg8::StaticOrder, true, true>(lds + RING_OFF, g, SP, E); }
        pg8::gemm_phase<pg8::EpiFoxIn, pg8::StaticOrder, true, true>(lds + RING_OFF, g, S, E);
        for (int rb = bx * 64; rb < MTOK; rb += G * 64) {
            const int arow = rb + 16 * (wave & 3) + (lane & 15), brow = 4 * DM + 16 * (wave >> 2) + (lane & 15), kg = (lane >> 4) * 8;
            pg8::f32x4 acc = {0.f, 0.f, 0.f, 0.f};
#pragma unroll 8
            for (int ks = 0; ks < DM / 32; ++ks) {
                const bf16x8 af = *(const GAS bf16x8*)(XB + tiled_off(arow, 32 * ks + kg)), bfv = *(const GAS bf16x8*)(W1T + tiled_off(brow, 32 * ks + kg));
                acc = __builtin_amdgcn_mfma_f32_16x16x32_bf16(af, bfv, acc, 0, 0, 0); }
            const int h = 16 * (wave >> 2) + (lane & 15), r0 = rb + 16 * (wave & 3) + 4 * (lane >> 4); const float bb = fox_b_f[h];
            f32x4 o; o.x = logsigmoidf(acc[0] * R0[r0] + bb); o.y = logsigmoidf(acc[1] * R0[r0 + 1] + bb); o.z = logsigmoidf(acc[2] * R0[r0 + 2] + bb); o.w = logsigmoidf(acc[3] * R0[r0 + 3] + bb);
            *(GAS f32x4*)(LOGF + ((size_t)((r0 >> 12) * NH + h) << 12) + (r0 & 4095)) = o;
        }
        { LAS float* scr = (LAS float*)(lds + RING_OFF + wave * 16384);
          constexpr int I2 = (DM / 64) * (DM / 32), I3 = (DM / 64) * (SWA_IN / 32);
          for (int it = gw; it < I2 + I3; it += NGW) { if (it < I2) p0_transpose_item(fox_w_out, DM, DM, W2T, scr, it, lane, nullptr); else p0_transpose_item(swa_w_in, DM, SWA_IN, W3T, scr, it - I2, lane, norm_g + DM); } }
    }
    SEAM(1);
    if (IN(2)) REP(2) {
        for (int sq = vcu; sq < NB * NH; sq += G) {
            const GAS f32x4* lf = (const GAS f32x4*)(LOGF + (size_t)sq * SEQ + wave * 512) + lane * 2; const f32x4 v0 = lf[0], v1 = lf[1];
            const double tot = (((double)v0.x + (double)v0.y) + ((double)v0.z + (double)v0.w)) + (((double)v1.x + (double)v1.y) + ((double)v1.z + (double)v1.w));
            double incl = tot;
#pragma unroll
            for (int o = 1; o < 64; o <<= 1) { const double up = __shfl_up(incl, o); if (lane >= o) incl += up; }
            volatile LAS double* wt = (volatile LAS double*)(lds + RING_OFF);
            __syncthreads();
            if (lane == 63) wt[wave] = incl;
            __syncthreads();
            double run = incl - tot;
            for (int w2 = 0; w2 < wave; ++w2) run += wt[w2];
            const float vv[8] = {v0.x, v0.y, v0.z, v0.w, v1.x, v1.y, v1.z, v1.w}; float cv[8];
#pragma unroll
            for (int e = 0; e < 8; ++e) { run += (double)vv[e]; cv[e] = (float)(run * 1.4426950408889634); }
            GAS f32x4* co = (GAS f32x4*)(CUM + (size_t)sq * SEQ + wave * 512) + lane * 2; co[0] = (f32x4){cv[0], cv[1], cv[2], cv[3]}; co[1] = (f32x4){cv[4], cv[5], cv[6], cv[7]};
            GAS v4u* ka = (GAS v4u*)(KAUG + ((size_t)sq * SEQ + wave * 512 + lane * 8) * 8);
#pragma unroll
            for (int e = 0; e < 8; ++e) { unsigned h1, h2, h3; fa::split3(-cv[e], h1, h2, h3); ka[e] = (v4u){h1 | (h2 << 16), h3 | 0x3F800000u, 0x3F803F80u, 0u}; }
        }
    }
    SEAM(2);
    if (IN(3)) {
        const fa::Params P{Qb, Kb, Vb, Gb, YG, CUM, nullptr, KMAX, TICKET, KAUG};
        volatile LAS unsigned* slot = (volatile LAS unsigned*)(lds + RING_OFF + fa::F_FLAG + 128);
#define FOX_FETCH(dst) do { unsigned code_ = 0xFFFFFFFFu; for (int k_ = 0; k_ < 8; ++k_) { const unsigned q_ = (unsigned)((bx + k_) & 7); const unsigned t_ = atomicAdd(TICKET + q_ * 64, 1u); \
            if (t_ < 256u) { code_ = q_ * 256u + t_; break; } } (dst) = code_; } while (0)
        if (tid == 0) FOX_FETCH(slot[0]);
        __syncthreads();
        unsigned tk = slot[0]; int par = 0;
        while (tk != 0xFFFFFFFFu) {
            if (tid == 0) FOX_FETCH(slot[par ^ 1]);
            const int q = (int)(tk >> 8), tq = (int)(tk & 255u), pi = tq >> 4, hs = 3 - (pi >> 2);
            const int h = hs == 0 ? q : hs == 1 ? 15 - q : hs == 2 ? 16 + q : 31 - q;
            fa::fox_unit(lds + RING_OFF, P, pi & 3, h, 15 - (tq & 15));
            par ^= 1; tk = slot[par];
        }
#undef FOX_FETCH
        __syncthreads();
    }
    SEAM(3);
    if (IN(4)) {
        pg8::Gemm g{YG, W2T, MTOK, DM, DM}; pg8::StaticOrder S; S.init(MTOK, DM, G, bx);
        pg8::EpiRes<true> E{x, XB, SS1};
        pg8::gemm_phase<pg8::EpiRes<true>, pg8::StaticOrder, true, true>(lds + RING_OFF, g, S, E);
    }
    SEAM(4);
    if (IN(5)) {
        pg8::Gemm g{XB, W3T, MTOK, SWA_IN, DM}; pg8::StaticOrder S; S.init(MTOK, SWA_IN, G, bx, (DUP_MASK >> 5) & 1);
        pg8::EpiSwaIn E{Qb, Kb, Vb, Gb, SS1, ROPE};
        pg8::gemm_phase<pg8::EpiSwaIn, pg8::StaticOrder, true, true>(lds + RING_OFF, g, S, E);
        { const int nwg = (MTOK / 256) * (SWA_IN / 256), rem = nwg % G, nidle = rem ? G - rem : G, ii = rem ? bx - rem : bx;
          if (ii >= 0) { LAS float* scr = (LAS float*)(lds + RING_OFF + wave * 16384); constexpr int I2 = (DM / 64) * (DM / 32);
              for (int it = ii * NWAVES + wave; it < I2; it += nidle * NWAVES) p0_transpose_item(swa_w_out, DM, DM, W4T, scr, it, lane, nullptr); } }
    }
    SEAM(5);
    if (IN(6)) REP(6) {
        const fa::Params P{Qb, Kb, Vb, Gb, YG, nullptr, swa_sinks, nullptr, nullptr, nullptr};
        for (int u = (G == 256 ? vcu : bx); u < NB * 4 * 16; u += G) fa::swa_unit(lds + RING_OFF, P, u >> 6, (u >> 4) & 3, u & 15);
    }
    SEAM(6);
    if (IN(7)) {
        pg8::Gemm g{YG, W4T, MTOK, DM, DM}; pg8::StaticOrder S; S.init(MTOK, DM, G, bx);
        pg8::EpiRes<false> E{nullptr, XB, nullptr};
        pg8::gemm_phase<pg8::EpiRes<false>, pg8::StaticOrder, true, true>(lds + RING_OFF, g, S, E);
    }
    SEAM(7);
    if (IN(8)) {
        f32x4 gq[8];
#pragma unroll
        for (int j = 0; j < 8; ++j) gq[j] = ((const GAS f32x4*)final_g)[lane + 64 * j];
        for (int m = 2 * gw; m < MTOK; m += 2 * NGW) {
            f32x4 v[8], v2[8]; float s = 0.f, s2 = 0.f; unsigned long long xw[8], xw2[8];
#pragma unroll
            for (int j = 0; j < 8; ++j) { xw[j] = *(const GAS unsigned long long*)(XB + tiled_off(m, 256 * j + 4 * lane)); xw2[j] = *(const GAS unsigned long long*)(XB + tiled_off(m + 1, 256 * j + 4 * lane)); }
#pragma unroll
            for (int j = 0; j < 8; ++j) { const unsigned lo32 = (unsigned)xw[j], hi32 = (unsigned)(xw[j] >> 32), lo2 = (unsigned)xw2[j], hi2 = (unsigned)(xw2[j] >> 32);
                v[j] = (f32x4){__uint_as_float(lo32 << 16), __uint_as_float(lo32 & 0xffff0000u), __uint_as_float(hi32 << 16), __uint_as_float(hi32 & 0xffff0000u)};
                v2[j] = (f32x4){__uint_as_float(lo2 << 16), __uint_as_float(lo2 & 0xffff0000u), __uint_as_float(hi2 << 16), __uint_as_float(hi2 & 0xffff0000u)};
                s += (v[j].x * v[j].x + v[j].y * v[j].y) + (v[j].z * v[j].z + v[j].w * v[j].w); s2 += (v2[j].x * v2[j].x + v2[j].y * v2[j].y) + (v2[j].z * v2[j].z + v2[j].w * v2[j].w); }
            const float r = 1.0f / sqrtf(wave_sum(s) * (1.f / DM) + RMS_EPS), r2 = 1.0f / sqrtf(wave_sum(s2) * (1.f / DM) + RMS_EPS);
            GAS f32x4* xr = (GAS f32x4*)(out + (size_t)m * DM) + lane; GAS f32x4* xr2 = (GAS f32x4*)(out + (size_t)(m + 1) * DM) + lane;
#pragma unroll
            for (int j = 0; j < 8; ++j) { xr[64 * j] = v[j] * r * gq[j]; xr2[64 * j] = v2[j] * r2 * gq[j]; }
        }
    }
#undef IN
#undef SEAM
}

extern "C" void kernel_launch(void* const* d_in, const int* in_sizes, int n_in, void* d_out, int out_size, void* d_ws, size_t ws_size, hipStream_t stream) {
    static int grid = 0;
    if (grid == 0) {
        if (n_in != 9 || in_sizes[0] != MTOK * DM || out_size != MTOK * DM || ws_size < WS_END) { fprintf(stderr, "kernel_launch: unexpected shapes (n_in %d, in0 %d, out %d, ws %zu)\n", n_in, n_in > 0 ? in_sizes[0] : -1, out_size, ws_size); grid = -1; return; }
        int dev = 0, cus = 0, per_cu = 0;
        if (hipGetDevice(&dev) != hipSuccess || hipDeviceGetAttribute(&cus, hipDeviceAttributeMultiprocessorCount, dev) != hipSuccess) { fprintf(stderr, "kernel_launch: device query failed\n"); grid = -1; return; }
        if (hipFuncSetAttribute((const void*)mega_fwd, hipFuncAttributeMaxDynamicSharedMemorySize, LDS_BYTES) != hipSuccess) { fprintf(stderr, "kernel_launch: hipFuncSetAttribute failed\n"); grid = -1; return; }
        if (hipOccupancyMaxActiveBlocksPerMultiprocessor(&per_cu, (const void*)mega_fwd, NWAVES * 64, LDS_BYTES) != hipSuccess || per_cu < 1) { fprintf(stderr, "kernel_launch: occupancy query reports %d workgroups per CU; nothing launched\n", per_cu); (void)hipGetLastError(); grid = -1; return; }
        grid = cus;
    }
    if (grid < 0) return;
    (void)hipMemsetAsync((unsigned char*)d_ws + WS_CTL, 0, CTL_ZERO_BYTES, stream);
    Args a{};
    for (int i = 0; i < 9; ++i) a.in[i] = (const float*)d_in[i];
    a.out = (float*)d_out; a.ws = (unsigned char*)d_ws;
    int p = 0;
    while (p < N_PHASES) {
        if (!((FAST_MASK >> p) & 1)) { ++p; continue; }
        int e = p + 1; if (ONE_LAUNCH) while (e < N_PHASES && ((FAST_MASK >> e) & 1)) ++e;
        a.ph_lo = p; a.ph_hi = e;
        hipLaunchKernelGGL(mega_fwd, dim3(grid), dim3(NWAVES * 64), LDS_BYTES, stream, a);
        p = e;
    }
}
```

```cpp
#include <hip/hip_runtime.h>
#include <cstdio>
#include <cstdint>

constexpr int NB = 4, SEQ = 4096, DM = 2048, MTOK = NB * SEQ, NH = 32, HD = 64;
constexpr int FOX_IN = 8224, SWA_IN = 4608, KVW = 256;
constexpr float RMS_EPS = 1e-6f;
constexpr float LOG2E = 1.4426950408889634f;
constexpr float C2 = 0.125f * LOG2E;

typedef unsigned short bf16_t;
__device__ __forceinline__ float bf2f(bf16_t v) { return __uint_as_float((unsigned)v << 16); }
__device__ __forceinline__ bf16_t f2bf(float f) { unsigned u = __float_as_uint(f); return (bf16_t)((u + 0x7fffu + ((u >> 16) & 1u)) >> 16); }
__device__ __forceinline__ float logsigmoidf(float z) { return z < 0.f ? z - log1pf(expf(z)) : -log1pf(expf(-z)); }
__device__ __forceinline__ float siluf(float g) { return g / (1.f + expf(-g)); }

__host__ __device__ __forceinline__ size_t tiled_off(int row, int k) { return ((size_t)(((row >> 8) * (DM / 64) + (k >> 6)) * 2 + ((k >> 5) & 1)) << 13) + (size_t)(((row & 255) << 5) + (k & 31)); }

__host__ __device__ __forceinline__ size_t hm_off(int row  , int col  , int nheads) { return ((size_t)(((row >> 12) * nheads + (col >> 6)) * 2 + ((col >> 5) & 1)) * SEQ + (row & 4095)) * 32 + (col & 31); }

constexpr size_t MiB = 1u << 20;
constexpr size_t WS_CTL = 0, CTL_ZERO_BYTES = 1 * MiB;
constexpr size_t WS_KMAX = 64 * 1024, WS_TICKET = 66 * 1024;
constexpr size_t WS_SS1 = 512 * 1024;
constexpr size_t WS_R0 = 1 * MiB;
constexpr size_t WS_ROPE = 1 * MiB + 512 * 1024;
constexpr size_t WS_LOGF = 2 * MiB;
constexpr size_t WS_CUM = 4 * MiB;
constexpr size_t WS_W1T = 8 * MiB, WS_W2T = 41 * MiB, WS_W3T = 49 * MiB, WS_W4T = 67 * MiB;
constexpr size_t WS_XB = 76 * MiB, WS_Q = 140 * MiB, WS_K = 204 * MiB, WS_V = 268 * MiB, WS_G = 332 * MiB, WS_YG = 396 * MiB, WS_KAUG = 460 * MiB, WS_END = 468 * MiB;

#ifndef FAST_MASK
#define FAST_MASK 0x1FF
#endif
#ifndef DUP_MASK
#define DUP_MASK 0x000
#endif
#ifndef ONE_LAUNCH
#define ONE_LAUNCH 1
#endif
namespace pg8 {
#define PG8_LAS __attribute__((address_space(3)))
typedef unsigned short bf16_t;
typedef short bf16x8 __attribute__((ext_vector_type(8)));
typedef float f32x4 __attribute__((ext_vector_type(4)));
typedef unsigned u32x4 __attribute__((ext_vector_type(4)));
constexpr int BM = 256, BK = 64, HALF = 128, HTB = HALF * BK * 2  , STAGE_BYTES = 8 * HTB, NXCD = 8, WGM = 8;

__host__ __device__ __forceinline__ int lds_byte(int r, int c) { const int st = (r >> 4) * 2 + (c >> 5), rr = r & 15, cc = c & 31, ob = rr * 64 + cc * 2; return st * 1024 + (ob ^ (((ob >> 9) & 1) << 5)); }
__host__ __device__ __forceinline__ void stage_rc(int b, int& R, int& C) { const int st = b / 1024, sb = b % 1024, swz = sb ^ (((sb >> 9) & 1) << 5); R = (st >> 1) * 16 + swz / 64; C = (st & 1) * 32 + (swz % 64) / 2; }
__host__ __device__ __forceinline__ int perm32(int rho) { const int n = rho >> 4, i = rho & 15; return 8 * (i >> 2) + 4 * n + (i & 3); }

struct Unit { int pm, pn, lm, ln; };
struct Gemm { const bf16_t* A; const bf16_t* Bt; int M, N, K; };

struct StaticOrder {
    int nM, nN, nwg, G, c, dup, epi2, same;
    __host__ __device__ void init(int M, int N, int G_, int c_, int dup_ = 0, int epi2_ = 0, int same_ = 0) { nM = M / BM; nN = N / BM; nwg = nM * nN; G = G_; c = c_; dup = dup_; epi2 = epi2_; same = same_; }
    __host__ __device__ bool next(int i, Unit& u) const {
        if (dup) i >>= 1;
        const long L = (long)i * G + c; if (L >= nwg) return false;
        int wgid = (int)L; { const int q = nwg / NXCD, r = nwg % NXCD, xcd = wgid % NXCD, off = wgid / NXCD; wgid = (xcd < r ? xcd * (q + 1) : r * (q + 1) + (xcd - r) * q) + off; }
        const int nig = WGM * nN, gid = wgid / nig, fm = gid * WGM, gsz = (nM - fm) < WGM ? (nM - fm) : WGM;
        u.pm = fm + ((wgid % nig) % gsz); u.pn = (wgid % nig) / gsz; u.lm = same ? 0 : u.pm; u.ln = same ? 0 : u.pn; return true;
    }
    __device__ __forceinline__ void a_ready(const Unit&) const {}
    __device__ __forceinline__ void done(const Unit&) const {}
};

__device__ __forceinline__ unsigned cvt_pk_bf16(float lo, float hi) { unsigned r; asm volatile("v_cvt_pk_bf16_f32 %0, %1, %2" : "=v"(r) : "v"(lo), "v"(hi)); return r; }
__device__ __forceinline__ float silu_fast(float g) { return g * __builtin_amdgcn_rcpf(1.0f + __builtin_amdgcn_exp2f(-g * 1.4426950408889634f)); }
__device__ __forceinline__ u32x4 pack8(const f32x4 v0, const f32x4 v1) { u32x4 w; w.x = cvt_pk_bf16(v0[0], v0[1]); w.y = cvt_pk_bf16(v0[2], v0[3]); w.z = cvt_pk_bf16(v1[0], v1[1]); w.w = cvt_pk_bf16(v1[2], v1[3]); return w; }
struct EpiFoxIn {
    static constexpr bool PERM = true, AFTER_DRAIN = false;
    bf16_t *Q, *K, *V, *G; float* LOGF; const float* R0; const float* bfb; unsigned* KMAX;
    __device__ __forceinline__ void operator()(const f32x4 (&acc)[2][2][4][2], const Unit& u, int wr, int wc, int fr, int fq) const {
        const int row0 = u.pm * BM + wr * 64 + fr, pn = u.pn;
        float rs[2][4];
#pragma unroll
        for (int ai = 0; ai < 2; ++ai)
#pragma unroll
            for (int m = 0; m < 4; ++m) rs[ai][m] = R0[row0 + ai * HALF + m * 16];
        {
            const int reg = pn >> 3; bf16_t* base = reg == 0 ? Q : reg == 1 ? K : reg == 2 ? V : G; float kmx[2] = {0.f, 0.f};
            const int col0 = (pn & 7) * BM + wc * 32 + 8 * fq;
#pragma unroll
            for (int ai = 0; ai < 2; ++ai)
#pragma unroll
                for (int m = 0; m < 4; ++m) { const int row = row0 + ai * HALF + m * 16; const float r = rs[ai][m]; const float sc = reg == 0 ? r * C2 : r;
#pragma unroll
                    for (int bj = 0; bj < 2; ++bj) { f32x4 v0 = acc[ai][bj][m][0] * sc, v1 = acc[ai][bj][m][1] * sc;
                        if (reg == 3) {
#pragma unroll
                            for (int j = 0; j < 4; ++j) { v0[j] = silu_fast(v0[j]); v1[j] = silu_fast(v1[j]); } }
                        if (reg == 1) { float ss = ((v0[0] * v0[0] + v0[1] * v0[1]) + (v0[2] * v0[2] + v0[3] * v0[3])) + ((v1[0] * v1[0] + v1[1] * v1[1]) + (v1[2] * v1[2] + v1[3] * v1[3]));
                            ss += __shfl_xor(ss, 16); ss += __shfl_xor(ss, 32); kmx[bj] = fmaxf(kmx[bj], ss); }
                        __builtin_nontemporal_store(pack8(v0, v1), (u32x4*)(base + hm_off(row, col0 + bj * HALF, NH))); } }
            if (reg == 1) {
#pragma unroll
                for (int bj = 0; bj < 2; ++bj) { float mx = kmx[bj];
#pragma unroll
                    for (int o = 1; o < 16; o <<= 1) mx = fmaxf(mx, __shfl_xor(mx, o));
                    if (fr == 0 && fq == 0) atomicMax(KMAX + ((row0 >> 12) * NH + (pn & 7) * 4 + bj * 2 + (wc >> 1)) * 2 + (wc & 1), __float_as_uint(mx)); } }
        }
    }
};
struct EpiSwaIn {
    static constexpr bool PERM = true, AFTER_DRAIN = false;
    bf16_t *Q, *K, *V, *G; const float* SS; const float* ROPE;
    __device__ __forceinline__ void operator()(const f32x4 (&acc)[2][2][4][2], const Unit& u, int wr, int wc, int fr, int fq) const {
        const int row0 = u.pm * BM + wr * 64 + fr, pn = u.pn;
        bf16_t* base; int pitch, colt; float osc = 1.f; const bool rope = pn <= 8, gate = pn >= 10;
        if (pn < 8) { base = Q; pitch = DM; colt = pn * BM; osc = C2; } else if (pn == 8) { base = K; pitch = KVW; colt = 0; } else if (pn == 9) { base = V; pitch = KVW; colt = 0; } else { base = G; pitch = DM; colt = (pn - 10) * BM; }
        const int col0 = colt + wc * 32 + 8 * fq; const bool rotw = rope && ((wc & 1) == 0); const float sgn = fq == 0 ? -1.f : 1.f; const bool rotl = fq < 2;
        float rs[2][4];
#pragma unroll
        for (int ai = 0; ai < 2; ++ai)
#pragma unroll
            for (int m = 0; m < 4; ++m) rs[ai][m] = SS[row0 + ai * HALF + m * 16];
        f32x4 nc0, nc1, ns0, ns1;
        if (rotw) { const float* rp = ROPE + (size_t)(row0 & 4095) * 16; nc0 = *(const f32x4*)rp; nc1 = *(const f32x4*)(rp + 4); ns0 = *(const f32x4*)(rp + 8); ns1 = *(const f32x4*)(rp + 12); }
#pragma unroll
        for (int ai = 0; ai < 2; ++ai)
#pragma unroll
            for (int m = 0; m < 4; ++m) { const int row = row0 + ai * HALF + m * 16; const float r = 1.0f / sqrtf(rs[ai][m] * (1.f / DM) + RMS_EPS);
                const f32x4 c0 = nc0, c1 = nc1, s0 = ns0, s1 = ns1;
                if (rotw && (ai * 4 + m) < 7) { const int nrow = row0 + ((ai * 4 + m + 1) >> 2) * HALF + ((ai * 4 + m + 1) & 3) * 16; const float* rp = ROPE + (size_t)(nrow & 4095) * 16; nc0 = *(const f32x4*)rp; nc1 = *(const f32x4*)(rp + 4); ns0 = *(const f32x4*)(rp + 8); ns1 = *(const f32x4*)(rp + 12); }
#pragma unroll
                for (int bj = 0; bj < 2; ++bj) { f32x4 v0 = acc[ai][bj][m][0] * r, v1 = acc[ai][bj][m][1] * r;
                    if (rotw) {
#pragma unroll
                        for (int j = 0; j < 4; ++j) { const float p0 = __shfl_xor(v0[j], 16), p1 = __shfl_xor(v1[j], 16);
                            const float n0 = v0[j] * c0[j] + sgn * p0 * s0[j], n1 = v1[j] * c1[j] + sgn * p1 * s1[j];
                            v0[j] = rotl ? n0 : v0[j]; v1[j] = rotl ? n1 : v1[j]; } }
                    if (gate) {
#pragma unroll
                        for (int j = 0; j < 4; ++j) { v0[j] = silu_fast(v0[j]); v1[j] = silu_fast(v1[j]); } }
                    v0 = v0 * osc; v1 = v1 * osc;
                    *(u32x4*)(base + hm_off(row, col0 + bj * HALF, pitch >> 6)) = pack8(v0, v1); } }
    }
};
template <bool FIRST> struct EpiRes {
    static constexpr bool PERM = true, AFTER_DRAIN = false;
    const float* xin; bf16_t* XB; float* SS;
    __device__ __forceinline__ void operator()(const f32x4 (&acc)[2][2][4][2], const Unit& u, int wr, int wc, int fr, int fq) const {
        const int row0 = u.pm * BM + wr * 64 + fr, col0 = u.pn * BM + wc * 32 + 8 * fq;
        if (FIRST) {
            f32x4 nx[2][2];
#pragma unroll
            for (int bj = 0; bj < 2; ++bj)
#pragma unroll
                for (int n = 0; n < 2; ++n) nx[bj][n] = *(const f32x4*)(xin + (size_t)row0 * DM + col0 + bj * HALF + n * 4);
#pragma unroll
            for (int ai = 0; ai < 2; ++ai)
#pragma unroll
                for (int m = 0; m < 4; ++m) { const int row = row0 + ai * HALF + m * 16; float ss = 0.f;
                    f32x4 cx[2][2];
#pragma unroll
                    for (int bj = 0; bj < 2; ++bj)
#pragma unroll
                        for (int n = 0; n < 2; ++n) cx[bj][n] = nx[bj][n];
                    if ((ai * 4 + m) < 7) { const int nrow = row0 + ((ai * 4 + m + 1) >> 2) * HALF + ((ai * 4 + m + 1) & 3) * 16;
#pragma unroll
                        for (int bj = 0; bj < 2; ++bj)
#pragma unroll
                            for (int n = 0; n < 2; ++n) nx[bj][n] = *(const f32x4*)(xin + (size_t)nrow * DM + col0 + bj * HALF + n * 4); }
#pragma unroll
                    for (int bj = 0; bj < 2; ++bj) { const f32x4 x0 = cx[bj][0] + acc[ai][bj][m][0], x1 = cx[bj][1] + acc[ai][bj][m][1];
                        *(u32x4*)(XB + tiled_off(row, col0 + bj * HALF)) = pack8(x0, x1);
                        ss += ((x0[0] * x0[0] + x0[1] * x0[1]) + (x0[2] * x0[2] + x0[3] * x0[3])) + ((x1[0] * x1[0] + x1[1] * x1[1]) + (x1[2] * x1[2] + x1[3] * x1[3])); }
                    ss += __shfl_xor(ss, 16); ss += __shfl_xor(ss, 32); if (fq == 0) atomicAdd(SS + row, ss); }
        } else {
            u32x4 xv[2][4][2];
#pragma unroll
            for (int ai = 0; ai < 2; ++ai)
#pragma unroll
                for (int m = 0; m < 4; ++m)
#pragma unroll
                    for (int bj = 0; bj < 2; ++bj) xv[ai][m][bj] = *(const u32x4*)(XB + tiled_off(row0 + ai * HALF + m * 16, col0 + bj * HALF));
#pragma unroll
            for (int ai = 0; ai < 2; ++ai)
#pragma unroll
                for (int m = 0; m < 4; ++m)
#pragma unroll
                    for (int bj = 0; bj < 2; ++bj) { const u32x4 xw = xv[ai][m][bj]; const f32x4 a0 = acc[ai][bj][m][0], a1 = acc[ai][bj][m][1];
                        const f32x4 y0 = {__uint_as_float(xw.x << 16) + a0[0], __uint_as_float(xw.x & 0xffff0000u) + a0[1], __uint_as_float(xw.y << 16) + a0[2], __uint_as_float(xw.y & 0xffff0000u) + a0[3]};
                        const f32x4 y1 = {__uint_as_float(xw.z << 16) + a1[0], __uint_as_float(xw.z & 0xffff0000u) + a1[1], __uint_as_float(xw.w << 16) + a1[2], __uint_as_float(xw.w & 0xffff0000u) + a1[3]};
                        *(u32x4*)(XB + tiled_off(row0 + ai * HALF + m * 16, col0 + bj * HALF)) = pack8(y0, y1); }
        }
    }
};
template <class Epi, class Sched, bool ALIGN_EPI = false, bool SP2 = false>
__device__ __forceinline__ void gemm_phase(PG8_LAS unsigned char* lds, const Gemm g, const Sched& S, const Epi& E) {
    const int tid = threadIdx.x, wid = __builtin_amdgcn_readfirstlane(tid >> 6), lane = tid & 63, wr = wid >> 2, wc = wid & 3, fr = lane & 15, fq = lane >> 4;
    const int K = g.K, nt = K / BK;
    unsigned voffA[2], voffB[2];
#pragma unroll
    for (int i = 0; i < 2; ++i) { int R, C; stage_rc(tid * 16 + i * 8192, R, C); const int Rb = Epi::PERM ? ((R & ~31) + perm32(R & 31)) : R;
        voffA[i] = (unsigned)((C >> 5) * (BM * 32) + R * 32 + (C & 31)) * 2u; voffB[i] = (unsigned)((C >> 5) * (BM * 32) + Rb * 32 + (C & 31)) * 2u; }
    const size_t kstep = (size_t)(BM * BK * 2);
    const size_t hstep = (size_t)(HALF * 32 * 2);
    const size_t tstep = (size_t)BM * K * 2;
    const unsigned ldsw = (unsigned)wid * 1024u;
    const int aoff = lds_byte(wr * 64 + fr, fq * 8), boff = lds_byte(wc * 32 + fr, fq * 8);
#define PG8_SA(b, h) (((b) * 2 + (h)) * HTB)
#define PG8_SB(b, h) ((4 + (b) * 2 + (h)) * HTB)
#define PG8_STAGE(bufoff, gbase, voff) do { _Pragma("unroll") for (int _i = 0; _i < 2; ++_i) \
        __builtin_amdgcn_global_load_lds((const unsigned*)((const char*)(gbase) + (voff)[_i]), (PG8_LAS unsigned*)(lds + (bufoff) + ldsw + _i * 8192), 16, 0, 0); } while (0)
#define PG8_LDA(dst, b, h) do { _Pragma("unroll") for (int m = 0; m < 4; ++m) _Pragma("unroll") for (int k = 0; k < 2; ++k) dst[m][k] = *(const PG8_LAS bf16x8*)(lds + PG8_SA(b, h) + aoff + m * 2048 + k * 1024); } while (0)
#define PG8_LDB(dst, b, h) do { _Pragma("unroll") for (int n = 0; n < 2; ++n) _Pragma("unroll") for (int k = 0; k < 2; ++k) dst[n][k] = *(const PG8_LAS bf16x8*)(lds + PG8_SB(b, h) + boff + n * 2048 + k * 1024); } while (0)
#define PG8_MMA(ai, bj, At, Bt) do { __builtin_amdgcn_s_setprio(1); _Pragma("unroll") for (int m = 0; m < 4; ++m) _Pragma("unroll") for (int n = 0; n < 2; ++n) _Pragma("unroll") for (int k = 0; k < 2; ++k) \
        acc[ai][bj][m][n] = __builtin_amdgcn_mfma_f32_16x16x32_bf16(Bt[n][k], At[m][k], acc[ai][bj][m][n], 0, 0, 0); __builtin_amdgcn_s_setprio(0); } while (0)
#define PG8_WAIT_V(n) asm volatile("s_waitcnt vmcnt(" #n ")" ::: "memory")
#define PG8_WAIT_L(n) asm volatile("s_waitcnt lgkmcnt(" #n ")" ::: "memory")
#define PG8_BAR __builtin_amdgcn_s_barrier()
#define PG8_SCHED __builtin_amdgcn_sched_barrier(0)
    Unit cur, nxt; int ui = 0;
    if (!S.next(0, cur)) return;
    f32x4 acc[2][2][4][2];
#pragma unroll
    for (int a = 0; a < 2; ++a)
#pragma unroll
        for (int b = 0; b < 2; ++b)
#pragma unroll
            for (int m = 0; m < 4; ++m)
#pragma unroll
                for (int n = 0; n < 2; ++n) acc[a][b][m][n] = (f32x4){0.f, 0.f, 0.f, 0.f};
    bf16x8 At[4][2], B0[2][2], B1[2][2];
    const char* cA = (const char*)g.A + (size_t)cur.lm * tstep; const char* cB = (const char*)g.Bt + (size_t)cur.ln * tstep;
    S.a_ready(cur);
    if constexpr (SP2) {
        PG8_STAGE(PG8_SB(0, 0), cB, voffB); PG8_STAGE(PG8_SB(0, 1), cB + hstep, voffB); PG8_STAGE(PG8_SA(0, 0), cA, voffA); PG8_STAGE(PG8_SA(0, 1), cA + hstep, voffA);
        if (wr == 1) PG8_BAR;
        PG8_WAIT_V(2); PG8_BAR;
        PG8_STAGE(PG8_SB(1, 0), cB + kstep, voffB); PG8_STAGE(PG8_SA(1, 0), cA + kstep, voffA); PG8_STAGE(PG8_SB(1, 1), cB + hstep + kstep, voffB);
        PG8_WAIT_V(6); PG8_BAR;
    } else {
        PG8_STAGE(PG8_SB(0, 0), cB, voffB); PG8_STAGE(PG8_SA(0, 0), cA, voffA); PG8_STAGE(PG8_SB(0, 1), cB + hstep, voffB); PG8_STAGE(PG8_SA(0, 1), cA + hstep, voffA);
        if (wr == 1) PG8_BAR;
        PG8_WAIT_V(4); PG8_BAR;
        PG8_STAGE(PG8_SB(1, 0), cB + kstep, voffB); PG8_STAGE(PG8_SA(1, 0), cA + kstep, voffA); PG8_STAGE(PG8_SB(1, 1), cB + hstep + kstep, voffB);
        PG8_WAIT_V(6); PG8_BAR;
    }
    for (;;) {
        const bool has_next = S.next(ui + 1, nxt);
        const char* nA = has_next ? (const char*)g.A + (size_t)nxt.lm * tstep : cA; const char* nB = has_next ? (const char*)g.Bt + (size_t)nxt.ln * tstep : cB;
        for (int t = 0; t < nt; t += 2) {
            const bool last = (t == nt - 2);
            const char* a1 = cA + (size_t)(t + 1) * kstep;
            const char* a2 = last ? nA : cA + (size_t)(t + 2) * kstep; const char* b2 = last ? nB : cB + (size_t)(t + 2) * kstep;
            const char* a3 = a2 + kstep; const char* b3 = b2 + kstep;
            if (last && has_next) S.a_ready(nxt);
            if constexpr (SP2) {
            PG8_LDB(B0, 0, 0); PG8_LDB(B1, 0, 1); PG8_SCHED; PG8_LDA(At, 0, 0); PG8_STAGE(PG8_SA(1, 1), a1 + hstep, voffA);
            PG8_WAIT_V(8); PG8_WAIT_L(0); PG8_BAR; PG8_MMA(0, 0, At, B0); PG8_MMA(0, 1, At, B1); PG8_BAR; PG8_SCHED;
            PG8_LDA(At, 0, 1); PG8_STAGE(PG8_SB(0, 0), b2, voffB); PG8_STAGE(PG8_SB(0, 1), b2 + hstep, voffB); PG8_STAGE(PG8_SA(0, 0), a2, voffA);
            PG8_WAIT_V(8); PG8_WAIT_L(0); PG8_BAR; PG8_MMA(1, 0, At, B0); PG8_MMA(1, 1, At, B1); PG8_BAR; PG8_SCHED;
            PG8_LDB(B0, 1, 0); PG8_LDB(B1, 1, 1); PG8_SCHED; PG8_LDA(At, 1, 0); PG8_STAGE(PG8_SA(0, 1), a2 + hstep, voffA);
            PG8_WAIT_V(8); PG8_WAIT_L(0); PG8_BAR; PG8_MMA(0, 0, At, B0); PG8_MMA(0, 1, At, B1); PG8_BAR; PG8_SCHED;
            PG8_LDA(At, 1, 1); PG8_STAGE(PG8_SB(1, 0), b3, voffB); PG8_STAGE(PG8_SB(1, 1), b3 + hstep, voffB); PG8_STAGE(PG8_SA(1, 0), a3, voffA);
            PG8_WAIT_V(8); PG8_WAIT_L(0); PG8_BAR; PG8_MMA(1, 0, At, B0); PG8_MMA(1, 1, At, B1); PG8_BAR; PG8_SCHED;
            } else {
            PG8_LDB(B0, 0, 0); PG8_SCHED; PG8_LDA(At, 0, 0); PG8_STAGE(PG8_SA(1, 1), a1 + hstep, voffA);
            PG8_WAIT_L(8); PG8_BAR; PG8_WAIT_L(0); PG8_MMA(0, 0, At, B0); PG8_BAR; PG8_SCHED;
            PG8_LDB(B1, 0, 1); PG8_STAGE(PG8_SB(0, 0), b2, voffB);
            PG8_BAR; PG8_WAIT_L(0); PG8_MMA(0, 1, At, B1); PG8_BAR;
            PG8_LDA(At, 0, 1); PG8_STAGE(PG8_SA(0, 0), a2, voffA);
            PG8_BAR; PG8_WAIT_L(0); PG8_MMA(1, 0, At, B0); PG8_BAR; PG8_SCHED;
            PG8_STAGE(PG8_SB(0, 1), b2 + hstep, voffB);
            PG8_WAIT_V(6); PG8_BAR; PG8_MMA(1, 1, At, B1); PG8_BAR;
            PG8_LDB(B0, 1, 0); PG8_SCHED; PG8_LDA(At, 1, 0); PG8_STAGE(PG8_SA(0, 1), a2 + hstep, voffA);
            PG8_WAIT_L(8); PG8_BAR; PG8_WAIT_L(0); PG8_MMA(0, 0, At, B0); PG8_BAR; PG8_SCHED;
            PG8_LDB(B1, 1, 1); PG8_STAGE(PG8_SB(1, 0), b3, voffB);
            PG8_BAR; PG8_WAIT_L(0); PG8_MMA(0, 1, At, B1); PG8_BAR;
            PG8_LDA(At, 1, 1); PG8_STAGE(PG8_SA(1, 0), a3, voffA);
            PG8_BAR; PG8_WAIT_L(0); PG8_MMA(1, 0, At, B0); PG8_BAR; PG8_SCHED;
            PG8_STAGE(PG8_SB(1, 1), b3 + hstep, voffB);
            PG8_WAIT_V(6); PG8_BAR; PG8_MMA(1, 1, At, B1); PG8_BAR;
            }
        }
        if constexpr (ALIGN_EPI) { if (wr == 0) PG8_BAR; }
        if constexpr (!Epi::AFTER_DRAIN) { E(acc, cur, wr, wc, fr, fq); if (S.epi2) E(acc, cur, wr, wc, fr, fq); S.done(cur); }
        if (!has_next) break;
#pragma unroll
        for (int a = 0; a < 2; ++a)
#pragma unroll
            for (int b = 0; b < 2; ++b)
#pragma unroll
                for (int m = 0; m < 4; ++m)
#pragma unroll
                    for (int n = 0; n < 2; ++n) acc[a][b][m][n] = (f32x4){0.f, 0.f, 0.f, 0.f};
        cur = nxt; cA = nA; cB = nB; ++ui;
        if constexpr (ALIGN_EPI) { if (wr == 1) PG8_BAR; }
    }
    PG8_WAIT_V(0);
    if constexpr (!ALIGN_EPI) { if (wr == 0) PG8_BAR; }
    PG8_BAR;
    if constexpr (Epi::AFTER_DRAIN) { E.fused(acc, cur, wr, wc, fr, fq, lds, wid, lane); S.done(cur); }
#undef PG8_SA
#undef PG8_SB
#undef PG8_STAGE
#undef PG8_LDA
#undef PG8_LDB
#undef PG8_MMA
#undef PG8_WAIT_V
#undef PG8_WAIT_L
#undef PG8_BAR
#undef PG8_SCHED
}
}
namespace fa {
#define FA_LAS __attribute__((address_space(3)))
typedef short bf16x8 __attribute__((ext_vector_type(8)));
typedef short s16x4 __attribute__((ext_vector_type(4)));
typedef short v4i16_t __attribute__((ext_vector_type(4)));
typedef float f32x16 __attribute__((ext_vector_type(16)));
typedef float f32x4 __attribute__((ext_vector_type(4)));
typedef unsigned u32x4 __attribute__((ext_vector_type(4)));
typedef float f32x2_t __attribute__((ext_vector_type(2))); typedef __bf16 bf16x2_t __attribute__((ext_vector_type(2)));
constexpr float THR = 8.f, TH_SKIP = 32.f;
constexpr int F_KBUF = 18432, F_AOFF = 8192, F_VOFF = 10240, F_WSF = 3 * F_KBUF, F_FLAG = F_WSF + 8 * 256, F_OST = F_FLAG + 256, F_LDS_BYTES = F_OST + 8 * 4096;
constexpr int S_KBUF = 16384, S_VOFF = 8192, S_WSF = 6 * S_KBUF, S_OST = S_WSF + 8 * 256, S_LDS_BYTES = S_OST + 8 * 4096;
struct Params { const bf16_t* Q; const bf16_t* K; const bf16_t* V; const bf16_t* G; bf16_t* O; const float* CUM; const float* sinks; const unsigned* KMAX; unsigned* ticket; const bf16_t* KAUG; };
__device__ __forceinline__ unsigned cvtpk(float lo, float hi) { f32x2_t v = {lo, hi}; bf16x2_t b = __builtin_convertvector(v, bf16x2_t); return __builtin_bit_cast(unsigned, b); }
__device__ __forceinline__ s16x4 vtr(FA_LAS unsigned char* p) { return __builtin_bit_cast(s16x4, __builtin_amdgcn_ds_read_tr16_b64_v4i16((FA_LAS v4i16_t*)p)); }
__device__ __forceinline__ float swap_max(float v) { auto rr = __builtin_amdgcn_permlane32_swap(__float_as_uint(v), __float_as_uint(v), false, false); return __builtin_fmaxf(__uint_as_float(rr[0]), __uint_as_float(rr[1])); }
__device__ __forceinline__ float swap_add(float v) { auto rr = __builtin_amdgcn_permlane32_swap(__float_as_uint(v), __float_as_uint(v), false, false); return __uint_as_float(rr[0]) + __uint_as_float(rr[1]); }
__device__ __forceinline__ void glds16(const void* gsrc, unsigned lds_dst) { unsigned keep;
    asm volatile("s_mov_b32 %0, m0\n\ts_mov_b32 m0, %2\n\ts_nop 0\n\tglobal_load_lds_dwordx4 %1, off\n\ts_mov_b32 m0, %0" : "=&s"(keep) : "v"(gsrc), "s"(lds_dst) : "memory"); }
#define FA_MFMA(a, b, c) __builtin_amdgcn_mfma_f32_32x32x16_bf16((a), (b), (c), 0, 0, 0)
#define FA_MX3(a, b, c) __builtin_fmaxf(__builtin_fmaxf((a), (b)), (c))
struct WaveSt { bf16x8 qr[4]; bf16x8 qa; f32x16 o0, o1; float cq, mhat, lsum, mrun; };

#define FA_SBAR() __builtin_amdgcn_sched_barrier(0)
#define FA_PIN(x) asm volatile("" : "+v"(x))
#define FA_LDK(p) (*(FA_LAS bf16x8*)(p))
#define FA_VF(l, h) ((bf16x8){l[0], l[1], l[2], l[3], h[0], h[1], h[2], h[3]})
#define FA_EX4(X, B) do { X[B] = __builtin_amdgcn_exp2f(X[B]); X[B + 1] = __builtin_amdgcn_exp2f(X[B + 1]); X[B + 2] = __builtin_amdgcn_exp2f(X[B + 2]); X[B + 3] = __builtin_amdgcn_exp2f(X[B + 3]); } while (0)
__device__ __forceinline__ void split3(float v, unsigned& h1, unsigned& h2, unsigned& h3) { const bf16_t a = f2bf(v); const float r1 = v - bf2f(a); const bf16_t b = f2bf(r1); const float r2 = r1 - bf2f(b); h1 = a; h2 = b; h3 = f2bf(r2); }
__device__ __forceinline__ void set_qa(WaveSt& w, int hi) {
    unsigned g1, g2, g3; split3(w.cq - w.mhat, g1, g2, g3);
    const u32x4 q = {hi == 0 ? 0x3F803F80u : 0u, hi == 0 ? (0x3F80u | (g1 << 16)) : 0u, hi == 0 ? (g2 | (g3 << 16)) : 0u, 0u};
    w.qa = __builtin_bit_cast(bf16x8, q);
}
template <int MODE, int AOFF, int VOFF>
__device__ __forceinline__ void tile_full(FA_LAS unsigned char* bb, FA_LAS unsigned char* vprev, FA_LAS float* wsf, WaveSt& w, f32x16& C0, f32x16& C1, f32x16& P0, f32x16& P1,
                                          int k0, int t, int qlo, int lane, int r32, int hi) {
    constexpr int W = MODE == 0 ? 0x40000000 : 128;
    FA_LAS unsigned char* kp = bb + hi * 1024 + r32 * 16; FA_LAS unsigned char* ap = bb + AOFF + r32 * 16;
    FA_LAS unsigned char* vp = vprev + VOFF + ((lane >> 4) & 1) * 32 + (lane & 3) * 8 + (4 * hi + ((lane & 15) >> 2)) * 64;
    bf16x8 kf0 = FA_LDK(kp), kf1 = FA_LDK(kp + 512), kf2 = FA_LDK(kp + 2048), kf3 = FA_LDK(kp + 2560), kf4, kf5, kf6, kf7, ka0, ka1;
    s16x4 vl0, vh0, vl1, vh1, vl2, vh2, vl3, vh3, vl4, vh4, vl5, vh5, vl6, vh6, vl7, vh7;
    u32x4 pw0, pw1, pw2, pw3; float sacc;
    const f32x16 Z = {0.f, 0.f, 0.f, 0.f, 0.f, 0.f, 0.f, 0.f, 0.f, 0.f, 0.f, 0.f, 0.f, 0.f, 0.f, 0.f};
    FA_SBAR();
    C0 = FA_MFMA(kf0, w.qr[0], Z); kf4 = FA_LDK(kp + 4096);
    sacc = (P0[0] + P0[1]) + (P0[2] + P0[3]); pw0.x = cvtpk(P0[0], P0[1]); pw0.y = cvtpk(P0[2], P0[3]); FA_PIN(sacc); FA_PIN(pw0.x); FA_PIN(pw0.y);
    FA_SBAR();
    C1 = FA_MFMA(kf1, w.qr[0], Z); kf5 = FA_LDK(kp + 4608);
    sacc += P0[4]; sacc += P0[5]; sacc += P0[6]; sacc += P0[7]; pw0.z = cvtpk(P0[4], P0[5]); pw0.w = cvtpk(P0[6], P0[7]); FA_PIN(sacc); FA_PIN(pw0.z); FA_PIN(pw0.w);
    FA_SBAR();
    C0 = FA_MFMA(kf2, w.qr[1], C0); kf6 = FA_LDK(kp + 6144);
    sacc += P0[8]; sacc += P0[9]; sacc += P0[10]; sacc += P0[11]; pw1.x = cvtpk(P0[8], P0[9]); pw1.y = cvtpk(P0[10], P0[11]); FA_PIN(sacc); FA_PIN(pw1.x); FA_PIN(pw1.y);
    FA_SBAR();
    C1 = FA_MFMA(kf3, w.qr[1], C1); kf7 = FA_LDK(kp + 6656);
    sacc += P0[12]; sacc += P0[13]; sacc += P0[14]; sacc += P0[15]; pw1.z = cvtpk(P0[12], P0[13]); pw1.w = cvtpk(P0[14], P0[15]); FA_PIN(sacc); FA_PIN(pw1.z); FA_PIN(pw1.w);
    FA_SBAR();
    C0 = FA_MFMA(kf4, w.qr[2], C0); if (MODE == 0) { ka0 = FA_LDK(ap); ka1 = FA_LDK(ap + 512); } else { const u32x4 kc = {0u, 0x3F800000u, 0x3F803F80u, 0u}; ka0 = __builtin_bit_cast(bf16x8, kc); ka1 = ka0; }
    sacc += P1[0]; sacc += P1[1]; sacc += P1[2]; sacc += P1[3]; pw2.x = cvtpk(P1[0], P1[1]); pw2.y = cvtpk(P1[2], P1[3]); FA_PIN(sacc); FA_PIN(pw2.x); FA_PIN(pw2.y);
    FA_SBAR();
    C1 = FA_MFMA(kf5, w.qr[2], C1); vl0 = vtr(vp); vh0 = vtr(vp + 512);
    sacc += P1[4]; sacc += P1[5]; sacc += P1[6]; sacc += P1[7]; pw2.z = cvtpk(P1[4], P1[5]); pw2.w = cvtpk(P1[6], P1[7]); FA_PIN(sacc); FA_PIN(pw2.z); FA_PIN(pw2.w);
    FA_SBAR();
    C0 = FA_MFMA(kf6, w.qr[3], C0); vl4 = vtr(vp + 4096); vh4 = vtr(vp + 4096 + 512);
    sacc += P1[8]; sacc += P1[9]; sacc += P1[10]; sacc += P1[11]; pw3.x = cvtpk(P1[8], P1[9]); pw3.y = cvtpk(P1[10], P1[11]); FA_PIN(sacc); FA_PIN(pw3.x); FA_PIN(pw3.y);
    FA_SBAR();
    C1 = FA_MFMA(kf7, w.qr[3], C1); vl1 = vtr(vp + 1024); vh1 = vtr(vp + 1024 + 512);
    sacc += P1[12]; sacc += P1[13]; sacc += P1[14]; sacc += P1[15]; pw3.z = cvtpk(P1[12], P1[13]); pw3.w = cvtpk(P1[14], P1[15]); FA_PIN(sacc); FA_PIN(pw3.z); FA_PIN(pw3.w);
    FA_SBAR();
    C0 = FA_MFMA(ka0, w.qa, C0); vl5 = vtr(vp + 4096 + 1024); vh5 = vtr(vp + 4096 + 1024 + 512); FA_SBAR();
    C1 = FA_MFMA(ka1, w.qa, C1); FA_SBAR();
    w.lsum += sacc;
    const bf16x8 pa0 = __builtin_bit_cast(bf16x8, pw0), pa1 = __builtin_bit_cast(bf16x8, pw1), pa2 = __builtin_bit_cast(bf16x8, pw2), pa3 = __builtin_bit_cast(bf16x8, pw3);
    vl2 = vtr(vp + 2048); vh2 = vtr(vp + 2048 + 512);
    w.o0 = FA_MFMA(pa0, FA_VF(vl0, vh0), w.o0); vl6 = vtr(vp + 4096 + 2048); vh6 = vtr(vp + 4096 + 2048 + 512);
    w.o1 = FA_MFMA(pa0, FA_VF(vl4, vh4), w.o1);
    FA_SBAR();
    if ((k0 + 63 > qlo) || (MODE == 1 && k0 <= qlo + 31 - W)) {
        const float NEG = -__builtin_inff(); const int dq = t - k0 - 4 * hi;
#pragma unroll
        for (int r = 0; r < 16; ++r) { const int c = (r & 3) + 8 * (r >> 2); if ((unsigned)(dq - c) >= (unsigned)W) C0[r] = NEG; if ((unsigned)(dq - c - 32) >= (unsigned)W) C1[r] = NEG; }
    }
    float ma = FA_MX3(C0[0], C0[1], C1[0]), mb = FA_MX3(C0[2], C0[3], C1[1]); ma = FA_MX3(ma, C1[2], C1[3]);
#pragma unroll
    for (int r = 4; r < 16; r += 4) { ma = FA_MX3(ma, C0[r], C0[r + 1]); mb = FA_MX3(mb, C0[r + 2], C0[r + 3]); ma = FA_MX3(ma, C1[r], C1[r + 1]); mb = FA_MX3(mb, C1[r + 2], C1[r + 3]); }
    const float rm = swap_max(__builtin_fmaxf(ma, mb));
    if (MODE == 0) w.mrun = __builtin_fmaxf(w.mrun, rm + w.mhat);
    const bool resc = __any(rm > THR);
    if (resc) {
        const float dl = __builtin_fmaxf(rm, 0.f); w.mhat += dl;
#pragma unroll
        for (int r = 0; r < 16; ++r) { C0[r] -= dl; C1[r] -= dl; }
        set_qa(w, hi);
        const float f = __builtin_amdgcn_exp2f(-dl); w.lsum *= f;
        if (hi == 0) wsf[r32] = f;
    }
    FA_SBAR();
    FA_EX4(C0, 0); FA_PIN(C0); vl3 = vtr(vp + 3072); vh3 = vtr(vp + 3072 + 512);
    w.o0 = FA_MFMA(pa1, FA_VF(vl1, vh1), w.o0); FA_EX4(C0, 4); FA_EX4(C0, 8); FA_PIN(C0); vl7 = vtr(vp + 4096 + 3072); vh7 = vtr(vp + 4096 + 3072 + 512); FA_SBAR();
    w.o1 = FA_MFMA(pa1, FA_VF(vl5, vh5), w.o1); FA_EX4(C0, 12); FA_PIN(C0); FA_EX4(C1, 0); FA_PIN(C1); FA_SBAR();
    w.o0 = FA_MFMA(pa2, FA_VF(vl2, vh2), w.o0); FA_EX4(C1, 4); FA_PIN(C1); FA_SBAR();
    w.o1 = FA_MFMA(pa2, FA_VF(vl6, vh6), w.o1); FA_EX4(C1, 8); FA_PIN(C1); FA_SBAR();
    w.o0 = FA_MFMA(pa3, FA_VF(vl3, vh3), w.o0); FA_EX4(C1, 12); FA_PIN(C1); FA_SBAR();
    w.o1 = FA_MFMA(pa3, FA_VF(vl7, vh7), w.o1); FA_SBAR();
    if (resc) {
        asm volatile("s_waitcnt lgkmcnt(0)" ::: "memory");
#pragma unroll
        for (int g = 0; g < 4; ++g) { const f32x4 a4 = *(FA_LAS f32x4*)(wsf + 8 * g + 4 * hi);
#pragma unroll
            for (int i = 0; i < 4; ++i) { w.o0[4 * g + i] *= a4[i]; w.o1[4 * g + i] *= a4[i]; } }
    }
}
template <int VOFF>
__device__ __forceinline__ void drain_full(FA_LAS unsigned char* vlast, WaveSt& w, f32x16& P0, f32x16& P1, int lane, int hi) {
    FA_LAS unsigned char* vp = vlast + VOFF + ((lane >> 4) & 1) * 32 + (lane & 3) * 8 + (4 * hi + ((lane & 15) >> 2)) * 64;
    float s0 = 0.f, s1 = 0.f;
#pragma unroll
    for (int r = 0; r < 16; ++r) { s0 += P0[r]; s1 += P1[r]; }
    w.lsum += s0 + s1;
    const u32x4 w0 = {cvtpk(P0[0], P0[1]), cvtpk(P0[2], P0[3]), cvtpk(P0[4], P0[5]), cvtpk(P0[6], P0[7])};
    const u32x4 w1 = {cvtpk(P0[8], P0[9]), cvtpk(P0[10], P0[11]), cvtpk(P0[12], P0[13]), cvtpk(P0[14], P0[15])};
    const u32x4 w2 = {cvtpk(P1[0], P1[1]), cvtpk(P1[2], P1[3]), cvtpk(P1[4], P1[5]), cvtpk(P1[6], P1[7])};
    const u32x4 w3 = {cvtpk(P1[8], P1[9]), cvtpk(P1[10], P1[11]), cvtpk(P1[12], P1[13]), cvtpk(P1[14], P1[15])};
    const bf16x8 pa0 = __builtin_bit_cast(bf16x8, w0), pa1 = __builtin_bit_cast(bf16x8, w1), pa2 = __builtin_bit_cast(bf16x8, w2), pa3 = __builtin_bit_cast(bf16x8, w3);
#define FA_PV(ks, pa) do { const s16x4 l0_ = vtr(vp + (ks) * 1024), h0_ = vtr(vp + (ks) * 1024 + 512), l1_ = vtr(vp + 4096 + (ks) * 1024), h1_ = vtr(vp + 4096 + (ks) * 1024 + 512); \
    w.o0 = FA_MFMA(pa, FA_VF(l0_, h0_), w.o0); w.o1 = FA_MFMA(pa, FA_VF(l1_, h1_), w.o1); } while (0)
    FA_PV(0, pa0); FA_PV(1, pa1); FA_PV(2, pa2); FA_PV(3, pa3);
#undef FA_PV
}
__device__ __forceinline__ void load_gate(u32x4 (&gq)[4], const bf16_t* G, size_t grow, int h, int lane) {
#pragma unroll
    for (int d0 = 0; d0 < 2; ++d0)
#pragma unroll
        for (int i = 0; i < 2; ++i) gq[2 * d0 + i] = *(const u32x4*)(G + hm_off((int)grow + i * 16 + (lane >> 2), h * 64 + d0 * 32 + (lane & 3) * 8, NH));
}
__device__ __forceinline__ void wave_epilogue(FA_LAS float* stg, FA_LAS float* wsf, WaveSt& w, const u32x4 (&gq)[4], bf16_t* O, size_t grow, int h, int lane, int r32, int hi) {
    const float l = swap_add(w.lsum);
    if (hi == 0) wsf[r32] = l;
    asm volatile("s_waitcnt lgkmcnt(0)" ::: "memory");
    float rl[16];
#pragma unroll
    for (int g = 0; g < 4; ++g) { const f32x4 l4 = *(FA_LAS f32x4*)(wsf + 8 * g + 4 * hi);
#pragma unroll
        for (int i = 0; i < 4; ++i) rl[4 * g + i] = 1.0f / l4[i]; }
#pragma unroll
    for (int d0 = 0; d0 < 2; ++d0) {
#pragma unroll
        for (int g = 0; g < 4; ++g)
#pragma unroll
            for (int i = 0; i < 4; ++i) stg[(8 * g + 4 * hi + i) * 32 + r32] = (d0 == 0 ? w.o0[4 * g + i] : w.o1[4 * g + i]) * rl[4 * g + i];
        asm volatile("s_waitcnt lgkmcnt(0)" ::: "memory");
#pragma unroll
        for (int i = 0; i < 2; ++i) { const int row = i * 16 + (lane >> 2), ch = lane & 3;
            const f32x4 x0 = *(FA_LAS f32x4*)(stg + row * 32 + ch * 8), x1 = *(FA_LAS f32x4*)(stg + row * 32 + ch * 8 + 4);
            const size_t ga = (grow + row) * DM + h * 64 + d0 * 32 + ch * 8; const u32x4 gv = gq[2 * d0 + i];
            u32x4 ov;
            ov.x = cvtpk(x0[0] * __uint_as_float(gv.x << 16), x0[1] * __uint_as_float(gv.x & 0xffff0000u)); ov.y = cvtpk(x0[2] * __uint_as_float(gv.y << 16), x0[3] * __uint_as_float(gv.y & 0xffff0000u));
            ov.z = cvtpk(x1[0] * __uint_as_float(gv.z << 16), x1[1] * __uint_as_float(gv.z & 0xffff0000u)); ov.w = cvtpk(x1[2] * __uint_as_float(gv.w << 16), x1[3] * __uint_as_float(gv.w & 0xffff0000u));
            *(u32x4*)(O + tiled_off((int)(grow + row), h * 64 + d0 * 32 + ch * 8)) = ov; }
        asm volatile("s_waitcnt lgkmcnt(0)" ::: "memory");
    }
}
template <int MODE> __device__ __forceinline__ void wave_init(WaveSt& w, int hi) {
#pragma unroll
    for (int r = 0; r < 16; ++r) { w.o0[r] = 0.f; w.o1[r] = 0.f; }
    set_qa(w, hi);
}

__device__ __forceinline__ void fox_unit(FA_LAS unsigned char* lds, const Params& P, int b, int h, int qb) {
    const int tid = threadIdx.x, lane = tid & 63, r32 = lane & 31, hi = lane >> 5;
    const int wid = __builtin_amdgcn_readfirstlane(tid >> 6);
    const int q0 = qb * 256, qlo = q0 + wid * 32, t = qlo + r32;
    const size_t rowbase = (size_t)b * SEQ;
    const bf16_t* ksrc = P.K + hm_off((int)rowbase + lane, h * 64 + wid * 8, NH);
    const bf16_t* vsrc = P.V + hm_off((int)rowbase + 16 * (wid & 3) + (lane >> 2), h * 64 + (wid >> 2) * 32 + (lane & 3) * 8, NH);
    const float* cum = P.CUM + (size_t)(b * NH + h) * SEQ;
    const bf16_t* asrc = P.KAUG + ((size_t)(b * NH + h) * SEQ + lane) * 8;
    const int NT = (q0 + 256) / 64;
    WaveSt w; float qn = 0.f;
#pragma unroll
    for (int d0 = 0; d0 < 4; ++d0) { w.qr[d0] = *(const bf16x8*)(P.Q + hm_off((int)rowbase + t, h * 64 + d0 * 16 + hi * 8, NH));
#pragma unroll
        for (int j = 0; j < 8; ++j) { const float qv = bf2f((bf16_t)w.qr[d0][j]); qn = fmaf(qv, qv, qn); } }
    w.cq = cum[t]; w.mhat = 0.f; w.lsum = 0.f; w.mrun = -1e30f;
    wave_init<0>(w, hi);
    u32x4 gq[4]; load_gate(gq, P.G, rowbase + qlo, h, lane);
    const float qkb = sqrtf(swap_add(qn) * (__uint_as_float(P.KMAX[(b * NH + h) * 2]) + __uint_as_float(P.KMAX[(b * NH + h) * 2 + 1]))) * 1.01f + 1e-3f;
    FA_LAS float* wsf = (FA_LAS float*)(lds + F_WSF) + wid * 64;
    FA_LAS unsigned* votes = (FA_LAS unsigned*)(lds + F_FLAG);
    float cnew = 0.f;
#define FA_LOADT(j, bf) do { const size_t ko_ = (size_t)(j) * 64 * 32; FA_LAS unsigned char* bb_ = lds + (bf) * F_KBUF; \
        glds16(ksrc + ko_, (unsigned)__builtin_amdgcn_readfirstlane((int)(unsigned)(uintptr_t)(bb_ + wid * 1024))); \
        glds16(vsrc + ko_, (unsigned)__builtin_amdgcn_readfirstlane((int)(unsigned)(uintptr_t)(bb_ + F_VOFF + (wid >> 2) * 4096 + (wid & 3) * 1024))); \
        if (wid == 0) glds16(asrc + (size_t)(j) * 64 * 8, (unsigned)__builtin_amdgcn_readfirstlane((int)(unsigned)(uintptr_t)(bb_ + F_AOFF))); \
        cnew = cum[(j) * 64 + 63]; } while (0)
    FA_LOADT(NT - 1, 0); asm volatile("s_waitcnt vmcnt(0)" ::: "memory"); __syncthreads();
    bool wdone = false; int n = 0; f32x16 pA0, pA1, pB0, pB1;
#pragma unroll
    for (int r = 0; r < 16; ++r) { pA0[r] = 0.f; pA1[r] = 0.f; pB0[r] = 0.f; pB1[r] = 0.f; }
    int cur = 0; bool fin = false;
#define FA_WALK(tt, CA0, CA1, PA0, PA1) do { \
        const int j = NT - 1 - (tt), k0 = j * 64; const int nxt = cur == 2 ? 0 : cur + 1, prv = cur == 0 ? 2 : cur - 1; \
        if (j > 0) FA_LOADT(j - 1, nxt); \
        if (!wdone && k0 <= qlo + 31) { FA_LAS unsigned char* bb = lds + cur * F_KBUF; \
            tile_full<0, F_AOFF, F_VOFF>(bb, n > 0 ? lds + prv * F_KBUF : bb, wsf, w, CA0, CA1, PA0, PA1, k0, t, qlo, lane, r32, hi); ++n; } \
        if (j > 0) { \
            if (!wdone && n > 0 && __all(qkb + w.cq - cnew - w.mrun <= -TH_SKIP)) { wdone = true; drain_full<F_VOFF>(lds + cur * F_KBUF, w, CA0, CA1, lane, hi); } \
            if (lane == 0) votes[((tt) & 1) * 8 + wid] = wdone ? 1u : 0u; } \
        asm volatile("s_waitcnt vmcnt(0)" ::: "memory"); \
        __syncthreads(); \
        if (j > 0) { const u32x4 v0 = *(FA_LAS u32x4*)(votes + ((tt) & 1) * 8), v1 = *(FA_LAS u32x4*)(votes + ((tt) & 1) * 8 + 4); \
            if ((v0.x & v0.y & v0.z & v0.w & v1.x & v1.y & v1.z & v1.w) != 0u) fin = true; } \
        else { if (!wdone && n > 0) drain_full<F_VOFF>(lds + cur * F_KBUF, w, CA0, CA1, lane, hi); fin = true; } \
        cur = nxt; } while (0)
    for (int tt = 0; !fin; tt += 2) {
        FA_WALK(tt, pA0, pA1, pB0, pB1);
        if (fin) break;
        FA_WALK(tt + 1, pB0, pB1, pA0, pA1);
    }
#undef FA_WALK
#undef FA_LOADT
    wave_epilogue((FA_LAS float*)(lds + F_OST + wid * 4096), wsf, w, gq, P.O, rowbase + qlo, h, lane, r32, hi);
    __syncthreads();
}
__device__ __forceinline__ void swa_unit(FA_LAS unsigned char* lds, const Params& P, int b, int kvh, int qb) {
    const int tid = threadIdx.x, lane = tid & 63, r32 = lane & 31, hi = lane >> 5;
    const int wid = __builtin_amdgcn_readfirstlane(tid >> 6);
    const int q0 = qb * 256, qlo = q0 + wid * 32, t = qlo + r32;
    const size_t rowbase = (size_t)b * SEQ;
    const int j_lo = q0 >= 128 ? (q0 - 128) / 64 : 0, NT = (q0 + 256) / 64 - j_lo;
    const bf16_t* ksrc = P.K + hm_off((int)rowbase + j_lo * 64 + lane, kvh * 64 + wid * 8, 4);
    const bf16_t* vsrc = P.V + hm_off((int)rowbase + j_lo * 64 + 16 * (wid & 3) + (lane >> 2), kvh * 64 + (wid >> 2) * 32 + (lane & 3) * 8, 4);
    for (int i = 0; i < NT; ++i) {
        glds16(ksrc + (size_t)i * 64 * 32, (unsigned)__builtin_amdgcn_readfirstlane((int)(unsigned)(uintptr_t)(lds + i * S_KBUF + wid * 1024)));
        glds16(vsrc + (size_t)i * 64 * 32, (unsigned)__builtin_amdgcn_readfirstlane((int)(unsigned)(uintptr_t)(lds + i * S_KBUF + S_VOFF + (wid >> 2) * 4096 + (wid & 3) * 1024))); }
    asm volatile("s_waitcnt vmcnt(0)" ::: "memory");
    __syncthreads();
    FA_LAS float* wsf = (FA_LAS float*)(lds + S_WSF) + wid * 64;
    const int ta = (qlo >= 127 ? (qlo - 127) / 64 : 0) - j_lo, tb = (qlo + 31) / 64 - j_lo;
    for (int hh = 0; hh < 8; ++hh) {
        const int h = kvh * 8 + hh;
        WaveSt w;
#pragma unroll
        for (int d0 = 0; d0 < 4; ++d0) w.qr[d0] = *(const bf16x8*)(P.Q + hm_off((int)rowbase + t, h * 64 + d0 * 16 + hi * 8, NH));
        u32x4 gq[4]; load_gate(gq, P.G, rowbase + qlo, h, lane);
        w.cq = 0.f; w.mhat = P.sinks[h] * LOG2E; w.lsum = 0.5f; w.mrun = 0.f;
        wave_init<1>(w, hi);
        f32x16 pA0, pA1, pB0, pB1;
#pragma unroll
        for (int r = 0; r < 16; ++r) { pB0[r] = 0.f; pB1[r] = 0.f; }
        for (int ti = tb;;) {
            { FA_LAS unsigned char* bb = lds + ti * S_KBUF;
              tile_full<1, 0, S_VOFF>(bb, ti == tb ? bb : bb + S_KBUF, wsf, w, pA0, pA1, pB0, pB1, (j_lo + ti) * 64, t, qlo, lane, r32, hi); }
            if (ti == ta) { drain_full<S_VOFF>(lds + ta * S_KBUF, w, pA0, pA1, lane, hi); break; }
            --ti;
            { FA_LAS unsigned char* bb = lds + ti * S_KBUF;
              tile_full<1, 0, S_VOFF>(bb, bb + S_KBUF, wsf, w, pB0, pB1, pA0, pA1, (j_lo + ti) * 64, t, qlo, lane, r32, hi); }
            if (ti == ta) { drain_full<S_VOFF>(lds + ta * S_KBUF, w, pB0, pB1, lane, hi); break; }
            --ti;
        }
        wave_epilogue((FA_LAS float*)(lds + S_OST + wid * 4096), wsf, w, gq, P.O, rowbase + qlo, h, lane, r32, hi);
    }
    __syncthreads();
}
}
#define GAS __attribute__((address_space(1)))
#define LAS __attribute__((address_space(3)))
typedef unsigned short bf16;
typedef unsigned v4u __attribute__((ext_vector_type(4)));
typedef float f32x4 __attribute__((ext_vector_type(4)));
typedef short bf16x8 __attribute__((ext_vector_type(8)));
typedef GAS unsigned gu32;
typedef GAS unsigned long long gu64;
#define RLX_AGENT __ATOMIC_RELAXED, __HIP_MEMORY_SCOPE_AGENT
#define LDS_WAIT() asm volatile("s_waitcnt lgkmcnt(0)" ::: "memory")
#define VM_WAIT() asm volatile("s_waitcnt vmcnt(0)" ::: "memory")
__device__ __forceinline__ unsigned long long rt() { return __builtin_amdgcn_s_memrealtime(); }
__device__ __forceinline__ unsigned pk2(float lo, float hi) { return (unsigned)f2bf(lo) | ((unsigned)f2bf(hi) << 16); }
#define XB_TMO      128
#define XB_XCNT(j)  (256  + 64 * (j))
#define XB_XSUB(j)  (1280 + 64 * (j))
#define XB_XGEN(j)  (2304 + 64 * (j))
#define XB_TOP      3328
#define XB_TOPGEN   3392
#define XCD_BAR_WORDS 3456
#define XB_SPIN_CAP (1u << 18)

__device__ __forceinline__ unsigned xb_ld(unsigned* p)              { return __hip_atomic_load(p, __ATOMIC_RELAXED, __HIP_MEMORY_SCOPE_AGENT); }
__device__ __forceinline__ unsigned xb_add(unsigned* p, unsigned v) { return __hip_atomic_fetch_add(p, v, __ATOMIC_RELAXED, __HIP_MEMORY_SCOPE_AGENT); }
__device__ __forceinline__ unsigned xb_xcc_id() { return (unsigned)__builtin_amdgcn_s_getreg((3 << 11) | 20) & 0xFu; }
#define XB_SPIN(cond, bar) do { unsigned _sp = 0; while (cond) { __builtin_amdgcn_s_sleep(1); \
    if ((++_sp & 255u) == 0u) { if (xb_ld(&(bar)[XB_TMO])) break; if (_sp > XB_SPIN_CAP) { atomicAdd(&(bar)[XB_TMO], 1u); break; } } } } while (0)

struct XcdBarrier {
    unsigned* bar; unsigned x;
    volatile LAS unsigned* st;
};

__device__ __forceinline__ XcdBarrier xcd_barrier_post(unsigned* bar, volatile LAS unsigned* st) {
    XcdBarrier b; b.bar = bar; b.x = xb_xcc_id(); b.st = st;
    if (threadIdx.x == 0) (void)xb_add(&bar[XB_XCNT(b.x)], 1u);
    return b;
}
__device__ __forceinline__ void xcd_barrier_complete(unsigned* bar, unsigned x, unsigned& nloc, unsigned& nx) {
    const unsigned G = gridDim.x * gridDim.y * gridDim.z;
    unsigned sum, cnt, mine, sp = 0u;
    for (;;) {
        sum = 0u; cnt = 0u; mine = 0u;
#pragma unroll
        for (unsigned j = 0; j < 16; ++j) { const unsigned c = xb_ld(&bar[XB_XCNT(j)]); sum += c; cnt += (c > 0u) ? 1u : 0u; mine = (j == x) ? c : mine; }
        if (sum == G) break;
        __builtin_amdgcn_s_sleep(1);
        if ((++sp & 255u) == 0u) { if (xb_ld(&bar[XB_TMO])) break; if (sp > XB_SPIN_CAP) { atomicAdd(&bar[XB_TMO], 1u); break; } }
    }
    nloc = mine > 0u ? mine : 1u; nx = cnt > 0u ? cnt : 1u;
}

__device__ __forceinline__ void xcd_barrier(const XcdBarrier& b) {
    asm volatile("s_waitcnt vmcnt(0)" ::: "memory");
    __syncthreads();
    if (threadIdx.x == 0) {
        unsigned* bar = b.bar;
        __builtin_amdgcn_s_waitcnt(0);
        unsigned nloc = b.st[0], nx = b.st[1];
        if (nloc == 0u) { xcd_barrier_complete(bar, b.x, nloc, nx); b.st[0] = nloc; b.st[1] = nx; }
        const unsigned old = xb_add(&bar[XB_XSUB(b.x)], 1u);
        const unsigned gen = old / nloc;
        if (old + 1u == (gen + 1u) * nloc) {
            __builtin_amdgcn_fence(__ATOMIC_RELEASE, "agent");
            asm volatile("s_waitcnt vmcnt(0)" ::: "memory");
            const unsigned og = xb_add(&bar[XB_TOP], 1u);
            const unsigned tg = og / nx;
            if (og + 1u == (tg + 1u) * nx) xb_add(&bar[XB_TOPGEN], 1u);
            else XB_SPIN(xb_ld(&bar[XB_TOPGEN]) == tg, bar);
            __builtin_amdgcn_fence(__ATOMIC_ACQUIRE, "agent");
            xb_add(&bar[XB_XGEN(b.x)], 1u);
            asm volatile("s_waitcnt vmcnt(0)" ::: "memory");
        } else {
            XB_SPIN(xb_ld(&bar[XB_XGEN(b.x)]) == gen, bar);
            __builtin_amdgcn_fence(__ATOMIC_ACQUIRE, "agent");
            asm volatile("s_waitcnt vmcnt(0)" ::: "memory");
        }
    }
    __syncthreads();
}
constexpr int NWAVES = 8;
constexpr int N1P = 8448;
constexpr int RING_OFF = 0, RING_BYTES = 135168;
constexpr int LDSCTL_OFF = RING_BYTES, MISC_OFF = LDSCTL_OFF + 320;
constexpr int LDS_BYTES = 147456;
constexpr int CW_BAR = 4096;
static_assert(fa::F_LDS_BYTES <= RING_BYTES && fa::S_LDS_BYTES <= RING_BYTES && pg8::STAGE_BYTES <= RING_BYTES && MISC_OFF + 128 <= LDS_BYTES && (CW_BAR + XCD_BAR_WORDS) * 4 <= (int)WS_KMAX, "LDS / CTL map");

__device__ __forceinline__ void p0_transpose_item(const float* W, int K, int N, bf16* WT, LAS float* scr, int item, int lane, const float* gs) {
    const int nblk = N / 32, kb = item / nblk, nb = item % nblk, k0 = 64 * kb, n0 = 32 * nb;
    const int kr = lane >> 3, nc = 4 * (lane & 7);
    f32x4 wv[8];
#pragma unroll
    for (int i = 0; i < 8; ++i) wv[i] = *(const GAS f32x4*)(W + (size_t)(k0 + 8 * i + kr) * N + n0 + nc);
#pragma unroll
    for (int i = 0; i < 8; ++i) { const int kk = 8 * i + kr; f32x4 w = wv[i]; if (gs) w = w * gs[k0 + kk]; LAS float* d = scr + kk * 33 + nc; d[0] = w.x; d[1] = w.y; d[2] = w.z; d[3] = w.w; }
    LDS_WAIT(); asm volatile("" ::: "memory");
    const int c = lane & 7;
#pragma unroll
    for (int j = 0; j < 4; ++j) { const int n = (lane >> 3) + 8 * j; const LAS float* sp = scr + (8 * c) * 33 + n;
        v4u o; o.x = pk2(sp[0 * 33], sp[1 * 33]); o.y = pk2(sp[2 * 33], sp[3 * 33]); o.z = pk2(sp[4 * 33], sp[5 * 33]); o.w = pk2(sp[6 * 33], sp[7 * 33]);
        *(GAS v4u*)(WT + tiled_off(n0 + n, k0 + 8 * c)) = o; }
    LDS_WAIT(); asm volatile("" ::: "memory");
}
__device__ __forceinline__ float wave_sum(float v) {
#pragma unroll
    for (int o = 1; o < 64; o <<= 1) v += __shfl_xor(v, o);
    return v;
}

struct Args { const float* in[9]; float* out; unsigned char* ws; int ph_lo, ph_hi; };
constexpr int N_PHASES = 9;
__global__ void __launch_bounds__(NWAVES * 64, 2) mega_fwd(Args args) {
    extern __shared__ __attribute__((aligned(16))) unsigned char lds_raw[];
    LAS unsigned char* lds = (LAS unsigned char*)lds_raw;
    volatile LAS unsigned* MISC = (volatile LAS unsigned*)(lds + MISC_OFF);
    const int tid = threadIdx.x, lane = tid & 63, wave = __builtin_amdgcn_readfirstlane(tid >> 6);
    const int G = gridDim.x, bx = blockIdx.x, vcu = (G % 8 == 0) ? (bx % 8) * (G / 8) + bx / 8 : bx;
    unsigned char* ws = args.ws;
    const float* x = args.in[0]; const float* norm_g = args.in[1]; const float* fox_w_in = args.in[2]; const float* fox_b_f = args.in[3]; const float* fox_w_out = args.in[4];
    const float* swa_w_in = args.in[5]; const float* swa_sinks = args.in[6]; const float* swa_w_out = args.in[7]; const float* final_g = args.in[8];
    float* out = args.out;
    gu32* ctl = (gu32*)(ws + WS_CTL);
    unsigned* KMAX = (unsigned*)(ws + WS_KMAX); unsigned* TICKET = (unsigned*)(ws + WS_TICKET);
    float* SS1 = (float*)(ws + WS_SS1); float* R0 = (float*)(ws + WS_R0); float* ROPE = (float*)(ws + WS_ROPE); float* LOGF = (float*)(ws + WS_LOGF); float* CUM = (float*)(ws + WS_CUM);
    bf16* W1T = (bf16*)(ws + WS_W1T); bf16* W2T = (bf16*)(ws + WS_W2T); bf16* W3T = (bf16*)(ws + WS_W3T); bf16* W4T = (bf16*)(ws + WS_W4T);
    bf16* KAUG = (bf16*)(ws + WS_KAUG);
    bf16* XB = (bf16*)(ws + WS_XB); bf16* Qb = (bf16*)(ws + WS_Q); bf16* Kb = (bf16*)(ws + WS_K); bf16* Vb = (bf16*)(ws + WS_V); bf16* Gb = (bf16*)(ws + WS_G); bf16* YG = (bf16*)(ws + WS_YG);
    for (int u = tid; u < (LDS_BYTES - LDSCTL_OFF) / 4; u += NWAVES * 64) ((LAS unsigned*)(lds + LDSCTL_OFF))[u] = 0u;
    __syncthreads();
    const int lo = args.ph_lo, hi = args.ph_hi;
    XcdBarrier bar; bar.bar = (unsigned*)(ctl + CW_BAR); bar.x = 0; bar.st = nullptr;
    if (hi - lo > 1) bar = xcd_barrier_post((unsigned*)(ctl + CW_BAR), MISC + 8);
#define IN(k) (lo <= (k) && (k) < hi)
#define REP(k) for (int rep_ = 0; rep_ < (((DUP_MASK >> (k)) & 1) ? 2 : 1); ++rep_)
#define SEAM(k) do { if (IN(k) && IN((k) + 1)) xcd_barrier(bar); } while (0)
    const int gw = vcu * NWAVES + wave, NGW = G * NWAVES;

    if (IN(0)) REP(0) {
        LAS float* scr = (LAS float*)(lds + RING_OFF + wave * 16384);
        constexpr int I1 = (DM / 64) * (FOX_IN / 32);
        for (int it = gw; it < I1; it += NGW) p0_transpose_item(fox_w_in, DM, FOX_IN, W1T, scr, it, lane, norm_g);
        for (int m = 2 * gw; m < MTOK; m += 2 * NGW) {
            const int m2 = m + 1;
            const GAS f32x4* xr = (const GAS f32x4*)(x + (size_t)m * DM) + lane; const GAS f32x4* xr2 = (const GAS f32x4*)(x + (size_t)m2 * DM) + lane; f32x4 v[8], v2[8]; float s = 0.f, s2 = 0.f;
#pragma unroll
            for (int j = 0; j < 8; ++j) { v[j] = xr[64 * j]; v2[j] = xr2[64 * j]; }
#pragma unroll
            for (int j = 0; j < 8; ++j) { s += (v[j].x * v[j].x + v[j].y * v[j].y) + (v[j].z * v[j].z + v[j].w * v[j].w); s2 += (v2[j].x * v2[j].x + v2[j].y * v2[j].y) + (v2[j].z * v2[j].z + v2[j].w * v2[j].w); }
            s = wave_sum(s); s2 = wave_sum(s2);
            if (lane == 0) { R0[m] = 1.0f / sqrtf(s * (1.f / DM) + RMS_EPS); R0[m2] = 1.0f / sqrtf(s2 * (1.f / DM) + RMS_EPS); }
#pragma unroll
            for (int j = 0; j < 8; ++j) { *(GAS unsigned long long*)(XB + tiled_off(m, 256 * j + 4 * lane)) = (unsigned long long)pk2(v[j].x, v[j].y) | ((unsigned long long)pk2(v[j].z, v[j].w) << 32);
                                          *(GAS unsigned long long*)(XB + tiled_off(m2, 256 * j + 4 * lane)) = (unsigned long long)pk2(v2[j].x, v2[j].y) | ((unsigned long long)pk2(v2[j].z, v2[j].w) << 32); }
        }
        { const int gt = gw * 64 + lane;
          if (gt < SEQ * 8) { const int pos = gt >> 3, i = gt & 7;
              const double invf[8] = {1.0, 0.19390220519133497, 0.037598065178462524, 0.0072903477503833845, 0.0014142135623730951, 0.00027421912901204056, 5.3171693730649086e-05, 1.0310108130908796e-05};
              double inv = invf[0];
#pragma unroll
              for (int k = 1; k < 8; ++k) inv = (i == k) ? invf[k] : inv;
              const double ang = (double)pos * inv; const double kk = __builtin_rint(ang * 0.15915494309189535); const float red = (float)(ang - kk * 6.283185307179586);
              ROPE[(size_t)pos * 16 + i] = cosf(red); ROPE[(size_t)pos * 16 + 8 + i] = sinf(red); } }
    }
    SEAM(0);
    if (IN(1)) {
        pg8::Gemm g{XB, W1T, MTOK, 4 * DM, DM}; pg8::StaticOrder S; S.init(MTOK, 4 * DM, G, bx, (DUP_MASK >> 1) & 1, (DUP_MASK >> 9) & 1);
        pg8::EpiFoxIn E{Qb, Kb, Vb, Gb, LOGF, R0, fox_b_f, KMAX};
        if ((DUP_MASK >> 10) & 1) { pg8::StaticOrder SP; SP.init(MTOK, 4 * DM, G, bx, 0, 0, 1); pg8::gemm_phase<pg8::EpiFoxIn, pg8::StaticOrder, true, true>(lds + RING_OFF, g, SP, E); }
        pg8::gemm_phase<pg8::EpiFoxIn, pg8::StaticOrder, true, true>(lds + RING_OFF, g, S, E);
        for (int rb = bx * 64; rb < MTOK; rb += G * 64) {
            const int arow = rb + 16 * (wave & 3) + (lane & 15), brow = 4 * DM + 16 * (wave >> 2) + (lane & 15), kg = (lane >> 4) * 8;
            pg8::f32x4 acc = {0.f, 0.f, 0.f, 0.f};
#pragma unroll 8
            for (int ks = 0; ks < DM / 32; ++ks) {
                const bf16x8 af = *(const GAS bf16x8*)(XB + tiled_off(arow, 32 * ks + kg)), bfv = *(const GAS bf16x8*)(W1T + tiled_off(brow, 32 * ks + kg));
                acc = __builtin_amdgcn_mfma_f32_16x16x32_bf16(af, bfv, acc, 0, 0, 0); }
            const int h = 16 * (wave >> 2) + (lane & 15), r0 = rb + 16 * (wave & 3) + 4 * (lane >> 4); const float bb = fox_b_f[h];
            f32x4 o; o.x = logsigmoidf(acc[0] * R0[r0] + bb); o.y = logsigmoidf(acc[1] * R0[r0 + 1] + bb); o.z = logsigmoidf(acc[2] * R0[r0 + 2] + bb); o.w = logsigmoidf(acc[3] * R0[r0 + 3] + bb);
            *(GAS f32x4*)(LOGF + ((size_t)((r0 >> 12) * NH + h) << 12) + (r0 & 4095)) = o;
        }
        { LAS float* scr = (LAS float*)(lds + RING_OFF + wave * 16384);
          constexpr int I2 = (DM / 64) * (DM / 32), I3 = (DM / 64) * (SWA_IN / 32);
          for (int it = gw; it < I2 + I3; it += NGW) { if (it < I2) p0_transpose_item(fox_w_out, DM, DM, W2T, scr, it, lane, nullptr); else p0_transpose_item(swa_w_in, DM, SWA_IN, W3T, scr, it - I2, lane, norm_g + DM); } }
    }
    SEAM(1);
    if (IN(2)) REP(2) {
        for (int sq = vcu; sq < NB * NH; sq += G) {
            const GAS f32x4* lf = (const GAS f32x4*)(LOGF + (size_t)sq * SEQ + wave * 512) + lane * 2; const f32x4 v0 = lf[0], v1 = lf[1];
            const double tot = (((double)v0.x + (double)v0.y) + ((double)v0.z + (double)v0.w)) + (((double)v1.x + (double)v1.y) + ((double)v1.z + (double)v1.w));
            double incl = tot;
#pragma unroll
            for (int o = 1; o < 64; o <<= 1) { const double up = __shfl_up(incl, o); if (lane >= o) incl += up; }
            volatile LAS double* wt = (volatile LAS double*)(lds + RING_OFF);
            __syncthreads();
            if (lane == 63) wt[wave] = incl;
            __syncthreads();
            double run = incl - tot;
            for (int w2 = 0; w2 < wave; ++w2) run += wt[w2];
            const float vv[8] = {v0.x, v0.y, v0.z, v0.w, v1.x, v1.y, v1.z, v1.w}; float cv[8];
#pragma unroll
            for (int e = 0; e < 8; ++e) { run += (double)vv[e]; cv[e] = (float)(run * 1.4426950408889634); }
            GAS f32x4* co = (GAS f32x4*)(CUM + (size_t)sq * SEQ + wave * 512) + lane * 2; co[0] = (f32x4){cv[0], cv[1], cv[2], cv[3]}; co[1] = (f32x4){cv[4], cv[5], cv[6], cv[7]};
            GAS v4u* ka = (GAS v4u*)(KAUG + ((size_t)sq * SEQ + wave * 512 + lane * 8) * 8);
#pragma unroll
            for (int e = 0; e < 8; ++e) { unsigned h1, h2, h3; fa::split3(-cv[e], h1, h2, h3); ka[e] = (v4u){h1 | (h2 << 16), h3 | 0x3F800000u, 0x3F803F80u, 0u}; }
        }
    }
    SEAM(2);
    if (IN(3)) {
        const fa::Params P{Qb, Kb, Vb, Gb, YG, CUM, nullptr, KMAX, TICKET, KAUG};
        volatile LAS unsigned* slot = (volatile LAS unsigned*)(lds + RING_OFF + fa::F_FLAG + 128);
#define FOX_FETCH(dst) do { unsigned code_ = 0xFFFFFFFFu; for (int k_ = 0; k_ < 8; ++k_) { const unsigned q_ = (unsigned)((bx + k_) & 7); const unsigned t_ = atomicAdd(TICKET + q_ * 64, 1u); \
            if (t_ < 256u) { code_ = q_ * 256u + t_; break; } } (dst) = code_; } while (0)
        if (tid == 0) FOX_FETCH(slot[0]);
        __syncthreads();
        unsigned tk = slot[0]; int par = 0;
        while (tk != 0xFFFFFFFFu) {
            if (tid == 0) FOX_FETCH(slot[par ^ 1]);
            const int q = (int)(tk >> 8), tq = (int)(tk & 255u), pi = tq >> 4, hs = 3 - (pi >> 2);
            const int h = hs == 0 ? q : hs == 1 ? 15 - q : hs == 2 ? 16 + q : 31 - q;
            fa::fox_unit(lds + RING_OFF, P, pi & 3, h, 15 - (tq & 15));
            par ^= 1; tk = slot[par];
        }
#undef FOX_FETCH
        __syncthreads();
    }
    SEAM(3);
    if (IN(4)) {
        pg8::Gemm g{YG, W2T, MTOK, DM, DM}; pg8::StaticOrder S; S.init(MTOK, DM, G, bx);
        pg8::EpiRes<true> E{x, XB, SS1};
        pg8::gemm_phase<pg8::EpiRes<true>, pg8::StaticOrder, true, true>(lds + RING_OFF, g, S, E);
    }
    SEAM(4);
    if (IN(5)) {
        pg8::Gemm g{XB, W3T, MTOK, SWA_IN, DM}; pg8::StaticOrder S; S.init(MTOK, SWA_IN, G, bx, (DUP_MASK >> 5) & 1);
        pg8::EpiSwaIn E{Qb, Kb, Vb, Gb, SS1, ROPE};
        pg8::gemm_phase<pg8::EpiSwaIn, pg8::StaticOrder, true, true>(lds + RING_OFF, g, S, E);
        { const int nwg = (MTOK / 256) * (SWA_IN / 256), rem = nwg % G, nidle = rem ? G - rem : G, ii = rem ? bx - rem : bx;
          if (ii >= 0) { LAS float* scr = (LAS float*)(lds + RING_OFF + wave * 16384); constexpr int I2 = (DM / 64) * (DM / 32);
              for (int it = ii * NWAVES + wave; it < I2; it += nidle * NWAVES) p0_transpose_item(swa_w_out, DM, DM, W4T, scr, it, lane, nullptr); } }
    }
    SEAM(5);
    if (IN(6)) REP(6) {
        const fa::Params P{Qb, Kb, Vb, Gb, YG, nullptr, swa_sinks, nullptr, nullptr, nullptr};
        for (int u = (G == 256 ? vcu : bx); u < NB * 4 * 16; u += G) fa::swa_unit(lds + RING_OFF, P, u >> 6, (u >> 4) & 3, u & 15);
    }
    SEAM(6);
    if (IN(7)) {
        pg8::Gemm g{YG, W4T, MTOK, DM, DM}; pg8::StaticOrder S; S.init(MTOK, DM, G, bx);
        pg8::EpiRes<false> E{nullptr, XB, nullptr};
        pg8::gemm_phase<pg8::EpiRes<false>, pg8::StaticOrder, true, true>(lds + RING_OFF, g, S, E);
    }
    SEAM(7);
    if (IN(8)) {
        f32x4 gq[8];
#pragma unroll
        for (int j = 0; j < 8; ++j) gq[j] = ((const GAS f32x4*)final_g)[lane + 64 * j];
        for (int m = 2 * gw; m < MTOK; m += 2 * NGW) {
            f32x4 v[8], v2[8]; float s = 0.f, s2 = 0.f; unsigned long long xw[8], xw2[8];
#pragma unroll
            for (int j = 0; j < 8; ++j) { xw[j] = *(const GAS unsigned long long*)(XB + tiled_off(m, 256 * j + 4 * lane)); xw2[j] = *(const GAS unsigned long long*)(XB + tiled_off(m + 1, 256 * j + 4 * lane)); }
#pragma unroll
            for (int j = 0; j < 8; ++j) { const unsigned lo32 = (unsigned)xw[j], hi32 = (unsigned)(xw[j] >> 32), lo2 = (unsigned)xw2[j], hi2 = (unsigned)(xw2[j] >> 32);
                v[j] = (f32x4){__uint_as_float(lo32 << 16), __uint_as_float(lo32 & 0xffff0000u), __uint_as_float(hi32 << 16), __uint_as_float(hi32 & 0xffff0000u)};
                v2[j] = (f32x4){__uint_as_float(lo2 << 16), __uint_as_float(lo2 & 0xffff0000u), __uint_as_float(hi2 << 16), __uint_as_float(hi2 & 0xffff0000u)};
                s += (v[j].x * v[j].x + v[j].y * v[j].y) + (v[j].z * v[j].z + v[j].w * v[j].w); s2 += (v2[j].x * v2[j].x + v2[j].y * v2[j].y) + (v2[j].z * v2[j].z + v2[j].w * v2[j].w); }
            const float r = 1.0f / sqrtf(wave_sum(s) * (1.f / DM) + RMS_EPS), r2 = 1.0f / sqrtf(wave_sum(s2) * (1.f / DM) + RMS_EPS);
            GAS f32x4* xr = (GAS f32x4*)(out + (size_t)m * DM) + lane; GAS f32x4* xr2 = (GAS f32x4*)(out + (size_t)(m + 1) * DM) + lane;
#pragma unroll
            for (int j = 0; j < 8; ++j) { xr[64 * j] = v[j] * r * gq[j]; xr2[64 * j] = v2[j] * r2 * gq[j]; }
        }
    }
#undef IN
#undef SEAM
}

extern "C" void kernel_launch(void* const* d_in, const int* in_sizes, int n_in, void* d_out, int out_size, void* d_ws, size_t ws_size, hipStream_t stream) {
    static int grid = 0;
    if (grid == 0) {
        if (n_in != 9 || in_sizes[0] != MTOK * DM || out_size != MTOK * DM || ws_size < WS_END) { fprintf(stderr, "kernel_launch: unexpected shapes (n_in %d, in0 %d, out %d, ws %zu)\n", n_in, n_in > 0 ? in_sizes[0] : -1, out_size, ws_size); grid = -1; return; }
        int dev = 0, cus = 0, per_cu = 0;
        if (hipGetDevice(&dev) != hipSuccess || hipDeviceGetAttribute(&cus, hipDeviceAttributeMultiprocessorCount, dev) != hipSuccess) { fprintf(stderr, "kernel_launch: device query failed\n"); grid = -1; return; }
        if (hipFuncSetAttribute((const void*)mega_fwd, hipFuncAttributeMaxDynamicSharedMemorySize, LDS_BYTES) != hipSuccess) { fprintf(stderr, "kernel_launch: hipFuncSetAttribute failed\n"); grid = -1; return; }
        if (hipOccupancyMaxActiveBlocksPerMultiprocessor(&per_cu, (const void*)mega_fwd, NWAVES * 64, LDS_BYTES) != hipSuccess || per_cu < 1) { fprintf(stderr, "kernel_launch: occupancy query reports %d workgroups per CU; nothing launched\n", per_cu); (void)hipGetLastError(); grid = -1; return; }
        grid = cus;
    }
    if (grid < 0) return;
    (void)hipMemsetAsync((unsigned char*)d_ws + WS_CTL, 0, CTL_ZERO_BYTES, stream);
    Args a{};
    for (int i = 0; i < 9; ++i) a.in[i] = (const float*)d_in[i];
    a.out = (float*)d_out; a.ws = (unsigned char*)d_ws;
    int p = 0;
    while (p < N_PHASES) {
        if (!((FAST_MASK >> p) & 1)) { ++p; continue; }
        int e = p + 1; if (ONE_LAUNCH) while (e < N_PHASES && ((FAST_MASK >> e) & 1)) ++e;
        a.ph_lo = p; a.ph_hi = e;
        hipLaunchKernelGGL(mega_fwd, dim3(grid), dim3(NWAVES * 64), LDS_BYTES, stream, a);
        p = e;
    }
}
```

```cpp
#include <hip/hip_runtime.h>
#include <cstdio>
#include <cstdint>

constexpr int NB = 4, SEQ = 4096, DM = 2048, MTOK = NB * SEQ, NH = 32, HD = 64;
constexpr int FOX_IN = 8224, SWA_IN = 4608, KVW = 256;
constexpr float RMS_EPS = 1e-6f;
constexpr float LOG2E = 1.4426950408889634f;
constexpr float C2 = 0.125f * LOG2E;

typedef unsigned short bf16_t;
__device__ __forceinline__ float bf2f(bf16_t v) { return __uint_as_float((unsigned)v << 16); }
__device__ __forceinline__ bf16_t f2bf(float f) { unsigned u = __float_as_uint(f); return (bf16_t)((u + 0x7fffu + ((u >> 16) & 1u)) >> 16); }
__device__ __forceinline__ float logsigmoidf(float z) { return z < 0.f ? z - log1pf(expf(z)) : -log1pf(expf(-z)); }
__device__ __forceinline__ float siluf(float g) { return g / (1.f + expf(-g)); }

__host__ __device__ __forceinline__ size_t tiled_off(int row, int k) { return ((size_t)(((row >> 8) * (DM / 64) + (k >> 6)) * 2 + ((k >> 5) & 1)) << 13) + (size_t)(((row & 255) << 5) + (k & 31)); }

__host__ __device__ __forceinline__ size_t hm_off(int row  , int col  , int nheads) { return ((size_t)(((row >> 12) * nheads + (col >> 6)) * 2 + ((col >> 5) & 1)) * SEQ + (row & 4095)) * 32 + (col & 31); }

constexpr size_t MiB = 1u << 20;
constexpr size_t WS_CTL = 0, CTL_ZERO_BYTES = 1 * MiB;
constexpr size_t WS_KMAX = 64 * 1024, WS_TICKET = 66 * 1024;
constexpr size_t WS_GS = 128 * 1024;
constexpr size_t WS_XT = 160 * 1024;
constexpr size_t WS_SS1 = 512 * 1024;
constexpr size_t WS_R0 = 1 * MiB;
constexpr size_t WS_ROPE = 1 * MiB + 512 * 1024;
constexpr size_t WS_LOGF = 2 * MiB;
constexpr size_t WS_CUM = 4 * MiB;
constexpr size_t WS_W1T = 8 * MiB, WS_W2T = 41 * MiB, WS_W3T = 49 * MiB, WS_W4T = 67 * MiB;
constexpr size_t WS_XB = 76 * MiB, WS_Q = 140 * MiB, WS_K = 204 * MiB, WS_V = 268 * MiB, WS_G = 332 * MiB, WS_YG = 396 * MiB, WS_KAUG = 460 * MiB, WS_END = 468 * MiB;

#ifndef FAST_MASK
#define FAST_MASK 0x1FF
#endif
#ifndef DUP_MASK
#define DUP_MASK 0x000
#endif
#ifndef ONE_LAUNCH
#define ONE_LAUNCH 1
#endif
namespace pg8 {
#define PG8_LAS __attribute__((address_space(3)))
typedef unsigned short bf16_t;
typedef short bf16x8 __attribute__((ext_vector_type(8)));
typedef float f32x4 __attribute__((ext_vector_type(4)));
typedef unsigned u32x4 __attribute__((ext_vector_type(4)));
constexpr int BM = 256, BK = 64, HALF = 128, HTB = HALF * BK * 2  , STAGE_BYTES = 8 * HTB, NXCD = 8, WGM = 8;

__host__ __device__ __forceinline__ int lds_byte(int r, int c) { const int st = (r >> 4) * 2 + (c >> 5), rr = r & 15, cc = c & 31, ob = rr * 64 + cc * 2; return st * 1024 + (ob ^ (((ob >> 9) & 1) << 5)); }
__host__ __device__ __forceinline__ void stage_rc(int b, int& R, int& C) { const int st = b / 1024, sb = b % 1024, swz = sb ^ (((sb >> 9) & 1) << 5); R = (st >> 1) * 16 + swz / 64; C = (st & 1) * 32 + (swz % 64) / 2; }
__host__ __device__ __forceinline__ int perm32(int rho) { const int n = rho >> 4, i = rho & 15; return 8 * (i >> 2) + 4 * n + (i & 3); }

struct Unit { int pm, pn, lm, ln; };
struct Gemm { const bf16_t* A; const bf16_t* Bt; int M, N, K; };

struct StaticOrder {
    int nM, nN, nwg, G, c, dup, epi2, same, i0, i1;
    __host__ __device__ void init(int M, int N, int G_, int c_, int dup_ = 0, int epi2_ = 0, int same_ = 0, int i0_ = 0, int i1_ = 1 << 20) { nM = M / BM; nN = N / BM; nwg = nM * nN; G = G_; c = c_; dup = dup_; epi2 = epi2_; same = same_; i0 = i0_; i1 = i1_; }
    __host__ __device__ bool next(int i, Unit& u) const {
        if (dup) i >>= 1;
        i += i0; if (i >= i1) return false;
        const long L = (long)i * G + c; if (L >= nwg) return false;
        int wgid = (int)L; { const int q = nwg / NXCD, r = nwg % NXCD, xcd = wgid % NXCD, off = wgid / NXCD; wgid = (xcd < r ? xcd * (q + 1) : r * (q + 1) + (xcd - r) * q) + off; }
        const int nig = WGM * nN, gid = wgid / nig, fm = gid * WGM, gsz = (nM - fm) < WGM ? (nM - fm) : WGM;
        u.pm = fm + ((wgid % nig) % gsz); u.pn = (wgid % nig) / gsz; u.lm = same ? 0 : u.pm; u.ln = same ? 0 : u.pn; return true;
    }
    __device__ __forceinline__ void a_ready(const Unit&) const {}
    __device__ __forceinline__ void done(const Unit&) const {}
};

__device__ __forceinline__ unsigned cvt_pk_bf16(float lo, float hi) { unsigned r; asm volatile("v_cvt_pk_bf16_f32 %0, %1, %2" : "=v"(r) : "v"(lo), "v"(hi)); return r; }
__device__ __forceinline__ float silu_fast(float g) { return g * __builtin_amdgcn_rcpf(1.0f + __builtin_amdgcn_exp2f(-g * 1.4426950408889634f)); }
__device__ __forceinline__ u32x4 pack8(const f32x4 v0, const f32x4 v1) { u32x4 w; w.x = cvt_pk_bf16(v0[0], v0[1]); w.y = cvt_pk_bf16(v0[2], v0[3]); w.z = cvt_pk_bf16(v1[0], v1[1]); w.w = cvt_pk_bf16(v1[2], v1[3]); return w; }
struct EpiFoxIn {
    static constexpr bool PERM = true, AFTER_DRAIN = false;
    bf16_t *Q, *K, *V, *G; float* LOGF; const float* R0; const float* bfb; unsigned* KMAX;
    __device__ __forceinline__ void operator()(const f32x4 (&acc)[2][2][4][2], const Unit& u, int wr, int wc, int fr, int fq) const {
        const int row0 = u.pm * BM + wr * 64 + fr, pn = u.pn;
        float rs[2][4];
#pragma unroll
        for (int ai = 0; ai < 2; ++ai)
#pragma unroll
            for (int m = 0; m < 4; ++m) rs[ai][m] = R0[row0 + ai * HALF + m * 16];
        {
            const int reg = pn >> 3; bf16_t* base = reg == 0 ? Q : reg == 1 ? K : reg == 2 ? V : G; float kmx[2] = {0.f, 0.f};
            const int col0 = (pn & 7) * BM + wc * 32 + 8 * fq;
#pragma unroll
            for (int ai = 0; ai < 2; ++ai)
#pragma unroll
                for (int m = 0; m < 4; ++m) { const int row = row0 + ai * HALF + m * 16; const float r = rs[ai][m]; const float sc = reg == 0 ? r * C2 : r;
#pragma unroll
                    for (int bj = 0; bj < 2; ++bj) { f32x4 v0 = acc[ai][bj][m][0] * sc, v1 = acc[ai][bj][m][1] * sc;
                        if (reg == 3) {
#pragma unroll
                            for (int j = 0; j < 4; ++j) { v0[j] = silu_fast(v0[j]); v1[j] = silu_fast(v1[j]); } }
                        if (reg == 1) { float ss = ((v0[0] * v0[0] + v0[1] * v0[1]) + (v0[2] * v0[2] + v0[3] * v0[3])) + ((v1[0] * v1[0] + v1[1] * v1[1]) + (v1[2] * v1[2] + v1[3] * v1[3]));
                            ss += __shfl_xor(ss, 16); ss += __shfl_xor(ss, 32); kmx[bj] = fmaxf(kmx[bj], ss); }
                        __builtin_nontemporal_store(pack8(v0, v1), (u32x4*)(base + hm_off(row, col0 + bj * HALF, NH))); } }
            if (reg == 1) {
#pragma unroll
                for (int bj = 0; bj < 2; ++bj) { float mx = kmx[bj];
#pragma unroll
                    for (int o = 1; o < 16; o <<= 1) mx = fmaxf(mx, __shfl_xor(mx, o));
                    if (fr == 0 && fq == 0) atomicMax(KMAX + ((row0 >> 12) * NH + (pn & 7) * 4 + bj * 2 + (wc >> 1)) * 2 + (wc & 1), __float_as_uint(mx)); } }
        }
    }
};
struct EpiSwaIn {
    static constexpr bool PERM = true, AFTER_DRAIN = false;
    bf16_t *Q, *K, *V, *G; const float* SS; const float* ROPE;
    __device__ __forceinline__ void operator()(const f32x4 (&acc)[2][2][4][2], const Unit& u, int wr, int wc, int fr, int fq) const {
        const int row0 = u.pm * BM + wr * 64 + fr, pn = u.pn;
        bf16_t* base; int pitch, colt; float osc = 1.f; const bool rope = pn <= 8, gate = pn >= 10;
        if (pn < 8) { base = Q; pitch = DM; colt = pn * BM; osc = C2; } else if (pn == 8) { base = K; pitch = KVW; colt = 0; } else if (pn == 9) { base = V; pitch = KVW; colt = 0; } else { base = G; pitch = DM; colt = (pn - 10) * BM; }
        const int col0 = colt + wc * 32 + 8 * fq; const bool rotw = rope && ((wc & 1) == 0); const float sgn = fq == 0 ? -1.f : 1.f; const bool rotl = fq < 2;
        float rs[2][4];
#pragma unroll
        for (int ai = 0; ai < 2; ++ai)
#pragma unroll
            for (int m = 0; m < 4; ++m) rs[ai][m] = SS[row0 + ai * HALF + m * 16];
        f32x4 nc0, nc1, ns0, ns1;
        if (rotw) { const float* rp = ROPE + (size_t)(row0 & 4095) * 16; nc0 = *(const f32x4*)rp; nc1 = *(const f32x4*)(rp + 4); ns0 = *(const f32x4*)(rp + 8); ns1 = *(const f32x4*)(rp + 12); }
#pragma unroll
        for (int ai = 0; ai < 2; ++ai)
#pragma unroll
            for (int m = 0; m < 4; ++m) { const int row = row0 + ai * HALF + m * 16; const float r = 1.0f / sqrtf(rs[ai][m] * (1.f / DM) + RMS_EPS);
                const f32x4 c0 = nc0, c1 = nc1, s0 = ns0, s1 = ns1;
                if (rotw && (ai * 4 + m) < 7) { const int nrow = row0 + ((ai * 4 + m + 1) >> 2) * HALF + ((ai * 4 + m + 1) & 3) * 16; const float* rp = ROPE + (size_t)(nrow & 4095) * 16; nc0 = *(const f32x4*)rp; nc1 = *(const f32x4*)(rp + 4); ns0 = *(const f32x4*)(rp + 8); ns1 = *(const f32x4*)(rp + 12); }
#pragma unroll
                for (int bj = 0; bj < 2; ++bj) { f32x4 v0 = acc[ai][bj][m][0] * r, v1 = acc[ai][bj][m][1] * r;
                    if (rotw) {
#pragma unroll
                        for (int j = 0; j < 4; ++j) { const float p0 = __shfl_xor(v0[j], 16), p1 = __shfl_xor(v1[j], 16);
                            const float n0 = v0[j] * c0[j] + sgn * p0 * s0[j], n1 = v1[j] * c1[j] + sgn * p1 * s1[j];
                            v0[j] = rotl ? n0 : v0[j]; v1[j] = rotl ? n1 : v1[j]; } }
                    if (gate) {
#pragma unroll
                        for (int j = 0; j < 4; ++j) { v0[j] = silu_fast(v0[j]); v1[j] = silu_fast(v1[j]); } }
                    v0 = v0 * osc; v1 = v1 * osc;
                    *(u32x4*)(base + hm_off(row, col0 + bj * HALF, pitch >> 6)) = pack8(v0, v1); } }
    }
};
template <bool FIRST> struct EpiRes {
    static constexpr bool PERM = true, AFTER_DRAIN = false;
    const float* xin; bf16_t* XB; float* SS;
    __device__ __forceinline__ void operator()(const f32x4 (&acc)[2][2][4][2], const Unit& u, int wr, int wc, int fr, int fq) const {
        const int row0 = u.pm * BM + wr * 64 + fr, col0 = u.pn * BM + wc * 32 + 8 * fq;
        if (FIRST) {
            f32x4 nx[2][2];
#pragma unroll
            for (int bj = 0; bj < 2; ++bj)
#pragma unroll
                for (int n = 0; n < 2; ++n) nx[bj][n] = *(const f32x4*)(xin + (size_t)row0 * DM + col0 + bj * HALF + n * 4);
#pragma unroll
            for (int ai = 0; ai < 2; ++ai)
#pragma unroll
                for (int m = 0; m < 4; ++m) { const int row = row0 + ai * HALF + m * 16; float ss = 0.f;
                    f32x4 cx[2][2];
#pragma unroll
                    for (int bj = 0; bj < 2; ++bj)
#pragma unroll
                        for (int n = 0; n < 2; ++n) cx[bj][n] = nx[bj][n];
                    if ((ai * 4 + m) < 7) { const int nrow = row0 + ((ai * 4 + m + 1) >> 2) * HALF + ((ai * 4 + m + 1) & 3) * 16;
#pragma unroll
                        for (int bj = 0; bj < 2; ++bj)
#pragma unroll
                            for (int n = 0; n < 2; ++n) nx[bj][n] = *(const f32x4*)(xin + (size_t)nrow * DM + col0 + bj * HALF + n * 4); }
#pragma unroll
                    for (int bj = 0; bj < 2; ++bj) { const f32x4 x0 = cx[bj][0] + acc[ai][bj][m][0], x1 = cx[bj][1] + acc[ai][bj][m][1];
                        *(u32x4*)(XB + tiled_off(row, col0 + bj * HALF)) = pack8(x0, x1);
                        ss += ((x0[0] * x0[0] + x0[1] * x0[1]) + (x0[2] * x0[2] + x0[3] * x0[3])) + ((x1[0] * x1[0] + x1[1] * x1[1]) + (x1[2] * x1[2] + x1[3] * x1[3])); }
                    ss += __shfl_xor(ss, 16); ss += __shfl_xor(ss, 32); if (fq == 0) atomicAdd(SS + row, ss); }
        } else {
            u32x4 xv[2][4][2];
#pragma unroll
            for (int ai = 0; ai < 2; ++ai)
#pragma unroll
                for (int m = 0; m < 4; ++m)
#pragma unroll
                    for (int bj = 0; bj < 2; ++bj) xv[ai][m][bj] = *(const u32x4*)(XB + tiled_off(row0 + ai * HALF + m * 16, col0 + bj * HALF));
#pragma unroll
            for (int ai = 0; ai < 2; ++ai)
#pragma unroll
                for (int m = 0; m < 4; ++m)
#pragma unroll
                    for (int bj = 0; bj < 2; ++bj) { const u32x4 xw = xv[ai][m][bj]; const f32x4 a0 = acc[ai][bj][m][0], a1 = acc[ai][bj][m][1];
                        const f32x4 y0 = {__uint_as_float(xw.x << 16) + a0[0], __uint_as_float(xw.x & 0xffff0000u) + a0[1], __uint_as_float(xw.y << 16) + a0[2], __uint_as_float(xw.y & 0xffff0000u) + a0[3]};
                        const f32x4 y1 = {__uint_as_float(xw.z << 16) + a1[0], __uint_as_float(xw.z & 0xffff0000u) + a1[1], __uint_as_float(xw.w << 16) + a1[2], __uint_as_float(xw.w & 0xffff0000u) + a1[3]};
                        *(u32x4*)(XB + tiled_off(row0 + ai * HALF + m * 16, col0 + bj * HALF)) = pack8(y0, y1); }
        }
    }
};
template <class Epi, class Sched, bool ALIGN_EPI = false, bool SP2 = false>
__device__ __forceinline__ void gemm_phase(PG8_LAS unsigned char* lds, const Gemm g, const Sched& S, const Epi& E) {
    const int tid = threadIdx.x, wid = __builtin_amdgcn_readfirstlane(tid >> 6), lane = tid & 63, wr = wid >> 2, wc = wid & 3, fr = lane & 15, fq = lane >> 4;
    const int K = g.K, nt = K / BK;
    unsigned voffA[2], voffB[2];
#pragma unroll
    for (int i = 0; i < 2; ++i) { int R, C; stage_rc(tid * 16 + i * 8192, R, C); const int Rb = Epi::PERM ? ((R & ~31) + perm32(R & 31)) : R;
        voffA[i] = (unsigned)((C >> 5) * (BM * 32) + R * 32 + (C & 31)) * 2u; voffB[i] = (unsigned)((C >> 5) * (BM * 32) + Rb * 32 + (C & 31)) * 2u; }
    const size_t kstep = (size_t)(BM * BK * 2);
    const size_t hstep = (size_t)(HALF * 32 * 2);
    const size_t tstep = (size_t)BM * K * 2;
    const unsigned ldsw = (unsigned)wid * 1024u;
    const int aoff = lds_byte(wr * 64 + fr, fq * 8), boff = lds_byte(wc * 32 + fr, fq * 8);
#define PG8_SA(b, h) (((b) * 2 + (h)) * HTB)
#define PG8_SB(b, h) ((4 + (b) * 2 + (h)) * HTB)
#define PG8_STAGE(bufoff, gbase, voff) do { _Pragma("unroll") for (int _i = 0; _i < 2; ++_i) \
        __builtin_amdgcn_global_load_lds((const unsigned*)((const char*)(gbase) + (voff)[_i]), (PG8_LAS unsigned*)(lds + (bufoff) + ldsw + _i * 8192), 16, 0, 0); } while (0)
#define PG8_LDA(dst, b, h) do { _Pragma("unroll") for (int m = 0; m < 4; ++m) _Pragma("unroll") for (int k = 0; k < 2; ++k) dst[m][k] = *(const PG8_LAS bf16x8*)(lds + PG8_SA(b, h) + aoff + m * 2048 + k * 1024); } while (0)
#define PG8_LDB(dst, b, h) do { _Pragma("unroll") for (int n = 0; n < 2; ++n) _Pragma("unroll") for (int k = 0; k < 2; ++k) dst[n][k] = *(const PG8_LAS bf16x8*)(lds + PG8_SB(b, h) + boff + n * 2048 + k * 1024); } while (0)
#define PG8_MMA(ai, bj, At, Bt) do { __builtin_amdgcn_s_setprio(1); _Pragma("unroll") for (int m = 0; m < 4; ++m) _Pragma("unroll") for (int n = 0; n < 2; ++n) _Pragma("unroll") for (int k = 0; k < 2; ++k) \
        acc[ai][bj][m][n] = __builtin_amdgcn_mfma_f32_16x16x32_bf16(Bt[n][k], At[m][k], acc[ai][bj][m][n], 0, 0, 0); __builtin_amdgcn_s_setprio(0); } while (0)
#define PG8_WAIT_V(n) asm volatile("s_waitcnt vmcnt(" #n ")" ::: "memory")
#define PG8_WAIT_L(n) asm volatile("s_waitcnt lgkmcnt(" #n ")" ::: "memory")
#define PG8_BAR __builtin_amdgcn_s_barrier()
#define PG8_SCHED __builtin_amdgcn_sched_barrier(0)
    Unit cur, nxt; int ui = 0;
    if (!S.next(0, cur)) return;
    f32x4 acc[2][2][4][2];
#pragma unroll
    for (int a = 0; a < 2; ++a)
#pragma unroll
        for (int b = 0; b < 2; ++b)
#pragma unroll
            for (int m = 0; m < 4; ++m)
#pragma unroll
                for (int n = 0; n < 2; ++n) acc[a][b][m][n] = (f32x4){0.f, 0.f, 0.f, 0.f};
    bf16x8 At[4][2], B0[2][2], B1[2][2];
    const char* cA = (const char*)g.A + (size_t)cur.lm * tstep; const char* cB = (const char*)g.Bt + (size_t)cur.ln * tstep;
    S.a_ready(cur);
    if constexpr (SP2) {
        PG8_STAGE(PG8_SB(0, 0), cB, voffB); PG8_STAGE(PG8_SB(0, 1), cB + hstep, voffB); PG8_STAGE(PG8_SA(0, 0), cA, voffA); PG8_STAGE(PG8_SA(0, 1), cA + hstep, voffA);
        if (wr == 1) PG8_BAR;
        PG8_WAIT_V(2); PG8_BAR;
        PG8_STAGE(PG8_SB(1, 0), cB + kstep, voffB); PG8_STAGE(PG8_SA(1, 0), cA + kstep, voffA); PG8_STAGE(PG8_SB(1, 1), cB + hstep + kstep, voffB);
        PG8_WAIT_V(6); PG8_BAR;
    } else {
        PG8_STAGE(PG8_SB(0, 0), cB, voffB); PG8_STAGE(PG8_SA(0, 0), cA, voffA); PG8_STAGE(PG8_SB(0, 1), cB + hstep, voffB); PG8_STAGE(PG8_SA(0, 1), cA + hstep, voffA);
        if (wr == 1) PG8_BAR;
        PG8_WAIT_V(4); PG8_BAR;
        PG8_STAGE(PG8_SB(1, 0), cB + kstep, voffB); PG8_STAGE(PG8_SA(1, 0), cA + kstep, voffA); PG8_STAGE(PG8_SB(1, 1), cB + hstep + kstep, voffB);
        PG8_WAIT_V(6); PG8_BAR;
    }
    for (;;) {
        const bool has_next = S.next(ui + 1, nxt);
        const char* nA = has_next ? (const char*)g.A + (size_t)nxt.lm * tstep : cA; const char* nB = has_next ? (const char*)g.Bt + (size_t)nxt.ln * tstep : cB;
        for (int t = 0; t < nt; t += 2) {
            const bool last = (t == nt - 2);
            const char* a1 = cA + (size_t)(t + 1) * kstep;
            const char* a2 = last ? nA : cA + (size_t)(t + 2) * kstep; const char* b2 = last ? nB : cB + (size_t)(t + 2) * kstep;
            const char* a3 = a2 + kstep; const char* b3 = b2 + kstep;
            if (last && has_next) S.a_ready(nxt);
            if constexpr (SP2) {
            PG8_LDB(B0, 0, 0); PG8_LDB(B1, 0, 1); PG8_SCHED; PG8_LDA(At, 0, 0); PG8_STAGE(PG8_SA(1, 1), a1 + hstep, voffA);
            PG8_WAIT_V(8); PG8_WAIT_L(0); PG8_BAR; PG8_MMA(0, 0, At, B0); PG8_MMA(0, 1, At, B1); PG8_BAR; PG8_SCHED;
            PG8_LDA(At, 0, 1); PG8_STAGE(PG8_SB(0, 0), b2, voffB); PG8_STAGE(PG8_SB(0, 1), b2 + hstep, voffB); PG8_STAGE(PG8_SA(0, 0), a2, voffA);
            PG8_WAIT_V(8); PG8_WAIT_L(0); PG8_BAR; PG8_MMA(1, 0, At, B0); PG8_MMA(1, 1, At, B1); PG8_BAR; PG8_SCHED;
            PG8_LDB(B0, 1, 0); PG8_LDB(B1, 1, 1); PG8_SCHED; PG8_LDA(At, 1, 0); PG8_STAGE(PG8_SA(0, 1), a2 + hstep, voffA);
            PG8_WAIT_V(8); PG8_WAIT_L(0); PG8_BAR; PG8_MMA(0, 0, At, B0); PG8_MMA(0, 1, At, B1); PG8_BAR; PG8_SCHED;
            PG8_LDA(At, 1, 1); PG8_STAGE(PG8_SB(1, 0), b3, voffB); PG8_STAGE(PG8_SB(1, 1), b3 + hstep, voffB); PG8_STAGE(PG8_SA(1, 0), a3, voffA);
            PG8_WAIT_V(8); PG8_WAIT_L(0); PG8_BAR; PG8_MMA(1, 0, At, B0); PG8_MMA(1, 1, At, B1); PG8_BAR; PG8_SCHED;
            } else {
            PG8_LDB(B0, 0, 0); PG8_SCHED; PG8_LDA(At, 0, 0); PG8_STAGE(PG8_SA(1, 1), a1 + hstep, voffA);
            PG8_WAIT_L(8); PG8_BAR; PG8_WAIT_L(0); PG8_MMA(0, 0, At, B0); PG8_BAR; PG8_SCHED;
            PG8_LDB(B1, 0, 1); PG8_STAGE(PG8_SB(0, 0), b2, voffB);
            PG8_BAR; PG8_WAIT_L(0); PG8_MMA(0, 1, At, B1); PG8_BAR;
            PG8_LDA(At, 0, 1); PG8_STAGE(PG8_SA(0, 0), a2, voffA);
            PG8_BAR; PG8_WAIT_L(0); PG8_MMA(1, 0, At, B0); PG8_BAR; PG8_SCHED;
            PG8_STAGE(PG8_SB(0, 1), b2 + hstep, voffB);
            PG8_WAIT_V(6); PG8_BAR; PG8_MMA(1, 1, At, B1); PG8_BAR;
            PG8_LDB(B0, 1, 0); PG8_SCHED; PG8_LDA(At, 1, 0); PG8_STAGE(PG8_SA(0, 1), a2 + hstep, voffA);
            PG8_WAIT_L(8); PG8_BAR; PG8_WAIT_L(0); PG8_MMA(0, 0, At, B0); PG8_BAR; PG8_SCHED;
            PG8_LDB(B1, 1, 1); PG8_STAGE(PG8_SB(1, 0), b3, voffB);
            PG8_BAR; PG8_WAIT_L(0); PG8_MMA(0, 1, At, B1); PG8_BAR;
            PG8_LDA(At, 1, 1); PG8_STAGE(PG8_SA(1, 0), a3, voffA);
            PG8_BAR; PG8_WAIT_L(0); PG8_MMA(1, 0, At, B0); PG8_BAR; PG8_SCHED;
            PG8_STAGE(PG8_SB(1, 1), b3 + hstep, voffB);
            PG8_WAIT_V(6); PG8_BAR; PG8_MMA(1, 1, At, B1); PG8_BAR;
            }
        }
        if constexpr (ALIGN_EPI) { if (wr == 0) PG8_BAR; }
        if constexpr (!Epi::AFTER_DRAIN) { E(acc, cur, wr, wc, fr, fq); if (S.epi2) E(acc, cur, wr, wc, fr, fq); S.done(cur); }
        if (!has_next) break;
#pragma unroll
        for (int a = 0; a < 2; ++a)
#pragma unroll
            for (int b = 0; b < 2; ++b)
#pragma unroll
                for (int m = 0; m < 4; ++m)
#pragma unroll
                    for (int n = 0; n < 2; ++n) acc[a][b][m][n] = (f32x4){0.f, 0.f, 0.f, 0.f};
        cur = nxt; cA = nA; cB = nB; ++ui;
        if constexpr (ALIGN_EPI) { if (wr == 1) PG8_BAR; }
    }
    PG8_WAIT_V(0);
    if constexpr (!ALIGN_EPI) { if (wr == 0) PG8_BAR; }
    PG8_BAR;
    if constexpr (Epi::AFTER_DRAIN) { E.fused(acc, cur, wr, wc, fr, fq, lds, wid, lane); S.done(cur); }
#undef PG8_SA
#undef PG8_SB
#undef PG8_STAGE
#undef PG8_LDA
#undef PG8_LDB
#undef PG8_MMA
#undef PG8_WAIT_V
#undef PG8_WAIT_L
#undef PG8_BAR
#undef PG8_SCHED
}
}
namespace fa {
#define FA_LAS __attribute__((address_space(3)))
typedef short bf16x8 __attribute__((ext_vector_type(8)));
typedef short s16x4 __attribute__((ext_vector_type(4)));
typedef short v4i16_t __attribute__((ext_vector_type(4)));
typedef float f32x16 __attribute__((ext_vector_type(16)));
typedef float f32x4 __attribute__((ext_vector_type(4)));
typedef unsigned u32x4 __attribute__((ext_vector_type(4)));
typedef float f32x2_t __attribute__((ext_vector_type(2))); typedef __bf16 bf16x2_t __attribute__((ext_vector_type(2)));
constexpr float THR = 8.f, TH_SKIP = 32.f;
constexpr int F_KBUF = 18432, F_AOFF = 8192, F_VOFF = 10240, F_WSF = 3 * F_KBUF, F_FLAG = F_WSF + 8 * 256, F_OST = F_FLAG + 256, F_LDS_BYTES = F_OST + 8 * 4096;
constexpr int S_KBUF = 16384, S_VOFF = 8192, S_WSF = 6 * S_KBUF, S_OST = S_WSF + 8 * 256, S_LDS_BYTES = S_OST + 8 * 4096;
struct Params { const bf16_t* Q; const bf16_t* K; const bf16_t* V; const bf16_t* G; bf16_t* O; const float* CUM; const float* sinks; const unsigned* KMAX; unsigned* ticket; const bf16_t* KAUG; };
__device__ __forceinline__ unsigned cvtpk(float lo, float hi) { f32x2_t v = {lo, hi}; bf16x2_t b = __builtin_convertvector(v, bf16x2_t); return __builtin_bit_cast(unsigned, b); }
__device__ __forceinline__ s16x4 vtr(FA_LAS unsigned char* p) { return __builtin_bit_cast(s16x4, __builtin_amdgcn_ds_read_tr16_b64_v4i16((FA_LAS v4i16_t*)p)); }
__device__ __forceinline__ float swap_max(float v) { auto rr = __builtin_amdgcn_permlane32_swap(__float_as_uint(v), __float_as_uint(v), false, false); return __builtin_fmaxf(__uint_as_float(rr[0]), __uint_as_float(rr[1])); }
__device__ __forceinline__ float swap_add(float v) { auto rr = __builtin_amdgcn_permlane32_swap(__float_as_uint(v), __float_as_uint(v), false, false); return __uint_as_float(rr[0]) + __uint_as_float(rr[1]); }
__device__ __forceinline__ void glds16(const void* gsrc, unsigned lds_dst) { unsigned keep;
    asm volatile("s_mov_b32 %0, m0\n\ts_mov_b32 m0, %2\n\ts_nop 0\n\tglobal_load_lds_dwordx4 %1, off\n\ts_mov_b32 m0, %0" : "=&s"(keep) : "v"(gsrc), "s"(lds_dst) : "memory"); }
#define FA_MFMA(a, b, c) __builtin_amdgcn_mfma_f32_32x32x16_bf16((a), (b), (c), 0, 0, 0)
#define FA_MX3(a, b, c) __builtin_fmaxf(__builtin_fmaxf((a), (b)), (c))
struct WaveSt { bf16x8 qr[4]; bf16x8 qa; f32x16 o0, o1; float cq, mhat, lsum, mrun; };

#define FA_SBAR() __builtin_amdgcn_sched_barrier(0)
#define FA_PIN(x) asm volatile("" : "+v"(x))
#define FA_LDK(p) (*(FA_LAS bf16x8*)(p))
#define FA_VF(l, h) ((bf16x8){l[0], l[1], l[2], l[3], h[0], h[1], h[2], h[3]})
#define FA_EX4(X, B) do { X[B] = __builtin_amdgcn_exp2f(X[B]); X[B + 1] = __builtin_amdgcn_exp2f(X[B + 1]); X[B + 2] = __builtin_amdgcn_exp2f(X[B + 2]); X[B + 3] = __builtin_amdgcn_exp2f(X[B + 3]); } while (0)
__device__ __forceinline__ void split3(float v, unsigned& h1, unsigned& h2, unsigned& h3) { const bf16_t a = f2bf(v); const float r1 = v - bf2f(a); const bf16_t b = f2bf(r1); const float r2 = r1 - bf2f(b); h1 = a; h2 = b; h3 = f2bf(r2); }
__device__ __forceinline__ void set_qa(WaveSt& w, int hi) {
    unsigned g1, g2, g3; split3(w.cq - w.mhat, g1, g2, g3);
    const u32x4 q = {hi == 0 ? 0x3F803F80u : 0u, hi == 0 ? (0x3F80u | (g1 << 16)) : 0u, hi == 0 ? (g2 | (g3 << 16)) : 0u, 0u};
    w.qa = __builtin_bit_cast(bf16x8, q);
}
template <int MODE, int AOFF, int VOFF>
__device__ __forceinline__ void tile_full(FA_LAS unsigned char* bb, FA_LAS unsigned char* vprev, FA_LAS float* wsf, WaveSt& w, f32x16& C0, f32x16& C1, f32x16& P0, f32x16& P1,
                                          int k0, int t, int qlo, int lane, int r32, int hi) {
    constexpr int W = MODE == 0 ? 0x40000000 : 128;
    FA_LAS unsigned char* kp = bb + hi * 1024 + r32 * 16; FA_LAS unsigned char* ap = bb + AOFF + r32 * 16;
    FA_LAS unsigned char* vp = vprev + VOFF + ((lane >> 4) & 1) * 32 + (lane & 3) * 8 + (4 * hi + ((lane & 15) >> 2)) * 64;
    bf16x8 kf0 = FA_LDK(kp), kf1 = FA_LDK(kp + 512), kf2 = FA_LDK(kp + 2048), kf3 = FA_LDK(kp + 2560), kf4, kf5, kf6, kf7, ka0, ka1;
    s16x4 vl0, vh0, vl1, vh1, vl2, vh2, vl3, vh3, vl4, vh4, vl5, vh5, vl6, vh6, vl7, vh7;
    u32x4 pw0, pw1, pw2, pw3; float sacc;
    const f32x16 Z = {0.f, 0.f, 0.f, 0.f, 0.f, 0.f, 0.f, 0.f, 0.f, 0.f, 0.f, 0.f, 0.f, 0.f, 0.f, 0.f};
    FA_SBAR();
    C0 = FA_MFMA(kf0, w.qr[0], Z); kf4 = FA_LDK(kp + 4096);
    sacc = (P0[0] + P0[1]) + (P0[2] + P0[3]); pw0.x = cvtpk(P0[0], P0[1]); pw0.y = cvtpk(P0[2], P0[3]); FA_PIN(sacc); FA_PIN(pw0.x); FA_PIN(pw0.y);
    FA_SBAR();
    C1 = FA_MFMA(kf1, w.qr[0], Z); kf5 = FA_LDK(kp + 4608);
    sacc += P0[4]; sacc += P0[5]; sacc += P0[6]; sacc += P0[7]; pw0.z = cvtpk(P0[4], P0[5]); pw0.w = cvtpk(P0[6], P0[7]); FA_PIN(sacc); FA_PIN(pw0.z); FA_PIN(pw0.w);
    FA_SBAR();
    C0 = FA_MFMA(kf2, w.qr[1], C0); kf6 = FA_LDK(kp + 6144);
    sacc += P0[8]; sacc += P0[9]; sacc += P0[10]; sacc += P0[11]; pw1.x = cvtpk(P0[8], P0[9]); pw1.y = cvtpk(P0[10], P0[11]); FA_PIN(sacc); FA_PIN(pw1.x); FA_PIN(pw1.y);
    FA_SBAR();
    C1 = FA_MFMA(kf3, w.qr[1], C1); kf7 = FA_LDK(kp + 6656);
    sacc += P0[12]; sacc += P0[13]; sacc += P0[14]; sacc += P0[15]; pw1.z = cvtpk(P0[12], P0[13]); pw1.w = cvtpk(P0[14], P0[15]); FA_PIN(sacc); FA_PIN(pw1.z); FA_PIN(pw1.w);
    FA_SBAR();
    C0 = FA_MFMA(kf4, w.qr[2], C0); if (MODE == 0) { ka0 = FA_LDK(ap); ka1 = FA_LDK(ap + 512); } else { const u32x4 kc = {0u, 0x3F800000u, 0x3F803F80u, 0u}; ka0 = __builtin_bit_cast(bf16x8, kc); ka1 = ka0; }
    sacc += P1[0]; sacc += P1[1]; sacc += P1[2]; sacc += P1[3]; pw2.x = cvtpk(P1[0], P1[1]); pw2.y = cvtpk(P1[2], P1[3]); FA_PIN(sacc); FA_PIN(pw2.x); FA_PIN(pw2.y);
    FA_SBAR();
    C1 = FA_MFMA(kf5, w.qr[2], C1); vl0 = vtr(vp); vh0 = vtr(vp + 512);
    sacc += P1[4]; sacc += P1[5]; sacc += P1[6]; sacc += P1[7]; pw2.z = cvtpk(P1[4], P1[5]); pw2.w = cvtpk(P1[6], P1[7]); FA_PIN(sacc); FA_PIN(pw2.z); FA_PIN(pw2.w);
    FA_SBAR();
    C0 = FA_MFMA(kf6, w.qr[3], C0); vl4 = vtr(vp + 4096); vh4 = vtr(vp + 4096 + 512);
    sacc += P1[8]; sacc += P1[9]; sacc += P1[10]; sacc += P1[11]; pw3.x = cvtpk(P1[8], P1[9]); pw3.y = cvtpk(P1[10], P1[11]); FA_PIN(sacc); FA_PIN(pw3.x); FA_PIN(pw3.y);
    FA_SBAR();
    C1 = FA_MFMA(kf7, w.qr[3], C1); vl1 = vtr(vp + 1024); vh1 = vtr(vp + 1024 + 512);
    sacc += P1[12]; sacc += P1[13]; sacc += P1[14]; sacc += P1[15]; pw3.z = cvtpk(P1[12], P1[13]); pw3.w = cvtpk(P1[14], P1[15]); FA_PIN(sacc); FA_PIN(pw3.z); FA_PIN(pw3.w);
    FA_SBAR();
    C0 = FA_MFMA(ka0, w.qa, C0); vl5 = vtr(vp + 4096 + 1024); vh5 = vtr(vp + 4096 + 1024 + 512); FA_SBAR();
    C1 = FA_MFMA(ka1, w.qa, C1); FA_SBAR();
    w.lsum += sacc;
    const bf16x8 pa0 = __builtin_bit_cast(bf16x8, pw0), pa1 = __builtin_bit_cast(bf16x8, pw1), pa2 = __builtin_bit_cast(bf16x8, pw2), pa3 = __builtin_bit_cast(bf16x8, pw3);
    vl2 = vtr(vp + 2048); vh2 = vtr(vp + 2048 + 512);
    w.o0 = FA_MFMA(pa0, FA_VF(vl0, vh0), w.o0); vl6 = vtr(vp + 4096 + 2048); vh6 = vtr(vp + 4096 + 2048 + 512);
    w.o1 = FA_MFMA(pa0, FA_VF(vl4, vh4), w.o1);
    FA_SBAR();
    if ((k0 + 63 > qlo) || (MODE == 1 && k0 <= qlo + 31 - W)) {
        const float NEG = -__builtin_inff(); const int dq = t - k0 - 4 * hi;
#pragma unroll
        for (int r = 0; r < 16; ++r) { const int c = (r & 3) + 8 * (r >> 2); if ((unsigned)(dq - c) >= (unsigned)W) C0[r] = NEG; if ((unsigned)(dq - c - 32) >= (unsigned)W) C1[r] = NEG; }
    }
    float ma = FA_MX3(C0[0], C0[1], C1[0]), mb = FA_MX3(C0[2], C0[3], C1[1]); ma = FA_MX3(ma, C1[2], C1[3]);
#pragma unroll
    for (int r = 4; r < 16; r += 4) { ma = FA_MX3(ma, C0[r], C0[r + 1]); mb = FA_MX3(mb, C0[r + 2], C0[r + 3]); ma = FA_MX3(ma, C1[r], C1[r + 1]); mb = FA_MX3(mb, C1[r + 2], C1[r + 3]); }
    const float rm = swap_max(__builtin_fmaxf(ma, mb));
    if (MODE == 0) w.mrun = __builtin_fmaxf(w.mrun, rm + w.mhat);
    const bool resc = __any(rm > THR);
    if (resc) {
        const float dl = __builtin_fmaxf(rm, 0.f); w.mhat += dl;
#pragma unroll
        for (int r = 0; r < 16; ++r) { C0[r] -= dl; C1[r] -= dl; }
        set_qa(w, hi);
        const float f = __builtin_amdgcn_exp2f(-dl); w.lsum *= f;
        if (hi == 0) wsf[r32] = f;
    }
    FA_SBAR();
    FA_EX4(C0, 0); FA_PIN(C0); vl3 = vtr(vp + 3072); vh3 = vtr(vp + 3072 + 512);
    w.o0 = FA_MFMA(pa1, FA_VF(vl1, vh1), w.o0); FA_EX4(C0, 4); FA_EX4(C0, 8); FA_PIN(C0); vl7 = vtr(vp + 4096 + 3072); vh7 = vtr(vp + 4096 + 3072 + 512); FA_SBAR();
    w.o1 = FA_MFMA(pa1, FA_VF(vl5, vh5), w.o1); FA_EX4(C0, 12); FA_PIN(C0); FA_EX4(C1, 0); FA_PIN(C1); FA_SBAR();
    w.o0 = FA_MFMA(pa2, FA_VF(vl2, vh2), w.o0); FA_EX4(C1, 4); FA_PIN(C1); FA_SBAR();
    w.o1 = FA_MFMA(pa2, FA_VF(vl6, vh6), w.o1); FA_EX4(C1, 8); FA_PIN(C1); FA_SBAR();
    w.o0 = FA_MFMA(pa3, FA_VF(vl3, vh3), w.o0); FA_EX4(C1, 12); FA_PIN(C1); FA_SBAR();
    w.o1 = FA_MFMA(pa3, FA_VF(vl7, vh7), w.o1); FA_SBAR();
    if (resc) {
        asm volatile("s_waitcnt lgkmcnt(0)" ::: "memory");
#pragma unroll
        for (int g = 0; g < 4; ++g) { const f32x4 a4 = *(FA_LAS f32x4*)(wsf + 8 * g + 4 * hi);
#pragma unroll
            for (int i = 0; i < 4; ++i) { w.o0[4 * g + i] *= a4[i]; w.o1[4 * g + i] *= a4[i]; } }
    }
}
template <int VOFF>
__device__ __forceinline__ void drain_full(FA_LAS unsigned char* vlast, WaveSt& w, f32x16& P0, f32x16& P1, int lane, int hi) {
    FA_LAS unsigned char* vp = vlast + VOFF + ((lane >> 4) & 1) * 32 + (lane & 3) * 8 + (4 * hi + ((lane & 15) >> 2)) * 64;
    float s0 = 0.f, s1 = 0.f;
#pragma unroll
    for (int r = 0; r < 16; ++r) { s0 += P0[r]; s1 += P1[r]; }
    w.lsum += s0 + s1;
    const u32x4 w0 = {cvtpk(P0[0], P0[1]), cvtpk(P0[2], P0[3]), cvtpk(P0[4], P0[5]), cvtpk(P0[6], P0[7])};
    const u32x4 w1 = {cvtpk(P0[8], P0[9]), cvtpk(P0[10], P0[11]), cvtpk(P0[12], P0[13]), cvtpk(P0[14], P0[15])};
    const u32x4 w2 = {cvtpk(P1[0], P1[1]), cvtpk(P1[2], P1[3]), cvtpk(P1[4], P1[5]), cvtpk(P1[6], P1[7])};
    const u32x4 w3 = {cvtpk(P1[8], P1[9]), cvtpk(P1[10], P1[11]), cvtpk(P1[12], P1[13]), cvtpk(P1[14], P1[15])};
    const bf16x8 pa0 = __builtin_bit_cast(bf16x8, w0), pa1 = __builtin_bit_cast(bf16x8, w1), pa2 = __builtin_bit_cast(bf16x8, w2), pa3 = __builtin_bit_cast(bf16x8, w3);
#define FA_PV(ks, pa) do { const s16x4 l0_ = vtr(vp + (ks) * 1024), h0_ = vtr(vp + (ks) * 1024 + 512), l1_ = vtr(vp + 4096 + (ks) * 1024), h1_ = vtr(vp + 4096 + (ks) * 1024 + 512); \
    w.o0 = FA_MFMA(pa, FA_VF(l0_, h0_), w.o0); w.o1 = FA_MFMA(pa, FA_VF(l1_, h1_), w.o1); } while (0)
    FA_PV(0, pa0); FA_PV(1, pa1); FA_PV(2, pa2); FA_PV(3, pa3);
#undef FA_PV
}
__device__ __forceinline__ void load_gate(u32x4 (&gq)[4], const bf16_t* G, size_t grow, int h, int lane) {
#pragma unroll
    for (int d0 = 0; d0 < 2; ++d0)
#pragma unroll
        for (int i = 0; i < 2; ++i) gq[2 * d0 + i] = *(const u32x4*)(G + hm_off((int)grow + i * 16 + (lane >> 2), h * 64 + d0 * 32 + (lane & 3) * 8, NH));
}
__device__ __forceinline__ void wave_epilogue(FA_LAS float* stg, FA_LAS float* wsf, WaveSt& w, const u32x4 (&gq)[4], bf16_t* O, size_t grow, int h, int lane, int r32, int hi) {
    const float l = swap_add(w.lsum);
    if (hi == 0) wsf[r32] = l;
    asm volatile("s_waitcnt lgkmcnt(0)" ::: "memory");
    float rl[16];
#pragma unroll
    for (int g = 0; g < 4; ++g) { const f32x4 l4 = *(FA_LAS f32x4*)(wsf + 8 * g + 4 * hi);
#pragma unroll
        for (int i = 0; i < 4; ++i) rl[4 * g + i] = 1.0f / l4[i]; }
#pragma unroll
    for (int d0 = 0; d0 < 2; ++d0) {
#pragma unroll
        for (int g = 0; g < 4; ++g)
#pragma unroll
            for (int i = 0; i < 4; ++i) stg[(8 * g + 4 * hi + i) * 32 + r32] = (d0 == 0 ? w.o0[4 * g + i] : w.o1[4 * g + i]) * rl[4 * g + i];
        asm volatile("s_waitcnt lgkmcnt(0)" ::: "memory");
#pragma unroll
        for (int i = 0; i < 2; ++i) { const int row = i * 16 + (lane >> 2), ch = lane & 3;
            const f32x4 x0 = *(FA_LAS f32x4*)(stg + row * 32 + ch * 8), x1 = *(FA_LAS f32x4*)(stg + row * 32 + ch * 8 + 4);
            const size_t ga = (grow + row) * DM + h * 64 + d0 * 32 + ch * 8; const u32x4 gv = gq[2 * d0 + i];
            u32x4 ov;
            ov.x = cvtpk(x0[0] * __uint_as_float(gv.x << 16), x0[1] * __uint_as_float(gv.x & 0xffff0000u)); ov.y = cvtpk(x0[2] * __uint_as_float(gv.y << 16), x0[3] * __uint_as_float(gv.y & 0xffff0000u));
            ov.z = cvtpk(x1[0] * __uint_as_float(gv.z << 16), x1[1] * __uint_as_float(gv.z & 0xffff0000u)); ov.w = cvtpk(x1[2] * __uint_as_float(gv.w << 16), x1[3] * __uint_as_float(gv.w & 0xffff0000u));
            *(u32x4*)(O + tiled_off((int)(grow + row), h * 64 + d0 * 32 + ch * 8)) = ov; }
        asm volatile("s_waitcnt lgkmcnt(0)" ::: "memory");
    }
}
template <int MODE> __device__ __forceinline__ void wave_init(WaveSt& w, int hi) {
#pragma unroll
    for (int r = 0; r < 16; ++r) { w.o0[r] = 0.f; w.o1[r] = 0.f; }
    set_qa(w, hi);
}

__device__ __forceinline__ void fox_unit(FA_LAS unsigned char* lds, const Params& P, int b, int h, int qb) {
    const int tid = threadIdx.x, lane = tid & 63, r32 = lane & 31, hi = lane >> 5;
    const int wid = __builtin_amdgcn_readfirstlane(tid >> 6);
    const int q0 = qb * 256, qlo = q0 + wid * 32, t = qlo + r32;
    const size_t rowbase = (size_t)b * SEQ;
    const bf16_t* ksrc = P.K + hm_off((int)rowbase + lane, h * 64 + wid * 8, NH);
    const bf16_t* vsrc = P.V + hm_off((int)rowbase + 16 * (wid & 3) + (lane >> 2), h * 64 + (wid >> 2) * 32 + (lane & 3) * 8, NH);
    const float* cum = P.CUM + (size_t)(b * NH + h) * SEQ;
    const bf16_t* asrc = P.KAUG + ((size_t)(b * NH + h) * SEQ + lane) * 8;
    const int NT = (q0 + 256) / 64;
    WaveSt w; float qn = 0.f;
#pragma unroll
    for (int d0 = 0; d0 < 4; ++d0) { w.qr[d0] = *(const bf16x8*)(P.Q + hm_off((int)rowbase + t, h * 64 + d0 * 16 + hi * 8, NH));
#pragma unroll
        for (int j = 0; j < 8; ++j) { const float qv = bf2f((bf16_t)w.qr[d0][j]); qn = fmaf(qv, qv, qn); } }
    w.cq = cum[t]; w.mhat = 0.f; w.lsum = 0.f; w.mrun = -1e30f;
    wave_init<0>(w, hi);
    u32x4 gq[4]; load_gate(gq, P.G, rowbase + qlo, h, lane);
    const float qkb = sqrtf(swap_add(qn) * (__uint_as_float(P.KMAX[(b * NH + h) * 2]) + __uint_as_float(P.KMAX[(b * NH + h) * 2 + 1]))) * 1.01f + 1e-3f;
    FA_LAS float* wsf = (FA_LAS float*)(lds + F_WSF) + wid * 64;
    FA_LAS unsigned* votes = (FA_LAS unsigned*)(lds + F_FLAG);
    float cnew = 0.f;
#define FA_LOADT(j, bf) do { const size_t ko_ = (size_t)(j) * 64 * 32; FA_LAS unsigned char* bb_ = lds + (bf) * F_KBUF; \
        glds16(ksrc + ko_, (unsigned)__builtin_amdgcn_readfirstlane((int)(unsigned)(uintptr_t)(bb_ + wid * 1024))); \
        glds16(vsrc + ko_, (unsigned)__builtin_amdgcn_readfirstlane((int)(unsigned)(uintptr_t)(bb_ + F_VOFF + (wid >> 2) * 4096 + (wid & 3) * 1024))); \
        if (wid == 0) glds16(asrc + (size_t)(j) * 64 * 8, (unsigned)__builtin_amdgcn_readfirstlane((int)(unsigned)(uintptr_t)(bb_ + F_AOFF))); \
        cnew = cum[(j) * 64 + 63]; } while (0)
    FA_LOADT(NT - 1, 0); asm volatile("s_waitcnt vmcnt(0)" ::: "memory"); __syncthreads();
    bool wdone = false; int n = 0; f32x16 pA0, pA1, pB0, pB1;
#pragma unroll
    for (int r = 0; r < 16; ++r) { pA0[r] = 0.f; pA1[r] = 0.f; pB0[r] = 0.f; pB1[r] = 0.f; }
    int cur = 0; bool fin = false;
#define FA_WALK(tt, CA0, CA1, PA0, PA1) do { \
        const int j = NT - 1 - (tt), k0 = j * 64; const int nxt = cur == 2 ? 0 : cur + 1, prv = cur == 0 ? 2 : cur - 1; \
        if (j > 0) FA_LOADT(j - 1, nxt); \
        if (!wdone && k0 <= qlo + 31) { FA_LAS unsigned char* bb = lds + cur * F_KBUF; \
            tile_full<0, F_AOFF, F_VOFF>(bb, n > 0 ? lds + prv * F_KBUF : bb, wsf, w, CA0, CA1, PA0, PA1, k0, t, qlo, lane, r32, hi); ++n; } \
        if (j > 0) { \
            if (!wdone && n > 0 && __all(qkb + w.cq - cnew - w.mrun <= -TH_SKIP)) { wdone = true; drain_full<F_VOFF>(lds + cur * F_KBUF, w, CA0, CA1, lane, hi); } \
            if (lane == 0) votes[((tt) & 1) * 8 + wid] = wdone ? 1u : 0u; } \
        asm volatile("s_waitcnt vmcnt(0)" ::: "memory"); \
        __syncthreads(); \
        if (j > 0) { const u32x4 v0 = *(FA_LAS u32x4*)(votes + ((tt) & 1) * 8), v1 = *(FA_LAS u32x4*)(votes + ((tt) & 1) * 8 + 4); \
            if ((v0.x & v0.y & v0.z & v0.w & v1.x & v1.y & v1.z & v1.w) != 0u) fin = true; } \
        else { if (!wdone && n > 0) drain_full<F_VOFF>(lds + cur * F_KBUF, w, CA0, CA1, lane, hi); fin = true; } \
        cur = nxt; } while (0)
    for (int tt = 0; !fin; tt += 2) {
        FA_WALK(tt, pA0, pA1, pB0, pB1);
        if (fin) break;
        FA_WALK(tt + 1, pB0, pB1, pA0, pA1);
    }
#undef FA_WALK
#undef FA_LOADT
    wave_epilogue((FA_LAS float*)(lds + F_OST + wid * 4096), wsf, w, gq, P.O, rowbase + qlo, h, lane, r32, hi);
    __syncthreads();
}
__device__ __forceinline__ void swa_unit(FA_LAS unsigned char* lds, const Params& P, int b, int kvh, int qb, int hh_lo = 0, int hh_hi = 8) {
    const int tid = threadIdx.x, lane = tid & 63, r32 = lane & 31, hi = lane >> 5;
    const int wid = __builtin_amdgcn_readfirstlane(tid >> 6);
    const int q0 = qb * 256, qlo = q0 + wid * 32, t = qlo + r32;
    const size_t rowbase = (size_t)b * SEQ;
    const int j_lo = q0 >= 128 ? (q0 - 128) / 64 : 0, NT = (q0 + 256) / 64 - j_lo;
    const bf16_t* ksrc = P.K + hm_off((int)rowbase + j_lo * 64 + lane, kvh * 64 + wid * 8, 4);
    const bf16_t* vsrc = P.V + hm_off((int)rowbase + j_lo * 64 + 16 * (wid & 3) + (lane >> 2), kvh * 64 + (wid >> 2) * 32 + (lane & 3) * 8, 4);
    for (int i = 0; i < NT; ++i) {
        glds16(ksrc + (size_t)i * 64 * 32, (unsigned)__builtin_amdgcn_readfirstlane((int)(unsigned)(uintptr_t)(lds + i * S_KBUF + wid * 1024)));
        glds16(vsrc + (size_t)i * 64 * 32, (unsigned)__builtin_amdgcn_readfirstlane((int)(unsigned)(uintptr_t)(lds + i * S_KBUF + S_VOFF + (wid >> 2) * 4096 + (wid & 3) * 1024))); }
    asm volatile("s_waitcnt vmcnt(0)" ::: "memory");
    __syncthreads();
    FA_LAS float* wsf = (FA_LAS float*)(lds + S_WSF) + wid * 64;
    const int ta = (qlo >= 127 ? (qlo - 127) / 64 : 0) - j_lo, tb = (qlo + 31) / 64 - j_lo;
    for (int hh = hh_lo; hh < hh_hi; ++hh) {
        const int h = kvh * 8 + hh;
        WaveSt w;
#pragma unroll
        for (int d0 = 0; d0 < 4; ++d0) w.qr[d0] = *(const bf16x8*)(P.Q + hm_off((int)rowbase + t, h * 64 + d0 * 16 + hi * 8, NH));
        u32x4 gq[4]; load_gate(gq, P.G, rowbase + qlo, h, lane);
        w.cq = 0.f; w.mhat = P.sinks[h] * LOG2E; w.lsum = 0.5f; w.mrun = 0.f;
        wave_init<1>(w, hi);
        f32x16 pA0, pA1, pB0, pB1;
#pragma unroll
        for (int r = 0; r < 16; ++r) { pB0[r] = 0.f; pB1[r] = 0.f; }
        for (int ti = tb;;) {
            { FA_LAS unsigned char* bb = lds + ti * S_KBUF;
              tile_full<1, 0, S_VOFF>(bb, ti == tb ? bb : bb + S_KBUF, wsf, w, pA0, pA1, pB0, pB1, (j_lo + ti) * 64, t, qlo, lane, r32, hi); }
            if (ti == ta) { drain_full<S_VOFF>(lds + ta * S_KBUF, w, pA0, pA1, lane, hi); break; }
            --ti;
            { FA_LAS unsigned char* bb = lds + ti * S_KBUF;
              tile_full<1, 0, S_VOFF>(bb, bb + S_KBUF, wsf, w, pB0, pB1, pA0, pA1, (j_lo + ti) * 64, t, qlo, lane, r32, hi); }
            if (ti == ta) { drain_full<S_VOFF>(lds + ta * S_KBUF, w, pB0, pB1, lane, hi); break; }
            --ti;
        }
        wave_epilogue((FA_LAS float*)(lds + S_OST + wid * 4096), wsf, w, gq, P.O, rowbase + qlo, h, lane, r32, hi);
    }
    __syncthreads();
}
}
#define GAS __attribute__((address_space(1)))
#define LAS __attribute__((address_space(3)))
typedef unsigned short bf16;
typedef unsigned v4u __attribute__((ext_vector_type(4)));
typedef float f32x4 __attribute__((ext_vector_type(4)));
typedef short bf16x8 __attribute__((ext_vector_type(8)));
typedef GAS unsigned gu32;
typedef GAS unsigned long long gu64;
#define RLX_AGENT __ATOMIC_RELAXED, __HIP_MEMORY_SCOPE_AGENT
#define LDS_WAIT() asm volatile("s_waitcnt lgkmcnt(0)" ::: "memory")
#define VM_WAIT() asm volatile("s_waitcnt vmcnt(0)" ::: "memory")
__device__ __forceinline__ unsigned long long rt() { return __builtin_amdgcn_s_memrealtime(); }
__device__ __forceinline__ unsigned pk2(float lo, float hi) { return (unsigned)f2bf(lo) | ((unsigned)f2bf(hi) << 16); }
#define XB_TMO      128
#define XB_XCNT(j)  (256  + 64 * (j))
#define XB_XSUB(j)  (1280 + 64 * (j))
#define XB_XGEN(j)  (2304 + 64 * (j))
#define XB_TOP      3328
#define XB_TOPGEN   3392
#define XCD_BAR_WORDS 3456
#define XB_SPIN_CAP (1u << 18)

__device__ __forceinline__ unsigned xb_ld(unsigned* p)              { return __hip_atomic_load(p, __ATOMIC_RELAXED, __HIP_MEMORY_SCOPE_AGENT); }
__device__ __forceinline__ unsigned xb_add(unsigned* p, unsigned v) { return __hip_atomic_fetch_add(p, v, __ATOMIC_RELAXED, __HIP_MEMORY_SCOPE_AGENT); }
__device__ __forceinline__ unsigned xb_xcc_id() { return (unsigned)__builtin_amdgcn_s_getreg((3 << 11) | 20) & 0xFu; }
#define XB_SPIN(cond, bar) do { unsigned _sp = 0; while (cond) { __builtin_amdgcn_s_sleep(1); \
    if ((++_sp & 255u) == 0u) { if (xb_ld(&(bar)[XB_TMO])) break; if (_sp > XB_SPIN_CAP) { atomicAdd(&(bar)[XB_TMO], 1u); break; } } } } while (0)

struct XcdBarrier {
    unsigned* bar; unsigned x;
    volatile LAS unsigned* st;
};

__device__ __forceinline__ XcdBarrier xcd_barrier_post(unsigned* bar, volatile LAS unsigned* st) {
    XcdBarrier b; b.bar = bar; b.x = xb_xcc_id(); b.st = st;
    if (threadIdx.x == 0) (void)xb_add(&bar[XB_XCNT(b.x)], 1u);
    return b;
}
__device__ __forceinline__ void xcd_barrier_complete(unsigned* bar, unsigned x, unsigned& nloc, unsigned& nx) {
    const unsigned G = gridDim.x * gridDim.y * gridDim.z;
    unsigned sum, cnt, mine, sp = 0u;
    for (;;) {
        sum = 0u; cnt = 0u; mine = 0u;
#pragma unroll
        for (unsigned j = 0; j < 16; ++j) { const unsigned c = xb_ld(&bar[XB_XCNT(j)]); sum += c; cnt += (c > 0u) ? 1u : 0u; mine = (j == x) ? c : mine; }
        if (sum == G) break;
        __builtin_amdgcn_s_sleep(1);
        if ((++sp & 255u) == 0u) { if (xb_ld(&bar[XB_TMO])) break; if (sp > XB_SPIN_CAP) { atomicAdd(&bar[XB_TMO], 1u); break; } }
    }
    nloc = mine > 0u ? mine : 1u; nx = cnt > 0u ? cnt : 1u;
}

__device__ __forceinline__ void xcd_barrier(const XcdBarrier& b) {
    asm volatile("s_waitcnt vmcnt(0)" ::: "memory");
    __syncthreads();
    if (threadIdx.x == 0) {
        unsigned* bar = b.bar;
        __builtin_amdgcn_s_waitcnt(0);
        unsigned nloc = b.st[0], nx = b.st[1];
        if (nloc == 0u) { xcd_barrier_complete(bar, b.x, nloc, nx); b.st[0] = nloc; b.st[1] = nx; }
        const unsigned old = xb_add(&bar[XB_XSUB(b.x)], 1u);
        const unsigned gen = old / nloc;
        if (old + 1u == (gen + 1u) * nloc) {
            __builtin_amdgcn_fence(__ATOMIC_RELEASE, "agent");
            asm volatile("s_waitcnt vmcnt(0)" ::: "memory");
            const unsigned og = xb_add(&bar[XB_TOP], 1u);
            const unsigned tg = og / nx;
            if (og + 1u == (tg + 1u) * nx) xb_add(&bar[XB_TOPGEN], 1u);
            else XB_SPIN(xb_ld(&bar[XB_TOPGEN]) == tg, bar);
            __builtin_amdgcn_fence(__ATOMIC_ACQUIRE, "agent");
            xb_add(&bar[XB_XGEN(b.x)], 1u);
            asm volatile("s_waitcnt vmcnt(0)" ::: "memory");
        } else {
            XB_SPIN(xb_ld(&bar[XB_XGEN(b.x)]) == gen, bar);
            __builtin_amdgcn_fence(__ATOMIC_ACQUIRE, "agent");
            asm volatile("s_waitcnt vmcnt(0)" ::: "memory");
        }
    }
    __syncthreads();
}
constexpr int NWAVES = 8;
constexpr int N1P = 8448;
constexpr int RING_OFF = 0, RING_BYTES = 135168;
constexpr int LDSCTL_OFF = RING_BYTES, MISC_OFF = LDSCTL_OFF + 320;
constexpr int LDS_BYTES = 147456;
constexpr int CW_BAR = 4096;
static_assert(fa::F_LDS_BYTES <= RING_BYTES && fa::S_LDS_BYTES <= RING_BYTES && pg8::STAGE_BYTES <= RING_BYTES && MISC_OFF + 128 <= LDS_BYTES && (CW_BAR + XCD_BAR_WORDS) * 4 <= (int)WS_KMAX, "LDS / CTL map");

__device__ __forceinline__ void p0_transpose_item(const float* W, int K, int N, bf16* WT, LAS float* scr, int item, int lane, const float* gs) {
    const int nblk = N / 32, kb = item / nblk, nb = item % nblk, k0 = 64 * kb, n0 = 32 * nb;
    const int kr = lane >> 3, nc = 4 * (lane & 7);
    f32x4 wv[8];
#pragma unroll
    for (int i = 0; i < 8; ++i) wv[i] = *(const GAS f32x4*)(W + (size_t)(k0 + 8 * i + kr) * N + n0 + nc);
#pragma unroll
    for (int i = 0; i < 8; ++i) { const int kk = 8 * i + kr; f32x4 w = wv[i]; if (gs) w = w * gs[k0 + kk]; LAS float* d = scr + kk * 33 + nc; d[0] = w.x; d[1] = w.y; d[2] = w.z; d[3] = w.w; }
    LDS_WAIT(); asm volatile("" ::: "memory");
    const int c = lane & 7;
#pragma unroll
    for (int j = 0; j < 4; ++j) { const int n = (lane >> 3) + 8 * j; const LAS float* sp = scr + (8 * c) * 33 + n;
        v4u o; o.x = pk2(sp[0 * 33], sp[1 * 33]); o.y = pk2(sp[2 * 33], sp[3 * 33]); o.z = pk2(sp[4 * 33], sp[5 * 33]); o.w = pk2(sp[6 * 33], sp[7 * 33]);
        *(GAS v4u*)(WT + tiled_off(n0 + n, k0 + 8 * c)) = o; }
    LDS_WAIT(); asm volatile("" ::: "memory");
}
__device__ __forceinline__ float wave_sum(float v) {
#pragma unroll
    for (int o = 1; o < 64; o <<= 1) v += __shfl_xor(v, o);
    return v;
}

struct Args { const float* in[9]; float* out; unsigned char* ws; int ph_lo, ph_hi; };
constexpr int N_PHASES = 9;
__global__ void __launch_bounds__(NWAVES * 64, 2) mega_fwd(Args args) {
    extern __shared__ __attribute__((aligned(16))) unsigned char lds_raw[];
    LAS unsigned char* lds = (LAS unsigned char*)lds_raw;
    volatile LAS unsigned* MISC = (volatile LAS unsigned*)(lds + MISC_OFF);
    const int tid = threadIdx.x, lane = tid & 63, wave = __builtin_amdgcn_readfirstlane(tid >> 6);
    const int G = gridDim.x, bx = blockIdx.x, vcu = (G % 8 == 0) ? (bx % 8) * (G / 8) + bx / 8 : bx;
    unsigned char* ws = args.ws;
    const float* x = args.in[0]; const float* norm_g = args.in[1]; const float* fox_w_in = args.in[2]; const float* fox_b_f = args.in[3]; const float* fox_w_out = args.in[4];
    const float* swa_w_in = args.in[5]; const float* swa_sinks = args.in[6]; const float* swa_w_out = args.in[7]; const float* final_g = args.in[8];
    float* out = args.out;
    gu32* ctl = (gu32*)(ws + WS_CTL);
    unsigned* KMAX = (unsigned*)(ws + WS_KMAX); unsigned* TICKET = (unsigned*)(ws + WS_TICKET);
    float* SS1 = (float*)(ws + WS_SS1); float* R0 = (float*)(ws + WS_R0); float* ROPE = (float*)(ws + WS_ROPE); float* LOGF = (float*)(ws + WS_LOGF); float* CUM = (float*)(ws + WS_CUM);
    bf16* W1T = (bf16*)(ws + WS_W1T); bf16* W2T = (bf16*)(ws + WS_W2T); bf16* W3T = (bf16*)(ws + WS_W3T); bf16* W4T = (bf16*)(ws + WS_W4T);
    bf16* KAUG = (bf16*)(ws + WS_KAUG);
    bf16* XB = (bf16*)(ws + WS_XB); bf16* Qb = (bf16*)(ws + WS_Q); bf16* Kb = (bf16*)(ws + WS_K); bf16* Vb = (bf16*)(ws + WS_V); bf16* Gb = (bf16*)(ws + WS_G); bf16* YG = (bf16*)(ws + WS_YG);
    for (int u = tid; u < (LDS_BYTES - LDSCTL_OFF) / 4; u += NWAVES * 64) ((LAS unsigned*)(lds + LDSCTL_OFF))[u] = 0u;
    __syncthreads();
    const int lo = args.ph_lo, hi = args.ph_hi;
    XcdBarrier bar; bar.bar = (unsigned*)(ctl + CW_BAR); bar.x = 0; bar.st = nullptr;
    if (hi - lo > 1) bar = xcd_barrier_post((unsigned*)(ctl + CW_BAR), MISC + 8);
#define IN(k) (lo <= (k) && (k) < hi)
#define REP(k) for (int rep_ = 0; rep_ < (((DUP_MASK >> (k)) & 1) ? 2 : 1); ++rep_)
#define SEAM(k) do { if (IN(k) && IN((k) + 1)) xcd_barrier(bar); } while (0)
    const int gw = vcu * NWAVES + wave, NGW = G * NWAVES;
    const bool grp = (G == 256) && lo == 0 && hi == N_PHASES;
    const int gpm = 8 * (bx & 7) + ((bx >> 3) & 7), gj = bx >> 6;
    unsigned* GS = (unsigned*)(ws + WS_GS);
    unsigned* XT = (unsigned*)(ws + WS_XT);
    if (grp && tid == 0) __hip_atomic_store(XT + bx, xb_xcc_id() + 1u, __ATOMIC_RELAXED, __HIP_MEMORY_SCOPE_AGENT);
#define G_ARRIVE() do { asm volatile("s_waitcnt vmcnt(0)" ::: "memory"); __syncthreads(); \
        if (tid == 0) { if (MISC[12] != 0u) { __builtin_amdgcn_fence(__ATOMIC_RELEASE, "agent"); asm volatile("s_waitcnt vmcnt(0)" ::: "memory"); } (void)xb_add(GS + gpm * 16, 1u); } } while (0)
#define G_WAIT(pm_, target) do { if (tid == 0) { unsigned* w_ = GS + (pm_) * 16; XB_SPIN(xb_ld(w_) < (unsigned)(target), bar.bar); \
        __builtin_amdgcn_fence(__ATOMIC_ACQUIRE, "agent"); asm volatile("s_waitcnt vmcnt(0)" ::: "memory"); } __syncthreads(); } while (0)

    if (IN(0)) REP(0) {
        LAS float* scr = (LAS float*)(lds + RING_OFF + wave * 16384);
        constexpr int I1 = (DM / 64) * (FOX_IN / 32);
        for (int it = gw; it < I1; it += NGW) p0_transpose_item(fox_w_in, DM, FOX_IN, W1T, scr, it, lane, norm_g);
        for (int m = 2 * gw; m < MTOK; m += 2 * NGW) {
            const int m2 = m + 1;
            const GAS f32x4* xr = (const GAS f32x4*)(x + (size_t)m * DM) + lane; const GAS f32x4* xr2 = (const GAS f32x4*)(x + (size_t)m2 * DM) + lane; f32x4 v[8], v2[8]; float s = 0.f, s2 = 0.f;
#pragma unroll
            for (int j = 0; j < 8; ++j) { v[j] = xr[64 * j]; v2[j] = xr2[64 * j]; }
#pragma unroll
            for (int j = 0; j < 8; ++j) { s += (v[j].x * v[j].x + v[j].y * v[j].y) + (v[j].z * v[j].z + v[j].w * v[j].w); s2 += (v2[j].x * v2[j].x + v2[j].y * v2[j].y) + (v2[j].z * v2[j].z + v2[j].w * v2[j].w); }
            s = wave_sum(s); s2 = wave_sum(s2);
            if (lane == 0) { R0[m] = 1.0f / sqrtf(s * (1.f / DM) + RMS_EPS); R0[m2] = 1.0f / sqrtf(s2 * (1.f / DM) + RMS_EPS); }
#pragma unroll
            for (int j = 0; j < 8; ++j) { *(GAS unsigned long long*)(XB + tiled_off(m, 256 * j + 4 * lane)) = (unsigned long long)pk2(v[j].x, v[j].y) | ((unsigned long long)pk2(v[j].z, v[j].w) << 32);
                                          *(GAS unsigned long long*)(XB + tiled_off(m2, 256 * j + 4 * lane)) = (unsigned long long)pk2(v2[j].x, v2[j].y) | ((unsigned long long)pk2(v2[j].z, v2[j].w) << 32); }
        }
        { const int gt = gw * 64 + lane;
          if (gt < SEQ * 8) { const int pos = gt >> 3, i = gt & 7;
              const double invf[8] = {1.0, 0.19390220519133497, 0.037598065178462524, 0.0072903477503833845, 0.0014142135623730951, 0.00027421912901204056, 5.3171693730649086e-05, 1.0310108130908796e-05};
              double inv = invf[0];
#pragma unroll
              for (int k = 1; k < 8; ++k) inv = (i == k) ? invf[k] : inv;
              const double ang = (double)pos * inv; const double kk = __builtin_rint(ang * 0.15915494309189535); const float red = (float)(ang - kk * 6.283185307179586);
              ROPE[(size_t)pos * 16 + i] = cosf(red); ROPE[(size_t)pos * 16 + 8 + i] = sinf(red); } }
    }
    SEAM(0);
    if (IN(1)) {
        pg8::Gemm g{XB, W1T, MTOK, 4 * DM, DM}; pg8::StaticOrder S; S.init(MTOK, 4 * DM, G, bx, (DUP_MASK >> 1) & 1, (DUP_MASK >> 9) & 1);
        pg8::EpiFoxIn E{Qb, Kb, Vb, Gb, LOGF, R0, fox_b_f, KMAX};
        if ((DUP_MASK >> 10) & 1) { pg8::StaticOrder SP; SP.init(MTOK, 4 * DM, G, bx, 0, 0, 1); pg8::gemm_phase<pg8::EpiFoxIn, pg8::StaticOrder, true, true>(lds + RING_OFF, g, SP, E); }
        pg8::gemm_phase<pg8::EpiFoxIn, pg8::StaticOrder, true, true>(lds + RING_OFF, g, S, E);
        for (int rb = bx * 64; rb < MTOK; rb += G * 64) {
            const int arow = rb + 16 * (wave & 3) + (lane & 15), brow = 4 * DM + 16 * (wave >> 2) + (lane & 15), kg = (lane >> 4) * 8;
            pg8::f32x4 acc = {0.f, 0.f, 0.f, 0.f};
#pragma unroll 8
            for (int ks = 0; ks < DM / 32; ++ks) {
                const bf16x8 af = *(const GAS bf16x8*)(XB + tiled_off(arow, 32 * ks + kg)), bfv = *(const GAS bf16x8*)(W1T + tiled_off(brow, 32 * ks + kg));
                acc = __builtin_amdgcn_mfma_f32_16x16x32_bf16(af, bfv, acc, 0, 0, 0); }
            const int h = 16 * (wave >> 2) + (lane & 15), r0 = rb + 16 * (wave & 3) + 4 * (lane >> 4); const float bb = fox_b_f[h];
            f32x4 o; o.x = logsigmoidf(acc[0] * R0[r0] + bb); o.y = logsigmoidf(acc[1] * R0[r0 + 1] + bb); o.z = logsigmoidf(acc[2] * R0[r0 + 2] + bb); o.w = logsigmoidf(acc[3] * R0[r0 + 3] + bb);
            *(GAS f32x4*)(LOGF + ((size_t)((r0 >> 12) * NH + h) << 12) + (r0 & 4095)) = o;
        }
        { LAS float* scr = (LAS float*)(lds + RING_OFF + wave * 16384);
          constexpr int I2 = (DM / 64) * (DM / 32), I3 = (DM / 64) * (SWA_IN / 32);
          for (int it = gw; it < I2 + I3; it += NGW) { if (it < I2) p0_transpose_item(fox_w_out, DM, DM, W2T, scr, it, lane, nullptr); else p0_transpose_item(swa_w_in, DM, SWA_IN, W3T, scr, it - I2, lane, norm_g + DM); } }
    }
    SEAM(1);
    if (IN(2)) REP(2) {
        for (int sq = vcu; sq < NB * NH; sq += G) {
            const GAS f32x4* lf = (const GAS f32x4*)(LOGF + (size_t)sq * SEQ + wave * 512) + lane * 2; const f32x4 v0 = lf[0], v1 = lf[1];
            const double tot = (((double)v0.x + (double)v0.y) + ((double)v0.z + (double)v0.w)) + (((double)v1.x + (double)v1.y) + ((double)v1.z + (double)v1.w));
            double incl = tot;
#pragma unroll
            for (int o = 1; o < 64; o <<= 1) { const double up = __shfl_up(incl, o); if (lane >= o) incl += up; }
            volatile LAS double* wt = (volatile LAS double*)(lds + RING_OFF);
            __syncthreads();
            if (lane == 63) wt[wave] = incl;
            __syncthreads();
            double run = incl - tot;
            for (int w2 = 0; w2 < wave; ++w2) run += wt[w2];
            const float vv[8] = {v0.x, v0.y, v0.z, v0.w, v1.x, v1.y, v1.z, v1.w}; float cv[8];
#pragma unroll
            for (int e = 0; e < 8; ++e) { run += (double)vv[e]; cv[e] = (float)(run * 1.4426950408889634); }
            GAS f32x4* co = (GAS f32x4*)(CUM + (size_t)sq * SEQ + wave * 512) + lane * 2; co[0] = (f32x4){cv[0], cv[1], cv[2], cv[3]}; co[1] = (f32x4){cv[4], cv[5], cv[6], cv[7]};
            GAS v4u* ka = (GAS v4u*)(KAUG + ((size_t)sq * SEQ + wave * 512 + lane * 8) * 8);
#pragma unroll
            for (int e = 0; e < 8; ++e) { unsigned h1, h2, h3; fa::split3(-cv[e], h1, h2, h3); ka[e] = (v4u){h1 | (h2 << 16), h3 | 0x3F800000u, 0x3F803F80u, 0u}; }
        }
        { const int nidle = G > NB * NH ? G - NB * NH : G, ii = G > NB * NH ? vcu - NB * NH : vcu;
          if (ii >= 0) { __syncthreads(); LAS float* scr = (LAS float*)(lds + RING_OFF + wave * 16384); constexpr int I2 = (DM / 64) * (DM / 32);
              for (int it = ii * NWAVES + wave; it < I2; it += nidle * NWAVES) p0_transpose_item(swa_w_out, DM, DM, W4T, scr, it, lane, nullptr); } }
    }
    SEAM(2);
    if (IN(3)) {
        const fa::Params P{Qb, Kb, Vb, Gb, YG, CUM, nullptr, KMAX, TICKET, KAUG};
        if (grp && tid == 0) {
            const unsigned me = xb_xcc_id() + 1u; const int pn = gpm + 1, two = ((pn & 15) != 0) ? 1 : 0, pq = two ? pn : gpm;
            const unsigned r0 = xb_ld(XT + 8 * (16 + (gpm & 7)) + (gpm >> 3)), r1 = xb_ld(XT + 8 * (24 + (gpm & 7)) + (gpm >> 3));
            const unsigned r2 = xb_ld(XT + 8 * (16 + (pq & 7)) + (pq >> 3)), r3 = xb_ld(XT + 8 * (24 + (pq & 7)) + (pq >> 3));
            MISC[12] = (r0 != me || r1 != me || r2 != me || r3 != me) ? 1u : 0u; }
        volatile LAS unsigned* slot = (volatile LAS unsigned*)(lds + RING_OFF + fa::F_FLAG + 128);
#define FOX_FETCH(dst) do { unsigned code_ = 0xFFFFFFFFu; for (int k_ = 0; k_ < 8; ++k_) { const unsigned q_ = (unsigned)((bx + k_) & 7); const unsigned t_ = atomicAdd(TICKET + q_ * 64, 1u); \
            if (t_ < 256u) { code_ = q_ * 256u + t_; break; } } (dst) = code_; } while (0)
        if (tid == 0) FOX_FETCH(slot[0]);
        __syncthreads();
        unsigned tk = slot[0]; int par = 0;
        while (tk != 0xFFFFFFFFu) {
            if (tid == 0) FOX_FETCH(slot[par ^ 1]);
            const int q = (int)(tk >> 8), tq = (int)(tk & 255u), pi = tq >> 4, hs = 3 - (pi >> 2);
            const int h = hs == 0 ? q : hs == 1 ? 15 - q : hs == 2 ? 16 + q : 31 - q;
            fa::fox_unit(lds + RING_OFF, P, pi & 3, h, 15 - (tq & 15));
            par ^= 1; tk = slot[par];
        }
#undef FOX_FETCH
        __syncthreads();
    }
    SEAM(3);
    if (IN(4)) {
        pg8::Gemm g{YG, W2T, MTOK, DM, DM}; pg8::StaticOrder S; S.init(MTOK, DM, G, bx);
        pg8::EpiRes<true> E{x, XB, SS1};
        pg8::gemm_phase<pg8::EpiRes<true>, pg8::StaticOrder, true, true>(lds + RING_OFF, g, S, E);
    }
    SEAM(4);
    if (IN(5)) {
        pg8::Gemm g{XB, W3T, MTOK, SWA_IN, DM}; pg8::StaticOrder S; S.init(MTOK, SWA_IN, G, bx, (DUP_MASK >> 5) & 1, 0, 0, 0, grp ? 4 : (1 << 20));
        pg8::EpiSwaIn E{Qb, Kb, Vb, Gb, SS1, ROPE};
        pg8::gemm_phase<pg8::EpiSwaIn, pg8::StaticOrder, true, true>(lds + RING_OFF, g, S, E);
        if (grp) {
            G_ARRIVE();
            if (gj < 2) { pg8::StaticOrder S4; S4.init(MTOK, SWA_IN, G, bx, 0, 0, 0, 4, 5); pg8::gemm_phase<pg8::EpiSwaIn, pg8::StaticOrder, true, true>(lds + RING_OFF, g, S4, E); }
            else { const fa::Params P{Qb, Kb, Vb, Gb, YG, nullptr, swa_sinks, nullptr, nullptr, nullptr};
                   G_WAIT(gpm, 4); if ((gpm & 15) != 0) G_WAIT(gpm - 1, 4);
                   fa::swa_unit(lds + RING_OFF, P, gpm >> 4, gj - 2, gpm & 15); }
        }
    }
    SEAM(5);
    if (IN(6)) REP(6) {
        const fa::Params P{Qb, Kb, Vb, Gb, YG, nullptr, swa_sinks, nullptr, nullptr, nullptr};
        if (grp) fa::swa_unit(lds + RING_OFF, P, gpm >> 4, 2 + (gj >> 1), gpm & 15, (gj & 1) * 4, (gj & 1) * 4 + 4);
        else for (int u = bx; u < NB * 4 * 16; u += G) fa::swa_unit(lds + RING_OFF, P, u >> 6, (u >> 4) & 3, u & 15);
    }
    SEAM(6);
    if (IN(7)) {
        pg8::Gemm g{YG, W4T, MTOK, DM, DM}; pg8::StaticOrder S; S.init(MTOK, DM, G, bx);
        pg8::EpiRes<false> E{nullptr, XB, nullptr};
        pg8::gemm_phase<pg8::EpiRes<false>, pg8::StaticOrder, true, true>(lds + RING_OFF, g, S, E);
    }
    SEAM(7);
    if (IN(8)) {
        f32x4 gq[8];
#pragma unroll
        for (int j = 0; j < 8; ++j) gq[j] = ((const GAS f32x4*)final_g)[lane + 64 * j];
        for (int m = 2 * gw; m < MTOK; m += 2 * NGW) {
            f32x4 v[8], v2[8]; float s = 0.f, s2 = 0.f; unsigned long long xw[8], xw2[8];
#pragma unroll
            for (int j = 0; j < 8; ++j) { xw[j] = *(const GAS unsigned long long*)(XB + tiled_off(m, 256 * j + 4 * lane)); xw2[j] = *(const GAS unsigned long long*)(XB + tiled_off(m + 1, 256 * j + 4 * lane)); }
#pragma unroll
            for (int j = 0; j < 8; ++j) { const unsigned lo32 = (unsigned)xw[j], hi32 = (unsigned)(xw[j] >> 32), lo2 = (unsigned)xw2[j], hi2 = (unsigned)(xw2[j] >> 32);
                v[j] = (f32x4){__uint_as_float(lo32 << 16), __uint_as_float(lo32 & 0xffff0000u), __uint_as_float(hi32 << 16), __uint_as_float(hi32 & 0xffff0000u)};
                v2[j] = (f32x4){__uint_as_float(lo2 << 16), __uint_as_float(lo2 & 0xffff0000u), __uint_as_float(hi2 << 16), __uint_as_float(hi2 & 0xffff0000u)};
                s += (v[j].x * v[j].x + v[j].y * v[j].y) + (v[j].z * v[j].z + v[j].w * v[j].w); s2 += (v2[j].x * v2[j].x + v2[j].y * v2[j].y) + (v2[j].z * v2[j].z + v2[j].w * v2[j].w); }
            const float r = 1.0f / sqrtf(wave_sum(s) * (1.f / DM) + RMS_EPS), r2 = 1.0f / sqrtf(wave_sum(s2) * (1.f / DM) + RMS_EPS);
            GAS f32x4* xr = (GAS f32x4*)(out + (size_t)m * DM) + lane; GAS f32x4* xr2 = (GAS f32x4*)(out + (size_t)(m + 1) * DM) + lane;
#pragma unroll
            for (int j = 0; j < 8; ++j) { xr[64 * j] = v[j] * r * gq[j]; xr2[64 * j] = v2[j] * r2 * gq[j]; }
        }
    }
#undef IN
#undef SEAM
#undef G_ARRIVE
#undef G_WAIT
}

extern "C" void kernel_launch(void* const* d_in, const int* in_sizes, int n_in, void* d_out, int out_size, void* d_ws, size_t ws_size, hipStream_t stream) {
    static int grid = 0;
    if (grid == 0) {
        if (n_in != 9 || in_sizes[0] != MTOK * DM || out_size != MTOK * DM || ws_size < WS_END) { fprintf(stderr, "kernel_launch: unexpected shapes (n_in %d, in0 %d, out %d, ws %zu)\n", n_in, n_in > 0 ? in_sizes[0] : -1, out_size, ws_size); grid = -1; return; }
        int dev = 0, cus = 0, per_cu = 0;
        if (hipGetDevice(&dev) != hipSuccess || hipDeviceGetAttribute(&cus, hipDeviceAttributeMultiprocessorCount, dev) != hipSuccess) { fprintf(stderr, "kernel_launch: device query failed\n"); grid = -1; return; }
        if (hipFuncSetAttribute((const void*)mega_fwd, hipFuncAttributeMaxDynamicSharedMemorySize, LDS_BYTES) != hipSuccess) { fprintf(stderr, "kernel_launch: hipFuncSetAttribute failed\n"); grid = -1; return; }
        if (hipOccupancyMaxActiveBlocksPerMultiprocessor(&per_cu, (const void*)mega_fwd, NWAVES * 64, LDS_BYTES) != hipSuccess || per_cu < 1) { fprintf(stderr, "kernel_launch: occupancy query reports %d workgroups per CU; nothing launched\n", per_cu); (void)hipGetLastError(); grid = -1; return; }
        grid = cus;
    }
    if (grid < 0) return;
    (void)hipMemsetAsync((unsigned char*)d_ws + WS_CTL, 0, CTL_ZERO_BYTES, stream);
    Args a{};
    for (int i = 0; i < 9; ++i) a.in[i] = (const float*)d_in[i];
    a.out = (float*)d_out; a.ws = (unsigned char*)d_ws;
    int p = 0;
    while (p < N_PHASES) {
        if (!((FAST_MASK >> p) & 1)) { ++p; continue; }
        int e = p + 1; if (ONE_LAUNCH) while (e < N_PHASES && ((FAST_MASK >> e) & 1)) ++e;
        a.ph_lo = p; a.ph_hi = e;
        hipLaunchKernelGGL(mega_fwd, dim3(grid), dim3(NWAVES * 64), LDS_BYTES, stream, a);
        p = e;
    }
}
```

```cpp
#include <hip/hip_runtime.h>
#include <cstdio>
#include <cstdint>

constexpr int NB = 4, SEQ = 4096, DM = 2048, MTOK = NB * SEQ, NH = 32, HD = 64;
constexpr int FOX_IN = 8224, SWA_IN = 4608, KVW = 256;
constexpr float RMS_EPS = 1e-6f;
constexpr float LOG2E = 1.4426950408889634f;
constexpr float C2 = 0.125f * LOG2E;

typedef unsigned short bf16_t;
__device__ __forceinline__ float bf2f(bf16_t v) { return __uint_as_float((unsigned)v << 16); }
__device__ __forceinline__ bf16_t f2bf(float f) { unsigned u = __float_as_uint(f); return (bf16_t)((u + 0x7fffu + ((u >> 16) & 1u)) >> 16); }
__device__ __forceinline__ float logsigmoidf(float z) { return z < 0.f ? z - log1pf(expf(z)) : -log1pf(expf(-z)); }
__device__ __forceinline__ float siluf(float g) { return g / (1.f + expf(-g)); }

__host__ __device__ __forceinline__ size_t tiled_off(int row, int k) { return ((size_t)(((row >> 8) * (DM / 64) + (k >> 6)) * 2 + ((k >> 5) & 1)) << 13) + (size_t)(((row & 255) << 5) + (k & 31)); }

__host__ __device__ __forceinline__ size_t hm_off(int row  , int col  , int nheads) { return ((size_t)(((row >> 12) * nheads + (col >> 6)) * 2 + ((col >> 5) & 1)) * SEQ + (row & 4095)) * 32 + (col & 31); }

constexpr size_t MiB = 1u << 20;
constexpr size_t WS_CTL = 0, CTL_ZERO_BYTES = 1 * MiB;
constexpr size_t WS_KMAX = 64 * 1024, WS_TICKET = 66 * 1024;
constexpr size_t WS_GS = 128 * 1024;
constexpr size_t WS_XT = 160 * 1024;
constexpr size_t WS_SS1 = 512 * 1024;
constexpr size_t WS_R0 = 1 * MiB;
constexpr size_t WS_ROPE = 1 * MiB + 512 * 1024;
constexpr size_t WS_LOGF = 2 * MiB;
constexpr size_t WS_CUM = 4 * MiB;
constexpr size_t WS_W1T = 8 * MiB, WS_W2T = 41 * MiB, WS_W3T = 49 * MiB, WS_W4T = 67 * MiB;
constexpr size_t WS_XB = 76 * MiB, WS_Q = 140 * MiB, WS_K = 204 * MiB, WS_V = 268 * MiB, WS_G = 332 * MiB, WS_YG = 396 * MiB, WS_KAUG = 460 * MiB, WS_END = 468 * MiB;

#ifndef FAST_MASK
#define FAST_MASK 0x1FF
#endif
#ifndef DUP_MASK
#define DUP_MASK 0x000
#endif
#ifndef ONE_LAUNCH
#define ONE_LAUNCH 1
#endif
namespace pg8 {
#define PG8_LAS __attribute__((address_space(3)))
typedef unsigned short bf16_t;
typedef short bf16x8 __attribute__((ext_vector_type(8)));
typedef float f32x4 __attribute__((ext_vector_type(4)));
typedef unsigned u32x4 __attribute__((ext_vector_type(4)));
constexpr int BM = 256, BK = 64, HALF = 128, HTB = HALF * BK * 2  , STAGE_BYTES = 8 * HTB, NXCD = 8, WGM = 8;

__host__ __device__ __forceinline__ int lds_byte(int r, int c) { const int st = (r >> 4) * 2 + (c >> 5), rr = r & 15, cc = c & 31, ob = rr * 64 + cc * 2; return st * 1024 + (ob ^ (((ob >> 9) & 1) << 5)); }
__host__ __device__ __forceinline__ void stage_rc(int b, int& R, int& C) { const int st = b / 1024, sb = b % 1024, swz = sb ^ (((sb >> 9) & 1) << 5); R = (st >> 1) * 16 + swz / 64; C = (st & 1) * 32 + (swz % 64) / 2; }
__host__ __device__ __forceinline__ int perm32(int rho) { const int n = rho >> 4, i = rho & 15; return 8 * (i >> 2) + 4 * n + (i & 3); }

struct Unit { int pm, pn, lm, ln; };
struct Gemm { const bf16_t* A; const bf16_t* Bt; int M, N, K; };

struct StaticOrder {
    int nM, nN, nwg, G, c, dup, epi2, same, i0, i1;
    __host__ __device__ void init(int M, int N, int G_, int c_, int dup_ = 0, int epi2_ = 0, int same_ = 0, int i0_ = 0, int i1_ = 1 << 20) { nM = M / BM; nN = N / BM; nwg = nM * nN; G = G_; c = c_; dup = dup_; epi2 = epi2_; same = same_; i0 = i0_; i1 = i1_; }
    __host__ __device__ bool next(int i, Unit& u) const {
        if (dup) i >>= 1;
        i += i0; if (i >= i1) return false;
        const long L = (long)i * G + c; if (L >= nwg) return false;
        int wgid = (int)L; { const int q = nwg / NXCD, r = nwg % NXCD, xcd = wgid % NXCD, off = wgid / NXCD; wgid = (xcd < r ? xcd * (q + 1) : r * (q + 1) + (xcd - r) * q) + off; }
        const int nig = WGM * nN, gid = wgid / nig, fm = gid * WGM, gsz = (nM - fm) < WGM ? (nM - fm) : WGM;
        u.pm = fm + ((wgid % nig) % gsz); u.pn = (wgid % nig) / gsz; u.lm = same ? 0 : u.pm; u.ln = same ? 0 : u.pn; return true;
    }
    __device__ __forceinline__ void a_ready(const Unit&) const {}
    __device__ __forceinline__ void done(const Unit&) const {}
};

__device__ __forceinline__ unsigned cvt_pk_bf16(float lo, float hi) { unsigned r; asm volatile("v_cvt_pk_bf16_f32 %0, %1, %2" : "=v"(r) : "v"(lo), "v"(hi)); return r; }
__device__ __forceinline__ float silu_fast(float g) { return g * __builtin_amdgcn_rcpf(1.0f + __builtin_amdgcn_exp2f(-g * 1.4426950408889634f)); }
__device__ __forceinline__ u32x4 pack8(const f32x4 v0, const f32x4 v1) { u32x4 w; w.x = cvt_pk_bf16(v0[0], v0[1]); w.y = cvt_pk_bf16(v0[2], v0[3]); w.z = cvt_pk_bf16(v1[0], v1[1]); w.w = cvt_pk_bf16(v1[2], v1[3]); return w; }
struct EpiFoxIn {
    static constexpr bool PERM = true, AFTER_DRAIN = false;
    bf16_t *Q, *K, *V, *G; float* LOGF; const float* R0; const float* bfb; unsigned* KMAX;
    __device__ __forceinline__ void operator()(const f32x4 (&acc)[2][2][4][2], const Unit& u, int wr, int wc, int fr, int fq) const {
        const int row0 = u.pm * BM + wr * 64 + fr, pn = u.pn;
        float rs[2][4];
#pragma unroll
        for (int ai = 0; ai < 2; ++ai)
#pragma unroll
            for (int m = 0; m < 4; ++m) rs[ai][m] = R0[row0 + ai * HALF + m * 16];
        {
            const int reg = pn >> 3; bf16_t* base = reg == 0 ? Q : reg == 1 ? K : reg == 2 ? V : G; float kmx[2] = {0.f, 0.f};
            const int col0 = (pn & 7) * BM + wc * 32 + 8 * fq;
#pragma unroll
            for (int ai = 0; ai < 2; ++ai)
#pragma unroll
                for (int m = 0; m < 4; ++m) { const int row = row0 + ai * HALF + m * 16; const float r = rs[ai][m]; const float sc = reg == 0 ? r * C2 : r;
#pragma unroll
                    for (int bj = 0; bj < 2; ++bj) { f32x4 v0 = acc[ai][bj][m][0] * sc, v1 = acc[ai][bj][m][1] * sc;
                        if (reg == 3) {
#pragma unroll
                            for (int j = 0; j < 4; ++j) { v0[j] = silu_fast(v0[j]); v1[j] = silu_fast(v1[j]); } }
                        if (reg == 1) { float ss = ((v0[0] * v0[0] + v0[1] * v0[1]) + (v0[2] * v0[2] + v0[3] * v0[3])) + ((v1[0] * v1[0] + v1[1] * v1[1]) + (v1[2] * v1[2] + v1[3] * v1[3]));
                            ss += __shfl_xor(ss, 16); ss += __shfl_xor(ss, 32); kmx[bj] = fmaxf(kmx[bj], ss); }
                        __builtin_nontemporal_store(pack8(v0, v1), (u32x4*)(base + hm_off(row, col0 + bj * HALF, NH))); } }
            if (reg == 1) {
#pragma unroll
                for (int bj = 0; bj < 2; ++bj) { float mx = kmx[bj];
#pragma unroll
                    for (int o = 1; o < 16; o <<= 1) mx = fmaxf(mx, __shfl_xor(mx, o));
                    if (fr == 0 && fq == 0) atomicMax(KMAX + ((row0 >> 12) * NH + (pn & 7) * 4 + bj * 2 + (wc >> 1)) * 2 + (wc & 1), __float_as_uint(mx)); } }
        }
    }
};
struct EpiSwaIn {
    static constexpr bool PERM = true, AFTER_DRAIN = false;
    bf16_t *Q, *K, *V, *G; const float* SS; const float* ROPE;
    __device__ __forceinline__ void operator()(const f32x4 (&acc)[2][2][4][2], const Unit& u, int wr, int wc, int fr, int fq) const {
        const int row0 = u.pm * BM + wr * 64 + fr, pn = u.pn;
        bf16_t* base; int pitch, colt; float osc = 1.f; const bool rope = pn <= 8, gate = pn >= 10;
        if (pn < 8) { base = Q; pitch = DM; colt = pn * BM; osc = C2; } else if (pn == 8) { base = K; pitch = KVW; colt = 0; } else if (pn == 9) { base = V; pitch = KVW; colt = 0; } else { base = G; pitch = DM; colt = (pn - 10) * BM; }
        const int col0 = colt + wc * 32 + 8 * fq; const bool rotw = rope && ((wc & 1) == 0); const float sgn = fq == 0 ? -1.f : 1.f; const bool rotl = fq < 2;
        float rs[2][4];
#pragma unroll
        for (int ai = 0; ai < 2; ++ai)
#pragma unroll
            for (int m = 0; m < 4; ++m) rs[ai][m] = SS[row0 + ai * HALF + m * 16];
        f32x4 nc0, nc1, ns0, ns1;
        if (rotw) { const float* rp = ROPE + (size_t)(row0 & 4095) * 16; nc0 = *(const f32x4*)rp; nc1 = *(const f32x4*)(rp + 4); ns0 = *(const f32x4*)(rp + 8); ns1 = *(const f32x4*)(rp + 12); }
#pragma unroll
        for (int ai = 0; ai < 2; ++ai)
#pragma unroll
            for (int m = 0; m < 4; ++m) { const int row = row0 + ai * HALF + m * 16; const float r = 1.0f / sqrtf(rs[ai][m] * (1.f / DM) + RMS_EPS);
                const f32x4 c0 = nc0, c1 = nc1, s0 = ns0, s1 = ns1;
                if (rotw && (ai * 4 + m) < 7) { const int nrow = row0 + ((ai * 4 + m + 1) >> 2) * HALF + ((ai * 4 + m + 1) & 3) * 16; const float* rp = ROPE + (size_t)(nrow & 4095) * 16; nc0 = *(const f32x4*)rp; nc1 = *(const f32x4*)(rp + 4); ns0 = *(const f32x4*)(rp + 8); ns1 = *(const f32x4*)(rp + 12); }
#pragma unroll
                for (int bj = 0; bj < 2; ++bj) { f32x4 v0 = acc[ai][bj][m][0] * r, v1 = acc[ai][bj][m][1] * r;
                    if (rotw) {
#pragma unroll
                        for (int j = 0; j < 4; ++j) { const float p0 = __shfl_xor(v0[j], 16), p1 = __shfl_xor(v1[j], 16);
                            const float n0 = v0[j] * c0[j] + sgn * p0 * s0[j], n1 = v1[j] * c1[j] + sgn * p1 * s1[j];
                            v0[j] = rotl ? n0 : v0[j]; v1[j] = rotl ? n1 : v1[j]; } }
                    if (gate) {
#pragma unroll
                        for (int j = 0; j < 4; ++j) { v0[j] = silu_fast(v0[j]); v1[j] = silu_fast(v1[j]); } }
                    v0 = v0 * osc; v1 = v1 * osc;
                    *(u32x4*)(base + hm_off(row, col0 + bj * HALF, pitch >> 6)) = pack8(v0, v1); } }
    }
};
template <bool FIRST> struct EpiRes {
    static constexpr bool PERM = true, AFTER_DRAIN = false;
    const float* xin; bf16_t* XB; float* SS;
    __device__ __forceinline__ void operator()(const f32x4 (&acc)[2][2][4][2], const Unit& u, int wr, int wc, int fr, int fq) const {
        const int row0 = u.pm * BM + wr * 64 + fr, col0 = u.pn * BM + wc * 32 + 8 * fq;
        if (FIRST) {
            f32x4 nx[2][2];
#pragma unroll
            for (int bj = 0; bj < 2; ++bj)
#pragma unroll
                for (int n = 0; n < 2; ++n) nx[bj][n] = *(const f32x4*)(xin + (size_t)row0 * DM + col0 + bj * HALF + n * 4);
#pragma unroll
            for (int ai = 0; ai < 2; ++ai)
#pragma unroll
                for (int m = 0; m < 4; ++m) { const int row = row0 + ai * HALF + m * 16; float ss = 0.f;
                    f32x4 cx[2][2];
#pragma unroll
                    for (int bj = 0; bj < 2; ++bj)
#pragma unroll
                        for (int n = 0; n < 2; ++n) cx[bj][n] = nx[bj][n];
                    if ((ai * 4 + m) < 7) { const int nrow = row0 + ((ai * 4 + m + 1) >> 2) * HALF + ((ai * 4 + m + 1) & 3) * 16;
#pragma unroll
                        for (int bj = 0; bj < 2; ++bj)
#pragma unroll
                            for (int n = 0; n < 2; ++n) nx[bj][n] = *(const f32x4*)(xin + (size_t)nrow * DM + col0 + bj * HALF + n * 4); }
#pragma unroll
                    for (int bj = 0; bj < 2; ++bj) { const f32x4 x0 = cx[bj][0] + acc[ai][bj][m][0], x1 = cx[bj][1] + acc[ai][bj][m][1];
                        *(u32x4*)(XB + tiled_off(row, col0 + bj * HALF)) = pack8(x0, x1);
                        ss += ((x0[0] * x0[0] + x0[1] * x0[1]) + (x0[2] * x0[2] + x0[3] * x0[3])) + ((x1[0] * x1[0] + x1[1] * x1[1]) + (x1[2] * x1[2] + x1[3] * x1[3])); }
                    ss += __shfl_xor(ss, 16); ss += __shfl_xor(ss, 32); if (fq == 0) atomicAdd(SS + row, ss); }
        } else {
            u32x4 xv[2][4][2];
#pragma unroll
            for (int ai = 0; ai < 2; ++ai)
#pragma unroll
                for (int m = 0; m < 4; ++m)
#pragma unroll
                    for (int bj = 0; bj < 2; ++bj) xv[ai][m][bj] = *(const u32x4*)(XB + tiled_off(row0 + ai * HALF + m * 16, col0 + bj * HALF));
#pragma unroll
            for (int ai = 0; ai < 2; ++ai)
#pragma unroll
                for (int m = 0; m < 4; ++m)
#pragma unroll
                    for (int bj = 0; bj < 2; ++bj) { const u32x4 xw = xv[ai][m][bj]; const f32x4 a0 = acc[ai][bj][m][0], a1 = acc[ai][bj][m][1];
                        const f32x4 y0 = {__uint_as_float(xw.x << 16) + a0[0], __uint_as_float(xw.x & 0xffff0000u) + a0[1], __uint_as_float(xw.y << 16) + a0[2], __uint_as_float(xw.y & 0xffff0000u) + a0[3]};
                        const f32x4 y1 = {__uint_as_float(xw.z << 16) + a1[0], __uint_as_float(xw.z & 0xffff0000u) + a1[1], __uint_as_float(xw.w << 16) + a1[2], __uint_as_float(xw.w & 0xffff0000u) + a1[3]};
                        *(u32x4*)(XB + tiled_off(row0 + ai * HALF + m * 16, col0 + bj * HALF)) = pack8(y0, y1); }
        }
    }
};
template <class Epi, class Sched, bool ALIGN_EPI = false, bool SP2 = false>
__device__ __forceinline__ void gemm_phase(PG8_LAS unsigned char* lds, const Gemm g, const Sched& S, const Epi& E) {
    const int tid = threadIdx.x, wid = __builtin_amdgcn_readfirstlane(tid >> 6), lane = tid & 63, wr = wid >> 2, wc = wid & 3, fr = lane & 15, fq = lane >> 4;
    const int K = g.K, nt = K / BK;
    unsigned voffA[2], voffB[2];
#pragma unroll
    for (int i = 0; i < 2; ++i) { int R, C; stage_rc(tid * 16 + i * 8192, R, C); const int Rb = Epi::PERM ? ((R & ~31) + perm32(R & 31)) : R;
        voffA[i] = (unsigned)((C >> 5) * (BM * 32) + R * 32 + (C & 31)) * 2u; voffB[i] = (unsigned)((C >> 5) * (BM * 32) + Rb * 32 + (C & 31)) * 2u; }
    const size_t kstep = (size_t)(BM * BK * 2);
    const size_t hstep = (size_t)(HALF * 32 * 2);
    const size_t tstep = (size_t)BM * K * 2;
    const unsigned ldsw = (unsigned)wid * 1024u;
    const int aoff = lds_byte(wr * 64 + fr, fq * 8), boff = lds_byte(wc * 32 + fr, fq * 8);
#define PG8_SA(b, h) (((b) * 2 + (h)) * HTB)
#define PG8_SB(b, h) ((4 + (b) * 2 + (h)) * HTB)
#define PG8_STAGE(bufoff, gbase, voff) do { _Pragma("unroll") for (int _i = 0; _i < 2; ++_i) \
        __builtin_amdgcn_global_load_lds((const unsigned*)((const char*)(gbase) + (voff)[_i]), (PG8_LAS unsigned*)(lds + (bufoff) + ldsw + _i * 8192), 16, 0, 0); } while (0)
#define PG8_LDA(dst, b, h) do { _Pragma("unroll") for (int m = 0; m < 4; ++m) _Pragma("unroll") for (int k = 0; k < 2; ++k) dst[m][k] = *(const PG8_LAS bf16x8*)(lds + PG8_SA(b, h) + aoff + m * 2048 + k * 1024); } while (0)
#define PG8_LDB(dst, b, h) do { _Pragma("unroll") for (int n = 0; n < 2; ++n) _Pragma("unroll") for (int k = 0; k < 2; ++k) dst[n][k] = *(const PG8_LAS bf16x8*)(lds + PG8_SB(b, h) + boff + n * 2048 + k * 1024); } while (0)
#define PG8_MMA(ai, bj, At, Bt) do { __builtin_amdgcn_s_setprio(1); _Pragma("unroll") for (int m = 0; m < 4; ++m) _Pragma("unroll") for (int n = 0; n < 2; ++n) _Pragma("unroll") for (int k = 0; k < 2; ++k) \
        acc[ai][bj][m][n] = __builtin_amdgcn_mfma_f32_16x16x32_bf16(Bt[n][k], At[m][k], acc[ai][bj][m][n], 0, 0, 0); __builtin_amdgcn_s_setprio(0); } while (0)
#define PG8_WAIT_V(n) asm volatile("s_waitcnt vmcnt(" #n ")" ::: "memory")
#define PG8_WAIT_L(n) asm volatile("s_waitcnt lgkmcnt(" #n ")" ::: "memory")
#define PG8_BAR __builtin_amdgcn_s_barrier()
#define PG8_SCHED __builtin_amdgcn_sched_barrier(0)
    Unit cur, nxt; int ui = 0;
    if (!S.next(0, cur)) return;
    f32x4 acc[2][2][4][2];
#pragma unroll
    for (int a = 0; a < 2; ++a)
#pragma unroll
        for (int b = 0; b < 2; ++b)
#pragma unroll
            for (int m = 0; m < 4; ++m)
#pragma unroll
                for (int n = 0; n < 2; ++n) acc[a][b][m][n] = (f32x4){0.f, 0.f, 0.f, 0.f};
    bf16x8 At[4][2], B0[2][2], B1[2][2];
    const char* cA = (const char*)g.A + (size_t)cur.lm * tstep; const char* cB = (const char*)g.Bt + (size_t)cur.ln * tstep;
    S.a_ready(cur);
    if constexpr (SP2) {
        PG8_STAGE(PG8_SB(0, 0), cB, voffB); PG8_STAGE(PG8_SB(0, 1), cB + hstep, voffB); PG8_STAGE(PG8_SA(0, 0), cA, voffA); PG8_STAGE(PG8_SA(0, 1), cA + hstep, voffA);
        if (wr == 1) PG8_BAR;
        PG8_WAIT_V(2); PG8_BAR;
        PG8_STAGE(PG8_SB(1, 0), cB + kstep, voffB); PG8_STAGE(PG8_SA(1, 0), cA + kstep, voffA); PG8_STAGE(PG8_SB(1, 1), cB + hstep + kstep, voffB);
        PG8_WAIT_V(6); PG8_BAR;
    } else {
        PG8_STAGE(PG8_SB(0, 0), cB, voffB); PG8_STAGE(PG8_SA(0, 0), cA, voffA); PG8_STAGE(PG8_SB(0, 1), cB + hstep, voffB); PG8_STAGE(PG8_SA(0, 1), cA + hstep, voffA);
        if (wr == 1) PG8_BAR;
        PG8_WAIT_V(4); PG8_BAR;
        PG8_STAGE(PG8_SB(1, 0), cB + kstep, voffB); PG8_STAGE(PG8_SA(1, 0), cA + kstep, voffA); PG8_STAGE(PG8_SB(1, 1), cB + hstep + kstep, voffB);
        PG8_WAIT_V(6); PG8_BAR;
    }
    for (;;) {
        const bool has_next = S.next(ui + 1, nxt);
        const char* nA = has_next ? (const char*)g.A + (size_t)nxt.lm * tstep : cA; const char* nB = has_next ? (const char*)g.Bt + (size_t)nxt.ln * tstep : cB;
        for (int t = 0; t < nt; t += 2) {
            const bool last = (t == nt - 2);
            const char* a1 = cA + (size_t)(t + 1) * kstep;
            const char* a2 = last ? nA : cA + (size_t)(t + 2) * kstep; const char* b2 = last ? nB : cB + (size_t)(t + 2) * kstep;
            const char* a3 = a2 + kstep; const char* b3 = b2 + kstep;
            if (last && has_next) S.a_ready(nxt);
            if constexpr (SP2) {
            PG8_LDB(B0, 0, 0); PG8_LDB(B1, 0, 1); PG8_SCHED; PG8_LDA(At, 0, 0); PG8_STAGE(PG8_SA(1, 1), a1 + hstep, voffA);
            PG8_WAIT_V(8); PG8_WAIT_L(0); PG8_BAR; PG8_MMA(0, 0, At, B0); PG8_MMA(0, 1, At, B1); PG8_BAR; PG8_SCHED;
            PG8_LDA(At, 0, 1); PG8_STAGE(PG8_SB(0, 0), b2, voffB); PG8_STAGE(PG8_SB(0, 1), b2 + hstep, voffB); PG8_STAGE(PG8_SA(0, 0), a2, voffA);
            PG8_WAIT_V(8); PG8_WAIT_L(0); PG8_BAR; PG8_MMA(1, 0, At, B0); PG8_MMA(1, 1, At, B1); PG8_BAR; PG8_SCHED;
            PG8_LDB(B0, 1, 0); PG8_LDB(B1, 1, 1); PG8_SCHED; PG8_LDA(At, 1, 0); PG8_STAGE(PG8_SA(0, 1), a2 + hstep, voffA);
            PG8_WAIT_V(8); PG8_WAIT_L(0); PG8_BAR; PG8_MMA(0, 0, At, B0); PG8_MMA(0, 1, At, B1); PG8_BAR; PG8_SCHED;
            PG8_LDA(At, 1, 1); PG8_STAGE(PG8_SB(1, 0), b3, voffB); PG8_STAGE(PG8_SB(1, 1), b3 + hstep, voffB); PG8_STAGE(PG8_SA(1, 0), a3, voffA);
            PG8_WAIT_V(8); PG8_WAIT_L(0); PG8_BAR; PG8_MMA(1, 0, At, B0); PG8_MMA(1, 1, At, B1); PG8_BAR; PG8_SCHED;
            } else {
            PG8_LDB(B0, 0, 0); PG8_SCHED; PG8_LDA(At, 0, 0); PG8_STAGE(PG8_SA(1, 1), a1 + hstep, voffA);
            PG8_WAIT_L(8); PG8_BAR; PG8_WAIT_L(0); PG8_MMA(0, 0, At, B0); PG8_BAR; PG8_SCHED;
            PG8_LDB(B1, 0, 1); PG8_STAGE(PG8_SB(0, 0), b2, voffB);
            PG8_BAR; PG8_WAIT_L(0); PG8_MMA(0, 1, At, B1); PG8_BAR;
            PG8_LDA(At, 0, 1); PG8_STAGE(PG8_SA(0, 0), a2, voffA);
            PG8_BAR; PG8_WAIT_L(0); PG8_MMA(1, 0, At, B0); PG8_BAR; PG8_SCHED;
            PG8_STAGE(PG8_SB(0, 1), b2 + hstep, voffB);
            PG8_WAIT_V(6); PG8_BAR; PG8_MMA(1, 1, At, B1); PG8_BAR;
            PG8_LDB(B0, 1, 0); PG8_SCHED; PG8_LDA(At, 1, 0); PG8_STAGE(PG8_SA(0, 1), a2 + hstep, voffA);
            PG8_WAIT_L(8); PG8_BAR; PG8_WAIT_L(0); PG8_MMA(0, 0, At, B0); PG8_BAR; PG8_SCHED;
            PG8_LDB(B1, 1, 1); PG8_STAGE(PG8_SB(1, 0), b3, voffB);
            PG8_BAR; PG8_WAIT_L(0); PG8_MMA(0, 1, At, B1); PG8_BAR;
            PG8_LDA(At, 1, 1); PG8_STAGE(PG8_SA(1, 0), a3, voffA);
            PG8_BAR; PG8_WAIT_L(0); PG8_MMA(1, 0, At, B0); PG8_BAR; PG8_SCHED;
            PG8_STAGE(PG8_SB(1, 1), b3 + hstep, voffB);
            PG8_WAIT_V(6); PG8_BAR; PG8_MMA(1, 1, At, B1); PG8_BAR;
            }
        }
        if constexpr (ALIGN_EPI) { if (wr == 0) PG8_BAR; }
        if constexpr (!Epi::AFTER_DRAIN) { E(acc, cur, wr, wc, fr, fq); if (S.epi2) E(acc, cur, wr, wc, fr, fq); S.done(cur); }
        if (!has_next) break;
#pragma unroll
        for (int a = 0; a < 2; ++a)
#pragma unroll
            for (int b = 0; b < 2; ++b)
#pragma unroll
                for (int m = 0; m < 4; ++m)
#pragma unroll
                    for (int n = 0; n < 2; ++n) acc[a][b][m][n] = (f32x4){0.f, 0.f, 0.f, 0.f};
        cur = nxt; cA = nA; cB = nB; ++ui;
        if constexpr (ALIGN_EPI) { if (wr == 1) PG8_BAR; }
    }
    PG8_WAIT_V(0);
    if constexpr (!ALIGN_EPI) { if (wr == 0) PG8_BAR; }
    PG8_BAR;
    if constexpr (Epi::AFTER_DRAIN) { E.fused(acc, cur, wr, wc, fr, fq, lds, wid, lane); S.done(cur); }
#undef PG8_SA
#undef PG8_SB
#undef PG8_STAGE
#undef PG8_LDA
#undef PG8_LDB
#undef PG8_MMA
#undef PG8_WAIT_V
#undef PG8_WAIT_L
#undef PG8_BAR
#undef PG8_SCHED
}
}
namespace fa {
#define FA_LAS __attribute__((address_space(3)))
typedef short bf16x8 __attribute__((ext_vector_type(8)));
typedef short s16x4 __attribute__((ext_vector_type(4)));
typedef short v4i16_t __attribute__((ext_vector_type(4)));
typedef float f32x16 __attribute__((ext_vector_type(16)));
typedef float f32x4 __attribute__((ext_vector_type(4)));
typedef unsigned u32x4 __attribute__((ext_vector_type(4)));
typedef float f32x2_t __attribute__((ext_vector_type(2))); typedef __bf16 bf16x2_t __attribute__((ext_vector_type(2)));
constexpr float THR = 8.f, TH_SKIP = 32.f;
constexpr int F_KBUF = 18432, F_AOFF = 8192, F_VOFF = 10240, F_WSF = 3 * F_KBUF, F_FLAG = F_WSF + 8 * 256, F_OST = F_FLAG + 256, F_LDS_BYTES = F_OST + 8 * 4096;
constexpr int S_KBUF = 16384, S_VOFF = 8192, S_WSF = 6 * S_KBUF, S_OST = S_WSF + 8 * 256, S_LDS_BYTES = S_OST + 8 * 4096;
struct Params { const bf16_t* Q; const bf16_t* K; const bf16_t* V; const bf16_t* G; bf16_t* O; const float* CUM; const float* sinks; const unsigned* KMAX; unsigned* ticket; const bf16_t* KAUG; };
__device__ __forceinline__ unsigned cvtpk(float lo, float hi) { f32x2_t v = {lo, hi}; bf16x2_t b = __builtin_convertvector(v, bf16x2_t); return __builtin_bit_cast(unsigned, b); }
__device__ __forceinline__ s16x4 vtr(FA_LAS unsigned char* p) { return __builtin_bit_cast(s16x4, __builtin_amdgcn_ds_read_tr16_b64_v4i16((FA_LAS v4i16_t*)p)); }
__device__ __forceinline__ float swap_max(float v) { auto rr = __builtin_amdgcn_permlane32_swap(__float_as_uint(v), __float_as_uint(v), false, false); return __builtin_fmaxf(__uint_as_float(rr[0]), __uint_as_float(rr[1])); }
__device__ __forceinline__ float swap_add(float v) { auto rr = __builtin_amdgcn_permlane32_swap(__float_as_uint(v), __float_as_uint(v), false, false); return __uint_as_float(rr[0]) + __uint_as_float(rr[1]); }
__device__ __forceinline__ void glds16(const void* gsrc, unsigned lds_dst) { unsigned keep;
    asm volatile("s_mov_b32 %0, m0\n\ts_mov_b32 m0, %2\n\ts_nop 0\n\tglobal_load_lds_dwordx4 %1, off\n\ts_mov_b32 m0, %0" : "=&s"(keep) : "v"(gsrc), "s"(lds_dst) : "memory"); }
#define FA_MFMA(a, b, c) __builtin_amdgcn_mfma_f32_32x32x16_bf16((a), (b), (c), 0, 0, 0)
#define FA_MX3(a, b, c) __builtin_fmaxf(__builtin_fmaxf((a), (b)), (c))
struct WaveSt { bf16x8 qr[4]; bf16x8 qa; f32x16 o0, o1; float cq, mhat, lsum, mrun; };

#define FA_SBAR() __builtin_amdgcn_sched_barrier(0)
#define FA_PIN(x) asm volatile("" : "+v"(x))
#define FA_LDK(p) (*(FA_LAS bf16x8*)(p))
#define FA_VF(l, h) ((bf16x8){l[0], l[1], l[2], l[3], h[0], h[1], h[2], h[3]})
#define FA_EX4(X, B) do { X[B] = __builtin_amdgcn_exp2f(X[B]); X[B + 1] = __builtin_amdgcn_exp2f(X[B + 1]); X[B + 2] = __builtin_amdgcn_exp2f(X[B + 2]); X[B + 3] = __builtin_amdgcn_exp2f(X[B + 3]); } while (0)
__device__ __forceinline__ void split3(float v, unsigned& h1, unsigned& h2, unsigned& h3) { const bf16_t a = f2bf(v); const float r1 = v - bf2f(a); const bf16_t b = f2bf(r1); const float r2 = r1 - bf2f(b); h1 = a; h2 = b; h3 = f2bf(r2); }
__device__ __forceinline__ void set_qa(WaveSt& w, int hi) {
    unsigned g1, g2, g3; split3(w.cq - w.mhat, g1, g2, g3);
    const u32x4 q = {hi == 0 ? 0x3F803F80u : 0u, hi == 0 ? (0x3F80u | (g1 << 16)) : 0u, hi == 0 ? (g2 | (g3 << 16)) : 0u, 0u};
    w.qa = __builtin_bit_cast(bf16x8, q);
}
template <int MODE, int AOFF, int VOFF>
__device__ __forceinline__ void tile_full(FA_LAS unsigned char* bb, FA_LAS unsigned char* vprev, FA_LAS float* wsf, WaveSt& w, f32x16& C0, f32x16& C1, f32x16& P0, f32x16& P1,
                                          int k0, int t, int qlo, int lane, int r32, int hi) {
    constexpr int W = MODE == 0 ? 0x40000000 : 128;
    FA_LAS unsigned char* kp = bb + hi * 1024 + r32 * 16; FA_LAS unsigned char* ap = bb + AOFF + r32 * 16;
    FA_LAS unsigned char* vp = vprev + VOFF + ((lane >> 4) & 1) * 32 + (lane & 3) * 8 + (4 * hi + ((lane & 15) >> 2)) * 64;
    bf16x8 kf0 = FA_LDK(kp), kf1 = FA_LDK(kp + 512), kf2 = FA_LDK(kp + 2048), kf3 = FA_LDK(kp + 2560), kf4, kf5, kf6, kf7, ka0, ka1;
    s16x4 vl0, vh0, vl1, vh1, vl2, vh2, vl3, vh3, vl4, vh4, vl5, vh5, vl6, vh6, vl7, vh7;
    u32x4 pw0, pw1, pw2, pw3; float sacc;
    const f32x16 Z = {0.f, 0.f, 0.f, 0.f, 0.f, 0.f, 0.f, 0.f, 0.f, 0.f, 0.f, 0.f, 0.f, 0.f, 0.f, 0.f};
    FA_SBAR();
    C0 = FA_MFMA(kf0, w.qr[0], Z); kf4 = FA_LDK(kp + 4096);
    sacc = (P0[0] + P0[1]) + (P0[2] + P0[3]); pw0.x = cvtpk(P0[0], P0[1]); pw0.y = cvtpk(P0[2], P0[3]); FA_PIN(sacc); FA_PIN(pw0.x); FA_PIN(pw0.y);
    FA_SBAR();
    C1 = FA_MFMA(kf1, w.qr[0], Z); kf5 = FA_LDK(kp + 4608);
    sacc += P0[4]; sacc += P0[5]; sacc += P0[6]; sacc += P0[7]; pw0.z = cvtpk(P0[4], P0[5]); pw0.w = cvtpk(P0[6], P0[7]); FA_PIN(sacc); FA_PIN(pw0.z); FA_PIN(pw0.w);
    FA_SBAR();
    C0 = FA_MFMA(kf2, w.qr[1], C0); kf6 = FA_LDK(kp + 6144);
    sacc += P0[8]; sacc += P0[9]; sacc += P0[10]; sacc += P0[11]; pw1.x = cvtpk(P0[8], P0[9]); pw1.y = cvtpk(P0[10], P0[11]); FA_PIN(sacc); FA_PIN(pw1.x); FA_PIN(pw1.y);
    FA_SBAR();
    C1 = FA_MFMA(kf3, w.qr[1], C1); kf7 = FA_LDK(kp + 6656);
    sacc += P0[12]; sacc += P0[13]; sacc += P0[14]; sacc += P0[15]; pw1.z = cvtpk(P0[12], P0[13]); pw1.w = cvtpk(P0[14], P0[15]); FA_PIN(sacc); FA_PIN(pw1.z); FA_PIN(pw1.w);
    FA_SBAR();
    C0 = FA_MFMA(kf4, w.qr[2], C0); if (MODE == 0) { ka0 = FA_LDK(ap); ka1 = FA_LDK(ap + 512); } else { const u32x4 kc = {0u, 0x3F800000u, 0x3F803F80u, 0u}; ka0 = __builtin_bit_cast(bf16x8, kc); ka1 = ka0; }
    sacc += P1[0]; sacc += P1[1]; sacc += P1[2]; sacc += P1[3]; pw2.x = cvtpk(P1[0], P1[1]); pw2.y = cvtpk(P1[2], P1[3]); FA_PIN(sacc); FA_PIN(pw2.x); FA_PIN(pw2.y);
    FA_SBAR();
    C1 = FA_MFMA(kf5, w.qr[2], C1); vl0 = vtr(vp); vh0 = vtr(vp + 512);
    sacc += P1[4]; sacc += P1[5]; sacc += P1[6]; sacc += P1[7]; pw2.z = cvtpk(P1[4], P1[5]); pw2.w = cvtpk(P1[6], P1[7]); FA_PIN(sacc); FA_PIN(pw2.z); FA_PIN(pw2.w);
    FA_SBAR();
    C0 = FA_MFMA(kf6, w.qr[3], C0); vl4 = vtr(vp + 4096); vh4 = vtr(vp + 4096 + 512);
    sacc += P1[8]; sacc += P1[9]; sacc += P1[10]; sacc += P1[11]; pw3.x = cvtpk(P1[8], P1[9]); pw3.y = cvtpk(P1[10], P1[11]); FA_PIN(sacc); FA_PIN(pw3.x); FA_PIN(pw3.y);
    FA_SBAR();
    C1 = FA_MFMA(kf7, w.qr[3], C1); vl1 = vtr(vp + 1024); vh1 = vtr(vp + 1024 + 512);
    sacc += P1[12]; sacc += P1[13]; sacc += P1[14]; sacc += P1[15]; pw3.z = cvtpk(P1[12], P1[13]); pw3.w = cvtpk(P1[14], P1[15]); FA_PIN(sacc); FA_PIN(pw3.z); FA_PIN(pw3.w);
    FA_SBAR();
    C0 = FA_MFMA(ka0, w.qa, C0); vl5 = vtr(vp + 4096 + 1024); vh5 = vtr(vp + 4096 + 1024 + 512); FA_SBAR();
    C1 = FA_MFMA(ka1, w.qa, C1); FA_SBAR();
    w.lsum += sacc;
    const bf16x8 pa0 = __builtin_bit_cast(bf16x8, pw0), pa1 = __builtin_bit_cast(bf16x8, pw1), pa2 = __builtin_bit_cast(bf16x8, pw2), pa3 = __builtin_bit_cast(bf16x8, pw3);
    vl2 = vtr(vp + 2048); vh2 = vtr(vp + 2048 + 512);
    w.o0 = FA_MFMA(pa0, FA_VF(vl0, vh0), w.o0); vl6 = vtr(vp + 4096 + 2048); vh6 = vtr(vp + 4096 + 2048 + 512);
    w.o1 = FA_MFMA(pa0, FA_VF(vl4, vh4), w.o1);
    FA_SBAR();
    if ((k0 + 63 > qlo) || (MODE == 1 && k0 <= qlo + 31 - W)) {
        const float NEG = -__builtin_inff(); const int dq = t - k0 - 4 * hi;
#pragma unroll
        for (int r = 0; r < 16; ++r) { const int c = (r & 3) + 8 * (r >> 2); if ((unsigned)(dq - c) >= (unsigned)W) C0[r] = NEG; if ((unsigned)(dq - c - 32) >= (unsigned)W) C1[r] = NEG; }
    }
    float ma = FA_MX3(C0[0], C0[1], C1[0]), mb = FA_MX3(C0[2], C0[3], C1[1]); ma = FA_MX3(ma, C1[2], C1[3]);
#pragma unroll
    for (int r = 4; r < 16; r += 4) { ma = FA_MX3(ma, C0[r], C0[r + 1]); mb = FA_MX3(mb, C0[r + 2], C0[r + 3]); ma = FA_MX3(ma, C1[r], C1[r + 1]); mb = FA_MX3(mb, C1[r + 2], C1[r + 3]); }
    const float rm = swap_max(__builtin_fmaxf(ma, mb));
    if (MODE == 0) w.mrun = __builtin_fmaxf(w.mrun, rm + w.mhat);
    const bool resc = __any(rm > THR);
    if (resc) {
        const float dl = __builtin_fmaxf(rm, 0.f); w.mhat += dl;
#pragma unroll
        for (int r = 0; r < 16; ++r) { C0[r] -= dl; C1[r] -= dl; }
        set_qa(w, hi);
        const float f = __builtin_amdgcn_exp2f(-dl); w.lsum *= f;
        if (hi == 0) wsf[r32] = f;
    }
    FA_SBAR();
    FA_EX4(C0, 0); FA_PIN(C0); vl3 = vtr(vp + 3072); vh3 = vtr(vp + 3072 + 512);
    w.o0 = FA_MFMA(pa1, FA_VF(vl1, vh1), w.o0); FA_EX4(C0, 4); FA_EX4(C0, 8); FA_PIN(C0); vl7 = vtr(vp + 4096 + 3072); vh7 = vtr(vp + 4096 + 3072 + 512); FA_SBAR();
    w.o1 = FA_MFMA(pa1, FA_VF(vl5, vh5), w.o1); FA_EX4(C0, 12); FA_PIN(C0); FA_EX4(C1, 0); FA_PIN(C1); FA_SBAR();
    w.o0 = FA_MFMA(pa2, FA_VF(vl2, vh2), w.o0); FA_EX4(C1, 4); FA_PIN(C1); FA_SBAR();
    w.o1 = FA_MFMA(pa2, FA_VF(vl6, vh6), w.o1); FA_EX4(C1, 8); FA_PIN(C1); FA_SBAR();
    w.o0 = FA_MFMA(pa3, FA_VF(vl3, vh3), w.o0); FA_EX4(C1, 12); FA_PIN(C1); FA_SBAR();
    w.o1 = FA_MFMA(pa3, FA_VF(vl7, vh7), w.o1); FA_SBAR();
    if (resc) {
        asm volatile("s_waitcnt lgkmcnt(0)" ::: "memory");
#pragma unroll
        for (int g = 0; g < 4; ++g) { const f32x4 a4 = *(FA_LAS f32x4*)(wsf + 8 * g + 4 * hi);
#pragma unroll
            for (int i = 0; i < 4; ++i) { w.o0[4 * g + i] *= a4[i]; w.o1[4 * g + i] *= a4[i]; } }
    }
}
template <int VOFF>
__device__ __forceinline__ void drain_full(FA_LAS unsigned char* vlast, WaveSt& w, f32x16& P0, f32x16& P1, int lane, int hi) {
    FA_LAS unsigned char* vp = vlast + VOFF + ((lane >> 4) & 1) * 32 + (lane & 3) * 8 + (4 * hi + ((lane & 15) >> 2)) * 64;
    float s0 = 0.f, s1 = 0.f;
#pragma unroll
    for (int r = 0; r < 16; ++r) { s0 += P0[r]; s1 += P1[r]; }
    w.lsum += s0 + s1;
    const u32x4 w0 = {cvtpk(P0[0], P0[1]), cvtpk(P0[2], P0[3]), cvtpk(P0[4], P0[5]), cvtpk(P0[6], P0[7])};
    const u32x4 w1 = {cvtpk(P0[8], P0[9]), cvtpk(P0[10], P0[11]), cvtpk(P0[12], P0[13]), cvtpk(P0[14], P0[15])};
    const u32x4 w2 = {cvtpk(P1[0], P1[1]), cvtpk(P1[2], P1[3]), cvtpk(P1[4], P1[5]), cvtpk(P1[6], P1[7])};
    const u32x4 w3 = {cvtpk(P1[8], P1[9]), cvtpk(P1[10], P1[11]), cvtpk(P1[12], P1[13]), cvtpk(P1[14], P1[15])};
    const bf16x8 pa0 = __builtin_bit_cast(bf16x8, w0), pa1 = __builtin_bit_cast(bf16x8, w1), pa2 = __builtin_bit_cast(bf16x8, w2), pa3 = __builtin_bit_cast(bf16x8, w3);
#define FA_PV(ks, pa) do { const s16x4 l0_ = vtr(vp + (ks) * 1024), h0_ = vtr(vp + (ks) * 1024 + 512), l1_ = vtr(vp + 4096 + (ks) * 1024), h1_ = vtr(vp + 4096 + (ks) * 1024 + 512); \
    w.o0 = FA_MFMA(pa, FA_VF(l0_, h0_), w.o0); w.o1 = FA_MFMA(pa, FA_VF(l1_, h1_), w.o1); } while (0)
    FA_PV(0, pa0); FA_PV(1, pa1); FA_PV(2, pa2); FA_PV(3, pa3);
#undef FA_PV
}
__device__ __forceinline__ void load_gate(u32x4 (&gq)[4], const bf16_t* G, size_t grow, int h, int lane) {
#pragma unroll
    for (int d0 = 0; d0 < 2; ++d0)
#pragma unroll
        for (int i = 0; i < 2; ++i) gq[2 * d0 + i] = *(const u32x4*)(G + hm_off((int)grow + i * 16 + (lane >> 2), h * 64 + d0 * 32 + (lane & 3) * 8, NH));
}
__device__ __forceinline__ void wave_epilogue(FA_LAS float* stg, FA_LAS float* wsf, WaveSt& w, const u32x4 (&gq)[4], bf16_t* O, size_t grow, int h, int lane, int r32, int hi) {
    const float l = swap_add(w.lsum);
    if (hi == 0) wsf[r32] = l;
    asm volatile("s_waitcnt lgkmcnt(0)" ::: "memory");
    float rl[16];
#pragma unroll
    for (int g = 0; g < 4; ++g) { const f32x4 l4 = *(FA_LAS f32x4*)(wsf + 8 * g + 4 * hi);
#pragma unroll
        for (int i = 0; i < 4; ++i) rl[4 * g + i] = 1.0f / l4[i]; }
#pragma unroll
    for (int d0 = 0; d0 < 2; ++d0) {
#pragma unroll
        for (int g = 0; g < 4; ++g)
#pragma unroll
            for (int i = 0; i < 4; ++i) stg[(8 * g + 4 * hi + i) * 32 + r32] = (d0 == 0 ? w.o0[4 * g + i] : w.o1[4 * g + i]) * rl[4 * g + i];
        asm volatile("s_waitcnt lgkmcnt(0)" ::: "memory");
#pragma unroll
        for (int i = 0; i < 2; ++i) { const int row = i * 16 + (lane >> 2), ch = lane & 3;
            const f32x4 x0 = *(FA_LAS f32x4*)(stg + row * 32 + ch * 8), x1 = *(FA_LAS f32x4*)(stg + row * 32 + ch * 8 + 4);
            const size_t ga = (grow + row) * DM + h * 64 + d0 * 32 + ch * 8; const u32x4 gv = gq[2 * d0 + i];
            u32x4 ov;
            ov.x = cvtpk(x0[0] * __uint_as_float(gv.x << 16), x0[1] * __uint_as_float(gv.x & 0xffff0000u)); ov.y = cvtpk(x0[2] * __uint_as_float(gv.y << 16), x0[3] * __uint_as_float(gv.y & 0xffff0000u));
            ov.z = cvtpk(x1[0] * __uint_as_float(gv.z << 16), x1[1] * __uint_as_float(gv.z & 0xffff0000u)); ov.w = cvtpk(x1[2] * __uint_as_float(gv.w << 16), x1[3] * __uint_as_float(gv.w & 0xffff0000u));
            *(u32x4*)(O + tiled_off((int)(grow + row), h * 64 + d0 * 32 + ch * 8)) = ov; }
        asm volatile("s_waitcnt lgkmcnt(0)" ::: "memory");
    }
}
template <int MODE> __device__ __forceinline__ void wave_init(WaveSt& w, int hi) {
#pragma unroll
    for (int r = 0; r < 16; ++r) { w.o0[r] = 0.f; w.o1[r] = 0.f; }
    set_qa(w, hi);
}

__device__ __forceinline__ void fox_unit(FA_LAS unsigned char* lds, const Params& P, int b, int h, int qb) {
    const int tid = threadIdx.x, lane = tid & 63, r32 = lane & 31, hi = lane >> 5;
    const int wid = __builtin_amdgcn_readfirstlane(tid >> 6);
    const int q0 = qb * 256, qlo = q0 + wid * 32, t = qlo + r32;
    const size_t rowbase = (size_t)b * SEQ;
    const bf16_t* ksrc = P.K + hm_off((int)rowbase + lane, h * 64 + wid * 8, NH);
    const bf16_t* vsrc = P.V + hm_off((int)rowbase + 16 * (wid & 3) + (lane >> 2), h * 64 + (wid >> 2) * 32 + (lane & 3) * 8, NH);
    const float* cum = P.CUM + (size_t)(b * NH + h) * SEQ;
    const bf16_t* asrc = P.KAUG + ((size_t)(b * NH + h) * SEQ + lane) * 8;
    const int NT = (q0 + 256) / 64;
    WaveSt w; float qn = 0.f;
#pragma unroll
    for (int d0 = 0; d0 < 4; ++d0) { w.qr[d0] = *(const bf16x8*)(P.Q + hm_off((int)rowbase + t, h * 64 + d0 * 16 + hi * 8, NH));
#pragma unroll
        for (int j = 0; j < 8; ++j) { const float qv = bf2f((bf16_t)w.qr[d0][j]); qn = fmaf(qv, qv, qn); } }
    w.cq = cum[t]; w.mhat = 0.f; w.lsum = 0.f; w.mrun = -1e30f;
    wave_init<0>(w, hi);
    u32x4 gq[4]; load_gate(gq, P.G, rowbase + qlo, h, lane);
    const float qkb = sqrtf(swap_add(qn) * (__uint_as_float(P.KMAX[(b * NH + h) * 2]) + __uint_as_float(P.KMAX[(b * NH + h) * 2 + 1]))) * 1.01f + 1e-3f;
    FA_LAS float* wsf = (FA_LAS float*)(lds + F_WSF) + wid * 64;
    FA_LAS unsigned* votes = (FA_LAS unsigned*)(lds + F_FLAG);
    float cnew = 0.f;
#define FA_LOADT(j, bf) do { const size_t ko_ = (size_t)(j) * 64 * 32; FA_LAS unsigned char* bb_ = lds + (bf) * F_KBUF; \
        glds16(ksrc + ko_, (unsigned)__builtin_amdgcn_readfirstlane((int)(unsigned)(uintptr_t)(bb_ + wid * 1024))); \
        glds16(vsrc + ko_, (unsigned)__builtin_amdgcn_readfirstlane((int)(unsigned)(uintptr_t)(bb_ + F_VOFF + (wid >> 2) * 4096 + (wid & 3) * 1024))); \
        if (wid == 0) glds16(asrc + (size_t)(j) * 64 * 8, (unsigned)__builtin_amdgcn_readfirstlane((int)(unsigned)(uintptr_t)(bb_ + F_AOFF))); \
        cnew = cum[(j) * 64 + 63]; } while (0)
    FA_LOADT(NT - 1, 0); asm volatile("s_waitcnt vmcnt(0)" ::: "memory"); __syncthreads();
    bool wdone = false; int n = 0; f32x16 pA0, pA1, pB0, pB1;
#pragma unroll
    for (int r = 0; r < 16; ++r) { pA0[r] = 0.f; pA1[r] = 0.f; pB0[r] = 0.f; pB1[r] = 0.f; }
    int cur = 0; bool fin = false;
#define FA_WALK(tt, CA0, CA1, PA0, PA1) do { \
        const int j = NT - 1 - (tt), k0 = j * 64; const int nxt = cur == 2 ? 0 : cur + 1, prv = cur == 0 ? 2 : cur - 1; \
        if (j > 0) FA_LOADT(j - 1, nxt); \
        if (!wdone && k0 <= qlo + 31) { FA_LAS unsigned char* bb = lds + cur * F_KBUF; \
            tile_full<0, F_AOFF, F_VOFF>(bb, n > 0 ? lds + prv * F_KBUF : bb, wsf, w, CA0, CA1, PA0, PA1, k0, t, qlo, lane, r32, hi); ++n; } \
        if (j > 0) { \
            if (!wdone && n > 0 && __all(qkb + w.cq - cnew - w.mrun <= -TH_SKIP)) { wdone = true; drain_full<F_VOFF>(lds + cur * F_KBUF, w, CA0, CA1, lane, hi); } \
            if (lane == 0) votes[((tt) & 1) * 8 + wid] = wdone ? 1u : 0u; } \
        asm volatile("s_waitcnt vmcnt(0)" ::: "memory"); \
        __syncthreads(); \
        if (j > 0) { const u32x4 v0 = *(FA_LAS u32x4*)(votes + ((tt) & 1) * 8), v1 = *(FA_LAS u32x4*)(votes + ((tt) & 1) * 8 + 4); \
            if ((v0.x & v0.y & v0.z & v0.w & v1.x & v1.y & v1.z & v1.w) != 0u) fin = true; } \
        else { if (!wdone && n > 0) drain_full<F_VOFF>(lds + cur * F_KBUF, w, CA0, CA1, lane, hi); fin = true; } \
        cur = nxt; } while (0)
    for (int tt = 0; !fin; tt += 2) {
        FA_WALK(tt, pA0, pA1, pB0, pB1);
        if (fin) break;
        FA_WALK(tt + 1, pB0, pB1, pA0, pA1);
    }
#undef FA_WALK
#undef FA_LOADT
    wave_epilogue((FA_LAS float*)(lds + F_OST + wid * 4096), wsf, w, gq, P.O, rowbase + qlo, h, lane, r32, hi);
    __syncthreads();
}
__device__ __forceinline__ void swa_unit(FA_LAS unsigned char* lds, const Params& P, int b, int kvh, int qb, int hh_lo = 0, int hh_hi = 8) {
    const int tid = threadIdx.x, lane = tid & 63, r32 = lane & 31, hi = lane >> 5;
    const int wid = __builtin_amdgcn_readfirstlane(tid >> 6);
    const int q0 = qb * 256, qlo = q0 + wid * 32, t = qlo + r32;
    const size_t rowbase = (size_t)b * SEQ;
    const int j_lo = q0 >= 128 ? (q0 - 128) / 64 : 0, NT = (q0 + 256) / 64 - j_lo;
    const bf16_t* ksrc = P.K + hm_off((int)rowbase + j_lo * 64 + lane, kvh * 64 + wid * 8, 4);
    const bf16_t* vsrc = P.V + hm_off((int)rowbase + j_lo * 64 + 16 * (wid & 3) + (lane >> 2), kvh * 64 + (wid >> 2) * 32 + (lane & 3) * 8, 4);
    for (int i = 0; i < NT; ++i) {
        glds16(ksrc + (size_t)i * 64 * 32, (unsigned)__builtin_amdgcn_readfirstlane((int)(unsigned)(uintptr_t)(lds + i * S_KBUF + wid * 1024)));
        glds16(vsrc + (size_t)i * 64 * 32, (unsigned)__builtin_amdgcn_readfirstlane((int)(unsigned)(uintptr_t)(lds + i * S_KBUF + S_VOFF + (wid >> 2) * 4096 + (wid & 3) * 1024))); }
    asm volatile("s_waitcnt vmcnt(0)" ::: "memory");
    __syncthreads();
    FA_LAS float* wsf = (FA_LAS float*)(lds + S_WSF) + wid * 64;
    const int ta = (qlo >= 127 ? (qlo - 127) / 64 : 0) - j_lo, tb = (qlo + 31) / 64 - j_lo;
    for (int hh = hh_lo; hh < hh_hi; ++hh) {
        const int h = kvh * 8 + hh;
        WaveSt w;
#pragma unroll
        for (int d0 = 0; d0 < 4; ++d0) w.qr[d0] = *(const bf16x8*)(P.Q + hm_off((int)rowbase + t, h * 64 + d0 * 16 + hi * 8, NH));
        u32x4 gq[4]; load_gate(gq, P.G, rowbase + qlo, h, lane);
        w.cq = 0.f; w.mhat = P.sinks[h] * LOG2E; w.lsum = 0.5f; w.mrun = 0.f;
        wave_init<1>(w, hi);
        f32x16 pA0, pA1, pB0, pB1;
#pragma unroll
        for (int r = 0; r < 16; ++r) { pB0[r] = 0.f; pB1[r] = 0.f; }
        for (int ti = tb;;) {
            { FA_LAS unsigned char* bb = lds + ti * S_KBUF;
              tile_full<1, 0, S_VOFF>(bb, ti == tb ? bb : bb + S_KBUF, wsf, w, pA0, pA1, pB0, pB1, (j_lo + ti) * 64, t, qlo, lane, r32, hi); }
            if (ti == ta) { drain_full<S_VOFF>(lds + ta * S_KBUF, w, pA0, pA1, lane, hi); break; }
            --ti;
            { FA_LAS unsigned char* bb = lds + ti * S_KBUF;
              tile_full<1, 0, S_VOFF>(bb, bb + S_KBUF, wsf, w, pB0, pB1, pA0, pA1, (j_lo + ti) * 64, t, qlo, lane, r32, hi); }
            if (ti == ta) { drain_full<S_VOFF>(lds + ta * S_KBUF, w, pB0, pB1, lane, hi); break; }
            --ti;
        }
        wave_epilogue((FA_LAS float*)(lds + S_OST + wid * 4096), wsf, w, gq, P.O, rowbase + qlo, h, lane, r32, hi);
    }
    __syncthreads();
}
}
#define GAS __attribute__((address_space(1)))
#define LAS __attribute__((address_space(3)))
typedef unsigned short bf16;
typedef unsigned v4u __attribute__((ext_vector_type(4)));
typedef float f32x4 __attribute__((ext_vector_type(4)));
typedef short bf16x8 __attribute__((ext_vector_type(8)));
typedef GAS unsigned gu32;
typedef GAS unsigned long long gu64;
#define RLX_AGENT __ATOMIC_RELAXED, __HIP_MEMORY_SCOPE_AGENT
#define LDS_WAIT() asm volatile("s_waitcnt lgkmcnt(0)" ::: "memory")
#define VM_WAIT() asm volatile("s_waitcnt vmcnt(0)" ::: "memory")
__device__ __forceinline__ unsigned long long rt() { return __builtin_amdgcn_s_memrealtime(); }
__device__ __forceinline__ unsigned pk2(float lo, float hi) { return (unsigned)f2bf(lo) | ((unsigned)f2bf(hi) << 16); }
#define XB_TMO      128
#define XB_XCNT(j)  (256  + 64 * (j))
#define XB_XSUB(j)  (1280 + 64 * (j))
#define XB_XGEN(j)  (2304 + 64 * (j))
#define XB_TOP      3328
#define XB_TOPGEN   3392
#define XCD_BAR_WORDS 3456
#define XB_SPIN_CAP (1u << 18)

__device__ __forceinline__ unsigned xb_ld(unsigned* p)              { return __hip_atomic_load(p, __ATOMIC_RELAXED, __HIP_MEMORY_SCOPE_AGENT); }
__device__ __forceinline__ unsigned xb_add(unsigned* p, unsigned v) { return __hip_atomic_fetch_add(p, v, __ATOMIC_RELAXED, __HIP_MEMORY_SCOPE_AGENT); }
__device__ __forceinline__ unsigned xb_xcc_id() { return (unsigned)__builtin_amdgcn_s_getreg((3 << 11) | 20) & 0xFu; }
#define XB_SPIN(cond, bar) do { unsigned _sp = 0; while (cond) { __builtin_amdgcn_s_sleep(1); \
    if ((++_sp & 255u) == 0u) { if (xb_ld(&(bar)[XB_TMO])) break; if (_sp > XB_SPIN_CAP) { atomicAdd(&(bar)[XB_TMO], 1u); break; } } } } while (0)

struct XcdBarrier {
    unsigned* bar; unsigned x;
    volatile LAS unsigned* st;
};

__device__ __forceinline__ XcdBarrier xcd_barrier_post(unsigned* bar, volatile LAS unsigned* st) {
    XcdBarrier b; b.bar = bar; b.x = xb_xcc_id(); b.st = st;
    if (threadIdx.x == 0) (void)xb_add(&bar[XB_XCNT(b.x)], 1u);
    return b;
}
__device__ __forceinline__ void xcd_barrier_complete(unsigned* bar, unsigned x, unsigned& nloc, unsigned& nx) {
    const unsigned G = gridDim.x * gridDim.y * gridDim.z;
    unsigned sum, cnt, mine, sp = 0u;
    for (;;) {
        sum = 0u; cnt = 0u; mine = 0u;
#pragma unroll
        for (unsigned j = 0; j < 16; ++j) { const unsigned c = xb_ld(&bar[XB_XCNT(j)]); sum += c; cnt += (c > 0u) ? 1u : 0u; mine = (j == x) ? c : mine; }
        if (sum == G) break;
        __builtin_amdgcn_s_sleep(1);
        if ((++sp & 255u) == 0u) { if (xb_ld(&bar[XB_TMO])) break; if (sp > XB_SPIN_CAP) { atomicAdd(&bar[XB_TMO], 1u); break; } }
    }
    nloc = mine > 0u ? mine : 1u; nx = cnt > 0u ? cnt : 1u;
}

__device__ __forceinline__ void xcd_barrier(const XcdBarrier& b) {
    asm volatile("s_waitcnt vmcnt(0)" ::: "memory");
    __syncthreads();
    if (threadIdx.x == 0) {
        unsigned* bar = b.bar;
        __builtin_amdgcn_s_waitcnt(0);
        unsigned nloc = b.st[0], nx = b.st[1];
        if (nloc == 0u) { xcd_barrier_complete(bar, b.x, nloc, nx); b.st[0] = nloc; b.st[1] = nx; }
        const unsigned old = xb_add(&bar[XB_XSUB(b.x)], 1u);
        const unsigned gen = old / nloc;
        if (old + 1u == (gen + 1u) * nloc) {
            __builtin_amdgcn_fence(__ATOMIC_RELEASE, "agent");
            asm volatile("s_waitcnt vmcnt(0)" ::: "memory");
            const unsigned og = xb_add(&bar[XB_TOP], 1u);
            const unsigned tg = og / nx;
            if (og + 1u == (tg + 1u) * nx) xb_add(&bar[XB_TOPGEN], 1u);
            else XB_SPIN(xb_ld(&bar[XB_TOPGEN]) == tg, bar);
            __builtin_amdgcn_fence(__ATOMIC_ACQUIRE, "agent");
            xb_add(&bar[XB_XGEN(b.x)], 1u);
            asm volatile("s_waitcnt vmcnt(0)" ::: "memory");
        } else {
            XB_SPIN(xb_ld(&bar[XB_XGEN(b.x)]) == gen, bar);
            __builtin_amdgcn_fence(__ATOMIC_ACQUIRE, "agent");
            asm volatile("s_waitcnt vmcnt(0)" ::: "memory");
        }
    }
    __syncthreads();
}
constexpr int NWAVES = 8;
constexpr int N1P = 8448;
constexpr int RING_OFF = 0, RING_BYTES = 135168;
constexpr int LDSCTL_OFF = RING_BYTES, MISC_OFF = LDSCTL_OFF + 320;
constexpr int LDS_BYTES = 147456;
constexpr int CW_BAR = 4096;
static_assert(fa::F_LDS_BYTES <= RING_BYTES && fa::S_LDS_BYTES <= RING_BYTES && pg8::STAGE_BYTES <= RING_BYTES && MISC_OFF + 128 <= LDS_BYTES && (CW_BAR + XCD_BAR_WORDS) * 4 <= (int)WS_KMAX, "LDS / CTL map");

__device__ __forceinline__ void p0_transpose_item(const float* W, int K, int N, bf16* WT, LAS float* scr, int item, int lane, const float* gs) {
    const int nblk = N / 32, kb = item / nblk, nb = item % nblk, k0 = 64 * kb, n0 = 32 * nb;
    const int kr = lane >> 3, nc = 4 * (lane & 7);
    f32x4 wv[8];
#pragma unroll
    for (int i = 0; i < 8; ++i) wv[i] = *(const GAS f32x4*)(W + (size_t)(k0 + 8 * i + kr) * N + n0 + nc);
#pragma unroll
    for (int i = 0; i < 8; ++i) { const int kk = 8 * i + kr; f32x4 w = wv[i]; if (gs) w = w * gs[k0 + kk]; LAS float* d = scr + kk * 33 + nc; d[0] = w.x; d[1] = w.y; d[2] = w.z; d[3] = w.w; }
    LDS_WAIT(); asm volatile("" ::: "memory");
    const int c = lane & 7;
#pragma unroll
    for (int j = 0; j < 4; ++j) { const int n = (lane >> 3) + 8 * j; const LAS float* sp = scr + (8 * c) * 33 + n;
        v4u o; o.x = pk2(sp[0 * 33], sp[1 * 33]); o.y = pk2(sp[2 * 33], sp[3 * 33]); o.z = pk2(sp[4 * 33], sp[5 * 33]); o.w = pk2(sp[6 * 33], sp[7 * 33]);
        *(GAS v4u*)(WT + tiled_off(n0 + n, k0 + 8 * c)) = o; }
    LDS_WAIT(); asm volatile("" ::: "memory");
}
__device__ __forceinline__ float wave_sum(float v) {
#pragma unroll
    for (int o = 1; o < 64; o <<= 1) v += __shfl_xor(v, o);
    return v;
}

struct Args { const float* in[9]; float* out; unsigned char* ws; int ph_lo, ph_hi; };
constexpr int N_PHASES = 9;
__global__ void __launch_bounds__(NWAVES * 64, 2) mega_fwd(Args args) {
    extern __shared__ __attribute__((aligned(16))) unsigned char lds_raw[];
    LAS unsigned char* lds = (LAS unsigned char*)lds_raw;
    volatile LAS unsigned* MISC = (volatile LAS unsigned*)(lds + MISC_OFF);
    const int tid = threadIdx.x, lane = tid & 63, wave = __builtin_amdgcn_readfirstlane(tid >> 6);
    const int G = gridDim.x, bx = blockIdx.x, vcu = (G % 8 == 0) ? (bx % 8) * (G / 8) + bx / 8 : bx;
    unsigned char* ws = args.ws;
    const float* x = args.in[0]; const float* norm_g = args.in[1]; const float* fox_w_in = args.in[2]; const float* fox_b_f = args.in[3]; const float* fox_w_out = args.in[4];
    const float* swa_w_in = args.in[5]; const float* swa_sinks = args.in[6]; const float* swa_w_out = args.in[7]; const float* final_g = args.in[8];
    float* out = args.out;
    gu32* ctl = (gu32*)(ws + WS_CTL);
    unsigned* KMAX = (unsigned*)(ws + WS_KMAX); unsigned* TICKET = (unsigned*)(ws + WS_TICKET);
    float* SS1 = (float*)(ws + WS_SS1); float* R0 = (float*)(ws + WS_R0); float* ROPE = (float*)(ws + WS_ROPE); float* LOGF = (float*)(ws + WS_LOGF); float* CUM = (float*)(ws + WS_CUM);
    bf16* W1T = (bf16*)(ws + WS_W1T); bf16* W2T = (bf16*)(ws + WS_W2T); bf16* W3T = (bf16*)(ws + WS_W3T); bf16* W4T = (bf16*)(ws + WS_W4T);
    bf16* KAUG = (bf16*)(ws + WS_KAUG);
    bf16* XB = (bf16*)(ws + WS_XB); bf16* Qb = (bf16*)(ws + WS_Q); bf16* Kb = (bf16*)(ws + WS_K); bf16* Vb = (bf16*)(ws + WS_V); bf16* Gb = (bf16*)(ws + WS_G); bf16* YG = (bf16*)(ws + WS_YG);
    for (int u = tid; u < (LDS_BYTES - LDSCTL_OFF) / 4; u += NWAVES * 64) ((LAS unsigned*)(lds + LDSCTL_OFF))[u] = 0u;
    __syncthreads();
    const int lo = args.ph_lo, hi = args.ph_hi;
    XcdBarrier bar; bar.bar = (unsigned*)(ctl + CW_BAR); bar.x = 0; bar.st = nullptr;
    if (hi - lo > 1) bar = xcd_barrier_post((unsigned*)(ctl + CW_BAR), MISC + 8);
#define IN(k) (lo <= (k) && (k) < hi)
#define REP(k) for (int rep_ = 0; rep_ < (((DUP_MASK >> (k)) & 1) ? 2 : 1); ++rep_)
#define SEAM(k) do { if (IN(k) && IN((k) + 1)) xcd_barrier(bar); } while (0)
    const int gw = vcu * NWAVES + wave, NGW = G * NWAVES;
    const bool grp = (G == 256) && lo == 0 && hi == N_PHASES;
    const int gpm = 8 * (bx & 7) + ((bx >> 3) & 7), gj = bx >> 6;
    unsigned* GS = (unsigned*)(ws + WS_GS);
    unsigned* XT = (unsigned*)(ws + WS_XT);
    if (grp && tid == 0) __hip_atomic_store(XT + bx, xb_xcc_id() + 1u, __ATOMIC_RELAXED, __HIP_MEMORY_SCOPE_AGENT);
#define G_ARRIVE() do { asm volatile("s_waitcnt vmcnt(0)" ::: "memory"); __syncthreads(); \
        if (tid == 0) { if (MISC[12] != 0u) { __builtin_amdgcn_fence(__ATOMIC_RELEASE, "agent"); asm volatile("s_waitcnt vmcnt(0)" ::: "memory"); } (void)xb_add(GS + gpm * 16, 1u); } } while (0)
#define G_WAIT(pm_, target) do { if (tid == 0) { unsigned* w_ = GS + (pm_) * 16; XB_SPIN(xb_ld(w_) < (unsigned)(target), bar.bar); \
        __builtin_amdgcn_fence(__ATOMIC_ACQUIRE, "agent"); asm volatile("s_waitcnt vmcnt(0)" ::: "memory"); } __syncthreads(); } while (0)

    if (IN(0)) REP(0) {
        LAS float* scr = (LAS float*)(lds + RING_OFF + wave * 16384);
        constexpr int I1 = (DM / 64) * (FOX_IN / 32);
        for (int it = gw; it < I1; it += NGW) p0_transpose_item(fox_w_in, DM, FOX_IN, W1T, scr, it, lane, norm_g);
        for (int m = 2 * gw; m < MTOK; m += 2 * NGW) {
            const int m2 = m + 1;
            const GAS f32x4* xr = (const GAS f32x4*)(x + (size_t)m * DM) + lane; const GAS f32x4* xr2 = (const GAS f32x4*)(x + (size_t)m2 * DM) + lane; f32x4 v[8], v2[8]; float s = 0.f, s2 = 0.f;
#pragma unroll
            for (int j = 0; j < 8; ++j) { v[j] = xr[64 * j]; v2[j] = xr2[64 * j]; }
#pragma unroll
            for (int j = 0; j < 8; ++j) { s += (v[j].x * v[j].x + v[j].y * v[j].y) + (v[j].z * v[j].z + v[j].w * v[j].w); s2 += (v2[j].x * v2[j].x + v2[j].y * v2[j].y) + (v2[j].z * v2[j].z + v2[j].w * v2[j].w); }
            s = wave_sum(s); s2 = wave_sum(s2);
            if (lane == 0) { R0[m] = 1.0f / sqrtf(s * (1.f / DM) + RMS_EPS); R0[m2] = 1.0f / sqrtf(s2 * (1.f / DM) + RMS_EPS); }
#pragma unroll
            for (int j = 0; j < 8; ++j) { *(GAS unsigned long long*)(XB + tiled_off(m, 256 * j + 4 * lane)) = (unsigned long long)pk2(v[j].x, v[j].y) | ((unsigned long long)pk2(v[j].z, v[j].w) << 32);
                                          *(GAS unsigned long long*)(XB + tiled_off(m2, 256 * j + 4 * lane)) = (unsigned long long)pk2(v2[j].x, v2[j].y) | ((unsigned long long)pk2(v2[j].z, v2[j].w) << 32); }
        }
        { const int gt = gw * 64 + lane;
          if (gt < SEQ * 8) { const int pos = gt >> 3, i = gt & 7;
              const double invf[8] = {1.0, 0.19390220519133497, 0.037598065178462524, 0.0072903477503833845, 0.0014142135623730951, 0.00027421912901204056, 5.3171693730649086e-05, 1.0310108130908796e-05};
              double inv = invf[0];
#pragma unroll
              for (int k = 1; k < 8; ++k) inv = (i == k) ? invf[k] : inv;
              const double ang = (double)pos * inv; const double kk = __builtin_rint(ang * 0.15915494309189535); const float red = (float)(ang - kk * 6.283185307179586);
              ROPE[(size_t)pos * 16 + i] = cosf(red); ROPE[(size_t)pos * 16 + 8 + i] = sinf(red); } }
    }
    SEAM(0);
    if (IN(1)) {
        pg8::Gemm g{XB, W1T, MTOK, 4 * DM, DM}; pg8::StaticOrder S; S.init(MTOK, 4 * DM, G, bx, (DUP_MASK >> 1) & 1, (DUP_MASK >> 9) & 1);
        pg8::EpiFoxIn E{Qb, Kb, Vb, Gb, LOGF, R0, fox_b_f, KMAX};
        if ((DUP_MASK >> 10) & 1) { pg8::StaticOrder SP; SP.init(MTOK, 4 * DM, G, bx, 0, 0, 1); pg8::gemm_phase<pg8::EpiFoxIn, pg8::StaticOrder, true, true>(lds + RING_OFF, g, SP, E); }
        pg8::gemm_phase<pg8::EpiFoxIn, pg8::StaticOrder, true, true>(lds + RING_OFF, g, S, E);
        for (int rb = bx * 64; rb < MTOK; rb += G * 64) {
            LAS unsigned char* bl = lds + RING_OFF;
#pragma unroll
            for (int pc = 0; pc < 16; ++pc) { const int pidx = wave + 8 * pc;
                fa::glds16(W1T + tiled_off(4 * DM, 0) + (size_t)(pidx >> 1) * 8192 + (pidx & 1) * 512 + lane * 8, (unsigned)__builtin_amdgcn_readfirstlane((int)(unsigned)(uintptr_t)(bl + pidx * 1024))); }
            const int arow = rb + 16 * (wave & 3) + (lane & 15), kg = (lane >> 4) * 8, kh = wave >> 2;
            bf16x8 af[32];
#pragma unroll
            for (int ks = 0; ks < 32; ++ks) af[ks] = *(const GAS bf16x8*)(XB + tiled_off(arow, 32 * (32 * kh + ks) + kg));
            asm volatile("s_waitcnt vmcnt(0)" ::: "memory");
            __syncthreads();
            pg8::f32x4 acc0 = {0.f, 0.f, 0.f, 0.f}, acc1 = {0.f, 0.f, 0.f, 0.f};
            const LAS unsigned char* bp = bl + (32 * kh) * 2048 + (lane & 15) * 64 + (lane >> 4) * 16;
#pragma unroll
            for (int ks = 0; ks < 32; ++ks) {
                const bf16x8 b0 = *(const LAS bf16x8*)(bp + ks * 2048), b1 = *(const LAS bf16x8*)(bp + ks * 2048 + 1024);
                acc0 = __builtin_amdgcn_mfma_f32_16x16x32_bf16(af[ks], b0, acc0, 0, 0, 0); acc1 = __builtin_amdgcn_mfma_f32_16x16x32_bf16(af[ks], b1, acc1, 0, 0, 0); }
            __syncthreads();
            LAS pg8::f32x4* xs = (LAS pg8::f32x4*)bl + ((wave & 3) * 64 + lane) * 2;
            if (kh == 1) { xs[0] = acc0; xs[1] = acc1; }
            __syncthreads();
            if (kh == 0) {
                acc0 = acc0 + xs[0]; acc1 = acc1 + xs[1];
                const int r0 = rb + 16 * (wave & 3) + 4 * (lane >> 4); const float s0 = R0[r0], s1 = R0[r0 + 1], s2 = R0[r0 + 2], s3 = R0[r0 + 3];
#pragma unroll
                for (int g2 = 0; g2 < 2; ++g2) { const int h = 16 * g2 + (lane & 15); const float bb = fox_b_f[h]; const pg8::f32x4 a = g2 ? acc1 : acc0;
                    f32x4 o; o.x = logsigmoidf(a[0] * s0 + bb); o.y = logsigmoidf(a[1] * s1 + bb); o.z = logsigmoidf(a[2] * s2 + bb); o.w = logsigmoidf(a[3] * s3 + bb);
                    *(GAS f32x4*)(LOGF + ((size_t)((r0 >> 12) * NH + h) << 12) + (r0 & 4095)) = o; }
            }
            __syncthreads();
        }
        { LAS float* scr = (LAS float*)(lds + RING_OFF + wave * 16384);
          constexpr int I2 = (DM / 64) * (DM / 32), I3 = (DM / 64) * (SWA_IN / 32);
          for (int it = gw; it < I2 + I3; it += NGW) { if (it < I2) p0_transpose_item(fox_w_out, DM, DM, W2T, scr, it, lane, nullptr); else p0_transpose_item(swa_w_in, DM, SWA_IN, W3T, scr, it - I2, lane, norm_g + DM); } }
    }
    SEAM(1);
    if (IN(2)) REP(2) {
        for (int sq = vcu; sq < NB * NH; sq += G) {
            const GAS f32x4* lf = (const GAS f32x4*)(LOGF + (size_t)sq * SEQ + wave * 512) + lane * 2; const f32x4 v0 = lf[0], v1 = lf[1];
            const double tot = (((double)v0.x + (double)v0.y) + ((double)v0.z + (double)v0.w)) + (((double)v1.x + (double)v1.y) + ((double)v1.z + (double)v1.w));
            double incl = tot;
#pragma unroll
            for (int o = 1; o < 64; o <<= 1) { const double up = __shfl_up(incl, o); if (lane >= o) incl += up; }
            volatile LAS double* wt = (volatile LAS double*)(lds + RING_OFF);
            __syncthreads();
            if (lane == 63) wt[wave] = incl;
            __syncthreads();
            double run = incl - tot;
            for (int w2 = 0; w2 < wave; ++w2) run += wt[w2];
            const float vv[8] = {v0.x, v0.y, v0.z, v0.w, v1.x, v1.y, v1.z, v1.w}; float cv[8];
#pragma unroll
            for (int e = 0; e < 8; ++e) { run += (double)vv[e]; cv[e] = (float)(run * 1.4426950408889634); }
            GAS f32x4* co = (GAS f32x4*)(CUM + (size_t)sq * SEQ + wave * 512) + lane * 2; co[0] = (f32x4){cv[0], cv[1], cv[2], cv[3]}; co[1] = (f32x4){cv[4], cv[5], cv[6], cv[7]};
            GAS v4u* ka = (GAS v4u*)(KAUG + ((size_t)sq * SEQ + wave * 512 + lane * 8) * 8);
#pragma unroll
            for (int e = 0; e < 8; ++e) { unsigned h1, h2, h3; fa::split3(-cv[e], h1, h2, h3); ka[e] = (v4u){h1 | (h2 << 16), h3 | 0x3F800000u, 0x3F803F80u, 0u}; }
        }
        { const int nidle = G > NB * NH ? G - NB * NH : G, ii = G > NB * NH ? vcu - NB * NH : vcu;
          if (ii >= 0) { __syncthreads(); LAS float* scr = (LAS float*)(lds + RING_OFF + wave * 16384); constexpr int I2 = (DM / 64) * (DM / 32);
              for (int it = ii * NWAVES + wave; it < I2; it += nidle * NWAVES) p0_transpose_item(swa_w_out, DM, DM, W4T, scr, it, lane, nullptr); } }
    }
    SEAM(2);
    if (IN(3)) {
        const fa::Params P{Qb, Kb, Vb, Gb, YG, CUM, nullptr, KMAX, TICKET, KAUG};
        if (grp && tid == 0) {
            const unsigned me = xb_xcc_id() + 1u; const int pn = gpm + 1, two = ((pn & 15) != 0) ? 1 : 0, pq = two ? pn : gpm;
            const unsigned r0 = xb_ld(XT + 8 * (16 + (gpm & 7)) + (gpm >> 3)), r1 = xb_ld(XT + 8 * (24 + (gpm & 7)) + (gpm >> 3));
            const unsigned r2 = xb_ld(XT + 8 * (16 + (pq & 7)) + (pq >> 3)), r3 = xb_ld(XT + 8 * (24 + (pq & 7)) + (pq >> 3));
            MISC[12] = (r0 != me || r1 != me || r2 != me || r3 != me) ? 1u : 0u; }
        volatile LAS unsigned* slot = (volatile LAS unsigned*)(lds + RING_OFF + fa::F_FLAG + 128);
#define FOX_FETCH(dst) do { unsigned code_ = 0xFFFFFFFFu; for (int k_ = 0; k_ < 8; ++k_) { const unsigned q_ = (unsigned)((bx + k_) & 7); const unsigned t_ = atomicAdd(TICKET + q_ * 64, 1u); \
            if (t_ < 256u) { code_ = q_ * 256u + t_; break; } } (dst) = code_; } while (0)
        if (tid == 0) FOX_FETCH(slot[0]);
        __syncthreads();
        unsigned tk = slot[0]; int par = 0;
        while (tk != 0xFFFFFFFFu) {
            if (tid == 0) FOX_FETCH(slot[par ^ 1]);
            const int q = (int)(tk >> 8), tq = (int)(tk & 255u), pi = tq >> 4, hs = 3 - (pi >> 2);
            const int h = hs == 0 ? q : hs == 1 ? 15 - q : hs == 2 ? 16 + q : 31 - q;
            fa::fox_unit(lds + RING_OFF, P, pi & 3, h, 15 - (tq & 15));
            par ^= 1; tk = slot[par];
        }
#undef FOX_FETCH
        __syncthreads();
    }
    SEAM(3);
    if (IN(4)) {
        pg8::Gemm g{YG, W2T, MTOK, DM, DM}; pg8::StaticOrder S; S.init(MTOK, DM, G, bx);
        pg8::EpiRes<true> E{x, XB, SS1};
        pg8::gemm_phase<pg8::EpiRes<true>, pg8::StaticOrder, true, true>(lds + RING_OFF, g, S, E);
    }
    SEAM(4);
    if (IN(5)) {
        pg8::Gemm g{XB, W3T, MTOK, SWA_IN, DM}; pg8::StaticOrder S; S.init(MTOK, SWA_IN, G, bx, (DUP_MASK >> 5) & 1, 0, 0, 0, grp ? 4 : (1 << 20));
        pg8::EpiSwaIn E{Qb, Kb, Vb, Gb, SS1, ROPE};
        pg8::gemm_phase<pg8::EpiSwaIn, pg8::StaticOrder, true, true>(lds + RING_OFF, g, S, E);
        if (grp) {
            G_ARRIVE();
            if (gj < 2) { pg8::StaticOrder S4; S4.init(MTOK, SWA_IN, G, bx, 0, 0, 0, 4, 5); pg8::gemm_phase<pg8::EpiSwaIn, pg8::StaticOrder, true, true>(lds + RING_OFF, g, S4, E); }
            else { const fa::Params P{Qb, Kb, Vb, Gb, YG, nullptr, swa_sinks, nullptr, nullptr, nullptr};
                   G_WAIT(gpm, 4); if ((gpm & 15) != 0) G_WAIT(gpm - 1, 4);
                   fa::swa_unit(lds + RING_OFF, P, gpm >> 4, gj - 2, gpm & 15); }
        }
    }
    SEAM(5);
    if (IN(6)) REP(6) {
        const fa::Params P{Qb, Kb, Vb, Gb, YG, nullptr, swa_sinks, nullptr, nullptr, nullptr};
        if (grp) fa::swa_unit(lds + RING_OFF, P, gpm >> 4, 2 + (gj >> 1), gpm & 15, (gj & 1) * 4, (gj & 1) * 4 + 4);
        else for (int u = bx; u < NB * 4 * 16; u += G) fa::swa_unit(lds + RING_OFF, P, u >> 6, (u >> 4) & 3, u & 15);
    }
    SEAM(6);
    if (IN(7)) {
        pg8::Gemm g{YG, W4T, MTOK, DM, DM}; pg8::StaticOrder S; S.init(MTOK, DM, G, bx);
        pg8::EpiRes<false> E{nullptr, XB, nullptr};
        pg8::gemm_phase<pg8::EpiRes<false>, pg8::StaticOrder, true, true>(lds + RING_OFF, g, S, E);
    }
    SEAM(7);
    if (IN(8)) {
        f32x4 gq[8];
#pragma unroll
        for (int j = 0; j < 8; ++j) gq[j] = ((const GAS f32x4*)final_g)[lane + 64 * j];
        for (int m = 2 * gw; m < MTOK; m += 2 * NGW) {
            f32x4 v[8], v2[8]; float s = 0.f, s2 = 0.f; unsigned long long xw[8], xw2[8];
#pragma unroll
            for (int j = 0; j < 8; ++j) { xw[j] = *(const GAS unsigned long long*)(XB + tiled_off(m, 256 * j + 4 * lane)); xw2[j] = *(const GAS unsigned long long*)(XB + tiled_off(m + 1, 256 * j + 4 * lane)); }
#pragma unroll
            for (int j = 0; j < 8; ++j) { const unsigned lo32 = (unsigned)xw[j], hi32 = (unsigned)(xw[j] >> 32), lo2 = (unsigned)xw2[j], hi2 = (unsigned)(xw2[j] >> 32);
                v[j] = (f32x4){__uint_as_float(lo32 << 16), __uint_as_float(lo32 & 0xffff0000u), __uint_as_float(hi32 << 16), __uint_as_float(hi32 & 0xffff0000u)};
                v2[j] = (f32x4){__uint_as_float(lo2 << 16), __uint_as_float(lo2 & 0xffff0000u), __uint_as_float(hi2 << 16), __uint_as_float(hi2 & 0xffff0000u)};
                s += (v[j].x * v[j].x + v[j].y * v[j].y) + (v[j].z * v[j].z + v[j].w * v[j].w); s2 += (v2[j].x * v2[j].x + v2[j].y * v2[j].y) + (v2[j].z * v2[j].z + v2[j].w * v2[j].w); }
            const float r = 1.0f / sqrtf(wave_sum(s) * (1.f / DM) + RMS_EPS), r2 = 1.0f / sqrtf(wave_sum(s2) * (1.f / DM) + RMS_EPS);
            GAS f32x4* xr = (GAS f32x4*)(out + (size_t)m * DM) + lane; GAS f32x4* xr2 = (GAS f32x4*)(out + (size_t)(m + 1) * DM) + lane;
#pragma unroll
            for (int j = 0; j < 8; ++j) { xr[64 * j] = v[j] * r * gq[j]; xr2[64 * j] = v2[j] * r2 * gq[j]; }
        }
    }
#undef IN
#undef SEAM
#undef G_ARRIVE
#undef G_WAIT
}

extern "C" void kernel_launch(void* const* d_in, const int* in_sizes, int n_in, void* d_out, int out_size, void* d_ws, size_t ws_size, hipStream_t stream) {
    static int grid = 0;
    if (grid == 0) {
        if (n_in != 9 || in_sizes[0] != MTOK * DM || out_size != MTOK * DM || ws_size < WS_END) { fprintf(stderr, "kernel_launch: unexpected shapes (n_in %d, in0 %d, out %d, ws %zu)\n", n_in, n_in > 0 ? in_sizes[0] : -1, out_size, ws_size); grid = -1; return; }
        int dev = 0, cus = 0, per_cu = 0;
        if (hipGetDevice(&dev) != hipSuccess || hipDeviceGetAttribute(&cus, hipDeviceAttributeMultiprocessorCount, dev) != hipSuccess) { fprintf(stderr, "kernel_launch: device query failed\n"); grid = -1; return; }
        if (hipFuncSetAttribute((const void*)mega_fwd, hipFuncAttributeMaxDynamicSharedMemorySize, LDS_BYTES) != hipSuccess) { fprintf(stderr, "kernel_launch: hipFuncSetAttribute failed\n"); grid = -1; return; }
        if (hipOccupancyMaxActiveBlocksPerMultiprocessor(&per_cu, (const void*)mega_fwd, NWAVES * 64, LDS_BYTES) != hipSuccess || per_cu < 1) { fprintf(stderr, "kernel_launch: occupancy query reports %d workgroups per CU; nothing launched\n", per_cu); (void)hipGetLastError(); grid = -1; return; }
        grid = cus;
    }
    if (grid < 0) return;
    (void)hipMemsetAsync((unsigned char*)d_ws + WS_CTL, 0, CTL_ZERO_BYTES, stream);
    Args a{};
    for (int i = 0; i < 9; ++i) a.in[i] = (const float*)d_in[i];
    a.out = (float*)d_out; a.ws = (unsigned char*)d_ws;
    int p = 0;
    while (p < N_PHASES) {
        if (!((FAST_MASK >> p) & 1)) { ++p; continue; }
        int e = p + 1; if (ONE_LAUNCH) while (e < N_PHASES && ((FAST_MASK >> e) & 1)) ++e;
        a.ph_lo = p; a.ph_hi = e;
        hipLaunchKernelGGL(mega_fwd, dim3(grid), dim3(NWAVES * 64), LDS_BYTES, stream, a);
        p = e;
    }
}
```

```cpp
#include <hip/hip_runtime.h>
#include <cstdio>
#include <cstdint>

constexpr int NB = 4, SEQ = 4096, DM = 2048, MTOK = NB * SEQ, NH = 32, HD = 64;
constexpr int FOX_IN = 8224, SWA_IN = 4608, KVW = 256;
constexpr float RMS_EPS = 1e-6f;
constexpr float LOG2E = 1.4426950408889634f;
constexpr float C2 = 0.125f * LOG2E;

typedef unsigned short bf16_t;
__device__ __forceinline__ float bf2f(bf16_t v) { return __uint_as_float((unsigned)v << 16); }
__device__ __forceinline__ bf16_t f2bf(float f) { unsigned u = __float_as_uint(f); return (bf16_t)((u + 0x7fffu + ((u >> 16) & 1u)) >> 16); }
__device__ __forceinline__ float logsigmoidf(float z) { return z < 0.f ? z - log1pf(expf(z)) : -log1pf(expf(-z)); }
__device__ __forceinline__ float siluf(float g) { return g / (1.f + expf(-g)); }

__host__ __device__ __forceinline__ size_t tiled_off(int row, int k) { return ((size_t)(((row >> 8) * (DM / 64) + (k >> 6)) * 2 + ((k >> 5) & 1)) << 13) + (size_t)(((row & 255) << 5) + (k & 31)); }

__host__ __device__ __forceinline__ size_t hm_off(int row  , int col  , int nheads) { return ((size_t)(((row >> 12) * nheads + (col >> 6)) * 2 + ((col >> 5) & 1)) * SEQ + (row & 4095)) * 32 + (col & 31); }

constexpr size_t MiB = 1u << 20;
constexpr size_t WS_CTL = 0, CTL_ZERO_BYTES = 1 * MiB;
constexpr size_t WS_KMAX = 64 * 1024, WS_TICKET = 66 * 1024;
constexpr size_t WS_GS = 128 * 1024;
constexpr size_t WS_XT = 160 * 1024;
constexpr size_t WS_SS1 = 512 * 1024;
constexpr size_t WS_R0 = 1 * MiB;
constexpr size_t WS_ROPE = 1 * MiB + 512 * 1024;
constexpr size_t WS_LOGF = 2 * MiB;
constexpr size_t WS_CUM = 4 * MiB;
constexpr size_t WS_W1T = 8 * MiB, WS_W2T = 41 * MiB, WS_W3T = 49 * MiB, WS_W4T = 67 * MiB;
constexpr size_t WS_XB = 76 * MiB, WS_Q = 140 * MiB, WS_K = 204 * MiB, WS_V = 268 * MiB, WS_G = 332 * MiB, WS_YG = 396 * MiB, WS_KAUG = 460 * MiB, WS_END = 468 * MiB;

#ifndef FAST_MASK
#define FAST_MASK 0x1FF
#endif
#ifndef DUP_MASK
#define DUP_MASK 0x000
#endif
#ifndef ONE_LAUNCH
#define ONE_LAUNCH 1
#endif
namespace pg8 {
#define PG8_LAS __attribute__((address_space(3)))
typedef unsigned short bf16_t;
typedef short bf16x8 __attribute__((ext_vector_type(8)));
typedef float f32x4 __attribute__((ext_vector_type(4)));
typedef unsigned u32x4 __attribute__((ext_vector_type(4)));
constexpr int BM = 256, BK = 64, HALF = 128, HTB = HALF * BK * 2  , STAGE_BYTES = 8 * HTB, NXCD = 8, WGM = 8;

__host__ __device__ __forceinline__ int lds_byte(int r, int c) { const int st = (r >> 4) * 2 + (c >> 5), rr = r & 15, cc = c & 31, ob = rr * 64 + cc * 2; return st * 1024 + (ob ^ (((ob >> 9) & 1) << 5)); }
__host__ __device__ __forceinline__ void stage_rc(int b, int& R, int& C) { const int st = b / 1024, sb = b % 1024, swz = sb ^ (((sb >> 9) & 1) << 5); R = (st >> 1) * 16 + swz / 64; C = (st & 1) * 32 + (swz % 64) / 2; }
__host__ __device__ __forceinline__ int perm32(int rho) { const int n = rho >> 4, i = rho & 15; return 8 * (i >> 2) + 4 * n + (i & 3); }

struct Unit { int pm, pn, lm, ln; };
struct Gemm { const bf16_t* A; const bf16_t* Bt; int M, N, K; };

struct StaticOrder {
    int nM, nN, nwg, G, c, dup, epi2, same, i0, i1;
    __host__ __device__ void init(int M, int N, int G_, int c_, int dup_ = 0, int epi2_ = 0, int same_ = 0, int i0_ = 0, int i1_ = 1 << 20) { nM = M / BM; nN = N / BM; nwg = nM * nN; G = G_; c = c_; dup = dup_; epi2 = epi2_; same = same_; i0 = i0_; i1 = i1_; }
    __host__ __device__ bool next(int i, Unit& u) const {
        if (dup) i >>= 1;
        i += i0; if (i >= i1) return false;
        const long L = (long)i * G + c; if (L >= nwg) return false;
        int wgid = (int)L; { const int q = nwg / NXCD, r = nwg % NXCD, xcd = wgid % NXCD, off = wgid / NXCD; wgid = (xcd < r ? xcd * (q + 1) : r * (q + 1) + (xcd - r) * q) + off; }
        const int nig = WGM * nN, gid = wgid / nig, fm = gid * WGM, gsz = (nM - fm) < WGM ? (nM - fm) : WGM;
        u.pm = fm + ((wgid % nig) % gsz); u.pn = (wgid % nig) / gsz;
        { const int ng = nN >> 2, cg = u.pn >> 2; if (cg < ng) u.pn = 4 * ((cg + (int)(L & 7)) % ng) + (u.pn & 3); }
        u.lm = same ? 0 : u.pm; u.ln = same ? 0 : u.pn; return true;
    }
    __device__ __forceinline__ void a_ready(const Unit&) const {}
    __device__ __forceinline__ void done(const Unit&) const {}
};

__device__ __forceinline__ unsigned cvt_pk_bf16(float lo, float hi) { unsigned r; asm volatile("v_cvt_pk_bf16_f32 %0, %1, %2" : "=v"(r) : "v"(lo), "v"(hi)); return r; }
__device__ __forceinline__ float silu_fast(float g) { return g * __builtin_amdgcn_rcpf(1.0f + __builtin_amdgcn_exp2f(-g * 1.4426950408889634f)); }
__device__ __forceinline__ u32x4 pack8(const f32x4 v0, const f32x4 v1) { u32x4 w; w.x = cvt_pk_bf16(v0[0], v0[1]); w.y = cvt_pk_bf16(v0[2], v0[3]); w.z = cvt_pk_bf16(v1[0], v1[1]); w.w = cvt_pk_bf16(v1[2], v1[3]); return w; }
struct EpiFoxIn {
    static constexpr bool PERM = true, AFTER_DRAIN = false;
    bf16_t *Q, *K, *V, *G; float* LOGF; const float* R0; const float* bfb; unsigned* KMAX;
    __device__ __forceinline__ void operator()(const f32x4 (&acc)[2][2][4][2], const Unit& u, int wr, int wc, int fr, int fq) const {
        const int row0 = u.pm * BM + wr * 64 + fr, pn = u.pn;
        float rs[2][4];
#pragma unroll
        for (int ai = 0; ai < 2; ++ai)
#pragma unroll
            for (int m = 0; m < 4; ++m) rs[ai][m] = R0[row0 + ai * HALF + m * 16];
        {
            const int reg = pn >> 3; bf16_t* base = reg == 0 ? Q : reg == 1 ? K : reg == 2 ? V : G; float kmx[2] = {0.f, 0.f};
            const int col0 = (pn & 7) * BM + wc * 32 + 8 * fq;
#pragma unroll
            for (int ai = 0; ai < 2; ++ai)
#pragma unroll
                for (int m = 0; m < 4; ++m) { const int row = row0 + ai * HALF + m * 16; const float r = rs[ai][m]; const float sc = reg == 0 ? r * C2 : r;
#pragma unroll
                    for (int bj = 0; bj < 2; ++bj) { f32x4 v0 = acc[ai][bj][m][0] * sc, v1 = acc[ai][bj][m][1] * sc;
                        if (reg == 3) {
#pragma unroll
                            for (int j = 0; j < 4; ++j) { v0[j] = silu_fast(v0[j]); v1[j] = silu_fast(v1[j]); } }
                        if (reg == 1) { float ss = ((v0[0] * v0[0] + v0[1] * v0[1]) + (v0[2] * v0[2] + v0[3] * v0[3])) + ((v1[0] * v1[0] + v1[1] * v1[1]) + (v1[2] * v1[2] + v1[3] * v1[3]));
                            ss += __shfl_xor(ss, 16); ss += __shfl_xor(ss, 32); kmx[bj] = fmaxf(kmx[bj], ss); }
                        __builtin_nontemporal_store(pack8(v0, v1), (u32x4*)(base + hm_off(row, col0 + bj * HALF, NH))); } }
            if (reg == 1) {
#pragma unroll
                for (int bj = 0; bj < 2; ++bj) { float mx = kmx[bj];
#pragma unroll
                    for (int o = 1; o < 16; o <<= 1) mx = fmaxf(mx, __shfl_xor(mx, o));
                    if (fr == 0 && fq == 0) atomicMax(KMAX + ((row0 >> 12) * NH + (pn & 7) * 4 + bj * 2 + (wc >> 1)) * 2 + (wc & 1), __float_as_uint(mx)); } }
        }
    }
};
struct EpiSwaIn {
    static constexpr bool PERM = true, AFTER_DRAIN = false;
    bf16_t *Q, *K, *V, *G; const float* SS; const float* ROPE;
    __device__ __forceinline__ void operator()(const f32x4 (&acc)[2][2][4][2], const Unit& u, int wr, int wc, int fr, int fq) const {
        const int row0 = u.pm * BM + wr * 64 + fr, pn = u.pn;
        bf16_t* base; int pitch, colt; float osc = 1.f; const bool rope = pn <= 8, gate = pn >= 10;
        if (pn < 8) { base = Q; pitch = DM; colt = pn * BM; osc = C2; } else if (pn == 8) { base = K; pitch = KVW; colt = 0; } else if (pn == 9) { base = V; pitch = KVW; colt = 0; } else { base = G; pitch = DM; colt = (pn - 10) * BM; }
        const int col0 = colt + wc * 32 + 8 * fq; const bool rotw = rope && ((wc & 1) == 0); const float sgn = fq == 0 ? -1.f : 1.f; const bool rotl = fq < 2;
        float rs[2][4];
#pragma unroll
        for (int ai = 0; ai < 2; ++ai)
#pragma unroll
            for (int m = 0; m < 4; ++m) rs[ai][m] = SS[row0 + ai * HALF + m * 16];
        f32x4 nc0, nc1, ns0, ns1;
        if (rotw) { const float* rp = ROPE + (size_t)(row0 & 4095) * 16; nc0 = *(const f32x4*)rp; nc1 = *(const f32x4*)(rp + 4); ns0 = *(const f32x4*)(rp + 8); ns1 = *(const f32x4*)(rp + 12); }
#pragma unroll
        for (int ai = 0; ai < 2; ++ai)
#pragma unroll
            for (int m = 0; m < 4; ++m) { const int row = row0 + ai * HALF + m * 16; const float r = 1.0f / sqrtf(rs[ai][m] * (1.f / DM) + RMS_EPS);
                const f32x4 c0 = nc0, c1 = nc1, s0 = ns0, s1 = ns1;
                if (rotw && (ai * 4 + m) < 7) { const int nrow = row0 + ((ai * 4 + m + 1) >> 2) * HALF + ((ai * 4 + m + 1) & 3) * 16; const float* rp = ROPE + (size_t)(nrow & 4095) * 16; nc0 = *(const f32x4*)rp; nc1 = *(const f32x4*)(rp + 4); ns0 = *(const f32x4*)(rp + 8); ns1 = *(const f32x4*)(rp + 12); }
#pragma unroll
                for (int bj = 0; bj < 2; ++bj) { f32x4 v0 = acc[ai][bj][m][0] * r, v1 = acc[ai][bj][m][1] * r;
                    if (rotw) {
#pragma unroll
                        for (int j = 0; j < 4; ++j) { const float p0 = __shfl_xor(v0[j], 16), p1 = __shfl_xor(v1[j], 16);
                            const float n0 = v0[j] * c0[j] + sgn * p0 * s0[j], n1 = v1[j] * c1[j] + sgn * p1 * s1[j];
                            v0[j] = rotl ? n0 : v0[j]; v1[j] = rotl ? n1 : v1[j]; } }
                    if (gate) {
#pragma unroll
                        for (int j = 0; j < 4; ++j) { v0[j] = silu_fast(v0[j]); v1[j] = silu_fast(v1[j]); } }
                    v0 = v0 * osc; v1 = v1 * osc;
                    *(u32x4*)(base + hm_off(row, col0 + bj * HALF, pitch >> 6)) = pack8(v0, v1); } }
    }
};
template <bool FIRST> struct EpiRes {
    static constexpr bool PERM = true, AFTER_DRAIN = false;
    const float* xin; bf16_t* XB; float* SS;
    __device__ __forceinline__ void operator()(const f32x4 (&acc)[2][2][4][2], const Unit& u, int wr, int wc, int fr, int fq) const {
        const int row0 = u.pm * BM + wr * 64 + fr, col0 = u.pn * BM + wc * 32 + 8 * fq;
        if (FIRST) {
            f32x4 nx[2][2];
#pragma unroll
            for (int bj = 0; bj < 2; ++bj)
#pragma unroll
                for (int n = 0; n < 2; ++n) nx[bj][n] = *(const f32x4*)(xin + (size_t)row0 * DM + col0 + bj * HALF + n * 4);
#pragma unroll
            for (int ai = 0; ai < 2; ++ai)
#pragma unroll
                for (int m = 0; m < 4; ++m) { const int row = row0 + ai * HALF + m * 16; float ss = 0.f;
                    f32x4 cx[2][2];
#pragma unroll
                    for (int bj = 0; bj < 2; ++bj)
#pragma unroll
                        for (int n = 0; n < 2; ++n) cx[bj][n] = nx[bj][n];
                    if ((ai * 4 + m) < 7) { const int nrow = row0 + ((ai * 4 + m + 1) >> 2) * HALF + ((ai * 4 + m + 1) & 3) * 16;
#pragma unroll
                        for (int bj = 0; bj < 2; ++bj)
#pragma unroll
                            for (int n = 0; n < 2; ++n) nx[bj][n] = *(const f32x4*)(xin + (size_t)nrow * DM + col0 + bj * HALF + n * 4); }
#pragma unroll
                    for (int bj = 0; bj < 2; ++bj) { const f32x4 x0 = cx[bj][0] + acc[ai][bj][m][0], x1 = cx[bj][1] + acc[ai][bj][m][1];
                        *(u32x4*)(XB + tiled_off(row, col0 + bj * HALF)) = pack8(x0, x1);
                        ss += ((x0[0] * x0[0] + x0[1] * x0[1]) + (x0[2] * x0[2] + x0[3] * x0[3])) + ((x1[0] * x1[0] + x1[1] * x1[1]) + (x1[2] * x1[2] + x1[3] * x1[3])); }
                    ss += __shfl_xor(ss, 16); ss += __shfl_xor(ss, 32); if (fq == 0) atomicAdd(SS + row, ss); }
        } else {
            u32x4 xv[2][4][2];
#pragma unroll
            for (int ai = 0; ai < 2; ++ai)
#pragma unroll
                for (int m = 0; m < 4; ++m)
#pragma unroll
                    for (int bj = 0; bj < 2; ++bj) xv[ai][m][bj] = *(const u32x4*)(XB + tiled_off(row0 + ai * HALF + m * 16, col0 + bj * HALF));
#pragma unroll
            for (int ai = 0; ai < 2; ++ai)
#pragma unroll
                for (int m = 0; m < 4; ++m)
#pragma unroll
                    for (int bj = 0; bj < 2; ++bj) { const u32x4 xw = xv[ai][m][bj]; const f32x4 a0 = acc[ai][bj][m][0], a1 = acc[ai][bj][m][1];
                        const f32x4 y0 = {__uint_as_float(xw.x << 16) + a0[0], __uint_as_float(xw.x & 0xffff0000u) + a0[1], __uint_as_float(xw.y << 16) + a0[2], __uint_as_float(xw.y & 0xffff0000u) + a0[3]};
                        const f32x4 y1 = {__uint_as_float(xw.z << 16) + a1[0], __uint_as_float(xw.z & 0xffff0000u) + a1[1], __uint_as_float(xw.w << 16) + a1[2], __uint_as_float(xw.w & 0xffff0000u) + a1[3]};
                        *(u32x4*)(XB + tiled_off(row0 + ai * HALF + m * 16, col0 + bj * HALF)) = pack8(y0, y1); }
        }
    }
};
template <class Epi, class Sched, bool ALIGN_EPI = false, bool SP2 = false>
__device__ __forceinline__ void gemm_phase(PG8_LAS unsigned char* lds, const Gemm g, const Sched& S, const Epi& E) {
    const int tid = threadIdx.x, wid = __builtin_amdgcn_readfirstlane(tid >> 6), lane = tid & 63, wr = wid >> 2, wc = wid & 3, fr = lane & 15, fq = lane >> 4;
    const int K = g.K, nt = K / BK;
    unsigned voffA[2], voffB[2];
#pragma unroll
    for (int i = 0; i < 2; ++i) { int R, C; stage_rc(tid * 16 + i * 8192, R, C); const int Rb = Epi::PERM ? ((R & ~31) + perm32(R & 31)) : R;
        voffA[i] = (unsigned)((C >> 5) * (BM * 32) + R * 32 + (C & 31)) * 2u; voffB[i] = (unsigned)((C >> 5) * (BM * 32) + Rb * 32 + (C & 31)) * 2u; }
    const size_t kstep = (size_t)(BM * BK * 2);
    const size_t hstep = (size_t)(HALF * 32 * 2);
    const size_t tstep = (size_t)BM * K * 2;
    const unsigned ldsw = (unsigned)wid * 1024u;
    const int aoff = lds_byte(wr * 64 + fr, fq * 8), boff = lds_byte(wc * 32 + fr, fq * 8);
#define PG8_SA(b, h) (((b) * 2 + (h)) * HTB)
#define PG8_SB(b, h) ((4 + (b) * 2 + (h)) * HTB)
#define PG8_STAGE(bufoff, gbase, voff) do { _Pragma("unroll") for (int _i = 0; _i < 2; ++_i) \
        __builtin_amdgcn_global_load_lds((const unsigned*)((const char*)(gbase) + (voff)[_i]), (PG8_LAS unsigned*)(lds + (bufoff) + ldsw + _i * 8192), 16, 0, 0); } while (0)
#define PG8_LDA(dst, b, h) do { _Pragma("unroll") for (int m = 0; m < 4; ++m) _Pragma("unroll") for (int k = 0; k < 2; ++k) dst[m][k] = *(const PG8_LAS bf16x8*)(lds + PG8_SA(b, h) + aoff + m * 2048 + k * 1024); } while (0)
#define PG8_LDB(dst, b, h) do { _Pragma("unroll") for (int n = 0; n < 2; ++n) _Pragma("unroll") for (int k = 0; k < 2; ++k) dst[n][k] = *(const PG8_LAS bf16x8*)(lds + PG8_SB(b, h) + boff + n * 2048 + k * 1024); } while (0)
#define PG8_MMA(ai, bj, At, Bt) do { __builtin_amdgcn_s_setprio(1); _Pragma("unroll") for (int m = 0; m < 4; ++m) _Pragma("unroll") for (int n = 0; n < 2; ++n) _Pragma("unroll") for (int k = 0; k < 2; ++k) \
        acc[ai][bj][m][n] = __builtin_amdgcn_mfma_f32_16x16x32_bf16(Bt[n][k], At[m][k], acc[ai][bj][m][n], 0, 0, 0); __builtin_amdgcn_s_setprio(0); } while (0)
#define PG8_WAIT_V(n) asm volatile("s_waitcnt vmcnt(" #n ")" ::: "memory")
#define PG8_WAIT_L(n) asm volatile("s_waitcnt lgkmcnt(" #n ")" ::: "memory")
#define PG8_BAR __builtin_amdgcn_s_barrier()
#define PG8_SCHED __builtin_amdgcn_sched_barrier(0)
    Unit cur, nxt; int ui = 0;
    if (!S.next(0, cur)) return;
    f32x4 acc[2][2][4][2];
#pragma unroll
    for (int a = 0; a < 2; ++a)
#pragma unroll
        for (int b = 0; b < 2; ++b)
#pragma unroll
            for (int m = 0; m < 4; ++m)
#pragma unroll
                for (int n = 0; n < 2; ++n) acc[a][b][m][n] = (f32x4){0.f, 0.f, 0.f, 0.f};
    bf16x8 At[4][2], B0[2][2], B1[2][2];
    const char* cA = (const char*)g.A + (size_t)cur.lm * tstep; const char* cB = (const char*)g.Bt + (size_t)cur.ln * tstep;
    S.a_ready(cur);
    if constexpr (SP2) {
        PG8_STAGE(PG8_SB(0, 0), cB, voffB); PG8_STAGE(PG8_SB(0, 1), cB + hstep, voffB); PG8_STAGE(PG8_SA(0, 0), cA, voffA); PG8_STAGE(PG8_SA(0, 1), cA + hstep, voffA);
        if (wr == 1) PG8_BAR;
        PG8_WAIT_V(2); PG8_BAR;
        PG8_STAGE(PG8_SB(1, 0), cB + kstep, voffB); PG8_STAGE(PG8_SA(1, 0), cA + kstep, voffA); PG8_STAGE(PG8_SB(1, 1), cB + hstep + kstep, voffB);
        PG8_WAIT_V(6); PG8_BAR;
    } else {
        PG8_STAGE(PG8_SB(0, 0), cB, voffB); PG8_STAGE(PG8_SA(0, 0), cA, voffA); PG8_STAGE(PG8_SB(0, 1), cB + hstep, voffB); PG8_STAGE(PG8_SA(0, 1), cA + hstep, voffA);
        if (wr == 1) PG8_BAR;
        PG8_WAIT_V(4); PG8_BAR;
        PG8_STAGE(PG8_SB(1, 0), cB + kstep, voffB); PG8_STAGE(PG8_SA(1, 0), cA + kstep, voffA); PG8_STAGE(PG8_SB(1, 1), cB + hstep + kstep, voffB);
        PG8_WAIT_V(6); PG8_BAR;
    }
    for (;;) {
        const bool has_next = S.next(ui + 1, nxt);
        const char* nA = has_next ? (const char*)g.A + (size_t)nxt.lm * tstep : cA; const char* nB = has_next ? (const char*)g.Bt + (size_t)nxt.ln * tstep : cB;
        for (int t = 0; t < nt; t += 2) {
            const bool last = (t == nt - 2);
            const char* a1 = cA + (size_t)(t + 1) * kstep;
            const char* a2 = last ? nA : cA + (size_t)(t + 2) * kstep; const char* b2 = last ? nB : cB + (size_t)(t + 2) * kstep;
            const char* a3 = a2 + kstep; const char* b3 = b2 + kstep;
            if (last && has_next) S.a_ready(nxt);
            if constexpr (SP2) {
            PG8_LDB(B0, 0, 0); PG8_LDB(B1, 0, 1); PG8_SCHED; PG8_LDA(At, 0, 0); PG8_STAGE(PG8_SA(1, 0), a1, voffA); PG8_STAGE(PG8_SA(1, 1), a1 + hstep, voffA);
            PG8_WAIT_V(8); PG8_WAIT_L(0); PG8_BAR; PG8_MMA(0, 0, At, B0); PG8_MMA(0, 1, At, B1); PG8_BAR; PG8_SCHED;
            PG8_LDA(At, 0, 1); PG8_STAGE(PG8_SB(0, 0), b2, voffB); PG8_STAGE(PG8_SB(0, 1), b2 + hstep, voffB);
            PG8_WAIT_V(6); PG8_WAIT_L(0); PG8_BAR; PG8_MMA(1, 0, At, B0); PG8_MMA(1, 1, At, B1); PG8_BAR; PG8_SCHED;
            PG8_LDB(B0, 1, 0); PG8_LDB(B1, 1, 1); PG8_SCHED; PG8_LDA(At, 1, 0); PG8_STAGE(PG8_SA(0, 0), a2, voffA); PG8_STAGE(PG8_SA(0, 1), a2 + hstep, voffA);
            PG8_WAIT_V(8); PG8_WAIT_L(0); PG8_BAR; PG8_MMA(0, 0, At, B0); PG8_MMA(0, 1, At, B1); PG8_BAR; PG8_SCHED;
            PG8_LDA(At, 1, 1); PG8_STAGE(PG8_SB(1, 0), b3, voffB); PG8_STAGE(PG8_SB(1, 1), b3 + hstep, voffB);
            PG8_WAIT_V(6); PG8_WAIT_L(0); PG8_BAR; PG8_MMA(1, 0, At, B0); PG8_MMA(1, 1, At, B1); PG8_BAR; PG8_SCHED;
            } else {
            PG8_LDB(B0, 0, 0); PG8_SCHED; PG8_LDA(At, 0, 0); PG8_STAGE(PG8_SA(1, 1), a1 + hstep, voffA);
            PG8_WAIT_L(8); PG8_BAR; PG8_WAIT_L(0); PG8_MMA(0, 0, At, B0); PG8_BAR; PG8_SCHED;
            PG8_LDB(B1, 0, 1); PG8_STAGE(PG8_SB(0, 0), b2, voffB);
            PG8_BAR; PG8_WAIT_L(0); PG8_MMA(0, 1, At, B1); PG8_BAR;
            PG8_LDA(At, 0, 1); PG8_STAGE(PG8_SA(0, 0), a2, voffA);
            PG8_BAR; PG8_WAIT_L(0); PG8_MMA(1, 0, At, B0); PG8_BAR; PG8_SCHED;
            PG8_STAGE(PG8_SB(0, 1), b2 + hstep, voffB);
            PG8_WAIT_V(6); PG8_BAR; PG8_MMA(1, 1, At, B1); PG8_BAR;
            PG8_LDB(B0, 1, 0); PG8_SCHED; PG8_LDA(At, 1, 0); PG8_STAGE(PG8_SA(0, 1), a2 + hstep, voffA);
            PG8_WAIT_L(8); PG8_BAR; PG8_WAIT_L(0); PG8_MMA(0, 0, At, B0); PG8_BAR; PG8_SCHED;
            PG8_LDB(B1, 1, 1); PG8_STAGE(PG8_SB(1, 0), b3, voffB);
            PG8_BAR; PG8_WAIT_L(0); PG8_MMA(0, 1, At, B1); PG8_BAR;
            PG8_LDA(At, 1, 1); PG8_STAGE(PG8_SA(1, 0), a3, voffA);
            PG8_BAR; PG8_WAIT_L(0); PG8_MMA(1, 0, At, B0); PG8_BAR; PG8_SCHED;
            PG8_STAGE(PG8_SB(1, 1), b3 + hstep, voffB);
            PG8_WAIT_V(6); PG8_BAR; PG8_MMA(1, 1, At, B1); PG8_BAR;
            }
        }
        if constexpr (ALIGN_EPI) { if (wr == 0) PG8_BAR; }
        if constexpr (!Epi::AFTER_DRAIN) { E(acc, cur, wr, wc, fr, fq); if (S.epi2) E(acc, cur, wr, wc, fr, fq); S.done(cur); }
        if (!has_next) break;
#pragma unroll
        for (int a = 0; a < 2; ++a)
#pragma unroll
            for (int b = 0; b < 2; ++b)
#pragma unroll
                for (int m = 0; m < 4; ++m)
#pragma unroll
                    for (int n = 0; n < 2; ++n) acc[a][b][m][n] = (f32x4){0.f, 0.f, 0.f, 0.f};
        cur = nxt; cA = nA; cB = nB; ++ui;
        if constexpr (ALIGN_EPI) { if (wr == 1) PG8_BAR; }
    }
    PG8_WAIT_V(0);
    if constexpr (!ALIGN_EPI) { if (wr == 0) PG8_BAR; }
    PG8_BAR;
    if constexpr (Epi::AFTER_DRAIN) { E.fused(acc, cur, wr, wc, fr, fq, lds, wid, lane); S.done(cur); }
#undef PG8_SA
#undef PG8_SB
#undef PG8_STAGE
#undef PG8_LDA
#undef PG8_LDB
#undef PG8_MMA
#undef PG8_WAIT_V
#undef PG8_WAIT_L
#undef PG8_BAR
#undef PG8_SCHED
}
}
namespace fa {
#define FA_LAS __attribute__((address_space(3)))
typedef short bf16x8 __attribute__((ext_vector_type(8)));
typedef short s16x4 __attribute__((ext_vector_type(4)));
typedef short v4i16_t __attribute__((ext_vector_type(4)));
typedef float f32x16 __attribute__((ext_vector_type(16)));
typedef float f32x4 __attribute__((ext_vector_type(4)));
typedef unsigned u32x4 __attribute__((ext_vector_type(4)));
typedef float f32x2_t __attribute__((ext_vector_type(2))); typedef __bf16 bf16x2_t __attribute__((ext_vector_type(2)));
constexpr float THR = 8.f, TH_SKIP = 32.f;
constexpr int F_KBUF = 18432, F_AOFF = 8192, F_VOFF = 10240, F_WSF = 3 * F_KBUF, F_FLAG = F_WSF + 8 * 256, F_OST = F_FLAG + 256, F_LDS_BYTES = F_OST + 8 * 4096;
constexpr int S_KBUF = 16384, S_VOFF = 8192, S_WSF = 6 * S_KBUF, S_OST = S_WSF + 8 * 256, S_LDS_BYTES = S_OST + 8 * 4096;
struct Params { const bf16_t* Q; const bf16_t* K; const bf16_t* V; const bf16_t* G; bf16_t* O; const float* CUM; const float* sinks; const unsigned* KMAX; unsigned* ticket; const bf16_t* KAUG; };
__device__ __forceinline__ unsigned cvtpk(float lo, float hi) { f32x2_t v = {lo, hi}; bf16x2_t b = __builtin_convertvector(v, bf16x2_t); return __builtin_bit_cast(unsigned, b); }
__device__ __forceinline__ s16x4 vtr(FA_LAS unsigned char* p) { return __builtin_bit_cast(s16x4, __builtin_amdgcn_ds_read_tr16_b64_v4i16((FA_LAS v4i16_t*)p)); }
__device__ __forceinline__ float swap_max(float v) { auto rr = __builtin_amdgcn_permlane32_swap(__float_as_uint(v), __float_as_uint(v), false, false); return __builtin_fmaxf(__uint_as_float(rr[0]), __uint_as_float(rr[1])); }
__device__ __forceinline__ float swap_add(float v) { auto rr = __builtin_amdgcn_permlane32_swap(__float_as_uint(v), __float_as_uint(v), false, false); return __uint_as_float(rr[0]) + __uint_as_float(rr[1]); }
__device__ __forceinline__ void glds16(const void* gsrc, unsigned lds_dst) { unsigned keep;
    asm volatile("s_mov_b32 %0, m0\n\ts_mov_b32 m0, %2\n\ts_nop 0\n\tglobal_load_lds_dwordx4 %1, off\n\ts_mov_b32 m0, %0" : "=&s"(keep) : "v"(gsrc), "s"(lds_dst) : "memory"); }
#define FA_MFMA(a, b, c) __builtin_amdgcn_mfma_f32_32x32x16_bf16((a), (b), (c), 0, 0, 0)
#define FA_MX3(a, b, c) __builtin_fmaxf(__builtin_fmaxf((a), (b)), (c))
struct WaveSt { bf16x8 qr[4]; bf16x8 qa; f32x16 o0, o1; float cq, mhat, lsum, mrun; };

#define FA_SBAR() __builtin_amdgcn_sched_barrier(0)
#define FA_PIN(x) asm volatile("" : "+v"(x))
#define FA_LDK(p) (*(FA_LAS bf16x8*)(p))
#define FA_VF(l, h) ((bf16x8){l[0], l[1], l[2], l[3], h[0], h[1], h[2], h[3]})
#define FA_EX4(X, B) do { X[B] = __builtin_amdgcn_exp2f(X[B]); X[B + 1] = __builtin_amdgcn_exp2f(X[B + 1]); X[B + 2] = __builtin_amdgcn_exp2f(X[B + 2]); X[B + 3] = __builtin_amdgcn_exp2f(X[B + 3]); } while (0)
__device__ __forceinline__ void split3(float v, unsigned& h1, unsigned& h2, unsigned& h3) { const bf16_t a = f2bf(v); const float r1 = v - bf2f(a); const bf16_t b = f2bf(r1); const float r2 = r1 - bf2f(b); h1 = a; h2 = b; h3 = f2bf(r2); }
__device__ __forceinline__ void set_qa(WaveSt& w, int hi) {
    unsigned g1, g2, g3; split3(w.cq - w.mhat, g1, g2, g3);
    const u32x4 q = {hi == 0 ? 0x3F803F80u : 0u, hi == 0 ? (0x3F80u | (g1 << 16)) : 0u, hi == 0 ? (g2 | (g3 << 16)) : 0u, 0u};
    w.qa = __builtin_bit_cast(bf16x8, q);
}
template <int MODE, int AOFF, int VOFF>
__device__ __forceinline__ void tile_full(FA_LAS unsigned char* bb, FA_LAS unsigned char* vprev, FA_LAS float* wsf, WaveSt& w, f32x16& C0, f32x16& C1, f32x16& P0, f32x16& P1,
                                          int k0, int t, int qlo, int lane, int r32, int hi) {
    constexpr int W = MODE == 0 ? 0x40000000 : 128;
    FA_LAS unsigned char* kp = bb + hi * 1024 + r32 * 16; FA_LAS unsigned char* ap = bb + AOFF + r32 * 16;
    FA_LAS unsigned char* vp = vprev + VOFF + ((lane >> 4) & 1) * 32 + (lane & 3) * 8 + (4 * hi + ((lane & 15) >> 2)) * 64;
    bf16x8 kf0 = FA_LDK(kp), kf1 = FA_LDK(kp + 512), kf2 = FA_LDK(kp + 2048), kf3 = FA_LDK(kp + 2560), kf4, kf5, kf6, kf7, ka0, ka1;
    s16x4 vl0, vh0, vl1, vh1, vl2, vh2, vl3, vh3, vl4, vh4, vl5, vh5, vl6, vh6, vl7, vh7;
    u32x4 pw0, pw1, pw2, pw3; float sacc;
    const f32x16 Z = {0.f, 0.f, 0.f, 0.f, 0.f, 0.f, 0.f, 0.f, 0.f, 0.f, 0.f, 0.f, 0.f, 0.f, 0.f, 0.f};
    FA_SBAR();
    C0 = FA_MFMA(kf0, w.qr[0], Z); kf4 = FA_LDK(kp + 4096);
    sacc = (P0[0] + P0[1]) + (P0[2] + P0[3]); pw0.x = cvtpk(P0[0], P0[1]); pw0.y = cvtpk(P0[2], P0[3]); FA_PIN(sacc); FA_PIN(pw0.x); FA_PIN(pw0.y);
    FA_SBAR();
    C1 = FA_MFMA(kf1, w.qr[0], Z); kf5 = FA_LDK(kp + 4608);
    sacc += P0[4]; sacc += P0[5]; sacc += P0[6]; sacc += P0[7]; pw0.z = cvtpk(P0[4], P0[5]); pw0.w = cvtpk(P0[6], P0[7]); FA_PIN(sacc); FA_PIN(pw0.z); FA_PIN(pw0.w);
    FA_SBAR();
    C0 = FA_MFMA(kf2, w.qr[1], C0); kf6 = FA_LDK(kp + 6144);
    sacc += P0[8]; sacc += P0[9]; sacc += P0[10]; sacc += P0[11]; pw1.x = cvtpk(P0[8], P0[9]); pw1.y = cvtpk(P0[10], P0[11]); FA_PIN(sacc); FA_PIN(pw1.x); FA_PIN(pw1.y);
    FA_SBAR();
    C1 = FA_MFMA(kf3, w.qr[1], C1); kf7 = FA_LDK(kp + 6656);
    sacc += P0[12]; sacc += P0[13]; sacc += P0[14]; sacc += P0[15]; pw1.z = cvtpk(P0[12], P0[13]); pw1.w = cvtpk(P0[14], P0[15]); FA_PIN(sacc); FA_PIN(pw1.z); FA_PIN(pw1.w);
    FA_SBAR();
    C0 = FA_MFMA(kf4, w.qr[2], C0); if (MODE == 0) { ka0 = FA_LDK(ap); ka1 = FA_LDK(ap + 512); } else { const u32x4 kc = {0u, 0x3F800000u, 0x3F803F80u, 0u}; ka0 = __builtin_bit_cast(bf16x8, kc); ka1 = ka0; }
    sacc += P1[0]; sacc += P1[1]; sacc += P1[2]; sacc += P1[3]; pw2.x = cvtpk(P1[0], P1[1]); pw2.y = cvtpk(P1[2], P1[3]); FA_PIN(sacc); FA_PIN(pw2.x); FA_PIN(pw2.y);
    FA_SBAR();
    C1 = FA_MFMA(kf5, w.qr[2], C1); vl0 = vtr(vp); vh0 = vtr(vp + 512);
    sacc += P1[4]; sacc += P1[5]; sacc += P1[6]; sacc += P1[7]; pw2.z = cvtpk(P1[4], P1[5]); pw2.w = cvtpk(P1[6], P1[7]); FA_PIN(sacc); FA_PIN(pw2.z); FA_PIN(pw2.w);
    FA_SBAR();
    C0 = FA_MFMA(kf6, w.qr[3], C0); vl4 = vtr(vp + 4096); vh4 = vtr(vp + 4096 + 512);
    sacc += P1[8]; sacc += P1[9]; sacc += P1[10]; sacc += P1[11]; pw3.x = cvtpk(P1[8], P1[9]); pw3.y = cvtpk(P1[10], P1[11]); FA_PIN(sacc); FA_PIN(pw3.x); FA_PIN(pw3.y);
    FA_SBAR();
    C1 = FA_MFMA(kf7, w.qr[3], C1); vl1 = vtr(vp + 1024); vh1 = vtr(vp + 1024 + 512);
    sacc += P1[12]; sacc += P1[13]; sacc += P1[14]; sacc += P1[15]; pw3.z = cvtpk(P1[12], P1[13]); pw3.w = cvtpk(P1[14], P1[15]); FA_PIN(sacc); FA_PIN(pw3.z); FA_PIN(pw3.w);
    FA_SBAR();
    C0 = FA_MFMA(ka0, w.qa, C0); vl5 = vtr(vp + 4096 + 1024); vh5 = vtr(vp + 4096 + 1024 + 512); FA_SBAR();
    C1 = FA_MFMA(ka1, w.qa, C1); FA_SBAR();
    w.lsum += sacc;
    const bf16x8 pa0 = __builtin_bit_cast(bf16x8, pw0), pa1 = __builtin_bit_cast(bf16x8, pw1), pa2 = __builtin_bit_cast(bf16x8, pw2), pa3 = __builtin_bit_cast(bf16x8, pw3);
    vl2 = vtr(vp + 2048); vh2 = vtr(vp + 2048 + 512);
    w.o0 = FA_MFMA(pa0, FA_VF(vl0, vh0), w.o0); vl6 = vtr(vp + 4096 + 2048); vh6 = vtr(vp + 4096 + 2048 + 512);
    w.o1 = FA_MFMA(pa0, FA_VF(vl4, vh4), w.o1);
    FA_SBAR();
    if ((k0 + 63 > qlo) || (MODE == 1 && k0 <= qlo + 31 - W)) {
        const float NEG = -__builtin_inff(); const int dq = t - k0 - 4 * hi;
#pragma unroll
        for (int r = 0; r < 16; ++r) { const int c = (r & 3) + 8 * (r >> 2); if ((unsigned)(dq - c) >= (unsigned)W) C0[r] = NEG; if ((unsigned)(dq - c - 32) >= (unsigned)W) C1[r] = NEG; }
    }
    float ma = FA_MX3(C0[0], C0[1], C1[0]), mb = FA_MX3(C0[2], C0[3], C1[1]); ma = FA_MX3(ma, C1[2], C1[3]);
#pragma unroll
    for (int r = 4; r < 16; r += 4) { ma = FA_MX3(ma, C0[r], C0[r + 1]); mb = FA_MX3(mb, C0[r + 2], C0[r + 3]); ma = FA_MX3(ma, C1[r], C1[r + 1]); mb = FA_MX3(mb, C1[r + 2], C1[r + 3]); }
    const float rm = swap_max(__builtin_fmaxf(ma, mb));
    if (MODE == 0) w.mrun = __builtin_fmaxf(w.mrun, rm + w.mhat);
    const bool resc = __any(rm > THR);
    if (resc) {
        const float dl = __builtin_fmaxf(rm, 0.f); w.mhat += dl;
#pragma unroll
        for (int r = 0; r < 16; ++r) { C0[r] -= dl; C1[r] -= dl; }
        set_qa(w, hi);
        const float f = __builtin_amdgcn_exp2f(-dl); w.lsum *= f;
        if (hi == 0) wsf[r32] = f;
    }
    FA_SBAR();
    FA_EX4(C0, 0); FA_PIN(C0); vl3 = vtr(vp + 3072); vh3 = vtr(vp + 3072 + 512);
    w.o0 = FA_MFMA(pa1, FA_VF(vl1, vh1), w.o0); FA_EX4(C0, 4); FA_EX4(C0, 8); FA_PIN(C0); vl7 = vtr(vp + 4096 + 3072); vh7 = vtr(vp + 4096 + 3072 + 512); FA_SBAR();
    w.o1 = FA_MFMA(pa1, FA_VF(vl5, vh5), w.o1); FA_EX4(C0, 12); FA_PIN(C0); FA_EX4(C1, 0); FA_PIN(C1); FA_SBAR();
    w.o0 = FA_MFMA(pa2, FA_VF(vl2, vh2), w.o0); FA_EX4(C1, 4); FA_PIN(C1); FA_SBAR();
    w.o1 = FA_MFMA(pa2, FA_VF(vl6, vh6), w.o1); FA_EX4(C1, 8); FA_PIN(C1); FA_SBAR();
    w.o0 = FA_MFMA(pa3, FA_VF(vl3, vh3), w.o0); FA_EX4(C1, 12); FA_PIN(C1); FA_SBAR();
    w.o1 = FA_MFMA(pa3, FA_VF(vl7, vh7), w.o1); FA_SBAR();
    if (resc) {
        asm volatile("s_waitcnt lgkmcnt(0)" ::: "memory");
#pragma unroll
        for (int g = 0; g < 4; ++g) { const f32x4 a4 = *(FA_LAS f32x4*)(wsf + 8 * g + 4 * hi);
#pragma unroll
            for (int i = 0; i < 4; ++i) { w.o0[4 * g + i] *= a4[i]; w.o1[4 * g + i] *= a4[i]; } }
    }
}
template <int VOFF>
__device__ __forceinline__ void drain_full(FA_LAS unsigned char* vlast, WaveSt& w, f32x16& P0, f32x16& P1, int lane, int hi) {
    FA_LAS unsigned char* vp = vlast + VOFF + ((lane >> 4) & 1) * 32 + (lane & 3) * 8 + (4 * hi + ((lane & 15) >> 2)) * 64;
    float s0 = 0.f, s1 = 0.f;
#pragma unroll
    for (int r = 0; r < 16; ++r) { s0 += P0[r]; s1 += P1[r]; }
    w.lsum += s0 + s1;
    const u32x4 w0 = {cvtpk(P0[0], P0[1]), cvtpk(P0[2], P0[3]), cvtpk(P0[4], P0[5]), cvtpk(P0[6], P0[7])};
    const u32x4 w1 = {cvtpk(P0[8], P0[9]), cvtpk(P0[10], P0[11]), cvtpk(P0[12], P0[13]), cvtpk(P0[14], P0[15])};
    const u32x4 w2 = {cvtpk(P1[0], P1[1]), cvtpk(P1[2], P1[3]), cvtpk(P1[4], P1[5]), cvtpk(P1[6], P1[7])};
    const u32x4 w3 = {cvtpk(P1[8], P1[9]), cvtpk(P1[10], P1[11]), cvtpk(P1[12], P1[13]), cvtpk(P1[14], P1[15])};
    const bf16x8 pa0 = __builtin_bit_cast(bf16x8, w0), pa1 = __builtin_bit_cast(bf16x8, w1), pa2 = __builtin_bit_cast(bf16x8, w2), pa3 = __builtin_bit_cast(bf16x8, w3);
#define FA_PV(ks, pa) do { const s16x4 l0_ = vtr(vp + (ks) * 1024), h0_ = vtr(vp + (ks) * 1024 + 512), l1_ = vtr(vp + 4096 + (ks) * 1024), h1_ = vtr(vp + 4096 + (ks) * 1024 + 512); \
    w.o0 = FA_MFMA(pa, FA_VF(l0_, h0_), w.o0); w.o1 = FA_MFMA(pa, FA_VF(l1_, h1_), w.o1); } while (0)
    FA_PV(0, pa0); FA_PV(1, pa1); FA_PV(2, pa2); FA_PV(3, pa3);
#undef FA_PV
}
__device__ __forceinline__ void load_gate(u32x4 (&gq)[4], const bf16_t* G, size_t grow, int h, int lane) {
#pragma unroll
    for (int d0 = 0; d0 < 2; ++d0)
#pragma unroll
        for (int i = 0; i < 2; ++i) gq[2 * d0 + i] = *(const u32x4*)(G + hm_off((int)grow + i * 16 + (lane >> 2), h * 64 + d0 * 32 + (lane & 3) * 8, NH));
}
__device__ __forceinline__ void wave_epilogue(FA_LAS float* stg, FA_LAS float* wsf, WaveSt& w, const u32x4 (&gq)[4], bf16_t* O, size_t grow, int h, int lane, int r32, int hi) {
    const float l = swap_add(w.lsum);
    if (hi == 0) wsf[r32] = l;
    asm volatile("s_waitcnt lgkmcnt(0)" ::: "memory");
    float rl[16];
#pragma unroll
    for (int g = 0; g < 4; ++g) { const f32x4 l4 = *(FA_LAS f32x4*)(wsf + 8 * g + 4 * hi);
#pragma unroll
        for (int i = 0; i < 4; ++i) rl[4 * g + i] = 1.0f / l4[i]; }
#pragma unroll
    for (int d0 = 0; d0 < 2; ++d0) {
#pragma unroll
        for (int g = 0; g < 4; ++g)
#pragma unroll
            for (int i = 0; i < 4; ++i) stg[(8 * g + 4 * hi + i) * 32 + r32] = (d0 == 0 ? w.o0[4 * g + i] : w.o1[4 * g + i]) * rl[4 * g + i];
        asm volatile("s_waitcnt lgkmcnt(0)" ::: "memory");
#pragma unroll
        for (int i = 0; i < 2; ++i) { const int row = i * 16 + (lane >> 2), ch = lane & 3;
            const f32x4 x0 = *(FA_LAS f32x4*)(stg + row * 32 + ch * 8), x1 = *(FA_LAS f32x4*)(stg + row * 32 + ch * 8 + 4);
            const size_t ga = (grow + row) * DM + h * 64 + d0 * 32 + ch * 8; const u32x4 gv = gq[2 * d0 + i];
            u32x4 ov;
            ov.x = cvtpk(x0[0] * __uint_as_float(gv.x << 16), x0[1] * __uint_as_float(gv.x & 0xffff0000u)); ov.y = cvtpk(x0[2] * __uint_as_float(gv.y << 16), x0[3] * __uint_as_float(gv.y & 0xffff0000u));
            ov.z = cvtpk(x1[0] * __uint_as_float(gv.z << 16), x1[1] * __uint_as_float(gv.z & 0xffff0000u)); ov.w = cvtpk(x1[2] * __uint_as_float(gv.w << 16), x1[3] * __uint_as_float(gv.w & 0xffff0000u));
            *(u32x4*)(O + tiled_off((int)(grow + row), h * 64 + d0 * 32 + ch * 8)) = ov; }
        asm volatile("s_waitcnt lgkmcnt(0)" ::: "memory");
    }
}
template <int MODE> __device__ __forceinline__ void wave_init(WaveSt& w, int hi) {
#pragma unroll
    for (int r = 0; r < 16; ++r) { w.o0[r] = 0.f; w.o1[r] = 0.f; }
    set_qa(w, hi);
}

__device__ __forceinline__ void fox_unit(FA_LAS unsigned char* lds, const Params& P, int b, int h, int qb) {
    const int tid = threadIdx.x, lane = tid & 63, r32 = lane & 31, hi = lane >> 5;
    const int wid = __builtin_amdgcn_readfirstlane(tid >> 6);
    const int q0 = qb * 256, qlo = q0 + wid * 32, t = qlo + r32;
    const size_t rowbase = (size_t)b * SEQ;
    const bf16_t* ksrc = P.K + hm_off((int)rowbase + lane, h * 64 + wid * 8, NH);
    const bf16_t* vsrc = P.V + hm_off((int)rowbase + 16 * (wid & 3) + (lane >> 2), h * 64 + (wid >> 2) * 32 + (lane & 3) * 8, NH);
    const float* cum = P.CUM + (size_t)(b * NH + h) * SEQ;
    const bf16_t* asrc = P.KAUG + ((size_t)(b * NH + h) * SEQ + lane) * 8;
    const int NT = (q0 + 256) / 64;
    WaveSt w; float qn = 0.f;
#pragma unroll
    for (int d0 = 0; d0 < 4; ++d0) { w.qr[d0] = *(const bf16x8*)(P.Q + hm_off((int)rowbase + t, h * 64 + d0 * 16 + hi * 8, NH));
#pragma unroll
        for (int j = 0; j < 8; ++j) { const float qv = bf2f((bf16_t)w.qr[d0][j]); qn = fmaf(qv, qv, qn); } }
    w.cq = cum[t]; w.mhat = 0.f; w.lsum = 0.f; w.mrun = -1e30f;
    wave_init<0>(w, hi);
    u32x4 gq[4]; load_gate(gq, P.G, rowbase + qlo, h, lane);
    const float qkb = sqrtf(swap_add(qn) * (__uint_as_float(P.KMAX[(b * NH + h) * 2]) + __uint_as_float(P.KMAX[(b * NH + h) * 2 + 1]))) * 1.01f + 1e-3f;
    FA_LAS float* wsf = (FA_LAS float*)(lds + F_WSF) + wid * 64;
    FA_LAS unsigned* votes = (FA_LAS unsigned*)(lds + F_FLAG);
    float cnew = 0.f;
#define FA_LOADT(j, bf) do { const size_t ko_ = (size_t)(j) * 64 * 32; FA_LAS unsigned char* bb_ = lds + (bf) * F_KBUF; \
        glds16(ksrc + ko_, (unsigned)__builtin_amdgcn_readfirstlane((int)(unsigned)(uintptr_t)(bb_ + wid * 1024))); \
        glds16(vsrc + ko_, (unsigned)__builtin_amdgcn_readfirstlane((int)(unsigned)(uintptr_t)(bb_ + F_VOFF + (wid >> 2) * 4096 + (wid & 3) * 1024))); \
        if (wid == 0) glds16(asrc + (size_t)(j) * 64 * 8, (unsigned)__builtin_amdgcn_readfirstlane((int)(unsigned)(uintptr_t)(bb_ + F_AOFF))); \
        cnew = cum[(j) * 64 + 63]; } while (0)
    FA_LOADT(NT - 1, 0); asm volatile("s_waitcnt vmcnt(0)" ::: "memory"); __syncthreads();
    bool wdone = false; int n = 0; f32x16 pA0, pA1, pB0, pB1;
#pragma unroll
    for (int r = 0; r < 16; ++r) { pA0[r] = 0.f; pA1[r] = 0.f; pB0[r] = 0.f; pB1[r] = 0.f; }
    int cur = 0; bool fin = false;
#define FA_WALK(tt, CA0, CA1, PA0, PA1) do { \
        const int j = NT - 1 - (tt), k0 = j * 64; const int nxt = cur == 2 ? 0 : cur + 1, prv = cur == 0 ? 2 : cur - 1; \
        if (j > 0) FA_LOADT(j - 1, nxt); \
        if (!wdone && k0 <= qlo + 31) { FA_LAS unsigned char* bb = lds + cur * F_KBUF; \
            tile_full<0, F_AOFF, F_VOFF>(bb, n > 0 ? lds + prv * F_KBUF : bb, wsf, w, CA0, CA1, PA0, PA1, k0, t, qlo, lane, r32, hi); ++n; } \
        if (j > 0) { \
            if (!wdone && n > 0 && __all(qkb + w.cq - cnew - w.mrun <= -TH_SKIP)) { wdone = true; drain_full<F_VOFF>(lds + cur * F_KBUF, w, CA0, CA1, lane, hi); } \
            if (lane == 0) votes[((tt) & 1) * 8 + wid] = wdone ? 1u : 0u; } \
        asm volatile("s_waitcnt vmcnt(0)" ::: "memory"); \
        __syncthreads(); \
        if (j > 0) { const u32x4 v0 = *(FA_LAS u32x4*)(votes + ((tt) & 1) * 8), v1 = *(FA_LAS u32x4*)(votes + ((tt) & 1) * 8 + 4); \
            if ((v0.x & v0.y & v0.z & v0.w & v1.x & v1.y & v1.z & v1.w) != 0u) fin = true; } \
        else { if (!wdone && n > 0) drain_full<F_VOFF>(lds + cur * F_KBUF, w, CA0, CA1, lane, hi); fin = true; } \
        cur = nxt; } while (0)
    for (int tt = 0; !fin; tt += 2) {
        FA_WALK(tt, pA0, pA1, pB0, pB1);
        if (fin) break;
        FA_WALK(tt + 1, pB0, pB1, pA0, pA1);
    }
#undef FA_WALK
#undef FA_LOADT
    wave_epilogue((FA_LAS float*)(lds + F_OST + wid * 4096), wsf, w, gq, P.O, rowbase + qlo, h, lane, r32, hi);
    __syncthreads();
}
__device__ __forceinline__ void swa_unit(FA_LAS unsigned char* lds, const Params& P, int b, int kvh, int qb, int hh_lo = 0, int hh_hi = 8) {
    const int tid = threadIdx.x, lane = tid & 63, r32 = lane & 31, hi = lane >> 5;
    const int wid = __builtin_amdgcn_readfirstlane(tid >> 6);
    const int q0 = qb * 256, qlo = q0 + wid * 32, t = qlo + r32;
    const size_t rowbase = (size_t)b * SEQ;
    const int j_lo = q0 >= 128 ? (q0 - 128) / 64 : 0, NT = (q0 + 256) / 64 - j_lo;
    const bf16_t* ksrc = P.K + hm_off((int)rowbase + j_lo * 64 + lane, kvh * 64 + wid * 8, 4);
    const bf16_t* vsrc = P.V + hm_off((int)rowbase + j_lo * 64 + 16 * (wid & 3) + (lane >> 2), kvh * 64 + (wid >> 2) * 32 + (lane & 3) * 8, 4);
    for (int i = 0; i < NT; ++i) {
        glds16(ksrc + (size_t)i * 64 * 32, (unsigned)__builtin_amdgcn_readfirstlane((int)(unsigned)(uintptr_t)(lds + i * S_KBUF + wid * 1024)));
        glds16(vsrc + (size_t)i * 64 * 32, (unsigned)__builtin_amdgcn_readfirstlane((int)(unsigned)(uintptr_t)(lds + i * S_KBUF + S_VOFF + (wid >> 2) * 4096 + (wid & 3) * 1024))); }
    asm volatile("s_waitcnt vmcnt(0)" ::: "memory");
    __syncthreads();
    FA_LAS float* wsf = (FA_LAS float*)(lds + S_WSF) + wid * 64;
    const int ta = (qlo >= 127 ? (qlo - 127) / 64 : 0) - j_lo, tb = (qlo + 31) / 64 - j_lo;
    for (int hh = hh_lo; hh < hh_hi; ++hh) {
        const int h = kvh * 8 + hh;
        WaveSt w;
#pragma unroll
        for (int d0 = 0; d0 < 4; ++d0) w.qr[d0] = *(const bf16x8*)(P.Q + hm_off((int)rowbase + t, h * 64 + d0 * 16 + hi * 8, NH));
        u32x4 gq[4]; load_gate(gq, P.G, rowbase + qlo, h, lane);
        w.cq = 0.f; w.mhat = P.sinks[h] * LOG2E; w.lsum = 0.5f; w.mrun = 0.f;
        wave_init<1>(w, hi);
        f32x16 pA0, pA1, pB0, pB1;
#pragma unroll
        for (int r = 0; r < 16; ++r) { pB0[r] = 0.f; pB1[r] = 0.f; }
        for (int ti = tb;;) {
            { FA_LAS unsigned char* bb = lds + ti * S_KBUF;
              tile_full<1, 0, S_VOFF>(bb, ti == tb ? bb : bb + S_KBUF, wsf, w, pA0, pA1, pB0, pB1, (j_lo + ti) * 64, t, qlo, lane, r32, hi); }
            if (ti == ta) { drain_full<S_VOFF>(lds + ta * S_KBUF, w, pA0, pA1, lane, hi); break; }
            --ti;
            { FA_LAS unsigned char* bb = lds + ti * S_KBUF;
              tile_full<1, 0, S_VOFF>(bb, bb + S_KBUF, wsf, w, pB0, pB1, pA0, pA1, (j_lo + ti) * 64, t, qlo, lane, r32, hi); }
            if (ti == ta) { drain_full<S_VOFF>(lds + ta * S_KBUF, w, pB0, pB1, lane, hi); break; }
            --ti;
        }
        wave_epilogue((FA_LAS float*)(lds + S_OST + wid * 4096), wsf, w, gq, P.O, rowbase + qlo, h, lane, r32, hi);
    }
    __syncthreads();
}
}
#define GAS __attribute__((address_space(1)))
#define LAS __attribute__((address_space(3)))
typedef unsigned short bf16;
typedef unsigned v4u __attribute__((ext_vector_type(4)));
typedef float f32x4 __attribute__((ext_vector_type(4)));
typedef short bf16x8 __attribute__((ext_vector_type(8)));
typedef GAS unsigned gu32;
typedef GAS unsigned long long gu64;
#define RLX_AGENT __ATOMIC_RELAXED, __HIP_MEMORY_SCOPE_AGENT
#define LDS_WAIT() asm volatile("s_waitcnt lgkmcnt(0)" ::: "memory")
#define VM_WAIT() asm volatile("s_waitcnt vmcnt(0)" ::: "memory")
__device__ __forceinline__ unsigned long long rt() { return __builtin_amdgcn_s_memrealtime(); }
__device__ __forceinline__ unsigned pk2(float lo, float hi) { return (unsigned)f2bf(lo) | ((unsigned)f2bf(hi) << 16); }
#define XB_TMO      128
#define XB_XCNT(j)  (256  + 64 * (j))
#define XB_XSUB(j)  (1280 + 64 * (j))
#define XB_XGEN(j)  (2304 + 64 * (j))
#define XB_TOP      3328
#define XB_TOPGEN   3392
#define XCD_BAR_WORDS 3456
#define XB_SPIN_CAP (1u << 18)

__device__ __forceinline__ unsigned xb_ld(unsigned* p)              { return __hip_atomic_load(p, __ATOMIC_RELAXED, __HIP_MEMORY_SCOPE_AGENT); }
__device__ __forceinline__ unsigned xb_add(unsigned* p, unsigned v) { return __hip_atomic_fetch_add(p, v, __ATOMIC_RELAXED, __HIP_MEMORY_SCOPE_AGENT); }
__device__ __forceinline__ unsigned xb_xcc_id() { return (unsigned)__builtin_amdgcn_s_getreg((3 << 11) | 20) & 0xFu; }
#define XB_SPIN(cond, bar) do { unsigned _sp = 0; while (cond) { __builtin_amdgcn_s_sleep(1); \
    if ((++_sp & 255u) == 0u) { if (xb_ld(&(bar)[XB_TMO])) break; if (_sp > XB_SPIN_CAP) { atomicAdd(&(bar)[XB_TMO], 1u); break; } } } } while (0)

struct XcdBarrier {
    unsigned* bar; unsigned x;
    volatile LAS unsigned* st;
};

__device__ __forceinline__ XcdBarrier xcd_barrier_post(unsigned* bar, volatile LAS unsigned* st) {
    XcdBarrier b; b.bar = bar; b.x = xb_xcc_id(); b.st = st;
    if (threadIdx.x == 0) (void)xb_add(&bar[XB_XCNT(b.x)], 1u);
    return b;
}
__device__ __forceinline__ void xcd_barrier_complete(unsigned* bar, unsigned x, unsigned& nloc, unsigned& nx) {
    const unsigned G = gridDim.x * gridDim.y * gridDim.z;
    unsigned sum, cnt, mine, sp = 0u;
    for (;;) {
        sum = 0u; cnt = 0u; mine = 0u;
#pragma unroll
        for (unsigned j = 0; j < 16; ++j) { const unsigned c = xb_ld(&bar[XB_XCNT(j)]); sum += c; cnt += (c > 0u) ? 1u : 0u; mine = (j == x) ? c : mine; }
        if (sum == G) break;
        __builtin_amdgcn_s_sleep(1);
        if ((++sp & 255u) == 0u) { if (xb_ld(&bar[XB_TMO])) break; if (sp > XB_SPIN_CAP) { atomicAdd(&bar[XB_TMO], 1u); break; } }
    }
    nloc = mine > 0u ? mine : 1u; nx = cnt > 0u ? cnt : 1u;
}

__device__ __forceinline__ void xcd_barrier(const XcdBarrier& b) {
    asm volatile("s_waitcnt vmcnt(0)" ::: "memory");
    __syncthreads();
    if (threadIdx.x == 0) {
        unsigned* bar = b.bar;
        __builtin_amdgcn_s_waitcnt(0);
        unsigned nloc = b.st[0], nx = b.st[1];
        if (nloc == 0u) { xcd_barrier_complete(bar, b.x, nloc, nx); b.st[0] = nloc; b.st[1] = nx; }
        const unsigned old = xb_add(&bar[XB_XSUB(b.x)], 1u);
        const unsigned gen = old / nloc;
        if (old + 1u == (gen + 1u) * nloc) {
            __builtin_amdgcn_fence(__ATOMIC_RELEASE, "agent");
            asm volatile("s_waitcnt vmcnt(0)" ::: "memory");
            const unsigned og = xb_add(&bar[XB_TOP], 1u);
            const unsigned tg = og / nx;
            if (og + 1u == (tg + 1u) * nx) xb_add(&bar[XB_TOPGEN], 1u);
            else XB_SPIN(xb_ld(&bar[XB_TOPGEN]) == tg, bar);
            __builtin_amdgcn_fence(__ATOMIC_ACQUIRE, "agent");
            xb_add(&bar[XB_XGEN(b.x)], 1u);
            asm volatile("s_waitcnt vmcnt(0)" ::: "memory");
        } else {
            XB_SPIN(xb_ld(&bar[XB_XGEN(b.x)]) == gen, bar);
            __builtin_amdgcn_fence(__ATOMIC_ACQUIRE, "agent");
            asm volatile("s_waitcnt vmcnt(0)" ::: "memory");
        }
    }
    __syncthreads();
}
constexpr int NWAVES = 8;
constexpr int N1P = 8448;
constexpr int RING_OFF = 0, RING_BYTES = 135168;
constexpr int LDSCTL_OFF = RING_BYTES, MISC_OFF = LDSCTL_OFF + 320;
constexpr int LDS_BYTES = 147456;
constexpr int CW_BAR = 4096;
static_assert(fa::F_LDS_BYTES <= RING_BYTES && fa::S_LDS_BYTES <= RING_BYTES && pg8::STAGE_BYTES <= RING_BYTES && MISC_OFF + 128 <= LDS_BYTES && (CW_BAR + XCD_BAR_WORDS) * 4 <= (int)WS_KMAX, "LDS / CTL map");

__device__ __forceinline__ void p0_transpose_item(const float* W, int K, int N, bf16* WT, LAS float* scr, int item, int lane, const float* gs) {
    const int nblk = N / 32, kb = item / nblk, nb = item % nblk, k0 = 64 * kb, n0 = 32 * nb;
    const int kr = lane >> 3, nc = 4 * (lane & 7);
    f32x4 wv[8];
#pragma unroll
    for (int i = 0; i < 8; ++i) wv[i] = *(const GAS f32x4*)(W + (size_t)(k0 + 8 * i + kr) * N + n0 + nc);
#pragma unroll
    for (int i = 0; i < 8; ++i) { const int kk = 8 * i + kr; f32x4 w = wv[i]; if (gs) w = w * gs[k0 + kk]; LAS float* d = scr + kk * 33 + nc; d[0] = w.x; d[1] = w.y; d[2] = w.z; d[3] = w.w; }
    LDS_WAIT(); asm volatile("" ::: "memory");
    const int c = lane & 7;
#pragma unroll
    for (int j = 0; j < 4; ++j) { const int n = (lane >> 3) + 8 * j; const LAS float* sp = scr + (8 * c) * 33 + n;
        v4u o; o.x = pk2(sp[0 * 33], sp[1 * 33]); o.y = pk2(sp[2 * 33], sp[3 * 33]); o.z = pk2(sp[4 * 33], sp[5 * 33]); o.w = pk2(sp[6 * 33], sp[7 * 33]);
        *(GAS v4u*)(WT + tiled_off(n0 + n, k0 + 8 * c)) = o; }
    LDS_WAIT(); asm volatile("" ::: "memory");
}
__device__ __forceinline__ float wave_sum(float v) {
#pragma unroll
    for (int o = 1; o < 64; o <<= 1) v += __shfl_xor(v, o);
    return v;
}

struct Args { const float* in[9]; float* out; unsigned char* ws; int ph_lo, ph_hi; };
constexpr int N_PHASES = 9;
__global__ void __launch_bounds__(NWAVES * 64, 2) mega_fwd(Args args) {
    extern __shared__ __attribute__((aligned(16))) unsigned char lds_raw[];
    LAS unsigned char* lds = (LAS unsigned char*)lds_raw;
    volatile LAS unsigned* MISC = (volatile LAS unsigned*)(lds + MISC_OFF);
    const int tid = threadIdx.x, lane = tid & 63, wave = __builtin_amdgcn_readfirstlane(tid >> 6);
    const int G = gridDim.x, bx = blockIdx.x, vcu = (G % 8 == 0) ? (bx % 8) * (G / 8) + bx / 8 : bx;
    unsigned char* ws = args.ws;
    const float* x = args.in[0]; const float* norm_g = args.in[1]; const float* fox_w_in = args.in[2]; const float* fox_b_f = args.in[3]; const float* fox_w_out = args.in[4];
    const float* swa_w_in = args.in[5]; const float* swa_sinks = args.in[6]; const float* swa_w_out = args.in[7]; const float* final_g = args.in[8];
    float* out = args.out;
    gu32* ctl = (gu32*)(ws + WS_CTL);
    unsigned* KMAX = (unsigned*)(ws + WS_KMAX); unsigned* TICKET = (unsigned*)(ws + WS_TICKET);
    float* SS1 = (float*)(ws + WS_SS1); float* R0 = (float*)(ws + WS_R0); float* ROPE = (float*)(ws + WS_ROPE); float* LOGF = (float*)(ws + WS_LOGF); float* CUM = (float*)(ws + WS_CUM);
    bf16* W1T = (bf16*)(ws + WS_W1T); bf16* W2T = (bf16*)(ws + WS_W2T); bf16* W3T = (bf16*)(ws + WS_W3T); bf16* W4T = (bf16*)(ws + WS_W4T);
    bf16* KAUG = (bf16*)(ws + WS_KAUG);
    bf16* XB = (bf16*)(ws + WS_XB); bf16* Qb = (bf16*)(ws + WS_Q); bf16* Kb = (bf16*)(ws + WS_K); bf16* Vb = (bf16*)(ws + WS_V); bf16* Gb = (bf16*)(ws + WS_G); bf16* YG = (bf16*)(ws + WS_YG);
    for (int u = tid; u < (LDS_BYTES - LDSCTL_OFF) / 4; u += NWAVES * 64) ((LAS unsigned*)(lds + LDSCTL_OFF))[u] = 0u;
    __syncthreads();
    const int lo = args.ph_lo, hi = args.ph_hi;
    XcdBarrier bar; bar.bar = (unsigned*)(ctl + CW_BAR); bar.x = 0; bar.st = nullptr;
    if (hi - lo > 1) bar = xcd_barrier_post((unsigned*)(ctl + CW_BAR), MISC + 8);
#define IN(k) (lo <= (k) && (k) < hi)
#define REP(k) for (int rep_ = 0; rep_ < (((DUP_MASK >> (k)) & 1) ? 2 : 1); ++rep_)
#define SEAM(k) do { if (IN(k) && IN((k) + 1)) xcd_barrier(bar); } while (0)
    const int gw = vcu * NWAVES + wave, NGW = G * NWAVES;
#define STAGGER() do { for (int s_ = 0; s_ < ((bx >> 3) & 31); ++s_) __builtin_amdgcn_s_sleep(1); } while (0)
    const bool grp = (G == 256) && lo == 0 && hi == N_PHASES;
    const int gpm = 8 * (bx & 7) + ((bx >> 3) & 7), gj = bx >> 6;
    unsigned* GS = (unsigned*)(ws + WS_GS);
    unsigned* XT = (unsigned*)(ws + WS_XT);
    if (grp && tid == 0) __hip_atomic_store(XT + bx, xb_xcc_id() + 1u, __ATOMIC_RELAXED, __HIP_MEMORY_SCOPE_AGENT);
#define G_ARRIVE() do { asm volatile("s_waitcnt vmcnt(0)" ::: "memory"); __syncthreads(); \
        if (tid == 0) { if (MISC[12] != 0u) { __builtin_amdgcn_fence(__ATOMIC_RELEASE, "agent"); asm volatile("s_waitcnt vmcnt(0)" ::: "memory"); } (void)xb_add(GS + gpm * 16, 1u); } } while (0)
#define G_WAIT(pm_, target) do { if (tid == 0) { unsigned* w_ = GS + (pm_) * 16; XB_SPIN(xb_ld(w_) < (unsigned)(target), bar.bar); \
        __builtin_amdgcn_fence(__ATOMIC_ACQUIRE, "agent"); asm volatile("s_waitcnt vmcnt(0)" ::: "memory"); } __syncthreads(); } while (0)

    if (IN(0)) REP(0) {
        LAS float* scr = (LAS float*)(lds + RING_OFF + wave * 16384);
        constexpr int I1 = (DM / 64) * (FOX_IN / 32);
        for (int it = gw; it < I1; it += NGW) p0_transpose_item(fox_w_in, DM, FOX_IN, W1T, scr, it, lane, norm_g);
        for (int m = 2 * gw; m < MTOK; m += 2 * NGW) {
            const int m2 = m + 1;
            const GAS f32x4* xr = (const GAS f32x4*)(x + (size_t)m * DM) + lane; const GAS f32x4* xr2 = (const GAS f32x4*)(x + (size_t)m2 * DM) + lane; f32x4 v[8], v2[8]; float s = 0.f, s2 = 0.f;
#pragma unroll
            for (int j = 0; j < 8; ++j) { v[j] = xr[64 * j]; v2[j] = xr2[64 * j]; }
#pragma unroll
            for (int j = 0; j < 8; ++j) { s += (v[j].x * v[j].x + v[j].y * v[j].y) + (v[j].z * v[j].z + v[j].w * v[j].w); s2 += (v2[j].x * v2[j].x + v2[j].y * v2[j].y) + (v2[j].z * v2[j].z + v2[j].w * v2[j].w); }
            s = wave_sum(s); s2 = wave_sum(s2);
            if (lane == 0) { R0[m] = 1.0f / sqrtf(s * (1.f / DM) + RMS_EPS); R0[m2] = 1.0f / sqrtf(s2 * (1.f / DM) + RMS_EPS); }
#pragma unroll
            for (int j = 0; j < 8; ++j) { *(GAS unsigned long long*)(XB + tiled_off(m, 256 * j + 4 * lane)) = (unsigned long long)pk2(v[j].x, v[j].y) | ((unsigned long long)pk2(v[j].z, v[j].w) << 32);
                                          *(GAS unsigned long long*)(XB + tiled_off(m2, 256 * j + 4 * lane)) = (unsigned long long)pk2(v2[j].x, v2[j].y) | ((unsigned long long)pk2(v2[j].z, v2[j].w) << 32); }
        }
        { const int gt = gw * 64 + lane;
          if (gt < SEQ * 8) { const int pos = gt >> 3, i = gt & 7;
              const double invf[8] = {1.0, 0.19390220519133497, 0.037598065178462524, 0.0072903477503833845, 0.0014142135623730951, 0.00027421912901204056, 5.3171693730649086e-05, 1.0310108130908796e-05};
              double inv = invf[0];
#pragma unroll
              for (int k = 1; k < 8; ++k) inv = (i == k) ? invf[k] : inv;
              const double ang = (double)pos * inv; const double kk = __builtin_rint(ang * 0.15915494309189535); const float red = (float)(ang - kk * 6.283185307179586);
              ROPE[(size_t)pos * 16 + i] = cosf(red); ROPE[(size_t)pos * 16 + 8 + i] = sinf(red); } }
    }
    SEAM(0);
    if (IN(1)) {
        pg8::Gemm g{XB, W1T, MTOK, 4 * DM, DM}; pg8::StaticOrder S; S.init(MTOK, 4 * DM, G, bx, (DUP_MASK >> 1) & 1, (DUP_MASK >> 9) & 1);
        pg8::EpiFoxIn E{Qb, Kb, Vb, Gb, LOGF, R0, fox_b_f, KMAX};
        if ((DUP_MASK >> 10) & 1) { pg8::StaticOrder SP; SP.init(MTOK, 4 * DM, G, bx, 0, 0, 1); pg8::gemm_phase<pg8::EpiFoxIn, pg8::StaticOrder, true, true>(lds + RING_OFF, g, SP, E); }
        STAGGER();
        pg8::gemm_phase<pg8::EpiFoxIn, pg8::StaticOrder, true, true>(lds + RING_OFF, g, S, E);
        for (int rb = bx * 64; rb < MTOK; rb += G * 64) {
            LAS unsigned char* bl = lds + RING_OFF;
#pragma unroll
            for (int pc = 0; pc < 16; ++pc) { const int pidx = wave + 8 * pc;
                fa::glds16(W1T + tiled_off(4 * DM, 0) + (size_t)(pidx >> 1) * 8192 + (pidx & 1) * 512 + lane * 8, (unsigned)__builtin_amdgcn_readfirstlane((int)(unsigned)(uintptr_t)(bl + pidx * 1024))); }
            const int arow = rb + 16 * (wave & 3) + (lane & 15), kg = (lane >> 4) * 8, kh = wave >> 2;
            bf16x8 af[32];
#pragma unroll
            for (int ks = 0; ks < 32; ++ks) af[ks] = *(const GAS bf16x8*)(XB + tiled_off(arow, 32 * (32 * kh + ks) + kg));
            asm volatile("s_waitcnt vmcnt(0)" ::: "memory");
            __syncthreads();
            pg8::f32x4 acc0 = {0.f, 0.f, 0.f, 0.f}, acc1 = {0.f, 0.f, 0.f, 0.f};
            const LAS unsigned char* bp = bl + (32 * kh) * 2048 + (lane & 15) * 64 + (lane >> 4) * 16;
#pragma unroll
            for (int ks = 0; ks < 32; ++ks) {
                const bf16x8 b0 = *(const LAS bf16x8*)(bp + ks * 2048), b1 = *(const LAS bf16x8*)(bp + ks * 2048 + 1024);
                acc0 = __builtin_amdgcn_mfma_f32_16x16x32_bf16(af[ks], b0, acc0, 0, 0, 0); acc1 = __builtin_amdgcn_mfma_f32_16x16x32_bf16(af[ks], b1, acc1, 0, 0, 0); }
            __syncthreads();
            LAS pg8::f32x4* xs = (LAS pg8::f32x4*)bl + ((wave & 3) * 64 + lane) * 2;
            if (kh == 1) { xs[0] = acc0; xs[1] = acc1; }
            __syncthreads();
            if (kh == 0) {
                acc0 = acc0 + xs[0]; acc1 = acc1 + xs[1];
                const int r0 = rb + 16 * (wave & 3) + 4 * (lane >> 4); const float s0 = R0[r0], s1 = R0[r0 + 1], s2 = R0[r0 + 2], s3 = R0[r0 + 3];
#pragma unroll
                for (int g2 = 0; g2 < 2; ++g2) { const int h = 16 * g2 + (lane & 15); const float bb = fox_b_f[h]; const pg8::f32x4 a = g2 ? acc1 : acc0;
                    f32x4 o; o.x = logsigmoidf(a[0] * s0 + bb); o.y = logsigmoidf(a[1] * s1 + bb); o.z = logsigmoidf(a[2] * s2 + bb); o.w = logsigmoidf(a[3] * s3 + bb);
                    *(GAS f32x4*)(LOGF + ((size_t)((r0 >> 12) * NH + h) << 12) + (r0 & 4095)) = o; }
            }
            __syncthreads();
        }
        { LAS float* scr = (LAS float*)(lds + RING_OFF + wave * 16384);
          constexpr int I2 = (DM / 64) * (DM / 32), I3 = (DM / 64) * (SWA_IN / 32);
          for (int it = gw; it < I2 + I3; it += NGW) { if (it < I2) p0_transpose_item(fox_w_out, DM, DM, W2T, scr, it, lane, nullptr); else p0_transpose_item(swa_w_in, DM, SWA_IN, W3T, scr, it - I2, lane, norm_g + DM); } }
    }
    SEAM(1);
    if (IN(2)) REP(2) {
        for (int sq = vcu; sq < NB * NH; sq += G) {
            const GAS f32x4* lf = (const GAS f32x4*)(LOGF + (size_t)sq * SEQ + wave * 512) + lane * 2; const f32x4 v0 = lf[0], v1 = lf[1];
            const double tot = (((double)v0.x + (double)v0.y) + ((double)v0.z + (double)v0.w)) + (((double)v1.x + (double)v1.y) + ((double)v1.z + (double)v1.w));
            double incl = tot;
#pragma unroll
            for (int o = 1; o < 64; o <<= 1) { const double up = __shfl_up(incl, o); if (lane >= o) incl += up; }
            volatile LAS double* wt = (volatile LAS double*)(lds + RING_OFF);
            __syncthreads();
            if (lane == 63) wt[wave] = incl;
            __syncthreads();
            double run = incl - tot;
            for (int w2 = 0; w2 < wave; ++w2) run += wt[w2];
            const float vv[8] = {v0.x, v0.y, v0.z, v0.w, v1.x, v1.y, v1.z, v1.w}; float cv[8];
#pragma unroll
            for (int e = 0; e < 8; ++e) { run += (double)vv[e]; cv[e] = (float)(run * 1.4426950408889634); }
            GAS f32x4* co = (GAS f32x4*)(CUM + (size_t)sq * SEQ + wave * 512) + lane * 2; co[0] = (f32x4){cv[0], cv[1], cv[2], cv[3]}; co[1] = (f32x4){cv[4], cv[5], cv[6], cv[7]};
            GAS v4u* ka = (GAS v4u*)(KAUG + ((size_t)sq * SEQ + wave * 512 + lane * 8) * 8);
#pragma unroll
            for (int e = 0; e < 8; ++e) { unsigned h1, h2, h3; fa::split3(-cv[e], h1, h2, h3); ka[e] = (v4u){h1 | (h2 << 16), h3 | 0x3F800000u, 0x3F803F80u, 0u}; }
        }
        { const int nidle = G > NB * NH ? G - NB * NH : G, ii = G > NB * NH ? vcu - NB * NH : vcu;
          if (ii >= 0) { __syncthreads(); LAS float* scr = (LAS float*)(lds + RING_OFF + wave * 16384); constexpr int I2 = (DM / 64) * (DM / 32);
              for (int it = ii * NWAVES + wave; it < I2; it += nidle * NWAVES) p0_transpose_item(swa_w_out, DM, DM, W4T, scr, it, lane, nullptr); } }
    }
    SEAM(2);
    if (IN(3)) {
        const fa::Params P{Qb, Kb, Vb, Gb, YG, CUM, nullptr, KMAX, TICKET, KAUG};
        if (grp && tid == 0) {
            const unsigned me = xb_xcc_id() + 1u; const int pn = gpm + 1, two = ((pn & 15) != 0) ? 1 : 0, pq = two ? pn : gpm;
            const unsigned r0 = xb_ld(XT + 8 * (16 + (gpm & 7)) + (gpm >> 3)), r1 = xb_ld(XT + 8 * (24 + (gpm & 7)) + (gpm >> 3));
            const unsigned r2 = xb_ld(XT + 8 * (16 + (pq & 7)) + (pq >> 3)), r3 = xb_ld(XT + 8 * (24 + (pq & 7)) + (pq >> 3));
            MISC[12] = (r0 != me || r1 != me || r2 != me || r3 != me) ? 1u : 0u; }
        volatile LAS unsigned* slot = (volatile LAS unsigned*)(lds + RING_OFF + fa::F_FLAG + 128);
#define FOX_FETCH(dst) do { unsigned code_ = 0xFFFFFFFFu; for (int k_ = 0; k_ < 8; ++k_) { const unsigned q_ = (unsigned)((bx + k_) & 7); const unsigned t_ = atomicAdd(TICKET + q_ * 64, 1u); \
            if (t_ < 256u) { code_ = q_ * 256u + t_; break; } } (dst) = code_; } while (0)
        if (tid == 0) FOX_FETCH(slot[0]);
        __syncthreads();
        unsigned tk = slot[0]; int par = 0;
        while (tk != 0xFFFFFFFFu) {
            if (tid == 0) FOX_FETCH(slot[par ^ 1]);
            const int q = (int)(tk >> 8), tq = (int)(tk & 255u), pi = tq >> 4, hs = 3 - (pi >> 2);
            const int h = hs == 0 ? q : hs == 1 ? 15 - q : hs == 2 ? 16 + q : 31 - q;
            fa::fox_unit(lds + RING_OFF, P, pi & 3, h, 15 - (tq & 15));
            par ^= 1; tk = slot[par];
        }
#undef FOX_FETCH
        __syncthreads();
    }
    SEAM(3);
    if (IN(4)) {
        pg8::Gemm g{YG, W2T, MTOK, DM, DM}; pg8::StaticOrder S; S.init(MTOK, DM, G, bx);
        pg8::EpiRes<true> E{x, XB, SS1};
        STAGGER();
        pg8::gemm_phase<pg8::EpiRes<true>, pg8::StaticOrder, true, true>(lds + RING_OFF, g, S, E);
    }
    SEAM(4);
    if (IN(5)) {
        pg8::Gemm g{XB, W3T, MTOK, SWA_IN, DM}; pg8::StaticOrder S; S.init(MTOK, SWA_IN, G, bx, (DUP_MASK >> 5) & 1, 0, 0, 0, grp ? 4 : (1 << 20));
        pg8::EpiSwaIn E{Qb, Kb, Vb, Gb, SS1, ROPE};
        STAGGER();
        pg8::gemm_phase<pg8::EpiSwaIn, pg8::StaticOrder, true, true>(lds + RING_OFF, g, S, E);
        if (grp) {
            G_ARRIVE();
            if (gj < 2) { pg8::StaticOrder S4; S4.init(MTOK, SWA_IN, G, bx, 0, 0, 0, 4, 5); pg8::gemm_phase<pg8::EpiSwaIn, pg8::StaticOrder, true, true>(lds + RING_OFF, g, S4, E); }
            else { const fa::Params P{Qb, Kb, Vb, Gb, YG, nullptr, swa_sinks, nullptr, nullptr, nullptr};
                   G_WAIT(gpm, 4); if ((gpm & 15) != 0) G_WAIT(gpm - 1, 4);
                   fa::swa_unit(lds + RING_OFF, P, gpm >> 4, gj - 2, gpm & 15); }
        }
    }
    SEAM(5);
    if (IN(6)) REP(6) {
        const fa::Params P{Qb, Kb, Vb, Gb, YG, nullptr, swa_sinks, nullptr, nullptr, nullptr};
        if (grp) fa::swa_unit(lds + RING_OFF, P, gpm >> 4, 2 + (gj >> 1), gpm & 15, (gj & 1) * 4, (gj & 1) * 4 + 4);
        else for (int u = bx; u < NB * 4 * 16; u += G) fa::swa_unit(lds + RING_OFF, P, u >> 6, (u >> 4) & 3, u & 15);
    }
    SEAM(6);
    if (IN(7)) {
        pg8::Gemm g{YG, W4T, MTOK, DM, DM}; pg8::StaticOrder S; S.init(MTOK, DM, G, bx);
        pg8::EpiRes<false> E{nullptr, XB, nullptr};
        STAGGER();
        pg8::gemm_phase<pg8::EpiRes<false>, pg8::StaticOrder, true, true>(lds + RING_OFF, g, S, E);
    }
    SEAM(7);
    if (IN(8)) {
        f32x4 gq[8];
#pragma unroll
        for (int j = 0; j < 8; ++j) gq[j] = ((const GAS f32x4*)final_g)[lane + 64 * j];
        for (int m = 2 * gw; m < MTOK; m += 2 * NGW) {
            f32x4 v[8], v2[8]; float s = 0.f, s2 = 0.f; unsigned long long xw[8], xw2[8];
#pragma unroll
            for (int j = 0; j < 8; ++j) { xw[j] = *(const GAS unsigned long long*)(XB + tiled_off(m, 256 * j + 4 * lane)); xw2[j] = *(const GAS unsigned long long*)(XB + tiled_off(m + 1, 256 * j + 4 * lane)); }
#pragma unroll
            for (int j = 0; j < 8; ++j) { const unsigned lo32 = (unsigned)xw[j], hi32 = (unsigned)(xw[j] >> 32), lo2 = (unsigned)xw2[j], hi2 = (unsigned)(xw2[j] >> 32);
                v[j] = (f32x4){__uint_as_float(lo32 << 16), __uint_as_float(lo32 & 0xffff0000u), __uint_as_float(hi32 << 16), __uint_as_float(hi32 & 0xffff0000u)};
                v2[j] = (f32x4){__uint_as_float(lo2 << 16), __uint_as_float(lo2 & 0xffff0000u), __uint_as_float(hi2 << 16), __uint_as_float(hi2 & 0xffff0000u)};
                s += (v[j].x * v[j].x + v[j].y * v[j].y) + (v[j].z * v[j].z + v[j].w * v[j].w); s2 += (v2[j].x * v2[j].x + v2[j].y * v2[j].y) + (v2[j].z * v2[j].z + v2[j].w * v2[j].w); }
            const float r = 1.0f / sqrtf(wave_sum(s) * (1.f / DM) + RMS_EPS), r2 = 1.0f / sqrtf(wave_sum(s2) * (1.f / DM) + RMS_EPS);
            GAS f32x4* xr = (GAS f32x4*)(out + (size_t)m * DM) + lane; GAS f32x4* xr2 = (GAS f32x4*)(out + (size_t)(m + 1) * DM) + lane;
#pragma unroll
            for (int j = 0; j < 8; ++j) { xr[64 * j] = v[j] * r * gq[j]; xr2[64 * j] = v2[j] * r2 * gq[j]; }
        }
    }
#undef IN
#undef SEAM
#undef G_ARRIVE
#undef G_WAIT
}

extern "C" void kernel_launch(void* const* d_in, const int* in_sizes, int n_in, void* d_out, int out_size, void* d_ws, size_t ws_size, hipStream_t stream) {
    static int grid = 0;
    if (grid == 0) {
        if (n_in != 9 || in_sizes[0] != MTOK * DM || out_size != MTOK * DM || ws_size < WS_END) { fprintf(stderr, "kernel_launch: unexpected shapes (n_in %d, in0 %d, out %d, ws %zu)\n", n_in, n_in > 0 ? in_sizes[0] : -1, out_size, ws_size); grid = -1; return; }
        int dev = 0, cus = 0, per_cu = 0;
        if (hipGetDevice(&dev) != hipSuccess || hipDeviceGetAttribute(&cus, hipDeviceAttributeMultiprocessorCount, dev) != hipSuccess) { fprintf(stderr, "kernel_launch: device query failed\n"); grid = -1; return; }
        if (hipFuncSetAttribute((const void*)mega_fwd, hipFuncAttributeMaxDynamicSharedMemorySize, LDS_BYTES) != hipSuccess) { fprintf(stderr, "kernel_launch: hipFuncSetAttribute failed\n"); grid = -1; return; }
        if (hipOccupancyMaxActiveBlocksPerMultiprocessor(&per_cu, (const void*)mega_fwd, NWAVES * 64, LDS_BYTES) != hipSuccess || per_cu < 1) { fprintf(stderr, "kernel_launch: occupancy query reports %d workgroups per CU; nothing launched\n", per_cu); (void)hipGetLastError(); grid = -1; return; }
        grid = cus;
    }
    if (grid < 0) return;
    (void)hipMemsetAsync((unsigned char*)d_ws + WS_CTL, 0, CTL_ZERO_BYTES, stream);
    Args a{};
    for (int i = 0; i < 9; ++i) a.in[i] = (const float*)d_in[i];
    a.out = (float*)d_out; a.ws = (unsigned char*)d_ws;
    int p = 0;
    while (p < N_PHASES) {
        if (!((FAST_MASK >> p) & 1)) { ++p; continue; }
        int e = p + 1; if (ONE_LAUNCH) while (e < N_PHASES && ((FAST_MASK >> e) & 1)) ++e;
        a.ph_lo = p; a.ph_hi = e;
        hipLaunchKernelGGL(mega_fwd, dim3(grid), dim3(NWAVES * 64), LDS_BYTES, stream, a);
        p = e;
    }
}
```

```cpp
#include <hip/hip_runtime.h>
#include <cstdio>
#include <cstdint>

constexpr int NB = 4, SEQ = 4096, DM = 2048, MTOK = NB * SEQ, NH = 32, HD = 64;
constexpr int FOX_IN = 8224, SWA_IN = 4608, KVW = 256;
constexpr float RMS_EPS = 1e-6f;
constexpr float LOG2E = 1.4426950408889634f;
constexpr float C2 = 0.125f * LOG2E;

typedef unsigned short bf16_t;
__device__ __forceinline__ float bf2f(bf16_t v) { return __uint_as_float((unsigned)v << 16); }
__device__ __forceinline__ bf16_t f2bf(float f) { unsigned u = __float_as_uint(f); return (bf16_t)((u + 0x7fffu + ((u >> 16) & 1u)) >> 16); }
__device__ __forceinline__ float logsigmoidf(float z) { return z < 0.f ? z - log1pf(expf(z)) : -log1pf(expf(-z)); }
__device__ __forceinline__ float siluf(float g) { return g / (1.f + expf(-g)); }

__host__ __device__ __forceinline__ size_t tiled_off(int row, int k) { return ((size_t)(((row >> 8) * (DM / 64) + (k >> 6)) * 2 + ((k >> 5) & 1)) << 13) + (size_t)(((row & 255) << 5) + (k & 31)); }

__host__ __device__ __forceinline__ size_t hm_off(int row  , int col  , int nheads) { return ((size_t)(((row >> 12) * nheads + (col >> 6)) * 2 + ((col >> 5) & 1)) * SEQ + (row & 4095)) * 32 + (col & 31); }

constexpr size_t MiB = 1u << 20;
constexpr size_t WS_CTL = 0, CTL_ZERO_BYTES = 1 * MiB;
constexpr size_t WS_KMAX = 64 * 1024, WS_TICKET = 66 * 1024;
constexpr size_t WS_GS = 128 * 1024;
constexpr size_t WS_XT = 160 * 1024;
constexpr size_t WS_SS1 = 512 * 1024;
constexpr size_t WS_R0 = 1 * MiB;
constexpr size_t WS_ROPE = 1 * MiB + 512 * 1024;
constexpr size_t WS_LOGF = 2 * MiB;
constexpr size_t WS_CUM = 4 * MiB;
constexpr size_t WS_W1T = 8 * MiB, WS_W2T = 41 * MiB, WS_W3T = 49 * MiB, WS_W4T = 67 * MiB;
constexpr size_t WS_XB = 76 * MiB, WS_Q = 140 * MiB, WS_K = 204 * MiB, WS_V = 268 * MiB, WS_G = 332 * MiB, WS_YG = 396 * MiB, WS_KAUG = 460 * MiB, WS_END = 468 * MiB;

#ifndef FAST_MASK
#define FAST_MASK 0x1FF
#endif
#ifndef DUP_MASK
#define DUP_MASK 0x000
#endif
#ifndef ONE_LAUNCH
#define ONE_LAUNCH 1
#endif
namespace pg8 {
#define PG8_LAS __attribute__((address_space(3)))
typedef unsigned short bf16_t;
typedef short bf16x8 __attribute__((ext_vector_type(8)));
typedef float f32x4 __attribute__((ext_vector_type(4)));
typedef unsigned u32x4 __attribute__((ext_vector_type(4)));
constexpr int BM = 256, BK = 64, HALF = 128, HTB = HALF * BK * 2  , STAGE_BYTES = 8 * HTB, NXCD = 8, WGM = 8;

__host__ __device__ __forceinline__ int lds_byte(int r, int c) { const int st = (r >> 4) * 2 + (c >> 5), rr = r & 15, cc = c & 31, ob = rr * 64 + cc * 2; return st * 1024 + (ob ^ (((ob >> 9) & 1) << 5)); }
__host__ __device__ __forceinline__ void stage_rc(int b, int& R, int& C) { const int st = b / 1024, sb = b % 1024, swz = sb ^ (((sb >> 9) & 1) << 5); R = (st >> 1) * 16 + swz / 64; C = (st & 1) * 32 + (swz % 64) / 2; }
__host__ __device__ __forceinline__ int perm32(int rho) { const int n = rho >> 4, i = rho & 15; return 8 * (i >> 2) + 4 * n + (i & 3); }

struct Unit { int pm, pn, lm, ln; };
struct Gemm { const bf16_t* A; const bf16_t* Bt; int M, N, K; };

struct StaticOrder {
    int nM, nN, nwg, G, c, dup, epi2, same, i0, i1;
    __host__ __device__ void init(int M, int N, int G_, int c_, int dup_ = 0, int epi2_ = 0, int same_ = 0, int i0_ = 0, int i1_ = 1 << 20) { nM = M / BM; nN = N / BM; nwg = nM * nN; G = G_; c = c_; dup = dup_; epi2 = epi2_; same = same_; i0 = i0_; i1 = i1_; }
    __host__ __device__ bool next(int i, Unit& u) const {
        if (dup) i >>= 1;
        i += i0; if (i >= i1) return false;
        const long L = (long)i * G + c; if (L >= nwg) return false;
        int wgid = (int)L; { const int q = nwg / NXCD, r = nwg % NXCD, xcd = wgid % NXCD, off = wgid / NXCD; wgid = (xcd < r ? xcd * (q + 1) : r * (q + 1) + (xcd - r) * q) + off; }
        const int nig = WGM * nN, gid = wgid / nig, fm = gid * WGM, gsz = (nM - fm) < WGM ? (nM - fm) : WGM;
        u.pm = fm + ((wgid % nig) % gsz); u.pn = (wgid % nig) / gsz;
        { const int ng = nN >> 2, cg = u.pn >> 2; if (cg < ng) u.pn = 4 * ((cg + (int)(L & 7)) % ng) + (u.pn & 3); }
        u.lm = same ? 0 : u.pm; u.ln = same ? 0 : u.pn; return true;
    }
    __device__ __forceinline__ void a_ready(const Unit&) const {}
    __device__ __forceinline__ void done(const Unit&) const {}
};

__device__ __forceinline__ unsigned cvt_pk_bf16(float lo, float hi) { unsigned r; asm volatile("v_cvt_pk_bf16_f32 %0, %1, %2" : "=v"(r) : "v"(lo), "v"(hi)); return r; }
__device__ __forceinline__ float silu_fast(float g) { return g * __builtin_amdgcn_rcpf(1.0f + __builtin_amdgcn_exp2f(-g * 1.4426950408889634f)); }
__device__ __forceinline__ u32x4 pack8(const f32x4 v0, const f32x4 v1) { u32x4 w; w.x = cvt_pk_bf16(v0[0], v0[1]); w.y = cvt_pk_bf16(v0[2], v0[3]); w.z = cvt_pk_bf16(v1[0], v1[1]); w.w = cvt_pk_bf16(v1[2], v1[3]); return w; }
struct EpiFoxIn {
    static constexpr bool PERM = true, AFTER_DRAIN = false;
    bf16_t *Q, *K, *V, *G; float* LOGF; const float* R0; const float* bfb; unsigned* KMAX;
    __device__ __forceinline__ void operator()(const f32x4 (&acc)[2][2][4][2], const Unit& u, int wr, int wc, int fr, int fq) const {
        const int row0 = u.pm * BM + wr * 64 + fr, pn = u.pn;
        float rs[2][4];
#pragma unroll
        for (int ai = 0; ai < 2; ++ai)
#pragma unroll
            for (int m = 0; m < 4; ++m) rs[ai][m] = R0[row0 + ai * HALF + m * 16];
        {
            const int reg = pn >> 3; bf16_t* base = reg == 0 ? Q : reg == 1 ? K : reg == 2 ? V : G; float kmx[2] = {0.f, 0.f};
            const int col0 = (pn & 7) * BM + wc * 32 + 8 * fq;
#pragma unroll
            for (int ai = 0; ai < 2; ++ai)
#pragma unroll
                for (int m = 0; m < 4; ++m) { const int row = row0 + ai * HALF + m * 16; const float r = rs[ai][m]; const float sc = reg == 0 ? r * C2 : r;
#pragma unroll
                    for (int bj = 0; bj < 2; ++bj) { f32x4 v0 = acc[ai][bj][m][0] * sc, v1 = acc[ai][bj][m][1] * sc;
                        if (reg == 3) {
#pragma unroll
                            for (int j = 0; j < 4; ++j) { v0[j] = silu_fast(v0[j]); v1[j] = silu_fast(v1[j]); } }
                        if (reg == 1) { float ss = ((v0[0] * v0[0] + v0[1] * v0[1]) + (v0[2] * v0[2] + v0[3] * v0[3])) + ((v1[0] * v1[0] + v1[1] * v1[1]) + (v1[2] * v1[2] + v1[3] * v1[3]));
                            ss += __shfl_xor(ss, 16); ss += __shfl_xor(ss, 32); kmx[bj] = fmaxf(kmx[bj], ss); }
                        __builtin_nontemporal_store(pack8(v0, v1), (u32x4*)(base + hm_off(row, col0 + bj * HALF, NH))); } }
            if (reg == 1) {
#pragma unroll
                for (int bj = 0; bj < 2; ++bj) { float mx = kmx[bj];
#pragma unroll
                    for (int o = 1; o < 16; o <<= 1) mx = fmaxf(mx, __shfl_xor(mx, o));
                    if (fr == 0 && fq == 0) atomicMax(KMAX + ((row0 >> 12) * NH + (pn & 7) * 4 + bj * 2 + (wc >> 1)) * 2 + (wc & 1), __float_as_uint(mx)); } }
        }
    }
};
struct EpiSwaIn {
    static constexpr bool PERM = true, AFTER_DRAIN = false;
    bf16_t *Q, *K, *V, *G; const float* SS; const float* ROPE;
    __device__ __forceinline__ void operator()(const f32x4 (&acc)[2][2][4][2], const Unit& u, int wr, int wc, int fr, int fq) const {
        const int row0 = u.pm * BM + wr * 64 + fr, pn = u.pn;
        bf16_t* base; int pitch, colt; float osc = 1.f; const bool rope = pn <= 8, gate = pn >= 10;
        if (pn < 8) { base = Q; pitch = DM; colt = pn * BM; osc = C2; } else if (pn == 8) { base = K; pitch = KVW; colt = 0; } else if (pn == 9) { base = V; pitch = KVW; colt = 0; } else { base = G; pitch = DM; colt = (pn - 10) * BM; }
        const int col0 = colt + wc * 32 + 8 * fq; const bool rotw = rope && ((wc & 1) == 0); const float sgn = fq == 0 ? -1.f : 1.f; const bool rotl = fq < 2;
        float rs[2][4];
#pragma unroll
        for (int ai = 0; ai < 2; ++ai)
#pragma unroll
            for (int m = 0; m < 4; ++m) rs[ai][m] = SS[row0 + ai * HALF + m * 16];
        f32x4 nc0, nc1, ns0, ns1;
        if (rotw) { const float* rp = ROPE + (size_t)(row0 & 4095) * 16; nc0 = *(const f32x4*)rp; nc1 = *(const f32x4*)(rp + 4); ns0 = *(const f32x4*)(rp + 8); ns1 = *(const f32x4*)(rp + 12); }
#pragma unroll
        for (int ai = 0; ai < 2; ++ai)
#pragma unroll
            for (int m = 0; m < 4; ++m) { const int row = row0 + ai * HALF + m * 16; const float r = 1.0f / sqrtf(rs[ai][m] * (1.f / DM) + RMS_EPS);
                const f32x4 c0 = nc0, c1 = nc1, s0 = ns0, s1 = ns1;
                if (rotw && (ai * 4 + m) < 7) { const int nrow = row0 + ((ai * 4 + m + 1) >> 2) * HALF + ((ai * 4 + m + 1) & 3) * 16; const float* rp = ROPE + (size_t)(nrow & 4095) * 16; nc0 = *(const f32x4*)rp; nc1 = *(const f32x4*)(rp + 4); ns0 = *(const f32x4*)(rp + 8); ns1 = *(const f32x4*)(rp + 12); }
#pragma unroll
                for (int bj = 0; bj < 2; ++bj) { f32x4 v0 = acc[ai][bj][m][0] * r, v1 = acc[ai][bj][m][1] * r;
                    if (rotw) {
#pragma unroll
                        for (int j = 0; j < 4; ++j) { const float p0 = __shfl_xor(v0[j], 16), p1 = __shfl_xor(v1[j], 16);
                            const float n0 = v0[j] * c0[j] + sgn * p0 * s0[j], n1 = v1[j] * c1[j] + sgn * p1 * s1[j];
                            v0[j] = rotl ? n0 : v0[j]; v1[j] = rotl ? n1 : v1[j]; } }
                    if (gate) {
#pragma unroll
                        for (int j = 0; j < 4; ++j) { v0[j] = silu_fast(v0[j]); v1[j] = silu_fast(v1[j]); } }
                    v0 = v0 * osc; v1 = v1 * osc;
                    *(u32x4*)(base + hm_off(row, col0 + bj * HALF, pitch >> 6)) = pack8(v0, v1); } }
    }
};
template <bool FIRST> struct EpiRes {
    static constexpr bool PERM = true, AFTER_DRAIN = false;
    const float* xin; bf16_t* XB; float* SS;
    __device__ __forceinline__ void operator()(const f32x4 (&acc)[2][2][4][2], const Unit& u, int wr, int wc, int fr, int fq) const {
        const int row0 = u.pm * BM + wr * 64 + fr, col0 = u.pn * BM + wc * 32 + 8 * fq;
        if (FIRST) {
            f32x4 nx[2][2];
#pragma unroll
            for (int bj = 0; bj < 2; ++bj)
#pragma unroll
                for (int n = 0; n < 2; ++n) nx[bj][n] = *(const f32x4*)(xin + (size_t)row0 * DM + col0 + bj * HALF + n * 4);
#pragma unroll
            for (int ai = 0; ai < 2; ++ai)
#pragma unroll
                for (int m = 0; m < 4; ++m) { const int row = row0 + ai * HALF + m * 16; float ss = 0.f;
                    f32x4 cx[2][2];
#pragma unroll
                    for (int bj = 0; bj < 2; ++bj)
#pragma unroll
                        for (int n = 0; n < 2; ++n) cx[bj][n] = nx[bj][n];
                    if ((ai * 4 + m) < 7) { const int nrow = row0 + ((ai * 4 + m + 1) >> 2) * HALF + ((ai * 4 + m + 1) & 3) * 16;
#pragma unroll
                        for (int bj = 0; bj < 2; ++bj)
#pragma unroll
                            for (int n = 0; n < 2; ++n) nx[bj][n] = *(const f32x4*)(xin + (size_t)nrow * DM + col0 + bj * HALF + n * 4); }
#pragma unroll
                    for (int bj = 0; bj < 2; ++bj) { const f32x4 x0 = cx[bj][0] + acc[ai][bj][m][0], x1 = cx[bj][1] + acc[ai][bj][m][1];
                        *(u32x4*)(XB + tiled_off(row, col0 + bj * HALF)) = pack8(x0, x1);
                        ss += ((x0[0] * x0[0] + x0[1] * x0[1]) + (x0[2] * x0[2] + x0[3] * x0[3])) + ((x1[0] * x1[0] + x1[1] * x1[1]) + (x1[2] * x1[2] + x1[3] * x1[3])); }
                    ss += __shfl_xor(ss, 16); ss += __shfl_xor(ss, 32); if (fq == 0) atomicAdd(SS + row, ss); }
        } else {
            u32x4 xv[2][4][2];
#pragma unroll
            for (int ai = 0; ai < 2; ++ai)
#pragma unroll
                for (int m = 0; m < 4; ++m)
#pragma unroll
                    for (int bj = 0; bj < 2; ++bj) xv[ai][m][bj] = *(const u32x4*)(XB + tiled_off(row0 + ai * HALF + m * 16, col0 + bj * HALF));
#pragma unroll
            for (int ai = 0; ai < 2; ++ai)
#pragma unroll
                for (int m = 0; m < 4; ++m)
#pragma unroll
                    for (int bj = 0; bj < 2; ++bj) { const u32x4 xw = xv[ai][m][bj]; const f32x4 a0 = acc[ai][bj][m][0], a1 = acc[ai][bj][m][1];
                        const f32x4 y0 = {__uint_as_float(xw.x << 16) + a0[0], __uint_as_float(xw.x & 0xffff0000u) + a0[1], __uint_as_float(xw.y << 16) + a0[2], __uint_as_float(xw.y & 0xffff0000u) + a0[3]};
                        const f32x4 y1 = {__uint_as_float(xw.z << 16) + a1[0], __uint_as_float(xw.z & 0xffff0000u) + a1[1], __uint_as_float(xw.w << 16) + a1[2], __uint_as_float(xw.w & 0xffff0000u) + a1[3]};
                        *(u32x4*)(XB + tiled_off(row0 + ai * HALF + m * 16, col0 + bj * HALF)) = pack8(y0, y1); }
        }
    }
};
template <class Epi, class Sched, bool ALIGN_EPI = false, bool SP2 = false>
__device__ __forceinline__ void gemm_phase(PG8_LAS unsigned char* lds, const Gemm g, const Sched& S, const Epi& E) {
    const int tid = threadIdx.x, wid = __builtin_amdgcn_readfirstlane(tid >> 6), lane = tid & 63, wr = wid >> 2, wc = wid & 3, fr = lane & 15, fq = lane >> 4;
    const int K = g.K, nt = K / BK;
    unsigned voffA[2], voffB[2];
#pragma unroll
    for (int i = 0; i < 2; ++i) { int R, C; stage_rc(tid * 16 + i * 8192, R, C); const int Rb = Epi::PERM ? ((R & ~31) + perm32(R & 31)) : R;
        voffA[i] = (unsigned)((C >> 5) * (BM * 32) + R * 32 + (C & 31)) * 2u; voffB[i] = (unsigned)((C >> 5) * (BM * 32) + Rb * 32 + (C & 31)) * 2u; }
    const size_t kstep = (size_t)(BM * BK * 2);
    const size_t hstep = (size_t)(HALF * 32 * 2);
    const size_t tstep = (size_t)BM * K * 2;
    const unsigned ldsw = (unsigned)wid * 1024u;
    const int aoff = lds_byte(wr * 64 + fr, fq * 8), boff = lds_byte(wc * 32 + fr, fq * 8);
#define PG8_SA(b, h) (((b) * 2 + (h)) * HTB)
#define PG8_SB(b, h) ((4 + (b) * 2 + (h)) * HTB)
#define PG8_STAGE(bufoff, gbase, voff) do { _Pragma("unroll") for (int _i = 0; _i < 2; ++_i) \
        __builtin_amdgcn_global_load_lds((const unsigned*)((const char*)(gbase) + (voff)[_i]), (PG8_LAS unsigned*)(lds + (bufoff) + ldsw + _i * 8192), 16, 0, 0); } while (0)
#define PG8_LDA(dst, b, h) do { _Pragma("unroll") for (int m = 0; m < 4; ++m) _Pragma("unroll") for (int k = 0; k < 2; ++k) dst[m][k] = *(const PG8_LAS bf16x8*)(lds + PG8_SA(b, h) + aoff + m * 2048 + k * 1024); } while (0)
#define PG8_LDB(dst, b, h) do { _Pragma("unroll") for (int n = 0; n < 2; ++n) _Pragma("unroll") for (int k = 0; k < 2; ++k) dst[n][k] = *(const PG8_LAS bf16x8*)(lds + PG8_SB(b, h) + boff + n * 2048 + k * 1024); } while (0)
#define PG8_MMA(ai, bj, At, Bt) do { __builtin_amdgcn_s_setprio(1); _Pragma("unroll") for (int m = 0; m < 4; ++m) _Pragma("unroll") for (int n = 0; n < 2; ++n) _Pragma("unroll") for (int k = 0; k < 2; ++k) \
        acc[ai][bj][m][n] = __builtin_amdgcn_mfma_f32_16x16x32_bf16(Bt[n][k], At[m][k], acc[ai][bj][m][n], 0, 0, 0); __builtin_amdgcn_s_setprio(0); } while (0)
#define PG8_WAIT_V(n) asm volatile("s_waitcnt vmcnt(" #n ")" ::: "memory")
#define PG8_WAIT_L(n) asm volatile("s_waitcnt lgkmcnt(" #n ")" ::: "memory")
#define PG8_BAR __builtin_amdgcn_s_barrier()
#define PG8_SCHED __builtin_amdgcn_sched_barrier(0)
    Unit cur, nxt; int ui = 0;
    if (!S.next(0, cur)) return;
    f32x4 acc[2][2][4][2];
#pragma unroll
    for (int a = 0; a < 2; ++a)
#pragma unroll
        for (int b = 0; b < 2; ++b)
#pragma unroll
            for (int m = 0; m < 4; ++m)
#pragma unroll
                for (int n = 0; n < 2; ++n) acc[a][b][m][n] = (f32x4){0.f, 0.f, 0.f, 0.f};
    bf16x8 At[4][2], B0[2][2], B1[2][2];
    const char* cA = (const char*)g.A + (size_t)cur.lm * tstep; const char* cB = (const char*)g.Bt + (size_t)cur.ln * tstep;
    S.a_ready(cur);
    if constexpr (SP2) {
        PG8_STAGE(PG8_SB(0, 0), cB, voffB); PG8_STAGE(PG8_SB(0, 1), cB + hstep, voffB); PG8_STAGE(PG8_SA(0, 0), cA, voffA); PG8_STAGE(PG8_SA(0, 1), cA + hstep, voffA);
        if (wr == 1) PG8_BAR;
        PG8_WAIT_V(2); PG8_BAR;
        PG8_STAGE(PG8_SB(1, 0), cB + kstep, voffB); PG8_STAGE(PG8_SA(1, 0), cA + kstep, voffA); PG8_STAGE(PG8_SB(1, 1), cB + hstep + kstep, voffB);
        PG8_WAIT_V(6); PG8_BAR;
    } else {
        PG8_STAGE(PG8_SB(0, 0), cB, voffB); PG8_STAGE(PG8_SA(0, 0), cA, voffA); PG8_STAGE(PG8_SB(0, 1), cB + hstep, voffB); PG8_STAGE(PG8_SA(0, 1), cA + hstep, voffA);
        if (wr == 1) PG8_BAR;
        PG8_WAIT_V(4); PG8_BAR;
        PG8_STAGE(PG8_SB(1, 0), cB + kstep, voffB); PG8_STAGE(PG8_SA(1, 0), cA + kstep, voffA); PG8_STAGE(PG8_SB(1, 1), cB + hstep + kstep, voffB);
        PG8_WAIT_V(6); PG8_BAR;
    }
    for (;;) {
        const bool has_next = S.next(ui + 1, nxt);
        const char* nA = has_next ? (const char*)g.A + (size_t)nxt.lm * tstep : cA; const char* nB = has_next ? (const char*)g.Bt + (size_t)nxt.ln * tstep : cB;
        for (int t = 0; t < nt; t += 2) {
            const bool last = (t == nt - 2);
            const char* a1 = cA + (size_t)(t + 1) * kstep;
            const char* a2 = last ? nA : cA + (size_t)(t + 2) * kstep; const char* b2 = last ? nB : cB + (size_t)(t + 2) * kstep;
            const char* a3 = a2 + kstep; const char* b3 = b2 + kstep;
            if (last && has_next) S.a_ready(nxt);
            if constexpr (SP2) {
            PG8_LDB(B0, 0, 0); PG8_LDB(B1, 0, 1); PG8_SCHED; PG8_LDA(At, 0, 0); PG8_STAGE(PG8_SA(1, 0), a1, voffA); PG8_STAGE(PG8_SA(1, 1), a1 + hstep, voffA);
            PG8_WAIT_V(8); PG8_WAIT_L(0); PG8_BAR; PG8_MMA(0, 0, At, B0); PG8_MMA(0, 1, At, B1); PG8_BAR; PG8_SCHED;
            PG8_LDA(At, 0, 1); PG8_STAGE(PG8_SB(0, 0), b2, voffB); PG8_STAGE(PG8_SB(0, 1), b2 + hstep, voffB);
            PG8_WAIT_V(6); PG8_WAIT_L(0); PG8_BAR; PG8_MMA(1, 0, At, B0); PG8_MMA(1, 1, At, B1); PG8_BAR; PG8_SCHED;
            PG8_LDB(B0, 1, 0); PG8_LDB(B1, 1, 1); PG8_SCHED; PG8_LDA(At, 1, 0); PG8_STAGE(PG8_SA(0, 0), a2, voffA); PG8_STAGE(PG8_SA(0, 1), a2 + hstep, voffA);
            PG8_WAIT_V(8); PG8_WAIT_L(0); PG8_BAR; PG8_MMA(0, 0, At, B0); PG8_MMA(0, 1, At, B1); PG8_BAR; PG8_SCHED;
            PG8_LDA(At, 1, 1); PG8_STAGE(PG8_SB(1, 0), b3, voffB); PG8_STAGE(PG8_SB(1, 1), b3 + hstep, voffB);
            PG8_WAIT_V(6); PG8_WAIT_L(0); PG8_BAR; PG8_MMA(1, 0, At, B0); PG8_MMA(1, 1, At, B1); PG8_BAR; PG8_SCHED;
            } else {
            PG8_LDB(B0, 0, 0); PG8_SCHED; PG8_LDA(At, 0, 0); PG8_STAGE(PG8_SA(1, 1), a1 + hstep, voffA);
            PG8_WAIT_L(8); PG8_BAR; PG8_WAIT_L(0); PG8_MMA(0, 0, At, B0); PG8_BAR; PG8_SCHED;
            PG8_LDB(B1, 0, 1); PG8_STAGE(PG8_SB(0, 0), b2, voffB);
            PG8_BAR; PG8_WAIT_L(0); PG8_MMA(0, 1, At, B1); PG8_BAR;
            PG8_LDA(At, 0, 1); PG8_STAGE(PG8_SA(0, 0), a2, voffA);
            PG8_BAR; PG8_WAIT_L(0); PG8_MMA(1, 0, At, B0); PG8_BAR; PG8_SCHED;
            PG8_STAGE(PG8_SB(0, 1), b2 + hstep, voffB);
            PG8_WAIT_V(6); PG8_BAR; PG8_MMA(1, 1, At, B1); PG8_BAR;
            PG8_LDB(B0, 1, 0); PG8_SCHED; PG8_LDA(At, 1, 0); PG8_STAGE(PG8_SA(0, 1), a2 + hstep, voffA);
            PG8_WAIT_L(8); PG8_BAR; PG8_WAIT_L(0); PG8_MMA(0, 0, At, B0); PG8_BAR; PG8_SCHED;
            PG8_LDB(B1, 1, 1); PG8_STAGE(PG8_SB(1, 0), b3, voffB);
            PG8_BAR; PG8_WAIT_L(0); PG8_MMA(0, 1, At, B1); PG8_BAR;
            PG8_LDA(At, 1, 1); PG8_STAGE(PG8_SA(1, 0), a3, voffA);
            PG8_BAR; PG8_WAIT_L(0); PG8_MMA(1, 0, At, B0); PG8_BAR; PG8_SCHED;
            PG8_STAGE(PG8_SB(1, 1), b3 + hstep, voffB);
            PG8_WAIT_V(6); PG8_BAR; PG8_MMA(1, 1, At, B1); PG8_BAR;
            }
        }
        if constexpr (ALIGN_EPI) { if (wr == 0) PG8_BAR; }
        if constexpr (!Epi::AFTER_DRAIN) { E(acc, cur, wr, wc, fr, fq); if (S.epi2) E(acc, cur, wr, wc, fr, fq); S.done(cur); }
        if (!has_next) break;
#pragma unroll
        for (int a = 0; a < 2; ++a)
#pragma unroll
            for (int b = 0; b < 2; ++b)
#pragma unroll
                for (int m = 0; m < 4; ++m)
#pragma unroll
                    for (int n = 0; n < 2; ++n) acc[a][b][m][n] = (f32x4){0.f, 0.f, 0.f, 0.f};
        cur = nxt; cA = nA; cB = nB; ++ui;
        if constexpr (ALIGN_EPI) { if (wr == 1) PG8_BAR; }
    }
    PG8_WAIT_V(0);
    if constexpr (!ALIGN_EPI) { if (wr == 0) PG8_BAR; }
    PG8_BAR;
    if constexpr (Epi::AFTER_DRAIN) { E.fused(acc, cur, wr, wc, fr, fq, lds, wid, lane); S.done(cur); }
#undef PG8_SA
#undef PG8_SB
#undef PG8_STAGE
#undef PG8_LDA
#undef PG8_LDB
#undef PG8_MMA
#undef PG8_WAIT_V
#undef PG8_WAIT_L
#undef PG8_BAR
#undef PG8_SCHED
}
}
namespace fa {
#define FA_LAS __attribute__((address_space(3)))
typedef short bf16x8 __attribute__((ext_vector_type(8)));
typedef short s16x4 __attribute__((ext_vector_type(4)));
typedef short v4i16_t __attribute__((ext_vector_type(4)));
typedef float f32x16 __attribute__((ext_vector_type(16)));
typedef float f32x4 __attribute__((ext_vector_type(4)));
typedef unsigned u32x4 __attribute__((ext_vector_type(4)));
typedef float f32x2_t __attribute__((ext_vector_type(2))); typedef __bf16 bf16x2_t __attribute__((ext_vector_type(2)));
constexpr float THR = 8.f, TH_SKIP = 32.f;
constexpr int F_KBUF = 18432, F_AOFF = 8192, F_VOFF = 10240, F_WSF = 3 * F_KBUF, F_FLAG = F_WSF + 8 * 256, F_OST = F_FLAG + 256, F_LDS_BYTES = F_OST + 8 * 4096;
constexpr int S_KBUF = 16384, S_VOFF = 8192, S_WSF = 6 * S_KBUF, S_OST = S_WSF + 8 * 256, S_LDS_BYTES = S_OST + 8 * 4096;
struct Params { const bf16_t* Q; const bf16_t* K; const bf16_t* V; const bf16_t* G; bf16_t* O; const float* CUM; const float* sinks; const unsigned* KMAX; unsigned* ticket; const bf16_t* KAUG; };
__device__ __forceinline__ unsigned cvtpk(float lo, float hi) { f32x2_t v = {lo, hi}; bf16x2_t b = __builtin_convertvector(v, bf16x2_t); return __builtin_bit_cast(unsigned, b); }
__device__ __forceinline__ s16x4 vtr(FA_LAS unsigned char* p) { return __builtin_bit_cast(s16x4, __builtin_amdgcn_ds_read_tr16_b64_v4i16((FA_LAS v4i16_t*)p)); }
__device__ __forceinline__ float swap_max(float v) { auto rr = __builtin_amdgcn_permlane32_swap(__float_as_uint(v), __float_as_uint(v), false, false); return __builtin_fmaxf(__uint_as_float(rr[0]), __uint_as_float(rr[1])); }
__device__ __forceinline__ float swap_add(float v) { auto rr = __builtin_amdgcn_permlane32_swap(__float_as_uint(v), __float_as_uint(v), false, false); return __uint_as_float(rr[0]) + __uint_as_float(rr[1]); }
__device__ __forceinline__ void glds16(const void* gsrc, unsigned lds_dst) { unsigned keep;
    asm volatile("s_mov_b32 %0, m0\n\ts_mov_b32 m0, %2\n\ts_nop 0\n\tglobal_load_lds_dwordx4 %1, off\n\ts_mov_b32 m0, %0" : "=&s"(keep) : "v"(gsrc), "s"(lds_dst) : "memory"); }
#define FA_MFMA(a, b, c) __builtin_amdgcn_mfma_f32_32x32x16_bf16((a), (b), (c), 0, 0, 0)
#define FA_MX3(a, b, c) __builtin_fmaxf(__builtin_fmaxf((a), (b)), (c))
struct WaveSt { bf16x8 qr[4]; bf16x8 qa; f32x16 o0, o1; float cq, mhat, lsum, mrun; };

#define FA_SBAR() __builtin_amdgcn_sched_barrier(0)
#define FA_PIN(x) asm volatile("" : "+v"(x))
#define FA_LDK(p) (*(FA_LAS bf16x8*)(p))
#define FA_VF(l, h) ((bf16x8){l[0], l[1], l[2], l[3], h[0], h[1], h[2], h[3]})
#define FA_EX4(X, B) do { X[B] = __builtin_amdgcn_exp2f(X[B]); X[B + 1] = __builtin_amdgcn_exp2f(X[B + 1]); X[B + 2] = __builtin_amdgcn_exp2f(X[B + 2]); X[B + 3] = __builtin_amdgcn_exp2f(X[B + 3]); } while (0)
__device__ __forceinline__ void split3(float v, unsigned& h1, unsigned& h2, unsigned& h3) { const bf16_t a = f2bf(v); const float r1 = v - bf2f(a); const bf16_t b = f2bf(r1); const float r2 = r1 - bf2f(b); h1 = a; h2 = b; h3 = f2bf(r2); }
__device__ __forceinline__ void set_qa(WaveSt& w, int hi) {
    unsigned g1, g2, g3; split3(w.cq - w.mhat, g1, g2, g3);
    const u32x4 q = {hi == 0 ? 0x3F803F80u : 0u, hi == 0 ? (0x3F80u | (g1 << 16)) : 0u, hi == 0 ? (g2 | (g3 << 16)) : 0u, 0u};
    w.qa = __builtin_bit_cast(bf16x8, q);
}
template <int MODE, int AOFF, int VOFF>
__device__ __forceinline__ void tile_full(FA_LAS unsigned char* bb, FA_LAS unsigned char* vprev, FA_LAS float* wsf, WaveSt& w, f32x16& C0, f32x16& C1, f32x16& P0, f32x16& P1,
                                          int k0, int t, int qlo, int lane, int r32, int hi) {
    constexpr int W = MODE == 0 ? 0x40000000 : 128;
    FA_LAS unsigned char* kp = bb + hi * 1024 + r32 * 16; FA_LAS unsigned char* ap = bb + AOFF + r32 * 16;
    FA_LAS unsigned char* vp = vprev + VOFF + ((lane >> 4) & 1) * 32 + (lane & 3) * 8 + (4 * hi + ((lane & 15) >> 2)) * 64;
    bf16x8 kf0 = FA_LDK(kp), kf1 = FA_LDK(kp + 512), kf2 = FA_LDK(kp + 2048), kf3 = FA_LDK(kp + 2560), kf4, kf5, kf6, kf7, ka0, ka1;
    s16x4 vl0, vh0, vl1, vh1, vl2, vh2, vl3, vh3, vl4, vh4, vl5, vh5, vl6, vh6, vl7, vh7;
    u32x4 pw0, pw1, pw2, pw3; float sacc;
    const f32x16 Z = {0.f, 0.f, 0.f, 0.f, 0.f, 0.f, 0.f, 0.f, 0.f, 0.f, 0.f, 0.f, 0.f, 0.f, 0.f, 0.f};
    FA_SBAR();
    C0 = FA_MFMA(kf0, w.qr[0], Z); kf4 = FA_LDK(kp + 4096);
    sacc = (P0[0] + P0[1]) + (P0[2] + P0[3]); pw0.x = cvtpk(P0[0], P0[1]); pw0.y = cvtpk(P0[2], P0[3]); FA_PIN(sacc); FA_PIN(pw0.x); FA_PIN(pw0.y);
    FA_SBAR();
    C1 = FA_MFMA(kf1, w.qr[0], Z); kf5 = FA_LDK(kp + 4608);
    sacc += P0[4]; sacc += P0[5]; sacc += P0[6]; sacc += P0[7]; pw0.z = cvtpk(P0[4], P0[5]); pw0.w = cvtpk(P0[6], P0[7]); FA_PIN(sacc); FA_PIN(pw0.z); FA_PIN(pw0.w);
    FA_SBAR();
    C0 = FA_MFMA(kf2, w.qr[1], C0); kf6 = FA_LDK(kp + 6144);
    sacc += P0[8]; sacc += P0[9]; sacc += P0[10]; sacc += P0[11]; pw1.x = cvtpk(P0[8], P0[9]); pw1.y = cvtpk(P0[10], P0[11]); FA_PIN(sacc); FA_PIN(pw1.x); FA_PIN(pw1.y);
    FA_SBAR();
    C1 = FA_MFMA(kf3, w.qr[1], C1); kf7 = FA_LDK(kp + 6656);
    sacc += P0[12]; sacc += P0[13]; sacc += P0[14]; sacc += P0[15]; pw1.z = cvtpk(P0[12], P0[13]); pw1.w = cvtpk(P0[14], P0[15]); FA_PIN(sacc); FA_PIN(pw1.z); FA_PIN(pw1.w);
    FA_SBAR();
    C0 = FA_MFMA(kf4, w.qr[2], C0); if (MODE == 0) { ka0 = FA_LDK(ap); ka1 = FA_LDK(ap + 512); } else { const u32x4 kc = {0u, 0x3F800000u, 0x3F803F80u, 0u}; ka0 = __builtin_bit_cast(bf16x8, kc); ka1 = ka0; }
    sacc += P1[0]; sacc += P1[1]; sacc += P1[2]; sacc += P1[3]; pw2.x = cvtpk(P1[0], P1[1]); pw2.y = cvtpk(P1[2], P1[3]); FA_PIN(sacc); FA_PIN(pw2.x); FA_PIN(pw2.y);
    FA_SBAR();
    C1 = FA_MFMA(kf5, w.qr[2], C1); vl0 = vtr(vp); vh0 = vtr(vp + 512);
    sacc += P1[4]; sacc += P1[5]; sacc += P1[6]; sacc += P1[7]; pw2.z = cvtpk(P1[4], P1[5]); pw2.w = cvtpk(P1[6], P1[7]); FA_PIN(sacc); FA_PIN(pw2.z); FA_PIN(pw2.w);
    FA_SBAR();
    C0 = FA_MFMA(kf6, w.qr[3], C0); vl4 = vtr(vp + 4096); vh4 = vtr(vp + 4096 + 512);
    sacc += P1[8]; sacc += P1[9]; sacc += P1[10]; sacc += P1[11]; pw3.x = cvtpk(P1[8], P1[9]); pw3.y = cvtpk(P1[10], P1[11]); FA_PIN(sacc); FA_PIN(pw3.x); FA_PIN(pw3.y);
    FA_SBAR();
    C1 = FA_MFMA(kf7, w.qr[3], C1); vl1 = vtr(vp + 1024); vh1 = vtr(vp + 1024 + 512);
    sacc += P1[12]; sacc += P1[13]; sacc += P1[14]; sacc += P1[15]; pw3.z = cvtpk(P1[12], P1[13]); pw3.w = cvtpk(P1[14], P1[15]); FA_PIN(sacc); FA_PIN(pw3.z); FA_PIN(pw3.w);
    FA_SBAR();
    C0 = FA_MFMA(ka0, w.qa, C0); vl5 = vtr(vp + 4096 + 1024); vh5 = vtr(vp + 4096 + 1024 + 512); FA_SBAR();
    C1 = FA_MFMA(ka1, w.qa, C1); FA_SBAR();
    w.lsum += sacc;
    const bf16x8 pa0 = __builtin_bit_cast(bf16x8, pw0), pa1 = __builtin_bit_cast(bf16x8, pw1), pa2 = __builtin_bit_cast(bf16x8, pw2), pa3 = __builtin_bit_cast(bf16x8, pw3);
    vl2 = vtr(vp + 2048); vh2 = vtr(vp + 2048 + 512);
    w.o0 = FA_MFMA(pa0, FA_VF(vl0, vh0), w.o0); vl6 = vtr(vp + 4096 + 2048); vh6 = vtr(vp + 4096 + 2048 + 512);
    w.o1 = FA_MFMA(pa0, FA_VF(vl4, vh4), w.o1);
    FA_SBAR();
    if ((k0 + 63 > qlo) || (MODE == 1 && k0 <= qlo + 31 - W)) {
        const float NEG = -__builtin_inff(); const int dq = t - k0 - 4 * hi;
#pragma unroll
        for (int r = 0; r < 16; ++r) { const int c = (r & 3) + 8 * (r >> 2); if ((unsigned)(dq - c) >= (unsigned)W) C0[r] = NEG; if ((unsigned)(dq - c - 32) >= (unsigned)W) C1[r] = NEG; }
    }
    float ma = FA_MX3(C0[0], C0[1], C1[0]), mb = FA_MX3(C0[2], C0[3], C1[1]); ma = FA_MX3(ma, C1[2], C1[3]);
#pragma unroll
    for (int r = 4; r < 16; r += 4) { ma = FA_MX3(ma, C0[r], C0[r + 1]); mb = FA_MX3(mb, C0[r + 2], C0[r + 3]); ma = FA_MX3(ma, C1[r], C1[r + 1]); mb = FA_MX3(mb, C1[r + 2], C1[r + 3]); }
    const float rm = swap_max(__builtin_fmaxf(ma, mb));
    if (MODE == 0) w.mrun = __builtin_fmaxf(w.mrun, rm + w.mhat);
    const bool resc = __any(rm > THR);
    if (resc) {
        const float dl = __builtin_fmaxf(rm, 0.f); w.mhat += dl;
#pragma unroll
        for (int r = 0; r < 16; ++r) { C0[r] -= dl; C1[r] -= dl; }
        set_qa(w, hi);
        const float f = __builtin_amdgcn_exp2f(-dl); w.lsum *= f;
        if (hi == 0) wsf[r32] = f;
    }
    FA_SBAR();
    FA_EX4(C0, 0); FA_PIN(C0); vl3 = vtr(vp + 3072); vh3 = vtr(vp + 3072 + 512);
    w.o0 = FA_MFMA(pa1, FA_VF(vl1, vh1), w.o0); FA_EX4(C0, 4); FA_EX4(C0, 8); FA_PIN(C0); vl7 = vtr(vp + 4096 + 3072); vh7 = vtr(vp + 4096 + 3072 + 512); FA_SBAR();
    w.o1 = FA_MFMA(pa1, FA_VF(vl5, vh5), w.o1); FA_EX4(C0, 12); FA_PIN(C0); FA_EX4(C1, 0); FA_PIN(C1); FA_SBAR();
    w.o0 = FA_MFMA(pa2, FA_VF(vl2, vh2), w.o0); FA_EX4(C1, 4); FA_PIN(C1); FA_SBAR();
    w.o1 = FA_MFMA(pa2, FA_VF(vl6, vh6), w.o1); FA_EX4(C1, 8); FA_PIN(C1); FA_SBAR();
    w.o0 = FA_MFMA(pa3, FA_VF(vl3, vh3), w.o0); FA_EX4(C1, 12); FA_PIN(C1); FA_SBAR();
    w.o1 = FA_MFMA(pa3, FA_VF(vl7, vh7), w.o1); FA_SBAR();
    if (resc) {
        asm volatile("s_waitcnt lgkmcnt(0)" ::: "memory");
#pragma unroll
        for (int g = 0; g < 4; ++g) { const f32x4 a4 = *(FA_LAS f32x4*)(wsf + 8 * g + 4 * hi);
#pragma unroll
            for (int i = 0; i < 4; ++i) { w.o0[4 * g + i] *= a4[i]; w.o1[4 * g + i] *= a4[i]; } }
    }
}
template <int VOFF>
__device__ __forceinline__ void drain_full(FA_LAS unsigned char* vlast, WaveSt& w, f32x16& P0, f32x16& P1, int lane, int hi) {
    FA_LAS unsigned char* vp = vlast + VOFF + ((lane >> 4) & 1) * 32 + (lane & 3) * 8 + (4 * hi + ((lane & 15) >> 2)) * 64;
    float s0 = 0.f, s1 = 0.f;
#pragma unroll
    for (int r = 0; r < 16; ++r) { s0 += P0[r]; s1 += P1[r]; }
    w.lsum += s0 + s1;
    const u32x4 w0 = {cvtpk(P0[0], P0[1]), cvtpk(P0[2], P0[3]), cvtpk(P0[4], P0[5]), cvtpk(P0[6], P0[7])};
    const u32x4 w1 = {cvtpk(P0[8], P0[9]), cvtpk(P0[10], P0[11]), cvtpk(P0[12], P0[13]), cvtpk(P0[14], P0[15])};
    const u32x4 w2 = {cvtpk(P1[0], P1[1]), cvtpk(P1[2], P1[3]), cvtpk(P1[4], P1[5]), cvtpk(P1[6], P1[7])};
    const u32x4 w3 = {cvtpk(P1[8], P1[9]), cvtpk(P1[10], P1[11]), cvtpk(P1[12], P1[13]), cvtpk(P1[14], P1[15])};
    const bf16x8 pa0 = __builtin_bit_cast(bf16x8, w0), pa1 = __builtin_bit_cast(bf16x8, w1), pa2 = __builtin_bit_cast(bf16x8, w2), pa3 = __builtin_bit_cast(bf16x8, w3);
#define FA_PV(ks, pa) do { const s16x4 l0_ = vtr(vp + (ks) * 1024), h0_ = vtr(vp + (ks) * 1024 + 512), l1_ = vtr(vp + 4096 + (ks) * 1024), h1_ = vtr(vp + 4096 + (ks) * 1024 + 512); \
    w.o0 = FA_MFMA(pa, FA_VF(l0_, h0_), w.o0); w.o1 = FA_MFMA(pa, FA_VF(l1_, h1_), w.o1); } while (0)
    FA_PV(0, pa0); FA_PV(1, pa1); FA_PV(2, pa2); FA_PV(3, pa3);
#undef FA_PV
}
__device__ __forceinline__ void load_gate(u32x4 (&gq)[4], const bf16_t* G, size_t grow, int h, int lane) {
#pragma unroll
    for (int d0 = 0; d0 < 2; ++d0)
#pragma unroll
        for (int i = 0; i < 2; ++i) gq[2 * d0 + i] = *(const u32x4*)(G + hm_off((int)grow + i * 16 + (lane >> 2), h * 64 + d0 * 32 + (lane & 3) * 8, NH));
}
__device__ __forceinline__ void wave_epilogue(FA_LAS float* stg, FA_LAS float* wsf, WaveSt& w, const u32x4 (&gq)[4], bf16_t* O, size_t grow, int h, int lane, int r32, int hi) {
    const float l = swap_add(w.lsum);
    if (hi == 0) wsf[r32] = l;
    asm volatile("s_waitcnt lgkmcnt(0)" ::: "memory");
    float rl[16];
#pragma unroll
    for (int g = 0; g < 4; ++g) { const f32x4 l4 = *(FA_LAS f32x4*)(wsf + 8 * g + 4 * hi);
#pragma unroll
        for (int i = 0; i < 4; ++i) rl[4 * g + i] = 1.0f / l4[i]; }
#pragma unroll
    for (int d0 = 0; d0 < 2; ++d0) {
#pragma unroll
        for (int g = 0; g < 4; ++g)
#pragma unroll
            for (int i = 0; i < 4; ++i) stg[(8 * g + 4 * hi + i) * 32 + r32] = (d0 == 0 ? w.o0[4 * g + i] : w.o1[4 * g + i]) * rl[4 * g + i];
        asm volatile("s_waitcnt lgkmcnt(0)" ::: "memory");
#pragma unroll
        for (int i = 0; i < 2; ++i) { const int row = i * 16 + (lane >> 2), ch = lane & 3;
            const f32x4 x0 = *(FA_LAS f32x4*)(stg + row * 32 + ch * 8), x1 = *(FA_LAS f32x4*)(stg + row * 32 + ch * 8 + 4);
            const size_t ga = (grow + row) * DM + h * 64 + d0 * 32 + ch * 8; const u32x4 gv = gq[2 * d0 + i];
            u32x4 ov;
            ov.x = cvtpk(x0[0] * __uint_as_float(gv.x << 16), x0[1] * __uint_as_float(gv.x & 0xffff0000u)); ov.y = cvtpk(x0[2] * __uint_as_float(gv.y << 16), x0[3] * __uint_as_float(gv.y & 0xffff0000u));
            ov.z = cvtpk(x1[0] * __uint_as_float(gv.z << 16), x1[1] * __uint_as_float(gv.z & 0xffff0000u)); ov.w = cvtpk(x1[2] * __uint_as_float(gv.w << 16), x1[3] * __uint_as_float(gv.w & 0xffff0000u));
            *(u32x4*)(O + tiled_off((int)(grow + row), h * 64 + d0 * 32 + ch * 8)) = ov; }
        asm volatile("s_waitcnt lgkmcnt(0)" ::: "memory");
    }
}
template <int MODE> __device__ __forceinline__ void wave_init(WaveSt& w, int hi) {
#pragma unroll
    for (int r = 0; r < 16; ++r) { w.o0[r] = 0.f; w.o1[r] = 0.f; }
    set_qa(w, hi);
}

__device__ __forceinline__ void fox_unit(FA_LAS unsigned char* lds, const Params& P, int b, int h, int qb) {
    const int tid = threadIdx.x, lane = tid & 63, r32 = lane & 31, hi = lane >> 5;
    const int wid = __builtin_amdgcn_readfirstlane(tid >> 6);
    const int q0 = qb * 256, qlo = q0 + wid * 32, t = qlo + r32;
    const size_t rowbase = (size_t)b * SEQ;
    const bf16_t* ksrc = P.K + hm_off((int)rowbase + lane, h * 64 + wid * 8, NH);
    const bf16_t* vsrc = P.V + hm_off((int)rowbase + 16 * (wid & 3) + (lane >> 2), h * 64 + (wid >> 2) * 32 + (lane & 3) * 8, NH);
    const float* cum = P.CUM + (size_t)(b * NH + h) * SEQ;
    const bf16_t* asrc = P.KAUG + ((size_t)(b * NH + h) * SEQ + lane) * 8;
    const int NT = (q0 + 256) / 64;
    WaveSt w; float qn = 0.f;
#pragma unroll
    for (int d0 = 0; d0 < 4; ++d0) { w.qr[d0] = *(const bf16x8*)(P.Q + hm_off((int)rowbase + t, h * 64 + d0 * 16 + hi * 8, NH));
#pragma unroll
        for (int j = 0; j < 8; ++j) { const float qv = bf2f((bf16_t)w.qr[d0][j]); qn = fmaf(qv, qv, qn); } }
    w.cq = cum[t]; w.mhat = 0.f; w.lsum = 0.f; w.mrun = -1e30f;
    wave_init<0>(w, hi);
    u32x4 gq[4]; load_gate(gq, P.G, rowbase + qlo, h, lane);
    const float qkb = sqrtf(swap_add(qn) * (__uint_as_float(P.KMAX[(b * NH + h) * 2]) + __uint_as_float(P.KMAX[(b * NH + h) * 2 + 1]))) * 1.01f + 1e-3f;
    FA_LAS float* wsf = (FA_LAS float*)(lds + F_WSF) + wid * 64;
    FA_LAS unsigned* votes = (FA_LAS unsigned*)(lds + F_FLAG);
    float cnew = 0.f;
#define FA_LOADT(j, bf) do { const size_t ko_ = (size_t)(j) * 64 * 32; FA_LAS unsigned char* bb_ = lds + (bf) * F_KBUF; \
        glds16(ksrc + ko_, (unsigned)__builtin_amdgcn_readfirstlane((int)(unsigned)(uintptr_t)(bb_ + wid * 1024))); \
        glds16(vsrc + ko_, (unsigned)__builtin_amdgcn_readfirstlane((int)(unsigned)(uintptr_t)(bb_ + F_VOFF + (wid >> 2) * 4096 + (wid & 3) * 1024))); \
        if (wid == 0) glds16(asrc + (size_t)(j) * 64 * 8, (unsigned)__builtin_amdgcn_readfirstlane((int)(unsigned)(uintptr_t)(bb_ + F_AOFF))); \
        cnew = cum[(j) * 64 + 63]; } while (0)
    FA_LOADT(NT - 1, 0); asm volatile("s_waitcnt vmcnt(0)" ::: "memory"); __syncthreads();
    bool wdone = false; int n = 0; f32x16 pA0, pA1, pB0, pB1;
#pragma unroll
    for (int r = 0; r < 16; ++r) { pA0[r] = 0.f; pA1[r] = 0.f; pB0[r] = 0.f; pB1[r] = 0.f; }
    int cur = 0; bool fin = false;
#define FA_WALK(tt, CA0, CA1, PA0, PA1) do { \
        const int j = NT - 1 - (tt), k0 = j * 64; const int nxt = cur == 2 ? 0 : cur + 1, prv = cur == 0 ? 2 : cur - 1; \
        if (j > 0) FA_LOADT(j - 1, nxt); \
        if (!wdone && k0 <= qlo + 31) { FA_LAS unsigned char* bb = lds + cur * F_KBUF; \
            tile_full<0, F_AOFF, F_VOFF>(bb, n > 0 ? lds + prv * F_KBUF : bb, wsf, w, CA0, CA1, PA0, PA1, k0, t, qlo, lane, r32, hi); ++n; } \
        if (j > 0) { \
            if (!wdone && n > 0 && __all(qkb + w.cq - cnew - w.mrun <= -TH_SKIP)) { wdone = true; drain_full<F_VOFF>(lds + cur * F_KBUF, w, CA0, CA1, lane, hi); } \
            if (lane == 0) votes[((tt) & 1) * 8 + wid] = wdone ? 1u : 0u; } \
        asm volatile("s_waitcnt vmcnt(0)" ::: "memory"); \
        __syncthreads(); \
        if (j > 0) { const u32x4 v0 = *(FA_LAS u32x4*)(votes + ((tt) & 1) * 8), v1 = *(FA_LAS u32x4*)(votes + ((tt) & 1) * 8 + 4); \
            if ((v0.x & v0.y & v0.z & v0.w & v1.x & v1.y & v1.z & v1.w) != 0u) fin = true; } \
        else { if (!wdone && n > 0) drain_full<F_VOFF>(lds + cur * F_KBUF, w, CA0, CA1, lane, hi); fin = true; } \
        cur = nxt; } while (0)
    for (int tt = 0; !fin; tt += 2) {
        FA_WALK(tt, pA0, pA1, pB0, pB1);
        if (fin) break;
        FA_WALK(tt + 1, pB0, pB1, pA0, pA1);
    }
#undef FA_WALK
#undef FA_LOADT
    wave_epilogue((FA_LAS float*)(lds + F_OST + wid * 4096), wsf, w, gq, P.O, rowbase + qlo, h, lane, r32, hi);
    __syncthreads();
}
__device__ __forceinline__ void swa_unit(FA_LAS unsigned char* lds, const Params& P, int b, int kvh, int qb, int hh_lo = 0, int hh_hi = 8) {
    const int tid = threadIdx.x, lane = tid & 63, r32 = lane & 31, hi = lane >> 5;
    const int wid = __builtin_amdgcn_readfirstlane(tid >> 6);
    const int q0 = qb * 256, qlo = q0 + wid * 32, t = qlo + r32;
    const size_t rowbase = (size_t)b * SEQ;
    const int j_lo = q0 >= 128 ? (q0 - 128) / 64 : 0, NT = (q0 + 256) / 64 - j_lo;
    const bf16_t* ksrc = P.K + hm_off((int)rowbase + j_lo * 64 + lane, kvh * 64 + wid * 8, 4);
    const bf16_t* vsrc = P.V + hm_off((int)rowbase + j_lo * 64 + 16 * (wid & 3) + (lane >> 2), kvh * 64 + (wid >> 2) * 32 + (lane & 3) * 8, 4);
    for (int i = 0; i < NT; ++i) {
        glds16(ksrc + (size_t)i * 64 * 32, (unsigned)__builtin_amdgcn_readfirstlane((int)(unsigned)(uintptr_t)(lds + i * S_KBUF + wid * 1024)));
        glds16(vsrc + (size_t)i * 64 * 32, (unsigned)__builtin_amdgcn_readfirstlane((int)(unsigned)(uintptr_t)(lds + i * S_KBUF + S_VOFF + (wid >> 2) * 4096 + (wid & 3) * 1024))); }
    asm volatile("s_waitcnt vmcnt(0)" ::: "memory");
    __syncthreads();
    FA_LAS float* wsf = (FA_LAS float*)(lds + S_WSF) + wid * 64;
    const int ta = (qlo >= 127 ? (qlo - 127) / 64 : 0) - j_lo, tb = (qlo + 31) / 64 - j_lo;
    for (int hh = hh_lo; hh < hh_hi; ++hh) {
        const int h = kvh * 8 + hh;
        WaveSt w;
#pragma unroll
        for (int d0 = 0; d0 < 4; ++d0) w.qr[d0] = *(const bf16x8*)(P.Q + hm_off((int)rowbase + t, h * 64 + d0 * 16 + hi * 8, NH));
        u32x4 gq[4]; load_gate(gq, P.G, rowbase + qlo, h, lane);
        w.cq = 0.f; w.mhat = P.sinks[h] * LOG2E; w.lsum = 0.5f; w.mrun = 0.f;
        wave_init<1>(w, hi);
        f32x16 pA0, pA1, pB0, pB1;
#pragma unroll
        for (int r = 0; r < 16; ++r) { pB0[r] = 0.f; pB1[r] = 0.f; }
        for (int ti = tb;;) {
            { FA_LAS unsigned char* bb = lds + ti * S_KBUF;
              tile_full<1, 0, S_VOFF>(bb, ti == tb ? bb : bb + S_KBUF, wsf, w, pA0, pA1, pB0, pB1, (j_lo + ti) * 64, t, qlo, lane, r32, hi); }
            if (ti == ta) { drain_full<S_VOFF>(lds + ta * S_KBUF, w, pA0, pA1, lane, hi); break; }
            --ti;
            { FA_LAS unsigned char* bb = lds + ti * S_KBUF;
              tile_full<1, 0, S_VOFF>(bb, bb + S_KBUF, wsf, w, pB0, pB1, pA0, pA1, (j_lo + ti) * 64, t, qlo, lane, r32, hi); }
            if (ti == ta) { drain_full<S_VOFF>(lds + ta * S_KBUF, w, pB0, pB1, lane, hi); break; }
            --ti;
        }
        wave_epilogue((FA_LAS float*)(lds + S_OST + wid * 4096), wsf, w, gq, P.O, rowbase + qlo, h, lane, r32, hi);
    }
    __syncthreads();
}
}
#define GAS __attribute__((address_space(1)))
#define LAS __attribute__((address_space(3)))
typedef unsigned short bf16;
typedef unsigned v4u __attribute__((ext_vector_type(4)));
typedef float f32x4 __attribute__((ext_vector_type(4)));
typedef short bf16x8 __attribute__((ext_vector_type(8)));
typedef GAS unsigned gu32;
typedef GAS unsigned long long gu64;
#define RLX_AGENT __ATOMIC_RELAXED, __HIP_MEMORY_SCOPE_AGENT
#define LDS_WAIT() asm volatile("s_waitcnt lgkmcnt(0)" ::: "memory")
#define VM_WAIT() asm volatile("s_waitcnt vmcnt(0)" ::: "memory")
__device__ __forceinline__ unsigned long long rt() { return __builtin_amdgcn_s_memrealtime(); }
__device__ __forceinline__ unsigned pk2(float lo, float hi) { return (unsigned)f2bf(lo) | ((unsigned)f2bf(hi) << 16); }
#define XB_TMO      128
#define XB_XCNT(j)  (256  + 64 * (j))
#define XB_XSUB(j)  (1280 + 64 * (j))
#define XB_XGEN(j)  (2304 + 64 * (j))
#define XB_TOP      3328
#define XB_TOPGEN   3392
#define XCD_BAR_WORDS 3456
#define XB_SPIN_CAP (1u << 18)

__device__ __forceinline__ unsigned xb_ld(unsigned* p)              { return __hip_atomic_load(p, __ATOMIC_RELAXED, __HIP_MEMORY_SCOPE_AGENT); }
__device__ __forceinline__ unsigned xb_add(unsigned* p, unsigned v) { return __hip_atomic_fetch_add(p, v, __ATOMIC_RELAXED, __HIP_MEMORY_SCOPE_AGENT); }
__device__ __forceinline__ unsigned xb_xcc_id() { return (unsigned)__builtin_amdgcn_s_getreg((3 << 11) | 20) & 0xFu; }
#define XB_SPIN(cond, bar) do { unsigned _sp = 0; while (cond) { __builtin_amdgcn_s_sleep(1); \
    if ((++_sp & 255u) == 0u) { if (xb_ld(&(bar)[XB_TMO])) break; if (_sp > XB_SPIN_CAP) { atomicAdd(&(bar)[XB_TMO], 1u); break; } } } } while (0)

struct XcdBarrier {
    unsigned* bar; unsigned x;
    volatile LAS unsigned* st;
};

__device__ __forceinline__ XcdBarrier xcd_barrier_post(unsigned* bar, volatile LAS unsigned* st) {
    XcdBarrier b; b.bar = bar; b.x = xb_xcc_id(); b.st = st;
    if (threadIdx.x == 0) (void)xb_add(&bar[XB_XCNT(b.x)], 1u);
    return b;
}
__device__ __forceinline__ void xcd_barrier_complete(unsigned* bar, unsigned x, unsigned& nloc, unsigned& nx) {
    const unsigned G = gridDim.x * gridDim.y * gridDim.z;
    unsigned sum, cnt, mine, sp = 0u;
    for (;;) {
        sum = 0u; cnt = 0u; mine = 0u;
#pragma unroll
        for (unsigned j = 0; j < 16; ++j) { const unsigned c = xb_ld(&bar[XB_XCNT(j)]); sum += c; cnt += (c > 0u) ? 1u : 0u; mine = (j == x) ? c : mine; }
        if (sum == G) break;
        __builtin_amdgcn_s_sleep(1);
        if ((++sp & 255u) == 0u) { if (xb_ld(&bar[XB_TMO])) break; if (sp > XB_SPIN_CAP) { atomicAdd(&bar[XB_TMO], 1u); break; } }
    }
    nloc = mine > 0u ? mine : 1u; nx = cnt > 0u ? cnt : 1u;
}

__device__ __forceinline__ void xcd_barrier(const XcdBarrier& b) {
    asm volatile("s_waitcnt vmcnt(0)" ::: "memory");
    __syncthreads();
    if (threadIdx.x == 0) {
        unsigned* bar = b.bar;
        __builtin_amdgcn_s_waitcnt(0);
        unsigned nloc = b.st[0], nx = b.st[1];
        if (nloc == 0u) { xcd_barrier_complete(bar, b.x, nloc, nx); b.st[0] = nloc; b.st[1] = nx; }
        const unsigned old = xb_add(&bar[XB_XSUB(b.x)], 1u);
        const unsigned gen = old / nloc;
        if (old + 1u == (gen + 1u) * nloc) {
            __builtin_amdgcn_fence(__ATOMIC_RELEASE, "agent");
            asm volatile("s_waitcnt vmcnt(0)" ::: "memory");
            const unsigned og = xb_add(&bar[XB_TOP], 1u);
            const unsigned tg = og / nx;
            if (og + 1u == (tg + 1u) * nx) xb_add(&bar[XB_TOPGEN], 1u);
            else XB_SPIN(xb_ld(&bar[XB_TOPGEN]) == tg, bar);
            __builtin_amdgcn_fence(__ATOMIC_ACQUIRE, "agent");
            xb_add(&bar[XB_XGEN(b.x)], 1u);
            asm volatile("s_waitcnt vmcnt(0)" ::: "memory");
        } else {
            XB_SPIN(xb_ld(&bar[XB_XGEN(b.x)]) == gen, bar);
            __builtin_amdgcn_fence(__ATOMIC_ACQUIRE, "agent");
            asm volatile("s_waitcnt vmcnt(0)" ::: "memory");
        }
    }
    __syncthreads();
}
constexpr int NWAVES = 8;
constexpr int N1P = 8448;
constexpr int RING_OFF = 0, RING_BYTES = 135168;
constexpr int LDSCTL_OFF = RING_BYTES, MISC_OFF = LDSCTL_OFF + 320;
constexpr int LDS_BYTES = 147456;
constexpr int CW_BAR = 4096;
static_assert(fa::F_LDS_BYTES <= RING_BYTES && fa::S_LDS_BYTES <= RING_BYTES && pg8::STAGE_BYTES <= RING_BYTES && MISC_OFF + 128 <= LDS_BYTES && (CW_BAR + XCD_BAR_WORDS) * 4 <= (int)WS_KMAX, "LDS / CTL map");

__device__ __forceinline__ void p0_transpose_item(const float* W, int K, int N, bf16* WT, LAS float* scr, int item, int lane, const float* gs) {
    const int nblk = N / 32, kb = item / nblk, nb = item % nblk, k0 = 64 * kb, n0 = 32 * nb;
    const int kr = lane >> 3, nc = 4 * (lane & 7);
    f32x4 wv[8];
#pragma unroll
    for (int i = 0; i < 8; ++i) wv[i] = __builtin_nontemporal_load((const GAS f32x4*)(W + (size_t)(k0 + 8 * i + kr) * N + n0 + nc));
#pragma unroll
    for (int i = 0; i < 8; ++i) { const int kk = 8 * i + kr; f32x4 w = wv[i]; if (gs) w = w * gs[k0 + kk]; LAS float* d = scr + kk * 33 + nc; d[0] = w.x; d[1] = w.y; d[2] = w.z; d[3] = w.w; }
    LDS_WAIT(); asm volatile("" ::: "memory");
    const int c = lane & 7;
#pragma unroll
    for (int j = 0; j < 4; ++j) { const int n = (lane >> 3) + 8 * j; const LAS float* sp = scr + (8 * c) * 33 + n;
        v4u o; o.x = pk2(sp[0 * 33], sp[1 * 33]); o.y = pk2(sp[2 * 33], sp[3 * 33]); o.z = pk2(sp[4 * 33], sp[5 * 33]); o.w = pk2(sp[6 * 33], sp[7 * 33]);
        *(GAS v4u*)(WT + tiled_off(n0 + n, k0 + 8 * c)) = o; }
    LDS_WAIT(); asm volatile("" ::: "memory");
}
__device__ __forceinline__ float wave_sum(float v) {
#pragma unroll
    for (int o = 1; o < 64; o <<= 1) v += __shfl_xor(v, o);
    return v;
}

struct Args { const float* in[9]; float* out; unsigned char* ws; int ph_lo, ph_hi; };
constexpr int N_PHASES = 9;
__global__ void __launch_bounds__(NWAVES * 64, 2) mega_fwd(Args args) {
    extern __shared__ __attribute__((aligned(16))) unsigned char lds_raw[];
    LAS unsigned char* lds = (LAS unsigned char*)lds_raw;
    volatile LAS unsigned* MISC = (volatile LAS unsigned*)(lds + MISC_OFF);
    const int tid = threadIdx.x, lane = tid & 63, wave = __builtin_amdgcn_readfirstlane(tid >> 6);
    const int G = gridDim.x, bx = blockIdx.x, vcu = (G % 8 == 0) ? (bx % 8) * (G / 8) + bx / 8 : bx;
    unsigned char* ws = args.ws;
    const float* x = args.in[0]; const float* norm_g = args.in[1]; const float* fox_w_in = args.in[2]; const float* fox_b_f = args.in[3]; const float* fox_w_out = args.in[4];
    const float* swa_w_in = args.in[5]; const float* swa_sinks = args.in[6]; const float* swa_w_out = args.in[7]; const float* final_g = args.in[8];
    float* out = args.out;
    gu32* ctl = (gu32*)(ws + WS_CTL);
    unsigned* KMAX = (unsigned*)(ws + WS_KMAX); unsigned* TICKET = (unsigned*)(ws + WS_TICKET);
    float* SS1 = (float*)(ws + WS_SS1); float* R0 = (float*)(ws + WS_R0); float* ROPE = (float*)(ws + WS_ROPE); float* LOGF = (float*)(ws + WS_LOGF); float* CUM = (float*)(ws + WS_CUM);
    bf16* W1T = (bf16*)(ws + WS_W1T); bf16* W2T = (bf16*)(ws + WS_W2T); bf16* W3T = (bf16*)(ws + WS_W3T); bf16* W4T = (bf16*)(ws + WS_W4T);
    bf16* KAUG = (bf16*)(ws + WS_KAUG);
    bf16* XB = (bf16*)(ws + WS_XB); bf16* Qb = (bf16*)(ws + WS_Q); bf16* Kb = (bf16*)(ws + WS_K); bf16* Vb = (bf16*)(ws + WS_V); bf16* Gb = (bf16*)(ws + WS_G); bf16* YG = (bf16*)(ws + WS_YG);
    for (int u = tid; u < (LDS_BYTES - LDSCTL_OFF) / 4; u += NWAVES * 64) ((LAS unsigned*)(lds + LDSCTL_OFF))[u] = 0u;
    __syncthreads();
    const int lo = args.ph_lo, hi = args.ph_hi;
    XcdBarrier bar; bar.bar = (unsigned*)(ctl + CW_BAR); bar.x = 0; bar.st = nullptr;
    if (hi - lo > 1) bar = xcd_barrier_post((unsigned*)(ctl + CW_BAR), MISC + 8);
#define IN(k) (lo <= (k) && (k) < hi)
#define REP(k) for (int rep_ = 0; rep_ < (((DUP_MASK >> (k)) & 1) ? 2 : 1); ++rep_)
#define SEAM(k) do { if (IN(k) && IN((k) + 1)) xcd_barrier(bar); } while (0)
    const int gw = vcu * NWAVES + wave, NGW = G * NWAVES;
#define STAGGER() do { for (int s_ = 0; s_ < ((bx >> 3) & 31); ++s_) __builtin_amdgcn_s_sleep(1); } while (0)
    const bool grp = (G == 256) && lo == 0 && hi == N_PHASES;
    const int gpm = 8 * (bx & 7) + ((bx >> 3) & 7), gj = bx >> 6;
    unsigned* GS = (unsigned*)(ws + WS_GS);
    unsigned* XT = (unsigned*)(ws + WS_XT);
    if (grp && tid == 0) __hip_atomic_store(XT + bx, xb_xcc_id() + 1u, __ATOMIC_RELAXED, __HIP_MEMORY_SCOPE_AGENT);
#define G_ARRIVE() do { asm volatile("s_waitcnt vmcnt(0)" ::: "memory"); __syncthreads(); \
        if (tid == 0) { if (MISC[12] != 0u) { __builtin_amdgcn_fence(__ATOMIC_RELEASE, "agent"); asm volatile("s_waitcnt vmcnt(0)" ::: "memory"); } (void)xb_add(GS + gpm * 16, 1u); } } while (0)
#define G_WAIT(pm_, target) do { if (tid == 0) { unsigned* w_ = GS + (pm_) * 16; XB_SPIN(xb_ld(w_) < (unsigned)(target), bar.bar); \
        __builtin_amdgcn_fence(__ATOMIC_ACQUIRE, "agent"); asm volatile("s_waitcnt vmcnt(0)" ::: "memory"); } __syncthreads(); } while (0)

    if (IN(0)) REP(0) {
        LAS float* scr = (LAS float*)(lds + RING_OFF + wave * 16384);
        constexpr int I1 = (DM / 64) * (FOX_IN / 32);
        for (int it = gw; it < I1; it += NGW) p0_transpose_item(fox_w_in, DM, FOX_IN, W1T, scr, it, lane, norm_g);
        for (int m = 2 * gw; m < MTOK; m += 2 * NGW) {
            const int m2 = m + 1;
            const GAS f32x4* xr = (const GAS f32x4*)(x + (size_t)m * DM) + lane; const GAS f32x4* xr2 = (const GAS f32x4*)(x + (size_t)m2 * DM) + lane; f32x4 v[8], v2[8]; float s = 0.f, s2 = 0.f;
#pragma unroll
            for (int j = 0; j < 8; ++j) { v[j] = __builtin_nontemporal_load(xr + 64 * j); v2[j] = __builtin_nontemporal_load(xr2 + 64 * j); }
#pragma unroll
            for (int j = 0; j < 8; ++j) { s += (v[j].x * v[j].x + v[j].y * v[j].y) + (v[j].z * v[j].z + v[j].w * v[j].w); s2 += (v2[j].x * v2[j].x + v2[j].y * v2[j].y) + (v2[j].z * v2[j].z + v2[j].w * v2[j].w); }
            s = wave_sum(s); s2 = wave_sum(s2);
            if (lane == 0) { R0[m] = 1.0f / sqrtf(s * (1.f / DM) + RMS_EPS); R0[m2] = 1.0f / sqrtf(s2 * (1.f / DM) + RMS_EPS); }
#pragma unroll
            for (int j = 0; j < 8; ++j) { *(GAS unsigned long long*)(XB + tiled_off(m, 256 * j + 4 * lane)) = (unsigned long long)pk2(v[j].x, v[j].y) | ((unsigned long long)pk2(v[j].z, v[j].w) << 32);
                                          *(GAS unsigned long long*)(XB + tiled_off(m2, 256 * j + 4 * lane)) = (unsigned long long)pk2(v2[j].x, v2[j].y) | ((unsigned long long)pk2(v2[j].z, v2[j].w) << 32); }
        }
        { const int gt = gw * 64 + lane;
          if (gt < SEQ * 8) { const int pos = gt >> 3, i = gt & 7;
              const double invf[8] = {1.0, 0.19390220519133497, 0.037598065178462524, 0.0072903477503833845, 0.0014142135623730951, 0.00027421912901204056, 5.3171693730649086e-05, 1.0310108130908796e-05};
              double inv = invf[0];
#pragma unroll
              for (int k = 1; k < 8; ++k) inv = (i == k) ? invf[k] : inv;
              const double ang = (double)pos * inv; const double kk = __builtin_rint(ang * 0.15915494309189535); const float red = (float)(ang - kk * 6.283185307179586);
              ROPE[(size_t)pos * 16 + i] = cosf(red); ROPE[(size_t)pos * 16 + 8 + i] = sinf(red); } }
    }
    SEAM(0);
    if (IN(1)) {
        pg8::Gemm g{XB, W1T, MTOK, 4 * DM, DM}; pg8::StaticOrder S; S.init(MTOK, 4 * DM, G, bx, (DUP_MASK >> 1) & 1, (DUP_MASK >> 9) & 1);
        pg8::EpiFoxIn E{Qb, Kb, Vb, Gb, LOGF, R0, fox_b_f, KMAX};
        if ((DUP_MASK >> 10) & 1) { pg8::StaticOrder SP; SP.init(MTOK, 4 * DM, G, bx, 0, 0, 1); pg8::gemm_phase<pg8::EpiFoxIn, pg8::StaticOrder, true, true>(lds + RING_OFF, g, SP, E); }
        STAGGER();
        pg8::gemm_phase<pg8::EpiFoxIn, pg8::StaticOrder, true, true>(lds + RING_OFF, g, S, E);
        for (int rb = bx * 64; rb < MTOK; rb += G * 64) {
            LAS unsigned char* bl = lds + RING_OFF;
#pragma unroll
            for (int pc = 0; pc < 16; ++pc) { const int pidx = wave + 8 * pc;
                fa::glds16(W1T + tiled_off(4 * DM, 0) + (size_t)(pidx >> 1) * 8192 + (pidx & 1) * 512 + lane * 8, (unsigned)__builtin_amdgcn_readfirstlane((int)(unsigned)(uintptr_t)(bl + pidx * 1024))); }
            const int arow = rb + 16 * (wave & 3) + (lane & 15), kg = (lane >> 4) * 8, kh = wave >> 2;
            bf16x8 af[32];
#pragma unroll
            for (int ks = 0; ks < 32; ++ks) af[ks] = *(const GAS bf16x8*)(XB + tiled_off(arow, 32 * (32 * kh + ks) + kg));
            asm volatile("s_waitcnt vmcnt(0)" ::: "memory");
            __syncthreads();
            pg8::f32x4 acc0 = {0.f, 0.f, 0.f, 0.f}, acc1 = {0.f, 0.f, 0.f, 0.f};
            const LAS unsigned char* bp = bl + (32 * kh) * 2048 + (lane & 15) * 64 + (lane >> 4) * 16;
#pragma unroll
            for (int ks = 0; ks < 32; ++ks) {
                const bf16x8 b0 = *(const LAS bf16x8*)(bp + ks * 2048), b1 = *(const LAS bf16x8*)(bp + ks * 2048 + 1024);
                acc0 = __builtin_amdgcn_mfma_f32_16x16x32_bf16(af[ks], b0, acc0, 0, 0, 0); acc1 = __builtin_amdgcn_mfma_f32_16x16x32_bf16(af[ks], b1, acc1, 0, 0, 0); }
            __syncthreads();
            LAS pg8::f32x4* xs = (LAS pg8::f32x4*)bl + ((wave & 3) * 64 + lane) * 2;
            if (kh == 1) { xs[0] = acc0; xs[1] = acc1; }
            __syncthreads();
            if (kh == 0) {
                acc0 = acc0 + xs[0]; acc1 = acc1 + xs[1];
                const int r0 = rb + 16 * (wave & 3) + 4 * (lane >> 4); const float s0 = R0[r0], s1 = R0[r0 + 1], s2 = R0[r0 + 2], s3 = R0[r0 + 3];
#pragma unroll
                for (int g2 = 0; g2 < 2; ++g2) { const int h = 16 * g2 + (lane & 15); const float bb = fox_b_f[h]; const pg8::f32x4 a = g2 ? acc1 : acc0;
                    f32x4 o; o.x = logsigmoidf(a[0] * s0 + bb); o.y = logsigmoidf(a[1] * s1 + bb); o.z = logsigmoidf(a[2] * s2 + bb); o.w = logsigmoidf(a[3] * s3 + bb);
                    *(GAS f32x4*)(LOGF + ((size_t)((r0 >> 12) * NH + h) << 12) + (r0 & 4095)) = o; }
            }
            __syncthreads();
        }
        { LAS float* scr = (LAS float*)(lds + RING_OFF + wave * 16384);
          constexpr int I2 = (DM / 64) * (DM / 32), I3 = (DM / 64) * (SWA_IN / 32);
          for (int it = gw; it < I2 + I3; it += NGW) { if (it < I2) p0_transpose_item(fox_w_out, DM, DM, W2T, scr, it, lane, nullptr); else p0_transpose_item(swa_w_in, DM, SWA_IN, W3T, scr, it - I2, lane, norm_g + DM); } }
    }
    SEAM(1);
    if (IN(2)) REP(2) {
        for (int sq = vcu; sq < NB * NH; sq += G) {
            const GAS f32x4* lf = (const GAS f32x4*)(LOGF + (size_t)sq * SEQ + wave * 512) + lane * 2; const f32x4 v0 = lf[0], v1 = lf[1];
            const double tot = (((double)v0.x + (double)v0.y) + ((double)v0.z + (double)v0.w)) + (((double)v1.x + (double)v1.y) + ((double)v1.z + (double)v1.w));
            double incl = tot;
#pragma unroll
            for (int o = 1; o < 64; o <<= 1) { const double up = __shfl_up(incl, o); if (lane >= o) incl += up; }
            volatile LAS double* wt = (volatile LAS double*)(lds + RING_OFF);
            __syncthreads();
            if (lane == 63) wt[wave] = incl;
            __syncthreads();
            double run = incl - tot;
            for (int w2 = 0; w2 < wave; ++w2) run += wt[w2];
            const float vv[8] = {v0.x, v0.y, v0.z, v0.w, v1.x, v1.y, v1.z, v1.w}; float cv[8];
#pragma unroll
            for (int e = 0; e < 8; ++e) { run += (double)vv[e]; cv[e] = (float)(run * 1.4426950408889634); }
            GAS f32x4* co = (GAS f32x4*)(CUM + (size_t)sq * SEQ + wave * 512) + lane * 2; co[0] = (f32x4){cv[0], cv[1], cv[2], cv[3]}; co[1] = (f32x4){cv[4], cv[5], cv[6], cv[7]};
            GAS v4u* ka = (GAS v4u*)(KAUG + ((size_t)sq * SEQ + wave * 512 + lane * 8) * 8);
#pragma unroll
            for (int e = 0; e < 8; ++e) { unsigned h1, h2, h3; fa::split3(-cv[e], h1, h2, h3); ka[e] = (v4u){h1 | (h2 << 16), h3 | 0x3F800000u, 0x3F803F80u, 0u}; }
        }
        { const int nidle = G > NB * NH ? G - NB * NH : G, ii = G > NB * NH ? vcu - NB * NH : vcu;
          if (ii >= 0) { __syncthreads(); LAS float* scr = (LAS float*)(lds + RING_OFF + wave * 16384); constexpr int I2 = (DM / 64) * (DM / 32);
              for (int it = ii * NWAVES + wave; it < I2; it += nidle * NWAVES) p0_transpose_item(swa_w_out, DM, DM, W4T, scr, it, lane, nullptr); } }
    }
    SEAM(2);
    if (IN(3)) {
        const fa::Params P{Qb, Kb, Vb, Gb, YG, CUM, nullptr, KMAX, TICKET, KAUG};
        if (grp && tid == 0) {
            const unsigned me = xb_xcc_id() + 1u; const int pn = gpm + 1, two = ((pn & 15) != 0) ? 1 : 0, pq = two ? pn : gpm;
            const unsigned r0 = xb_ld(XT + 8 * (16 + (gpm & 7)) + (gpm >> 3)), r1 = xb_ld(XT + 8 * (24 + (gpm & 7)) + (gpm >> 3));
            const unsigned r2 = xb_ld(XT + 8 * (16 + (pq & 7)) + (pq >> 3)), r3 = xb_ld(XT + 8 * (24 + (pq & 7)) + (pq >> 3));
            MISC[12] = (r0 != me || r1 != me || r2 != me || r3 != me) ? 1u : 0u; }
        volatile LAS unsigned* slot = (volatile LAS unsigned*)(lds + RING_OFF + fa::F_FLAG + 128);
#define FOX_FETCH(dst) do { unsigned code_ = 0xFFFFFFFFu; for (int k_ = 0; k_ < 8; ++k_) { const unsigned q_ = (unsigned)((bx + k_) & 7); const unsigned t_ = atomicAdd(TICKET + q_ * 64, 1u); \
            if (t_ < 256u) { code_ = q_ * 256u + t_; break; } } (dst) = code_; } while (0)
        if (tid == 0) FOX_FETCH(slot[0]);
        __syncthreads();
        unsigned tk = slot[0]; int par = 0;
        while (tk != 0xFFFFFFFFu) {
            if (tid == 0) FOX_FETCH(slot[par ^ 1]);
            const int q = (int)(tk >> 8), tq = (int)(tk & 255u), pi = tq >> 4, hs = 3 - (pi >> 2);
            const int h = hs == 0 ? q : hs == 1 ? 15 - q : hs == 2 ? 16 + q : 31 - q;
            fa::fox_unit(lds + RING_OFF, P, pi & 3, h, 15 - (tq & 15));
            par ^= 1; tk = slot[par];
        }
#undef FOX_FETCH
        __syncthreads();
    }
    SEAM(3);
    if (IN(4)) {
        pg8::Gemm g{YG, W2T, MTOK, DM, DM}; pg8::StaticOrder S; S.init(MTOK, DM, G, bx);
        pg8::EpiRes<true> E{x, XB, SS1};
        STAGGER();
        pg8::gemm_phase<pg8::EpiRes<true>, pg8::StaticOrder, true, true>(lds + RING_OFF, g, S, E);
    }
    SEAM(4);
    if (IN(5)) {
        pg8::Gemm g{XB, W3T, MTOK, SWA_IN, DM}; pg8::StaticOrder S; S.init(MTOK, SWA_IN, G, bx, (DUP_MASK >> 5) & 1, 0, 0, 0, grp ? 4 : (1 << 20));
        pg8::EpiSwaIn E{Qb, Kb, Vb, Gb, SS1, ROPE};
        STAGGER();
        pg8::gemm_phase<pg8::EpiSwaIn, pg8::StaticOrder, true, true>(lds + RING_OFF, g, S, E);
        if (grp) {
            G_ARRIVE();
            if (gj < 2) { pg8::StaticOrder S4; S4.init(MTOK, SWA_IN, G, bx, 0, 0, 0, 4, 5); pg8::gemm_phase<pg8::EpiSwaIn, pg8::StaticOrder, true, true>(lds + RING_OFF, g, S4, E); }
            else { const fa::Params P{Qb, Kb, Vb, Gb, YG, nullptr, swa_sinks, nullptr, nullptr, nullptr};
                   G_WAIT(gpm, 4); if ((gpm & 15) != 0) G_WAIT(gpm - 1, 4);
                   fa::swa_unit(lds + RING_OFF, P, gpm >> 4, gj - 2, gpm & 15); }
        }
    }
    SEAM(5);
    if (IN(6)) REP(6) {
        const fa::Params P{Qb, Kb, Vb, Gb, YG, nullptr, swa_sinks, nullptr, nullptr, nullptr};
        if (grp) fa::swa_unit(lds + RING_OFF, P, gpm >> 4, 2 + (gj >> 1), gpm & 15, (gj & 1) * 4, (gj & 1) * 4 + 4);
        else for (int u = bx; u < NB * 4 * 16; u += G) fa::swa_unit(lds + RING_OFF, P, u >> 6, (u >> 4) & 3, u & 15);
    }
    SEAM(6);
    if (IN(7)) {
        pg8::Gemm g{YG, W4T, MTOK, DM, DM}; pg8::StaticOrder S; S.init(MTOK, DM, G, bx);
        pg8::EpiRes<false> E{nullptr, XB, nullptr};
        STAGGER();
        pg8::gemm_phase<pg8::EpiRes<false>, pg8::StaticOrder, true, true>(lds + RING_OFF, g, S, E);
    }
    SEAM(7);
    if (IN(8)) {
        f32x4 gq[8];
#pragma unroll
        for (int j = 0; j < 8; ++j) gq[j] = ((const GAS f32x4*)final_g)[lane + 64 * j];
        for (int m = 2 * gw; m < MTOK; m += 2 * NGW) {
            f32x4 v[8], v2[8]; float s = 0.f, s2 = 0.f; unsigned long long xw[8], xw2[8];
#pragma unroll
            for (int j = 0; j < 8; ++j) { xw[j] = *(const GAS unsigned long long*)(XB + tiled_off(m, 256 * j + 4 * lane)); xw2[j] = *(const GAS unsigned long long*)(XB + tiled_off(m + 1, 256 * j + 4 * lane)); }
#pragma unroll
            for (int j = 0; j < 8; ++j) { const unsigned lo32 = (unsigned)xw[j], hi32 = (unsigned)(xw[j] >> 32), lo2 = (unsigned)xw2[j], hi2 = (unsigned)(xw2[j] >> 32);
                v[j] = (f32x4){__uint_as_float(lo32 << 16), __uint_as_float(lo32 & 0xffff0000u), __uint_as_float(hi32 << 16), __uint_as_float(hi32 & 0xffff0000u)};
                v2[j] = (f32x4){__uint_as_float(lo2 << 16), __uint_as_float(lo2 & 0xffff0000u), __uint_as_float(hi2 << 16), __uint_as_float(hi2 & 0xffff0000u)};
                s += (v[j].x * v[j].x + v[j].y * v[j].y) + (v[j].z * v[j].z + v[j].w * v[j].w); s2 += (v2[j].x * v2[j].x + v2[j].y * v2[j].y) + (v2[j].z * v2[j].z + v2[j].w * v2[j].w); }
            const float r = 1.0f / sqrtf(wave_sum(s) * (1.f / DM) + RMS_EPS), r2 = 1.0f / sqrtf(wave_sum(s2) * (1.f / DM) + RMS_EPS);
            GAS f32x4* xr = (GAS f32x4*)(out + (size_t)m * DM) + lane; GAS f32x4* xr2 = (GAS f32x4*)(out + (size_t)(m + 1) * DM) + lane;
#pragma unroll
            for (int j = 0; j < 8; ++j) { __builtin_nontemporal_store(v[j] * r * gq[j], xr + 64 * j); __builtin_nontemporal_store(v2[j] * r2 * gq[j], xr2 + 64 * j); }
        }
    }
#undef IN
#undef SEAM
#undef G_ARRIVE
#undef G_WAIT
}

extern "C" void kernel_launch(void* const* d_in, const int* in_sizes, int n_in, void* d_out, int out_size, void* d_ws, size_t ws_size, hipStream_t stream) {
    static int grid = 0;
    if (grid == 0) {
        if (n_in != 9 || in_sizes[0] != MTOK * DM || out_size != MTOK * DM || ws_size < WS_END) { fprintf(stderr, "kernel_launch: unexpected shapes (n_in %d, in0 %d, out %d, ws %zu)\n", n_in, n_in > 0 ? in_sizes[0] : -1, out_size, ws_size); grid = -1; return; }
        int dev = 0, cus = 0, per_cu = 0;
        if (hipGetDevice(&dev) != hipSuccess || hipDeviceGetAttribute(&cus, hipDeviceAttributeMultiprocessorCount, dev) != hipSuccess) { fprintf(stderr, "kernel_launch: device query failed\n"); grid = -1; return; }
        if (hipFuncSetAttribute((const void*)mega_fwd, hipFuncAttributeMaxDynamicSharedMemorySize, LDS_BYTES) != hipSuccess) { fprintf(stderr, "kernel_launch: hipFuncSetAttribute failed\n"); grid = -1; return; }
        if (hipOccupancyMaxActiveBlocksPerMultiprocessor(&per_cu, (const void*)mega_fwd, NWAVES * 64, LDS_BYTES) != hipSuccess || per_cu < 1) { fprintf(stderr, "kernel_launch: occupancy query reports %d workgroups per CU; nothing launched\n", per_cu); (void)hipGetLastError(); grid = -1; return; }
        grid = cus;
    }
    if (grid < 0) return;
    (void)hipMemsetAsync((unsigned char*)d_ws + WS_CTL, 0, CTL_ZERO_BYTES, stream);
    Args a{};
    for (int i = 0; i < 9; ++i) a.in[i] = (const float*)d_in[i];
    a.out = (float*)d_out; a.ws = (unsigned char*)d_ws;
    int p = 0;
    while (p < N_PHASES) {
        if (!((FAST_MASK >> p) & 1)) { ++p; continue; }
        int e = p + 1; if (ONE_LAUNCH) while (e < N_PHASES && ((FAST_MASK >> e) & 1)) ++e;
        a.ph_lo = p; a.ph_hi = e;
        hipLaunchKernelGGL(mega_fwd, dim3(grid), dim3(NWAVES * 64), LDS_BYTES, stream, a);
        p = e;
    }
}
```

```cpp
#include <hip/hip_runtime.h>
#include <cstdio>
#include <cstdint>

constexpr int NB = 4, SEQ = 4096, DM = 2048, MTOK = NB * SEQ, NH = 32, HD = 64;
constexpr int FOX_IN = 8224, SWA_IN = 4608, KVW = 256;
constexpr float RMS_EPS = 1e-6f;
constexpr float LOG2E = 1.4426950408889634f;
constexpr float C2 = 0.125f * LOG2E;

typedef unsigned short bf16_t;
__device__ __forceinline__ float bf2f(bf16_t v) { return __uint_as_float((unsigned)v << 16); }
__device__ __forceinline__ bf16_t f2bf(float f) { unsigned u = __float_as_uint(f); return (bf16_t)((u + 0x7fffu + ((u >> 16) & 1u)) >> 16); }
__device__ __forceinline__ float logsigmoidf(float z) { return z < 0.f ? z - log1pf(expf(z)) : -log1pf(expf(-z)); }
__device__ __forceinline__ float siluf(float g) { return g / (1.f + expf(-g)); }

__host__ __device__ __forceinline__ size_t tiled_off(int row, int k) { return ((size_t)(((row >> 8) * (DM / 64) + (k >> 6)) * 2 + ((k >> 5) & 1)) << 13) + (size_t)(((row & 255) << 5) + (k & 31)); }

__host__ __device__ __forceinline__ size_t hm_off(int row  , int col  , int nheads) { return ((size_t)(((row >> 12) * nheads + (col >> 6)) * 2 + ((col >> 5) & 1)) * SEQ + (row & 4095)) * 32 + (col & 31); }

constexpr size_t MiB = 1u << 20;
constexpr size_t WS_CTL = 0, CTL_ZERO_BYTES = 1 * MiB;
constexpr size_t WS_KMAX = 64 * 1024, WS_TICKET = 66 * 1024;
constexpr size_t WS_GS = 128 * 1024;
constexpr size_t WS_XT = 160 * 1024;
constexpr size_t WS_SS1 = 512 * 1024;
constexpr size_t WS_R0 = 1 * MiB;
constexpr size_t WS_ROPE = 1 * MiB + 512 * 1024;
constexpr size_t WS_LOGF = 2 * MiB;
constexpr size_t WS_CUM = 4 * MiB;
constexpr size_t WS_W1T = 8 * MiB, WS_W2T = 41 * MiB, WS_W3T = 49 * MiB, WS_W4T = 67 * MiB;
constexpr size_t WS_XB = 76 * MiB, WS_Q = 140 * MiB, WS_K = 204 * MiB, WS_V = 268 * MiB, WS_G = 332 * MiB, WS_YG = 396 * MiB, WS_KAUG = 460 * MiB, WS_END = 468 * MiB;

#ifndef FAST_MASK
#define FAST_MASK 0x1FF
#endif
#ifndef DUP_MASK
#define DUP_MASK 0x000
#endif
#ifndef ONE_LAUNCH
#define ONE_LAUNCH 1
#endif
namespace pg8 {
#define PG8_LAS __attribute__((address_space(3)))
typedef unsigned short bf16_t;
typedef short bf16x8 __attribute__((ext_vector_type(8)));
typedef float f32x4 __attribute__((ext_vector_type(4)));
typedef unsigned u32x4 __attribute__((ext_vector_type(4)));
constexpr int BM = 256, BK = 64, HALF = 128, HTB = HALF * BK * 2  , STAGE_BYTES = 8 * HTB, NXCD = 8, WGM = 8;

__host__ __device__ __forceinline__ int lds_byte(int r, int c) { const int st = (r >> 4) * 2 + (c >> 5), rr = r & 15, cc = c & 31, ob = rr * 64 + cc * 2; return st * 1024 + (ob ^ (((ob >> 9) & 1) << 5)); }
__host__ __device__ __forceinline__ void stage_rc(int b, int& R, int& C) { const int st = b / 1024, sb = b % 1024, swz = sb ^ (((sb >> 9) & 1) << 5); R = (st >> 1) * 16 + swz / 64; C = (st & 1) * 32 + (swz % 64) / 2; }
__host__ __device__ __forceinline__ int perm32(int rho) { const int n = rho >> 4, i = rho & 15; return 8 * (i >> 2) + 4 * n + (i & 3); }

struct Unit { int pm, pn, lm, ln; };
struct Gemm { const bf16_t* A; const bf16_t* Bt; int M, N, K; };

struct StaticOrder {
    int nM, nN, nwg, G, c, dup, epi2, same, i0, i1;
    __host__ __device__ void init(int M, int N, int G_, int c_, int dup_ = 0, int epi2_ = 0, int same_ = 0, int i0_ = 0, int i1_ = 1 << 20) { nM = M / BM; nN = N / BM; nwg = nM * nN; G = G_; c = c_; dup = dup_; epi2 = epi2_; same = same_; i0 = i0_; i1 = i1_; }
    __host__ __device__ bool next(int i, Unit& u) const {
        if (dup) i >>= 1;
        i += i0; if (i >= i1) return false;
        const long L = (long)i * G + c; if (L >= nwg) return false;
        int wgid = (int)L; { const int q = nwg / NXCD, r = nwg % NXCD, xcd = wgid % NXCD, off = wgid / NXCD; wgid = (xcd < r ? xcd * (q + 1) : r * (q + 1) + (xcd - r) * q) + off; }
        const int nig = WGM * nN, gid = wgid / nig, fm = gid * WGM, gsz = (nM - fm) < WGM ? (nM - fm) : WGM;
        u.pm = fm + ((wgid % nig) % gsz); u.pn = (wgid % nig) / gsz;
        { const int ng = nN >> 2, cg = u.pn >> 2; if (cg < ng) u.pn = 4 * ((cg + (int)(L & 7)) % ng) + (u.pn & 3); }
        u.lm = same ? 0 : u.pm; u.ln = same ? 0 : u.pn; return true;
    }
    __device__ __forceinline__ void a_ready(const Unit&) const {}
    __device__ __forceinline__ void done(const Unit&) const {}
};

__device__ __forceinline__ unsigned cvt_pk_bf16(float lo, float hi) { unsigned r; asm volatile("v_cvt_pk_bf16_f32 %0, %1, %2" : "=v"(r) : "v"(lo), "v"(hi)); return r; }
__device__ __forceinline__ float silu_fast(float g) { return g * __builtin_amdgcn_rcpf(1.0f + __builtin_amdgcn_exp2f(-g * 1.4426950408889634f)); }
__device__ __forceinline__ u32x4 pack8(const f32x4 v0, const f32x4 v1) { u32x4 w; w.x = cvt_pk_bf16(v0[0], v0[1]); w.y = cvt_pk_bf16(v0[2], v0[3]); w.z = cvt_pk_bf16(v1[0], v1[1]); w.w = cvt_pk_bf16(v1[2], v1[3]); return w; }
struct EpiFoxIn {
    static constexpr bool PERM = true, AFTER_DRAIN = false;
    bf16_t *Q, *K, *V, *G; float* LOGF; const float* R0; const float* bfb; unsigned* KMAX;
    __device__ __forceinline__ void operator()(const f32x4 (&acc)[2][2][4][2], const Unit& u, int wr, int wc, int fr, int fq) const {
        const int row0 = u.pm * BM + wr * 64 + fr, pn = u.pn;
        float rs[2][4];
#pragma unroll
        for (int ai = 0; ai < 2; ++ai)
#pragma unroll
            for (int m = 0; m < 4; ++m) rs[ai][m] = R0[row0 + ai * HALF + m * 16];
        {
            const int reg = pn >> 3; bf16_t* base = reg == 0 ? Q : reg == 1 ? K : reg == 2 ? V : G; float kmx[2] = {0.f, 0.f};
            const int col0 = (pn & 7) * BM + wc * 32 + 8 * fq;
#pragma unroll
            for (int ai = 0; ai < 2; ++ai)
#pragma unroll
                for (int m = 0; m < 4; ++m) { const int row = row0 + ai * HALF + m * 16; const float r = rs[ai][m]; const float sc = reg == 0 ? r * C2 : r;
#pragma unroll
                    for (int bj = 0; bj < 2; ++bj) { f32x4 v0 = acc[ai][bj][m][0] * sc, v1 = acc[ai][bj][m][1] * sc;
                        if (reg == 3) {
#pragma unroll
                            for (int j = 0; j < 4; ++j) { v0[j] = silu_fast(v0[j]); v1[j] = silu_fast(v1[j]); } }
                        if (reg == 1) { float ss = ((v0[0] * v0[0] + v0[1] * v0[1]) + (v0[2] * v0[2] + v0[3] * v0[3])) + ((v1[0] * v1[0] + v1[1] * v1[1]) + (v1[2] * v1[2] + v1[3] * v1[3]));
                            ss += __shfl_xor(ss, 16); ss += __shfl_xor(ss, 32); kmx[bj] = fmaxf(kmx[bj], ss); }
                        __builtin_nontemporal_store(pack8(v0, v1), (u32x4*)(base + hm_off(row, col0 + bj * HALF, NH))); } }
            if (reg == 1) {
#pragma unroll
                for (int bj = 0; bj < 2; ++bj) { float mx = kmx[bj];
#pragma unroll
                    for (int o = 1; o < 16; o <<= 1) mx = fmaxf(mx, __shfl_xor(mx, o));
                    if (fr == 0 && fq == 0) atomicMax(KMAX + ((row0 >> 12) * NH + (pn & 7) * 4 + bj * 2 + (wc >> 1)) * 2 + (wc & 1), __float_as_uint(mx)); } }
        }
    }
};
struct EpiSwaIn {
    static constexpr bool PERM = true, AFTER_DRAIN = false;
    bf16_t *Q, *K, *V, *G; const float* SS; const float* ROPE;
    __device__ __forceinline__ void operator()(const f32x4 (&acc)[2][2][4][2], const Unit& u, int wr, int wc, int fr, int fq) const {
        const int row0 = u.pm * BM + wr * 64 + fr, pn = u.pn;
        bf16_t* base; int pitch, colt; float osc = 1.f; const bool rope = pn <= 8, gate = pn >= 10;
        if (pn < 8) { base = Q; pitch = DM; colt = pn * BM; osc = C2; } else if (pn == 8) { base = K; pitch = KVW; colt = 0; } else if (pn == 9) { base = V; pitch = KVW; colt = 0; } else { base = G; pitch = DM; colt = (pn - 10) * BM; }
        const int col0 = colt + wc * 32 + 8 * fq; const bool rotw = rope && ((wc & 1) == 0); const float sgn = fq == 0 ? -1.f : 1.f; const bool rotl = fq < 2;
        float rs[2][4];
#pragma unroll
        for (int ai = 0; ai < 2; ++ai)
#pragma unroll
            for (int m = 0; m < 4; ++m) rs[ai][m] = SS[row0 + ai * HALF + m * 16];
        f32x4 nc0, nc1, ns0, ns1;
        if (rotw) { const float* rp = ROPE + (size_t)(row0 & 4095) * 16; nc0 = *(const f32x4*)rp; nc1 = *(const f32x4*)(rp + 4); ns0 = *(const f32x4*)(rp + 8); ns1 = *(const f32x4*)(rp + 12); }
#pragma unroll
        for (int ai = 0; ai < 2; ++ai)
#pragma unroll
            for (int m = 0; m < 4; ++m) { const int row = row0 + ai * HALF + m * 16; const float r = 1.0f / sqrtf(rs[ai][m] * (1.f / DM) + RMS_EPS);
                const f32x4 c0 = nc0, c1 = nc1, s0 = ns0, s1 = ns1;
                if (rotw && (ai * 4 + m) < 7) { const int nrow = row0 + ((ai * 4 + m + 1) >> 2) * HALF + ((ai * 4 + m + 1) & 3) * 16; const float* rp = ROPE + (size_t)(nrow & 4095) * 16; nc0 = *(const f32x4*)rp; nc1 = *(const f32x4*)(rp + 4); ns0 = *(const f32x4*)(rp + 8); ns1 = *(const f32x4*)(rp + 12); }
#pragma unroll
                for (int bj = 0; bj < 2; ++bj) { f32x4 v0 = acc[ai][bj][m][0] * r, v1 = acc[ai][bj][m][1] * r;
                    if (rotw) {
#pragma unroll
                        for (int j = 0; j < 4; ++j) { const float p0 = __shfl_xor(v0[j], 16), p1 = __shfl_xor(v1[j], 16);
                            const float n0 = v0[j] * c0[j] + sgn * p0 * s0[j], n1 = v1[j] * c1[j] + sgn * p1 * s1[j];
                            v0[j] = rotl ? n0 : v0[j]; v1[j] = rotl ? n1 : v1[j]; } }
                    if (gate) {
#pragma unroll
                        for (int j = 0; j < 4; ++j) { v0[j] = silu_fast(v0[j]); v1[j] = silu_fast(v1[j]); } }
                    v0 = v0 * osc; v1 = v1 * osc;
                    *(u32x4*)(base + hm_off(row, col0 + bj * HALF, pitch >> 6)) = pack8(v0, v1); } }
    }
};
template <bool FIRST> struct EpiRes {
    static constexpr bool PERM = true, AFTER_DRAIN = false;
    const float* xin; bf16_t* XB; float* SS;
    __device__ __forceinline__ void operator()(const f32x4 (&acc)[2][2][4][2], const Unit& u, int wr, int wc, int fr, int fq) const {
        const int row0 = u.pm * BM + wr * 64 + fr, col0 = u.pn * BM + wc * 32 + 8 * fq;
        if (FIRST) {
            f32x4 nx[2][2];
#pragma unroll
            for (int bj = 0; bj < 2; ++bj)
#pragma unroll
                for (int n = 0; n < 2; ++n) nx[bj][n] = *(const f32x4*)(xin + (size_t)row0 * DM + col0 + bj * HALF + n * 4);
#pragma unroll
            for (int ai = 0; ai < 2; ++ai)
#pragma unroll
                for (int m = 0; m < 4; ++m) { const int row = row0 + ai * HALF + m * 16; float ss = 0.f;
                    f32x4 cx[2][2];
#pragma unroll
                    for (int bj = 0; bj < 2; ++bj)
#pragma unroll
                        for (int n = 0; n < 2; ++n) cx[bj][n] = nx[bj][n];
                    if ((ai * 4 + m) < 7) { const int nrow = row0 + ((ai * 4 + m + 1) >> 2) * HALF + ((ai * 4 + m + 1) & 3) * 16;
#pragma unroll
                        for (int bj = 0; bj < 2; ++bj)
#pragma unroll
                            for (int n = 0; n < 2; ++n) nx[bj][n] = *(const f32x4*)(xin + (size_t)nrow * DM + col0 + bj * HALF + n * 4); }
#pragma unroll
                    for (int bj = 0; bj < 2; ++bj) { const f32x4 x0 = cx[bj][0] + acc[ai][bj][m][0], x1 = cx[bj][1] + acc[ai][bj][m][1];
                        *(u32x4*)(XB + tiled_off(row, col0 + bj * HALF)) = pack8(x0, x1);
                        ss += ((x0[0] * x0[0] + x0[1] * x0[1]) + (x0[2] * x0[2] + x0[3] * x0[3])) + ((x1[0] * x1[0] + x1[1] * x1[1]) + (x1[2] * x1[2] + x1[3] * x1[3])); }
                    ss += __shfl_xor(ss, 16); ss += __shfl_xor(ss, 32); if (fq == 0) atomicAdd(SS + row, ss); }
        } else {
            u32x4 xv[2][4][2];
#pragma unroll
            for (int ai = 0; ai < 2; ++ai)
#pragma unroll
                for (int m = 0; m < 4; ++m)
#pragma unroll
                    for (int bj = 0; bj < 2; ++bj) xv[ai][m][bj] = *(const u32x4*)(XB + tiled_off(row0 + ai * HALF + m * 16, col0 + bj * HALF));
#pragma unroll
            for (int ai = 0; ai < 2; ++ai)
#pragma unroll
                for (int m = 0; m < 4; ++m)
#pragma unroll
                    for (int bj = 0; bj < 2; ++bj) { const u32x4 xw = xv[ai][m][bj]; const f32x4 a0 = acc[ai][bj][m][0], a1 = acc[ai][bj][m][1];
                        const f32x4 y0 = {__uint_as_float(xw.x << 16) + a0[0], __uint_as_float(xw.x & 0xffff0000u) + a0[1], __uint_as_float(xw.y << 16) + a0[2], __uint_as_float(xw.y & 0xffff0000u) + a0[3]};
                        const f32x4 y1 = {__uint_as_float(xw.z << 16) + a1[0], __uint_as_float(xw.z & 0xffff0000u) + a1[1], __uint_as_float(xw.w << 16) + a1[2], __uint_as_float(xw.w & 0xffff0000u) + a1[3]};
                        *(u32x4*)(XB + tiled_off(row0 + ai * HALF + m * 16, col0 + bj * HALF)) = pack8(y0, y1); }
        }
    }
};
template <class Epi, class Sched, bool ALIGN_EPI = false, bool SP2 = false>
__device__ __forceinline__ void gemm_phase(PG8_LAS unsigned char* lds, const Gemm g, const Sched& S, const Epi& E) {
    const int tid = threadIdx.x, wid = __builtin_amdgcn_readfirstlane(tid >> 6), lane = tid & 63, wr = wid >> 2, wc = wid & 3, fr = lane & 15, fq = lane >> 4;
    const int K = g.K, nt = K / BK;
    unsigned voffA[2], voffB[2];
#pragma unroll
    for (int i = 0; i < 2; ++i) { int R, C; stage_rc(tid * 16 + i * 8192, R, C); const int Rb = Epi::PERM ? ((R & ~31) + perm32(R & 31)) : R;
        voffA[i] = (unsigned)((C >> 5) * (BM * 32) + R * 32 + (C & 31)) * 2u; voffB[i] = (unsigned)((C >> 5) * (BM * 32) + Rb * 32 + (C & 31)) * 2u; }
    const size_t kstep = (size_t)(BM * BK * 2);
    const size_t hstep = (size_t)(HALF * 32 * 2);
    const size_t tstep = (size_t)BM * K * 2;
    const unsigned ldsw = (unsigned)wid * 1024u;
    const int aoff = lds_byte(wr * 64 + fr, fq * 8), boff = lds_byte(wc * 32 + fr, fq * 8);
#define PG8_SA(b, h) (((b) * 2 + (h)) * HTB)
#define PG8_SB(b, h) ((4 + (b) * 2 + (h)) * HTB)
#define PG8_STAGE(bufoff, gbase, voff) do { _Pragma("unroll") for (int _i = 0; _i < 2; ++_i) \
        __builtin_amdgcn_global_load_lds((const unsigned*)((const char*)(gbase) + (voff)[_i]), (PG8_LAS unsigned*)(lds + (bufoff) + ldsw + _i * 8192), 16, 0, 0); } while (0)
#define PG8_LDA(dst, b, h) do { _Pragma("unroll") for (int m = 0; m < 4; ++m) _Pragma("unroll") for (int k = 0; k < 2; ++k) dst[m][k] = *(const PG8_LAS bf16x8*)(lds + PG8_SA(b, h) + aoff + m * 2048 + k * 1024); } while (0)
#define PG8_LDB(dst, b, h) do { _Pragma("unroll") for (int n = 0; n < 2; ++n) _Pragma("unroll") for (int k = 0; k < 2; ++k) dst[n][k] = *(const PG8_LAS bf16x8*)(lds + PG8_SB(b, h) + boff + n * 2048 + k * 1024); } while (0)
#define PG8_MMA(ai, bj, At, Bt) do { __builtin_amdgcn_s_setprio(1); _Pragma("unroll") for (int m = 0; m < 4; ++m) _Pragma("unroll") for (int n = 0; n < 2; ++n) _Pragma("unroll") for (int k = 0; k < 2; ++k) \
        acc[ai][bj][m][n] = __builtin_amdgcn_mfma_f32_16x16x32_bf16(Bt[n][k], At[m][k], acc[ai][bj][m][n], 0, 0, 0); __builtin_amdgcn_s_setprio(0); } while (0)
#define PG8_WAIT_V(n) asm volatile("s_waitcnt vmcnt(" #n ")" ::: "memory")
#define PG8_WAIT_L(n) asm volatile("s_waitcnt lgkmcnt(" #n ")" ::: "memory")
#define PG8_BAR __builtin_amdgcn_s_barrier()
#define PG8_SCHED __builtin_amdgcn_sched_barrier(0)
    Unit cur, nxt; int ui = 0;
    if (!S.next(0, cur)) return;
    f32x4 acc[2][2][4][2];
#pragma unroll
    for (int a = 0; a < 2; ++a)
#pragma unroll
        for (int b = 0; b < 2; ++b)
#pragma unroll
            for (int m = 0; m < 4; ++m)
#pragma unroll
                for (int n = 0; n < 2; ++n) acc[a][b][m][n] = (f32x4){0.f, 0.f, 0.f, 0.f};
    bf16x8 At[4][2], B0[2][2], B1[2][2];
    const char* cA = (const char*)g.A + (size_t)cur.lm * tstep; const char* cB = (const char*)g.Bt + (size_t)cur.ln * tstep;
    S.a_ready(cur);
    if constexpr (SP2) {
        PG8_STAGE(PG8_SB(0, 0), cB, voffB); PG8_STAGE(PG8_SB(0, 1), cB + hstep, voffB); PG8_STAGE(PG8_SA(0, 0), cA, voffA); PG8_STAGE(PG8_SA(0, 1), cA + hstep, voffA);
        if (wr == 1) PG8_BAR;
        PG8_WAIT_V(2); PG8_BAR;
        PG8_STAGE(PG8_SB(1, 0), cB + kstep, voffB); PG8_STAGE(PG8_SA(1, 0), cA + kstep, voffA); PG8_STAGE(PG8_SB(1, 1), cB + hstep + kstep, voffB);
        PG8_WAIT_V(6); PG8_BAR;
    } else {
        PG8_STAGE(PG8_SB(0, 0), cB, voffB); PG8_STAGE(PG8_SA(0, 0), cA, voffA); PG8_STAGE(PG8_SB(0, 1), cB + hstep, voffB); PG8_STAGE(PG8_SA(0, 1), cA + hstep, voffA);
        if (wr == 1) PG8_BAR;
        PG8_WAIT_V(4); PG8_BAR;
        PG8_STAGE(PG8_SB(1, 0), cB + kstep, voffB); PG8_STAGE(PG8_SA(1, 0), cA + kstep, voffA); PG8_STAGE(PG8_SB(1, 1), cB + hstep + kstep, voffB);
        PG8_WAIT_V(6); PG8_BAR;
    }
    for (;;) {
        const bool has_next = S.next(ui + 1, nxt);
        const char* nA = has_next ? (const char*)g.A + (size_t)nxt.lm * tstep : cA; const char* nB = has_next ? (const char*)g.Bt + (size_t)nxt.ln * tstep : cB;
        for (int t = 0; t < nt; t += 2) {
            const bool last = (t == nt - 2);
            const char* a1 = cA + (size_t)(t + 1) * kstep;
            const char* a2 = last ? nA : cA + (size_t)(t + 2) * kstep; const char* b2 = last ? nB : cB + (size_t)(t + 2) * kstep;
            const char* a3 = a2 + kstep; const char* b3 = b2 + kstep;
            if (last && has_next) S.a_ready(nxt);
            if constexpr (SP2) {
            PG8_LDB(B0, 0, 0); PG8_LDB(B1, 0, 1); PG8_SCHED; PG8_LDA(At, 0, 0); PG8_STAGE(PG8_SA(1, 0), a1, voffA); PG8_STAGE(PG8_SA(1, 1), a1 + hstep, voffA);
            PG8_WAIT_V(8); PG8_WAIT_L(0); PG8_BAR; PG8_MMA(0, 0, At, B0); PG8_MMA(0, 1, At, B1); PG8_BAR; PG8_SCHED;
            PG8_LDA(At, 0, 1); PG8_STAGE(PG8_SB(0, 0), b2, voffB); PG8_STAGE(PG8_SB(0, 1), b2 + hstep, voffB);
            PG8_WAIT_V(6); PG8_WAIT_L(0); PG8_BAR; PG8_MMA(1, 0, At, B0); PG8_MMA(1, 1, At, B1); PG8_BAR; PG8_SCHED;
            PG8_LDB(B0, 1, 0); PG8_LDB(B1, 1, 1); PG8_SCHED; PG8_LDA(At, 1, 0); PG8_STAGE(PG8_SA(0, 0), a2, voffA); PG8_STAGE(PG8_SA(0, 1), a2 + hstep, voffA);
            PG8_WAIT_V(8); PG8_WAIT_L(0); PG8_BAR; PG8_MMA(0, 0, At, B0); PG8_MMA(0, 1, At, B1); PG8_BAR; PG8_SCHED;
            PG8_LDA(At, 1, 1); PG8_STAGE(PG8_SB(1, 0), b3, voffB); PG8_STAGE(PG8_SB(1, 1), b3 + hstep, voffB);
            PG8_WAIT_V(6); PG8_WAIT_L(0); PG8_BAR; PG8_MMA(1, 0, At, B0); PG8_MMA(1, 1, At, B1); PG8_BAR; PG8_SCHED;
            } else {
            PG8_LDB(B0, 0, 0); PG8_SCHED; PG8_LDA(At, 0, 0); PG8_STAGE(PG8_SA(1, 1), a1 + hstep, voffA);
            PG8_WAIT_L(8); PG8_BAR; PG8_WAIT_L(0); PG8_MMA(0, 0, At, B0); PG8_BAR; PG8_SCHED;
            PG8_LDB(B1, 0, 1); PG8_STAGE(PG8_SB(0, 0), b2, voffB);
            PG8_BAR; PG8_WAIT_L(0); PG8_MMA(0, 1, At, B1); PG8_BAR;
            PG8_LDA(At, 0, 1); PG8_STAGE(PG8_SA(0, 0), a2, voffA);
            PG8_BAR; PG8_WAIT_L(0); PG8_MMA(1, 0, At, B0); PG8_BAR; PG8_SCHED;
            PG8_STAGE(PG8_SB(0, 1), b2 + hstep, voffB);
            PG8_WAIT_V(6); PG8_BAR; PG8_MMA(1, 1, At, B1); PG8_BAR;
            PG8_LDB(B0, 1, 0); PG8_SCHED; PG8_LDA(At, 1, 0); PG8_STAGE(PG8_SA(0, 1), a2 + hstep, voffA);
            PG8_WAIT_L(8); PG8_BAR; PG8_WAIT_L(0); PG8_MMA(0, 0, At, B0); PG8_BAR; PG8_SCHED;
            PG8_LDB(B1, 1, 1); PG8_STAGE(PG8_SB(1, 0), b3, voffB);
            PG8_BAR; PG8_WAIT_L(0); PG8_MMA(0, 1, At, B1); PG8_BAR;
            PG8_LDA(At, 1, 1); PG8_STAGE(PG8_SA(1, 0), a3, voffA);
            PG8_BAR; PG8_WAIT_L(0); PG8_MMA(1, 0, At, B0); PG8_BAR; PG8_SCHED;
            PG8_STAGE(PG8_SB(1, 1), b3 + hstep, voffB);
            PG8_WAIT_V(6); PG8_BAR; PG8_MMA(1, 1, At, B1); PG8_BAR;
            }
        }
        if constexpr (ALIGN_EPI) { if (wr == 0) PG8_BAR; }
        if constexpr (!Epi::AFTER_DRAIN) { E(acc, cur, wr, wc, fr, fq); if (S.epi2) E(acc, cur, wr, wc, fr, fq); S.done(cur); }
        if (!has_next) break;
#pragma unroll
        for (int a = 0; a < 2; ++a)
#pragma unroll
            for (int b = 0; b < 2; ++b)
#pragma unroll
                for (int m = 0; m < 4; ++m)
#pragma unroll
                    for (int n = 0; n < 2; ++n) acc[a][b][m][n] = (f32x4){0.f, 0.f, 0.f, 0.f};
        cur = nxt; cA = nA; cB = nB; ++ui;
        if constexpr (ALIGN_EPI) { if (wr == 1) PG8_BAR; }
    }
    PG8_WAIT_V(0);
    if constexpr (!ALIGN_EPI) { if (wr == 0) PG8_BAR; }
    PG8_BAR;
    if constexpr (Epi::AFTER_DRAIN) { E.fused(acc, cur, wr, wc, fr, fq, lds, wid, lane); S.done(cur); }
#undef PG8_SA
#undef PG8_SB
#undef PG8_STAGE
#undef PG8_LDA
#undef PG8_LDB
#undef PG8_MMA
#undef PG8_WAIT_V
#undef PG8_WAIT_L
#undef PG8_BAR
#undef PG8_SCHED
}
}
namespace fa {
#define FA_LAS __attribute__((address_space(3)))
typedef short bf16x8 __attribute__((ext_vector_type(8)));
typedef short s16x4 __attribute__((ext_vector_type(4)));
typedef short v4i16_t __attribute__((ext_vector_type(4)));
typedef float f32x16 __attribute__((ext_vector_type(16)));
typedef float f32x4 __attribute__((ext_vector_type(4)));
typedef unsigned u32x4 __attribute__((ext_vector_type(4)));
typedef float f32x2_t __attribute__((ext_vector_type(2))); typedef __bf16 bf16x2_t __attribute__((ext_vector_type(2)));
constexpr float THR = 8.f, TH_SKIP = 32.f;
constexpr int F_KBUF = 18432, F_AOFF = 8192, F_VOFF = 10240, F_WSF = 3 * F_KBUF, F_FLAG = F_WSF + 8 * 256, F_OST = F_FLAG + 256, F_LDS_BYTES = F_OST + 8 * 4096;
constexpr int S_KBUF = 16384, S_VOFF = 8192, S_WSF = 6 * S_KBUF, S_OST = S_WSF + 8 * 256, S_LDS_BYTES = S_OST + 8 * 4096;
struct Params { const bf16_t* Q; const bf16_t* K; const bf16_t* V; const bf16_t* G; bf16_t* O; const float* CUM; const float* sinks; const unsigned* KMAX; unsigned* ticket; const bf16_t* KAUG; };
__device__ __forceinline__ unsigned cvtpk(float lo, float hi) { f32x2_t v = {lo, hi}; bf16x2_t b = __builtin_convertvector(v, bf16x2_t); return __builtin_bit_cast(unsigned, b); }
__device__ __forceinline__ s16x4 vtr(FA_LAS unsigned char* p) { return __builtin_bit_cast(s16x4, __builtin_amdgcn_ds_read_tr16_b64_v4i16((FA_LAS v4i16_t*)p)); }
__device__ __forceinline__ float swap_max(float v) { auto rr = __builtin_amdgcn_permlane32_swap(__float_as_uint(v), __float_as_uint(v), false, false); return __builtin_fmaxf(__uint_as_float(rr[0]), __uint_as_float(rr[1])); }
__device__ __forceinline__ float swap_add(float v) { auto rr = __builtin_amdgcn_permlane32_swap(__float_as_uint(v), __float_as_uint(v), false, false); return __uint_as_float(rr[0]) + __uint_as_float(rr[1]); }
__device__ __forceinline__ void glds16(const void* gsrc, unsigned lds_dst) { unsigned keep;
    asm volatile("s_mov_b32 %0, m0\n\ts_mov_b32 m0, %2\n\ts_nop 0\n\tglobal_load_lds_dwordx4 %1, off\n\ts_mov_b32 m0, %0" : "=&s"(keep) : "v"(gsrc), "s"(lds_dst) : "memory"); }
#define FA_MFMA(a, b, c) __builtin_amdgcn_mfma_f32_32x32x16_bf16((a), (b), (c), 0, 0, 0)
#define FA_MX3(a, b, c) __builtin_fmaxf(__builtin_fmaxf((a), (b)), (c))
struct WaveSt { bf16x8 qr[4]; bf16x8 qa; f32x16 o0, o1; float cq, mhat, lsum, mrun; };

#define FA_SBAR() __builtin_amdgcn_sched_barrier(0)
#define FA_PIN(x) asm volatile("" : "+v"(x))
#define FA_LDK(p) (*(FA_LAS bf16x8*)(p))
#define FA_VF(l, h) ((bf16x8){l[0], l[1], l[2], l[3], h[0], h[1], h[2], h[3]})
#define FA_EX4(X, B) do { X[B] = __builtin_amdgcn_exp2f(X[B]); X[B + 1] = __builtin_amdgcn_exp2f(X[B + 1]); X[B + 2] = __builtin_amdgcn_exp2f(X[B + 2]); X[B + 3] = __builtin_amdgcn_exp2f(X[B + 3]); } while (0)
__device__ __forceinline__ void split3(float v, unsigned& h1, unsigned& h2, unsigned& h3) { const bf16_t a = f2bf(v); const float r1 = v - bf2f(a); const bf16_t b = f2bf(r1); const float r2 = r1 - bf2f(b); h1 = a; h2 = b; h3 = f2bf(r2); }
__device__ __forceinline__ void set_qa(WaveSt& w, int hi) {
    unsigned g1, g2, g3; split3(w.cq - w.mhat, g1, g2, g3);
    const u32x4 q = {hi == 0 ? 0x3F803F80u : 0u, hi == 0 ? (0x3F80u | (g1 << 16)) : 0u, hi == 0 ? (g2 | (g3 << 16)) : 0u, 0u};
    w.qa = __builtin_bit_cast(bf16x8, q);
}
template <int MODE, int AOFF, int VOFF>
__device__ __forceinline__ void tile_full(FA_LAS unsigned char* bb, FA_LAS unsigned char* vprev, FA_LAS float* wsf, WaveSt& w, f32x16& C0, f32x16& C1, f32x16& P0, f32x16& P1,
                                          int k0, int t, int qlo, int lane, int r32, int hi) {
    constexpr int W = MODE == 0 ? 0x40000000 : 128;
    FA_LAS unsigned char* kp = bb + hi * 1024 + r32 * 16; FA_LAS unsigned char* ap = bb + AOFF + r32 * 16;
    FA_LAS unsigned char* vp = vprev + VOFF + ((lane >> 4) & 1) * 32 + (lane & 3) * 8 + (4 * hi + ((lane & 15) >> 2)) * 64;
    bf16x8 kf0 = FA_LDK(kp), kf1 = FA_LDK(kp + 512), kf2 = FA_LDK(kp + 2048), kf3 = FA_LDK(kp + 2560), kf4, kf5, kf6, kf7, ka0, ka1;
    s16x4 vl0, vh0, vl1, vh1, vl2, vh2, vl3, vh3, vl4, vh4, vl5, vh5, vl6, vh6, vl7, vh7;
    u32x4 pw0, pw1, pw2, pw3; float sacc;
    const f32x16 Z = {0.f, 0.f, 0.f, 0.f, 0.f, 0.f, 0.f, 0.f, 0.f, 0.f, 0.f, 0.f, 0.f, 0.f, 0.f, 0.f};
    FA_SBAR();
    C0 = FA_MFMA(kf0, w.qr[0], Z); kf4 = FA_LDK(kp + 4096);
    sacc = (P0[0] + P0[1]) + (P0[2] + P0[3]); pw0.x = cvtpk(P0[0], P0[1]); pw0.y = cvtpk(P0[2], P0[3]); FA_PIN(sacc); FA_PIN(pw0.x); FA_PIN(pw0.y);
    FA_SBAR();
    C1 = FA_MFMA(kf1, w.qr[0], Z); kf5 = FA_LDK(kp + 4608);
    sacc += P0[4]; sacc += P0[5]; sacc += P0[6]; sacc += P0[7]; pw0.z = cvtpk(P0[4], P0[5]); pw0.w = cvtpk(P0[6], P0[7]); FA_PIN(sacc); FA_PIN(pw0.z); FA_PIN(pw0.w);
    FA_SBAR();
    C0 = FA_MFMA(kf2, w.qr[1], C0); kf6 = FA_LDK(kp + 6144);
    sacc += P0[8]; sacc += P0[9]; sacc += P0[10]; sacc += P0[11]; pw1.x = cvtpk(P0[8], P0[9]); pw1.y = cvtpk(P0[10], P0[11]); FA_PIN(sacc); FA_PIN(pw1.x); FA_PIN(pw1.y);
    FA_SBAR();
    C1 = FA_MFMA(kf3, w.qr[1], C1); kf7 = FA_LDK(kp + 6656);
    sacc += P0[12]; sacc += P0[13]; sacc += P0[14]; sacc += P0[15]; pw1.z = cvtpk(P0[12], P0[13]); pw1.w = cvtpk(P0[14], P0[15]); FA_PIN(sacc); FA_PIN(pw1.z); FA_PIN(pw1.w);
    FA_SBAR();
    C0 = FA_MFMA(kf4, w.qr[2], C0); if (MODE == 0) { ka0 = FA_LDK(ap); ka1 = FA_LDK(ap + 512); } else { const u32x4 kc = {0u, 0x3F800000u, 0x3F803F80u, 0u}; ka0 = __builtin_bit_cast(bf16x8, kc); ka1 = ka0; }
    sacc += P1[0]; sacc += P1[1]; sacc += P1[2]; sacc += P1[3]; pw2.x = cvtpk(P1[0], P1[1]); pw2.y = cvtpk(P1[2], P1[3]); FA_PIN(sacc); FA_PIN(pw2.x); FA_PIN(pw2.y);
    FA_SBAR();
    C1 = FA_MFMA(kf5, w.qr[2], C1); vl0 = vtr(vp); vh0 = vtr(vp + 512);
    sacc += P1[4]; sacc += P1[5]; sacc += P1[6]; sacc += P1[7]; pw2.z = cvtpk(P1[4], P1[5]); pw2.w = cvtpk(P1[6], P1[7]); FA_PIN(sacc); FA_PIN(pw2.z); FA_PIN(pw2.w);
    FA_SBAR();
    C0 = FA_MFMA(kf6, w.qr[3], C0); vl4 = vtr(vp + 4096); vh4 = vtr(vp + 4096 + 512);
    sacc += P1[8]; sacc += P1[9]; sacc += P1[10]; sacc += P1[11]; pw3.x = cvtpk(P1[8], P1[9]); pw3.y = cvtpk(P1[10], P1[11]); FA_PIN(sacc); FA_PIN(pw3.x); FA_PIN(pw3.y);
    FA_SBAR();
    C1 = FA_MFMA(kf7, w.qr[3], C1); vl1 = vtr(vp + 1024); vh1 = vtr(vp + 1024 + 512);
    sacc += P1[12]; sacc += P1[13]; sacc += P1[14]; sacc += P1[15]; pw3.z = cvtpk(P1[12], P1[13]); pw3.w = cvtpk(P1[14], P1[15]); FA_PIN(sacc); FA_PIN(pw3.z); FA_PIN(pw3.w);
    FA_SBAR();
    C0 = FA_MFMA(ka0, w.qa, C0); vl5 = vtr(vp + 4096 + 1024); vh5 = vtr(vp + 4096 + 1024 + 512); FA_SBAR();
    C1 = FA_MFMA(ka1, w.qa, C1); FA_SBAR();
    w.lsum += sacc;
    const bf16x8 pa0 = __builtin_bit_cast(bf16x8, pw0), pa1 = __builtin_bit_cast(bf16x8, pw1), pa2 = __builtin_bit_cast(bf16x8, pw2), pa3 = __builtin_bit_cast(bf16x8, pw3);
    vl2 = vtr(vp + 2048); vh2 = vtr(vp + 2048 + 512);
    w.o0 = FA_MFMA(pa0, FA_VF(vl0, vh0), w.o0); vl6 = vtr(vp + 4096 + 2048); vh6 = vtr(vp + 4096 + 2048 + 512);
    w.o1 = FA_MFMA(pa0, FA_VF(vl4, vh4), w.o1);
    FA_SBAR();
    if ((k0 + 63 > qlo) || (MODE == 1 && k0 <= qlo + 31 - W)) {
        const float NEG = -__builtin_inff(); const int dq = t - k0 - 4 * hi;
#pragma unroll
        for (int r = 0; r < 16; ++r) { const int c = (r & 3) + 8 * (r >> 2); if ((unsigned)(dq - c) >= (unsigned)W) C0[r] = NEG; if ((unsigned)(dq - c - 32) >= (unsigned)W) C1[r] = NEG; }
    }
    float ma = FA_MX3(C0[0], C0[1], C1[0]), mb = FA_MX3(C0[2], C0[3], C1[1]); ma = FA_MX3(ma, C1[2], C1[3]);
#pragma unroll
    for (int r = 4; r < 16; r += 4) { ma = FA_MX3(ma, C0[r], C0[r + 1]); mb = FA_MX3(mb, C0[r + 2], C0[r + 3]); ma = FA_MX3(ma, C1[r], C1[r + 1]); mb = FA_MX3(mb, C1[r + 2], C1[r + 3]); }
    const float rm = swap_max(__builtin_fmaxf(ma, mb));
    if (MODE == 0) w.mrun = __builtin_fmaxf(w.mrun, rm + w.mhat);
    const bool resc = __any(rm > THR);
    if (resc) {
        const float dl = __builtin_fmaxf(rm, 0.f); w.mhat += dl;
#pragma unroll
        for (int r = 0; r < 16; ++r) { C0[r] -= dl; C1[r] -= dl; }
        set_qa(w, hi);
        const float f = __builtin_amdgcn_exp2f(-dl); w.lsum *= f;
        if (hi == 0) wsf[r32] = f;
    }
    FA_SBAR();
    FA_EX4(C0, 0); FA_PIN(C0); vl3 = vtr(vp + 3072); vh3 = vtr(vp + 3072 + 512);
    w.o0 = FA_MFMA(pa1, FA_VF(vl1, vh1), w.o0); FA_EX4(C0, 4); FA_EX4(C0, 8); FA_PIN(C0); vl7 = vtr(vp + 4096 + 3072); vh7 = vtr(vp + 4096 + 3072 + 512); FA_SBAR();
    w.o1 = FA_MFMA(pa1, FA_VF(vl5, vh5), w.o1); FA_EX4(C0, 12); FA_PIN(C0); FA_EX4(C1, 0); FA_PIN(C1); FA_SBAR();
    w.o0 = FA_MFMA(pa2, FA_VF(vl2, vh2), w.o0); FA_EX4(C1, 4); FA_PIN(C1); FA_SBAR();
    w.o1 = FA_MFMA(pa2, FA_VF(vl6, vh6), w.o1); FA_EX4(C1, 8); FA_PIN(C1); FA_SBAR();
    w.o0 = FA_MFMA(pa3, FA_VF(vl3, vh3), w.o0); FA_EX4(C1, 12); FA_PIN(C1); FA_SBAR();
    w.o1 = FA_MFMA(pa3, FA_VF(vl7, vh7), w.o1); FA_SBAR();
    if (resc) {
        asm volatile("s_waitcnt lgkmcnt(0)" ::: "memory");
#pragma unroll
        for (int g = 0; g < 4; ++g) { const f32x4 a4 = *(FA_LAS f32x4*)(wsf + 8 * g + 4 * hi);
#pragma unroll
            for (int i = 0; i < 4; ++i) { w.o0[4 * g + i] *= a4[i]; w.o1[4 * g + i] *= a4[i]; } }
    }
}
template <int VOFF>
__device__ __forceinline__ void drain_full(FA_LAS unsigned char* vlast, WaveSt& w, f32x16& P0, f32x16& P1, int lane, int hi) {
    FA_LAS unsigned char* vp = vlast + VOFF + ((lane >> 4) & 1) * 32 + (lane & 3) * 8 + (4 * hi + ((lane & 15) >> 2)) * 64;
    float s0 = 0.f, s1 = 0.f;
#pragma unroll
    for (int r = 0; r < 16; ++r) { s0 += P0[r]; s1 += P1[r]; }
    w.lsum += s0 + s1;
    const u32x4 w0 = {cvtpk(P0[0], P0[1]), cvtpk(P0[2], P0[3]), cvtpk(P0[4], P0[5]), cvtpk(P0[6], P0[7])};
    const u32x4 w1 = {cvtpk(P0[8], P0[9]), cvtpk(P0[10], P0[11]), cvtpk(P0[12], P0[13]), cvtpk(P0[14], P0[15])};
    const u32x4 w2 = {cvtpk(P1[0], P1[1]), cvtpk(P1[2], P1[3]), cvtpk(P1[4], P1[5]), cvtpk(P1[6], P1[7])};
    const u32x4 w3 = {cvtpk(P1[8], P1[9]), cvtpk(P1[10], P1[11]), cvtpk(P1[12], P1[13]), cvtpk(P1[14], P1[15])};
    const bf16x8 pa0 = __builtin_bit_cast(bf16x8, w0), pa1 = __builtin_bit_cast(bf16x8, w1), pa2 = __builtin_bit_cast(bf16x8, w2), pa3 = __builtin_bit_cast(bf16x8, w3);
#define FA_PV(ks, pa) do { const s16x4 l0_ = vtr(vp + (ks) * 1024), h0_ = vtr(vp + (ks) * 1024 + 512), l1_ = vtr(vp + 4096 + (ks) * 1024), h1_ = vtr(vp + 4096 + (ks) * 1024 + 512); \
    w.o0 = FA_MFMA(pa, FA_VF(l0_, h0_), w.o0); w.o1 = FA_MFMA(pa, FA_VF(l1_, h1_), w.o1); } while (0)
    FA_PV(0, pa0); FA_PV(1, pa1); FA_PV(2, pa2); FA_PV(3, pa3);
#undef FA_PV
}
__device__ __forceinline__ void load_gate(u32x4 (&gq)[4], const bf16_t* G, size_t grow, int h, int lane) {
#pragma unroll
    for (int d0 = 0; d0 < 2; ++d0)
#pragma unroll
        for (int i = 0; i < 2; ++i) gq[2 * d0 + i] = *(const u32x4*)(G + hm_off((int)grow + i * 16 + (lane >> 2), h * 64 + d0 * 32 + (lane & 3) * 8, NH));
}
__device__ __forceinline__ void wave_epilogue(FA_LAS float* stg, FA_LAS float* wsf, WaveSt& w, const u32x4 (&gq)[4], bf16_t* O, size_t grow, int h, int lane, int r32, int hi) {
    const float l = swap_add(w.lsum);
    if (hi == 0) wsf[r32] = l;
    asm volatile("s_waitcnt lgkmcnt(0)" ::: "memory");
    float rl[16];
#pragma unroll
    for (int g = 0; g < 4; ++g) { const f32x4 l4 = *(FA_LAS f32x4*)(wsf + 8 * g + 4 * hi);
#pragma unroll
        for (int i = 0; i < 4; ++i) rl[4 * g + i] = 1.0f / l4[i]; }
#pragma unroll
    for (int d0 = 0; d0 < 2; ++d0) {
#pragma unroll
        for (int g = 0; g < 4; ++g)
#pragma unroll
            for (int i = 0; i < 4; ++i) stg[(8 * g + 4 * hi + i) * 32 + r32] = (d0 == 0 ? w.o0[4 * g + i] : w.o1[4 * g + i]) * rl[4 * g + i];
        asm volatile("s_waitcnt lgkmcnt(0)" ::: "memory");
#pragma unroll
        for (int i = 0; i < 2; ++i) { const int row = i * 16 + (lane >> 2), ch = lane & 3;
            const f32x4 x0 = *(FA_LAS f32x4*)(stg + row * 32 + ch * 8), x1 = *(FA_LAS f32x4*)(stg + row * 32 + ch * 8 + 4);
            const size_t ga = (grow + row) * DM + h * 64 + d0 * 32 + ch * 8; const u32x4 gv = gq[2 * d0 + i];
            u32x4 ov;
            ov.x = cvtpk(x0[0] * __uint_as_float(gv.x << 16), x0[1] * __uint_as_float(gv.x & 0xffff0000u)); ov.y = cvtpk(x0[2] * __uint_as_float(gv.y << 16), x0[3] * __uint_as_float(gv.y & 0xffff0000u));
            ov.z = cvtpk(x1[0] * __uint_as_float(gv.z << 16), x1[1] * __uint_as_float(gv.z & 0xffff0000u)); ov.w = cvtpk(x1[2] * __uint_as_float(gv.w << 16), x1[3] * __uint_as_float(gv.w & 0xffff0000u));
            *(u32x4*)(O + tiled_off((int)(grow + row), h * 64 + d0 * 32 + ch * 8)) = ov; }
        asm volatile("s_waitcnt lgkmcnt(0)" ::: "memory");
    }
}
template <int MODE> __device__ __forceinline__ void wave_init(WaveSt& w, int hi) {
#pragma unroll
    for (int r = 0; r < 16; ++r) { w.o0[r] = 0.f; w.o1[r] = 0.f; }
    set_qa(w, hi);
}

__device__ __forceinline__ void fox_unit(FA_LAS unsigned char* lds, const Params& P, int b, int h, int qb) {
    const int tid = threadIdx.x, lane = tid & 63, r32 = lane & 31, hi = lane >> 5;
    const int wid = __builtin_amdgcn_readfirstlane(tid >> 6);
    const int q0 = qb * 256, qlo = q0 + wid * 32, t = qlo + r32;
    const size_t rowbase = (size_t)b * SEQ;
    const bf16_t* ksrc = P.K + hm_off((int)rowbase + lane, h * 64 + wid * 8, NH);
    const bf16_t* vsrc = P.V + hm_off((int)rowbase + 16 * (wid & 3) + (lane >> 2), h * 64 + (wid >> 2) * 32 + (lane & 3) * 8, NH);
    const float* cum = P.CUM + (size_t)(b * NH + h) * SEQ;
    const bf16_t* asrc = P.KAUG + ((size_t)(b * NH + h) * SEQ + lane) * 8;
    const int NT = (q0 + 256) / 64;
    WaveSt w; float qn = 0.f;
#pragma unroll
    for (int d0 = 0; d0 < 4; ++d0) { w.qr[d0] = *(const bf16x8*)(P.Q + hm_off((int)rowbase + t, h * 64 + d0 * 16 + hi * 8, NH));
#pragma unroll
        for (int j = 0; j < 8; ++j) { const float qv = bf2f((bf16_t)w.qr[d0][j]); qn = fmaf(qv, qv, qn); } }
    w.cq = cum[t]; w.mhat = 0.f; w.lsum = 0.f; w.mrun = -1e30f;
    wave_init<0>(w, hi);
    u32x4 gq[4]; load_gate(gq, P.G, rowbase + qlo, h, lane);
    const float qkb = sqrtf(swap_add(qn) * (__uint_as_float(P.KMAX[(b * NH + h) * 2]) + __uint_as_float(P.KMAX[(b * NH + h) * 2 + 1]))) * 1.01f + 1e-3f;
    FA_LAS float* wsf = (FA_LAS float*)(lds + F_WSF) + wid * 64;
    FA_LAS unsigned* votes = (FA_LAS unsigned*)(lds + F_FLAG);
    float cnew = 0.f;
#define FA_LOADT(j, bf) do { const size_t ko_ = (size_t)(j) * 64 * 32; FA_LAS unsigned char* bb_ = lds + (bf) * F_KBUF; \
        glds16(ksrc + ko_, (unsigned)__builtin_amdgcn_readfirstlane((int)(unsigned)(uintptr_t)(bb_ + wid * 1024))); \
        glds16(vsrc + ko_, (unsigned)__builtin_amdgcn_readfirstlane((int)(unsigned)(uintptr_t)(bb_ + F_VOFF + (wid >> 2) * 4096 + (wid & 3) * 1024))); \
        if (wid == 0) glds16(asrc + (size_t)(j) * 64 * 8, (unsigned)__builtin_amdgcn_readfirstlane((int)(unsigned)(uintptr_t)(bb_ + F_AOFF))); \
        cnew = cum[(j) * 64 + 63]; } while (0)
    FA_LOADT(NT - 1, 0); asm volatile("s_waitcnt vmcnt(0)" ::: "memory"); __syncthreads();
    bool wdone = false; int n = 0; f32x16 pA0, pA1, pB0, pB1;
#pragma unroll
    for (int r = 0; r < 16; ++r) { pA0[r] = 0.f; pA1[r] = 0.f; pB0[r] = 0.f; pB1[r] = 0.f; }
    int cur = 0; bool fin = false;
#define FA_WALK(tt, CA0, CA1, PA0, PA1) do { \
        const int j = NT - 1 - (tt), k0 = j * 64; const int nxt = cur == 2 ? 0 : cur + 1, prv = cur == 0 ? 2 : cur - 1; \
        if (j > 0) FA_LOADT(j - 1, nxt); \
        if (!wdone && k0 <= qlo + 31) { FA_LAS unsigned char* bb = lds + cur * F_KBUF; \
            tile_full<0, F_AOFF, F_VOFF>(bb, n > 0 ? lds + prv * F_KBUF : bb, wsf, w, CA0, CA1, PA0, PA1, k0, t, qlo, lane, r32, hi); ++n; } \
        if (j > 0) { \
            if (!wdone && n > 0 && __all(qkb + w.cq - cnew - w.mrun <= -TH_SKIP)) { wdone = true; drain_full<F_VOFF>(lds + cur * F_KBUF, w, CA0, CA1, lane, hi); } \
            if (lane == 0) votes[((tt) & 1) * 8 + wid] = wdone ? 1u : 0u; } \
        asm volatile("s_waitcnt vmcnt(0)" ::: "memory"); \
        __syncthreads(); \
        if (j > 0) { const u32x4 v0 = *(FA_LAS u32x4*)(votes + ((tt) & 1) * 8), v1 = *(FA_LAS u32x4*)(votes + ((tt) & 1) * 8 + 4); \
            if ((v0.x & v0.y & v0.z & v0.w & v1.x & v1.y & v1.z & v1.w) != 0u) fin = true; } \
        else { if (!wdone && n > 0) drain_full<F_VOFF>(lds + cur * F_KBUF, w, CA0, CA1, lane, hi); fin = true; } \
        cur = nxt; } while (0)
    for (int tt = 0; !fin; tt += 2) {
        FA_WALK(tt, pA0, pA1, pB0, pB1);
        if (fin) break;
        FA_WALK(tt + 1, pB0, pB1, pA0, pA1);
    }
#undef FA_WALK
#undef FA_LOADT
    wave_epilogue((FA_LAS float*)(lds + F_OST + wid * 4096), wsf, w, gq, P.O, rowbase + qlo, h, lane, r32, hi);
    __syncthreads();
}
__device__ __forceinline__ void swa_unit(FA_LAS unsigned char* lds, const Params& P, int b, int kvh, int qb, int hh_lo = 0, int hh_hi = 8) {
    const int tid = threadIdx.x, lane = tid & 63, r32 = lane & 31, hi = lane >> 5;
    const int wid = __builtin_amdgcn_readfirstlane(tid >> 6);
    const int q0 = qb * 256, qlo = q0 + wid * 32, t = qlo + r32;
    const size_t rowbase = (size_t)b * SEQ;
    const int j_lo = q0 >= 128 ? (q0 - 128) / 64 : 0, NT = (q0 + 256) / 64 - j_lo;
    const bf16_t* ksrc = P.K + hm_off((int)rowbase + j_lo * 64 + lane, kvh * 64 + wid * 8, 4);
    const bf16_t* vsrc = P.V + hm_off((int)rowbase + j_lo * 64 + 16 * (wid & 3) + (lane >> 2), kvh * 64 + (wid >> 2) * 32 + (lane & 3) * 8, 4);
    for (int i = 0; i < NT; ++i) {
        glds16(ksrc + (size_t)i * 64 * 32, (unsigned)__builtin_amdgcn_readfirstlane((int)(unsigned)(uintptr_t)(lds + i * S_KBUF + wid * 1024)));
        glds16(vsrc + (size_t)i * 64 * 32, (unsigned)__builtin_amdgcn_readfirstlane((int)(unsigned)(uintptr_t)(lds + i * S_KBUF + S_VOFF + (wid >> 2) * 4096 + (wid & 3) * 1024))); }
    asm volatile("s_waitcnt vmcnt(0)" ::: "memory");
    __syncthreads();
    FA_LAS float* wsf = (FA_LAS float*)(lds + S_WSF) + wid * 64;
    const int ta = (qlo >= 127 ? (qlo - 127) / 64 : 0) - j_lo, tb = (qlo + 31) / 64 - j_lo;
    for (int hh = hh_lo; hh < hh_hi; ++hh) {
        const int h = kvh * 8 + hh;
        WaveSt w;
#pragma unroll
        for (int d0 = 0; d0 < 4; ++d0) w.qr[d0] = *(const bf16x8*)(P.Q + hm_off((int)rowbase + t, h * 64 + d0 * 16 + hi * 8, NH));
        u32x4 gq[4]; load_gate(gq, P.G, rowbase + qlo, h, lane);
        w.cq = 0.f; w.mhat = P.sinks[h] * LOG2E; w.lsum = 0.5f; w.mrun = 0.f;
        wave_init<1>(w, hi);
        f32x16 pA0, pA1, pB0, pB1;
#pragma unroll
        for (int r = 0; r < 16; ++r) { pB0[r] = 0.f; pB1[r] = 0.f; }
        for (int ti = tb;;) {
            { FA_LAS unsigned char* bb = lds + ti * S_KBUF;
              tile_full<1, 0, S_VOFF>(bb, ti == tb ? bb : bb + S_KBUF, wsf, w, pA0, pA1, pB0, pB1, (j_lo + ti) * 64, t, qlo, lane, r32, hi); }
            if (ti == ta) { drain_full<S_VOFF>(lds + ta * S_KBUF, w, pA0, pA1, lane, hi); break; }
            --ti;
            { FA_LAS unsigned char* bb = lds + ti * S_KBUF;
              tile_full<1, 0, S_VOFF>(bb, bb + S_KBUF, wsf, w, pB0, pB1, pA0, pA1, (j_lo + ti) * 64, t, qlo, lane, r32, hi); }
            if (ti == ta) { drain_full<S_VOFF>(lds + ta * S_KBUF, w, pB0, pB1, lane, hi); break; }
            --ti;
        }
        wave_epilogue((FA_LAS float*)(lds + S_OST + wid * 4096), wsf, w, gq, P.O, rowbase + qlo, h, lane, r32, hi);
    }
    __syncthreads();
}
}
#define GAS __attribute__((address_space(1)))
#define LAS __attribute__((address_space(3)))
typedef unsigned short bf16;
typedef unsigned v4u __attribute__((ext_vector_type(4)));
typedef float f32x4 __attribute__((ext_vector_type(4)));
typedef short bf16x8 __attribute__((ext_vector_type(8)));
typedef GAS unsigned gu32;
typedef GAS unsigned long long gu64;
#define RLX_AGENT __ATOMIC_RELAXED, __HIP_MEMORY_SCOPE_AGENT
#define LDS_WAIT() asm volatile("s_waitcnt lgkmcnt(0)" ::: "memory")
#define VM_WAIT() asm volatile("s_waitcnt vmcnt(0)" ::: "memory")
__device__ __forceinline__ unsigned long long rt() { return __builtin_amdgcn_s_memrealtime(); }
__device__ __forceinline__ unsigned pk2(float lo, float hi) { return (unsigned)f2bf(lo) | ((unsigned)f2bf(hi) << 16); }
#define XB_TMO      128
#define XB_XCNT(j)  (256  + 64 * (j))
#define XB_XSUB(j)  (1280 + 64 * (j))
#define XB_XGEN(j)  (2304 + 64 * (j))
#define XB_TOP      3328
#define XB_TOPGEN   3392
#define XCD_BAR_WORDS 3456
#define XB_SPIN_CAP (1u << 18)

__device__ __forceinline__ unsigned xb_ld(unsigned* p)              { return __hip_atomic_load(p, __ATOMIC_RELAXED, __HIP_MEMORY_SCOPE_AGENT); }
__device__ __forceinline__ unsigned xb_add(unsigned* p, unsigned v) { return __hip_atomic_fetch_add(p, v, __ATOMIC_RELAXED, __HIP_MEMORY_SCOPE_AGENT); }
__device__ __forceinline__ unsigned xb_xcc_id() { return (unsigned)__builtin_amdgcn_s_getreg((3 << 11) | 20) & 0xFu; }
#define XB_SPIN(cond, bar) do { unsigned _sp = 0; while (cond) { __builtin_amdgcn_s_sleep(1); \
    if ((++_sp & 255u) == 0u) { if (xb_ld(&(bar)[XB_TMO])) break; if (_sp > XB_SPIN_CAP) { atomicAdd(&(bar)[XB_TMO], 1u); break; } } } } while (0)

struct XcdBarrier {
    unsigned* bar; unsigned x;
    volatile LAS unsigned* st;
};

__device__ __forceinline__ XcdBarrier xcd_barrier_post(unsigned* bar, volatile LAS unsigned* st) {
    XcdBarrier b; b.bar = bar; b.x = xb_xcc_id(); b.st = st;
    if (threadIdx.x == 0) (void)xb_add(&bar[XB_XCNT(b.x)], 1u);
    return b;
}
__device__ __forceinline__ void xcd_barrier_complete(unsigned* bar, unsigned x, unsigned& nloc, unsigned& nx) {
    const unsigned G = gridDim.x * gridDim.y * gridDim.z;
    unsigned sum, cnt, mine, sp = 0u;
    for (;;) {
        sum = 0u; cnt = 0u; mine = 0u;
#pragma unroll
        for (unsigned j = 0; j < 16; ++j) { const unsigned c = xb_ld(&bar[XB_XCNT(j)]); sum += c; cnt += (c > 0u) ? 1u : 0u; mine = (j == x) ? c : mine; }
        if (sum == G) break;
        __builtin_amdgcn_s_sleep(1);
        if ((++sp & 255u) == 0u) { if (xb_ld(&bar[XB_TMO])) break; if (sp > XB_SPIN_CAP) { atomicAdd(&bar[XB_TMO], 1u); break; } }
    }
    nloc = mine > 0u ? mine : 1u; nx = cnt > 0u ? cnt : 1u;
}

__device__ __forceinline__ void xcd_barrier(const XcdBarrier& b) {
    asm volatile("s_waitcnt vmcnt(0)" ::: "memory");
    __syncthreads();
    if (threadIdx.x == 0) {
        unsigned* bar = b.bar;
        __builtin_amdgcn_s_waitcnt(0);
        unsigned nloc = b.st[0], nx = b.st[1];
        if (nloc == 0u) { xcd_barrier_complete(bar, b.x, nloc, nx); b.st[0] = nloc; b.st[1] = nx; }
        const unsigned old = xb_add(&bar[XB_XSUB(b.x)], 1u);
        const unsigned gen = old / nloc;
        if (old + 1u == (gen + 1u) * nloc) {
            __builtin_amdgcn_fence(__ATOMIC_RELEASE, "agent");
            asm volatile("s_waitcnt vmcnt(0)" ::: "memory");
            const unsigned og = xb_add(&bar[XB_TOP], 1u);
            const unsigned tg = og / nx;
            if (og + 1u == (tg + 1u) * nx) xb_add(&bar[XB_TOPGEN], 1u);
            else XB_SPIN(xb_ld(&bar[XB_TOPGEN]) == tg, bar);
            __builtin_amdgcn_fence(__ATOMIC_ACQUIRE, "agent");
            xb_add(&bar[XB_XGEN(b.x)], 1u);
            asm volatile("s_waitcnt vmcnt(0)" ::: "memory");
        } else {
            XB_SPIN(xb_ld(&bar[XB_XGEN(b.x)]) == gen, bar);
            __builtin_amdgcn_fence(__ATOMIC_ACQUIRE, "agent");
            asm volatile("s_waitcnt vmcnt(0)" ::: "memory");
        }
    }
    __syncthreads();
}
constexpr int NWAVES = 8;
constexpr int N1P = 8448;
constexpr int RING_OFF = 0, RING_BYTES = 135168;
constexpr int LDSCTL_OFF = RING_BYTES, MISC_OFF = LDSCTL_OFF + 320;
constexpr int LDS_BYTES = 147456;
constexpr int CW_BAR = 4096;
static_assert(fa::F_LDS_BYTES <= RING_BYTES && fa::S_LDS_BYTES <= RING_BYTES && pg8::STAGE_BYTES <= RING_BYTES && MISC_OFF + 128 <= LDS_BYTES && (CW_BAR + XCD_BAR_WORDS) * 4 <= (int)WS_KMAX, "LDS / CTL map");

__device__ __forceinline__ void p0_transpose_item(const float* W, int K, int N, bf16* WT, LAS float* scr, int item, int lane, const float* gs) {
    const int nblk = N / 32, kb = item / nblk, nb = item % nblk, k0 = 64 * kb, n0 = 32 * nb;
    const int kr = lane >> 3, nc = 4 * (lane & 7);
    f32x4 wv[8];
#pragma unroll
    for (int i = 0; i < 8; ++i) wv[i] = __builtin_nontemporal_load((const GAS f32x4*)(W + (size_t)(k0 + 8 * i + kr) * N + n0 + nc));
#pragma unroll
    for (int i = 0; i < 8; ++i) { const int kk = 8 * i + kr; f32x4 w = wv[i]; if (gs) w = w * gs[k0 + kk]; LAS float* d = scr + kk * 33 + nc; d[0] = w.x; d[1] = w.y; d[2] = w.z; d[3] = w.w; }
    LDS_WAIT(); asm volatile("" ::: "memory");
    const int c = lane & 7;
#pragma unroll
    for (int j = 0; j < 4; ++j) { const int n = (lane >> 3) + 8 * j; const LAS float* sp = scr + (8 * c) * 33 + n;
        v4u o; o.x = pk2(sp[0 * 33], sp[1 * 33]); o.y = pk2(sp[2 * 33], sp[3 * 33]); o.z = pk2(sp[4 * 33], sp[5 * 33]); o.w = pk2(sp[6 * 33], sp[7 * 33]);
        *(GAS v4u*)(WT + tiled_off(n0 + n, k0 + 8 * c)) = o; }
    LDS_WAIT(); asm volatile("" ::: "memory");
}
__device__ __forceinline__ float wave_sum(float v) {
#pragma unroll
    for (int o = 1; o < 64; o <<= 1) v += __shfl_xor(v, o);
    return v;
}

struct Args { const float* in[9]; float* out; unsigned char* ws; int ph_lo, ph_hi; };
constexpr int N_PHASES = 9;
__global__ void __launch_bounds__(NWAVES * 64, 2) mega_fwd(Args args) {
    extern __shared__ __attribute__((aligned(16))) unsigned char lds_raw[];
    LAS unsigned char* lds = (LAS unsigned char*)lds_raw;
    volatile LAS unsigned* MISC = (volatile LAS unsigned*)(lds + MISC_OFF);
    const int tid = threadIdx.x, lane = tid & 63, wave = __builtin_amdgcn_readfirstlane(tid >> 6);
    const int G = gridDim.x, bx = blockIdx.x, vcu = (G % 8 == 0) ? (bx % 8) * (G / 8) + bx / 8 : bx;
    unsigned char* ws = args.ws;
    const float* x = args.in[0]; const float* norm_g = args.in[1]; const float* fox_w_in = args.in[2]; const float* fox_b_f = args.in[3]; const float* fox_w_out = args.in[4];
    const float* swa_w_in = args.in[5]; const float* swa_sinks = args.in[6]; const float* swa_w_out = args.in[7]; const float* final_g = args.in[8];
    float* out = args.out;
    gu32* ctl = (gu32*)(ws + WS_CTL);
    unsigned* KMAX = (unsigned*)(ws + WS_KMAX); unsigned* TICKET = (unsigned*)(ws + WS_TICKET);
    float* SS1 = (float*)(ws + WS_SS1); float* R0 = (float*)(ws + WS_R0); float* ROPE = (float*)(ws + WS_ROPE); float* LOGF = (float*)(ws + WS_LOGF); float* CUM = (float*)(ws + WS_CUM);
    bf16* W1T = (bf16*)(ws + WS_W1T); bf16* W2T = (bf16*)(ws + WS_W2T); bf16* W3T = (bf16*)(ws + WS_W3T); bf16* W4T = (bf16*)(ws + WS_W4T);
    bf16* KAUG = (bf16*)(ws + WS_KAUG);
    bf16* XB = (bf16*)(ws + WS_XB); bf16* Qb = (bf16*)(ws + WS_Q); bf16* Kb = (bf16*)(ws + WS_K); bf16* Vb = (bf16*)(ws + WS_V); bf16* Gb = (bf16*)(ws + WS_G); bf16* YG = (bf16*)(ws + WS_YG);
    for (int u = tid; u < (LDS_BYTES - LDSCTL_OFF) / 4; u += NWAVES * 64) ((LAS unsigned*)(lds + LDSCTL_OFF))[u] = 0u;
    __syncthreads();
    const int lo = args.ph_lo, hi = args.ph_hi;
    XcdBarrier bar; bar.bar = (unsigned*)(ctl + CW_BAR); bar.x = 0; bar.st = nullptr;
    if (hi - lo > 1) bar = xcd_barrier_post((unsigned*)(ctl + CW_BAR), MISC + 8);
#define IN(k) (lo <= (k) && (k) < hi)
#define REP(k) for (int rep_ = 0; rep_ < (((DUP_MASK >> (k)) & 1) ? 2 : 1); ++rep_)
#define SEAM(k) do { if (IN(k) && IN((k) + 1)) xcd_barrier(bar); } while (0)
    const int gw = vcu * NWAVES + wave, NGW = G * NWAVES;
#define STAGGER() do { for (int s_ = 0; s_ < ((bx >> 3) & 31); ++s_) __builtin_amdgcn_s_sleep(1); } while (0)
    const bool grp = (G == 256) && lo == 0 && hi == N_PHASES;
    const int gpm = 8 * (bx & 7) + ((bx >> 3) & 7), gj = bx >> 6;
    unsigned* GS = (unsigned*)(ws + WS_GS);
    unsigned* XT = (unsigned*)(ws + WS_XT);
    if (grp && tid == 0) __hip_atomic_store(XT + bx, xb_xcc_id() + 1u, __ATOMIC_RELAXED, __HIP_MEMORY_SCOPE_AGENT);
#define G_ARRIVE() do { asm volatile("s_waitcnt vmcnt(0)" ::: "memory"); __syncthreads(); \
        if (tid == 0) { if (MISC[12] != 0u) { __builtin_amdgcn_fence(__ATOMIC_RELEASE, "agent"); asm volatile("s_waitcnt vmcnt(0)" ::: "memory"); } (void)xb_add(GS + gpm * 16, 1u); } } while (0)
#define G_WAIT(pm_, target) do { if (tid == 0) { unsigned* w_ = GS + (pm_) * 16; XB_SPIN(xb_ld(w_) < (unsigned)(target), bar.bar); \
        __builtin_amdgcn_fence(__ATOMIC_ACQUIRE, "agent"); asm volatile("s_waitcnt vmcnt(0)" ::: "memory"); } __syncthreads(); } while (0)

    if (IN(0)) REP(0) {
        LAS float* scr = (LAS float*)(lds + RING_OFF + wave * 16384);
        constexpr int I1 = (DM / 64) * (FOX_IN / 32);
        for (int it = gw; it < I1; it += NGW) p0_transpose_item(fox_w_in, DM, FOX_IN, W1T, scr, it, lane, norm_g);
        for (int m = 2 * gw; m < MTOK; m += 2 * NGW) {
            const int m2 = m + 1;
            const GAS f32x4* xr = (const GAS f32x4*)(x + (size_t)m * DM) + lane; const GAS f32x4* xr2 = (const GAS f32x4*)(x + (size_t)m2 * DM) + lane; f32x4 v[8], v2[8]; float s = 0.f, s2 = 0.f;
#pragma unroll
            for (int j = 0; j < 8; ++j) { v[j] = __builtin_nontemporal_load(xr + 64 * j); v2[j] = __builtin_nontemporal_load(xr2 + 64 * j); }
#pragma unroll
            for (int j = 0; j < 8; ++j) { s += (v[j].x * v[j].x + v[j].y * v[j].y) + (v[j].z * v[j].z + v[j].w * v[j].w); s2 += (v2[j].x * v2[j].x + v2[j].y * v2[j].y) + (v2[j].z * v2[j].z + v2[j].w * v2[j].w); }
            s = wave_sum(s); s2 = wave_sum(s2);
            if (lane == 0) { R0[m] = 1.0f / sqrtf(s * (1.f / DM) + RMS_EPS); R0[m2] = 1.0f / sqrtf(s2 * (1.f / DM) + RMS_EPS); }
#pragma unroll
            for (int j = 0; j < 8; ++j) { *(GAS unsigned long long*)(XB + tiled_off(m, 256 * j + 4 * lane)) = (unsigned long long)pk2(v[j].x, v[j].y) | ((unsigned long long)pk2(v[j].z, v[j].w) << 32);
                                          *(GAS unsigned long long*)(XB + tiled_off(m2, 256 * j + 4 * lane)) = (unsigned long long)pk2(v2[j].x, v2[j].y) | ((unsigned long long)pk2(v2[j].z, v2[j].w) << 32); }
        }
        { const int gt = gw * 64 + lane;
          if (gt < SEQ * 8) { const int pos = gt >> 3, i = gt & 7;
              const double invf[8] = {1.0, 0.19390220519133497, 0.037598065178462524, 0.0072903477503833845, 0.0014142135623730951, 0.00027421912901204056, 5.3171693730649086e-05, 1.0310108130908796e-05};
              double inv = invf[0];
#pragma unroll
              for (int k = 1; k < 8; ++k) inv = (i == k) ? invf[k] : inv;
              const double ang = (double)pos * inv; const double kk = __builtin_rint(ang * 0.15915494309189535); const float red = (float)(ang - kk * 6.283185307179586);
              ROPE[(size_t)pos * 16 + i] = cosf(red); ROPE[(size_t)pos * 16 + 8 + i] = sinf(red); } }
    }
    SEAM(0);
    if (IN(1)) {
        pg8::Gemm g{XB, W1T, MTOK, 4 * DM, DM}; pg8::StaticOrder S; S.init(MTOK, 4 * DM, G, bx, (DUP_MASK >> 1) & 1, (DUP_MASK >> 9) & 1);
        pg8::EpiFoxIn E{Qb, Kb, Vb, Gb, LOGF, R0, fox_b_f, KMAX};
        if ((DUP_MASK >> 10) & 1) { pg8::StaticOrder SP; SP.init(MTOK, 4 * DM, G, bx, 0, 0, 1); pg8::gemm_phase<pg8::EpiFoxIn, pg8::StaticOrder, true, true>(lds + RING_OFF, g, SP, E); }
        STAGGER();
        pg8::gemm_phase<pg8::EpiFoxIn, pg8::StaticOrder, true, true>(lds + RING_OFF, g, S, E);
        for (int rb = bx * 64; rb < MTOK; rb += G * 64) {
            LAS unsigned char* bl = lds + RING_OFF;
#pragma unroll
            for (int pc = 0; pc < 16; ++pc) { const int pidx = wave + 8 * pc;
                fa::glds16(W1T + tiled_off(4 * DM, 0) + (size_t)(pidx >> 1) * 8192 + (pidx & 1) * 512 + lane * 8, (unsigned)__builtin_amdgcn_readfirstlane((int)(unsigned)(uintptr_t)(bl + pidx * 1024))); }
            const int arow = rb + 16 * (wave & 3) + (lane & 15), kg = (lane >> 4) * 8, kh = wave >> 2;
            bf16x8 af[32];
#pragma unroll
            for (int ks = 0; ks < 32; ++ks) af[ks] = *(const GAS bf16x8*)(XB + tiled_off(arow, 32 * (32 * kh + ks) + kg));
            asm volatile("s_waitcnt vmcnt(0)" ::: "memory");
            __syncthreads();
            pg8::f32x4 acc0 = {0.f, 0.f, 0.f, 0.f}, acc1 = {0.f, 0.f, 0.f, 0.f};
            const LAS unsigned char* bp = bl + (32 * kh) * 2048 + (lane & 15) * 64 + (lane >> 4) * 16;
#pragma unroll
            for (int ks = 0; ks < 32; ++ks) {
                const bf16x8 b0 = *(const LAS bf16x8*)(bp + ks * 2048), b1 = *(const LAS bf16x8*)(bp + ks * 2048 + 1024);
                acc0 = __builtin_amdgcn_mfma_f32_16x16x32_bf16(af[ks], b0, acc0, 0, 0, 0); acc1 = __builtin_amdgcn_mfma_f32_16x16x32_bf16(af[ks], b1, acc1, 0, 0, 0); }
            __syncthreads();
            LAS pg8::f32x4* xs = (LAS pg8::f32x4*)bl + ((wave & 3) * 64 + lane) * 2;
            if (kh == 1) { xs[0] = acc0; xs[1] = acc1; }
            __syncthreads();
            if (kh == 0) {
                acc0 = acc0 + xs[0]; acc1 = acc1 + xs[1];
                const int r0 = rb + 16 * (wave & 3) + 4 * (lane >> 4); const float s0 = R0[r0], s1 = R0[r0 + 1], s2 = R0[r0 + 2], s3 = R0[r0 + 3];
#pragma unroll
                for (int g2 = 0; g2 < 2; ++g2) { const int h = 16 * g2 + (lane & 15); const float bb = fox_b_f[h]; const pg8::f32x4 a = g2 ? acc1 : acc0;
                    f32x4 o; o.x = logsigmoidf(a[0] * s0 + bb); o.y = logsigmoidf(a[1] * s1 + bb); o.z = logsigmoidf(a[2] * s2 + bb); o.w = logsigmoidf(a[3] * s3 + bb);
                    *(GAS f32x4*)(LOGF + ((size_t)((r0 >> 12) * NH + h) << 12) + (r0 & 4095)) = o; }
            }
            __syncthreads();
        }
        { LAS float* scr = (LAS float*)(lds + RING_OFF + wave * 16384);
          constexpr int I2 = (DM / 64) * (DM / 32), I3 = (DM / 64) * (SWA_IN / 32);
          for (int it = gw; it < I2 + I3; it += NGW) { if (it < I2) p0_transpose_item(fox_w_out, DM, DM, W2T, scr, it, lane, nullptr); else p0_transpose_item(swa_w_in, DM, SWA_IN, W3T, scr, it - I2, lane, norm_g + DM); } }
    }
    SEAM(1);
    if (IN(2)) REP(2) {
        for (int sq = vcu; sq < NB * NH; sq += G) {
            const GAS f32x4* lf = (const GAS f32x4*)(LOGF + (size_t)sq * SEQ + wave * 512) + lane * 2; const f32x4 v0 = __builtin_nontemporal_load(lf), v1 = __builtin_nontemporal_load(lf + 1);
            const double tot = (((double)v0.x + (double)v0.y) + ((double)v0.z + (double)v0.w)) + (((double)v1.x + (double)v1.y) + ((double)v1.z + (double)v1.w));
            double incl = tot;
#pragma unroll
            for (int o = 1; o < 64; o <<= 1) { const double up = __shfl_up(incl, o); if (lane >= o) incl += up; }
            volatile LAS double* wt = (volatile LAS double*)(lds + RING_OFF);
            __syncthreads();
            if (lane == 63) wt[wave] = incl;
            __syncthreads();
            double run = incl - tot;
            for (int w2 = 0; w2 < wave; ++w2) run += wt[w2];
            const float vv[8] = {v0.x, v0.y, v0.z, v0.w, v1.x, v1.y, v1.z, v1.w}; float cv[8];
#pragma unroll
            for (int e = 0; e < 8; ++e) { run += (double)vv[e]; cv[e] = (float)(run * 1.4426950408889634); }
            GAS f32x4* co = (GAS f32x4*)(CUM + (size_t)sq * SEQ + wave * 512) + lane * 2; co[0] = (f32x4){cv[0], cv[1], cv[2], cv[3]}; co[1] = (f32x4){cv[4], cv[5], cv[6], cv[7]};
            GAS v4u* ka = (GAS v4u*)(KAUG + ((size_t)sq * SEQ + wave * 512 + lane * 8) * 8);
#pragma unroll
            for (int e = 0; e < 8; ++e) { unsigned h1, h2, h3; fa::split3(-cv[e], h1, h2, h3); ka[e] = (v4u){h1 | (h2 << 16), h3 | 0x3F800000u, 0x3F803F80u, 0u}; }
        }
        { const int nidle = G > NB * NH ? G - NB * NH : G, ii = G > NB * NH ? vcu - NB * NH : vcu;
          if (ii >= 0) { __syncthreads(); LAS float* scr = (LAS float*)(lds + RING_OFF + wave * 16384); constexpr int I2 = (DM / 64) * (DM / 32);
              for (int it = ii * NWAVES + wave; it < I2; it += nidle * NWAVES) p0_transpose_item(swa_w_out, DM, DM, W4T, scr, it, lane, nullptr); } }
    }
    SEAM(2);
    if (IN(3)) {
        const fa::Params P{Qb, Kb, Vb, Gb, YG, CUM, nullptr, KMAX, TICKET, KAUG};
        if (grp && tid == 0) {
            const unsigned me = xb_xcc_id() + 1u; const int pn = gpm + 1, two = ((pn & 15) != 0) ? 1 : 0, pq = two ? pn : gpm;
            const unsigned r0 = xb_ld(XT + 8 * (16 + (gpm & 7)) + (gpm >> 3)), r1 = xb_ld(XT + 8 * (24 + (gpm & 7)) + (gpm >> 3));
            const unsigned r2 = xb_ld(XT + 8 * (16 + (pq & 7)) + (pq >> 3)), r3 = xb_ld(XT + 8 * (24 + (pq & 7)) + (pq >> 3));
            MISC[12] = (r0 != me || r1 != me || r2 != me || r3 != me) ? 1u : 0u; }
        volatile LAS unsigned* slot = (volatile LAS unsigned*)(lds + RING_OFF + fa::F_FLAG + 128);
#define FOX_FETCH(dst) do { unsigned code_ = 0xFFFFFFFFu; for (int k_ = 0; k_ < 8; ++k_) { const unsigned q_ = (unsigned)((bx + k_) & 7); const unsigned t_ = atomicAdd(TICKET + q_ * 64, 1u); \
            if (t_ < 256u) { code_ = q_ * 256u + t_; break; } } (dst) = code_; } while (0)
        if (tid == 0) FOX_FETCH(slot[0]);
        __syncthreads();
        unsigned tk = slot[0]; int par = 0;
        while (tk != 0xFFFFFFFFu) {
            if (tid == 0) FOX_FETCH(slot[par ^ 1]);
            const int q = (int)(tk >> 8), tq = (int)(tk & 255u), pi = tq >> 4, hs = 3 - (pi >> 2);
            const int h = hs == 0 ? q : hs == 1 ? 15 - q : hs == 2 ? 16 + q : 31 - q;
            fa::fox_unit(lds + RING_OFF, P, pi & 3, h, 15 - (tq & 15));
            par ^= 1; tk = slot[par];
        }
#undef FOX_FETCH
        __syncthreads();
    }
    SEAM(3);
    if (IN(4)) {
        pg8::Gemm g{YG, W2T, MTOK, DM, DM}; pg8::StaticOrder S; S.init(MTOK, DM, G, bx);
        pg8::EpiRes<true> E{x, XB, SS1};
        STAGGER();
        pg8::gemm_phase<pg8::EpiRes<true>, pg8::StaticOrder, true, true>(lds + RING_OFF, g, S, E);
    }
    SEAM(4);
    if (IN(5)) {
        pg8::Gemm g{XB, W3T, MTOK, SWA_IN, DM}; pg8::StaticOrder S; S.init(MTOK, SWA_IN, G, bx, (DUP_MASK >> 5) & 1, 0, 0, 0, grp ? 4 : (1 << 20));
        pg8::EpiSwaIn E{Qb, Kb, Vb, Gb, SS1, ROPE};
        STAGGER();
        pg8::gemm_phase<pg8::EpiSwaIn, pg8::StaticOrder, true, true>(lds + RING_OFF, g, S, E);
        if (grp) {
            G_ARRIVE();
            if (gj < 2) { pg8::StaticOrder S4; S4.init(MTOK, SWA_IN, G, bx, 0, 0, 0, 4, 5); pg8::gemm_phase<pg8::EpiSwaIn, pg8::StaticOrder, true, true>(lds + RING_OFF, g, S4, E); }
            else { const fa::Params P{Qb, Kb, Vb, Gb, YG, nullptr, swa_sinks, nullptr, nullptr, nullptr};
                   G_WAIT(gpm, 4); if ((gpm & 15) != 0) G_WAIT(gpm - 1, 4);
                   fa::swa_unit(lds + RING_OFF, P, gpm >> 4, gj - 2, gpm & 15); }
        }
    }
    SEAM(5);
    if (IN(6)) REP(6) {
        const fa::Params P{Qb, Kb, Vb, Gb, YG, nullptr, swa_sinks, nullptr, nullptr, nullptr};
        if (grp) fa::swa_unit(lds + RING_OFF, P, gpm >> 4, 2 + (gj >> 1), gpm & 15, (gj & 1) * 4, (gj & 1) * 4 + 4);
        else for (int u = bx; u < NB * 4 * 16; u += G) fa::swa_unit(lds + RING_OFF, P, u >> 6, (u >> 4) & 3, u & 15);
    }
    SEAM(6);
    if (IN(7)) {
        pg8::Gemm g{YG, W4T, MTOK, DM, DM}; pg8::StaticOrder S; S.init(MTOK, DM, G, bx);
        pg8::EpiRes<false> E{nullptr, XB, nullptr};
        STAGGER();
        pg8::gemm_phase<pg8::EpiRes<false>, pg8::StaticOrder, true, true>(lds + RING_OFF, g, S, E);
    }
    SEAM(7);
    if (IN(8)) {
        f32x4 gq[8];
#pragma unroll
        for (int j = 0; j < 8; ++j) gq[j] = ((const GAS f32x4*)final_g)[lane + 64 * j];
        for (int m = 2 * gw; m < MTOK; m += 2 * NGW) {
            f32x4 v[8], v2[8]; float s = 0.f, s2 = 0.f; unsigned long long xw[8], xw2[8];
#pragma unroll
            for (int j = 0; j < 8; ++j) { xw[j] = *(const GAS unsigned long long*)(XB + tiled_off(m, 256 * j + 4 * lane)); xw2[j] = *(const GAS unsigned long long*)(XB + tiled_off(m + 1, 256 * j + 4 * lane)); }
#pragma unroll
            for (int j = 0; j < 8; ++j) { const unsigned lo32 = (unsigned)xw[j], hi32 = (unsigned)(xw[j] >> 32), lo2 = (unsigned)xw2[j], hi2 = (unsigned)(xw2[j] >> 32);
                v[j] = (f32x4){__uint_as_float(lo32 << 16), __uint_as_float(lo32 & 0xffff0000u), __uint_as_float(hi32 << 16), __uint_as_float(hi32 & 0xffff0000u)};
                v2[j] = (f32x4){__uint_as_float(lo2 << 16), __uint_as_float(lo2 & 0xffff0000u), __uint_as_float(hi2 << 16), __uint_as_float(hi2 & 0xffff0000u)};
                s += (v[j].x * v[j].x + v[j].y * v[j].y) + (v[j].z * v[j].z + v[j].w * v[j].w); s2 += (v2[j].x * v2[j].x + v2[j].y * v2[j].y) + (v2[j].z * v2[j].z + v2[j].w * v2[j].w); }
            const float r = 1.0f / sqrtf(wave_sum(s) * (1.f / DM) + RMS_EPS), r2 = 1.0f / sqrtf(wave_sum(s2) * (1.f / DM) + RMS_EPS);
            GAS f32x4* xr = (GAS f32x4*)(out + (size_t)m * DM) + lane; GAS f32x4* xr2 = (GAS f32x4*)(out + (size_t)(m + 1) * DM) + lane;
#pragma unroll
            for (int j = 0; j < 8; ++j) { __builtin_nontemporal_store(v[j] * r * gq[j], xr + 64 * j); __builtin_nontemporal_store(v2[j] * r2 * gq[j], xr2 + 64 * j); }
        }
    }
#undef IN
#undef SEAM
#undef G_ARRIVE
#undef G_WAIT
}

extern "C" void kernel_launch(void* const* d_in, const int* in_sizes, int n_in, void* d_out, int out_size, void* d_ws, size_t ws_size, hipStream_t stream) {
    static int grid = 0;
    if (grid == 0) {
        if (n_in != 9 || in_sizes[0] != MTOK * DM || out_size != MTOK * DM || ws_size < WS_END) { fprintf(stderr, "kernel_launch: unexpected shapes (n_in %d, in0 %d, out %d, ws %zu)\n", n_in, n_in > 0 ? in_sizes[0] : -1, out_size, ws_size); grid = -1; return; }
        int dev = 0, cus = 0, per_cu = 0;
        if (hipGetDevice(&dev) != hipSuccess || hipDeviceGetAttribute(&cus, hipDeviceAttributeMultiprocessorCount, dev) != hipSuccess) { fprintf(stderr, "kernel_launch: device query failed\n"); grid = -1; return; }
        if (hipFuncSetAttribute((const void*)mega_fwd, hipFuncAttributeMaxDynamicSharedMemorySize, LDS_BYTES) != hipSuccess) { fprintf(stderr, "kernel_launch: hipFuncSetAttribute failed\n"); grid = -1; return; }
        if (hipOccupancyMaxActiveBlocksPerMultiprocessor(&per_cu, (const void*)mega_fwd, NWAVES * 64, LDS_BYTES) != hipSuccess || per_cu < 1) { fprintf(stderr, "kernel_launch: occupancy query reports %d workgroups per CU; nothing launched\n", per_cu); (void)hipGetLastError(); grid = -1; return; }
        grid = cus;
    }
    if (grid < 0) return;
    (void)hipMemsetAsync((unsigned char*)d_ws + WS_CTL, 0, CTL_ZERO_BYTES, stream);
    Args a{};
    for (int i = 0; i < 9; ++i) a.in[i] = (const float*)d_in[i];
    a.out = (float*)d_out; a.ws = (unsigned char*)d_ws;
    int p = 0;
    while (p < N_PHASES) {
        if (!((FAST_MASK >> p) & 1)) { ++p; continue; }
        int e = p + 1; if (ONE_LAUNCH) while (e < N_PHASES && ((FAST_MASK >> e) & 1)) ++e;
        a.ph_lo = p; a.ph_hi = e;
        hipLaunchKernelGGL(mega_fwd, dim3(grid), dim3(NWAVES * 64), LDS_BYTES, stream, a);
        p = e;
    }
}
```

```cpp
#include <hip/hip_runtime.h>
#include <cstdio>
#include <cstdint>

constexpr int NB = 4, SEQ = 4096, DM = 2048, MTOK = NB * SEQ, NH = 32, HD = 64;
constexpr int FOX_IN = 8224, SWA_IN = 4608, KVW = 256;
constexpr float RMS_EPS = 1e-6f;
constexpr float LOG2E = 1.4426950408889634f;
constexpr float C2 = 0.125f * LOG2E;

typedef unsigned short bf16_t;
__device__ __forceinline__ float bf2f(bf16_t v) { return __uint_as_float((unsigned)v << 16); }
__device__ __forceinline__ bf16_t f2bf(float f) { unsigned u = __float_as_uint(f); return (bf16_t)((u + 0x7fffu + ((u >> 16) & 1u)) >> 16); }
__device__ __forceinline__ float logsigmoidf(float z) { return z < 0.f ? z - log1pf(expf(z)) : -log1pf(expf(-z)); }
__device__ __forceinline__ float siluf(float g) { return g / (1.f + expf(-g)); }

__host__ __device__ __forceinline__ size_t tiled_off(int row, int k) { return ((size_t)(((row >> 8) * (DM / 64) + (k >> 6)) * 2 + ((k >> 5) & 1)) << 13) + (size_t)(((row & 255) << 5) + (k & 31)); }

__host__ __device__ __forceinline__ size_t hm_off(int row  , int col  , int nheads) { return ((size_t)(((row >> 12) * nheads + (col >> 6)) * 2 + ((col >> 5) & 1)) * SEQ + (row & 4095)) * 32 + (col & 31); }

constexpr size_t MiB = 1u << 20;
constexpr size_t WS_CTL = 0, CTL_ZERO_BYTES = 1 * MiB;
constexpr size_t WS_KMAX = 64 * 1024, WS_TICKET = 66 * 1024;
constexpr size_t WS_GS = 128 * 1024;
constexpr size_t WS_XT = 160 * 1024;
constexpr size_t WS_SS1 = 512 * 1024;
constexpr size_t WS_R0 = 1 * MiB;
constexpr size_t WS_ROPE = 1 * MiB + 512 * 1024;
constexpr size_t WS_LOGF = 2 * MiB;
constexpr size_t WS_CUM = 4 * MiB;
constexpr size_t WS_W1T = 8 * MiB, WS_W2T = 41 * MiB, WS_W3T = 49 * MiB, WS_W4T = 67 * MiB;
constexpr size_t WS_XB = 76 * MiB, WS_Q = 140 * MiB, WS_K = 204 * MiB, WS_V = 268 * MiB, WS_G = 332 * MiB, WS_YG = 396 * MiB, WS_KAUG = 460 * MiB, WS_END = 468 * MiB;

#ifndef FAST_MASK
#define FAST_MASK 0x1FF
#endif
#ifndef DUP_MASK
#define DUP_MASK 0x000
#endif
#ifndef ONE_LAUNCH
#define ONE_LAUNCH 1
#endif
namespace pg8 {
#define PG8_LAS __attribute__((address_space(3)))
typedef unsigned short bf16_t;
typedef short bf16x8 __attribute__((ext_vector_type(8)));
typedef float f32x4 __attribute__((ext_vector_type(4)));
typedef unsigned u32x4 __attribute__((ext_vector_type(4)));
constexpr int BM = 256, BK = 64, HALF = 128, HTB = HALF * BK * 2  , STAGE_BYTES = 8 * HTB, NXCD = 8, WGM = 8;

__host__ __device__ __forceinline__ int lds_byte(int r, int c) { const int st = (r >> 4) * 2 + (c >> 5), rr = r & 15, cc = c & 31, ob = rr * 64 + cc * 2; return st * 1024 + (ob ^ (((ob >> 9) & 1) << 5)); }
__host__ __device__ __forceinline__ void stage_rc(int b, int& R, int& C) { const int st = b / 1024, sb = b % 1024, swz = sb ^ (((sb >> 9) & 1) << 5); R = (st >> 1) * 16 + swz / 64; C = (st & 1) * 32 + (swz % 64) / 2; }
__host__ __device__ __forceinline__ int perm32(int rho) { const int n = rho >> 4, i = rho & 15; return 8 * (i >> 2) + 4 * n + (i & 3); }

struct Unit { int pm, pn, lm, ln; };
struct Gemm { const bf16_t* A; const bf16_t* Bt; int M, N, K; };

struct StaticOrder {
    int nM, nN, nwg, G, c, dup, epi2, same, i0, i1;
    __host__ __device__ void init(int M, int N, int G_, int c_, int dup_ = 0, int epi2_ = 0, int same_ = 0, int i0_ = 0, int i1_ = 1 << 20) { nM = M / BM; nN = N / BM; nwg = nM * nN; G = G_; c = c_; dup = dup_; epi2 = epi2_; same = same_; i0 = i0_; i1 = i1_; }
    __host__ __device__ bool next(int i, Unit& u) const {
        if (dup) i >>= 1;
        i += i0; if (i >= i1) return false;
        const long L = (long)i * G + c; if (L >= nwg) return false;
        int wgid = (int)L; { const int q = nwg / NXCD, r = nwg % NXCD, xcd = wgid % NXCD, off = wgid / NXCD; wgid = (xcd < r ? xcd * (q + 1) : r * (q + 1) + (xcd - r) * q) + off; }
        const int nig = WGM * nN, gid = wgid / nig, fm = gid * WGM, gsz = (nM - fm) < WGM ? (nM - fm) : WGM;
        u.pm = fm + ((wgid % nig) % gsz); u.pn = (wgid % nig) / gsz;
        { const int ng = nN >> 2, cg = u.pn >> 2; if (cg < ng) u.pn = 4 * ((cg + (int)(L & 7)) % ng) + (u.pn & 3); }
        u.lm = same ? 0 : u.pm; u.ln = same ? 0 : u.pn; return true;
    }
    __device__ __forceinline__ void a_ready(const Unit&) const {}
    __device__ __forceinline__ void done(const Unit&) const {}
};

__device__ __forceinline__ unsigned cvt_pk_bf16(float lo, float hi) { unsigned r; asm volatile("v_cvt_pk_bf16_f32 %0, %1, %2" : "=v"(r) : "v"(lo), "v"(hi)); return r; }
__device__ __forceinline__ float silu_fast(float g) { return g * __builtin_amdgcn_rcpf(1.0f + __builtin_amdgcn_exp2f(-g * 1.4426950408889634f)); }
__device__ __forceinline__ u32x4 pack8(const f32x4 v0, const f32x4 v1) { u32x4 w; w.x = cvt_pk_bf16(v0[0], v0[1]); w.y = cvt_pk_bf16(v0[2], v0[3]); w.z = cvt_pk_bf16(v1[0], v1[1]); w.w = cvt_pk_bf16(v1[2], v1[3]); return w; }
struct EpiFoxIn {
    static constexpr bool PERM = true, AFTER_DRAIN = false;
    bf16_t *Q, *K, *V, *G; float* LOGF; const float* R0; const float* bfb; unsigned* KMAX;
    __device__ __forceinline__ void operator()(const f32x4 (&acc)[2][2][4][2], const Unit& u, int wr, int wc, int fr, int fq) const {
        const int row0 = u.pm * BM + wr * 64 + fr, pn = u.pn;
        float rs[2][4];
#pragma unroll
        for (int ai = 0; ai < 2; ++ai)
#pragma unroll
            for (int m = 0; m < 4; ++m) rs[ai][m] = R0[row0 + ai * HALF + m * 16];
        {
            const int reg = pn >> 3; bf16_t* base = reg == 0 ? Q : reg == 1 ? K : reg == 2 ? V : G; float kmx[2] = {0.f, 0.f};
            const int col0 = (pn & 7) * BM + wc * 32 + 8 * fq;
#pragma unroll
            for (int ai = 0; ai < 2; ++ai)
#pragma unroll
                for (int m = 0; m < 4; ++m) { const int row = row0 + ai * HALF + m * 16; const float r = rs[ai][m]; const float sc = reg == 0 ? r * C2 : r;
#pragma unroll
                    for (int bj = 0; bj < 2; ++bj) { f32x4 v0 = acc[ai][bj][m][0] * sc, v1 = acc[ai][bj][m][1] * sc;
                        if (reg == 3) {
#pragma unroll
                            for (int j = 0; j < 4; ++j) { v0[j] = silu_fast(v0[j]); v1[j] = silu_fast(v1[j]); } }
                        if (reg == 1) { float ss = ((v0[0] * v0[0] + v0[1] * v0[1]) + (v0[2] * v0[2] + v0[3] * v0[3])) + ((v1[0] * v1[0] + v1[1] * v1[1]) + (v1[2] * v1[2] + v1[3] * v1[3]));
                            ss += __shfl_xor(ss, 16); ss += __shfl_xor(ss, 32); kmx[bj] = fmaxf(kmx[bj], ss); }
                        __builtin_nontemporal_store(pack8(v0, v1), (u32x4*)(base + hm_off(row, col0 + bj * HALF, NH))); } }
            if (reg == 1) {
#pragma unroll
                for (int bj = 0; bj < 2; ++bj) { float mx = kmx[bj];
#pragma unroll
                    for (int o = 1; o < 16; o <<= 1) mx = fmaxf(mx, __shfl_xor(mx, o));
                    if (fr == 0 && fq == 0) atomicMax(KMAX + ((row0 >> 12) * NH + (pn & 7) * 4 + bj * 2 + (wc >> 1)) * 2 + (wc & 1), __float_as_uint(mx)); } }
        }
    }
};
struct EpiSwaIn {
    static constexpr bool PERM = true, AFTER_DRAIN = false;
    bf16_t *Q, *K, *V, *G; const float* SS; const float* ROPE;
    __device__ __forceinline__ void operator()(const f32x4 (&acc)[2][2][4][2], const Unit& u, int wr, int wc, int fr, int fq) const {
        const int row0 = u.pm * BM + wr * 64 + fr, pn = u.pn;
        bf16_t* base; int pitch, colt; float osc = 1.f; const bool rope = pn <= 8, gate = pn >= 10;
        if (pn < 8) { base = Q; pitch = DM; colt = pn * BM; osc = C2; } else if (pn == 8) { base = K; pitch = KVW; colt = 0; } else if (pn == 9) { base = V; pitch = KVW; colt = 0; } else { base = G; pitch = DM; colt = (pn - 10) * BM; }
        const int col0 = colt + wc * 32 + 8 * fq; const bool rotw = rope && ((wc & 1) == 0); const float sgn = fq == 0 ? -1.f : 1.f; const bool rotl = fq < 2;
        float rs[2][4];
#pragma unroll
        for (int ai = 0; ai < 2; ++ai)
#pragma unroll
            for (int m = 0; m < 4; ++m) rs[ai][m] = SS[row0 + ai * HALF + m * 16];
        f32x4 nc0, nc1, ns0, ns1;
        if (rotw) { const float* rp = ROPE + (size_t)(row0 & 4095) * 16; nc0 = *(const f32x4*)rp; nc1 = *(const f32x4*)(rp + 4); ns0 = *(const f32x4*)(rp + 8); ns1 = *(const f32x4*)(rp + 12); }
#pragma unroll
        for (int ai = 0; ai < 2; ++ai)
#pragma unroll
            for (int m = 0; m < 4; ++m) { const int row = row0 + ai * HALF + m * 16; const float r = 1.0f / sqrtf(rs[ai][m] * (1.f / DM) + RMS_EPS);
                const f32x4 c0 = nc0, c1 = nc1, s0 = ns0, s1 = ns1;
                if (rotw && (ai * 4 + m) < 7) { const int nrow = row0 + ((ai * 4 + m + 1) >> 2) * HALF + ((ai * 4 + m + 1) & 3) * 16; const float* rp = ROPE + (size_t)(nrow & 4095) * 16; nc0 = *(const f32x4*)rp; nc1 = *(const f32x4*)(rp + 4); ns0 = *(const f32x4*)(rp + 8); ns1 = *(const f32x4*)(rp + 12); }
#pragma unroll
                for (int bj = 0; bj < 2; ++bj) { f32x4 v0 = acc[ai][bj][m][0] * r, v1 = acc[ai][bj][m][1] * r;
                    if (rotw) {
#pragma unroll
                        for (int j = 0; j < 4; ++j) { const float p0 = __shfl_xor(v0[j], 16), p1 = __shfl_xor(v1[j], 16);
                            const float n0 = v0[j] * c0[j] + sgn * p0 * s0[j], n1 = v1[j] * c1[j] + sgn * p1 * s1[j];
                            v0[j] = rotl ? n0 : v0[j]; v1[j] = rotl ? n1 : v1[j]; } }
                    if (gate) {
#pragma unroll
                        for (int j = 0; j < 4; ++j) { v0[j] = silu_fast(v0[j]); v1[j] = silu_fast(v1[j]); } }
                    v0 = v0 * osc; v1 = v1 * osc;
                    *(u32x4*)(base + hm_off(row, col0 + bj * HALF, pitch >> 6)) = pack8(v0, v1); } }
    }
};
template <bool FIRST> struct EpiRes {
    static constexpr bool PERM = true, AFTER_DRAIN = false;
    const float* xin; bf16_t* XB; float* SS;
    __device__ __forceinline__ void operator()(const f32x4 (&acc)[2][2][4][2], const Unit& u, int wr, int wc, int fr, int fq) const {
        const int row0 = u.pm * BM + wr * 64 + fr, col0 = u.pn * BM + wc * 32 + 8 * fq;
        if (FIRST) {
            f32x4 nx[2][2];
#pragma unroll
            for (int bj = 0; bj < 2; ++bj)
#pragma unroll
                for (int n = 0; n < 2; ++n) nx[bj][n] = *(const f32x4*)(xin + (size_t)row0 * DM + col0 + bj * HALF + n * 4);
#pragma unroll
            for (int ai = 0; ai < 2; ++ai)
#pragma unroll
                for (int m = 0; m < 4; ++m) { const int row = row0 + ai * HALF + m * 16; float ss = 0.f;
                    f32x4 cx[2][2];
#pragma unroll
                    for (int bj = 0; bj < 2; ++bj)
#pragma unroll
                        for (int n = 0; n < 2; ++n) cx[bj][n] = nx[bj][n];
                    if ((ai * 4 + m) < 7) { const int nrow = row0 + ((ai * 4 + m + 1) >> 2) * HALF + ((ai * 4 + m + 1) & 3) * 16;
#pragma unroll
                        for (int bj = 0; bj < 2; ++bj)
#pragma unroll
                            for (int n = 0; n < 2; ++n) nx[bj][n] = *(const f32x4*)(xin + (size_t)nrow * DM + col0 + bj * HALF + n * 4); }
#pragma unroll
                    for (int bj = 0; bj < 2; ++bj) { const f32x4 x0 = cx[bj][0] + acc[ai][bj][m][0], x1 = cx[bj][1] + acc[ai][bj][m][1];
                        *(u32x4*)(XB + tiled_off(row, col0 + bj * HALF)) = pack8(x0, x1);
                        ss += ((x0[0] * x0[0] + x0[1] * x0[1]) + (x0[2] * x0[2] + x0[3] * x0[3])) + ((x1[0] * x1[0] + x1[1] * x1[1]) + (x1[2] * x1[2] + x1[3] * x1[3])); }
                    ss += __shfl_xor(ss, 16); ss += __shfl_xor(ss, 32); if (fq == 0) atomicAdd(SS + row, ss); }
        } else {
            u32x4 xv[2][4][2];
#pragma unroll
            for (int ai = 0; ai < 2; ++ai)
#pragma unroll
                for (int m = 0; m < 4; ++m)
#pragma unroll
                    for (int bj = 0; bj < 2; ++bj) xv[ai][m][bj] = *(const u32x4*)(XB + tiled_off(row0 + ai * HALF + m * 16, col0 + bj * HALF));
#pragma unroll
            for (int ai = 0; ai < 2; ++ai)
#pragma unroll
                for (int m = 0; m < 4; ++m)
#pragma unroll
                    for (int bj = 0; bj < 2; ++bj) { const u32x4 xw = xv[ai][m][bj]; const f32x4 a0 = acc[ai][bj][m][0], a1 = acc[ai][bj][m][1];
                        const f32x4 y0 = {__uint_as_float(xw.x << 16) + a0[0], __uint_as_float(xw.x & 0xffff0000u) + a0[1], __uint_as_float(xw.y << 16) + a0[2], __uint_as_float(xw.y & 0xffff0000u) + a0[3]};
                        const f32x4 y1 = {__uint_as_float(xw.z << 16) + a1[0], __uint_as_float(xw.z & 0xffff0000u) + a1[1], __uint_as_float(xw.w << 16) + a1[2], __uint_as_float(xw.w & 0xffff0000u) + a1[3]};
                        *(u32x4*)(XB + tiled_off(row0 + ai * HALF + m * 16, col0 + bj * HALF)) = pack8(y0, y1);
                        if (SS) { float ss = ((y0[0] * y0[0] + y0[1] * y0[1]) + (y0[2] * y0[2] + y0[3] * y0[3])) + ((y1[0] * y1[0] + y1[1] * y1[1]) + (y1[2] * y1[2] + y1[3] * y1[3]));
                            ss += __shfl_xor(ss, 16); ss += __shfl_xor(ss, 32); if (fq == 0) atomicAdd(SS + row0 + ai * HALF + m * 16, ss); } }
        }
    }
};
template <class Epi, class Sched, bool ALIGN_EPI = false, bool SP2 = false>
__device__ __forceinline__ void gemm_phase(PG8_LAS unsigned char* lds, const Gemm g, const Sched& S, const Epi& E) {
    const int tid = threadIdx.x, wid = __builtin_amdgcn_readfirstlane(tid >> 6), lane = tid & 63, wr = wid >> 2, wc = wid & 3, fr = lane & 15, fq = lane >> 4;
    const int K = g.K, nt = K / BK;
    unsigned voffA[2], voffB[2];
#pragma unroll
    for (int i = 0; i < 2; ++i) { int R, C; stage_rc(tid * 16 + i * 8192, R, C); const int Rb = Epi::PERM ? ((R & ~31) + perm32(R & 31)) : R;
        voffA[i] = (unsigned)((C >> 5) * (BM * 32) + R * 32 + (C & 31)) * 2u; voffB[i] = (unsigned)((C >> 5) * (BM * 32) + Rb * 32 + (C & 31)) * 2u; }
    const size_t kstep = (size_t)(BM * BK * 2);
    const size_t hstep = (size_t)(HALF * 32 * 2);
    const size_t tstep = (size_t)BM * K * 2;
    const unsigned ldsw = (unsigned)wid * 1024u;
    const int aoff = lds_byte(wr * 64 + fr, fq * 8), boff = lds_byte(wc * 32 + fr, fq * 8);
#define PG8_SA(b, h) (((b) * 2 + (h)) * HTB)
#define PG8_SB(b, h) ((4 + (b) * 2 + (h)) * HTB)
#define PG8_STAGE(bufoff, gbase, voff) do { _Pragma("unroll") for (int _i = 0; _i < 2; ++_i) \
        __builtin_amdgcn_global_load_lds((const unsigned*)((const char*)(gbase) + (voff)[_i]), (PG8_LAS unsigned*)(lds + (bufoff) + ldsw + _i * 8192), 16, 0, 0); } while (0)
#define PG8_LDA(dst, b, h) do { _Pragma("unroll") for (int m = 0; m < 4; ++m) _Pragma("unroll") for (int k = 0; k < 2; ++k) dst[m][k] = *(const PG8_LAS bf16x8*)(lds + PG8_SA(b, h) + aoff + m * 2048 + k * 1024); } while (0)
#define PG8_LDB(dst, b, h) do { _Pragma("unroll") for (int n = 0; n < 2; ++n) _Pragma("unroll") for (int k = 0; k < 2; ++k) dst[n][k] = *(const PG8_LAS bf16x8*)(lds + PG8_SB(b, h) + boff + n * 2048 + k * 1024); } while (0)
#define PG8_MMA(ai, bj, At, Bt) do { __builtin_amdgcn_s_setprio(1); _Pragma("unroll") for (int m = 0; m < 4; ++m) _Pragma("unroll") for (int n = 0; n < 2; ++n) _Pragma("unroll") for (int k = 0; k < 2; ++k) \
        acc[ai][bj][m][n] = __builtin_amdgcn_mfma_f32_16x16x32_bf16(Bt[n][k], At[m][k], acc[ai][bj][m][n], 0, 0, 0); __builtin_amdgcn_s_setprio(0); } while (0)
#define PG8_WAIT_V(n) asm volatile("s_waitcnt vmcnt(" #n ")" ::: "memory")
#define PG8_WAIT_L(n) asm volatile("s_waitcnt lgkmcnt(" #n ")" ::: "memory")
#define PG8_BAR __builtin_amdgcn_s_barrier()
#define PG8_SCHED __builtin_amdgcn_sched_barrier(0)
    Unit cur, nxt; int ui = 0;
    if (!S.next(0, cur)) return;
    f32x4 acc[2][2][4][2];
#pragma unroll
    for (int a = 0; a < 2; ++a)
#pragma unroll
        for (int b = 0; b < 2; ++b)
#pragma unroll
            for (int m = 0; m < 4; ++m)
#pragma unroll
                for (int n = 0; n < 2; ++n) acc[a][b][m][n] = (f32x4){0.f, 0.f, 0.f, 0.f};
    bf16x8 At[4][2], B0[2][2], B1[2][2];
    const char* cA = (const char*)g.A + (size_t)cur.lm * tstep; const char* cB = (const char*)g.Bt + (size_t)cur.ln * tstep;
    S.a_ready(cur);
    if constexpr (SP2) {
        PG8_STAGE(PG8_SB(0, 0), cB, voffB); PG8_STAGE(PG8_SB(0, 1), cB + hstep, voffB); PG8_STAGE(PG8_SA(0, 0), cA, voffA); PG8_STAGE(PG8_SA(0, 1), cA + hstep, voffA);
        if (wr == 1) PG8_BAR;
        PG8_WAIT_V(2); PG8_BAR;
        PG8_STAGE(PG8_SB(1, 0), cB + kstep, voffB); PG8_STAGE(PG8_SA(1, 0), cA + kstep, voffA); PG8_STAGE(PG8_SB(1, 1), cB + hstep + kstep, voffB);
        PG8_WAIT_V(6); PG8_BAR;
    } else {
        PG8_STAGE(PG8_SB(0, 0), cB, voffB); PG8_STAGE(PG8_SA(0, 0), cA, voffA); PG8_STAGE(PG8_SB(0, 1), cB + hstep, voffB); PG8_STAGE(PG8_SA(0, 1), cA + hstep, voffA);
        if (wr == 1) PG8_BAR;
        PG8_WAIT_V(4); PG8_BAR;
        PG8_STAGE(PG8_SB(1, 0), cB + kstep, voffB); PG8_STAGE(PG8_SA(1, 0), cA + kstep, voffA); PG8_STAGE(PG8_SB(1, 1), cB + hstep + kstep, voffB);
        PG8_WAIT_V(6); PG8_BAR;
    }
    for (;;) {
        const bool has_next = S.next(ui + 1, nxt);
        const char* nA = has_next ? (const char*)g.A + (size_t)nxt.lm * tstep : cA; const char* nB = has_next ? (const char*)g.Bt + (size_t)nxt.ln * tstep : cB;
        for (int t = 0; t < nt; t += 2) {
            const bool last = (t == nt - 2);
            const char* a1 = cA + (size_t)(t + 1) * kstep;
            const char* a2 = last ? nA : cA + (size_t)(t + 2) * kstep; const char* b2 = last ? nB : cB + (size_t)(t + 2) * kstep;
            const char* a3 = a2 + kstep; const char* b3 = b2 + kstep;
            if (last && has_next) S.a_ready(nxt);
            if constexpr (SP2) {
            PG8_LDB(B0, 0, 0); PG8_LDB(B1, 0, 1); PG8_SCHED; PG8_LDA(At, 0, 0); PG8_STAGE(PG8_SA(1, 0), a1, voffA); PG8_STAGE(PG8_SA(1, 1), a1 + hstep, voffA);
            PG8_WAIT_V(8); PG8_WAIT_L(0); PG8_BAR; PG8_MMA(0, 0, At, B0); PG8_MMA(0, 1, At, B1); PG8_BAR; PG8_SCHED;
            PG8_LDA(At, 0, 1); PG8_STAGE(PG8_SB(0, 0), b2, voffB); PG8_STAGE(PG8_SB(0, 1), b2 + hstep, voffB);
            PG8_WAIT_V(6); PG8_WAIT_L(0); PG8_BAR; PG8_MMA(1, 0, At, B0); PG8_MMA(1, 1, At, B1); PG8_BAR; PG8_SCHED;
            PG8_LDB(B0, 1, 0); PG8_LDB(B1, 1, 1); PG8_SCHED; PG8_LDA(At, 1, 0); PG8_STAGE(PG8_SA(0, 0), a2, voffA); PG8_STAGE(PG8_SA(0, 1), a2 + hstep, voffA);
            PG8_WAIT_V(8); PG8_WAIT_L(0); PG8_BAR; PG8_MMA(0, 0, At, B0); PG8_MMA(0, 1, At, B1); PG8_BAR; PG8_SCHED;
            PG8_LDA(At, 1, 1); PG8_STAGE(PG8_SB(1, 0), b3, voffB); PG8_STAGE(PG8_SB(1, 1), b3 + hstep, voffB);
            PG8_WAIT_V(6); PG8_WAIT_L(0); PG8_BAR; PG8_MMA(1, 0, At, B0); PG8_MMA(1, 1, At, B1); PG8_BAR; PG8_SCHED;
            } else {
            PG8_LDB(B0, 0, 0); PG8_SCHED; PG8_LDA(At, 0, 0); PG8_STAGE(PG8_SA(1, 1), a1 + hstep, voffA);
            PG8_WAIT_L(8); PG8_BAR; PG8_WAIT_L(0); PG8_MMA(0, 0, At, B0); PG8_BAR; PG8_SCHED;
            PG8_LDB(B1, 0, 1); PG8_STAGE(PG8_SB(0, 0), b2, voffB);
            PG8_BAR; PG8_WAIT_L(0); PG8_MMA(0, 1, At, B1); PG8_BAR;
            PG8_LDA(At, 0, 1); PG8_STAGE(PG8_SA(0, 0), a2, voffA);
            PG8_BAR; PG8_WAIT_L(0); PG8_MMA(1, 0, At, B0); PG8_BAR; PG8_SCHED;
            PG8_STAGE(PG8_SB(0, 1), b2 + hstep, voffB);
            PG8_WAIT_V(6); PG8_BAR; PG8_MMA(1, 1, At, B1); PG8_BAR;
            PG8_LDB(B0, 1, 0); PG8_SCHED; PG8_LDA(At, 1, 0); PG8_STAGE(PG8_SA(0, 1), a2 + hstep, voffA);
            PG8_WAIT_L(8); PG8_BAR; PG8_WAIT_L(0); PG8_MMA(0, 0, At, B0); PG8_BAR; PG8_SCHED;
            PG8_LDB(B1, 1, 1); PG8_STAGE(PG8_SB(1, 0), b3, voffB);
            PG8_BAR; PG8_WAIT_L(0); PG8_MMA(0, 1, At, B1); PG8_BAR;
            PG8_LDA(At, 1, 1); PG8_STAGE(PG8_SA(1, 0), a3, voffA);
            PG8_BAR; PG8_WAIT_L(0); PG8_MMA(1, 0, At, B0); PG8_BAR; PG8_SCHED;
            PG8_STAGE(PG8_SB(1, 1), b3 + hstep, voffB);
            PG8_WAIT_V(6); PG8_BAR; PG8_MMA(1, 1, At, B1); PG8_BAR;
            }
        }
        if constexpr (ALIGN_EPI) { if (wr == 0) PG8_BAR; }
        if constexpr (!Epi::AFTER_DRAIN) { E(acc, cur, wr, wc, fr, fq); if (S.epi2) E(acc, cur, wr, wc, fr, fq); S.done(cur); }
        if (!has_next) break;
#pragma unroll
        for (int a = 0; a < 2; ++a)
#pragma unroll
            for (int b = 0; b < 2; ++b)
#pragma unroll
                for (int m = 0; m < 4; ++m)
#pragma unroll
                    for (int n = 0; n < 2; ++n) acc[a][b][m][n] = (f32x4){0.f, 0.f, 0.f, 0.f};
        cur = nxt; cA = nA; cB = nB; ++ui;
        if constexpr (ALIGN_EPI) { if (wr == 1) PG8_BAR; }
    }
    PG8_WAIT_V(0);
    if constexpr (!ALIGN_EPI) { if (wr == 0) PG8_BAR; }
    PG8_BAR;
    if constexpr (Epi::AFTER_DRAIN) { E.fused(acc, cur, wr, wc, fr, fq, lds, wid, lane); S.done(cur); }
#undef PG8_SA
#undef PG8_SB
#undef PG8_STAGE
#undef PG8_LDA
#undef PG8_LDB
#undef PG8_MMA
#undef PG8_WAIT_V
#undef PG8_WAIT_L
#undef PG8_BAR
#undef PG8_SCHED
}
}
namespace fa {
#define FA_LAS __attribute__((address_space(3)))
typedef short bf16x8 __attribute__((ext_vector_type(8)));
typedef short s16x4 __attribute__((ext_vector_type(4)));
typedef short v4i16_t __attribute__((ext_vector_type(4)));
typedef float f32x16 __attribute__((ext_vector_type(16)));
typedef float f32x4 __attribute__((ext_vector_type(4)));
typedef unsigned u32x4 __attribute__((ext_vector_type(4)));
typedef float f32x2_t __attribute__((ext_vector_type(2))); typedef __bf16 bf16x2_t __attribute__((ext_vector_type(2)));
constexpr float THR = 8.f, TH_SKIP = 32.f;
constexpr int F_KBUF = 18432, F_AOFF = 8192, F_VOFF = 10240, F_WSF = 3 * F_KBUF, F_FLAG = F_WSF + 8 * 256, F_OST = F_FLAG + 256, F_LDS_BYTES = F_OST + 8 * 4096;
constexpr int S_KBUF = 16384, S_VOFF = 8192, S_WSF = 6 * S_KBUF, S_OST = S_WSF + 8 * 256, S_LDS_BYTES = S_OST + 8 * 4096;
struct Params { const bf16_t* Q; const bf16_t* K; const bf16_t* V; const bf16_t* G; bf16_t* O; const float* CUM; const float* sinks; const unsigned* KMAX; unsigned* ticket; const bf16_t* KAUG; };
__device__ __forceinline__ unsigned cvtpk(float lo, float hi) { f32x2_t v = {lo, hi}; bf16x2_t b = __builtin_convertvector(v, bf16x2_t); return __builtin_bit_cast(unsigned, b); }
__device__ __forceinline__ s16x4 vtr(FA_LAS unsigned char* p) { return __builtin_bit_cast(s16x4, __builtin_amdgcn_ds_read_tr16_b64_v4i16((FA_LAS v4i16_t*)p)); }
__device__ __forceinline__ float swap_max(float v) { auto rr = __builtin_amdgcn_permlane32_swap(__float_as_uint(v), __float_as_uint(v), false, false); return __builtin_fmaxf(__uint_as_float(rr[0]), __uint_as_float(rr[1])); }
__device__ __forceinline__ float swap_add(float v) { auto rr = __builtin_amdgcn_permlane32_swap(__float_as_uint(v), __float_as_uint(v), false, false); return __uint_as_float(rr[0]) + __uint_as_float(rr[1]); }
__device__ __forceinline__ void glds16(const void* gsrc, unsigned lds_dst) { unsigned keep;
    asm volatile("s_mov_b32 %0, m0\n\ts_mov_b32 m0, %2\n\ts_nop 0\n\tglobal_load_lds_dwordx4 %1, off\n\ts_mov_b32 m0, %0" : "=&s"(keep) : "v"(gsrc), "s"(lds_dst) : "memory"); }
#define FA_MFMA(a, b, c) __builtin_amdgcn_mfma_f32_32x32x16_bf16((a), (b), (c), 0, 0, 0)
#define FA_MX3(a, b, c) __builtin_fmaxf(__builtin_fmaxf((a), (b)), (c))
struct WaveSt { bf16x8 qr[4]; bf16x8 qa; f32x16 o0, o1; float cq, mhat, lsum, mrun; };

#define FA_SBAR() __builtin_amdgcn_sched_barrier(0)
#define FA_PIN(x) asm volatile("" : "+v"(x))
#define FA_LDK(p) (*(FA_LAS bf16x8*)(p))
#define FA_VF(l, h) ((bf16x8){l[0], l[1], l[2], l[3], h[0], h[1], h[2], h[3]})
#define FA_EX4(X, B) do { X[B] = __builtin_amdgcn_exp2f(X[B]); X[B + 1] = __builtin_amdgcn_exp2f(X[B + 1]); X[B + 2] = __builtin_amdgcn_exp2f(X[B + 2]); X[B + 3] = __builtin_amdgcn_exp2f(X[B + 3]); } while (0)
__device__ __forceinline__ void split3(float v, unsigned& h1, unsigned& h2, unsigned& h3) { const bf16_t a = f2bf(v); const float r1 = v - bf2f(a); const bf16_t b = f2bf(r1); const float r2 = r1 - bf2f(b); h1 = a; h2 = b; h3 = f2bf(r2); }
__device__ __forceinline__ void set_qa(WaveSt& w, int hi) {
    unsigned g1, g2, g3; split3(w.cq - w.mhat, g1, g2, g3);
    const u32x4 q = {hi == 0 ? 0x3F803F80u : 0u, hi == 0 ? (0x3F80u | (g1 << 16)) : 0u, hi == 0 ? (g2 | (g3 << 16)) : 0u, 0u};
    w.qa = __builtin_bit_cast(bf16x8, q);
}
template <int MODE, int AOFF, int VOFF>
__device__ __forceinline__ void tile_full(FA_LAS unsigned char* bb, FA_LAS unsigned char* vprev, FA_LAS float* wsf, WaveSt& w, f32x16& C0, f32x16& C1, f32x16& P0, f32x16& P1,
                                          int k0, int t, int qlo, int lane, int r32, int hi) {
    constexpr int W = MODE == 0 ? 0x40000000 : 128;
    FA_LAS unsigned char* kp = bb + hi * 1024 + r32 * 16; FA_LAS unsigned char* ap = bb + AOFF + r32 * 16;
    FA_LAS unsigned char* vp = vprev + VOFF + ((lane >> 4) & 1) * 32 + (lane & 3) * 8 + (4 * hi + ((lane & 15) >> 2)) * 64;
    bf16x8 kf0 = FA_LDK(kp), kf1 = FA_LDK(kp + 512), kf2 = FA_LDK(kp + 2048), kf3 = FA_LDK(kp + 2560), kf4, kf5, kf6, kf7, ka0, ka1;
    s16x4 vl0, vh0, vl1, vh1, vl2, vh2, vl3, vh3, vl4, vh4, vl5, vh5, vl6, vh6, vl7, vh7;
    u32x4 pw0, pw1, pw2, pw3; float sacc;
    const f32x16 Z = {0.f, 0.f, 0.f, 0.f, 0.f, 0.f, 0.f, 0.f, 0.f, 0.f, 0.f, 0.f, 0.f, 0.f, 0.f, 0.f};
    FA_SBAR();
    C0 = FA_MFMA(kf0, w.qr[0], Z); kf4 = FA_LDK(kp + 4096);
    sacc = (P0[0] + P0[1]) + (P0[2] + P0[3]); pw0.x = cvtpk(P0[0], P0[1]); pw0.y = cvtpk(P0[2], P0[3]); FA_PIN(sacc); FA_PIN(pw0.x); FA_PIN(pw0.y);
    FA_SBAR();
    C1 = FA_MFMA(kf1, w.qr[0], Z); kf5 = FA_LDK(kp + 4608);
    sacc += P0[4]; sacc += P0[5]; sacc += P0[6]; sacc += P0[7]; pw0.z = cvtpk(P0[4], P0[5]); pw0.w = cvtpk(P0[6], P0[7]); FA_PIN(sacc); FA_PIN(pw0.z); FA_PIN(pw0.w);
    FA_SBAR();
    C0 = FA_MFMA(kf2, w.qr[1], C0); kf6 = FA_LDK(kp + 6144);
    sacc += P0[8]; sacc += P0[9]; sacc += P0[10]; sacc += P0[11]; pw1.x = cvtpk(P0[8], P0[9]); pw1.y = cvtpk(P0[10], P0[11]); FA_PIN(sacc); FA_PIN(pw1.x); FA_PIN(pw1.y);
    FA_SBAR();
    C1 = FA_MFMA(kf3, w.qr[1], C1); kf7 = FA_LDK(kp + 6656);
    sacc += P0[12]; sacc += P0[13]; sacc += P0[14]; sacc += P0[15]; pw1.z = cvtpk(P0[12], P0[13]); pw1.w = cvtpk(P0[14], P0[15]); FA_PIN(sacc); FA_PIN(pw1.z); FA_PIN(pw1.w);
    FA_SBAR();
    C0 = FA_MFMA(kf4, w.qr[2], C0); if (MODE == 0) { ka0 = FA_LDK(ap); ka1 = FA_LDK(ap + 512); } else { const u32x4 kc = {0u, 0x3F800000u, 0x3F803F80u, 0u}; ka0 = __builtin_bit_cast(bf16x8, kc); ka1 = ka0; }
    sacc += P1[0]; sacc += P1[1]; sacc += P1[2]; sacc += P1[3]; pw2.x = cvtpk(P1[0], P1[1]); pw2.y = cvtpk(P1[2], P1[3]); FA_PIN(sacc); FA_PIN(pw2.x); FA_PIN(pw2.y);
    FA_SBAR();
    C1 = FA_MFMA(kf5, w.qr[2], C1); vl0 = vtr(vp); vh0 = vtr(vp + 512);
    sacc += P1[4]; sacc += P1[5]; sacc += P1[6]; sacc += P1[7]; pw2.z = cvtpk(P1[4], P1[5]); pw2.w = cvtpk(P1[6], P1[7]); FA_PIN(sacc); FA_PIN(pw2.z); FA_PIN(pw2.w);
    FA_SBAR();
    C0 = FA_MFMA(kf6, w.qr[3], C0); vl4 = vtr(vp + 4096); vh4 = vtr(vp + 4096 + 512);
    sacc += P1[8]; sacc += P1[9]; sacc += P1[10]; sacc += P1[11]; pw3.x = cvtpk(P1[8], P1[9]); pw3.y = cvtpk(P1[10], P1[11]); FA_PIN(sacc); FA_PIN(pw3.x); FA_PIN(pw3.y);
    FA_SBAR();
    C1 = FA_MFMA(kf7, w.qr[3], C1); vl1 = vtr(vp + 1024); vh1 = vtr(vp + 1024 + 512);
    sacc += P1[12]; sacc += P1[13]; sacc += P1[14]; sacc += P1[15]; pw3.z = cvtpk(P1[12], P1[13]); pw3.w = cvtpk(P1[14], P1[15]); FA_PIN(sacc); FA_PIN(pw3.z); FA_PIN(pw3.w);
    FA_SBAR();
    C0 = FA_MFMA(ka0, w.qa, C0); vl5 = vtr(vp + 4096 + 1024); vh5 = vtr(vp + 4096 + 1024 + 512); FA_SBAR();
    C1 = FA_MFMA(ka1, w.qa, C1); FA_SBAR();
    w.lsum += sacc;
    const bf16x8 pa0 = __builtin_bit_cast(bf16x8, pw0), pa1 = __builtin_bit_cast(bf16x8, pw1), pa2 = __builtin_bit_cast(bf16x8, pw2), pa3 = __builtin_bit_cast(bf16x8, pw3);
    vl2 = vtr(vp + 2048); vh2 = vtr(vp + 2048 + 512);
    w.o0 = FA_MFMA(pa0, FA_VF(vl0, vh0), w.o0); vl6 = vtr(vp + 4096 + 2048); vh6 = vtr(vp + 4096 + 2048 + 512);
    w.o1 = FA_MFMA(pa0, FA_VF(vl4, vh4), w.o1);
    FA_SBAR();
    if ((k0 + 63 > qlo) || (MODE == 1 && k0 <= qlo + 31 - W)) {
        const float NEG = -__builtin_inff(); const int dq = t - k0 - 4 * hi;
#pragma unroll
        for (int r = 0; r < 16; ++r) { const int c = (r & 3) + 8 * (r >> 2); if ((unsigned)(dq - c) >= (unsigned)W) C0[r] = NEG; if ((unsigned)(dq - c - 32) >= (unsigned)W) C1[r] = NEG; }
    }
    float ma = FA_MX3(C0[0], C0[1], C1[0]), mb = FA_MX3(C0[2], C0[3], C1[1]); ma = FA_MX3(ma, C1[2], C1[3]);
#pragma unroll
    for (int r = 4; r < 16; r += 4) { ma = FA_MX3(ma, C0[r], C0[r + 1]); mb = FA_MX3(mb, C0[r + 2], C0[r + 3]); ma = FA_MX3(ma, C1[r], C1[r + 1]); mb = FA_MX3(mb, C1[r + 2], C1[r + 3]); }
    const float rm = swap_max(__builtin_fmaxf(ma, mb));
    if (MODE == 0) w.mrun = __builtin_fmaxf(w.mrun, rm + w.mhat);
    const bool resc = __any(rm > THR);
    if (resc) {
        const float dl = __builtin_fmaxf(rm, 0.f); w.mhat += dl;
#pragma unroll
        for (int r = 0; r < 16; ++r) { C0[r] -= dl; C1[r] -= dl; }
        set_qa(w, hi);
        const float f = __builtin_amdgcn_exp2f(-dl); w.lsum *= f;
        if (hi == 0) wsf[r32] = f;
    }
    FA_SBAR();
    FA_EX4(C0, 0); FA_PIN(C0); vl3 = vtr(vp + 3072); vh3 = vtr(vp + 3072 + 512);
    w.o0 = FA_MFMA(pa1, FA_VF(vl1, vh1), w.o0); FA_EX4(C0, 4); FA_EX4(C0, 8); FA_PIN(C0); vl7 = vtr(vp + 4096 + 3072); vh7 = vtr(vp + 4096 + 3072 + 512); FA_SBAR();
    w.o1 = FA_MFMA(pa1, FA_VF(vl5, vh5), w.o1); FA_EX4(C0, 12); FA_PIN(C0); FA_EX4(C1, 0); FA_PIN(C1); FA_SBAR();
    w.o0 = FA_MFMA(pa2, FA_VF(vl2, vh2), w.o0); FA_EX4(C1, 4); FA_PIN(C1); FA_SBAR();
    w.o1 = FA_MFMA(pa2, FA_VF(vl6, vh6), w.o1); FA_EX4(C1, 8); FA_PIN(C1); FA_SBAR();
    w.o0 = FA_MFMA(pa3, FA_VF(vl3, vh3), w.o0); FA_EX4(C1, 12); FA_PIN(C1); FA_SBAR();
    w.o1 = FA_MFMA(pa3, FA_VF(vl7, vh7), w.o1); FA_SBAR();
    if (resc) {
        asm volatile("s_waitcnt lgkmcnt(0)" ::: "memory");
#pragma unroll
        for (int g = 0; g < 4; ++g) { const f32x4 a4 = *(FA_LAS f32x4*)(wsf + 8 * g + 4 * hi);
#pragma unroll
            for (int i = 0; i < 4; ++i) { w.o0[4 * g + i] *= a4[i]; w.o1[4 * g + i] *= a4[i]; } }
    }
}
template <int VOFF>
__device__ __forceinline__ void drain_full(FA_LAS unsigned char* vlast, WaveSt& w, f32x16& P0, f32x16& P1, int lane, int hi) {
    FA_LAS unsigned char* vp = vlast + VOFF + ((lane >> 4) & 1) * 32 + (lane & 3) * 8 + (4 * hi + ((lane & 15) >> 2)) * 64;
    float s0 = 0.f, s1 = 0.f;
#pragma unroll
    for (int r = 0; r < 16; ++r) { s0 += P0[r]; s1 += P1[r]; }
    w.lsum += s0 + s1;
    const u32x4 w0 = {cvtpk(P0[0], P0[1]), cvtpk(P0[2], P0[3]), cvtpk(P0[4], P0[5]), cvtpk(P0[6], P0[7])};
    const u32x4 w1 = {cvtpk(P0[8], P0[9]), cvtpk(P0[10], P0[11]), cvtpk(P0[12], P0[13]), cvtpk(P0[14], P0[15])};
    const u32x4 w2 = {cvtpk(P1[0], P1[1]), cvtpk(P1[2], P1[3]), cvtpk(P1[4], P1[5]), cvtpk(P1[6], P1[7])};
    const u32x4 w3 = {cvtpk(P1[8], P1[9]), cvtpk(P1[10], P1[11]), cvtpk(P1[12], P1[13]), cvtpk(P1[14], P1[15])};
    const bf16x8 pa0 = __builtin_bit_cast(bf16x8, w0), pa1 = __builtin_bit_cast(bf16x8, w1), pa2 = __builtin_bit_cast(bf16x8, w2), pa3 = __builtin_bit_cast(bf16x8, w3);
#define FA_PV(ks, pa) do { const s16x4 l0_ = vtr(vp + (ks) * 1024), h0_ = vtr(vp + (ks) * 1024 + 512), l1_ = vtr(vp + 4096 + (ks) * 1024), h1_ = vtr(vp + 4096 + (ks) * 1024 + 512); \
    w.o0 = FA_MFMA(pa, FA_VF(l0_, h0_), w.o0); w.o1 = FA_MFMA(pa, FA_VF(l1_, h1_), w.o1); } while (0)
    FA_PV(0, pa0); FA_PV(1, pa1); FA_PV(2, pa2); FA_PV(3, pa3);
#undef FA_PV
}
__device__ __forceinline__ void load_gate(u32x4 (&gq)[4], const bf16_t* G, size_t grow, int h, int lane) {
#pragma unroll
    for (int d0 = 0; d0 < 2; ++d0)
#pragma unroll
        for (int i = 0; i < 2; ++i) gq[2 * d0 + i] = *(const u32x4*)(G + hm_off((int)grow + i * 16 + (lane >> 2), h * 64 + d0 * 32 + (lane & 3) * 8, NH));
}
__device__ __forceinline__ void wave_epilogue(FA_LAS float* stg, FA_LAS float* wsf, WaveSt& w, const u32x4 (&gq)[4], bf16_t* O, size_t grow, int h, int lane, int r32, int hi) {
    const float l = swap_add(w.lsum);
    if (hi == 0) wsf[r32] = l;
    asm volatile("s_waitcnt lgkmcnt(0)" ::: "memory");
    float rl[16];
#pragma unroll
    for (int g = 0; g < 4; ++g) { const f32x4 l4 = *(FA_LAS f32x4*)(wsf + 8 * g + 4 * hi);
#pragma unroll
        for (int i = 0; i < 4; ++i) rl[4 * g + i] = 1.0f / l4[i]; }
#pragma unroll
    for (int d0 = 0; d0 < 2; ++d0) {
#pragma unroll
        for (int g = 0; g < 4; ++g)
#pragma unroll
            for (int i = 0; i < 4; ++i) stg[(8 * g + 4 * hi + i) * 32 + r32] = (d0 == 0 ? w.o0[4 * g + i] : w.o1[4 * g + i]) * rl[4 * g + i];
        asm volatile("s_waitcnt lgkmcnt(0)" ::: "memory");
#pragma unroll
        for (int i = 0; i < 2; ++i) { const int row = i * 16 + (lane >> 2), ch = lane & 3;
            const f32x4 x0 = *(FA_LAS f32x4*)(stg + row * 32 + ch * 8), x1 = *(FA_LAS f32x4*)(stg + row * 32 + ch * 8 + 4);
            const size_t ga = (grow + row) * DM + h * 64 + d0 * 32 + ch * 8; const u32x4 gv = gq[2 * d0 + i];
            u32x4 ov;
            ov.x = cvtpk(x0[0] * __uint_as_float(gv.x << 16), x0[1] * __uint_as_float(gv.x & 0xffff0000u)); ov.y = cvtpk(x0[2] * __uint_as_float(gv.y << 16), x0[3] * __uint_as_float(gv.y & 0xffff0000u));
            ov.z = cvtpk(x1[0] * __uint_as_float(gv.z << 16), x1[1] * __uint_as_float(gv.z & 0xffff0000u)); ov.w = cvtpk(x1[2] * __uint_as_float(gv.w << 16), x1[3] * __uint_as_float(gv.w & 0xffff0000u));
            *(u32x4*)(O + tiled_off((int)(grow + row), h * 64 + d0 * 32 + ch * 8)) = ov; }
        asm volatile("s_waitcnt lgkmcnt(0)" ::: "memory");
    }
}
template <int MODE> __device__ __forceinline__ void wave_init(WaveSt& w, int hi) {
#pragma unroll
    for (int r = 0; r < 16; ++r) { w.o0[r] = 0.f; w.o1[r] = 0.f; }
    set_qa(w, hi);
}

__device__ __forceinline__ void fox_unit(FA_LAS unsigned char* lds, const Params& P, int b, int h, int qb) {
    const int tid = threadIdx.x, lane = tid & 63, r32 = lane & 31, hi = lane >> 5;
    const int wid = __builtin_amdgcn_readfirstlane(tid >> 6);
    const int q0 = qb * 256, qlo = q0 + wid * 32, t = qlo + r32;
    const size_t rowbase = (size_t)b * SEQ;
    const bf16_t* ksrc = P.K + hm_off((int)rowbase + lane, h * 64 + wid * 8, NH);
    const bf16_t* vsrc = P.V + hm_off((int)rowbase + 16 * (wid & 3) + (lane >> 2), h * 64 + (wid >> 2) * 32 + (lane & 3) * 8, NH);
    const float* cum = P.CUM + (size_t)(b * NH + h) * SEQ;
    const bf16_t* asrc = P.KAUG + ((size_t)(b * NH + h) * SEQ + lane) * 8;
    const int NT = (q0 + 256) / 64;
    WaveSt w; float qn = 0.f;
#pragma unroll
    for (int d0 = 0; d0 < 4; ++d0) { w.qr[d0] = *(const bf16x8*)(P.Q + hm_off((int)rowbase + t, h * 64 + d0 * 16 + hi * 8, NH));
#pragma unroll
        for (int j = 0; j < 8; ++j) { const float qv = bf2f((bf16_t)w.qr[d0][j]); qn = fmaf(qv, qv, qn); } }
    w.cq = cum[t]; w.mhat = 0.f; w.lsum = 0.f; w.mrun = -1e30f;
    wave_init<0>(w, hi);
    u32x4 gq[4]; load_gate(gq, P.G, rowbase + qlo, h, lane);
    const float qkb = sqrtf(swap_add(qn) * (__uint_as_float(P.KMAX[(b * NH + h) * 2]) + __uint_as_float(P.KMAX[(b * NH + h) * 2 + 1]))) * 1.01f + 1e-3f;
    FA_LAS float* wsf = (FA_LAS float*)(lds + F_WSF) + wid * 64;
    FA_LAS unsigned* votes = (FA_LAS unsigned*)(lds + F_FLAG);
    float cnew = 0.f;
#define FA_LOADT(j, bf) do { const size_t ko_ = (size_t)(j) * 64 * 32; FA_LAS unsigned char* bb_ = lds + (bf) * F_KBUF; \
        glds16(ksrc + ko_, (unsigned)__builtin_amdgcn_readfirstlane((int)(unsigned)(uintptr_t)(bb_ + wid * 1024))); \
        glds16(vsrc + ko_, (unsigned)__builtin_amdgcn_readfirstlane((int)(unsigned)(uintptr_t)(bb_ + F_VOFF + (wid >> 2) * 4096 + (wid & 3) * 1024))); \
        if (wid == 0) glds16(asrc + (size_t)(j) * 64 * 8, (unsigned)__builtin_amdgcn_readfirstlane((int)(unsigned)(uintptr_t)(bb_ + F_AOFF))); \
        cnew = cum[(j) * 64 + 63]; } while (0)
    FA_LOADT(NT - 1, 0); asm volatile("s_waitcnt vmcnt(0)" ::: "memory"); __syncthreads();
    bool wdone = false; int n = 0; f32x16 pA0, pA1, pB0, pB1;
#pragma unroll
    for (int r = 0; r < 16; ++r) { pA0[r] = 0.f; pA1[r] = 0.f; pB0[r] = 0.f; pB1[r] = 0.f; }
    int cur = 0; bool fin = false;
#define FA_WALK(tt, CA0, CA1, PA0, PA1) do { \
        const int j = NT - 1 - (tt), k0 = j * 64; const int nxt = cur == 2 ? 0 : cur + 1, prv = cur == 0 ? 2 : cur - 1; \
        if (j > 0) FA_LOADT(j - 1, nxt); \
        if (!wdone && k0 <= qlo + 31) { FA_LAS unsigned char* bb = lds + cur * F_KBUF; \
            tile_full<0, F_AOFF, F_VOFF>(bb, n > 0 ? lds + prv * F_KBUF : bb, wsf, w, CA0, CA1, PA0, PA1, k0, t, qlo, lane, r32, hi); ++n; } \
        if (j > 0) { \
            if (!wdone && n > 0 && __all(qkb + w.cq - cnew - w.mrun <= -TH_SKIP)) { wdone = true; drain_full<F_VOFF>(lds + cur * F_KBUF, w, CA0, CA1, lane, hi); } \
            if (lane == 0) votes[((tt) & 1) * 8 + wid] = wdone ? 1u : 0u; } \
        asm volatile("s_waitcnt vmcnt(0)" ::: "memory"); \
        __syncthreads(); \
        if (j > 0) { const u32x4 v0 = *(FA_LAS u32x4*)(votes + ((tt) & 1) * 8), v1 = *(FA_LAS u32x4*)(votes + ((tt) & 1) * 8 + 4); \
            if ((v0.x & v0.y & v0.z & v0.w & v1.x & v1.y & v1.z & v1.w) != 0u) fin = true; } \
        else { if (!wdone && n > 0) drain_full<F_VOFF>(lds + cur * F_KBUF, w, CA0, CA1, lane, hi); fin = true; } \
        cur = nxt; } while (0)
    for (int tt = 0; !fin; tt += 2) {
        FA_WALK(tt, pA0, pA1, pB0, pB1);
        if (fin) break;
        FA_WALK(tt + 1, pB0, pB1, pA0, pA1);
    }
#undef FA_WALK
#undef FA_LOADT
    wave_epilogue((FA_LAS float*)(lds + F_OST + wid * 4096), wsf, w, gq, P.O, rowbase + qlo, h, lane, r32, hi);
    __syncthreads();
}
__device__ __forceinline__ void swa_unit(FA_LAS unsigned char* lds, const Params& P, int b, int kvh, int qb, int hh_lo = 0, int hh_hi = 8) {
    const int tid = threadIdx.x, lane = tid & 63, r32 = lane & 31, hi = lane >> 5;
    const int wid = __builtin_amdgcn_readfirstlane(tid >> 6);
    const int q0 = qb * 256, qlo = q0 + wid * 32, t = qlo + r32;
    const size_t rowbase = (size_t)b * SEQ;
    const int j_lo = q0 >= 128 ? (q0 - 128) / 64 : 0, NT = (q0 + 256) / 64 - j_lo;
    const bf16_t* ksrc = P.K + hm_off((int)rowbase + j_lo * 64 + lane, kvh * 64 + wid * 8, 4);
    const bf16_t* vsrc = P.V + hm_off((int)rowbase + j_lo * 64 + 16 * (wid & 3) + (lane >> 2), kvh * 64 + (wid >> 2) * 32 + (lane & 3) * 8, 4);
    for (int i = 0; i < NT; ++i) {
        glds16(ksrc + (size_t)i * 64 * 32, (unsigned)__builtin_amdgcn_readfirstlane((int)(unsigned)(uintptr_t)(lds + i * S_KBUF + wid * 1024)));
        glds16(vsrc + (size_t)i * 64 * 32, (unsigned)__builtin_amdgcn_readfirstlane((int)(unsigned)(uintptr_t)(lds + i * S_KBUF + S_VOFF + (wid >> 2) * 4096 + (wid & 3) * 1024))); }
    asm volatile("s_waitcnt vmcnt(0)" ::: "memory");
    __syncthreads();
    FA_LAS float* wsf = (FA_LAS float*)(lds + S_WSF) + wid * 64;
    const int ta = (qlo >= 127 ? (qlo - 127) / 64 : 0) - j_lo, tb = (qlo + 31) / 64 - j_lo;
    for (int hh = hh_lo; hh < hh_hi; ++hh) {
        const int h = kvh * 8 + hh;
        WaveSt w;
#pragma unroll
        for (int d0 = 0; d0 < 4; ++d0) w.qr[d0] = *(const bf16x8*)(P.Q + hm_off((int)rowbase + t, h * 64 + d0 * 16 + hi * 8, NH));
        u32x4 gq[4]; load_gate(gq, P.G, rowbase + qlo, h, lane);
        w.cq = 0.f; w.mhat = P.sinks[h] * LOG2E; w.lsum = 0.5f; w.mrun = 0.f;
        wave_init<1>(w, hi);
        f32x16 pA0, pA1, pB0, pB1;
#pragma unroll
        for (int r = 0; r < 16; ++r) { pB0[r] = 0.f; pB1[r] = 0.f; }
        for (int ti = tb;;) {
            { FA_LAS unsigned char* bb = lds + ti * S_KBUF;
              tile_full<1, 0, S_VOFF>(bb, ti == tb ? bb : bb + S_KBUF, wsf, w, pA0, pA1, pB0, pB1, (j_lo + ti) * 64, t, qlo, lane, r32, hi); }
            if (ti == ta) { drain_full<S_VOFF>(lds + ta * S_KBUF, w, pA0, pA1, lane, hi); break; }
            --ti;
            { FA_LAS unsigned char* bb = lds + ti * S_KBUF;
              tile_full<1, 0, S_VOFF>(bb, bb + S_KBUF, wsf, w, pB0, pB1, pA0, pA1, (j_lo + ti) * 64, t, qlo, lane, r32, hi); }
            if (ti == ta) { drain_full<S_VOFF>(lds + ta * S_KBUF, w, pB0, pB1, lane, hi); break; }
            --ti;
        }
        wave_epilogue((FA_LAS float*)(lds + S_OST + wid * 4096), wsf, w, gq, P.O, rowbase + qlo, h, lane, r32, hi);
    }
    __syncthreads();
}
}
#define GAS __attribute__((address_space(1)))
#define LAS __attribute__((address_space(3)))
typedef unsigned short bf16;
typedef unsigned v4u __attribute__((ext_vector_type(4)));
typedef float f32x4 __attribute__((ext_vector_type(4)));
typedef short bf16x8 __attribute__((ext_vector_type(8)));
typedef GAS unsigned gu32;
typedef GAS unsigned long long gu64;
#define RLX_AGENT __ATOMIC_RELAXED, __HIP_MEMORY_SCOPE_AGENT
#define LDS_WAIT() asm volatile("s_waitcnt lgkmcnt(0)" ::: "memory")
#define VM_WAIT() asm volatile("s_waitcnt vmcnt(0)" ::: "memory")
__device__ __forceinline__ unsigned long long rt() { return __builtin_amdgcn_s_memrealtime(); }
__device__ __forceinline__ unsigned pk2(float lo, float hi) { return (unsigned)f2bf(lo) | ((unsigned)f2bf(hi) << 16); }
#define XB_TMO      128
#define XB_XCNT(j)  (256  + 64 * (j))
#define XB_XSUB(j)  (1280 + 64 * (j))
#define XB_XGEN(j)  (2304 + 64 * (j))
#define XB_TOP      3328
#define XB_TOPGEN   3392
#define XCD_BAR_WORDS 3456
#define XB_SPIN_CAP (1u << 18)

__device__ __forceinline__ unsigned xb_ld(unsigned* p)              { return __hip_atomic_load(p, __ATOMIC_RELAXED, __HIP_MEMORY_SCOPE_AGENT); }
__device__ __forceinline__ unsigned xb_add(unsigned* p, unsigned v) { return __hip_atomic_fetch_add(p, v, __ATOMIC_RELAXED, __HIP_MEMORY_SCOPE_AGENT); }
__device__ __forceinline__ unsigned xb_xcc_id() { return (unsigned)__builtin_amdgcn_s_getreg((3 << 11) | 20) & 0xFu; }
#define XB_SPIN(cond, bar) do { unsigned _sp = 0; while (cond) { __builtin_amdgcn_s_sleep(1); \
    if ((++_sp & 255u) == 0u) { if (xb_ld(&(bar)[XB_TMO])) break; if (_sp > XB_SPIN_CAP) { atomicAdd(&(bar)[XB_TMO], 1u); break; } } } } while (0)

struct XcdBarrier {
    unsigned* bar; unsigned x;
    volatile LAS unsigned* st;
};

__device__ __forceinline__ XcdBarrier xcd_barrier_post(unsigned* bar, volatile LAS unsigned* st) {
    XcdBarrier b; b.bar = bar; b.x = xb_xcc_id(); b.st = st;
    if (threadIdx.x == 0) (void)xb_add(&bar[XB_XCNT(b.x)], 1u);
    return b;
}
__device__ __forceinline__ void xcd_barrier_complete(unsigned* bar, unsigned x, unsigned& nloc, unsigned& nx) {
    const unsigned G = gridDim.x * gridDim.y * gridDim.z;
    unsigned sum, cnt, mine, sp = 0u;
    for (;;) {
        sum = 0u; cnt = 0u; mine = 0u;
#pragma unroll
        for (unsigned j = 0; j < 16; ++j) { const unsigned c = xb_ld(&bar[XB_XCNT(j)]); sum += c; cnt += (c > 0u) ? 1u : 0u; mine = (j == x) ? c : mine; }
        if (sum == G) break;
        __builtin_amdgcn_s_sleep(1);
        if ((++sp & 255u) == 0u) { if (xb_ld(&bar[XB_TMO])) break; if (sp > XB_SPIN_CAP) { atomicAdd(&bar[XB_TMO], 1u); break; } }
    }
    nloc = mine > 0u ? mine : 1u; nx = cnt > 0u ? cnt : 1u;
}

__device__ __forceinline__ void xcd_barrier(const XcdBarrier& b) {
    asm volatile("s_waitcnt vmcnt(0)" ::: "memory");
    __syncthreads();
    if (threadIdx.x == 0) {
        unsigned* bar = b.bar;
        __builtin_amdgcn_s_waitcnt(0);
        unsigned nloc = b.st[0], nx = b.st[1];
        if (nloc == 0u) { xcd_barrier_complete(bar, b.x, nloc, nx); b.st[0] = nloc; b.st[1] = nx; }
        const unsigned old = xb_add(&bar[XB_XSUB(b.x)], 1u);
        const unsigned gen = old / nloc;
        if (old + 1u == (gen + 1u) * nloc) {
            __builtin_amdgcn_fence(__ATOMIC_RELEASE, "agent");
            asm volatile("s_waitcnt vmcnt(0)" ::: "memory");
            const unsigned og = xb_add(&bar[XB_TOP], 1u);
            const unsigned tg = og / nx;
            if (og + 1u == (tg + 1u) * nx) xb_add(&bar[XB_TOPGEN], 1u);
            else XB_SPIN(xb_ld(&bar[XB_TOPGEN]) == tg, bar);
            __builtin_amdgcn_fence(__ATOMIC_ACQUIRE, "agent");
            xb_add(&bar[XB_XGEN(b.x)], 1u);
            asm volatile("s_waitcnt vmcnt(0)" ::: "memory");
        } else {
            XB_SPIN(xb_ld(&bar[XB_XGEN(b.x)]) == gen, bar);
            __builtin_amdgcn_fence(__ATOMIC_ACQUIRE, "agent");
            asm volatile("s_waitcnt vmcnt(0)" ::: "memory");
        }
    }
    __syncthreads();
}
constexpr int NWAVES = 8;
constexpr int N1P = 8448;
constexpr int RING_OFF = 0, RING_BYTES = 135168;
constexpr int LDSCTL_OFF = RING_BYTES, MISC_OFF = LDSCTL_OFF + 320;
constexpr int LDS_BYTES = 147456;
constexpr int CW_BAR = 4096;
static_assert(fa::F_LDS_BYTES <= RING_BYTES && fa::S_LDS_BYTES <= RING_BYTES && pg8::STAGE_BYTES <= RING_BYTES && MISC_OFF + 128 <= LDS_BYTES && (CW_BAR + XCD_BAR_WORDS) * 4 <= (int)WS_KMAX, "LDS / CTL map");

__device__ __forceinline__ void p0_transpose_item(const float* W, int K, int N, bf16* WT, LAS float* scr, int item, int lane, const float* gs) {
    const int nblk = N / 32, kb = item / nblk, nb = item % nblk, k0 = 64 * kb, n0 = 32 * nb;
    const int kr = lane >> 3, nc = 4 * (lane & 7);
    f32x4 wv[8];
#pragma unroll
    for (int i = 0; i < 8; ++i) wv[i] = __builtin_nontemporal_load((const GAS f32x4*)(W + (size_t)(k0 + 8 * i + kr) * N + n0 + nc));
#pragma unroll
    for (int i = 0; i < 8; ++i) { const int kk = 8 * i + kr; f32x4 w = wv[i]; if (gs) w = w * gs[k0 + kk]; LAS float* d = scr + kk * 33 + nc; d[0] = w.x; d[1] = w.y; d[2] = w.z; d[3] = w.w; }
    LDS_WAIT(); asm volatile("" ::: "memory");
    const int c = lane & 7;
#pragma unroll
    for (int j = 0; j < 4; ++j) { const int n = (lane >> 3) + 8 * j; const LAS float* sp = scr + (8 * c) * 33 + n;
        v4u o; o.x = pk2(sp[0 * 33], sp[1 * 33]); o.y = pk2(sp[2 * 33], sp[3 * 33]); o.z = pk2(sp[4 * 33], sp[5 * 33]); o.w = pk2(sp[6 * 33], sp[7 * 33]);
        *(GAS v4u*)(WT + tiled_off(n0 + n, k0 + 8 * c)) = o; }
    LDS_WAIT(); asm volatile("" ::: "memory");
}
__device__ __forceinline__ float wave_sum(float v) {
#pragma unroll
    for (int o = 1; o < 64; o <<= 1) v += __shfl_xor(v, o);
    return v;
}

struct Args { const float* in[9]; float* out; unsigned char* ws; int ph_lo, ph_hi; };
constexpr int N_PHASES = 9;
__global__ void __launch_bounds__(NWAVES * 64, 2) mega_fwd(Args args) {
    extern __shared__ __attribute__((aligned(16))) unsigned char lds_raw[];
    LAS unsigned char* lds = (LAS unsigned char*)lds_raw;
    volatile LAS unsigned* MISC = (volatile LAS unsigned*)(lds + MISC_OFF);
    const int tid = threadIdx.x, lane = tid & 63, wave = __builtin_amdgcn_readfirstlane(tid >> 6);
    const int G = gridDim.x, bx = blockIdx.x, vcu = (G % 8 == 0) ? (bx % 8) * (G / 8) + bx / 8 : bx;
    unsigned char* ws = args.ws;
    const float* x = args.in[0]; const float* norm_g = args.in[1]; const float* fox_w_in = args.in[2]; const float* fox_b_f = args.in[3]; const float* fox_w_out = args.in[4];
    const float* swa_w_in = args.in[5]; const float* swa_sinks = args.in[6]; const float* swa_w_out = args.in[7]; const float* final_g = args.in[8];
    float* out = args.out;
    gu32* ctl = (gu32*)(ws + WS_CTL);
    unsigned* KMAX = (unsigned*)(ws + WS_KMAX); unsigned* TICKET = (unsigned*)(ws + WS_TICKET);
    float* SS1 = (float*)(ws + WS_SS1); float* R0 = (float*)(ws + WS_R0); float* ROPE = (float*)(ws + WS_ROPE); float* LOGF = (float*)(ws + WS_LOGF); float* CUM = (float*)(ws + WS_CUM);
    bf16* W1T = (bf16*)(ws + WS_W1T); bf16* W2T = (bf16*)(ws + WS_W2T); bf16* W3T = (bf16*)(ws + WS_W3T); bf16* W4T = (bf16*)(ws + WS_W4T);
    bf16* KAUG = (bf16*)(ws + WS_KAUG);
    bf16* XB = (bf16*)(ws + WS_XB); bf16* Qb = (bf16*)(ws + WS_Q); bf16* Kb = (bf16*)(ws + WS_K); bf16* Vb = (bf16*)(ws + WS_V); bf16* Gb = (bf16*)(ws + WS_G); bf16* YG = (bf16*)(ws + WS_YG);
    for (int u = tid; u < (LDS_BYTES - LDSCTL_OFF) / 4; u += NWAVES * 64) ((LAS unsigned*)(lds + LDSCTL_OFF))[u] = 0u;
    __syncthreads();
    const int lo = args.ph_lo, hi = args.ph_hi;
    XcdBarrier bar; bar.bar = (unsigned*)(ctl + CW_BAR); bar.x = 0; bar.st = nullptr;
    if (hi - lo > 1) bar = xcd_barrier_post((unsigned*)(ctl + CW_BAR), MISC + 8);
#define IN(k) (lo <= (k) && (k) < hi)
#define REP(k) for (int rep_ = 0; rep_ < (((DUP_MASK >> (k)) & 1) ? 2 : 1); ++rep_)
#define SEAM(k) do { if (IN(k) && IN((k) + 1)) xcd_barrier(bar); } while (0)
    const int gw = vcu * NWAVES + wave, NGW = G * NWAVES;
#define STAGGER() do { for (int s_ = 0; s_ < ((bx >> 3) & 31); ++s_) __builtin_amdgcn_s_sleep(1); } while (0)
    const bool grp = (G == 256) && lo == 0 && hi == N_PHASES;
    const int gpm = 8 * (bx & 7) + ((bx >> 3) & 7), gj = bx >> 6;
    unsigned* GS = (unsigned*)(ws + WS_GS);
    unsigned* XT = (unsigned*)(ws + WS_XT);
    if (grp && tid == 0) __hip_atomic_store(XT + bx, xb_xcc_id() + 1u, __ATOMIC_RELAXED, __HIP_MEMORY_SCOPE_AGENT);
#define G_ARRIVE() do { asm volatile("s_waitcnt vmcnt(0)" ::: "memory"); __syncthreads(); \
        if (tid == 0) { if (MISC[12] != 0u) { __builtin_amdgcn_fence(__ATOMIC_RELEASE, "agent"); asm volatile("s_waitcnt vmcnt(0)" ::: "memory"); } (void)xb_add(GS + gpm * 16, 1u); } } while (0)
#define G_WAIT(pm_, target) do { if (tid == 0) { unsigned* w_ = GS + (pm_) * 16; XB_SPIN(xb_ld(w_) < (unsigned)(target), bar.bar); \
        __builtin_amdgcn_fence(__ATOMIC_ACQUIRE, "agent"); asm volatile("s_waitcnt vmcnt(0)" ::: "memory"); } __syncthreads(); } while (0)

    if (IN(0)) REP(0) {
        LAS float* scr = (LAS float*)(lds + RING_OFF + wave * 16384);
        constexpr int I1 = (DM / 64) * (FOX_IN / 32);
        for (int it = gw; it < I1; it += NGW) p0_transpose_item(fox_w_in, DM, FOX_IN, W1T, scr, it, lane, norm_g);
        for (int m = 2 * gw; m < MTOK; m += 2 * NGW) {
            const int m2 = m + 1;
            const GAS f32x4* xr = (const GAS f32x4*)(x + (size_t)m * DM) + lane; const GAS f32x4* xr2 = (const GAS f32x4*)(x + (size_t)m2 * DM) + lane; f32x4 v[8], v2[8]; float s = 0.f, s2 = 0.f;
#pragma unroll
            for (int j = 0; j < 8; ++j) { v[j] = __builtin_nontemporal_load(xr + 64 * j); v2[j] = __builtin_nontemporal_load(xr2 + 64 * j); }
#pragma unroll
            for (int j = 0; j < 8; ++j) { s += (v[j].x * v[j].x + v[j].y * v[j].y) + (v[j].z * v[j].z + v[j].w * v[j].w); s2 += (v2[j].x * v2[j].x + v2[j].y * v2[j].y) + (v2[j].z * v2[j].z + v2[j].w * v2[j].w); }
            s = wave_sum(s); s2 = wave_sum(s2);
            if (lane == 0) { R0[m] = 1.0f / sqrtf(s * (1.f / DM) + RMS_EPS); R0[m2] = 1.0f / sqrtf(s2 * (1.f / DM) + RMS_EPS); }
#pragma unroll
            for (int j = 0; j < 8; ++j) { *(GAS unsigned long long*)(XB + tiled_off(m, 256 * j + 4 * lane)) = (unsigned long long)pk2(v[j].x, v[j].y) | ((unsigned long long)pk2(v[j].z, v[j].w) << 32);
                                          *(GAS unsigned long long*)(XB + tiled_off(m2, 256 * j + 4 * lane)) = (unsigned long long)pk2(v2[j].x, v2[j].y) | ((unsigned long long)pk2(v2[j].z, v2[j].w) << 32); }
        }
        { const int gt = gw * 64 + lane;
          if (gt < SEQ * 8) { const int pos = gt >> 3, i = gt & 7;
              const double invf[8] = {1.0, 0.19390220519133497, 0.037598065178462524, 0.0072903477503833845, 0.0014142135623730951, 0.00027421912901204056, 5.3171693730649086e-05, 1.0310108130908796e-05};
              double inv = invf[0];
#pragma unroll
              for (int k = 1; k < 8; ++k) inv = (i == k) ? invf[k] : inv;
              const double ang = (double)pos * inv; const double kk = __builtin_rint(ang * 0.15915494309189535); const float red = (float)(ang - kk * 6.283185307179586);
              ROPE[(size_t)pos * 16 + i] = cosf(red); ROPE[(size_t)pos * 16 + 8 + i] = sinf(red); } }
    }
    SEAM(0);
    if (IN(1)) {
        pg8::Gemm g{XB, W1T, MTOK, 4 * DM, DM}; pg8::StaticOrder S; S.init(MTOK, 4 * DM, G, bx, (DUP_MASK >> 1) & 1, (DUP_MASK >> 9) & 1);
        pg8::EpiFoxIn E{Qb, Kb, Vb, Gb, LOGF, R0, fox_b_f, KMAX};
        if ((DUP_MASK >> 10) & 1) { pg8::StaticOrder SP; SP.init(MTOK, 4 * DM, G, bx, 0, 0, 1); pg8::gemm_phase<pg8::EpiFoxIn, pg8::StaticOrder, true, true>(lds + RING_OFF, g, SP, E); }
        STAGGER();
        pg8::gemm_phase<pg8::EpiFoxIn, pg8::StaticOrder, true, true>(lds + RING_OFF, g, S, E);
        for (int rb = bx * 64; rb < MTOK; rb += G * 64) {
            LAS unsigned char* bl = lds + RING_OFF;
#pragma unroll
            for (int pc = 0; pc < 16; ++pc) { const int pidx = wave + 8 * pc;
                fa::glds16(W1T + tiled_off(4 * DM, 0) + (size_t)(pidx >> 1) * 8192 + (pidx & 1) * 512 + lane * 8, (unsigned)__builtin_amdgcn_readfirstlane((int)(unsigned)(uintptr_t)(bl + pidx * 1024))); }
            const int arow = rb + 16 * (wave & 3) + (lane & 15), kg = (lane >> 4) * 8, kh = wave >> 2;
            bf16x8 af[32];
#pragma unroll
            for (int ks = 0; ks < 32; ++ks) af[ks] = *(const GAS bf16x8*)(XB + tiled_off(arow, 32 * (32 * kh + ks) + kg));
            asm volatile("s_waitcnt vmcnt(0)" ::: "memory");
            __syncthreads();
            pg8::f32x4 acc0 = {0.f, 0.f, 0.f, 0.f}, acc1 = {0.f, 0.f, 0.f, 0.f};
            const LAS unsigned char* bp = bl + (32 * kh) * 2048 + (lane & 15) * 64 + (lane >> 4) * 16;
#pragma unroll
            for (int ks = 0; ks < 32; ++ks) {
                const bf16x8 b0 = *(const LAS bf16x8*)(bp + ks * 2048), b1 = *(const LAS bf16x8*)(bp + ks * 2048 + 1024);
                acc0 = __builtin_amdgcn_mfma_f32_16x16x32_bf16(af[ks], b0, acc0, 0, 0, 0); acc1 = __builtin_amdgcn_mfma_f32_16x16x32_bf16(af[ks], b1, acc1, 0, 0, 0); }
            __syncthreads();
            LAS pg8::f32x4* xs = (LAS pg8::f32x4*)bl + ((wave & 3) * 64 + lane) * 2;
            if (kh == 1) { xs[0] = acc0; xs[1] = acc1; }
            __syncthreads();
            if (kh == 0) {
                acc0 = acc0 + xs[0]; acc1 = acc1 + xs[1];
                const int r0 = rb + 16 * (wave & 3) + 4 * (lane >> 4); const float s0 = R0[r0], s1 = R0[r0 + 1], s2 = R0[r0 + 2], s3 = R0[r0 + 3];
#pragma unroll
                for (int g2 = 0; g2 < 2; ++g2) { const int h = 16 * g2 + (lane & 15); const float bb = fox_b_f[h]; const pg8::f32x4 a = g2 ? acc1 : acc0;
                    f32x4 o; o.x = logsigmoidf(a[0] * s0 + bb); o.y = logsigmoidf(a[1] * s1 + bb); o.z = logsigmoidf(a[2] * s2 + bb); o.w = logsigmoidf(a[3] * s3 + bb);
                    *(GAS f32x4*)(LOGF + ((size_t)((r0 >> 12) * NH + h) << 12) + (r0 & 4095)) = o; }
            }
            __syncthreads();
        }
        { LAS float* scr = (LAS float*)(lds + RING_OFF + wave * 16384);
          constexpr int I2 = (DM / 64) * (DM / 32), I3 = (DM / 64) * (SWA_IN / 32);
          for (int it = gw; it < I2 + I3; it += NGW) { if (it < I2) p0_transpose_item(fox_w_out, DM, DM, W2T, scr, it, lane, nullptr); else p0_transpose_item(swa_w_in, DM, SWA_IN, W3T, scr, it - I2, lane, norm_g + DM); } }
    }
    SEAM(1);
    if (IN(2)) REP(2) {
        for (int sq = vcu; sq < NB * NH; sq += G) {
            const GAS f32x4* lf = (const GAS f32x4*)(LOGF + (size_t)sq * SEQ + wave * 512) + lane * 2; const f32x4 v0 = lf[0], v1 = lf[1];
            const double tot = (((double)v0.x + (double)v0.y) + ((double)v0.z + (double)v0.w)) + (((double)v1.x + (double)v1.y) + ((double)v1.z + (double)v1.w));
            double incl = tot;
#pragma unroll
            for (int o = 1; o < 64; o <<= 1) { const double up = __shfl_up(incl, o); if (lane >= o) incl += up; }
            volatile LAS double* wt = (volatile LAS double*)(lds + RING_OFF);
            __syncthreads();
            if (lane == 63) wt[wave] = incl;
            __syncthreads();
            double run = incl - tot;
            for (int w2 = 0; w2 < wave; ++w2) run += wt[w2];
            const float vv[8] = {v0.x, v0.y, v0.z, v0.w, v1.x, v1.y, v1.z, v1.w}; float cv[8];
#pragma unroll
            for (int e = 0; e < 8; ++e) { run += (double)vv[e]; cv[e] = (float)(run * 1.4426950408889634); }
            GAS f32x4* co = (GAS f32x4*)(CUM + (size_t)sq * SEQ + wave * 512) + lane * 2; co[0] = (f32x4){cv[0], cv[1], cv[2], cv[3]}; co[1] = (f32x4){cv[4], cv[5], cv[6], cv[7]};
            GAS v4u* ka = (GAS v4u*)(KAUG + ((size_t)sq * SEQ + wave * 512 + lane * 8) * 8);
#pragma unroll
            for (int e = 0; e < 8; ++e) { unsigned h1, h2, h3; fa::split3(-cv[e], h1, h2, h3); ka[e] = (v4u){h1 | (h2 << 16), h3 | 0x3F800000u, 0x3F803F80u, 0u}; }
        }
        { const int nidle = G > NB * NH ? G - NB * NH : G, ii = G > NB * NH ? vcu - NB * NH : vcu;
          if (ii >= 0) { __syncthreads(); LAS float* scr = (LAS float*)(lds + RING_OFF + wave * 16384); constexpr int I2 = (DM / 64) * (DM / 32);
              for (int it = ii * NWAVES + wave; it < I2; it += nidle * NWAVES) p0_transpose_item(swa_w_out, DM, DM, W4T, scr, it, lane, nullptr); } }
    }
    SEAM(2);
    if (IN(3)) {
        const fa::Params P{Qb, Kb, Vb, Gb, YG, CUM, nullptr, KMAX, TICKET, KAUG};
        if (grp && tid == 0) {
            const unsigned me = xb_xcc_id() + 1u; const int pn = gpm + 1, two = ((pn & 15) != 0) ? 1 : 0, pq = two ? pn : gpm;
            const unsigned r0 = xb_ld(XT + 8 * (16 + (gpm & 7)) + (gpm >> 3)), r1 = xb_ld(XT + 8 * (24 + (gpm & 7)) + (gpm >> 3));
            const unsigned r2 = xb_ld(XT + 8 * (16 + (pq & 7)) + (pq >> 3)), r3 = xb_ld(XT + 8 * (24 + (pq & 7)) + (pq >> 3));
            MISC[12] = (r0 != me || r1 != me || r2 != me || r3 != me) ? 1u : 0u; }
        volatile LAS unsigned* slot = (volatile LAS unsigned*)(lds + RING_OFF + fa::F_FLAG + 128);
#define FOX_FETCH(dst) do { unsigned code_ = 0xFFFFFFFFu; for (int k_ = 0; k_ < 8; ++k_) { const unsigned q_ = (unsigned)((bx + k_) & 7); const unsigned t_ = atomicAdd(TICKET + q_ * 64, 1u); \
            if (t_ < 256u) { code_ = q_ * 256u + t_; break; } } (dst) = code_; } while (0)
        if (tid == 0) FOX_FETCH(slot[0]);
        __syncthreads();
        unsigned tk = slot[0]; int par = 0;
        while (tk != 0xFFFFFFFFu) {
            if (tid == 0) FOX_FETCH(slot[par ^ 1]);
            const int q = (int)(tk >> 8), tq = (int)(tk & 255u), pi = tq >> 4, hs = 3 - (pi >> 2);
            const int h = hs == 0 ? q : hs == 1 ? 15 - q : hs == 2 ? 16 + q : 31 - q;
            fa::fox_unit(lds + RING_OFF, P, pi & 3, h, 15 - (tq & 15));
            par ^= 1; tk = slot[par];
        }
#undef FOX_FETCH
        __syncthreads();
    }
    SEAM(3);
    if (IN(4)) {
        pg8::Gemm g{YG, W2T, MTOK, DM, DM}; pg8::StaticOrder S; S.init(MTOK, DM, G, bx);
        pg8::EpiRes<false> E{nullptr, XB, SS1};
        STAGGER();
        pg8::gemm_phase<pg8::EpiRes<false>, pg8::StaticOrder, true, true>(lds + RING_OFF, g, S, E);
    }
    SEAM(4);
    if (IN(5)) {
        pg8::Gemm g{XB, W3T, MTOK, SWA_IN, DM}; pg8::StaticOrder S; S.init(MTOK, SWA_IN, G, bx, (DUP_MASK >> 5) & 1, 0, 0, 0, grp ? 4 : (1 << 20));
        pg8::EpiSwaIn E{Qb, Kb, Vb, Gb, SS1, ROPE};
        STAGGER();
        pg8::gemm_phase<pg8::EpiSwaIn, pg8::StaticOrder, true, true>(lds + RING_OFF, g, S, E);
        if (grp) {
            G_ARRIVE();
            if (gj < 2) { pg8::StaticOrder S4; S4.init(MTOK, SWA_IN, G, bx, 0, 0, 0, 4, 5); pg8::gemm_phase<pg8::EpiSwaIn, pg8::StaticOrder, true, true>(lds + RING_OFF, g, S4, E); }
            else { const fa::Params P{Qb, Kb, Vb, Gb, YG, nullptr, swa_sinks, nullptr, nullptr, nullptr};
                   G_WAIT(gpm, 4); if ((gpm & 15) != 0) G_WAIT(gpm - 1, 4);
                   fa::swa_unit(lds + RING_OFF, P, gpm >> 4, gj - 2, gpm & 15); }
        }
    }
    SEAM(5);
    if (IN(6)) REP(6) {
        const fa::Params P{Qb, Kb, Vb, Gb, YG, nullptr, swa_sinks, nullptr, nullptr, nullptr};
        if (grp) fa::swa_unit(lds + RING_OFF, P, gpm >> 4, 2 + (gj >> 1), gpm & 15, (gj & 1) * 4, (gj & 1) * 4 + 4);
        else for (int u = bx; u < NB * 4 * 16; u += G) fa::swa_unit(lds + RING_OFF, P, u >> 6, (u >> 4) & 3, u & 15);
    }
    SEAM(6);
    if (IN(7)) {
        pg8::Gemm g{YG, W4T, MTOK, DM, DM}; pg8::StaticOrder S; S.init(MTOK, DM, G, bx);
        pg8::EpiRes<false> E{nullptr, XB, nullptr};
        STAGGER();
        pg8::gemm_phase<pg8::EpiRes<false>, pg8::StaticOrder, true, true>(lds + RING_OFF, g, S, E);
    }
    SEAM(7);
    if (IN(8)) {
        f32x4 gq[8];
#pragma unroll
        for (int j = 0; j < 8; ++j) gq[j] = ((const GAS f32x4*)final_g)[lane + 64 * j];
        for (int m = 2 * gw; m < MTOK; m += 2 * NGW) {
            f32x4 v[8], v2[8]; float s = 0.f, s2 = 0.f; unsigned long long xw[8], xw2[8];
#pragma unroll
            for (int j = 0; j < 8; ++j) { xw[j] = *(const GAS unsigned long long*)(XB + tiled_off(m, 256 * j + 4 * lane)); xw2[j] = *(const GAS unsigned long long*)(XB + tiled_off(m + 1, 256 * j + 4 * lane)); }
#pragma unroll
            for (int j = 0; j < 8; ++j) { const unsigned lo32 = (unsigned)xw[j], hi32 = (unsigned)(xw[j] >> 32), lo2 = (unsigned)xw2[j], hi2 = (unsigned)(xw2[j] >> 32);
                v[j] = (f32x4){__uint_as_float(lo32 << 16), __uint_as_float(lo32 & 0xffff0000u), __uint_as_float(hi32 << 16), __uint_as_float(hi32 & 0xffff0000u)};
                v2[j] = (f32x4){__uint_as_float(lo2 << 16), __uint_as_float(lo2 & 0xffff0000u), __uint_as_float(hi2 << 16), __uint_as_float(hi2 & 0xffff0000u)};
                s += (v[j].x * v[j].x + v[j].y * v[j].y) + (v[j].z * v[j].z + v[j].w * v[j].w); s2 += (v2[j].x * v2[j].x + v2[j].y * v2[j].y) + (v2[j].z * v2[j].z + v2[j].w * v2[j].w); }
            const float r = 1.0f / sqrtf(wave_sum(s) * (1.f / DM) + RMS_EPS), r2 = 1.0f / sqrtf(wave_sum(s2) * (1.f / DM) + RMS_EPS);
            GAS f32x4* xr = (GAS f32x4*)(out + (size_t)m * DM) + lane; GAS f32x4* xr2 = (GAS f32x4*)(out + (size_t)(m + 1) * DM) + lane;
#pragma unroll
            for (int j = 0; j < 8; ++j) { __builtin_nontemporal_store(v[j] * r * gq[j], xr + 64 * j); __builtin_nontemporal_store(v2[j] * r2 * gq[j], xr2 + 64 * j); }
        }
    }
#undef IN
#undef SEAM
#undef G_ARRIVE
#undef G_WAIT
}

extern "C" void kernel_launch(void* const* d_in, const int* in_sizes, int n_in, void* d_out, int out_size, void* d_ws, size_t ws_size, hipStream_t stream) {
    static int grid = 0;
    if (grid == 0) {
        if (n_in != 9 || in_sizes[0] != MTOK * DM || out_size != MTOK * DM || ws_size < WS_END) { fprintf(stderr, "kernel_launch: unexpected shapes (n_in %d, in0 %d, out %d, ws %zu)\n", n_in, n_in > 0 ? in_sizes[0] : -1, out_size, ws_size); grid = -1; return; }
        int dev = 0, cus = 0, per_cu = 0;
        if (hipGetDevice(&dev) != hipSuccess || hipDeviceGetAttribute(&cus, hipDeviceAttributeMultiprocessorCount, dev) != hipSuccess) { fprintf(stderr, "kernel_launch: device query failed\n"); grid = -1; return; }
        if (hipFuncSetAttribute((const void*)mega_fwd, hipFuncAttributeMaxDynamicSharedMemorySize, LDS_BYTES) != hipSuccess) { fprintf(stderr, "kernel_launch: hipFuncSetAttribute failed\n"); grid = -1; return; }
        if (hipOccupancyMaxActiveBlocksPerMultiprocessor(&per_cu, (const void*)mega_fwd, NWAVES * 64, LDS_BYTES) != hipSuccess || per_cu < 1) { fprintf(stderr, "kernel_launch: occupancy query reports %d workgroups per CU; nothing launched\n", per_cu); (void)hipGetLastError(); grid = -1; return; }
        grid = cus;
    }
    if (grid < 0) return;
    (void)hipMemsetAsync((unsigned char*)d_ws + WS_CTL, 0, CTL_ZERO_BYTES, stream);
    Args a{};
    for (int i = 0; i < 9; ++i) a.in[i] = (const float*)d_in[i];
    a.out = (float*)d_out; a.ws = (unsigned char*)d_ws;
    int p = 0;
    while (p < N_PHASES) {
        if (!((FAST_MASK >> p) & 1)) { ++p; continue; }
        int e = p + 1; if (ONE_LAUNCH) while (e < N_PHASES && ((FAST_MASK >> e) & 1)) ++e;
        a.ph_lo = p; a.ph_hi = e;
        hipLaunchKernelGGL(mega_fwd, dim3(grid), dim3(NWAVES * 64), LDS_BYTES, stream, a);
        p = e;
    }
}
```

```cpp
#include <hip/hip_runtime.h>
#include <cstdio>
#include <cstdint>

constexpr int NB = 4, SEQ = 4096, DM = 2048, MTOK = NB * SEQ, NH = 32, HD = 64;
constexpr int FOX_IN = 8224, SWA_IN = 4608, KVW = 256;
constexpr float RMS_EPS = 1e-6f;
constexpr float LOG2E = 1.4426950408889634f;
constexpr float C2 = 0.125f * LOG2E;

typedef unsigned short bf16_t;
__device__ __forceinline__ float bf2f(bf16_t v) { return __uint_as_float((unsigned)v << 16); }
__device__ __forceinline__ bf16_t f2bf(float f) { unsigned u = __float_as_uint(f); return (bf16_t)((u + 0x7fffu + ((u >> 16) & 1u)) >> 16); }
__device__ __forceinline__ float logsigmoidf(float z) { return z < 0.f ? z - log1pf(expf(z)) : -log1pf(expf(-z)); }
__device__ __forceinline__ float siluf(float g) { return g / (1.f + expf(-g)); }

__host__ __device__ __forceinline__ size_t tiled_off(int row, int k) { return ((size_t)(((row >> 8) * (DM / 64) + (k >> 6)) * 2 + ((k >> 5) & 1)) << 13) + (size_t)(((row & 255) << 5) + (k & 31)); }

__host__ __device__ __forceinline__ size_t hm_off(int row  , int col  , int nheads) { return ((size_t)(((row >> 12) * nheads + (col >> 6)) * 2 + ((col >> 5) & 1)) * SEQ + (row & 4095)) * 32 + (col & 31); }

constexpr size_t MiB = 1u << 20;
constexpr size_t WS_CTL = 0, CTL_ZERO_BYTES = 1 * MiB;
constexpr size_t WS_KMAX = 64 * 1024, WS_TICKET = 66 * 1024;
constexpr size_t WS_GS = 128 * 1024;
constexpr size_t WS_XT = 160 * 1024;
constexpr size_t WS_SS1 = 512 * 1024;
constexpr size_t WS_R0 = 1 * MiB;
constexpr size_t WS_ROPE = 1 * MiB + 512 * 1024;
constexpr size_t WS_LOGF = 2 * MiB;
constexpr size_t WS_CUM = 4 * MiB;
constexpr size_t WS_W1T = 8 * MiB, WS_W2T = 41 * MiB, WS_W3T = 49 * MiB, WS_W4T = 67 * MiB;
constexpr size_t WS_XB = 76 * MiB, WS_Q = 140 * MiB, WS_K = 204 * MiB, WS_V = 268 * MiB, WS_G = 332 * MiB, WS_YG = 396 * MiB, WS_KAUG = 460 * MiB, WS_END = 468 * MiB;

#ifndef FAST_MASK
#define FAST_MASK 0x1FF
#endif
#ifndef DUP_MASK
#define DUP_MASK 0x000
#endif
#ifndef ONE_LAUNCH
#define ONE_LAUNCH 1
#endif
namespace pg8 {
#define PG8_LAS __attribute__((address_space(3)))
typedef unsigned short bf16_t;
typedef short bf16x8 __attribute__((ext_vector_type(8)));
typedef float f32x4 __attribute__((ext_vector_type(4)));
typedef unsigned u32x4 __attribute__((ext_vector_type(4)));
constexpr int BM = 256, BK = 64, HALF = 128, HTB = HALF * BK * 2  , STAGE_BYTES = 8 * HTB, NXCD = 8, WGM = 8;

__host__ __device__ __forceinline__ int lds_byte(int r, int c) { const int st = (r >> 4) * 2 + (c >> 5), rr = r & 15, cc = c & 31, ob = rr * 64 + cc * 2; return st * 1024 + (ob ^ (((ob >> 9) & 1) << 5)); }
__host__ __device__ __forceinline__ void stage_rc(int b, int& R, int& C) { const int st = b / 1024, sb = b % 1024, swz = sb ^ (((sb >> 9) & 1) << 5); R = (st >> 1) * 16 + swz / 64; C = (st & 1) * 32 + (swz % 64) / 2; }
__host__ __device__ __forceinline__ int perm32(int rho) { const int n = rho >> 4, i = rho & 15; return 8 * (i >> 2) + 4 * n + (i & 3); }

struct Unit { int pm, pn, lm, ln; };
struct Gemm { const bf16_t* A; const bf16_t* Bt; int M, N, K; };

struct StaticOrder {
    int nM, nN, nwg, G, c, dup, epi2, same, i0, i1;
    __host__ __device__ void init(int M, int N, int G_, int c_, int dup_ = 0, int epi2_ = 0, int same_ = 0, int i0_ = 0, int i1_ = 1 << 20) { nM = M / BM; nN = N / BM; nwg = nM * nN; G = G_; c = c_; dup = dup_; epi2 = epi2_; same = same_; i0 = i0_; i1 = i1_; }
    __host__ __device__ bool next(int i, Unit& u) const {
        if (dup) i >>= 1;
        i += i0; if (i >= i1) return false;
        const long L = (long)i * G + c; if (L >= nwg) return false;
        int wgid = (int)L; { const int q = nwg / NXCD, r = nwg % NXCD, xcd = wgid % NXCD, off = wgid / NXCD; wgid = (xcd < r ? xcd * (q + 1) : r * (q + 1) + (xcd - r) * q) + off; }
        const int nig = WGM * nN, gid = wgid / nig, fm = gid * WGM, gsz = (nM - fm) < WGM ? (nM - fm) : WGM;
        u.pm = fm + ((wgid % nig) % gsz); u.pn = (wgid % nig) / gsz;
        { const int ng = nN >> 2, cg = u.pn >> 2; if (cg < ng) u.pn = 4 * ((cg + (int)(L & 7)) % ng) + (u.pn & 3); }
        u.lm = same ? 0 : u.pm; u.ln = same ? 0 : u.pn; return true;
    }
    __device__ __forceinline__ void a_ready(const Unit&) const {}
    __device__ __forceinline__ void done(const Unit&) const {}
};

__device__ __forceinline__ unsigned cvt_pk_bf16(float lo, float hi) { unsigned r; asm volatile("v_cvt_pk_bf16_f32 %0, %1, %2" : "=v"(r) : "v"(lo), "v"(hi)); return r; }
__device__ __forceinline__ float silu_fast(float g) { return g * __builtin_amdgcn_rcpf(1.0f + __builtin_amdgcn_exp2f(-g * 1.4426950408889634f)); }
__device__ __forceinline__ u32x4 pack8(const f32x4 v0, const f32x4 v1) { u32x4 w; w.x = cvt_pk_bf16(v0[0], v0[1]); w.y = cvt_pk_bf16(v0[2], v0[3]); w.z = cvt_pk_bf16(v1[0], v1[1]); w.w = cvt_pk_bf16(v1[2], v1[3]); return w; }
struct EpiFoxIn {
    static constexpr bool PERM = true, AFTER_DRAIN = false;
    bf16_t *Q, *K, *V, *G; float* LOGF; const float* R0; const float* bfb; unsigned* KMAX;
    __device__ __forceinline__ void operator()(const f32x4 (&acc)[2][2][4][2], const Unit& u, int wr, int wc, int fr, int fq) const {
        const int row0 = u.pm * BM + wr * 64 + fr, pn = u.pn;
        float rs[2][4];
#pragma unroll
        for (int ai = 0; ai < 2; ++ai)
#pragma unroll
            for (int m = 0; m < 4; ++m) rs[ai][m] = R0[row0 + ai * HALF + m * 16];
        {
            const int reg = pn >> 3; bf16_t* base = reg == 0 ? Q : reg == 1 ? K : reg == 2 ? V : G; float kmx[2] = {0.f, 0.f};
            const int col0 = (pn & 7) * BM + wc * 32 + 8 * fq;
#pragma unroll
            for (int ai = 0; ai < 2; ++ai)
#pragma unroll
                for (int m = 0; m < 4; ++m) { const int row = row0 + ai * HALF + m * 16; const float r = rs[ai][m]; const float sc = reg == 0 ? r * C2 : r;
#pragma unroll
                    for (int bj = 0; bj < 2; ++bj) { f32x4 v0 = acc[ai][bj][m][0] * sc, v1 = acc[ai][bj][m][1] * sc;
                        if (reg == 3) {
#pragma unroll
                            for (int j = 0; j < 4; ++j) { v0[j] = silu_fast(v0[j]); v1[j] = silu_fast(v1[j]); } }
                        if (reg == 1) { float ss = ((v0[0] * v0[0] + v0[1] * v0[1]) + (v0[2] * v0[2] + v0[3] * v0[3])) + ((v1[0] * v1[0] + v1[1] * v1[1]) + (v1[2] * v1[2] + v1[3] * v1[3]));
                            ss += __shfl_xor(ss, 16); ss += __shfl_xor(ss, 32); kmx[bj] = fmaxf(kmx[bj], ss); }
                        __builtin_nontemporal_store(pack8(v0, v1), (u32x4*)(base + hm_off(row, col0 + bj * HALF, NH))); } }
            if (reg == 1) {
#pragma unroll
                for (int bj = 0; bj < 2; ++bj) { float mx = kmx[bj];
#pragma unroll
                    for (int o = 1; o < 16; o <<= 1) mx = fmaxf(mx, __shfl_xor(mx, o));
                    if (fr == 0 && fq == 0) atomicMax(KMAX + ((row0 >> 12) * NH + (pn & 7) * 4 + bj * 2 + (wc >> 1)) * 2 + (wc & 1), __float_as_uint(mx)); } }
        }
    }
};
struct EpiSwaIn {
    static constexpr bool PERM = true, AFTER_DRAIN = false;
    bf16_t *Q, *K, *V, *G; const float* SS; const float* ROPE;
    __device__ __forceinline__ void operator()(const f32x4 (&acc)[2][2][4][2], const Unit& u, int wr, int wc, int fr, int fq) const {
        const int row0 = u.pm * BM + wr * 64 + fr, pn = u.pn;
        bf16_t* base; int pitch, colt; float osc = 1.f; const bool rope = pn <= 8, gate = pn >= 10;
        if (pn < 8) { base = Q; pitch = DM; colt = pn * BM; osc = C2; } else if (pn == 8) { base = K; pitch = KVW; colt = 0; } else if (pn == 9) { base = V; pitch = KVW; colt = 0; } else { base = G; pitch = DM; colt = (pn - 10) * BM; }
        const int col0 = colt + wc * 32 + 8 * fq; const bool rotw = rope && ((wc & 1) == 0); const float sgn = fq == 0 ? -1.f : 1.f; const bool rotl = fq < 2;
        float rs[2][4];
#pragma unroll
        for (int ai = 0; ai < 2; ++ai)
#pragma unroll
            for (int m = 0; m < 4; ++m) rs[ai][m] = SS[row0 + ai * HALF + m * 16];
        f32x4 nc0, nc1, ns0, ns1;
        if (rotw) { const float* rp = ROPE + (size_t)(row0 & 4095) * 16; nc0 = *(const f32x4*)rp; nc1 = *(const f32x4*)(rp + 4); ns0 = *(const f32x4*)(rp + 8); ns1 = *(const f32x4*)(rp + 12); }
#pragma unroll
        for (int ai = 0; ai < 2; ++ai)
#pragma unroll
            for (int m = 0; m < 4; ++m) { const int row = row0 + ai * HALF + m * 16; const float r = 1.0f / sqrtf(rs[ai][m] * (1.f / DM) + RMS_EPS);
                const f32x4 c0 = nc0, c1 = nc1, s0 = ns0, s1 = ns1;
                if (rotw && (ai * 4 + m) < 7) { const int nrow = row0 + ((ai * 4 + m + 1) >> 2) * HALF + ((ai * 4 + m + 1) & 3) * 16; const float* rp = ROPE + (size_t)(nrow & 4095) * 16; nc0 = *(const f32x4*)rp; nc1 = *(const f32x4*)(rp + 4); ns0 = *(const f32x4*)(rp + 8); ns1 = *(const f32x4*)(rp + 12); }
#pragma unroll
                for (int bj = 0; bj < 2; ++bj) { f32x4 v0 = acc[ai][bj][m][0] * r, v1 = acc[ai][bj][m][1] * r;
                    if (rotw) {
#pragma unroll
                        for (int j = 0; j < 4; ++j) { const float p0 = __shfl_xor(v0[j], 16), p1 = __shfl_xor(v1[j], 16);
                            const float n0 = v0[j] * c0[j] + sgn * p0 * s0[j], n1 = v1[j] * c1[j] + sgn * p1 * s1[j];
                            v0[j] = rotl ? n0 : v0[j]; v1[j] = rotl ? n1 : v1[j]; } }
                    if (gate) {
#pragma unroll
                        for (int j = 0; j < 4; ++j) { v0[j] = silu_fast(v0[j]); v1[j] = silu_fast(v1[j]); } }
                    v0 = v0 * osc; v1 = v1 * osc;
                    *(u32x4*)(base + hm_off(row, col0 + bj * HALF, pitch >> 6)) = pack8(v0, v1); } }
    }
};
template <bool FIRST> struct EpiRes {
    static constexpr bool PERM = true, AFTER_DRAIN = false;
    const float* xin; bf16_t* XB; float* SS;
    __device__ __forceinline__ void operator()(const f32x4 (&acc)[2][2][4][2], const Unit& u, int wr, int wc, int fr, int fq) const {
        const int row0 = u.pm * BM + wr * 64 + fr, col0 = u.pn * BM + wc * 32 + 8 * fq;
        if (FIRST) {
            f32x4 nx[2][2];
#pragma unroll
            for (int bj = 0; bj < 2; ++bj)
#pragma unroll
                for (int n = 0; n < 2; ++n) nx[bj][n] = *(const f32x4*)(xin + (size_t)row0 * DM + col0 + bj * HALF + n * 4);
#pragma unroll
            for (int ai = 0; ai < 2; ++ai)
#pragma unroll
                for (int m = 0; m < 4; ++m) { const int row = row0 + ai * HALF + m * 16; float ss = 0.f;
                    f32x4 cx[2][2];
#pragma unroll
                    for (int bj = 0; bj < 2; ++bj)
#pragma unroll
                        for (int n = 0; n < 2; ++n) cx[bj][n] = nx[bj][n];
                    if ((ai * 4 + m) < 7) { const int nrow = row0 + ((ai * 4 + m + 1) >> 2) * HALF + ((ai * 4 + m + 1) & 3) * 16;
#pragma unroll
                        for (int bj = 0; bj < 2; ++bj)
#pragma unroll
                            for (int n = 0; n < 2; ++n) nx[bj][n] = *(const f32x4*)(xin + (size_t)nrow * DM + col0 + bj * HALF + n * 4); }
#pragma unroll
                    for (int bj = 0; bj < 2; ++bj) { const f32x4 x0 = cx[bj][0] + acc[ai][bj][m][0], x1 = cx[bj][1] + acc[ai][bj][m][1];
                        *(u32x4*)(XB + tiled_off(row, col0 + bj * HALF)) = pack8(x0, x1);
                        ss += ((x0[0] * x0[0] + x0[1] * x0[1]) + (x0[2] * x0[2] + x0[3] * x0[3])) + ((x1[0] * x1[0] + x1[1] * x1[1]) + (x1[2] * x1[2] + x1[3] * x1[3])); }
                    ss += __shfl_xor(ss, 16); ss += __shfl_xor(ss, 32); if (fq == 0) atomicAdd(SS + row, ss); }
        } else {
            u32x4 xv[2][4][2];
#pragma unroll
            for (int ai = 0; ai < 2; ++ai)
#pragma unroll
                for (int m = 0; m < 4; ++m)
#pragma unroll
                    for (int bj = 0; bj < 2; ++bj) xv[ai][m][bj] = *(const u32x4*)(XB + tiled_off(row0 + ai * HALF + m * 16, col0 + bj * HALF));
#pragma unroll
            for (int ai = 0; ai < 2; ++ai)
#pragma unroll
                for (int m = 0; m < 4; ++m)
#pragma unroll
                    for (int bj = 0; bj < 2; ++bj) { const u32x4 xw = xv[ai][m][bj]; const f32x4 a0 = acc[ai][bj][m][0], a1 = acc[ai][bj][m][1];
                        const f32x4 y0 = {__uint_as_float(xw.x << 16) + a0[0], __uint_as_float(xw.x & 0xffff0000u) + a0[1], __uint_as_float(xw.y << 16) + a0[2], __uint_as_float(xw.y & 0xffff0000u) + a0[3]};
                        const f32x4 y1 = {__uint_as_float(xw.z << 16) + a1[0], __uint_as_float(xw.z & 0xffff0000u) + a1[1], __uint_as_float(xw.w << 16) + a1[2], __uint_as_float(xw.w & 0xffff0000u) + a1[3]};
                        *(u32x4*)(XB + tiled_off(row0 + ai * HALF + m * 16, col0 + bj * HALF)) = pack8(y0, y1);
                        if (SS) { float ss = ((y0[0] * y0[0] + y0[1] * y0[1]) + (y0[2] * y0[2] + y0[3] * y0[3])) + ((y1[0] * y1[0] + y1[1] * y1[1]) + (y1[2] * y1[2] + y1[3] * y1[3]));
                            ss += __shfl_xor(ss, 16); ss += __shfl_xor(ss, 32); if (fq == 0) atomicAdd(SS + row0 + ai * HALF + m * 16, ss); } }
        }
    }
};
template <class Epi, class Sched, bool ALIGN_EPI = false, bool SP2 = false>
__device__ __forceinline__ void gemm_phase(PG8_LAS unsigned char* lds, const Gemm g, const Sched& S, const Epi& E) {
    const int tid = threadIdx.x, wid = __builtin_amdgcn_readfirstlane(tid >> 6), lane = tid & 63, wr = wid >> 2, wc = wid & 3, fr = lane & 15, fq = lane >> 4;
    const int K = g.K, nt = K / BK;
    unsigned voffA[2], voffB[2];
#pragma unroll
    for (int i = 0; i < 2; ++i) { int R, C; stage_rc(tid * 16 + i * 8192, R, C); const int Rb = Epi::PERM ? ((R & ~31) + perm32(R & 31)) : R;
        voffA[i] = (unsigned)((C >> 5) * (BM * 32) + R * 32 + (C & 31)) * 2u; voffB[i] = (unsigned)((C >> 5) * (BM * 32) + Rb * 32 + (C & 31)) * 2u; }
    const size_t kstep = (size_t)(BM * BK * 2);
    const size_t hstep = (size_t)(HALF * 32 * 2);
    const size_t tstep = (size_t)BM * K * 2;
    const unsigned ldsw = (unsigned)wid * 1024u;
    const int aoff = lds_byte(wr * 64 + fr, fq * 8), boff = lds_byte(wc * 32 + fr, fq * 8);
#define PG8_SA(b, h) (((b) * 2 + (h)) * HTB)
#define PG8_SB(b, h) ((4 + (b) * 2 + (h)) * HTB)
#define PG8_STAGE(bufoff, gbase, voff) do { _Pragma("unroll") for (int _i = 0; _i < 2; ++_i) \
        __builtin_amdgcn_global_load_lds((const unsigned*)((const char*)(gbase) + (voff)[_i]), (PG8_LAS unsigned*)(lds + (bufoff) + ldsw + _i * 8192), 16, 0, 0); } while (0)
#define PG8_LDA(dst, b, h) do { _Pragma("unroll") for (int m = 0; m < 4; ++m) _Pragma("unroll") for (int k = 0; k < 2; ++k) dst[m][k] = *(const PG8_LAS bf16x8*)(lds + PG8_SA(b, h) + aoff + m * 2048 + k * 1024); } while (0)
#define PG8_LDB(dst, b, h) do { _Pragma("unroll") for (int n = 0; n < 2; ++n) _Pragma("unroll") for (int k = 0; k < 2; ++k) dst[n][k] = *(const PG8_LAS bf16x8*)(lds + PG8_SB(b, h) + boff + n * 2048 + k * 1024); } while (0)
#define PG8_MMA(ai, bj, At, Bt) do { __builtin_amdgcn_s_setprio(1); _Pragma("unroll") for (int m = 0; m < 4; ++m) _Pragma("unroll") for (int n = 0; n < 2; ++n) _Pragma("unroll") for (int k = 0; k < 2; ++k) \
        acc[ai][bj][m][n] = __builtin_amdgcn_mfma_f32_16x16x32_bf16(Bt[n][k], At[m][k], acc[ai][bj][m][n], 0, 0, 0); __builtin_amdgcn_s_setprio(0); } while (0)
#define PG8_WAIT_V(n) asm volatile("s_waitcnt vmcnt(" #n ")" ::: "memory")
#define PG8_WAIT_L(n) asm volatile("s_waitcnt lgkmcnt(" #n ")" ::: "memory")
#define PG8_BAR __builtin_amdgcn_s_barrier()
#define PG8_SCHED __builtin_amdgcn_sched_barrier(0)
    Unit cur, nxt; int ui = 0;
    if (!S.next(0, cur)) return;
    f32x4 acc[2][2][4][2];
#pragma unroll
    for (int a = 0; a < 2; ++a)
#pragma unroll
        for (int b = 0; b < 2; ++b)
#pragma unroll
            for (int m = 0; m < 4; ++m)
#pragma unroll
                for (int n = 0; n < 2; ++n) acc[a][b][m][n] = (f32x4){0.f, 0.f, 0.f, 0.f};
    bf16x8 At[4][2], B0[2][2], B1[2][2];
    const char* cA = (const char*)g.A + (size_t)cur.lm * tstep; const char* cB = (const char*)g.Bt + (size_t)cur.ln * tstep;
    S.a_ready(cur);
    if constexpr (SP2) {
        PG8_STAGE(PG8_SB(0, 0), cB, voffB); PG8_STAGE(PG8_SB(0, 1), cB + hstep, voffB); PG8_STAGE(PG8_SA(0, 0), cA, voffA); PG8_STAGE(PG8_SA(0, 1), cA + hstep, voffA);
        if (wr == 1) PG8_BAR;
        PG8_WAIT_V(2); PG8_BAR;
        PG8_STAGE(PG8_SB(1, 0), cB + kstep, voffB); PG8_STAGE(PG8_SA(1, 0), cA + kstep, voffA); PG8_STAGE(PG8_SB(1, 1), cB + hstep + kstep, voffB);
        PG8_WAIT_V(6); PG8_BAR;
    } else {
        PG8_STAGE(PG8_SB(0, 0), cB, voffB); PG8_STAGE(PG8_SA(0, 0), cA, voffA); PG8_STAGE(PG8_SB(0, 1), cB + hstep, voffB); PG8_STAGE(PG8_SA(0, 1), cA + hstep, voffA);
        if (wr == 1) PG8_BAR;
        PG8_WAIT_V(4); PG8_BAR;
        PG8_STAGE(PG8_SB(1, 0), cB + kstep, voffB); PG8_STAGE(PG8_SA(1, 0), cA + kstep, voffA); PG8_STAGE(PG8_SB(1, 1), cB + hstep + kstep, voffB);
        PG8_WAIT_V(6); PG8_BAR;
    }
    for (;;) {
        const bool has_next = S.next(ui + 1, nxt);
        const char* nA = has_next ? (const char*)g.A + (size_t)nxt.lm * tstep : cA; const char* nB = has_next ? (const char*)g.Bt + (size_t)nxt.ln * tstep : cB;
        for (int t = 0; t < nt; t += 2) {
            const bool last = (t == nt - 2);
            const char* a1 = cA + (size_t)(t + 1) * kstep;
            const char* a2 = last ? nA : cA + (size_t)(t + 2) * kstep; const char* b2 = last ? nB : cB + (size_t)(t + 2) * kstep;
            const char* a3 = a2 + kstep; const char* b3 = b2 + kstep;
            if (last && has_next) S.a_ready(nxt);
            if constexpr (SP2) {
            PG8_LDB(B0, 0, 0); PG8_LDB(B1, 0, 1); PG8_SCHED; PG8_LDA(At, 0, 0); PG8_STAGE(PG8_SA(1, 0), a1, voffA); PG8_STAGE(PG8_SA(1, 1), a1 + hstep, voffA);
            PG8_WAIT_V(8); PG8_WAIT_L(0); PG8_BAR; PG8_MMA(0, 0, At, B0); PG8_MMA(0, 1, At, B1); PG8_BAR; PG8_SCHED;
            PG8_LDA(At, 0, 1); PG8_STAGE(PG8_SB(0, 0), b2, voffB); PG8_STAGE(PG8_SB(0, 1), b2 + hstep, voffB);
            PG8_WAIT_V(6); PG8_WAIT_L(0); PG8_BAR; PG8_MMA(1, 0, At, B0); PG8_MMA(1, 1, At, B1); PG8_BAR; PG8_SCHED;
            PG8_LDB(B0, 1, 0); PG8_LDB(B1, 1, 1); PG8_SCHED; PG8_LDA(At, 1, 0); PG8_STAGE(PG8_SA(0, 0), a2, voffA); PG8_STAGE(PG8_SA(0, 1), a2 + hstep, voffA);
            PG8_WAIT_V(8); PG8_WAIT_L(0); PG8_BAR; PG8_MMA(0, 0, At, B0); PG8_MMA(0, 1, At, B1); PG8_BAR; PG8_SCHED;
            PG8_LDA(At, 1, 1); PG8_STAGE(PG8_SB(1, 0), b3, voffB); PG8_STAGE(PG8_SB(1, 1), b3 + hstep, voffB);
            PG8_WAIT_V(6); PG8_WAIT_L(0); PG8_BAR; PG8_MMA(1, 0, At, B0); PG8_MMA(1, 1, At, B1); PG8_BAR; PG8_SCHED;
            } else {
            PG8_LDB(B0, 0, 0); PG8_SCHED; PG8_LDA(At, 0, 0); PG8_STAGE(PG8_SA(1, 1), a1 + hstep, voffA);
            PG8_WAIT_L(8); PG8_BAR; PG8_WAIT_L(0); PG8_MMA(0, 0, At, B0); PG8_BAR; PG8_SCHED;
            PG8_LDB(B1, 0, 1); PG8_STAGE(PG8_SB(0, 0), b2, voffB);
            PG8_BAR; PG8_WAIT_L(0); PG8_MMA(0, 1, At, B1); PG8_BAR;
            PG8_LDA(At, 0, 1); PG8_STAGE(PG8_SA(0, 0), a2, voffA);
            PG8_BAR; PG8_WAIT_L(0); PG8_MMA(1, 0, At, B0); PG8_BAR; PG8_SCHED;
            PG8_STAGE(PG8_SB(0, 1), b2 + hstep, voffB);
            PG8_WAIT_V(6); PG8_BAR; PG8_MMA(1, 1, At, B1); PG8_BAR;
            PG8_LDB(B0, 1, 0); PG8_SCHED; PG8_LDA(At, 1, 0); PG8_STAGE(PG8_SA(0, 1), a2 + hstep, voffA);
            PG8_WAIT_L(8); PG8_BAR; PG8_WAIT_L(0); PG8_MMA(0, 0, At, B0); PG8_BAR; PG8_SCHED;
            PG8_LDB(B1, 1, 1); PG8_STAGE(PG8_SB(1, 0), b3, voffB);
            PG8_BAR; PG8_WAIT_L(0); PG8_MMA(0, 1, At, B1); PG8_BAR;
            PG8_LDA(At, 1, 1); PG8_STAGE(PG8_SA(1, 0), a3, voffA);
            PG8_BAR; PG8_WAIT_L(0); PG8_MMA(1, 0, At, B0); PG8_BAR; PG8_SCHED;
            PG8_STAGE(PG8_SB(1, 1), b3 + hstep, voffB);
            PG8_WAIT_V(6); PG8_BAR; PG8_MMA(1, 1, At, B1); PG8_BAR;
            }
        }
        if constexpr (ALIGN_EPI) { if (wr == 0) PG8_BAR; }
        if constexpr (!Epi::AFTER_DRAIN) { E(acc, cur, wr, wc, fr, fq); if (S.epi2) E(acc, cur, wr, wc, fr, fq); S.done(cur); }
        if (!has_next) break;
#pragma unroll
        for (int a = 0; a < 2; ++a)
#pragma unroll
            for (int b = 0; b < 2; ++b)
#pragma unroll
                for (int m = 0; m < 4; ++m)
#pragma unroll
                    for (int n = 0; n < 2; ++n) acc[a][b][m][n] = (f32x4){0.f, 0.f, 0.f, 0.f};
        cur = nxt; cA = nA; cB = nB; ++ui;
        if constexpr (ALIGN_EPI) { if (wr == 1) PG8_BAR; }
    }
    PG8_WAIT_V(0);
    if constexpr (!ALIGN_EPI) { if (wr == 0) PG8_BAR; }
    PG8_BAR;
    if constexpr (Epi::AFTER_DRAIN) { E.fused(acc, cur, wr, wc, fr, fq, lds, wid, lane); S.done(cur); }
#undef PG8_SA
#undef PG8_SB
#undef PG8_STAGE
#undef PG8_LDA
#undef PG8_LDB
#undef PG8_MMA
#undef PG8_WAIT_V
#undef PG8_WAIT_L
#undef PG8_BAR
#undef PG8_SCHED
}
}
namespace fa {
#define FA_LAS __attribute__((address_space(3)))
typedef short bf16x8 __attribute__((ext_vector_type(8)));
typedef short s16x4 __attribute__((ext_vector_type(4)));
typedef short v4i16_t __attribute__((ext_vector_type(4)));
typedef float f32x16 __attribute__((ext_vector_type(16)));
typedef float f32x4 __attribute__((ext_vector_type(4)));
typedef unsigned u32x4 __attribute__((ext_vector_type(4)));
typedef float f32x2_t __attribute__((ext_vector_type(2))); typedef __bf16 bf16x2_t __attribute__((ext_vector_type(2)));
constexpr float THR = 8.f, TH_SKIP = 32.f;
constexpr int F_KBUF = 18432, F_AOFF = 8192, F_VOFF = 10240, F_WSF = 3 * F_KBUF, F_FLAG = F_WSF + 8 * 256, F_OST = F_FLAG + 256, F_LDS_BYTES = F_OST + 8 * 4096;
constexpr int S_KBUF = 16384, S_VOFF = 8192, S_WSF = 6 * S_KBUF, S_OST = S_WSF + 8 * 256, S_LDS_BYTES = S_OST + 8 * 4096;
struct Params { const bf16_t* Q; const bf16_t* K; const bf16_t* V; const bf16_t* G; bf16_t* O; const float* CUM; const float* sinks; const unsigned* KMAX; unsigned* ticket; const bf16_t* KAUG; };
__device__ __forceinline__ unsigned cvtpk(float lo, float hi) { f32x2_t v = {lo, hi}; bf16x2_t b = __builtin_convertvector(v, bf16x2_t); return __builtin_bit_cast(unsigned, b); }
__device__ __forceinline__ s16x4 vtr(FA_LAS unsigned char* p) { return __builtin_bit_cast(s16x4, __builtin_amdgcn_ds_read_tr16_b64_v4i16((FA_LAS v4i16_t*)p)); }
__device__ __forceinline__ float swap_max(float v) { auto rr = __builtin_amdgcn_permlane32_swap(__float_as_uint(v), __float_as_uint(v), false, false); return __builtin_fmaxf(__uint_as_float(rr[0]), __uint_as_float(rr[1])); }
__device__ __forceinline__ float swap_add(float v) { auto rr = __builtin_amdgcn_permlane32_swap(__float_as_uint(v), __float_as_uint(v), false, false); return __uint_as_float(rr[0]) + __uint_as_float(rr[1]); }
__device__ __forceinline__ void glds16(const void* gsrc, unsigned lds_dst) { unsigned keep;
    asm volatile("s_mov_b32 %0, m0\n\ts_mov_b32 m0, %2\n\ts_nop 0\n\tglobal_load_lds_dwordx4 %1, off\n\ts_mov_b32 m0, %0" : "=&s"(keep) : "v"(gsrc), "s"(lds_dst) : "memory"); }
#define FA_MFMA(a, b, c) __builtin_amdgcn_mfma_f32_32x32x16_bf16((a), (b), (c), 0, 0, 0)
#define FA_MX3(a, b, c) __builtin_fmaxf(__builtin_fmaxf((a), (b)), (c))
struct WaveSt { bf16x8 qr[4]; bf16x8 qa; f32x16 o0, o1; float cq, mhat, lsum, mrun; };

#define FA_SBAR() __builtin_amdgcn_sched_barrier(0)
#define FA_PIN(x) asm volatile("" : "+v"(x))
#define FA_LDK(p) (*(FA_LAS bf16x8*)(p))
#define FA_VF(l, h) ((bf16x8){l[0], l[1], l[2], l[3], h[0], h[1], h[2], h[3]})
#define FA_EX4(X, B) do { X[B] = __builtin_amdgcn_exp2f(X[B]); X[B + 1] = __builtin_amdgcn_exp2f(X[B + 1]); X[B + 2] = __builtin_amdgcn_exp2f(X[B + 2]); X[B + 3] = __builtin_amdgcn_exp2f(X[B + 3]); } while (0)
__device__ __forceinline__ void split3(float v, unsigned& h1, unsigned& h2, unsigned& h3) { const bf16_t a = f2bf(v); const float r1 = v - bf2f(a); const bf16_t b = f2bf(r1); const float r2 = r1 - bf2f(b); h1 = a; h2 = b; h3 = f2bf(r2); }
__device__ __forceinline__ void set_qa(WaveSt& w, int hi) {
    unsigned g1, g2, g3; split3(w.cq - w.mhat, g1, g2, g3);
    const u32x4 q = {hi == 0 ? 0x3F803F80u : 0u, hi == 0 ? (0x3F80u | (g1 << 16)) : 0u, hi == 0 ? (g2 | (g3 << 16)) : 0u, 0u};
    w.qa = __builtin_bit_cast(bf16x8, q);
}
template <int MODE, int AOFF, int VOFF>
__device__ __forceinline__ void tile_full(FA_LAS unsigned char* bb, FA_LAS unsigned char* vprev, FA_LAS float* wsf, WaveSt& w, f32x16& C0, f32x16& C1, f32x16& P0, f32x16& P1,
                                          int k0, int t, int qlo, int lane, int r32, int hi) {
    constexpr int W = MODE == 0 ? 0x40000000 : 128;
    FA_LAS unsigned char* kp = bb + hi * 1024 + r32 * 16; FA_LAS unsigned char* ap = bb + AOFF + r32 * 16;
    FA_LAS unsigned char* vp = vprev + VOFF + ((lane >> 4) & 1) * 32 + (lane & 3) * 8 + (4 * hi + ((lane & 15) >> 2)) * 64;
    bf16x8 kf0 = FA_LDK(kp), kf1 = FA_LDK(kp + 512), kf2 = FA_LDK(kp + 2048), kf3 = FA_LDK(kp + 2560), kf4, kf5, kf6, kf7, ka0, ka1;
    s16x4 vl0, vh0, vl1, vh1, vl2, vh2, vl3, vh3, vl4, vh4, vl5, vh5, vl6, vh6, vl7, vh7;
    u32x4 pw0, pw1, pw2, pw3; float sacc;
    const f32x16 Z = {0.f, 0.f, 0.f, 0.f, 0.f, 0.f, 0.f, 0.f, 0.f, 0.f, 0.f, 0.f, 0.f, 0.f, 0.f, 0.f};
    FA_SBAR();
    C0 = FA_MFMA(kf0, w.qr[0], Z); kf4 = FA_LDK(kp + 4096);
    sacc = (P0[0] + P0[1]) + (P0[2] + P0[3]); pw0.x = cvtpk(P0[0], P0[1]); pw0.y = cvtpk(P0[2], P0[3]); FA_PIN(sacc); FA_PIN(pw0.x); FA_PIN(pw0.y);
    FA_SBAR();
    C1 = FA_MFMA(kf1, w.qr[0], Z); kf5 = FA_LDK(kp + 4608);
    sacc += P0[4]; sacc += P0[5]; sacc += P0[6]; sacc += P0[7]; pw0.z = cvtpk(P0[4], P0[5]); pw0.w = cvtpk(P0[6], P0[7]); FA_PIN(sacc); FA_PIN(pw0.z); FA_PIN(pw0.w);
    FA_SBAR();
    C0 = FA_MFMA(kf2, w.qr[1], C0); kf6 = FA_LDK(kp + 6144);
    sacc += P0[8]; sacc += P0[9]; sacc += P0[10]; sacc += P0[11]; pw1.x = cvtpk(P0[8], P0[9]); pw1.y = cvtpk(P0[10], P0[11]); FA_PIN(sacc); FA_PIN(pw1.x); FA_PIN(pw1.y);
    FA_SBAR();
    C1 = FA_MFMA(kf3, w.qr[1], C1); kf7 = FA_LDK(kp + 6656);
    sacc += P0[12]; sacc += P0[13]; sacc += P0[14]; sacc += P0[15]; pw1.z = cvtpk(P0[12], P0[13]); pw1.w = cvtpk(P0[14], P0[15]); FA_PIN(sacc); FA_PIN(pw1.z); FA_PIN(pw1.w);
    FA_SBAR();
    C0 = FA_MFMA(kf4, w.qr[2], C0); if (MODE == 0) { ka0 = FA_LDK(ap); ka1 = FA_LDK(ap + 512); } else { const u32x4 kc = {0u, 0x3F800000u, 0x3F803F80u, 0u}; ka0 = __builtin_bit_cast(bf16x8, kc); ka1 = ka0; }
    sacc += P1[0]; sacc += P1[1]; sacc += P1[2]; sacc += P1[3]; pw2.x = cvtpk(P1[0], P1[1]); pw2.y = cvtpk(P1[2], P1[3]); FA_PIN(sacc); FA_PIN(pw2.x); FA_PIN(pw2.y);
    FA_SBAR();
    C1 = FA_MFMA(kf5, w.qr[2], C1); vl0 = vtr(vp); vh0 = vtr(vp + 512);
    sacc += P1[4]; sacc += P1[5]; sacc += P1[6]; sacc += P1[7]; pw2.z = cvtpk(P1[4], P1[5]); pw2.w = cvtpk(P1[6], P1[7]); FA_PIN(sacc); FA_PIN(pw2.z); FA_PIN(pw2.w);
    FA_SBAR();
    C0 = FA_MFMA(kf6, w.qr[3], C0); vl4 = vtr(vp + 4096); vh4 = vtr(vp + 4096 + 512);
    sacc += P1[8]; sacc += P1[9]; sacc += P1[10]; sacc += P1[11]; pw3.x = cvtpk(P1[8], P1[9]); pw3.y = cvtpk(P1[10], P1[11]); FA_PIN(sacc); FA_PIN(pw3.x); FA_PIN(pw3.y);
    FA_SBAR();
    C1 = FA_MFMA(kf7, w.qr[3], C1); vl1 = vtr(vp + 1024); vh1 = vtr(vp + 1024 + 512);
    sacc += P1[12]; sacc += P1[13]; sacc += P1[14]; sacc += P1[15]; pw3.z = cvtpk(P1[12], P1[13]); pw3.w = cvtpk(P1[14], P1[15]); FA_PIN(sacc); FA_PIN(pw3.z); FA_PIN(pw3.w);
    FA_SBAR();
    C0 = FA_MFMA(ka0, w.qa, C0); vl5 = vtr(vp + 4096 + 1024); vh5 = vtr(vp + 4096 + 1024 + 512); FA_SBAR();
    C1 = FA_MFMA(ka1, w.qa, C1); FA_SBAR();
    w.lsum += sacc;
    const bf16x8 pa0 = __builtin_bit_cast(bf16x8, pw0), pa1 = __builtin_bit_cast(bf16x8, pw1), pa2 = __builtin_bit_cast(bf16x8, pw2), pa3 = __builtin_bit_cast(bf16x8, pw3);
    vl2 = vtr(vp + 2048); vh2 = vtr(vp + 2048 + 512);
    w.o0 = FA_MFMA(pa0, FA_VF(vl0, vh0), w.o0); vl6 = vtr(vp + 4096 + 2048); vh6 = vtr(vp + 4096 + 2048 + 512);
    w.o1 = FA_MFMA(pa0, FA_VF(vl4, vh4), w.o1);
    FA_SBAR();
    if ((k0 + 63 > qlo) || (MODE == 1 && k0 <= qlo + 31 - W)) {
        const float NEG = -__builtin_inff(); const int dq = t - k0 - 4 * hi;
#pragma unroll
        for (int r = 0; r < 16; ++r) { const int c = (r & 3) + 8 * (r >> 2); if ((unsigned)(dq - c) >= (unsigned)W) C0[r] = NEG; if ((unsigned)(dq - c - 32) >= (unsigned)W) C1[r] = NEG; }
    }
    float ma = FA_MX3(C0[0], C0[1], C1[0]), mb = FA_MX3(C0[2], C0[3], C1[1]); ma = FA_MX3(ma, C1[2], C1[3]);
#pragma unroll
    for (int r = 4; r < 16; r += 4) { ma = FA_MX3(ma, C0[r], C0[r + 1]); mb = FA_MX3(mb, C0[r + 2], C0[r + 3]); ma = FA_MX3(ma, C1[r], C1[r + 1]); mb = FA_MX3(mb, C1[r + 2], C1[r + 3]); }
    const float rm = swap_max(__builtin_fmaxf(ma, mb));
    if (MODE == 0) w.mrun = __builtin_fmaxf(w.mrun, rm + w.mhat);
    const bool resc = __any(rm > THR);
    if (resc) {
        const float dl = __builtin_fmaxf(rm, 0.f); w.mhat += dl;
#pragma unroll
        for (int r = 0; r < 16; ++r) { C0[r] -= dl; C1[r] -= dl; }
        set_qa(w, hi);
        const float f = __builtin_amdgcn_exp2f(-dl); w.lsum *= f;
        if (hi == 0) wsf[r32] = f;
    }
    FA_SBAR();
    FA_EX4(C0, 0); FA_PIN(C0); vl3 = vtr(vp + 3072); vh3 = vtr(vp + 3072 + 512);
    w.o0 = FA_MFMA(pa1, FA_VF(vl1, vh1), w.o0); FA_EX4(C0, 4); FA_EX4(C0, 8); FA_PIN(C0); vl7 = vtr(vp + 4096 + 3072); vh7 = vtr(vp + 4096 + 3072 + 512); FA_SBAR();
    w.o1 = FA_MFMA(pa1, FA_VF(vl5, vh5), w.o1); FA_EX4(C0, 12); FA_PIN(C0); FA_EX4(C1, 0); FA_PIN(C1); FA_SBAR();
    w.o0 = FA_MFMA(pa2, FA_VF(vl2, vh2), w.o0); FA_EX4(C1, 4); FA_PIN(C1); FA_SBAR();
    w.o1 = FA_MFMA(pa2, FA_VF(vl6, vh6), w.o1); FA_EX4(C1, 8); FA_PIN(C1); FA_SBAR();
    w.o0 = FA_MFMA(pa3, FA_VF(vl3, vh3), w.o0); FA_EX4(C1, 12); FA_PIN(C1); FA_SBAR();
    w.o1 = FA_MFMA(pa3, FA_VF(vl7, vh7), w.o1); FA_SBAR();
    if (resc) {
        asm volatile("s_waitcnt lgkmcnt(0)" ::: "memory");
#pragma unroll
        for (int g = 0; g < 4; ++g) { const f32x4 a4 = *(FA_LAS f32x4*)(wsf + 8 * g + 4 * hi);
#pragma unroll
            for (int i = 0; i < 4; ++i) { w.o0[4 * g + i] *= a4[i]; w.o1[4 * g + i] *= a4[i]; } }
    }
}
template <int VOFF>
__device__ __forceinline__ void drain_full(FA_LAS unsigned char* vlast, WaveSt& w, f32x16& P0, f32x16& P1, int lane, int hi) {
    FA_LAS unsigned char* vp = vlast + VOFF + ((lane >> 4) & 1) * 32 + (lane & 3) * 8 + (4 * hi + ((lane & 15) >> 2)) * 64;
    float s0 = 0.f, s1 = 0.f;
#pragma unroll
    for (int r = 0; r < 16; ++r) { s0 += P0[r]; s1 += P1[r]; }
    w.lsum += s0 + s1;
    const u32x4 w0 = {cvtpk(P0[0], P0[1]), cvtpk(P0[2], P0[3]), cvtpk(P0[4], P0[5]), cvtpk(P0[6], P0[7])};
    const u32x4 w1 = {cvtpk(P0[8], P0[9]), cvtpk(P0[10], P0[11]), cvtpk(P0[12], P0[13]), cvtpk(P0[14], P0[15])};
    const u32x4 w2 = {cvtpk(P1[0], P1[1]), cvtpk(P1[2], P1[3]), cvtpk(P1[4], P1[5]), cvtpk(P1[6], P1[7])};
    const u32x4 w3 = {cvtpk(P1[8], P1[9]), cvtpk(P1[10], P1[11]), cvtpk(P1[12], P1[13]), cvtpk(P1[14], P1[15])};
    const bf16x8 pa0 = __builtin_bit_cast(bf16x8, w0), pa1 = __builtin_bit_cast(bf16x8, w1), pa2 = __builtin_bit_cast(bf16x8, w2), pa3 = __builtin_bit_cast(bf16x8, w3);
#define FA_PV(ks, pa) do { const s16x4 l0_ = vtr(vp + (ks) * 1024), h0_ = vtr(vp + (ks) * 1024 + 512), l1_ = vtr(vp + 4096 + (ks) * 1024), h1_ = vtr(vp + 4096 + (ks) * 1024 + 512); \
    w.o0 = FA_MFMA(pa, FA_VF(l0_, h0_), w.o0); w.o1 = FA_MFMA(pa, FA_VF(l1_, h1_), w.o1); } while (0)
    FA_PV(0, pa0); FA_PV(1, pa1); FA_PV(2, pa2); FA_PV(3, pa3);
#undef FA_PV
}
__device__ __forceinline__ void load_gate(u32x4 (&gq)[4], const bf16_t* G, size_t grow, int h, int lane) {
#pragma unroll
    for (int d0 = 0; d0 < 2; ++d0)
#pragma unroll
        for (int i = 0; i < 2; ++i) gq[2 * d0 + i] = *(const u32x4*)(G + hm_off((int)grow + i * 16 + (lane >> 2), h * 64 + d0 * 32 + (lane & 3) * 8, NH));
}
__device__ __forceinline__ void wave_epilogue(FA_LAS float* stg, FA_LAS float* wsf, WaveSt& w, const u32x4 (&gq)[4], bf16_t* O, size_t grow, int h, int lane, int r32, int hi) {
    const float l = swap_add(w.lsum);
    if (hi == 0) wsf[r32] = l;
    asm volatile("s_waitcnt lgkmcnt(0)" ::: "memory");
    float rl[16];
#pragma unroll
    for (int g = 0; g < 4; ++g) { const f32x4 l4 = *(FA_LAS f32x4*)(wsf + 8 * g + 4 * hi);
#pragma unroll
        for (int i = 0; i < 4; ++i) rl[4 * g + i] = 1.0f / l4[i]; }
#pragma unroll
    for (int d0 = 0; d0 < 2; ++d0) {
#pragma unroll
        for (int g = 0; g < 4; ++g)
#pragma unroll
            for (int i = 0; i < 4; ++i) stg[(8 * g + 4 * hi + i) * 32 + r32] = (d0 == 0 ? w.o0[4 * g + i] : w.o1[4 * g + i]) * rl[4 * g + i];
        asm volatile("s_waitcnt lgkmcnt(0)" ::: "memory");
#pragma unroll
        for (int i = 0; i < 2; ++i) { const int row = i * 16 + (lane >> 2), ch = lane & 3;
            const f32x4 x0 = *(FA_LAS f32x4*)(stg + row * 32 + ch * 8), x1 = *(FA_LAS f32x4*)(stg + row * 32 + ch * 8 + 4);
            const size_t ga = (grow + row) * DM + h * 64 + d0 * 32 + ch * 8; const u32x4 gv = gq[2 * d0 + i];
            u32x4 ov;
            ov.x = cvtpk(x0[0] * __uint_as_float(gv.x << 16), x0[1] * __uint_as_float(gv.x & 0xffff0000u)); ov.y = cvtpk(x0[2] * __uint_as_float(gv.y << 16), x0[3] * __uint_as_float(gv.y & 0xffff0000u));
            ov.z = cvtpk(x1[0] * __uint_as_float(gv.z << 16), x1[1] * __uint_as_float(gv.z & 0xffff0000u)); ov.w = cvtpk(x1[2] * __uint_as_float(gv.w << 16), x1[3] * __uint_as_float(gv.w & 0xffff0000u));
            *(u32x4*)(O + tiled_off((int)(grow + row), h * 64 + d0 * 32 + ch * 8)) = ov; }
        asm volatile("s_waitcnt lgkmcnt(0)" ::: "memory");
    }
}
template <int MODE> __device__ __forceinline__ void wave_init(WaveSt& w, int hi) {
#pragma unroll
    for (int r = 0; r < 16; ++r) { w.o0[r] = 0.f; w.o1[r] = 0.f; }
    set_qa(w, hi);
}

__device__ __forceinline__ void fox_unit(FA_LAS unsigned char* lds, const Params& P, int b, int h, int qb) {
    const int tid = threadIdx.x, lane = tid & 63, r32 = lane & 31, hi = lane >> 5;
    const int wid = __builtin_amdgcn_readfirstlane(tid >> 6);
    const int q0 = qb * 256, qlo = q0 + wid * 32, t = qlo + r32;
    const size_t rowbase = (size_t)b * SEQ;
    const bf16_t* ksrc = P.K + hm_off((int)rowbase + lane, h * 64 + wid * 8, NH);
    const bf16_t* vsrc = P.V + hm_off((int)rowbase + 16 * (wid & 3) + (lane >> 2), h * 64 + (wid >> 2) * 32 + (lane & 3) * 8, NH);
    const float* cum = P.CUM + (size_t)(b * NH + h) * SEQ;
    const bf16_t* asrc = P.KAUG + ((size_t)(b * NH + h) * SEQ + lane) * 8;
    const int NT = (q0 + 256) / 64;
    WaveSt w; float qn = 0.f;
#pragma unroll
    for (int d0 = 0; d0 < 4; ++d0) { w.qr[d0] = *(const bf16x8*)(P.Q + hm_off((int)rowbase + t, h * 64 + d0 * 16 + hi * 8, NH));
#pragma unroll
        for (int j = 0; j < 8; ++j) { const float qv = bf2f((bf16_t)w.qr[d0][j]); qn = fmaf(qv, qv, qn); } }
    w.cq = cum[t]; w.mhat = 0.f; w.lsum = 0.f; w.mrun = -1e30f;
    wave_init<0>(w, hi);
    u32x4 gq[4]; load_gate(gq, P.G, rowbase + qlo, h, lane);
    const float qkb = sqrtf(swap_add(qn) * (__uint_as_float(P.KMAX[(b * NH + h) * 2]) + __uint_as_float(P.KMAX[(b * NH + h) * 2 + 1]))) * 1.01f + 1e-3f;
    FA_LAS float* wsf = (FA_LAS float*)(lds + F_WSF) + wid * 64;
    FA_LAS unsigned* votes = (FA_LAS unsigned*)(lds + F_FLAG);
    float cnew = 0.f;
#define FA_LOADT(j, bf) do { const size_t ko_ = (size_t)(j) * 64 * 32; FA_LAS unsigned char* bb_ = lds + (bf) * F_KBUF; \
        glds16(ksrc + ko_, (unsigned)__builtin_amdgcn_readfirstlane((int)(unsigned)(uintptr_t)(bb_ + wid * 1024))); \
        glds16(vsrc + ko_, (unsigned)__builtin_amdgcn_readfirstlane((int)(unsigned)(uintptr_t)(bb_ + F_VOFF + (wid >> 2) * 4096 + (wid & 3) * 1024))); \
        if (wid == 0) glds16(asrc + (size_t)(j) * 64 * 8, (unsigned)__builtin_amdgcn_readfirstlane((int)(unsigned)(uintptr_t)(bb_ + F_AOFF))); \
        cnew = cum[(j) * 64 + 63]; } while (0)
    FA_LOADT(NT - 1, 0); asm volatile("s_waitcnt vmcnt(0)" ::: "memory"); __syncthreads();
    bool wdone = false; int n = 0; f32x16 pA0, pA1, pB0, pB1;
#pragma unroll
    for (int r = 0; r < 16; ++r) { pA0[r] = 0.f; pA1[r] = 0.f; pB0[r] = 0.f; pB1[r] = 0.f; }
    int cur = 0; bool fin = false;
#define FA_WALK(tt, CA0, CA1, PA0, PA1) do { \
        const int j = NT - 1 - (tt), k0 = j * 64; const int nxt = cur == 2 ? 0 : cur + 1, prv = cur == 0 ? 2 : cur - 1; \
        if (j > 0) FA_LOADT(j - 1, nxt); \
        if (!wdone && k0 <= qlo + 31) { FA_LAS unsigned char* bb = lds + cur * F_KBUF; \
            tile_full<0, F_AOFF, F_VOFF>(bb, n > 0 ? lds + prv * F_KBUF : bb, wsf, w, CA0, CA1, PA0, PA1, k0, t, qlo, lane, r32, hi); ++n; } \
        if (j > 0) { \
            if (!wdone && n > 0 && __all(qkb + w.cq - cnew - w.mrun <= -TH_SKIP)) { wdone = true; drain_full<F_VOFF>(lds + cur * F_KBUF, w, CA0, CA1, lane, hi); } \
            if (lane == 0) votes[((tt) & 1) * 8 + wid] = wdone ? 1u : 0u; } \
        asm volatile("s_waitcnt vmcnt(0)" ::: "memory"); \
        __syncthreads(); \
        if (j > 0) { const u32x4 v0 = *(FA_LAS u32x4*)(votes + ((tt) & 1) * 8), v1 = *(FA_LAS u32x4*)(votes + ((tt) & 1) * 8 + 4); \
            if ((v0.x & v0.y & v0.z & v0.w & v1.x & v1.y & v1.z & v1.w) != 0u) fin = true; } \
        else { if (!wdone && n > 0) drain_full<F_VOFF>(lds + cur * F_KBUF, w, CA0, CA1, lane, hi); fin = true; } \
        cur = nxt; } while (0)
    for (int tt = 0; !fin; tt += 2) {
        FA_WALK(tt, pA0, pA1, pB0, pB1);
        if (fin) break;
        FA_WALK(tt + 1, pB0, pB1, pA0, pA1);
    }
#undef FA_WALK
#undef FA_LOADT
    wave_epilogue((FA_LAS float*)(lds + F_OST + wid * 4096), wsf, w, gq, P.O, rowbase + qlo, h, lane, r32, hi);
    __syncthreads();
}
__device__ __forceinline__ void swa_unit(FA_LAS unsigned char* lds, const Params& P, int b, int kvh, int qb, int hh_lo = 0, int hh_hi = 8) {
    const int tid = threadIdx.x, lane = tid & 63, r32 = lane & 31, hi = lane >> 5;
    const int wid = __builtin_amdgcn_readfirstlane(tid >> 6);
    const int q0 = qb * 256, qlo = q0 + wid * 32, t = qlo + r32;
    const size_t rowbase = (size_t)b * SEQ;
    const int j_lo = q0 >= 128 ? (q0 - 128) / 64 : 0, NT = (q0 + 256) / 64 - j_lo;
    const bf16_t* ksrc = P.K + hm_off((int)rowbase + j_lo * 64 + lane, kvh * 64 + wid * 8, 4);
    const bf16_t* vsrc = P.V + hm_off((int)rowbase + j_lo * 64 + 16 * (wid & 3) + (lane >> 2), kvh * 64 + (wid >> 2) * 32 + (lane & 3) * 8, 4);
    for (int i = 0; i < NT; ++i) {
        glds16(ksrc + (size_t)i * 64 * 32, (unsigned)__builtin_amdgcn_readfirstlane((int)(unsigned)(uintptr_t)(lds + i * S_KBUF + wid * 1024)));
        glds16(vsrc + (size_t)i * 64 * 32, (unsigned)__builtin_amdgcn_readfirstlane((int)(unsigned)(uintptr_t)(lds + i * S_KBUF + S_VOFF + (wid >> 2) * 4096 + (wid & 3) * 1024))); }
    asm volatile("s_waitcnt vmcnt(0)" ::: "memory");
    __syncthreads();
    FA_LAS float* wsf = (FA_LAS float*)(lds + S_WSF) + wid * 64;
    const int ta = (qlo >= 127 ? (qlo - 127) / 64 : 0) - j_lo, tb = (qlo + 31) / 64 - j_lo;
    for (int hh = hh_lo; hh < hh_hi; ++hh) {
        const int h = kvh * 8 + hh;
        WaveSt w;
#pragma unroll
        for (int d0 = 0; d0 < 4; ++d0) w.qr[d0] = *(const bf16x8*)(P.Q + hm_off((int)rowbase + t, h * 64 + d0 * 16 + hi * 8, NH));
        u32x4 gq[4]; load_gate(gq, P.G, rowbase + qlo, h, lane);
        w.cq = 0.f; w.mhat = P.sinks[h] * LOG2E; w.lsum = 0.5f; w.mrun = 0.f;
        wave_init<1>(w, hi);
        f32x16 pA0, pA1, pB0, pB1;
#pragma unroll
        for (int r = 0; r < 16; ++r) { pB0[r] = 0.f; pB1[r] = 0.f; }
        for (int ti = tb;;) {
            { FA_LAS unsigned char* bb = lds + ti * S_KBUF;
              tile_full<1, 0, S_VOFF>(bb, ti == tb ? bb : bb + S_KBUF, wsf, w, pA0, pA1, pB0, pB1, (j_lo + ti) * 64, t, qlo, lane, r32, hi); }
            if (ti == ta) { drain_full<S_VOFF>(lds + ta * S_KBUF, w, pA0, pA1, lane, hi); break; }
            --ti;
            { FA_LAS unsigned char* bb = lds + ti * S_KBUF;
              tile_full<1, 0, S_VOFF>(bb, bb + S_KBUF, wsf, w, pB0, pB1, pA0, pA1, (j_lo + ti) * 64, t, qlo, lane, r32, hi); }
            if (ti == ta) { drain_full<S_VOFF>(lds + ta * S_KBUF, w, pB0, pB1, lane, hi); break; }
            --ti;
        }
        wave_epilogue((FA_LAS float*)(lds + S_OST + wid * 4096), wsf, w, gq, P.O, rowbase + qlo, h, lane, r32, hi);
    }
    __syncthreads();
}
}
#define GAS __attribute__((address_space(1)))
#define LAS __attribute__((address_space(3)))
typedef unsigned short bf16;
typedef unsigned v4u __attribute__((ext_vector_type(4)));
typedef float f32x4 __attribute__((ext_vector_type(4)));
typedef short bf16x8 __attribute__((ext_vector_type(8)));
typedef GAS unsigned gu32;
typedef GAS unsigned long long gu64;
#define RLX_AGENT __ATOMIC_RELAXED, __HIP_MEMORY_SCOPE_AGENT
#define LDS_WAIT() asm volatile("s_waitcnt lgkmcnt(0)" ::: "memory")
#define VM_WAIT() asm volatile("s_waitcnt vmcnt(0)" ::: "memory")
__device__ __forceinline__ unsigned long long rt() { return __builtin_amdgcn_s_memrealtime(); }
__device__ __forceinline__ unsigned pk2(float lo, float hi) { return (unsigned)f2bf(lo) | ((unsigned)f2bf(hi) << 16); }
#define XB_TMO      128
#define XB_XCNT(j)  (256  + 64 * (j))
#define XB_XSUB(j)  (1280 + 64 * (j))
#define XB_XGEN(j)  (2304 + 64 * (j))
#define XB_TOP      3328
#define XB_TOPGEN   3392
#define XCD_BAR_WORDS 3456
#define XB_SPIN_CAP (1u << 18)

__device__ __forceinline__ unsigned xb_ld(unsigned* p)              { return __hip_atomic_load(p, __ATOMIC_RELAXED, __HIP_MEMORY_SCOPE_AGENT); }
__device__ __forceinline__ unsigned xb_add(unsigned* p, unsigned v) { return __hip_atomic_fetch_add(p, v, __ATOMIC_RELAXED, __HIP_MEMORY_SCOPE_AGENT); }
__device__ __forceinline__ unsigned xb_xcc_id() { return (unsigned)__builtin_amdgcn_s_getreg((3 << 11) | 20) & 0xFu; }
#define XB_SPIN(cond, bar) do { unsigned _sp = 0; while (cond) { __builtin_amdgcn_s_sleep(1); \
    if ((++_sp & 255u) == 0u) { if (xb_ld(&(bar)[XB_TMO])) break; if (_sp > XB_SPIN_CAP) { atomicAdd(&(bar)[XB_TMO], 1u); break; } } } } while (0)

struct XcdBarrier {
    unsigned* bar; unsigned x;
    volatile LAS unsigned* st;
};

__device__ __forceinline__ XcdBarrier xcd_barrier_post(unsigned* bar, volatile LAS unsigned* st) {
    XcdBarrier b; b.bar = bar; b.x = xb_xcc_id(); b.st = st;
    if (threadIdx.x == 0) (void)xb_add(&bar[XB_XCNT(b.x)], 1u);
    return b;
}
__device__ __forceinline__ void xcd_barrier_complete(unsigned* bar, unsigned x, unsigned& nloc, unsigned& nx) {
    const unsigned G = gridDim.x * gridDim.y * gridDim.z;
    unsigned sum, cnt, mine, sp = 0u;
    for (;;) {
        sum = 0u; cnt = 0u; mine = 0u;
#pragma unroll
        for (unsigned j = 0; j < 16; ++j) { const unsigned c = xb_ld(&bar[XB_XCNT(j)]); sum += c; cnt += (c > 0u) ? 1u : 0u; mine = (j == x) ? c : mine; }
        if (sum == G) break;
        __builtin_amdgcn_s_sleep(1);
        if ((++sp & 255u) == 0u) { if (xb_ld(&bar[XB_TMO])) break; if (sp > XB_SPIN_CAP) { atomicAdd(&bar[XB_TMO], 1u); break; } }
    }
    nloc = mine > 0u ? mine : 1u; nx = cnt > 0u ? cnt : 1u;
}

__device__ __forceinline__ void xcd_barrier(const XcdBarrier& b) {
    asm volatile("s_waitcnt vmcnt(0)" ::: "memory");
    __syncthreads();
    if (threadIdx.x == 0) {
        unsigned* bar = b.bar;
        __builtin_amdgcn_s_waitcnt(0);
        unsigned nloc = b.st[0], nx = b.st[1];
        if (nloc == 0u) { xcd_barrier_complete(bar, b.x, nloc, nx); b.st[0] = nloc; b.st[1] = nx; }
        const unsigned old = xb_add(&bar[XB_XSUB(b.x)], 1u);
        const unsigned gen = old / nloc;
        if (old + 1u == (gen + 1u) * nloc) {
            __builtin_amdgcn_fence(__ATOMIC_RELEASE, "agent");
            asm volatile("s_waitcnt vmcnt(0)" ::: "memory");
            const unsigned og = xb_add(&bar[XB_TOP], 1u);
            const unsigned tg = og / nx;
            if (og + 1u == (tg + 1u) * nx) xb_add(&bar[XB_TOPGEN], 1u);
            else XB_SPIN(xb_ld(&bar[XB_TOPGEN]) == tg, bar);
            __builtin_amdgcn_fence(__ATOMIC_ACQUIRE, "agent");
            xb_add(&bar[XB_XGEN(b.x)], 1u);
            asm volatile("s_waitcnt vmcnt(0)" ::: "memory");
        } else {
            XB_SPIN(xb_ld(&bar[XB_XGEN(b.x)]) == gen, bar);
            __builtin_amdgcn_fence(__ATOMIC_ACQUIRE, "agent");
            asm volatile("s_waitcnt vmcnt(0)" ::: "memory");
        }
    }
    __syncthreads();
}
constexpr int NWAVES = 8;
constexpr int N1P = 8448;
constexpr int RING_OFF = 0, RING_BYTES = 135168;
constexpr int LDSCTL_OFF = RING_BYTES, MISC_OFF = LDSCTL_OFF + 320;
constexpr int LDS_BYTES = 147456;
constexpr int CW_BAR = 4096;
static_assert(fa::F_LDS_BYTES <= RING_BYTES && fa::S_LDS_BYTES <= RING_BYTES && pg8::STAGE_BYTES <= RING_BYTES && MISC_OFF + 128 <= LDS_BYTES && (CW_BAR + XCD_BAR_WORDS) * 4 <= (int)WS_KMAX, "LDS / CTL map");

__device__ __forceinline__ void p0_transpose_item(const float* W, int K, int N, bf16* WT, LAS float* scr, int item, int lane, const float* gs) {
    const int nblk = N / 32, kb = item / nblk, nb = item % nblk, k0 = 64 * kb, n0 = 32 * nb;
    const int kr = lane >> 3, nc = 4 * (lane & 7);
    f32x4 wv[8];
#pragma unroll
    for (int i = 0; i < 8; ++i) wv[i] = __builtin_nontemporal_load((const GAS f32x4*)(W + (size_t)(k0 + 8 * i + kr) * N + n0 + nc));
#pragma unroll
    for (int i = 0; i < 8; ++i) { const int kk = 8 * i + kr; f32x4 w = wv[i]; if (gs) w = w * gs[k0 + kk]; LAS float* d = scr + kk * 33 + nc; d[0] = w.x; d[1] = w.y; d[2] = w.z; d[3] = w.w; }
    LDS_WAIT(); asm volatile("" ::: "memory");
    const int c = lane & 7;
#pragma unroll
    for (int j = 0; j < 4; ++j) { const int n = (lane >> 3) + 8 * j; const LAS float* sp = scr + (8 * c) * 33 + n;
        v4u o; o.x = pk2(sp[0 * 33], sp[1 * 33]); o.y = pk2(sp[2 * 33], sp[3 * 33]); o.z = pk2(sp[4 * 33], sp[5 * 33]); o.w = pk2(sp[6 * 33], sp[7 * 33]);
        *(GAS v4u*)(WT + tiled_off(n0 + n, k0 + 8 * c)) = o; }
    LDS_WAIT(); asm volatile("" ::: "memory");
}
__device__ __forceinline__ float wave_sum(float v) {
#pragma unroll
    for (int o = 1; o < 64; o <<= 1) v += __shfl_xor(v, o);
    return v;
}

struct Args { const float* in[9]; float* out; unsigned char* ws; int ph_lo, ph_hi; };
constexpr int N_PHASES = 9;
__global__ void __launch_bounds__(NWAVES * 64, 2) mega_fwd(Args args) {
    extern __shared__ __attribute__((aligned(16))) unsigned char lds_raw[];
    LAS unsigned char* lds = (LAS unsigned char*)lds_raw;
    volatile LAS unsigned* MISC = (volatile LAS unsigned*)(lds + MISC_OFF);
    const int tid = threadIdx.x, lane = tid & 63, wave = __builtin_amdgcn_readfirstlane(tid >> 6);
    const int G = gridDim.x, bx = blockIdx.x, vcu = (G % 8 == 0) ? (bx % 8) * (G / 8) + bx / 8 : bx;
    unsigned char* ws = args.ws;
    const float* x = args.in[0]; const float* norm_g = args.in[1]; const float* fox_w_in = args.in[2]; const float* fox_b_f = args.in[3]; const float* fox_w_out = args.in[4];
    const float* swa_w_in = args.in[5]; const float* swa_sinks = args.in[6]; const float* swa_w_out = args.in[7]; const float* final_g = args.in[8];
    float* out = args.out;
    gu32* ctl = (gu32*)(ws + WS_CTL);
    unsigned* KMAX = (unsigned*)(ws + WS_KMAX); unsigned* TICKET = (unsigned*)(ws + WS_TICKET);
    float* SS1 = (float*)(ws + WS_SS1); float* R0 = (float*)(ws + WS_R0); float* ROPE = (float*)(ws + WS_ROPE); float* LOGF = (float*)(ws + WS_LOGF); float* CUM = (float*)(ws + WS_CUM);
    bf16* W1T = (bf16*)(ws + WS_W1T); bf16* W2T = (bf16*)(ws + WS_W2T); bf16* W3T = (bf16*)(ws + WS_W3T); bf16* W4T = (bf16*)(ws + WS_W4T);
    bf16* KAUG = (bf16*)(ws + WS_KAUG);
    bf16* XB = (bf16*)(ws + WS_XB); bf16* Qb = (bf16*)(ws + WS_Q); bf16* Kb = (bf16*)(ws + WS_K); bf16* Vb = (bf16*)(ws + WS_V); bf16* Gb = (bf16*)(ws + WS_G); bf16* YG = (bf16*)(ws + WS_YG);
    for (int u = tid; u < (LDS_BYTES - LDSCTL_OFF) / 4; u += NWAVES * 64) ((LAS unsigned*)(lds + LDSCTL_OFF))[u] = 0u;
    __syncthreads();
    const int lo = args.ph_lo, hi = args.ph_hi;
    XcdBarrier bar; bar.bar = (unsigned*)(ctl + CW_BAR); bar.x = 0; bar.st = nullptr;
    if (hi - lo > 1) bar = xcd_barrier_post((unsigned*)(ctl + CW_BAR), MISC + 8);
#define IN(k) (lo <= (k) && (k) < hi)
#define REP(k) for (int rep_ = 0; rep_ < (((DUP_MASK >> (k)) & 1) ? 2 : 1); ++rep_)
#define SEAM(k) do { if (IN(k) && IN((k) + 1)) xcd_barrier(bar); } while (0)
    const int gw = vcu * NWAVES + wave, NGW = G * NWAVES;
    const bool grp = (G == 256) && lo == 0 && hi == N_PHASES;
    const int gpm = 8 * (bx & 7) + ((bx >> 3) & 7), gj = bx >> 6;
    unsigned* GS = (unsigned*)(ws + WS_GS);
    unsigned* XT = (unsigned*)(ws + WS_XT);
    if (grp && tid == 0) __hip_atomic_store(XT + bx, xb_xcc_id() + 1u, __ATOMIC_RELAXED, __HIP_MEMORY_SCOPE_AGENT);
#define G_ARRIVE() do { asm volatile("s_waitcnt vmcnt(0)" ::: "memory"); __syncthreads(); \
        if (tid == 0) { if (MISC[12] != 0u) { __builtin_amdgcn_fence(__ATOMIC_RELEASE, "agent"); asm volatile("s_waitcnt vmcnt(0)" ::: "memory"); } (void)xb_add(GS + gpm * 16, 1u); } } while (0)
#define G_WAIT(pm_, target) do { if (tid == 0) { unsigned* w_ = GS + (pm_) * 16; XB_SPIN(xb_ld(w_) < (unsigned)(target), bar.bar); \
        __builtin_amdgcn_fence(__ATOMIC_ACQUIRE, "agent"); asm volatile("s_waitcnt vmcnt(0)" ::: "memory"); } __syncthreads(); } while (0)

    if (IN(0)) REP(0) {
        LAS float* scr = (LAS float*)(lds + RING_OFF + wave * 16384);
        constexpr int I1 = (DM / 64) * (FOX_IN / 32);
        for (int it = gw; it < I1; it += NGW) p0_transpose_item(fox_w_in, DM, FOX_IN, W1T, scr, it, lane, norm_g);
        for (int m = 2 * gw; m < MTOK; m += 2 * NGW) {
            const int m2 = m + 1;
            const GAS f32x4* xr = (const GAS f32x4*)(x + (size_t)m * DM) + lane; const GAS f32x4* xr2 = (const GAS f32x4*)(x + (size_t)m2 * DM) + lane; f32x4 v[8], v2[8]; float s = 0.f, s2 = 0.f;
#pragma unroll
            for (int j = 0; j < 8; ++j) { v[j] = __builtin_nontemporal_load(xr + 64 * j); v2[j] = __builtin_nontemporal_load(xr2 + 64 * j); }
#pragma unroll
            for (int j = 0; j < 8; ++j) { s += (v[j].x * v[j].x + v[j].y * v[j].y) + (v[j].z * v[j].z + v[j].w * v[j].w); s2 += (v2[j].x * v2[j].x + v2[j].y * v2[j].y) + (v2[j].z * v2[j].z + v2[j].w * v2[j].w); }
            s = wave_sum(s); s2 = wave_sum(s2);
            if (lane == 0) { R0[m] = 1.0f / sqrtf(s * (1.f / DM) + RMS_EPS); R0[m2] = 1.0f / sqrtf(s2 * (1.f / DM) + RMS_EPS); }
#pragma unroll
            for (int j = 0; j < 8; ++j) { *(GAS unsigned long long*)(XB + tiled_off(m, 256 * j + 4 * lane)) = (unsigned long long)pk2(v[j].x, v[j].y) | ((unsigned long long)pk2(v[j].z, v[j].w) << 32);
                                          *(GAS unsigned long long*)(XB + tiled_off(m2, 256 * j + 4 * lane)) = (unsigned long long)pk2(v2[j].x, v2[j].y) | ((unsigned long long)pk2(v2[j].z, v2[j].w) << 32); }
        }
        { const int gt = gw * 64 + lane;
          if (gt < SEQ * 8) { const int pos = gt >> 3, i = gt & 7;
              const double invf[8] = {1.0, 0.19390220519133497, 0.037598065178462524, 0.0072903477503833845, 0.0014142135623730951, 0.00027421912901204056, 5.3171693730649086e-05, 1.0310108130908796e-05};
              double inv = invf[0];
#pragma unroll
              for (int k = 1; k < 8; ++k) inv = (i == k) ? invf[k] : inv;
              const double ang = (double)pos * inv; const double kk = __builtin_rint(ang * 0.15915494309189535); const float red = (float)(ang - kk * 6.283185307179586);
              ROPE[(size_t)pos * 16 + i] = cosf(red); ROPE[(size_t)pos * 16 + 8 + i] = sinf(red); } }
    }
    SEAM(0);
    if (IN(1)) {
        pg8::Gemm g{XB, W1T, MTOK, 4 * DM, DM}; pg8::StaticOrder S; S.init(MTOK, 4 * DM, G, bx, (DUP_MASK >> 1) & 1, (DUP_MASK >> 9) & 1);
        pg8::EpiFoxIn E{Qb, Kb, Vb, Gb, LOGF, R0, fox_b_f, KMAX};
        if ((DUP_MASK >> 10) & 1) { pg8::StaticOrder SP; SP.init(MTOK, 4 * DM, G, bx, 0, 0, 1); pg8::gemm_phase<pg8::EpiFoxIn, pg8::StaticOrder, true, true>(lds + RING_OFF, g, SP, E); }
        pg8::gemm_phase<pg8::EpiFoxIn, pg8::StaticOrder, true, true>(lds + RING_OFF, g, S, E);
        for (int rb = bx * 64; rb < MTOK; rb += G * 64) {
            LAS unsigned char* bl = lds + RING_OFF;
#pragma unroll
            for (int pc = 0; pc < 16; ++pc) { const int pidx = wave + 8 * pc;
                fa::glds16(W1T + tiled_off(4 * DM, 0) + (size_t)(pidx >> 1) * 8192 + (pidx & 1) * 512 + lane * 8, (unsigned)__builtin_amdgcn_readfirstlane((int)(unsigned)(uintptr_t)(bl + pidx * 1024))); }
            const int arow = rb + 16 * (wave & 3) + (lane & 15), kg = (lane >> 4) * 8, kh = wave >> 2;
            bf16x8 af[32];
#pragma unroll
            for (int ks = 0; ks < 32; ++ks) af[ks] = *(const GAS bf16x8*)(XB + tiled_off(arow, 32 * (32 * kh + ks) + kg));
            asm volatile("s_waitcnt vmcnt(0)" ::: "memory");
            __syncthreads();
            pg8::f32x4 acc0 = {0.f, 0.f, 0.f, 0.f}, acc1 = {0.f, 0.f, 0.f, 0.f};
            const LAS unsigned char* bp = bl + (32 * kh) * 2048 + (lane & 15) * 64 + (lane >> 4) * 16;
#pragma unroll
            for (int ks = 0; ks < 32; ++ks) {
                const bf16x8 b0 = *(const LAS bf16x8*)(bp + ks * 2048), b1 = *(const LAS bf16x8*)(bp + ks * 2048 + 1024);
                acc0 = __builtin_amdgcn_mfma_f32_16x16x32_bf16(af[ks], b0, acc0, 0, 0, 0); acc1 = __builtin_amdgcn_mfma_f32_16x16x32_bf16(af[ks], b1, acc1, 0, 0, 0); }
            __syncthreads();
            LAS pg8::f32x4* xs = (LAS pg8::f32x4*)bl + ((wave & 3) * 64 + lane) * 2;
            if (kh == 1) { xs[0] = acc0; xs[1] = acc1; }
            __syncthreads();
            if (kh == 0) {
                acc0 = acc0 + xs[0]; acc1 = acc1 + xs[1];
                const int r0 = rb + 16 * (wave & 3) + 4 * (lane >> 4); const float s0 = R0[r0], s1 = R0[r0 + 1], s2 = R0[r0 + 2], s3 = R0[r0 + 3];
#pragma unroll
                for (int g2 = 0; g2 < 2; ++g2) { const int h = 16 * g2 + (lane & 15); const float bb = fox_b_f[h]; const pg8::f32x4 a = g2 ? acc1 : acc0;
                    f32x4 o; o.x = logsigmoidf(a[0] * s0 + bb); o.y = logsigmoidf(a[1] * s1 + bb); o.z = logsigmoidf(a[2] * s2 + bb); o.w = logsigmoidf(a[3] * s3 + bb);
                    *(GAS f32x4*)(LOGF + ((size_t)((r0 >> 12) * NH + h) << 12) + (r0 & 4095)) = o; }
            }
            __syncthreads();
        }
        { LAS float* scr = (LAS float*)(lds + RING_OFF + wave * 16384);
          constexpr int I2 = (DM / 64) * (DM / 32), I3 = (DM / 64) * (SWA_IN / 32);
          for (int it = gw; it < I2 + I3; it += NGW) { if (it < I2) p0_transpose_item(fox_w_out, DM, DM, W2T, scr, it, lane, nullptr); else p0_transpose_item(swa_w_in, DM, SWA_IN, W3T, scr, it - I2, lane, norm_g + DM); } }
    }
    SEAM(1);
    if (IN(2)) REP(2) {
        for (int sq = vcu; sq < NB * NH; sq += G) {
            const GAS f32x4* lf = (const GAS f32x4*)(LOGF + (size_t)sq * SEQ + wave * 512) + lane * 2; const f32x4 v0 = lf[0], v1 = lf[1];
            const double tot = (((double)v0.x + (double)v0.y) + ((double)v0.z + (double)v0.w)) + (((double)v1.x + (double)v1.y) + ((double)v1.z + (double)v1.w));
            double incl = tot;
#pragma unroll
            for (int o = 1; o < 64; o <<= 1) { const double up = __shfl_up(incl, o); if (lane >= o) incl += up; }
            volatile LAS double* wt = (volatile LAS double*)(lds + RING_OFF);
            __syncthreads();
            if (lane == 63) wt[wave] = incl;
            __syncthreads();
            double run = incl - tot;
            for (int w2 = 0; w2 < wave; ++w2) run += wt[w2];
            const float vv[8] = {v0.x, v0.y, v0.z, v0.w, v1.x, v1.y, v1.z, v1.w}; float cv[8];
#pragma unroll
            for (int e = 0; e < 8; ++e) { run += (double)vv[e]; cv[e] = (float)(run * 1.4426950408889634); }
            GAS f32x4* co = (GAS f32x4*)(CUM + (size_t)sq * SEQ + wave * 512) + lane * 2; co[0] = (f32x4){cv[0], cv[1], cv[2], cv[3]}; co[1] = (f32x4){cv[4], cv[5], cv[6], cv[7]};
            GAS v4u* ka = (GAS v4u*)(KAUG + ((size_t)sq * SEQ + wave * 512 + lane * 8) * 8);
#pragma unroll
            for (int e = 0; e < 8; ++e) { unsigned h1, h2, h3; fa::split3(-cv[e], h1, h2, h3); ka[e] = (v4u){h1 | (h2 << 16), h3 | 0x3F800000u, 0x3F803F80u, 0u}; }
        }
        { const int nidle = G > NB * NH ? G - NB * NH : G, ii = G > NB * NH ? vcu - NB * NH : vcu;
          if (ii >= 0) { __syncthreads(); LAS float* scr = (LAS float*)(lds + RING_OFF + wave * 16384); constexpr int I2 = (DM / 64) * (DM / 32);
              for (int it = ii * NWAVES + wave; it < I2; it += nidle * NWAVES) p0_transpose_item(swa_w_out, DM, DM, W4T, scr, it, lane, nullptr); } }
    }
    SEAM(2);
    if (IN(3)) {
        const fa::Params P{Qb, Kb, Vb, Gb, YG, CUM, nullptr, KMAX, TICKET, KAUG};
        if (grp && tid == 0) {
            const unsigned me = xb_xcc_id() + 1u; const int pn = gpm + 1, two = ((pn & 15) != 0) ? 1 : 0, pq = two ? pn : gpm;
            const unsigned r0 = xb_ld(XT + 8 * (16 + (gpm & 7)) + (gpm >> 3)), r1 = xb_ld(XT + 8 * (24 + (gpm & 7)) + (gpm >> 3));
            const unsigned r2 = xb_ld(XT + 8 * (16 + (pq & 7)) + (pq >> 3)), r3 = xb_ld(XT + 8 * (24 + (pq & 7)) + (pq >> 3));
            MISC[12] = (r0 != me || r1 != me || r2 != me || r3 != me) ? 1u : 0u; }
        volatile LAS unsigned* slot = (volatile LAS unsigned*)(lds + RING_OFF + fa::F_FLAG + 128);
#define FOX_FETCH(dst) do { unsigned code_ = 0xFFFFFFFFu; for (int k_ = 0; k_ < 8; ++k_) { const unsigned q_ = (unsigned)((bx + k_) & 7); const unsigned t_ = atomicAdd(TICKET + q_ * 64, 1u); \
            if (t_ < 256u) { code_ = q_ * 256u + t_; break; } } (dst) = code_; } while (0)
        if (tid == 0) FOX_FETCH(slot[0]);
        __syncthreads();
        unsigned tk = slot[0]; int par = 0;
        while (tk != 0xFFFFFFFFu) {
            if (tid == 0) FOX_FETCH(slot[par ^ 1]);
            const int q = (int)(tk >> 8), tq = (int)(tk & 255u), pi = tq >> 4, hs = 3 - (pi >> 2);
            const int h = hs == 0 ? q : hs == 1 ? 15 - q : hs == 2 ? 16 + q : 31 - q;
            fa::fox_unit(lds + RING_OFF, P, pi & 3, h, 15 - (tq & 15));
            par ^= 1; tk = slot[par];
        }
#undef FOX_FETCH
        __syncthreads();
    }
    SEAM(3);
    if (IN(4)) {
        pg8::Gemm g{YG, W2T, MTOK, DM, DM}; pg8::StaticOrder S; S.init(MTOK, DM, G, bx);
        pg8::EpiRes<false> E{nullptr, XB, SS1};
        pg8::gemm_phase<pg8::EpiRes<false>, pg8::StaticOrder, true, true>(lds + RING_OFF, g, S, E);
    }
    SEAM(4);
    if (IN(5)) {
        pg8::Gemm g{XB, W3T, MTOK, SWA_IN, DM}; pg8::StaticOrder S; S.init(MTOK, SWA_IN, G, bx, (DUP_MASK >> 5) & 1, 0, 0, 0, grp ? 4 : (1 << 20));
        pg8::EpiSwaIn E{Qb, Kb, Vb, Gb, SS1, ROPE};
        pg8::gemm_phase<pg8::EpiSwaIn, pg8::StaticOrder, true, true>(lds + RING_OFF, g, S, E);
        if (grp) {
            G_ARRIVE();
            if (gj < 2) { pg8::StaticOrder S4; S4.init(MTOK, SWA_IN, G, bx, 0, 0, 0, 4, 5); pg8::gemm_phase<pg8::EpiSwaIn, pg8::StaticOrder, true, true>(lds + RING_OFF, g, S4, E); }
            else { const fa::Params P{Qb, Kb, Vb, Gb, YG, nullptr, swa_sinks, nullptr, nullptr, nullptr};
                   G_WAIT(gpm, 4); if ((gpm & 15) != 0) G_WAIT(gpm - 1, 4);
                   fa::swa_unit(lds + RING_OFF, P, gpm >> 4, gj - 2, gpm & 15); }
        }
    }
    SEAM(5);
    if (IN(6)) REP(6) {
        const fa::Params P{Qb, Kb, Vb, Gb, YG, nullptr, swa_sinks, nullptr, nullptr, nullptr};
        if (grp) fa::swa_unit(lds + RING_OFF, P, gpm >> 4, 2 + (gj >> 1), gpm & 15, (gj & 1) * 4, (gj & 1) * 4 + 4);
        else for (int u = bx; u < NB * 4 * 16; u += G) fa::swa_unit(lds + RING_OFF, P, u >> 6, (u >> 4) & 3, u & 15);
    }
    SEAM(6);
    if (IN(7)) {
        pg8::Gemm g{YG, W4T, MTOK, DM, DM}; pg8::StaticOrder S; S.init(MTOK, DM, G, bx);
        pg8::EpiRes<false> E{nullptr, XB, nullptr};
        pg8::gemm_phase<pg8::EpiRes<false>, pg8::StaticOrder, true, true>(lds + RING_OFF, g, S, E);
    }
    SEAM(7);
    if (IN(8)) {
        f32x4 gq[8];
#pragma unroll
        for (int j = 0; j < 8; ++j) gq[j] = ((const GAS f32x4*)final_g)[lane + 64 * j];
        for (int m = 2 * gw; m < MTOK; m += 2 * NGW) {
            f32x4 v[8], v2[8]; float s = 0.f, s2 = 0.f; unsigned long long xw[8], xw2[8];
#pragma unroll
            for (int j = 0; j < 8; ++j) { xw[j] = *(const GAS unsigned long long*)(XB + tiled_off(m, 256 * j + 4 * lane)); xw2[j] = *(const GAS unsigned long long*)(XB + tiled_off(m + 1, 256 * j + 4 * lane)); }
#pragma unroll
            for (int j = 0; j < 8; ++j) { const unsigned lo32 = (unsigned)xw[j], hi32 = (unsigned)(xw[j] >> 32), lo2 = (unsigned)xw2[j], hi2 = (unsigned)(xw2[j] >> 32);
                v[j] = (f32x4){__uint_as_float(lo32 << 16), __uint_as_float(lo32 & 0xffff0000u), __uint_as_float(hi32 << 16), __uint_as_float(hi32 & 0xffff0000u)};
                v2[j] = (f32x4){__uint_as_float(lo2 << 16), __uint_as_float(lo2 & 0xffff0000u), __uint_as_float(hi2 << 16), __uint_as_float(hi2 & 0xffff0000u)};
                s += (v[j].x * v[j].x + v[j].y * v[j].y) + (v[j].z * v[j].z + v[j].w * v[j].w); s2 += (v2[j].x * v2[j].x + v2[j].y * v2[j].y) + (v2[j].z * v2[j].z + v2[j].w * v2[j].w); }
            const float r = 1.0f / sqrtf(wave_sum(s) * (1.f / DM) + RMS_EPS), r2 = 1.0f / sqrtf(wave_sum(s2) * (1.f / DM) + RMS_EPS);
            GAS f32x4* xr = (GAS f32x4*)(out + (size_t)m * DM) + lane; GAS f32x4* xr2 = (GAS f32x4*)(out + (size_t)(m + 1) * DM) + lane;
#pragma unroll
            for (int j = 0; j < 8; ++j) { __builtin_nontemporal_store(v[j] * r * gq[j], xr + 64 * j); __builtin_nontemporal_store(v2[j] * r2 * gq[j], xr2 + 64 * j); }
        }
    }
#undef IN
#undef SEAM
#undef G_ARRIVE
#undef G_WAIT
}

extern "C" void kernel_launch(void* const* d_in, const int* in_sizes, int n_in, void* d_out, int out_size, void* d_ws, size_t ws_size, hipStream_t stream) {
    static int grid = 0;
    if (grid == 0) {
        if (n_in != 9 || in_sizes[0] != MTOK * DM || out_size != MTOK * DM || ws_size < WS_END) { fprintf(stderr, "kernel_launch: unexpected shapes (n_in %d, in0 %d, out %d, ws %zu)\n", n_in, n_in > 0 ? in_sizes[0] : -1, out_size, ws_size); grid = -1; return; }
        int dev = 0, cus = 0, per_cu = 0;
        if (hipGetDevice(&dev) != hipSuccess || hipDeviceGetAttribute(&cus, hipDeviceAttributeMultiprocessorCount, dev) != hipSuccess) { fprintf(stderr, "kernel_launch: device query failed\n"); grid = -1; return; }
        if (hipFuncSetAttribute((const void*)mega_fwd, hipFuncAttributeMaxDynamicSharedMemorySize, LDS_BYTES) != hipSuccess) { fprintf(stderr, "kernel_launch: hipFuncSetAttribute failed\n"); grid = -1; return; }
        if (hipOccupancyMaxActiveBlocksPerMultiprocessor(&per_cu, (const void*)mega_fwd, NWAVES * 64, LDS_BYTES) != hipSuccess || per_cu < 1) { fprintf(stderr, "kernel_launch: occupancy query reports %d workgroups per CU; nothing launched\n", per_cu); (void)hipGetLastError(); grid = -1; return; }
        grid = cus;
    }
    if (grid < 0) return;
    (void)hipMemsetAsync((unsigned char*)d_ws + WS_CTL, 0, CTL_ZERO_BYTES, stream);
    Args a{};
    for (int i = 0; i < 9; ++i) a.in[i] = (const float*)d_in[i];
    a.out = (float*)d_out; a.ws = (unsigned char*)d_ws;
    int p = 0;
    while (p < N_PHASES) {
        if (!((FAST_MASK >> p) & 1)) { ++p; continue; }
        int e = p + 1; if (ONE_LAUNCH) while (e < N_PHASES && ((FAST_MASK >> e) & 1)) ++e;
        a.ph_lo = p; a.ph_hi = e;
        hipLaunchKernelGGL(mega_fwd, dim3(grid), dim3(NWAVES * 64), LDS_BYTES, stream, a);
        p = e;
    }
}
```
